# Optimizing an MI355X kernel written in HIP

```python
import jax, jax.numpy as jnp
from jax import lax
import numpy as np

D_MODEL = 1024
BATCH = 2
SEQ = 8192
DEPTH = 2

GRID_W = 64
CTX_LEN = 256
HEAD_DIM = 64
HGRN_HEADS = 4
HGRN_DK = 64
HGRN_DV = 64
HGRN_CHUNK = 64
HGRN_QK = HGRN_HEADS * HGRN_DK
HGRN_W = HGRN_HEADS * HGRN_DV
LB_MIN = 1e-6
NA_HEADS = 4
NA_WIN_ROWS = 8
NA_WIN_COLS = 16
NA_KEY_COLS = 2 * NA_WIN_COLS
NA_W = NA_HEADS * HEAD_DIM
SWA_Q_HEADS = 8
SWA_KV_HEADS = 2
SWA_GROUP = SWA_Q_HEADS // SWA_KV_HEADS
SWA_WINDOW = 128
SWA_BLOCK = 128
SWA_W = SWA_Q_HEADS * HEAD_DIM
SWA_KV_W = SWA_KV_HEADS * HEAD_DIM
ROPE_BASE = 10000.0
MIX_W = HGRN_W + NA_W + SWA_W
IN_W = 3 * HGRN_QK + 2 * HGRN_W + 3 * NA_W + SWA_W + 2 * SWA_KV_W
N_EXPERTS = 16
N_GROUPS = 4
TOP_K = 2
D_EXPERT = 512
LN_EPS = 1e-5
RMS_EPS = 1e-6
NEG = -1e30

kernel_name = 'hybrid_hgrn2_natten_swa_moe_dit'

F32 = jnp.float32


def layer_norm(x, g, b):
    xf = x.astype(F32)
    mu = jnp.mean(xf, axis=-1, keepdims=True)
    var = jnp.mean(jnp.square(xf - mu), axis=-1, keepdims=True)
    y = (xf - mu) * lax.rsqrt(var + LN_EPS) * g.astype(F32) + b.astype(F32)
    return y.astype(x.dtype)


def rms_norm(x, g):
    xf = x.astype(F32)
    y = xf * lax.rsqrt(jnp.mean(jnp.square(xf), axis=-1, keepdims=True) + RMS_EPS) * g.astype(F32)
    return y.astype(x.dtype)


def heads(a, n):
    return a.reshape(a.shape[0], a.shape[1], n, -1).transpose(0, 2, 1, 3)


def merge_heads(a):
    return a.transpose(0, 2, 1, 3).reshape(a.shape[0], a.shape[2], -1)


def flip_t(a):
    return jnp.flip(a, axis=2)


def axial_rope(x, row, col):
    half = HEAD_DIM // 2
    nf = half // 2
    inv = ROPE_BASE ** (-jnp.arange(nf, dtype=F32) / nf)

    def rot(xp, pos):
        ang = pos.astype(F32)[:, None] * inv
        cos = jnp.cos(ang).astype(x.dtype)
        sin = jnp.sin(ang).astype(x.dtype)
        x1, x2 = xp[..., :nf], xp[..., nf:]
        return jnp.concatenate([x1 * cos - x2 * sin, x1 * sin + x2 * cos], axis=-1)

    return jnp.concatenate([rot(x[..., :half], row), rot(x[..., half:], col)], axis=-1)


def hgrn_gates(z, lb):
    zf = z.astype(F32)
    logf = jnp.logaddexp(jnp.log(lb), jnp.log1p(-lb) + jax.nn.log_sigmoid(zf))
    k = (1.0 - lb) * jax.nn.sigmoid(-zf)
    return heads(logf, HGRN_HEADS), heads(k, HGRN_HEADS)


def hgrn_scan(q, k, v, logf, s0):
    b_, h_, t_, _ = q.shape
    dv = v.shape[-1]
    nc = t_ // HGRN_CHUNK

    def chunks(a):
        return a.reshape(b_, h_, nc, HGRN_CHUNK, a.shape[-1]).transpose(2, 0, 1, 3, 4)

    lower = jnp.tril(jnp.ones((HGRN_CHUNK, HGRN_CHUNK), dtype=bool))[:, :, None]

    def step(state, inp):
        qc, kc, vc, lf = inp
        cum = jnp.cumsum(lf, axis=2)
        inter = jnp.einsum('bhtd,bhde->bhte', qc * jnp.exp(cum), state)
        decay = jnp.exp(jnp.where(lower, cum[:, :, :, None, :] - cum[:, :, None, :, :], NEG))
        scores = jnp.einsum('bhtd,bhsd,bhtsd->bhts', qc, kc, decay)
        out = inter + jnp.einsum('bhts,bhse->bhte', scores, vc)
        last = cum[:, :, -1:, :]
        new_state = jnp.exp(last[:, :, 0, :, None]) * state + jnp.einsum(
            'bhsd,bhse->bhde', kc * jnp.exp(last - cum), vc)
        return new_state, out

    s_fin, out = lax.scan(step, s0, (chunks(q), chunks(k), chunks(v), chunks(logf)))
    return out.transpose(1, 2, 0, 3, 4).reshape(b_, h_, t_, dv), s_fin


def ctx_attention(q, k, v, sink):
    s = jnp.einsum('bngtd,bnkd->bngtk', q, k).astype(F32) * q.shape[-1] ** -0.5
    if sink is None:
        p = jax.nn.softmax(s, axis=-1)
    else:
        s_sink = jnp.broadcast_to(sink.astype(F32)[None, :, :, None, None], s.shape[:-1] + (1,))
        p = jax.nn.softmax(jnp.concatenate([s, s_sink], axis=-1), axis=-1)[..., :-1]
    return jnp.einsum('bngtk,bnkd->bngtd', p.astype(v.dtype), v)


def neighborhood_attention(q, k, v, kc, vc, rpb):
    b_, h_, l_, dh = q.shape
    rows = l_ // GRID_W
    wr = min(NA_WIN_ROWS, rows)
    ncb = GRID_W // NA_WIN_COLS
    scale = dh ** -0.5
    qcol = jnp.arange(GRID_W).reshape(ncb, NA_WIN_COLS)
    cs = jnp.clip(qcol - NA_WIN_COLS // 2, 0, GRID_W - NA_WIN_COLS)
    blk = jnp.clip(jnp.arange(ncb) * NA_WIN_COLS - NA_WIN_COLS // 2, 0, GRID_W - NA_KEY_COLS)
    kcol = blk[:, None] + jnp.arange(NA_KEY_COLS)
    colmask = (kcol[:, None, :] >= cs[:, :, None]) & (kcol[:, None, :] < cs[:, :, None] + NA_WIN_COLS)
    coff = jnp.clip(kcol[:, None, :] - qcol[:, :, None] + NA_WIN_COLS - 1, 0, 2 * NA_WIN_COLS - 2)
    rpb_c = rpb[:, :, coff].astype(F32)
    kg = k.reshape(b_, h_, rows, GRID_W, dh)
    vg = v.reshape(b_, h_, rows, GRID_W, dh)
    qg = q.reshape(b_, h_, rows, ncb, NA_WIN_COLS, dh).transpose(2, 0, 1, 3, 4, 5)
    nw = wr * NA_KEY_COLS

    def row_block(inp):
        r, qr = inp
        rs = jnp.clip(r - wr // 2, 0, rows - wr)
        kw = jnp.take(lax.dynamic_slice_in_dim(kg, rs, wr, axis=2), kcol, axis=3)
        vw = jnp.take(lax.dynamic_slice_in_dim(vg, rs, wr, axis=2), kcol, axis=3)
        ridx = rs + jnp.arange(wr) - r + NA_WIN_ROWS - 1
        bias = jnp.take(rpb_c, ridx, axis=1).transpose(0, 2, 3, 1, 4)
        s_win = jnp.einsum('bhjud,bhrjvd->bhjurv', qr, kw).astype(F32) * scale + bias
        s_win = jnp.where(colmask[:, :, None, :], s_win, NEG)
        s_ctx = jnp.einsum('bhjud,bhkd->bhjuk', qr, kc).astype(F32) * scale
        p = jax.nn.softmax(jnp.concatenate(
            [s_win.reshape(b_, h_, ncb, NA_WIN_COLS, nw), s_ctx], axis=-1), axis=-1).astype(q.dtype)
        p_win = p[..., :nw].reshape(b_, h_, ncb, NA_WIN_COLS, wr, NA_KEY_COLS)
        return (jnp.einsum('bhjurv,bhrjvd->bhjud', p_win, vw)
                + jnp.einsum('bhjuk,bhkd->bhjud', p[..., nw:], vc))

    o = lax.map(row_block, (jnp.arange(rows), qg))
    return o.transpose(1, 2, 0, 3, 4, 5).reshape(b_, h_, l_, dh)


def swa_attention(q, k, v, kc, vc, sink):
    b_, n_, g_, l_, dh = q.shape
    nb = l_ // SWA_BLOCK
    nctx = kc.shape[2]
    scale = dh ** -0.5
    qb = q.reshape(b_, n_, g_, nb, SWA_BLOCK, dh)

    def band(a):
        ap = jnp.pad(a, ((0, 0), (0, 0), (SWA_BLOCK, SWA_BLOCK), (0, 0))).reshape(b_, n_, nb + 2, SWA_BLOCK, dh)
        return jnp.concatenate([ap[:, :, :-2], ap[:, :, 1:-1], ap[:, :, 2:]], axis=3)

    kb, vb = band(k), band(v)
    qpos = jnp.arange(nb)[:, None] * SWA_BLOCK + jnp.arange(SWA_BLOCK)[None, :]
    kpos = (jnp.arange(nb)[:, None] - 1) * SWA_BLOCK + jnp.arange(3 * SWA_BLOCK)[None, :]
    mask = ((kpos[:, None, :] >= 0) & (kpos[:, None, :] < l_)
            & (jnp.abs(qpos[:, :, None] - kpos[:, None, :]) <= SWA_WINDOW))
    s_band = jnp.where(mask, jnp.einsum('bngjud,bnjvd->bngjuv', qb, kb).astype(F32) * scale, NEG)
    s_ctx = jnp.einsum('bngjud,bnkd->bngjuk', qb, kc).astype(F32) * scale
    s_sink = jnp.broadcast_to(sink.astype(F32)[None, :, :, None, None, None], s_ctx.shape[:-1] + (1,))
    p = jax.nn.softmax(jnp.concatenate([s_band, s_ctx, s_sink], axis=-1), axis=-1).astype(q.dtype)
    nk = 3 * SWA_BLOCK
    o = (jnp.einsum('bngjuv,bnjvd->bngjud', p[..., :nk], vb)
         + jnp.einsum('bngjuk,bnkd->bngjud', p[..., nk:nk + nctx], vc))
    return o.reshape(b_, n_, g_, l_, dh)


def mixer(h, hc, w_in, lb_fwd, lb_bwd, hgrn_norm, rpb, sink, w_out, with_ctx_out):
    b_, l_, _ = h.shape
    t = jnp.arange(l_)
    row, col = t // GRID_W, t % GRID_W
    sizes = [HGRN_QK, HGRN_QK, HGRN_QK, HGRN_W, HGRN_W, NA_W, NA_W, NA_W, SWA_W, SWA_KV_W, SWA_KV_W]
    splits = np.cumsum(sizes)[:-1].tolist()
    aq, af, ab, ai, ag, nq, nk, nv, sq, sk, sv = jnp.split(h @ w_in, splits, axis=-1)
    caq, caf, cab, cai, cag, cnq, cnk, cnv, csq, csk, csv = jnp.split(hc @ w_in, splits, axis=-1)

    lf_f, k_f = hgrn_gates(af, lb_fwd)
    lf_b, k_b = hgrn_gates(ab, lb_bwd)
    clf_f, ck_f = hgrn_gates(caf, lb_fwd)
    clf_b, ck_b = hgrn_gates(cab, lb_bwd)
    q_a, v_a = heads(aq, HGRN_HEADS).astype(F32), heads(ai, HGRN_HEADS).astype(F32)
    cq_a, cv_a = heads(caq, HGRN_HEADS).astype(F32), heads(cai, HGRN_HEADS).astype(F32)
    s0 = jnp.zeros((b_, HGRN_HEADS, HGRN_DK, HGRN_DV), F32)
    oc_f, sc_f = hgrn_scan(cq_a, ck_f, cv_a, clf_f, s0)
    oc_b, sc_b = hgrn_scan(flip_t(cq_a), flip_t(ck_b), flip_t(cv_a), flip_t(clf_b), s0)
    o_f, _ = hgrn_scan(q_a, k_f, v_a, lf_f, sc_f)
    o_b, _ = hgrn_scan(flip_t(q_a), flip_t(k_b), flip_t(v_a), flip_t(lf_b), sc_b)
    y_a = merge_heads(rms_norm(o_f + flip_t(o_b), hgrn_norm)).astype(h.dtype) * jax.nn.silu(ag)

    kc_n, vc_n = heads(cnk, NA_HEADS), heads(cnv, NA_HEADS)
    y_b = merge_heads(neighborhood_attention(heads(nq, NA_HEADS), heads(nk, NA_HEADS),
                                             heads(nv, NA_HEADS), kc_n, vc_n, rpb))

    q_s = axial_rope(heads(sq, SWA_Q_HEADS), row, col).reshape(b_, SWA_KV_HEADS, SWA_GROUP, l_, HEAD_DIM)
    k_s = axial_rope(heads(sk, SWA_KV_HEADS), row, col)
    v_s = heads(sv, SWA_KV_HEADS)
    kc_s, vc_s = heads(csk, SWA_KV_HEADS), heads(csv, SWA_KV_HEADS)
    sink_g = sink.reshape(SWA_KV_HEADS, SWA_GROUP)
    y_c = merge_heads(swa_attention(q_s, k_s, v_s, kc_s, vc_s, sink_g).reshape(b_, SWA_Q_HEADS, l_, HEAD_DIM))

    y = jnp.concatenate([y_a, y_b, y_c], axis=-1) @ w_out
    if not with_ctx_out:
        return y, None
    nctx = hc.shape[1]
    yc_a = merge_heads(rms_norm(oc_f + flip_t(oc_b), hgrn_norm)).astype(hc.dtype) * jax.nn.silu(cag)
    yc_b = merge_heads(ctx_attention(heads(cnq, NA_HEADS)[:, :, None], kc_n, vc_n, None)[:, :, 0])
    cq_s = heads(csq, SWA_Q_HEADS).reshape(b_, SWA_KV_HEADS, SWA_GROUP, nctx, HEAD_DIM)
    yc_c = merge_heads(ctx_attention(cq_s, kc_s, vc_s, sink_g).reshape(b_, SWA_Q_HEADS, nctx, HEAD_DIM))
    yc = jnp.concatenate([yc_a, yc_b, yc_c], axis=-1) @ w_out
    return y, yc


def moe(h, w_router, router_bias, w_gate, w_up, w_down):
    n = h.shape[0]
    epg = N_EXPERTS // N_GROUPS
    s = jax.nn.sigmoid((h @ w_router).astype(F32))
    sel = s + router_bias.astype(F32)
    grp = lax.top_k(sel.reshape(n, N_GROUPS, epg), TOP_K)[0].sum(-1)
    best = jnp.argmax(grp, axis=-1)
    in_group = (jnp.arange(N_EXPERTS) // epg)[None, :] == best[:, None]
    _, idx = lax.top_k(jnp.where(in_group, sel, NEG), TOP_K)
    w = jnp.take_along_axis(s, idx, axis=-1)
    w = w / jnp.sum(w, axis=-1, keepdims=True)
    gates = jnp.sum(jax.nn.one_hot(idx, N_EXPERTS, dtype=F32) * w[..., None], axis=1).astype(h.dtype)
    y = jnp.zeros_like(h)
    for e in range(N_EXPERTS):
        he = jax.nn.silu(h @ w_gate[e]) * (h @ w_up[e])
        y = y + gates[:, e:e + 1] * (he @ w_down[e])
    return y


def ada_mod(cond, w, b):
    m = (jax.nn.silu(cond) @ w + b)[..., None, :]
    return jnp.split(m, 6, axis=-1)


def setup_inputs(seed: int = 0) -> dict:
    key = jax.random.key(seed)
    ks = jax.random.split(key, 21)
    nrm = jax.random.normal
    beta = (8.0 * DEPTH) ** -0.25
    d = D_MODEL
    return {
        'x': nrm(ks[0], (BATCH, SEQ, d), F32),
        'c': nrm(ks[1], (BATCH, d), F32),
        'ctx': nrm(ks[2], (BATCH, CTX_LEN, d), F32),
        'c_ctx': nrm(ks[3], (d,), F32),
        'w_ada': nrm(ks[4], (DEPTH, d, 6 * d), F32) * (0.5 * d ** -0.5),
        'b_ada': nrm(ks[5], (DEPTH, 6 * d), F32) * 0.02,
        'w_in': nrm(ks[6], (DEPTH, d, IN_W), F32) * d ** -0.5,
        'lb_logits': nrm(ks[7], (DEPTH, 2, HGRN_QK), F32),
        'hgrn_norm': 1.0 + 0.1 * nrm(ks[8], (DEPTH, HGRN_DV), F32),
        'na_rpb': 0.02 * nrm(ks[9], (DEPTH, NA_HEADS, 2 * NA_WIN_ROWS - 1, 2 * NA_WIN_COLS - 1), F32),
        'swa_sink': nrm(ks[10], (DEPTH, SWA_Q_HEADS), F32),
        'w_out': nrm(ks[11], (DEPTH, MIX_W, d), F32) * (MIX_W ** -0.5 * beta),
        'ln1_g': 1.0 + 0.1 * nrm(ks[12], (DEPTH, d), F32),
        'ln1_b': 0.02 * nrm(ks[13], (DEPTH, d), F32),
        'ln2_g': 1.0 + 0.1 * nrm(ks[14], (DEPTH, d), F32),
        'ln2_b': 0.02 * nrm(ks[15], (DEPTH, d), F32),
        'w_router': nrm(ks[16], (d, N_EXPERTS), F32) * d ** -0.5,
        'router_bias': 0.01 * nrm(ks[17], (N_EXPERTS,), F32),
        'w_gate': nrm(ks[18], (DEPTH, N_EXPERTS, d, D_EXPERT), F32) * d ** -0.5,
        'w_up': nrm(ks[19], (DEPTH, N_EXPERTS, d, D_EXPERT), F32) * d ** -0.5,
        'w_down': nrm(ks[20], (DEPTH, N_EXPERTS, D_EXPERT, d), F32) * (D_EXPERT ** -0.5 * beta),
    }


def reference(x, c, ctx, c_ctx, w_ada, b_ada, w_in, lb_logits, hgrn_norm, na_rpb, swa_sink, w_out,
              ln1_g, ln1_b, ln2_g, ln2_b, w_router, router_bias, w_gate, w_up, w_down):
    b_, l_, d = x.shape
    alpha = (2.0 * DEPTH) ** 0.25
    p_lb = jax.nn.softmax(lb_logits.astype(F32), axis=0)
    lb_all = jnp.maximum(jnp.cumsum(p_lb, axis=0) - p_lb[0:1], LB_MIN)
    for l in range(DEPTH):
        last = l == DEPTH - 1
        sh1, sc1, g1, sh2, sc2, g2 = ada_mod(c, w_ada[l], b_ada[l])
        csh1, csc1, cg1, csh2, csc2, cg2 = ada_mod(c_ctx, w_ada[l], b_ada[l])
        h = x * (1.0 + sc1) + sh1
        hc = ctx * (1.0 + csc1) + csh1
        y, yc = mixer(h, hc, w_in[l], lb_all[l, 0], lb_all[l, 1], hgrn_norm[l], na_rpb[l], swa_sink[l],
                      w_out[l], not last)
        x = layer_norm(alpha * x + g1 * y, ln1_g[l], ln1_b[l])
        h2 = x * (1.0 + sc2) + sh2
        if last:
            f = moe(h2.reshape(-1, d), w_router, router_bias, w_gate[l], w_up[l], w_down[l]).reshape(x.shape)
            x = layer_norm(alpha * x + g2 * f, ln2_g[l], ln2_b[l])
        else:
            ctx = layer_norm(alpha * ctx + cg1 * yc, ln1_g[l], ln1_b[l])
            hc2 = ctx * (1.0 + csc2) + csh2
            f = moe(jnp.concatenate([h2, hc2], axis=1).reshape(-1, d), w_router, router_bias,
                    w_gate[l], w_up[l], w_down[l]).reshape(b_, l_ + ctx.shape[1], d)
            x = layer_norm(alpha * x + g2 * f[:, :l_], ln2_g[l], ln2_b[l])
            ctx = layer_norm(alpha * ctx + cg2 * f[:, l_:], ln2_g[l], ln2_b[l])
    return x
```

```cpp
#include <hip/hip_runtime.h>
#include <cstdint>
#include <cstdio>

#ifndef N_LAUNCH_MODE
#define N_LAUNCH_MODE 0
#endif
#ifndef FAST_GEMM
#define FAST_GEMM 0
#endif

#define LAS __attribute__((address_space(3)))
#define GAS __attribute__((address_space(1)))
typedef unsigned short bf16_t;
typedef short bf16x8 __attribute__((ext_vector_type(8)));
typedef float f32x4 __attribute__((ext_vector_type(4)));
typedef float f32x2 __attribute__((ext_vector_type(2)));
typedef unsigned u32x4 __attribute__((ext_vector_type(4)));
typedef unsigned u32x2 __attribute__((ext_vector_type(2)));
#define DI __device__ __forceinline__

constexpr int D = 1024, NB = 2, SEQ = 8192, CTXL = 256, NLAT = NB * SEQ, NCTX = NB * CTXL, NROWS = NLAT + NCTX;
constexpr int INW = 2816, PBW = 2304, ZW = 512, NEXP = 16, DEXP = 512, LISTCAP = NROWS;
constexpr int NTHREADS = 512, NWAVES = 8;
constexpr float ALPHA = 1.41421356237f, LN_EPS = 1e-5f, RMS_EPS = 1e-6f;
constexpr int PB_AQ = 0, PB_AI = 256, PB_AG = 512, PB_NQ = 768, PB_NK = 1024, PB_NV = 1280, PB_SQ = 1536, PB_SK = 2048, PB_SV = 2176;
constexpr int NCHAIN = 132;

constexpr size_t MiB = 1u << 20;
constexpr size_t WS_CTL = 0, CTL_BYTES = 1 * MiB;
constexpr size_t WS_MODS = 1 * MiB;
constexpr size_t WS_LB = WS_MODS + 2 * 3 * 6144 * 4;
constexpr size_t WS_ROPE = WS_LB + 2 * 2 * 256 * 4;
constexpr size_t WS_TOKE = WS_ROPE + 128 * 16 * 2 * 4;
constexpr size_t WS_TOKP = WS_TOKE + NROWS * 8;
constexpr size_t WS_TOKW = WS_TOKP + NROWS * 8;
constexpr size_t WS_LIST = 2 * MiB;
constexpr size_t WS_XC = 4 * MiB;
constexpr size_t WS_WIN = 6 * MiB;
constexpr size_t WS_WOUT = 17 * MiB;
constexpr size_t WS_WGU = 21 * MiB;
constexpr size_t WS_WD = 53 * MiB;
constexpr size_t WS_H = 69 * MiB;
constexpr size_t WS_Y = 102 * MiB;
constexpr size_t WS_S = 135 * MiB;
constexpr size_t WS_DD = 173 * MiB;
constexpr size_t WS_PB = 174 * MiB;
constexpr size_t WS_Z = WS_PB + (size_t)NROWS * PBW * 2;
constexpr size_t WS_O = 174 * MiB;
constexpr size_t WS_YO = 248 * MiB;
constexpr size_t WS_END = 282 * MiB;
constexpr int HE_ROWS = 37888;
static_assert(WS_Z + (size_t)NROWS * ZW * 4 <= WS_END && WS_O + (size_t)HE_ROWS * 1024 * 2 <= WS_YO && WS_YO + (size_t)NROWS * 2048 <= WS_END, "ws map");
static_assert(WS_TOKW + NROWS * 8 <= WS_LIST && WS_LIST + 16 * LISTCAP * 4 <= WS_XC, "ws map small");
constexpr int CW_CNT = 64;
constexpr int CW_BAR = 4096;

struct Params {
    const float* in[21];
    float* out;
    unsigned char* ws;
    int step_lo, step_hi;
};

DI unsigned f2bf(float f) { unsigned u = __builtin_bit_cast(unsigned, f); return (u + 0x7fffu + ((u >> 16) & 1u)) >> 16; }
DI float bf2f(unsigned h) { return __builtin_bit_cast(float, h << 16); }
DI unsigned pk2(float lo, float hi) { return f2bf(lo) | (f2bf(hi) << 16); }
DI float bflo(unsigned w) { return __builtin_bit_cast(float, w << 16); }
DI float bfhi(unsigned w) { return __builtin_bit_cast(float, w & 0xffff0000u); }
DI float wave_sum(float v) {
#pragma unroll
    for (int o = 1; o < 64; o <<= 1) v += __shfl_xor(v, o);
    return v;
}
DI float wave_max(float v) {
#pragma unroll
    for (int o = 1; o < 64; o <<= 1) v = fmaxf(v, __shfl_xor(v, o));
    return v;
}
DI float sigmoidf_(float x) { return 1.0f / (1.0f + __expf(-x)); }
DI float siluf_(float x) { return x / (1.0f + __expf(-x)); }
DI void store_bf4(bf16_t* p, f32x4 v) { u32x2 w; w.x = pk2(v[0], v[1]); w.y = pk2(v[2], v[3]); *(u32x2*)p = w; }

struct Ctx {
    LAS unsigned char* lds;
    int tid, lane, wave, bid, nb;
};

struct Unit { int pm, pn, e, cnt, i0; };

struct PlainSched {
    int nM, nN, nwg, G, c;
    DI void init(int M, int N, int G_, int c_) { nM = M / 256; nN = N / 256; nwg = nM * nN; G = G_; c = c_; }
    DI bool next(int i, Unit& u) const {
        const long L = (long)i * G + c; if (L >= nwg) return false;
        int wgid = (int)L; { const int q = nwg / 8, r = nwg % 8, xcd = wgid % 8, off = wgid / 8; wgid = (xcd < r ? xcd * (q + 1) : r * (q + 1) + (xcd - r) * q) + off; }
        const int nig = 8 * nN, gid = wgid / nig, fm = gid * 8, gsz = (nM - fm) < 8 ? (nM - fm) : 8;
        u.pm = fm + ((wgid % nig) % gsz); u.pn = (wgid % nig) / gsz; u.e = 0; u.cnt = 0; u.i0 = 0; return true;
    }
    DI int a_row(const Unit& u, int r) const { return u.pm * 256 + r; }
    DI int b_row0(const Unit& u) const { return u.pn * 256; }
};
struct MoeSched {
    const int* cnt; const int* list; int G, c, nct, bt_rows; bool gather;
    DI bool next(int i, Unit& u) const {
        const int xcd = c & 7, j = c >> 3; const int L = i * G + xcd * (G >> 3) + j;
        const int T = L / nct; int acc = 0, e = -1, i0 = 0, ce = 0;
#pragma unroll
        for (int q = 0; q < NEXP; ++q) { const int cq = cnt[q]; const int nt = (cq + 255) >> 8; if (e < 0 && T < acc + nt) { e = q; i0 = T - acc; ce = cq; } acc += nt; }
        if (e < 0) return false;
        u.pm = T; u.pn = L % nct; u.e = e; u.cnt = ce; u.i0 = i0; return true;
    }
    DI int a_row(const Unit& u, int r) const {
        if (!gather) return u.pm * 256 + r;
        const int idx = u.i0 * 256 + r; return list[u.e * LISTCAP + (idx < u.cnt ? idx : 0)];
    }
    DI int b_row0(const Unit& u) const { return u.e * bt_rows + u.pn * 256; }
};

struct EpiIn {
    bf16_t* PB; float* Z; const float* rope;
    DI void group(const Unit& u, int r, int c, f32x4 a0, f32x4 a1, f32x4 b0, f32x4 b1) const {
        const int row = u.pm * 256 + r, seg = u.pn, gc = u.pn * 256 + c;
        if (seg == 1 || seg == 2) {
            float* z = Z + (size_t)row * ZW + (seg - 1) * 256 + c;
            *(f32x4*)z = a0; *(f32x4*)(z + 16) = a1; *(f32x4*)(z + 128) = b0; *(f32x4*)(z + 144) = b1;
            return;
        }
        const bool lat = row < NLAT;
        if (seg >= 8 && lat) {
            const int t = row & (SEQ - 1); const int which = (c >> 5) & 1; const int pos = which ? (t & 63) : (t >> 6);
            const float* rp = rope + (pos * 16 + (c & 31)) * 2;
#pragma unroll
            for (int j = 0; j < 4; ++j) {
                const float cs = rp[2 * j], sn = rp[2 * j + 1];
                const float x1 = a0[j], x2 = a1[j]; a0[j] = x1 * cs - x2 * sn; a1[j] = x1 * sn + x2 * cs;
                if (seg < 10) { const float y1 = b0[j], y2 = b1[j]; b0[j] = y1 * cs - y2 * sn; b1[j] = y1 * sn + y2 * cs; }
            }
        }
        if (seg == 5 || seg == 8 || seg == 9) { a0 *= 0.125f; a1 *= 0.125f; b0 *= 0.125f; b1 *= 0.125f; }
        bf16_t* p = PB + (size_t)row * PBW + (gc >= 768 ? gc - 512 : gc);
        store_bf4(p, a0); store_bf4(p + 16, a1); store_bf4(p + 128, b0); store_bf4(p + 144, b1);
    }
};
struct EpiBf {
    bf16_t* C; int ldc;
    DI void group(const Unit& u, int r, int c, f32x4 a0, f32x4 a1, f32x4 b0, f32x4 b1) const {
        bf16_t* p = C + (size_t)(u.pm * 256 + r) * ldc + u.pn * 256 + c;
        store_bf4(p, a0); store_bf4(p + 16, a1); store_bf4(p + 128, b0); store_bf4(p + 144, b1);
    }
};
struct EpiGU {
    bf16_t* HE;
    DI void group(const Unit& u, int r, int c, f32x4 a0, f32x4 a1, f32x4 b0, f32x4 b1) const {
        f32x4 h0, h1;
#pragma unroll
        for (int j = 0; j < 4; ++j) { h0[j] = siluf_(a0[j]) * b0[j]; h1[j] = siluf_(a1[j]) * b1[j]; }
        bf16_t* p = HE + (size_t)(u.pm * 256 + r) * DEXP + u.pn * 128 + c;
        store_bf4(p, h0); store_bf4(p + 16, h1);
    }
};

template <class Sched, class Epi>
DI void gemm_naive(const Ctx& X, const bf16_t* A, const bf16_t* Bt, int K, const Sched& S, const Epi& E) {
    Unit u;
    for (int i = 0; S.next(i, u); ++i) {
        for (int g = X.tid; g < 4096; g += NTHREADS) {
            const int fq = g & 3, wc = (g >> 2) & 3, r = g >> 4, c = wc * 32 + fq * 4;
            const bf16_t* ap = A + (size_t)S.a_row(u, r) * K;
            const bf16_t* bp = Bt + (size_t)(S.b_row0(u) + c) * K;
            float acc[16];
#pragma unroll
            for (int q = 0; q < 16; ++q) acc[q] = 0.f;
            for (int k = 0; k < K; k += 8) {
                const u32x4 av = *(const u32x4*)(ap + k);
                float af[8] = {bflo(av.x), bfhi(av.x), bflo(av.y), bfhi(av.y), bflo(av.z), bfhi(av.z), bflo(av.w), bfhi(av.w)};
#pragma unroll
                for (int q = 0; q < 16; ++q) {
                    const int col = (q >> 3) * 128 + ((q >> 2) & 1) * 16 + (q & 3);
                    const u32x4 bv = *(const u32x4*)(bp + (size_t)col * K + k);
                    acc[q] += af[0] * bflo(bv.x) + af[1] * bfhi(bv.x) + af[2] * bflo(bv.y) + af[3] * bfhi(bv.y) + af[4] * bflo(bv.z) + af[5] * bfhi(bv.z) + af[6] * bflo(bv.w) + af[7] * bfhi(bv.w);
                }
            }
            E.group(u, r, c, (f32x4){acc[0], acc[1], acc[2], acc[3]}, (f32x4){acc[4], acc[5], acc[6], acc[7]}, (f32x4){acc[8], acc[9], acc[10], acc[11]}, (f32x4){acc[12], acc[13], acc[14], acc[15]});
        }
    }
}

DI void transpose_item(const float* W, int N, bf16_t* WT, int Kd, int k0, int n0, int drow0, LAS float* scr, int lane) {
#pragma unroll 8
    for (int i = 0; i < 32; ++i) { const int kk = 2 * i + (lane >> 5); scr[kk * 33 + (lane & 31)] = W[(size_t)(k0 + kk) * N + n0 + (lane & 31)]; }
    asm volatile("s_waitcnt lgkmcnt(0)" ::: "memory");
    const int c = lane & 7;
#pragma unroll
    for (int j = 0; j < 4; ++j) { const int n = (lane >> 3) + 8 * j; const LAS float* s = scr + (8 * c) * 33 + n;
        u32x4 o; o.x = pk2(s[0 * 33], s[1 * 33]); o.y = pk2(s[2 * 33], s[3 * 33]); o.z = pk2(s[4 * 33], s[5 * 33]); o.w = pk2(s[6 * 33], s[7 * 33]);
        *(u32x4*)(WT + (size_t)(drow0 + n) * Kd + k0 + 8 * c) = o; }
    asm volatile("s_waitcnt lgkmcnt(0)" ::: "memory");
}
DI void convert_experts(const Ctx& X, const Params& P, int l, LAS float* scr) {
    const int gw = X.bid * NWAVES + X.wave, NGW = X.nb * NWAVES;
    bf16_t* WGU = (bf16_t*)(P.ws + WS_WGU); bf16_t* WD = (bf16_t*)(P.ws + WS_WD);
    const float* wg = P.in[18] + (size_t)l * NEXP * D * DEXP; const float* wu = P.in[19] + (size_t)l * NEXP * D * DEXP; const float* wd = P.in[20] + (size_t)l * NEXP * DEXP * D;
    for (int it = gw; it < 3 * 4096; it += NGW) {
        const int set = it >> 12, r = it & 4095, e = r >> 8, q = r & 255;
        if (set < 2) { const int kb = q >> 4, nbk = q & 15, n0 = nbk * 32;
            transpose_item((set ? wu : wg) + (size_t)e * D * DEXP, DEXP, WGU + (size_t)e * 1024 * 1024, 1024, kb * 64, n0, 256 * (n0 >> 7) + (n0 & 127) + set * 128, scr, X.lane);
        } else { const int kb = q >> 5, nbk = q & 31, n0 = nbk * 32;
            transpose_item(wd + (size_t)e * DEXP * D, D, WD + (size_t)e * 1024 * 512, 512, kb * 64, n0, n0, scr, X.lane); }
    }
}
DI void ph_prologue(const Ctx& X, const Params& P) {
    LAS float* sc = (LAS float*)X.lds;
    LAS float* red = sc + 3072;
    float* MODS = (float*)(P.ws + WS_MODS);
    for (int it = X.bid; it < 193; it += X.nb) {
        if (it < 192) {
            const int l = it / 96, cg = it % 96;
            for (int i = X.tid; i < 3072; i += NTHREADS) { const int cond = i >> 10, k = i & 1023; const float v = cond < 2 ? P.in[1][cond * 1024 + k] : P.in[3][k]; sc[i] = siluf_(v); }
            __syncthreads();
            const int kq = X.tid >> 4, c4 = X.tid & 15;
            float acc[3][4];
#pragma unroll
            for (int a = 0; a < 3; ++a)
#pragma unroll
                for (int j = 0; j < 4; ++j) acc[a][j] = 0.f;
            const float* w = P.in[4] + (size_t)l * D * 6144 + cg * 64 + c4 * 4;
#pragma unroll 8
            for (int i = 0; i < 32; ++i) { const int k = kq + 32 * i; const f32x4 wv = *(const f32x4*)(w + (size_t)k * 6144);
                const float s0 = sc[k], s1 = sc[1024 + k], s2 = sc[2048 + k];
#pragma unroll
                for (int j = 0; j < 4; ++j) { acc[0][j] += s0 * wv[j]; acc[1][j] += s1 * wv[j]; acc[2][j] += s2 * wv[j]; } }
#pragma unroll
            for (int a = 0; a < 3; ++a)
#pragma unroll
                for (int j = 0; j < 4; ++j) red[(kq * 3 + a) * 64 + c4 * 4 + j] = acc[a][j];
            __syncthreads();
            if (X.tid < 192) { const int cond = X.tid >> 6, col = X.tid & 63; float s = 0.f;
                for (int q = 0; q < 32; ++q) s += red[(q * 3 + cond) * 64 + col];
                MODS[(l * 3 + cond) * 6144 + cg * 64 + col] = s + P.in[5][l * 6144 + cg * 64 + col]; }
            __syncthreads();
        } else {
            float* LB = (float*)(P.ws + WS_LB);
            { const int i = X.tid; const float l0 = P.in[7][i], l1 = P.in[7][512 + i]; const float p1 = 1.0f / (1.0f + expf(l0 - l1));
              LB[i] = 1e-6f; LB[512 + i] = fmaxf(p1, 1e-6f); }
            float* RP = (float*)(P.ws + WS_ROPE);
            for (int i = X.tid; i < 2048; i += NTHREADS) { const int pos = i >> 4, f = i & 15; const float inv = powf(10000.0f, -(float)f / 16.0f); const float ang = (float)pos * inv;
                RP[2 * i] = cosf(ang); RP[2 * i + 1] = sinf(ang); }
        }
    }
    __syncthreads();
    LAS float* scr = (LAS float*)X.lds + X.wave * (64 * 33);
    const int gw = X.bid * NWAVES + X.wave, NGW = X.nb * NWAVES;
    bf16_t* WIN = (bf16_t*)(P.ws + WS_WIN); bf16_t* WOUT = (bf16_t*)(P.ws + WS_WOUT);
    for (int it = gw; it < 2 * 1408 + 2 * 512; it += NGW) {
        if (it < 2816) { const int l = it / 1408, r = it % 1408, kb = r / 88, nbk = r % 88;
            transpose_item(P.in[6] + (size_t)l * D * INW, INW, WIN + (size_t)l * INW * D, D, kb * 64, nbk * 32, nbk * 32, scr, X.lane);
        } else { const int r0 = it - 2816, l = r0 >> 9, r = r0 & 511, kb = r >> 5, nbk = r & 31;
            transpose_item(P.in[11] + (size_t)l * D * D, D, WOUT + (size_t)l * D * D, D, kb * 64, nbk * 32, nbk * 32, scr, X.lane); }
    }
    convert_experts(X, P, 0, scr);
}

DI const float* mods_row(const Params& P, int l, int row) { const int cond = row < NLAT ? (row >> 13) : 2; return (const float*)(P.ws + WS_MODS) + (l * 3 + cond) * 6144; }
DI void ph_modulate(const Ctx& X, const Params& P, int l) {
    bf16_t* H = (bf16_t*)(P.ws + WS_H);
    const int gw = X.bid * NWAVES + X.wave, NGW = X.nb * NWAVES;
    for (int row = gw; row < NROWS; row += NGW) {
        const float* xr = row < NLAT ? P.in[0] + (size_t)row * D : P.in[2] + (size_t)(row - NLAT) * D; const float* md = mods_row(P, l, row);
#pragma unroll
        for (int j = 0; j < 4; ++j) { const int c = 4 * X.lane + 256 * j; const f32x4 x = *(const f32x4*)(xr + c), sh = *(const f32x4*)(md + c), sc = *(const f32x4*)(md + 1024 + c);
            store_bf4(H + (size_t)row * D + c, x * (1.0f + sc) + sh); }
    }
}
DI void ph_ln1(const Ctx& X, const Params& P, int l) {
    LAS float* wrT = (LAS float*)X.lds;
    for (int i = X.tid; i < 16384; i += NTHREADS) { const int k = i >> 4, e = i & 15; wrT[e * 1024 + k] = P.in[16][i]; }
    __syncthreads();
    const int nrows = l == 0 ? NROWS : NLAT;
    bf16_t* H = (bf16_t*)(P.ws + WS_H); const bf16_t* YO = (const bf16_t*)(P.ws + WS_YO); float* XC = (float*)(P.ws + WS_XC);
    int* TOKE = (int*)(P.ws + WS_TOKE); int* TOKP = (int*)(P.ws + WS_TOKP); float* TOKW = (float*)(P.ws + WS_TOKW); int* LIST = (int*)(P.ws + WS_LIST);
    unsigned* CNT = (unsigned*)(P.ws + WS_CTL) + CW_CNT + 64 * l;
    const float* g = P.in[12] + l * D; const float* bta = P.in[13] + l * D;
    const int gw = X.bid * NWAVES + X.wave, NGW = X.nb * NWAVES;
    for (int row = gw; row < nrows; row += NGW) {
        const bool lat = row < NLAT;
        const float* xr = lat ? (l == 0 ? P.in[0] : P.out) + (size_t)row * D : P.in[2] + (size_t)(row - NLAT) * D;
        float* xo = lat ? P.out + (size_t)row * D : XC + (size_t)(row - NLAT) * D;
        const float* md = mods_row(P, l, row);
        f32x4 v[4]; float s = 0.f;
#pragma unroll
        for (int j = 0; j < 4; ++j) { const int c = 4 * X.lane + 256 * j; const f32x4 x = *(const f32x4*)(xr + c), g1 = *(const f32x4*)(md + 2048 + c);
            const u32x2 yw = *(const u32x2*)(YO + (size_t)row * D + c); const f32x4 y = {bflo(yw.x), bfhi(yw.x), bflo(yw.y), bfhi(yw.y)};
            v[j] = ALPHA * x + g1 * y; s += (v[j][0] + v[j][1]) + (v[j][2] + v[j][3]); }
        const float mean = wave_sum(s) * (1.0f / D); float q = 0.f;
#pragma unroll
        for (int j = 0; j < 4; ++j) { v[j] = v[j] - mean; q += (v[j][0] * v[j][0] + v[j][1] * v[j][1]) + (v[j][2] * v[j][2] + v[j][3] * v[j][3]); }
        const float rstd = 1.0f / sqrtf(wave_sum(q) * (1.0f / D) + LN_EPS);
        f32x4 h2v[4];
#pragma unroll
        for (int j = 0; j < 4; ++j) { const int c = 4 * X.lane + 256 * j; const f32x4 x1 = v[j] * rstd * *(const f32x4*)(g + c) + *(const f32x4*)(bta + c);
            *(f32x4*)(xo + c) = x1;
            h2v[j] = x1 * (1.0f + *(const f32x4*)(md + 4096 + c)) + *(const f32x4*)(md + 3072 + c);
            store_bf4(H + (size_t)row * D + c, h2v[j]); }
        float lg[16];
#pragma unroll
        for (int e = 0; e < 16; ++e) { float a = 0.f;
#pragma unroll
            for (int j = 0; j < 4; ++j) { const f32x4 w = *(const LAS f32x4*)(wrT + e * 1024 + 4 * X.lane + 256 * j); a += (h2v[j][0] * w[0] + h2v[j][1] * w[1]) + (h2v[j][2] * w[2] + h2v[j][3] * w[3]); }
            lg[e] = a; asm volatile("" ::: "memory"); }
        float sg[16], sel[16];
#pragma unroll
        for (int e = 0; e < 16; ++e) { sg[e] = sigmoidf_(wave_sum(lg[e])); sel[e] = sg[e] + P.in[17][e]; }
        int best = 0; float bestv = -3e38f;
#pragma unroll
        for (int gq = 0; gq < 4; ++gq) { float m1 = -3e38f, m2 = -3e38f;
#pragma unroll
            for (int j = 0; j < 4; ++j) { const float t = sel[gq * 4 + j]; if (t > m1) { m2 = m1; m1 = t; } else if (t > m2) m2 = t; }
            const float gs = m1 + m2; if (gs > bestv) { bestv = gs; best = gq; } }
        int i0 = 0, i1 = 0; float v0 = -3e38f, v1 = -3e38f, s0 = 0.f, s1 = 0.f;
#pragma unroll
        for (int e = 0; e < 16; ++e) { if ((e >> 2) == best) { const float t = sel[e];
                if (t > v0) { v1 = v0; i1 = i0; s1 = s0; v0 = t; i0 = e; s0 = sg[e]; } else if (t > v1) { v1 = t; i1 = e; s1 = sg[e]; } } }
        if (X.lane == 0) {
            const float inv = 1.0f / (s0 + s1);
            const int p0 = (int)atomicAdd(CNT + i0, 1u), p1 = (int)atomicAdd(CNT + i1, 1u);
            LIST[i0 * LISTCAP + p0] = row; LIST[i1 * LISTCAP + p1] = row;
            TOKE[2 * row] = i0; TOKE[2 * row + 1] = i1; TOKP[2 * row] = p0; TOKP[2 * row + 1] = p1; TOKW[2 * row] = s0 * inv; TOKW[2 * row + 1] = s1 * inv;
        }
    }
}
DI void ph_ln2(const Ctx& X, const Params& P, int l) {
    const int nrows = l == 0 ? NROWS : NLAT;
    bf16_t* H = (bf16_t*)(P.ws + WS_H); const bf16_t* O = (const bf16_t*)(P.ws + WS_O); float* XC = (float*)(P.ws + WS_XC);
    const int* TOKE = (const int*)(P.ws + WS_TOKE); const int* TOKP = (const int*)(P.ws + WS_TOKP); const float* TOKW = (const float*)(P.ws + WS_TOKW);
    const unsigned* CNT = (const unsigned*)(P.ws + WS_CTL) + CW_CNT + 64 * l;
    const float* g = P.in[14] + l * D; const float* bta = P.in[15] + l * D;
    int off[16]; { int acc = 0;
#pragma unroll
        for (int e = 0; e < 16; ++e) { off[e] = acc; acc += (((int)CNT[e] + 255) >> 8) << 8; } }
    const int gw = X.bid * NWAVES + X.wave, NGW = X.nb * NWAVES;
    for (int row = gw; row < nrows; row += NGW) {
        const bool lat = row < NLAT;
        float* xr = lat ? P.out + (size_t)row * D : XC + (size_t)(row - NLAT) * D;
        const float* md = mods_row(P, l, row);
        const int e0 = TOKE[2 * row], e1 = TOKE[2 * row + 1]; int o0 = 0, o1 = 0;
#pragma unroll
        for (int e = 0; e < 16; ++e) { if (e == e0) o0 = off[e]; if (e == e1) o1 = off[e]; }
        const bf16_t* r0 = O + (size_t)(o0 + TOKP[2 * row]) * D; const bf16_t* r1 = O + (size_t)(o1 + TOKP[2 * row + 1]) * D;
        const float w0 = TOKW[2 * row], w1 = TOKW[2 * row + 1];
        f32x4 v[4]; float s = 0.f;
#pragma unroll
        for (int j = 0; j < 4; ++j) { const int c = 4 * X.lane + 256 * j; const f32x4 x = *(const f32x4*)(xr + c), g2 = *(const f32x4*)(md + 5120 + c);
            const u32x2 a = *(const u32x2*)(r0 + c), b = *(const u32x2*)(r1 + c);
            const f32x4 f = w0 * (f32x4){bflo(a.x), bfhi(a.x), bflo(a.y), bfhi(a.y)} + w1 * (f32x4){bflo(b.x), bfhi(b.x), bflo(b.y), bfhi(b.y)};
            v[j] = ALPHA * x + g2 * f; s += (v[j][0] + v[j][1]) + (v[j][2] + v[j][3]); }
        const float mean = wave_sum(s) * (1.0f / D); float q = 0.f;
#pragma unroll
        for (int j = 0; j < 4; ++j) { v[j] = v[j] - mean; q += (v[j][0] * v[j][0] + v[j][1] * v[j][1]) + (v[j][2] * v[j][2] + v[j][3] * v[j][3]); }
        const float rstd = 1.0f / sqrtf(wave_sum(q) * (1.0f / D) + LN_EPS);
        const float* mdn = mods_row(P, 1, row);
#pragma unroll
        for (int j = 0; j < 4; ++j) { const int c = 4 * X.lane + 256 * j; const f32x4 x2 = v[j] * rstd * *(const f32x4*)(g + c) + *(const f32x4*)(bta + c);
            *(f32x4*)(xr + c) = x2;
            if (l == 0) store_bf4(H + (size_t)row * D + c, x2 * (1.0f + *(const f32x4*)(mdn + 1024 + c)) + *(const f32x4*)(mdn + c)); }
    }
}

struct KeysNA { int b, r, c, rs, cs, h; const float* rpb;
    DI int n() const { return 128 + CTXL; }
    DI void get(int k, int& krow, float& bias) const { if (k < 128) { const int kr = rs + (k >> 4), kc = cs + (k & 15); krow = b * SEQ + kr * 64 + kc; bias = rpb[h * 465 + (kr - r + 7) * 31 + (kc - c + 15)]; } else { krow = NLAT + b * CTXL + (k - 128); bias = 0.f; } } };
struct KeysSWA { int b, lo, nband;
    DI int n() const { return nband + CTXL; }
    DI void get(int k, int& krow, float& bias) const { krow = k < nband ? b * SEQ + lo + k : NLAT + b * CTXL + (k - nband); bias = 0.f; } };
struct KeysCtx { int b;
    DI int n() const { return CTXL; }
    DI void get(int k, int& krow, float& bias) const { krow = NLAT + b * CTXL + k; bias = 0.f; } };
template <class Keys>
DI void attn_row_naive(const bf16_t* PB, int qrow, int qcol, int kcol, int vcol, const Keys& KS, bool has_sink, float sink, LAS float* sc, bf16_t* yout, int lane) {
    float q[64];
    { const u32x4* qp = (const u32x4*)(PB + (size_t)qrow * PBW + qcol);
#pragma unroll
      for (int i = 0; i < 8; ++i) { const u32x4 w = qp[i]; q[8 * i] = bflo(w.x); q[8 * i + 1] = bfhi(w.x); q[8 * i + 2] = bflo(w.y); q[8 * i + 3] = bfhi(w.y); q[8 * i + 4] = bflo(w.z); q[8 * i + 5] = bfhi(w.z); q[8 * i + 6] = bflo(w.w); q[8 * i + 7] = bfhi(w.w); } }
    const int nk = KS.n(); float mx = has_sink ? sink : -3e38f;
    for (int k = lane; k < nk; k += 64) { int krow; float bias; KS.get(k, krow, bias);
        const u32x4* kp = (const u32x4*)(PB + (size_t)krow * PBW + kcol); float s = 0.f;
#pragma unroll
        for (int i = 0; i < 8; ++i) { const u32x4 w = kp[i]; s += q[8 * i] * bflo(w.x) + q[8 * i + 1] * bfhi(w.x) + q[8 * i + 2] * bflo(w.y) + q[8 * i + 3] * bfhi(w.y) + q[8 * i + 4] * bflo(w.z) + q[8 * i + 5] * bfhi(w.z) + q[8 * i + 6] * bflo(w.w) + q[8 * i + 7] * bfhi(w.w); }
        s += bias; sc[k] = s; mx = fmaxf(mx, s); }
    mx = wave_max(mx); float den = 0.f;
    for (int k = lane; k < nk; k += 64) { const float p = __expf(sc[k] - mx); sc[k] = p; den += p; }
    den = wave_sum(den); if (has_sink) den += __expf(sink - mx);
    asm volatile("s_waitcnt lgkmcnt(0)" ::: "memory");
    float o = 0.f;
    for (int k = 0; k < nk; ++k) { int krow; float bias; KS.get(k, krow, bias); o += sc[k] * bf2f(PB[(size_t)krow * PBW + vcol + lane]); }
    yout[lane] = (bf16_t)f2bf(o / den);
    asm volatile("s_waitcnt lgkmcnt(0)" ::: "memory");
}
DI void ph_attn_naive(const Ctx& X, const Params& P, int l) {
    const bf16_t* PB = (const bf16_t*)(P.ws + WS_PB); bf16_t* Y = (bf16_t*)(P.ws + WS_Y);
    LAS float* sc = (LAS float*)X.lds + X.wave * 640;
    const float* rpb = P.in[9] + l * 4 * 465; const float* sink = P.in[10] + l * 8;
    const int nrows = l == 0 ? NROWS : NLAT;
    const int gw = X.bid * NWAVES + X.wave, NGW = X.nb * NWAVES;
    for (int it = gw; it < nrows * 12; it += NGW) {
        const int row = it / 12, hh = it % 12;
        if (row < NLAT) { const int b = row >> 13, t = row & (SEQ - 1);
            if (hh < 4) { KeysNA K; K.b = b; K.r = t >> 6; K.c = t & 63; K.rs = min(max(K.r - 4, 0), 120); K.cs = min(max(K.c - 8, 0), 48); K.h = hh; K.rpb = rpb;
                attn_row_naive(PB, row, PB_NQ + hh * 64, PB_NK + hh * 64, PB_NV + hh * 64, K, false, 0.f, sc, Y + (size_t)row * D + 256 + hh * 64, X.lane);
            } else { const int qh = hh - 4, n = qh >> 2; KeysSWA K; K.b = b; K.lo = max(t - 128, 0); K.nband = min(t + 128, SEQ - 1) - K.lo + 1;
                attn_row_naive(PB, row, PB_SQ + qh * 64, PB_SK + n * 64, PB_SV + n * 64, K, true, sink[qh], sc, Y + (size_t)row * D + 512 + qh * 64, X.lane); }
        } else { const int b = (row - NLAT) >> 8; KeysCtx K; K.b = b;
            if (hh < 4) attn_row_naive(PB, row, PB_NQ + hh * 64, PB_NK + hh * 64, PB_NV + hh * 64, K, false, 0.f, sc, Y + (size_t)row * D + 256 + hh * 64, X.lane);
            else { const int qh = hh - 4, n = qh >> 2; attn_row_naive(PB, row, PB_SQ + qh * 64, PB_SK + n * 64, PB_SV + n * 64, K, true, sink[qh], sc, Y + (size_t)row * D + 512 + qh * 64, X.lane); }
        }
    }
}
DI void ph_hgrn_naive(const Ctx& X, const Params& P, int l) {
    const bf16_t* PB = (const bf16_t*)(P.ws + WS_PB); const float* Z = (const float*)(P.ws + WS_Z); float* O32 = (float*)(P.ws + WS_S);
    const float* LB = (const float*)(P.ws + WS_LB) + l * 512;
    const int gw = X.bid * NWAVES + X.wave;
    if (gw >= 16) return;
    const int b = gw >> 3, h = (gw >> 1) & 3, dir = gw & 1, lane = X.lane;
    const float lb = LB[dir * 256 + h * 64 + lane];
    float S[64];
#pragma unroll
    for (int d = 0; d < 64; ++d) S[d] = 0.f;
    for (int step = 0; step < CTXL + SEQ; ++step) {
        int row;
        if (step < CTXL) row = NLAT + b * CTXL + (dir ? CTXL - 1 - step : step); else { const int t = step - CTXL; row = b * SEQ + (dir ? SEQ - 1 - t : t); }
        const float z = Z[(size_t)row * ZW + dir * 256 + h * 64 + lane];
        const float f = lb + (1.0f - lb) * sigmoidf_(z), kk = (1.0f - lb) * sigmoidf_(-z);
        const float qv = bf2f(PB[(size_t)row * PBW + PB_AQ + h * 64 + lane]), vv = bf2f(PB[(size_t)row * PBW + PB_AI + h * 64 + lane]);
        float o = 0.f;
#pragma unroll
        for (int d = 0; d < 64; ++d) { const float fd = __builtin_bit_cast(float, __builtin_amdgcn_readlane(__builtin_bit_cast(int, f), d)), kd = __builtin_bit_cast(float, __builtin_amdgcn_readlane(__builtin_bit_cast(int, kk), d)), qd = __builtin_bit_cast(float, __builtin_amdgcn_readlane(__builtin_bit_cast(int, qv), d));
            S[d] = fd * S[d] + kd * vv; o += S[d] * qd; }
        O32[((size_t)dir * NROWS + row) * 256 + h * 64 + lane] = o;
    }
}
DI void ph_hgrn_combine_naive(const Ctx& X, const Params& P, int l) {
    const bf16_t* PB = (const bf16_t*)(P.ws + WS_PB); const float* O32 = (const float*)(P.ws + WS_S); bf16_t* Y = (bf16_t*)(P.ws + WS_Y);
    const float* nw = P.in[8] + l * 64;
    const int nrows = l == 0 ? NROWS : NLAT;
    const int gw = X.bid * NWAVES + X.wave, NGW = X.nb * NWAVES;
    for (int it = gw; it < nrows * 4; it += NGW) { const int row = it >> 2, h = it & 3;
        const float o = O32[(size_t)row * 256 + h * 64 + X.lane] + O32[((size_t)NROWS + row) * 256 + h * 64 + X.lane];
        const float ms = wave_sum(o * o) * (1.0f / 64.0f); const float y = o * (1.0f / sqrtf(ms + RMS_EPS)) * nw[X.lane];
        const float gte = bf2f(PB[(size_t)row * PBW + PB_AG + h * 64 + X.lane]);
        Y[(size_t)row * D + h * 64 + X.lane] = (bf16_t)f2bf(y * siluf_(gte)); }
}

DI void ph_inproj(const Ctx& X, const Params& P, int l) {
    PlainSched S; S.init(NROWS, INW, X.nb, X.bid);
    EpiIn E{(bf16_t*)(P.ws + WS_PB), (float*)(P.ws + WS_Z), (const float*)(P.ws + WS_ROPE)};
    gemm_naive(X, (const bf16_t*)(P.ws + WS_H), (const bf16_t*)(P.ws + WS_WIN) + (size_t)l * INW * D, D, S, E);
}
DI void ph_outproj(const Ctx& X, const Params& P, int l) {
    PlainSched S; S.init(l == 0 ? NROWS : NLAT, D, X.nb, X.bid);
    EpiBf E{(bf16_t*)(P.ws + WS_YO), D};
    gemm_naive(X, (const bf16_t*)(P.ws + WS_Y), (const bf16_t*)(P.ws + WS_WOUT) + (size_t)l * D * D, D, S, E);
}
DI void ph_moe1(const Ctx& X, const Params& P, int l) {
    MoeSched S{(const int*)(P.ws + WS_CTL) + CW_CNT + 64 * l, (const int*)(P.ws + WS_LIST), X.nb, X.bid, 4, 1024, true};
    EpiGU E{(bf16_t*)(P.ws + WS_S)};
    gemm_naive(X, (const bf16_t*)(P.ws + WS_H), (const bf16_t*)(P.ws + WS_WGU), D, S, E);
}
DI void ph_moe2(const Ctx& X, const Params& P, int l) {
    MoeSched S{(const int*)(P.ws + WS_CTL) + CW_CNT + 64 * l, (const int*)(P.ws + WS_LIST), X.nb, X.bid, 4, 1024, false};
    EpiBf E{(bf16_t*)(P.ws + WS_O), D};
    gemm_naive(X, (const bf16_t*)(P.ws + WS_S), (const bf16_t*)(P.ws + WS_WD), DEXP, S, E);
}

template <int Q> DI void run_phase(const Ctx& X, const Params& P, int l) {
    if constexpr (Q == 0) ph_prologue(X, P);
    if constexpr (Q == 1) ph_modulate(X, P, 0);
    if constexpr (Q == 2) ph_inproj(X, P, l);
    if constexpr (Q == 3) ph_hgrn_naive(X, P, l);
    if constexpr (Q == 4) ph_hgrn_combine_naive(X, P, l);
    if constexpr (Q == 5) ph_attn_naive(X, P, l);
    if constexpr (Q == 6) ph_outproj(X, P, l);
    if constexpr (Q == 7) ph_ln1(X, P, l);
    if constexpr (Q == 8) ph_moe1(X, P, l);
    if constexpr (Q == 9) ph_moe2(X, P, l);
    if constexpr (Q == 10) { ph_ln2(X, P, l); if (l == 0) { __syncthreads(); convert_experts(X, P, 1, (LAS float*)X.lds + X.wave * (64 * 33)); } }
}

constexpr int LDS_BYTES = 147456;
template <int Q>
__global__ void __launch_bounds__(NTHREADS, 2) k_step(Params P, int l) {
    extern __shared__ __attribute__((aligned(16))) unsigned char lds_raw[];
    Ctx X; X.lds = (LAS unsigned char*)lds_raw; X.tid = threadIdx.x; X.lane = X.tid & 63; X.wave = __builtin_amdgcn_readfirstlane(X.tid >> 6); X.bid = blockIdx.x; X.nb = gridDim.x;
    run_phase<Q>(X, P, l);
}
template <int Q> static void launch_step(const Params& P, int l, int grid, hipStream_t stream) {
    static bool attr = false;
    if (!attr) { (void)hipFuncSetAttribute((const void*)k_step<Q>, hipFuncAttributeMaxDynamicSharedMemorySize, LDS_BYTES); attr = true; }
    hipLaunchKernelGGL(k_step<Q>, dim3(grid), dim3(NTHREADS), LDS_BYTES, stream, P, l);
}

extern "C" void kernel_launch(void* const* d_in, const int* in_sizes, int n_in, void* d_out, int out_size, void* d_ws, size_t ws_size, hipStream_t stream) {
    static int grid = 0;
    if (grid == 0) {
        if (n_in != 21 || out_size != NLAT * D || ws_size < WS_END) { fprintf(stderr, "kernel_launch: unexpected shapes n_in %d out %d ws %zu\n", n_in, out_size, ws_size); grid = -1; return; }
        int dev = 0, cus = 0; (void)hipGetDevice(&dev); (void)hipDeviceGetAttribute(&cus, hipDeviceAttributeMultiprocessorCount, dev);
        grid = cus > 0 ? cus : 256;
    }
    if (grid < 0) return;
    (void)hipMemsetAsync((char*)d_ws + WS_CTL, 0, CTL_BYTES, stream);
    Params P{};
    for (int i = 0; i < 21; ++i) P.in[i] = (const float*)d_in[i];
    P.out = (float*)d_out; P.ws = (unsigned char*)d_ws;
    launch_step<0>(P, 0, grid, stream);
    launch_step<1>(P, 0, grid, stream);
    for (int l = 0; l < 2; ++l) {
        launch_step<2>(P, l, grid, stream); launch_step<3>(P, l, grid, stream); launch_step<4>(P, l, grid, stream); launch_step<5>(P, l, grid, stream);
        launch_step<6>(P, l, grid, stream); launch_step<7>(P, l, grid, stream); launch_step<8>(P, l, grid, stream); launch_step<9>(P, l, grid, stream);
        launch_step<10>(P, l, grid, stream);
    }
}
```

```cpp
#include <hip/hip_runtime.h>
#include <cstdint>
#include <cstdio>

#ifndef N_LAUNCH_MODE
#define N_LAUNCH_MODE 1
#endif
#ifndef FAST_GEMM
#define FAST_GEMM 0
#endif

#define LAS __attribute__((address_space(3)))
#define GAS __attribute__((address_space(1)))
typedef unsigned short bf16_t;
typedef short bf16x8 __attribute__((ext_vector_type(8)));
typedef float f32x4 __attribute__((ext_vector_type(4)));
typedef float f32x2 __attribute__((ext_vector_type(2)));
typedef unsigned u32x4 __attribute__((ext_vector_type(4)));
typedef unsigned u32x2 __attribute__((ext_vector_type(2)));
#define DI __device__ __forceinline__

constexpr int D = 1024, NB = 2, SEQ = 8192, CTXL = 256, NLAT = NB * SEQ, NCTX = NB * CTXL, NROWS = NLAT + NCTX;
constexpr int INW = 2816, PBW = 2304, ZW = 512, NEXP = 16, DEXP = 512, LISTCAP = NROWS;
constexpr int NTHREADS = 512, NWAVES = 8;
constexpr float ALPHA = 1.41421356237f, LN_EPS = 1e-5f, RMS_EPS = 1e-6f;
constexpr int PB_AQ = 0, PB_AI = 256, PB_AG = 512, PB_NQ = 768, PB_NK = 1024, PB_NV = 1280, PB_SQ = 1536, PB_SK = 2048, PB_SV = 2176;
constexpr int NCHAIN = 132;

constexpr size_t MiB = 1u << 20;
constexpr size_t WS_CTL = 0, CTL_BYTES = 1 * MiB;
constexpr size_t WS_MODS = 1 * MiB;
constexpr size_t WS_LB = WS_MODS + 2 * 3 * 6144 * 4;
constexpr size_t WS_ROPE = WS_LB + 2 * 2 * 256 * 4;
constexpr size_t WS_TOKE = WS_ROPE + 128 * 16 * 2 * 4;
constexpr size_t WS_TOKP = WS_TOKE + NROWS * 8;
constexpr size_t WS_TOKW = WS_TOKP + NROWS * 8;
constexpr size_t WS_LIST = 2 * MiB;
constexpr size_t WS_XC = 4 * MiB;
constexpr size_t WS_WIN = 6 * MiB;
constexpr size_t WS_WOUT = 17 * MiB;
constexpr size_t WS_WGU = 21 * MiB;
constexpr size_t WS_WD = 53 * MiB;
constexpr size_t WS_H = 69 * MiB;
constexpr size_t WS_Y = 102 * MiB;
constexpr size_t WS_S = 135 * MiB;
constexpr size_t WS_DD = 173 * MiB;
constexpr size_t WS_PB = 174 * MiB;
constexpr size_t WS_Z = WS_PB + (size_t)NROWS * PBW * 2;
constexpr size_t WS_O = 174 * MiB;
constexpr size_t WS_YO = 248 * MiB;
constexpr size_t WS_END = 282 * MiB;
constexpr int HE_ROWS = 37888;
static_assert(WS_Z + (size_t)NROWS * ZW * 4 <= WS_END && WS_O + (size_t)HE_ROWS * 1024 * 2 <= WS_YO && WS_YO + (size_t)NROWS * 2048 <= WS_END, "ws map");
static_assert(WS_TOKW + NROWS * 8 <= WS_LIST && WS_LIST + 16 * LISTCAP * 4 <= WS_XC, "ws map small");
constexpr int CW_CNT = 64;
constexpr int CW_BAR = 4096;

struct Params {
    const float* in[21];
    float* out;
    unsigned char* ws;
    int step_lo, step_hi;
};

DI unsigned f2bf(float f) { unsigned u = __builtin_bit_cast(unsigned, f); return (u + 0x7fffu + ((u >> 16) & 1u)) >> 16; }
DI float bf2f(unsigned h) { return __builtin_bit_cast(float, h << 16); }
DI unsigned pk2(float lo, float hi) { return f2bf(lo) | (f2bf(hi) << 16); }
DI float bflo(unsigned w) { return __builtin_bit_cast(float, w << 16); }
DI float bfhi(unsigned w) { return __builtin_bit_cast(float, w & 0xffff0000u); }
DI float wave_sum(float v) {
#pragma unroll
    for (int o = 1; o < 64; o <<= 1) v += __shfl_xor(v, o);
    return v;
}
DI float wave_max(float v) {
#pragma unroll
    for (int o = 1; o < 64; o <<= 1) v = fmaxf(v, __shfl_xor(v, o));
    return v;
}
DI float sigmoidf_(float x) { return 1.0f / (1.0f + __expf(-x)); }
DI float siluf_(float x) { return x / (1.0f + __expf(-x)); }
DI void store_bf4(bf16_t* p, f32x4 v) { u32x2 w; w.x = pk2(v[0], v[1]); w.y = pk2(v[2], v[3]); *(u32x2*)p = w; }

struct Ctx {
    LAS unsigned char* lds;
    int tid, lane, wave, bid, nb;
};

struct Unit { int pm, pn, e, cnt, i0; };

struct PlainSched {
    int nM, nN, nwg, G, c;
    DI void init(int M, int N, int G_, int c_) { nM = M / 256; nN = N / 256; nwg = nM * nN; G = G_; c = c_; }
    DI bool next(int i, Unit& u) const {
        const long L = (long)i * G + c; if (L >= nwg) return false;
        int wgid = (int)L; { const int q = nwg / 8, r = nwg % 8, xcd = wgid % 8, off = wgid / 8; wgid = (xcd < r ? xcd * (q + 1) : r * (q + 1) + (xcd - r) * q) + off; }
        const int nig = 8 * nN, gid = wgid / nig, fm = gid * 8, gsz = (nM - fm) < 8 ? (nM - fm) : 8;
        u.pm = fm + ((wgid % nig) % gsz); u.pn = (wgid % nig) / gsz; u.e = 0; u.cnt = 0; u.i0 = 0; return true;
    }
    DI int a_row(const Unit& u, int r) const { return u.pm * 256 + r; }
    DI int b_row0(const Unit& u) const { return u.pn * 256; }
};
struct MoeSched {
    const int* cnt; const int* list; int G, c, nct, bt_rows; bool gather;
    DI bool next(int i, Unit& u) const {
        const int xcd = c & 7, j = c >> 3; const int L = i * G + xcd * (G >> 3) + j;
        const int T = L / nct; int acc = 0, e = -1, i0 = 0, ce = 0;
#pragma unroll
        for (int q = 0; q < NEXP; ++q) { const int cq = cnt[q]; const int nt = (cq + 255) >> 8; if (e < 0 && T < acc + nt) { e = q; i0 = T - acc; ce = cq; } acc += nt; }
        if (e < 0) return false;
        u.pm = T; u.pn = L % nct; u.e = e; u.cnt = ce; u.i0 = i0; return true;
    }
    DI int a_row(const Unit& u, int r) const {
        if (!gather) return u.pm * 256 + r;
        const int idx = u.i0 * 256 + r; return list[u.e * LISTCAP + (idx < u.cnt ? idx : 0)];
    }
    DI int b_row0(const Unit& u) const { return u.e * bt_rows + u.pn * 256; }
};

struct EpiIn {
    bf16_t* PB; float* Z; const float* rope;
    DI void group(const Unit& u, int r, int c, f32x4 a0, f32x4 a1, f32x4 b0, f32x4 b1) const {
        const int row = u.pm * 256 + r, seg = u.pn, gc = u.pn * 256 + c;
        if (seg == 1 || seg == 2) {
            float* z = Z + (size_t)row * ZW + (seg - 1) * 256 + c;
            *(f32x4*)z = a0; *(f32x4*)(z + 16) = a1; *(f32x4*)(z + 128) = b0; *(f32x4*)(z + 144) = b1;
            return;
        }
        const bool lat = row < NLAT;
        if (seg >= 8 && lat) {
            const int t = row & (SEQ - 1); const int which = (c >> 5) & 1; const int pos = which ? (t & 63) : (t >> 6);
            const float* rp = rope + (pos * 16 + (c & 31)) * 2;
#pragma unroll
            for (int j = 0; j < 4; ++j) {
                const float cs = rp[2 * j], sn = rp[2 * j + 1];
                const float x1 = a0[j], x2 = a1[j]; a0[j] = x1 * cs - x2 * sn; a1[j] = x1 * sn + x2 * cs;
                if (seg < 10) { const float y1 = b0[j], y2 = b1[j]; b0[j] = y1 * cs - y2 * sn; b1[j] = y1 * sn + y2 * cs; }
            }
        }
        if (seg == 5 || seg == 8 || seg == 9) { a0 *= 0.125f; a1 *= 0.125f; b0 *= 0.125f; b1 *= 0.125f; }
        bf16_t* p = PB + (size_t)row * PBW + (gc >= 768 ? gc - 512 : gc);
        store_bf4(p, a0); store_bf4(p + 16, a1); store_bf4(p + 128, b0); store_bf4(p + 144, b1);
    }
};
struct EpiBf {
    bf16_t* C; int ldc;
    DI void group(const Unit& u, int r, int c, f32x4 a0, f32x4 a1, f32x4 b0, f32x4 b1) const {
        bf16_t* p = C + (size_t)(u.pm * 256 + r) * ldc + u.pn * 256 + c;
        store_bf4(p, a0); store_bf4(p + 16, a1); store_bf4(p + 128, b0); store_bf4(p + 144, b1);
    }
};
struct EpiGU {
    bf16_t* HE;
    DI void group(const Unit& u, int r, int c, f32x4 a0, f32x4 a1, f32x4 b0, f32x4 b1) const {
        f32x4 h0, h1;
#pragma unroll
        for (int j = 0; j < 4; ++j) { h0[j] = siluf_(a0[j]) * b0[j]; h1[j] = siluf_(a1[j]) * b1[j]; }
        bf16_t* p = HE + (size_t)(u.pm * 256 + r) * DEXP + u.pn * 128 + c;
        store_bf4(p, h0); store_bf4(p + 16, h1);
    }
};

template <class Sched, class Epi>
DI void gemm_naive(const Ctx& X, const bf16_t* A, const bf16_t* Bt, int K, const Sched& S, const Epi& E) {
    Unit u;
    for (int i = 0; S.next(i, u); ++i) {
        for (int g = X.tid; g < 4096; g += NTHREADS) {
            const int fq = g & 3, wc = (g >> 2) & 3, r = g >> 4, c = wc * 32 + fq * 4;
            const bf16_t* ap = A + (size_t)S.a_row(u, r) * K;
            const bf16_t* bp = Bt + (size_t)(S.b_row0(u) + c) * K;
            float acc[16];
#pragma unroll
            for (int q = 0; q < 16; ++q) acc[q] = 0.f;
            for (int k = 0; k < K; k += 8) {
                const u32x4 av = *(const u32x4*)(ap + k);
                float af[8] = {bflo(av.x), bfhi(av.x), bflo(av.y), bfhi(av.y), bflo(av.z), bfhi(av.z), bflo(av.w), bfhi(av.w)};
#pragma unroll
                for (int q = 0; q < 16; ++q) {
                    const int col = (q >> 3) * 128 + ((q >> 2) & 1) * 16 + (q & 3);
                    const u32x4 bv = *(const u32x4*)(bp + (size_t)col * K + k);
                    acc[q] += af[0] * bflo(bv.x) + af[1] * bfhi(bv.x) + af[2] * bflo(bv.y) + af[3] * bfhi(bv.y) + af[4] * bflo(bv.z) + af[5] * bfhi(bv.z) + af[6] * bflo(bv.w) + af[7] * bfhi(bv.w);
                }
            }
            E.group(u, r, c, (f32x4){acc[0], acc[1], acc[2], acc[3]}, (f32x4){acc[4], acc[5], acc[6], acc[7]}, (f32x4){acc[8], acc[9], acc[10], acc[11]}, (f32x4){acc[12], acc[13], acc[14], acc[15]});
        }
    }
}

DI void transpose_item(const float* W, int N, bf16_t* WT, int Kd, int k0, int n0, int drow0, LAS float* scr, int lane) {
#pragma unroll 8
    for (int i = 0; i < 32; ++i) { const int kk = 2 * i + (lane >> 5); scr[kk * 33 + (lane & 31)] = W[(size_t)(k0 + kk) * N + n0 + (lane & 31)]; }
    asm volatile("s_waitcnt lgkmcnt(0)" ::: "memory");
    const int c = lane & 7;
#pragma unroll
    for (int j = 0; j < 4; ++j) { const int n = (lane >> 3) + 8 * j; const LAS float* s = scr + (8 * c) * 33 + n;
        u32x4 o; o.x = pk2(s[0 * 33], s[1 * 33]); o.y = pk2(s[2 * 33], s[3 * 33]); o.z = pk2(s[4 * 33], s[5 * 33]); o.w = pk2(s[6 * 33], s[7 * 33]);
        *(u32x4*)(WT + (size_t)(drow0 + n) * Kd + k0 + 8 * c) = o; }
    asm volatile("s_waitcnt lgkmcnt(0)" ::: "memory");
}
DI void convert_experts(const Ctx& X, const Params& P, int l, LAS float* scr) {
    const int gw = X.bid * NWAVES + X.wave, NGW = X.nb * NWAVES;
    bf16_t* WGU = (bf16_t*)(P.ws + WS_WGU); bf16_t* WD = (bf16_t*)(P.ws + WS_WD);
    const float* wg = P.in[18] + (size_t)l * NEXP * D * DEXP; const float* wu = P.in[19] + (size_t)l * NEXP * D * DEXP; const float* wd = P.in[20] + (size_t)l * NEXP * DEXP * D;
    for (int it = gw; it < 3 * 4096; it += NGW) {
        const int set = it >> 12, r = it & 4095, e = r >> 8, q = r & 255;
        if (set < 2) { const int kb = q >> 4, nbk = q & 15, n0 = nbk * 32;
            transpose_item((set ? wu : wg) + (size_t)e * D * DEXP, DEXP, WGU + (size_t)e * 1024 * 1024, 1024, kb * 64, n0, 256 * (n0 >> 7) + (n0 & 127) + set * 128, scr, X.lane);
        } else { const int kb = q >> 5, nbk = q & 31, n0 = nbk * 32;
            transpose_item(wd + (size_t)e * DEXP * D, D, WD + (size_t)e * 1024 * 512, 512, kb * 64, n0, n0, scr, X.lane); }
    }
}
DI void ph_prologue(const Ctx& X, const Params& P) {
    LAS float* sc = (LAS float*)X.lds;
    LAS float* red = sc + 3072;
    float* MODS = (float*)(P.ws + WS_MODS);
    for (int it = X.bid; it < 193; it += X.nb) {
        if (it < 192) {
            const int l = it / 96, cg = it % 96;
            for (int i = X.tid; i < 3072; i += NTHREADS) { const int cond = i >> 10, k = i & 1023; const float v = cond < 2 ? P.in[1][cond * 1024 + k] : P.in[3][k]; sc[i] = siluf_(v); }
            __syncthreads();
            const int kq = X.tid >> 4, c4 = X.tid & 15;
            float acc[3][4];
#pragma unroll
            for (int a = 0; a < 3; ++a)
#pragma unroll
                for (int j = 0; j < 4; ++j) acc[a][j] = 0.f;
            const float* w = P.in[4] + (size_t)l * D * 6144 + cg * 64 + c4 * 4;
#pragma unroll 8
            for (int i = 0; i < 32; ++i) { const int k = kq + 32 * i; const f32x4 wv = *(const f32x4*)(w + (size_t)k * 6144);
                const float s0 = sc[k], s1 = sc[1024 + k], s2 = sc[2048 + k];
#pragma unroll
                for (int j = 0; j < 4; ++j) { acc[0][j] += s0 * wv[j]; acc[1][j] += s1 * wv[j]; acc[2][j] += s2 * wv[j]; } }
#pragma unroll
            for (int a = 0; a < 3; ++a)
#pragma unroll
                for (int j = 0; j < 4; ++j) red[(kq * 3 + a) * 64 + c4 * 4 + j] = acc[a][j];
            __syncthreads();
            if (X.tid < 192) { const int cond = X.tid >> 6, col = X.tid & 63; float s = 0.f;
                for (int q = 0; q < 32; ++q) s += red[(q * 3 + cond) * 64 + col];
                MODS[(l * 3 + cond) * 6144 + cg * 64 + col] = s + P.in[5][l * 6144 + cg * 64 + col]; }
            __syncthreads();
        } else {
            float* LB = (float*)(P.ws + WS_LB);
            { const int i = X.tid; const float l0 = P.in[7][i], l1 = P.in[7][512 + i]; const float p1 = 1.0f / (1.0f + expf(l0 - l1));
              LB[i] = 1e-6f; LB[512 + i] = fmaxf(p1, 1e-6f); }
            float* RP = (float*)(P.ws + WS_ROPE);
            for (int i = X.tid; i < 2048; i += NTHREADS) { const int pos = i >> 4, f = i & 15; const float inv = powf(10000.0f, -(float)f / 16.0f); const float ang = (float)pos * inv;
                RP[2 * i] = cosf(ang); RP[2 * i + 1] = sinf(ang); }
        }
    }
    __syncthreads();
    LAS float* scr = (LAS float*)X.lds + X.wave * (64 * 33);
    const int gw = X.bid * NWAVES + X.wave, NGW = X.nb * NWAVES;
    bf16_t* WIN = (bf16_t*)(P.ws + WS_WIN); bf16_t* WOUT = (bf16_t*)(P.ws + WS_WOUT);
    for (int it = gw; it < 2 * 1408 + 2 * 512; it += NGW) {
        if (it < 2816) { const int l = it / 1408, r = it % 1408, kb = r / 88, nbk = r % 88;
            transpose_item(P.in[6] + (size_t)l * D * INW, INW, WIN + (size_t)l * INW * D, D, kb * 64, nbk * 32, nbk * 32, scr, X.lane);
        } else { const int r0 = it - 2816, l = r0 >> 9, r = r0 & 511, kb = r >> 5, nbk = r & 31;
            transpose_item(P.in[11] + (size_t)l * D * D, D, WOUT + (size_t)l * D * D, D, kb * 64, nbk * 32, nbk * 32, scr, X.lane); }
    }
    convert_experts(X, P, 0, scr);
}

DI const float* mods_row(const Params& P, int l, int row) { const int cond = row < NLAT ? (row >> 13) : 2; return (const float*)(P.ws + WS_MODS) + (l * 3 + cond) * 6144; }
DI void ph_modulate(const Ctx& X, const Params& P, int l) {
    bf16_t* H = (bf16_t*)(P.ws + WS_H);
    const int gw = X.bid * NWAVES + X.wave, NGW = X.nb * NWAVES;
    for (int row = gw; row < NROWS; row += NGW) {
        const float* xr = row < NLAT ? P.in[0] + (size_t)row * D : P.in[2] + (size_t)(row - NLAT) * D; const float* md = mods_row(P, l, row);
#pragma unroll
        for (int j = 0; j < 4; ++j) { const int c = 4 * X.lane + 256 * j; const f32x4 x = *(const f32x4*)(xr + c), sh = *(const f32x4*)(md + c), sc = *(const f32x4*)(md + 1024 + c);
            store_bf4(H + (size_t)row * D + c, x * (1.0f + sc) + sh); }
    }
}
DI void ph_ln1(const Ctx& X, const Params& P, int l) {
    LAS float* wrT = (LAS float*)X.lds;
    for (int i = X.tid; i < 16384; i += NTHREADS) { const int k = i >> 4, e = i & 15; wrT[e * 1024 + k] = P.in[16][i]; }
    __syncthreads();
    const int nrows = l == 0 ? NROWS : NLAT;
    bf16_t* H = (bf16_t*)(P.ws + WS_H); const bf16_t* YO = (const bf16_t*)(P.ws + WS_YO); float* XC = (float*)(P.ws + WS_XC);
    int* TOKE = (int*)(P.ws + WS_TOKE); int* TOKP = (int*)(P.ws + WS_TOKP); float* TOKW = (float*)(P.ws + WS_TOKW); int* LIST = (int*)(P.ws + WS_LIST);
    unsigned* CNT = (unsigned*)(P.ws + WS_CTL) + CW_CNT + 64 * l;
    const float* g = P.in[12] + l * D; const float* bta = P.in[13] + l * D;
    const int gw = X.bid * NWAVES + X.wave, NGW = X.nb * NWAVES;
    for (int row = gw; row < nrows; row += NGW) {
        const bool lat = row < NLAT;
        const float* xr = lat ? (l == 0 ? P.in[0] : P.out) + (size_t)row * D : P.in[2] + (size_t)(row - NLAT) * D;
        float* xo = lat ? P.out + (size_t)row * D : XC + (size_t)(row - NLAT) * D;
        const float* md = mods_row(P, l, row);
        f32x4 v[4]; float s = 0.f;
#pragma unroll
        for (int j = 0; j < 4; ++j) { const int c = 4 * X.lane + 256 * j; const f32x4 x = *(const f32x4*)(xr + c), g1 = *(const f32x4*)(md + 2048 + c);
            const u32x2 yw = *(const u32x2*)(YO + (size_t)row * D + c); const f32x4 y = {bflo(yw.x), bfhi(yw.x), bflo(yw.y), bfhi(yw.y)};
            v[j] = ALPHA * x + g1 * y; s += (v[j][0] + v[j][1]) + (v[j][2] + v[j][3]); }
        const float mean = wave_sum(s) * (1.0f / D); float q = 0.f;
#pragma unroll
        for (int j = 0; j < 4; ++j) { v[j] = v[j] - mean; q += (v[j][0] * v[j][0] + v[j][1] * v[j][1]) + (v[j][2] * v[j][2] + v[j][3] * v[j][3]); }
        const float rstd = 1.0f / sqrtf(wave_sum(q) * (1.0f / D) + LN_EPS);
        f32x4 h2v[4];
#pragma unroll
        for (int j = 0; j < 4; ++j) { const int c = 4 * X.lane + 256 * j; const f32x4 x1 = v[j] * rstd * *(const f32x4*)(g + c) + *(const f32x4*)(bta + c);
            *(f32x4*)(xo + c) = x1;
            h2v[j] = x1 * (1.0f + *(const f32x4*)(md + 4096 + c)) + *(const f32x4*)(md + 3072 + c);
            store_bf4(H + (size_t)row * D + c, h2v[j]); }
        float lg[16];
#pragma unroll
        for (int e = 0; e < 16; ++e) { float a = 0.f;
#pragma unroll
            for (int j = 0; j < 4; ++j) { const f32x4 w = *(const LAS f32x4*)(wrT + e * 1024 + 4 * X.lane + 256 * j); a += (h2v[j][0] * w[0] + h2v[j][1] * w[1]) + (h2v[j][2] * w[2] + h2v[j][3] * w[3]); }
            lg[e] = a; asm volatile("" ::: "memory"); }
        float sg[16], sel[16];
#pragma unroll
        for (int e = 0; e < 16; ++e) { sg[e] = sigmoidf_(wave_sum(lg[e])); sel[e] = sg[e] + P.in[17][e]; }
        int best = 0; float bestv = -3e38f;
#pragma unroll
        for (int gq = 0; gq < 4; ++gq) { float m1 = -3e38f, m2 = -3e38f;
#pragma unroll
            for (int j = 0; j < 4; ++j) { const float t = sel[gq * 4 + j]; if (t > m1) { m2 = m1; m1 = t; } else if (t > m2) m2 = t; }
            const float gs = m1 + m2; if (gs > bestv) { bestv = gs; best = gq; } }
        int i0 = 0, i1 = 0; float v0 = -3e38f, v1 = -3e38f, s0 = 0.f, s1 = 0.f;
#pragma unroll
        for (int e = 0; e < 16; ++e) { if ((e >> 2) == best) { const float t = sel[e];
                if (t > v0) { v1 = v0; i1 = i0; s1 = s0; v0 = t; i0 = e; s0 = sg[e]; } else if (t > v1) { v1 = t; i1 = e; s1 = sg[e]; } } }
        if (X.lane == 0) {
            const float inv = 1.0f / (s0 + s1);
            const int p0 = (int)atomicAdd(CNT + i0, 1u), p1 = (int)atomicAdd(CNT + i1, 1u);
            LIST[i0 * LISTCAP + p0] = row; LIST[i1 * LISTCAP + p1] = row;
            TOKE[2 * row] = i0; TOKE[2 * row + 1] = i1; TOKP[2 * row] = p0; TOKP[2 * row + 1] = p1; TOKW[2 * row] = s0 * inv; TOKW[2 * row + 1] = s1 * inv;
        }
    }
}
DI void ph_ln2(const Ctx& X, const Params& P, int l) {
    const int nrows = l == 0 ? NROWS : NLAT;
    bf16_t* H = (bf16_t*)(P.ws + WS_H); const bf16_t* O = (const bf16_t*)(P.ws + WS_O); float* XC = (float*)(P.ws + WS_XC);
    const int* TOKE = (const int*)(P.ws + WS_TOKE); const int* TOKP = (const int*)(P.ws + WS_TOKP); const float* TOKW = (const float*)(P.ws + WS_TOKW);
    const unsigned* CNT = (const unsigned*)(P.ws + WS_CTL) + CW_CNT + 64 * l;
    const float* g = P.in[14] + l * D; const float* bta = P.in[15] + l * D;
    int off[16]; { int acc = 0;
#pragma unroll
        for (int e = 0; e < 16; ++e) { off[e] = acc; acc += (((int)CNT[e] + 255) >> 8) << 8; } }
    const int gw = X.bid * NWAVES + X.wave, NGW = X.nb * NWAVES;
    for (int row = gw; row < nrows; row += NGW) {
        const bool lat = row < NLAT;
        float* xr = lat ? P.out + (size_t)row * D : XC + (size_t)(row - NLAT) * D;
        const float* md = mods_row(P, l, row);
        const int e0 = TOKE[2 * row], e1 = TOKE[2 * row + 1]; int o0 = 0, o1 = 0;
#pragma unroll
        for (int e = 0; e < 16; ++e) { if (e == e0) o0 = off[e]; if (e == e1) o1 = off[e]; }
        const bf16_t* r0 = O + (size_t)(o0 + TOKP[2 * row]) * D; const bf16_t* r1 = O + (size_t)(o1 + TOKP[2 * row + 1]) * D;
        const float w0 = TOKW[2 * row], w1 = TOKW[2 * row + 1];
        f32x4 v[4]; float s = 0.f;
#pragma unroll
        for (int j = 0; j < 4; ++j) { const int c = 4 * X.lane + 256 * j; const f32x4 x = *(const f32x4*)(xr + c), g2 = *(const f32x4*)(md + 5120 + c);
            const u32x2 a = *(const u32x2*)(r0 + c), b = *(const u32x2*)(r1 + c);
            const f32x4 f = w0 * (f32x4){bflo(a.x), bfhi(a.x), bflo(a.y), bfhi(a.y)} + w1 * (f32x4){bflo(b.x), bfhi(b.x), bflo(b.y), bfhi(b.y)};
            v[j] = ALPHA * x + g2 * f; s += (v[j][0] + v[j][1]) + (v[j][2] + v[j][3]); }
        const float mean = wave_sum(s) * (1.0f / D); float q = 0.f;
#pragma unroll
        for (int j = 0; j < 4; ++j) { v[j] = v[j] - mean; q += (v[j][0] * v[j][0] + v[j][1] * v[j][1]) + (v[j][2] * v[j][2] + v[j][3] * v[j][3]); }
        const float rstd = 1.0f / sqrtf(wave_sum(q) * (1.0f / D) + LN_EPS);
        const float* mdn = mods_row(P, 1, row);
#pragma unroll
        for (int j = 0; j < 4; ++j) { const int c = 4 * X.lane + 256 * j; const f32x4 x2 = v[j] * rstd * *(const f32x4*)(g + c) + *(const f32x4*)(bta + c);
            *(f32x4*)(xr + c) = x2;
            if (l == 0) store_bf4(H + (size_t)row * D + c, x2 * (1.0f + *(const f32x4*)(mdn + 1024 + c)) + *(const f32x4*)(mdn + c)); }
    }
}

struct KeysNA { int b, r, c, rs, cs, h; const float* rpb;
    DI int n() const { return 128 + CTXL; }
    DI void get(int k, int& krow, float& bias) const { if (k < 128) { const int kr = rs + (k >> 4), kc = cs + (k & 15); krow = b * SEQ + kr * 64 + kc; bias = rpb[h * 465 + (kr - r + 7) * 31 + (kc - c + 15)]; } else { krow = NLAT + b * CTXL + (k - 128); bias = 0.f; } } };
struct KeysSWA { int b, lo, nband;
    DI int n() const { return nband + CTXL; }
    DI void get(int k, int& krow, float& bias) const { krow = k < nband ? b * SEQ + lo + k : NLAT + b * CTXL + (k - nband); bias = 0.f; } };
struct KeysCtx { int b;
    DI int n() const { return CTXL; }
    DI void get(int k, int& krow, float& bias) const { krow = NLAT + b * CTXL + k; bias = 0.f; } };
template <class Keys>
DI void attn_row_naive(const bf16_t* PB, int qrow, int qcol, int kcol, int vcol, const Keys& KS, bool has_sink, float sink, LAS float* sc, bf16_t* yout, int lane) {
    float q[64];
    { const u32x4* qp = (const u32x4*)(PB + (size_t)qrow * PBW + qcol);
#pragma unroll
      for (int i = 0; i < 8; ++i) { const u32x4 w = qp[i]; q[8 * i] = bflo(w.x); q[8 * i + 1] = bfhi(w.x); q[8 * i + 2] = bflo(w.y); q[8 * i + 3] = bfhi(w.y); q[8 * i + 4] = bflo(w.z); q[8 * i + 5] = bfhi(w.z); q[8 * i + 6] = bflo(w.w); q[8 * i + 7] = bfhi(w.w); } }
    const int nk = KS.n(); float mx = has_sink ? sink : -3e38f;
    for (int k = lane; k < nk; k += 64) { int krow; float bias; KS.get(k, krow, bias);
        const u32x4* kp = (const u32x4*)(PB + (size_t)krow * PBW + kcol); float s = 0.f;
#pragma unroll
        for (int i = 0; i < 8; ++i) { const u32x4 w = kp[i]; s += q[8 * i] * bflo(w.x) + q[8 * i + 1] * bfhi(w.x) + q[8 * i + 2] * bflo(w.y) + q[8 * i + 3] * bfhi(w.y) + q[8 * i + 4] * bflo(w.z) + q[8 * i + 5] * bfhi(w.z) + q[8 * i + 6] * bflo(w.w) + q[8 * i + 7] * bfhi(w.w); }
        s += bias; sc[k] = s; mx = fmaxf(mx, s); }
    mx = wave_max(mx); float den = 0.f;
    for (int k = lane; k < nk; k += 64) { const float p = __expf(sc[k] - mx); sc[k] = p; den += p; }
    den = wave_sum(den); if (has_sink) den += __expf(sink - mx);
    asm volatile("s_waitcnt lgkmcnt(0)" ::: "memory");
    float o = 0.f;
    for (int k = 0; k < nk; ++k) { int krow; float bias; KS.get(k, krow, bias); o += sc[k] * bf2f(PB[(size_t)krow * PBW + vcol + lane]); }
    yout[lane] = (bf16_t)f2bf(o / den);
    asm volatile("s_waitcnt lgkmcnt(0)" ::: "memory");
}
DI void ph_attn_naive(const Ctx& X, const Params& P, int l) {
    const bf16_t* PB = (const bf16_t*)(P.ws + WS_PB); bf16_t* Y = (bf16_t*)(P.ws + WS_Y);
    LAS float* sc = (LAS float*)X.lds + X.wave * 640;
    const float* rpb = P.in[9] + l * 4 * 465; const float* sink = P.in[10] + l * 8;
    const int nrows = l == 0 ? NROWS : NLAT;
    const int gw = X.bid * NWAVES + X.wave, NGW = X.nb * NWAVES;
    for (int it = gw; it < nrows * 12; it += NGW) {
        const int row = it / 12, hh = it % 12;
        if (row < NLAT) { const int b = row >> 13, t = row & (SEQ - 1);
            if (hh < 4) { KeysNA K; K.b = b; K.r = t >> 6; K.c = t & 63; K.rs = min(max(K.r - 4, 0), 120); K.cs = min(max(K.c - 8, 0), 48); K.h = hh; K.rpb = rpb;
                attn_row_naive(PB, row, PB_NQ + hh * 64, PB_NK + hh * 64, PB_NV + hh * 64, K, false, 0.f, sc, Y + (size_t)row * D + 256 + hh * 64, X.lane);
            } else { const int qh = hh - 4, n = qh >> 2; KeysSWA K; K.b = b; K.lo = max(t - 128, 0); K.nband = min(t + 128, SEQ - 1) - K.lo + 1;
                attn_row_naive(PB, row, PB_SQ + qh * 64, PB_SK + n * 64, PB_SV + n * 64, K, true, sink[qh], sc, Y + (size_t)row * D + 512 + qh * 64, X.lane); }
        } else { const int b = (row - NLAT) >> 8; KeysCtx K; K.b = b;
            if (hh < 4) attn_row_naive(PB, row, PB_NQ + hh * 64, PB_NK + hh * 64, PB_NV + hh * 64, K, false, 0.f, sc, Y + (size_t)row * D + 256 + hh * 64, X.lane);
            else { const int qh = hh - 4, n = qh >> 2; attn_row_naive(PB, row, PB_SQ + qh * 64, PB_SK + n * 64, PB_SV + n * 64, K, true, sink[qh], sc, Y + (size_t)row * D + 512 + qh * 64, X.lane); }
        }
    }
}
DI void ph_hgrn_naive(const Ctx& X, const Params& P, int l) {
    const bf16_t* PB = (const bf16_t*)(P.ws + WS_PB); const float* Z = (const float*)(P.ws + WS_Z); float* O32 = (float*)(P.ws + WS_S);
    const float* LB = (const float*)(P.ws + WS_LB) + l * 512;
    const int gw = X.bid * NWAVES + X.wave;
    if (gw >= 16) return;
    const int b = gw >> 3, h = (gw >> 1) & 3, dir = gw & 1, lane = X.lane;
    const float lb = LB[dir * 256 + h * 64 + lane];
    float S[64];
#pragma unroll
    for (int d = 0; d < 64; ++d) S[d] = 0.f;
    for (int step = 0; step < CTXL + SEQ; ++step) {
        int row;
        if (step < CTXL) row = NLAT + b * CTXL + (dir ? CTXL - 1 - step : step); else { const int t = step - CTXL; row = b * SEQ + (dir ? SEQ - 1 - t : t); }
        const float z = Z[(size_t)row * ZW + dir * 256 + h * 64 + lane];
        const float f = lb + (1.0f - lb) * sigmoidf_(z), kk = (1.0f - lb) * sigmoidf_(-z);
        const float qv = bf2f(PB[(size_t)row * PBW + PB_AQ + h * 64 + lane]), vv = bf2f(PB[(size_t)row * PBW + PB_AI + h * 64 + lane]);
        float o = 0.f;
#pragma unroll
        for (int d = 0; d < 64; ++d) { const float fd = __builtin_bit_cast(float, __builtin_amdgcn_readlane(__builtin_bit_cast(int, f), d)), kd = __builtin_bit_cast(float, __builtin_amdgcn_readlane(__builtin_bit_cast(int, kk), d)), qd = __builtin_bit_cast(float, __builtin_amdgcn_readlane(__builtin_bit_cast(int, qv), d));
            S[d] = fd * S[d] + kd * vv; o += S[d] * qd; }
        O32[((size_t)dir * NROWS + row) * 256 + h * 64 + lane] = o;
    }
}
DI void ph_hgrn_combine_naive(const Ctx& X, const Params& P, int l) {
    const bf16_t* PB = (const bf16_t*)(P.ws + WS_PB); const float* O32 = (const float*)(P.ws + WS_S); bf16_t* Y = (bf16_t*)(P.ws + WS_Y);
    const float* nw = P.in[8] + l * 64;
    const int nrows = l == 0 ? NROWS : NLAT;
    const int gw = X.bid * NWAVES + X.wave, NGW = X.nb * NWAVES;
    for (int it = gw; it < nrows * 4; it += NGW) { const int row = it >> 2, h = it & 3;
        const float o = O32[(size_t)row * 256 + h * 64 + X.lane] + O32[((size_t)NROWS + row) * 256 + h * 64 + X.lane];
        const float ms = wave_sum(o * o) * (1.0f / 64.0f); const float y = o * (1.0f / sqrtf(ms + RMS_EPS)) * nw[X.lane];
        const float gte = bf2f(PB[(size_t)row * PBW + PB_AG + h * 64 + X.lane]);
        Y[(size_t)row * D + h * 64 + X.lane] = (bf16_t)f2bf(y * siluf_(gte)); }
}

DI void ph_inproj(const Ctx& X, const Params& P, int l) {
    PlainSched S; S.init(NROWS, INW, X.nb, X.bid);
    EpiIn E{(bf16_t*)(P.ws + WS_PB), (float*)(P.ws + WS_Z), (const float*)(P.ws + WS_ROPE)};
    gemm_naive(X, (const bf16_t*)(P.ws + WS_H), (const bf16_t*)(P.ws + WS_WIN) + (size_t)l * INW * D, D, S, E);
}
DI void ph_outproj(const Ctx& X, const Params& P, int l) {
    PlainSched S; S.init(l == 0 ? NROWS : NLAT, D, X.nb, X.bid);
    EpiBf E{(bf16_t*)(P.ws + WS_YO), D};
    gemm_naive(X, (const bf16_t*)(P.ws + WS_Y), (const bf16_t*)(P.ws + WS_WOUT) + (size_t)l * D * D, D, S, E);
}
DI void ph_moe1(const Ctx& X, const Params& P, int l) {
    MoeSched S{(const int*)(P.ws + WS_CTL) + CW_CNT + 64 * l, (const int*)(P.ws + WS_LIST), X.nb, X.bid, 4, 1024, true};
    EpiGU E{(bf16_t*)(P.ws + WS_S)};
    gemm_naive(X, (const bf16_t*)(P.ws + WS_H), (const bf16_t*)(P.ws + WS_WGU), D, S, E);
}
DI void ph_moe2(const Ctx& X, const Params& P, int l) {
    MoeSched S{(const int*)(P.ws + WS_CTL) + CW_CNT + 64 * l, (const int*)(P.ws + WS_LIST), X.nb, X.bid, 4, 1024, false};
    EpiBf E{(bf16_t*)(P.ws + WS_O), D};
    gemm_naive(X, (const bf16_t*)(P.ws + WS_S), (const bf16_t*)(P.ws + WS_WD), DEXP, S, E);
}

#define XB_TMO      128
#define XB_XCNT(j)  (256  + 64 * (j))
#define XB_XSUB(j)  (1280 + 64 * (j))
#define XB_XGEN(j)  (2304 + 64 * (j))
#define XB_TOP      3328
#define XB_TOPGEN   3392
#define XCD_BAR_WORDS 3456
#ifndef XB_SPIN_CAP
#define XB_SPIN_CAP (1u << 26)
#endif
DI unsigned xb_ld(unsigned* p)              { return __hip_atomic_load(p, __ATOMIC_RELAXED, __HIP_MEMORY_SCOPE_AGENT); }
DI unsigned xb_add(unsigned* p, unsigned v) { return __hip_atomic_fetch_add(p, v, __ATOMIC_RELAXED, __HIP_MEMORY_SCOPE_AGENT); }
DI unsigned xb_xcc_id() { return (unsigned)__builtin_amdgcn_s_getreg((3 << 11) | 20) & 0xFu; }
#define XB_SPIN(cond, bar) do { unsigned _sp = 0; while (cond) { __builtin_amdgcn_s_sleep(1); \
    if ((++_sp & 255u) == 0u) { if (xb_ld(&(bar)[XB_TMO])) break; if (_sp > XB_SPIN_CAP) { atomicAdd(&(bar)[XB_TMO], 1u); break; } } } } while (0)
struct XcdBarrier { unsigned* bar; unsigned x; volatile LAS unsigned* st; };
DI XcdBarrier xcd_barrier_post(unsigned* bar, volatile LAS unsigned* st) {
    XcdBarrier b; b.bar = bar; b.x = xb_xcc_id(); b.st = st;
    if (threadIdx.x == 0) (void)xb_add(&bar[XB_XCNT(b.x)], 1u);
    return b;
}
DI void xcd_barrier_complete(unsigned* bar, unsigned x, unsigned& nloc, unsigned& nx) {
    const unsigned G = gridDim.x * gridDim.y * gridDim.z;
    unsigned sum, cnt, mine, sp = 0u;
    for (;;) {
        sum = 0u; cnt = 0u; mine = 0u;
#pragma unroll
        for (unsigned j = 0; j < 16; ++j) { const unsigned c = xb_ld(&bar[XB_XCNT(j)]); sum += c; cnt += (c > 0u) ? 1u : 0u; mine = (j == x) ? c : mine; }
        if (sum == G) break;
        __builtin_amdgcn_s_sleep(1);
        if ((++sp & 255u) == 0u) { if (xb_ld(&bar[XB_TMO])) break; if (sp > XB_SPIN_CAP) { atomicAdd(&bar[XB_TMO], 1u); break; } }
    }
    nloc = mine > 0u ? mine : 1u; nx = cnt > 0u ? cnt : 1u;
}
DI void xcd_barrier(const XcdBarrier& b) {
    asm volatile("s_waitcnt vmcnt(0)" ::: "memory");
    __syncthreads();
    if (threadIdx.x == 0) {
        unsigned* bar = b.bar;
        __builtin_amdgcn_s_waitcnt(0);
        unsigned nloc = b.st[0], nx = b.st[1];
        if (nloc == 0u) { xcd_barrier_complete(bar, b.x, nloc, nx); b.st[0] = nloc; b.st[1] = nx; }
        const unsigned old = xb_add(&bar[XB_XSUB(b.x)], 1u);
        const unsigned gen = old / nloc;
        if (old + 1u == (gen + 1u) * nloc) {
            __builtin_amdgcn_fence(__ATOMIC_RELEASE, "agent");
            asm volatile("s_waitcnt vmcnt(0)" ::: "memory");
            const unsigned og = xb_add(&bar[XB_TOP], 1u);
            const unsigned tg = og / nx;
            if (og + 1u == (tg + 1u) * nx) xb_add(&bar[XB_TOPGEN], 1u);
            else XB_SPIN(xb_ld(&bar[XB_TOPGEN]) == tg, bar);
            __builtin_amdgcn_fence(__ATOMIC_ACQUIRE, "agent");
            xb_add(&bar[XB_XGEN(b.x)], 1u);
            asm volatile("s_waitcnt vmcnt(0)" ::: "memory");
        } else {
            XB_SPIN(xb_ld(&bar[XB_XGEN(b.x)]) == gen, bar);
            __builtin_amdgcn_fence(__ATOMIC_ACQUIRE, "agent");
            asm volatile("s_waitcnt vmcnt(0)" ::: "memory");
        }
    }
    __syncthreads();
}

template <int Q> DI void run_phase(const Ctx& X, const Params& P, int l) {
    if constexpr (Q == 0) ph_prologue(X, P);
    if constexpr (Q == 1) ph_modulate(X, P, 0);
    if constexpr (Q == 2) ph_inproj(X, P, l);
    if constexpr (Q == 3) ph_hgrn_naive(X, P, l);
    if constexpr (Q == 4) ph_hgrn_combine_naive(X, P, l);
    if constexpr (Q == 5) ph_attn_naive(X, P, l);
    if constexpr (Q == 6) ph_outproj(X, P, l);
    if constexpr (Q == 7) ph_ln1(X, P, l);
    if constexpr (Q == 8) ph_moe1(X, P, l);
    if constexpr (Q == 9) ph_moe2(X, P, l);
    if constexpr (Q == 10) { ph_ln2(X, P, l); if (l == 0) { __syncthreads(); convert_experts(X, P, 1, (LAS float*)X.lds + X.wave * (64 * 33)); } }
}

constexpr int LDS_BYTES = 147 * 1024;
template <int Q>
__global__ void __launch_bounds__(NTHREADS, 2) k_step(Params P, int l) {
    extern __shared__ __attribute__((aligned(16))) unsigned char lds_raw[];
    Ctx X; X.lds = (LAS unsigned char*)lds_raw; X.tid = threadIdx.x; X.lane = X.tid & 63; X.wave = __builtin_amdgcn_readfirstlane(X.tid >> 6); X.bid = blockIdx.x; X.nb = gridDim.x;
    run_phase<Q>(X, P, l);
}
template <int Q> static void launch_step(const Params& P, int l, int grid, hipStream_t stream) {
    static bool attr = false;
    if (!attr) { (void)hipFuncSetAttribute((const void*)k_step<Q>, hipFuncAttributeMaxDynamicSharedMemorySize, LDS_BYTES); attr = true; }
    hipLaunchKernelGGL(k_step<Q>, dim3(grid), dim3(NTHREADS), LDS_BYTES, stream, P, l);
}

constexpr int LDS_CTL_OFF = 144 * 1024;
__global__ void __launch_bounds__(NTHREADS, 2) k_mega(Params P) {
    extern __shared__ __attribute__((aligned(16))) unsigned char lds_raw[];
    Ctx X; X.lds = (LAS unsigned char*)lds_raw; X.tid = threadIdx.x; X.lane = X.tid & 63; X.wave = __builtin_amdgcn_readfirstlane(X.tid >> 6); X.bid = blockIdx.x; X.nb = gridDim.x;
    volatile LAS unsigned* st = (volatile LAS unsigned*)(X.lds + LDS_CTL_OFF);
    if (X.tid < 4) st[X.tid] = 0u;
    __syncthreads();
    const XcdBarrier bar = xcd_barrier_post((unsigned*)(P.ws + WS_CTL) + CW_BAR, st);
#define GBAR() xcd_barrier(bar)
    run_phase<0>(X, P, 0); GBAR();
    run_phase<1>(X, P, 0); GBAR();
    for (int l = 0; l < 2; ++l) {
        run_phase<2>(X, P, l); GBAR();
        run_phase<3>(X, P, l); GBAR();
        run_phase<4>(X, P, l); GBAR();
        run_phase<5>(X, P, l); GBAR();
        run_phase<6>(X, P, l); GBAR();
        run_phase<7>(X, P, l); GBAR();
        run_phase<8>(X, P, l); GBAR();
        run_phase<9>(X, P, l); GBAR();
        run_phase<10>(X, P, l); if (l == 0) GBAR();
    }
#undef GBAR
}

extern "C" void kernel_launch(void* const* d_in, const int* in_sizes, int n_in, void* d_out, int out_size, void* d_ws, size_t ws_size, hipStream_t stream) {
    static int grid = 0;
    if (grid == 0) {
        if (n_in != 21 || out_size != NLAT * D || ws_size < WS_END) { fprintf(stderr, "kernel_launch: unexpected shapes n_in %d out %d ws %zu\n", n_in, out_size, ws_size); grid = -1; return; }
        int dev = 0, cus = 0; (void)hipGetDevice(&dev); (void)hipDeviceGetAttribute(&cus, hipDeviceAttributeMultiprocessorCount, dev);
        grid = cus > 0 ? cus : 256;
        (void)hipFuncSetAttribute((const void*)k_mega, hipFuncAttributeMaxDynamicSharedMemorySize, LDS_BYTES);
    }
    if (grid < 0) return;
    (void)hipMemsetAsync((char*)d_ws + WS_CTL, 0, CTL_BYTES, stream);
    Params P{};
    for (int i = 0; i < 21; ++i) P.in[i] = (const float*)d_in[i];
    P.out = (float*)d_out; P.ws = (unsigned char*)d_ws;
#if N_LAUNCH_MODE == 1
    hipLaunchKernelGGL(k_mega, dim3(grid), dim3(NTHREADS), LDS_BYTES, stream, P);
#else
    launch_step<0>(P, 0, grid, stream);
    launch_step<1>(P, 0, grid, stream);
    for (int l = 0; l < 2; ++l) {
        launch_step<2>(P, l, grid, stream); launch_step<3>(P, l, grid, stream); launch_step<4>(P, l, grid, stream); launch_step<5>(P, l, grid, stream);
        launch_step<6>(P, l, grid, stream); launch_step<7>(P, l, grid, stream); launch_step<8>(P, l, grid, stream); launch_step<9>(P, l, grid, stream);
        launch_step<10>(P, l, grid, stream);
    }
#endif
}
```

```cpp
#include <hip/hip_runtime.h>
#include <cstdint>
#include <cstdio>

#ifndef N_LAUNCH_MODE
#define N_LAUNCH_MODE 1
#endif
#ifndef FAST_MIX
#define FAST_MIX 1
#endif
#ifndef DBG_TEST
#define DBG_TEST 0
#endif
#ifndef DBG_HG_MODE
#define DBG_HG_MODE 0
#endif
#ifndef FAST_GEMM
#define FAST_GEMM 1
#endif

#define LAS __attribute__((address_space(3)))
#define GAS __attribute__((address_space(1)))
typedef unsigned short bf16_t;
typedef short bf16x8 __attribute__((ext_vector_type(8)));
typedef float f32x4 __attribute__((ext_vector_type(4)));
typedef float f32x2 __attribute__((ext_vector_type(2)));
typedef unsigned u32x4 __attribute__((ext_vector_type(4)));
typedef unsigned u32x2 __attribute__((ext_vector_type(2)));
typedef short s16x4 __attribute__((ext_vector_type(4)));
typedef float f32x16 __attribute__((ext_vector_type(16)));
#define DI __device__ __forceinline__

constexpr int D = 1024, NB = 2, SEQ = 8192, CTXL = 256, NLAT = NB * SEQ, NCTX = NB * CTXL, NROWS = NLAT + NCTX;
constexpr int INW = 2816, PBW = 2304, ZW = 512, NEXP = 16, DEXP = 512, LISTCAP = NROWS;
constexpr int NTHREADS = 512, NWAVES = 8;
constexpr float ALPHA = 1.41421356237f, LN_EPS = 1e-5f, RMS_EPS = 1e-6f, LOG2E = 1.4426950408889634f, QSCALE = 0.125f * LOG2E;
constexpr int PB_AQ = 0, PB_AI = 256, PB_AG = 512, PB_NQ = 768, PB_NK = 1024, PB_NV = 1280, PB_SQ = 1536, PB_SK = 2048, PB_SV = 2176;
constexpr int NCHAIN = 132;

constexpr size_t MiB = 1u << 20;
constexpr size_t WS_CTL = 0, CTL_BYTES = 1 * MiB;
constexpr size_t WS_MODS = 1 * MiB;
constexpr size_t WS_LB = WS_MODS + 2 * 3 * 6144 * 4;
constexpr size_t WS_ROPE = WS_LB + 2 * 2 * 256 * 4;
constexpr size_t WS_TOKE = WS_ROPE + 128 * 16 * 2 * 4;
constexpr size_t WS_TOKP = WS_TOKE + NROWS * 8;
constexpr size_t WS_TOKW = WS_TOKP + NROWS * 8;
constexpr size_t WS_LIST = 2 * MiB;
constexpr size_t WS_XC = 4 * MiB;
constexpr size_t WS_WIN = 6 * MiB;
constexpr size_t WS_WOUT = 17 * MiB;
constexpr size_t WS_WGU = 21 * MiB;
constexpr size_t WS_WD = 53 * MiB;
constexpr size_t WS_H = 69 * MiB;
constexpr size_t WS_Y = 102 * MiB;
constexpr size_t WS_S = 135 * MiB;
constexpr size_t WS_DD = 282 * MiB;
constexpr size_t WS_PB = 174 * MiB;
constexpr size_t WS_Z = WS_PB + (size_t)NROWS * PBW * 2;
constexpr size_t WS_O = 174 * MiB;
constexpr size_t WS_YO = 248 * MiB;
constexpr size_t WS_END = 284 * MiB;
constexpr int HE_ROWS = 37888;
static_assert(WS_DD + (size_t)2 * 2112 * 64 * 4 <= WS_END && WS_Z + (size_t)NROWS * ZW * 4 <= WS_DD && WS_O + (size_t)HE_ROWS * 1024 * 2 <= WS_YO && WS_YO + (size_t)NROWS * 2048 <= WS_END, "ws map");
static_assert(WS_TOKW + NROWS * 8 <= WS_LIST && WS_LIST + 16 * LISTCAP * 4 <= WS_XC, "ws map small");
constexpr int CW_CNT = 64;
constexpr int CW_BAR = 4096;
constexpr int CW_DBG = 512;

struct Params {
    const float* in[21];
    float* out;
    unsigned char* ws;
    int step_lo, step_hi;
};

DI unsigned f2bf(float f) { unsigned u = __builtin_bit_cast(unsigned, f); return (u + 0x7fffu + ((u >> 16) & 1u)) >> 16; }
DI float bf2f(unsigned h) { return __builtin_bit_cast(float, h << 16); }
typedef __bf16 bf16x2_t __attribute__((ext_vector_type(2)));
DI unsigned pk2(float lo, float hi) { return __builtin_bit_cast(unsigned, __builtin_convertvector((f32x2){lo, hi}, bf16x2_t)); }
DI float bflo(unsigned w) { return __builtin_bit_cast(float, w << 16); }
DI float bfhi(unsigned w) { return __builtin_bit_cast(float, w & 0xffff0000u); }
DI float wave_sum(float v) {
#pragma unroll
    for (int o = 1; o < 64; o <<= 1) v += __shfl_xor(v, o);
    return v;
}
DI float wave_max(float v) {
#pragma unroll
    for (int o = 1; o < 64; o <<= 1) v = fmaxf(v, __shfl_xor(v, o));
    return v;
}
DI float sigmoidf_(float x) { return 1.0f / (1.0f + __expf(-x)); }
DI float siluf_(float x) { return x / (1.0f + __expf(-x)); }
DI void store_bf4(bf16_t* p, f32x4 v) { u32x2 w; w.x = pk2(v[0], v[1]); w.y = pk2(v[2], v[3]); *(u32x2*)p = w; }

struct Ctx {
    LAS unsigned char* lds;
    int tid, lane, wave, bid, nb;
};

struct Unit { int pm, pn, e, cnt, i0; };

struct PlainSched {
    int nM, nN, nwg, G, c;
    DI void init(int M, int N, int G_, int c_) { nM = M / 256; nN = N / 256; nwg = nM * nN; G = G_; c = c_; }
    DI bool next(int i, Unit& u) const {
        const long L = (long)i * G + c; if (L >= nwg) return false;
        int wgid = (int)L; { const int q = nwg / 8, r = nwg % 8, xcd = wgid % 8, off = wgid / 8; wgid = (xcd < r ? xcd * (q + 1) : r * (q + 1) + (xcd - r) * q) + off; }
        const int nig = 8 * nN, gid = wgid / nig, fm = gid * 8, gsz = (nM - fm) < 8 ? (nM - fm) : 8;
        u.pm = fm + ((wgid % nig) % gsz); u.pn = (wgid % nig) / gsz; u.e = 0; u.cnt = 0; u.i0 = 0; return true;
    }
    DI int a_row(const Unit& u, int r) const { return u.pm * 256 + r; }
    DI int b_row0(const Unit& u) const { return u.pn * 256; }
    static constexpr bool LOADS = false;
};
struct MoeSched {
    const int* cnt; const int* list; int G, c, nct, bt_rows; bool gather;
    DI bool next(int i, Unit& u) const {
        const int xcd = c & 7, j = c >> 3; const int L = i * G + xcd * (G >> 3) + j;
        const int T = L / nct; int acc = 0, e = -1, i0 = 0, ce = 0;
#pragma unroll
        for (int q = 0; q < NEXP; ++q) { const int cq = cnt[q]; const int nt = (cq + 255) >> 8; if (e < 0 && T < acc + nt) { e = q; i0 = T - acc; ce = cq; } acc += nt; }
        if (e < 0) return false;
        u.pm = T; u.pn = L % nct; u.e = e; u.cnt = ce; u.i0 = i0; return true;
    }
    DI int a_row(const Unit& u, int r) const {
        if (!gather) return u.pm * 256 + r;
        const int idx = u.i0 * 256 + r; return list[u.e * LISTCAP + (idx < u.cnt ? idx : 0)];
    }
    DI int b_row0(const Unit& u) const { return u.e * bt_rows + u.pn * 256; }
    static constexpr bool LOADS = true;
};

struct EpiIn {
    bf16_t* PB; float* Z; const float* rope;
    DI void group(const Unit& u, int r, int c, f32x4 a0, f32x4 a1, f32x4 b0, f32x4 b1) const {
        const int row = u.pm * 256 + r, seg = u.pn, gc = u.pn * 256 + c;
        if (seg == 1 || seg == 2) {
            float* z = Z + (size_t)row * ZW + (seg - 1) * 256 + c;
            *(f32x4*)z = a0; *(f32x4*)(z + 16) = a1; *(f32x4*)(z + 128) = b0; *(f32x4*)(z + 144) = b1;
            return;
        }
        const bool lat = row < NLAT;
        if (seg >= 8 && lat) {
            const int t = row & (SEQ - 1); const int which = (c >> 5) & 1; const int pos = which ? (t & 63) : (t >> 6);
            const float* rp = rope + (pos * 16 + (c & 31)) * 2;
#pragma unroll
            for (int j = 0; j < 4; ++j) {
                const float cs = rp[2 * j], sn = rp[2 * j + 1];
                const float x1 = a0[j], x2 = a1[j]; a0[j] = x1 * cs - x2 * sn; a1[j] = x1 * sn + x2 * cs;
                if (seg < 10) { const float y1 = b0[j], y2 = b1[j]; b0[j] = y1 * cs - y2 * sn; b1[j] = y1 * sn + y2 * cs; }
            }
        }
        if (seg == 5 || seg == 8 || seg == 9) { a0 *= QSCALE; a1 *= QSCALE; b0 *= QSCALE; b1 *= QSCALE; }
        bf16_t* p = PB + (size_t)row * PBW + (gc >= 768 ? gc - 512 : gc);
        store_bf4(p, a0); store_bf4(p + 16, a1); store_bf4(p + 128, b0); store_bf4(p + 144, b1);
    }
};
struct EpiBf {
    bf16_t* C; int ldc;
    DI void group(const Unit& u, int r, int c, f32x4 a0, f32x4 a1, f32x4 b0, f32x4 b1) const {
        bf16_t* p = C + (size_t)(u.pm * 256 + r) * ldc + u.pn * 256 + c;
        store_bf4(p, a0); store_bf4(p + 16, a1); store_bf4(p + 128, b0); store_bf4(p + 144, b1);
    }
};
struct EpiGU {
    bf16_t* HE;
    DI void group(const Unit& u, int r, int c, f32x4 a0, f32x4 a1, f32x4 b0, f32x4 b1) const {
        f32x4 h0, h1;
#pragma unroll
        for (int j = 0; j < 4; ++j) { h0[j] = siluf_(a0[j]) * b0[j]; h1[j] = siluf_(a1[j]) * b1[j]; }
        bf16_t* p = HE + (size_t)(u.pm * 256 + r) * DEXP + u.pn * 128 + c;
        store_bf4(p, h0); store_bf4(p + 16, h1);
    }
};

template <class Sched, class Epi>
DI void gemm_naive(const Ctx& X, const bf16_t* A, const bf16_t* Bt, int K, const Sched& S, const Epi& E) {
    Unit u;
    for (int i = 0; S.next(i, u); ++i) {
        for (int g = X.tid; g < 4096; g += NTHREADS) {
            const int fq = g & 3, wc = (g >> 2) & 3, r = g >> 4, c = wc * 32 + fq * 4;
            const bf16_t* ap = A + (size_t)S.a_row(u, r) * K;
            const bf16_t* bp = Bt + (size_t)(S.b_row0(u) + c) * K;
            float acc[16];
#pragma unroll
            for (int q = 0; q < 16; ++q) acc[q] = 0.f;
            for (int k = 0; k < K; k += 8) {
                const u32x4 av = *(const u32x4*)(ap + k);
                float af[8] = {bflo(av.x), bfhi(av.x), bflo(av.y), bfhi(av.y), bflo(av.z), bfhi(av.z), bflo(av.w), bfhi(av.w)};
#pragma unroll
                for (int q = 0; q < 16; ++q) {
                    const int col = (q >> 3) * 128 + ((q >> 2) & 1) * 16 + (q & 3);
                    const u32x4 bv = *(const u32x4*)(bp + (size_t)col * K + k);
                    acc[q] += af[0] * bflo(bv.x) + af[1] * bfhi(bv.x) + af[2] * bflo(bv.y) + af[3] * bfhi(bv.y) + af[4] * bflo(bv.z) + af[5] * bfhi(bv.z) + af[6] * bflo(bv.w) + af[7] * bfhi(bv.w);
                }
            }
            E.group(u, r, c, (f32x4){acc[0], acc[1], acc[2], acc[3]}, (f32x4){acc[4], acc[5], acc[6], acc[7]}, (f32x4){acc[8], acc[9], acc[10], acc[11]}, (f32x4){acc[12], acc[13], acc[14], acc[15]});
        }
    }
}

constexpr int HTB = 128 * 64 * 2;
DI int lds_byte(int r, int c) { const int st = (r >> 4) * 2 + (c >> 5), rr = r & 15, cc = c & 31, ob = rr * 64 + cc * 2; return st * 1024 + (ob ^ (((ob >> 9) & 1) << 5)); }
DI void stage_rc(int b, int& R, int& C) { const int st = b / 1024, sb = b % 1024, swz = sb ^ (((sb >> 9) & 1) << 5); R = (st >> 1) * 16 + swz / 64; C = (st & 1) * 32 + (swz % 64) / 2; }
template <class Sched, class Epi>
DI void gemm_fast(const Ctx& X, const bf16_t* A, const bf16_t* Bt, int K, const Sched& S, const Epi& E) {
    LAS unsigned char* lds = X.lds;
    const int tid = X.tid, wid = X.wave, lane = X.lane, wr = wid >> 2, wc = wid & 3, fr = lane & 15, fq = lane >> 4;
    const int nt = K / 64;
    int Rr[2], Cc[2]; unsigned voffB[2];
#pragma unroll
    for (int i = 0; i < 2; ++i) { stage_rc(tid * 16 + i * 8192, Rr[i], Cc[i]); voffB[i] = (unsigned)(Rr[i] * K + Cc[i]) * 2u; }
    const size_t kstep = 128, hstepB = (size_t)128 * K * 2;
    const unsigned ldsw = (unsigned)wid * 1024u;
    const int aoff = lds_byte(wr * 64 + fr, fq * 8), boff = lds_byte(wc * 32 + fr, fq * 8);
#define G_SA(b, h) (((b) * 2 + (h)) * HTB)
#define G_SB(b, h) ((4 + (b) * 2 + (h)) * HTB)
#define G_STAGE(bufoff, gbase, voff) do { _Pragma("unroll") for (int _i = 0; _i < 2; ++_i) \
        __builtin_amdgcn_global_load_lds((const unsigned*)((const char*)(gbase) + (voff)[_i]), (LAS unsigned*)(lds + (bufoff) + ldsw + _i * 8192), 16, 0, 0); } while (0)
#define G_LDA(dst, b, h) do { _Pragma("unroll") for (int m = 0; m < 4; ++m) _Pragma("unroll") for (int k = 0; k < 2; ++k) dst[m][k] = *(const LAS bf16x8*)(lds + G_SA(b, h) + aoff + m * 2048 + k * 1024); } while (0)
#define G_LDB(dst, b, h) do { _Pragma("unroll") for (int n = 0; n < 2; ++n) _Pragma("unroll") for (int k = 0; k < 2; ++k) dst[n][k] = *(const LAS bf16x8*)(lds + G_SB(b, h) + boff + n * 2048 + k * 1024); } while (0)
#define G_MMA(ai, bj, At, Bt_) do { __builtin_amdgcn_s_setprio(1); _Pragma("unroll") for (int m = 0; m < 4; ++m) _Pragma("unroll") for (int n = 0; n < 2; ++n) _Pragma("unroll") for (int k = 0; k < 2; ++k) \
        acc[ai][bj][m][n] = __builtin_amdgcn_mfma_f32_16x16x32_bf16(Bt_[n][k], At[m][k], acc[ai][bj][m][n], 0, 0, 0); __builtin_amdgcn_s_setprio(0); } while (0)
#define G_WAIT_V(n) asm volatile("s_waitcnt vmcnt(" #n ")" ::: "memory")
#define G_WAIT_L(n) asm volatile("s_waitcnt lgkmcnt(" #n ")" ::: "memory")
#define G_BAR __builtin_amdgcn_s_barrier()
#define G_SCHED __builtin_amdgcn_sched_barrier(0)
    Unit cur, nxt; int ui = 0;
    if (!S.next(0, cur)) return;
    f32x4 acc[2][2][4][2];
#pragma unroll
    for (int a = 0; a < 2; ++a)
#pragma unroll
        for (int b = 0; b < 2; ++b)
#pragma unroll
            for (int m = 0; m < 4; ++m)
#pragma unroll
                for (int n = 0; n < 2; ++n) acc[a][b][m][n] = (f32x4){0.f, 0.f, 0.f, 0.f};
    bf16x8 At[4][2], B0[2][2], B1[2][2];
    unsigned vAc[2][2], vAn[2][2];
#pragma unroll
    for (int h = 0; h < 2; ++h)
#pragma unroll
        for (int i = 0; i < 2; ++i) vAc[h][i] = (unsigned)(S.a_row(cur, h * 128 + Rr[i]) * K + Cc[i]) * 2u;
    G_WAIT_V(0);
    const char* A0 = (const char*)A;
    const char* cB = (const char*)Bt + (size_t)S.b_row0(cur) * K * 2;
    G_STAGE(G_SB(0, 0), cB, voffB); G_STAGE(G_SB(0, 1), cB + hstepB, voffB); G_STAGE(G_SA(0, 0), A0, vAc[0]); G_STAGE(G_SA(0, 1), A0, vAc[1]);
    if (wr == 1) G_BAR;
    G_WAIT_V(2); G_BAR;
    G_STAGE(G_SB(1, 0), cB + kstep, voffB); G_STAGE(G_SA(1, 0), A0 + kstep, vAc[0]); G_STAGE(G_SB(1, 1), cB + hstepB + kstep, voffB);
    G_WAIT_V(6); G_BAR;
    for (;;) {
        const bool has_next = S.next(ui + 1, nxt);
        if (has_next) {
#pragma unroll
            for (int h = 0; h < 2; ++h)
#pragma unroll
                for (int i = 0; i < 2; ++i) vAn[h][i] = (unsigned)(S.a_row(nxt, h * 128 + Rr[i]) * K + Cc[i]) * 2u;
            if (Sched::LOADS) G_WAIT_V(0);
        } else {
#pragma unroll
            for (int h = 0; h < 2; ++h)
#pragma unroll
                for (int i = 0; i < 2; ++i) vAn[h][i] = vAc[h][i];
        }
        const char* nB = has_next ? (const char*)Bt + (size_t)S.b_row0(nxt) * K * 2 : cB;
        for (int t = 0; t < nt; t += 2) {
            const bool last = (t == nt - 2);
            const char* a1 = A0 + (size_t)(t + 1) * kstep;
            const char* a2 = last ? A0 : A0 + (size_t)(t + 2) * kstep; const char* b2 = last ? nB : cB + (size_t)(t + 2) * kstep;
            const char* a3 = a2 + kstep; const char* b3 = b2 + kstep;
            unsigned v2[2][2];
#pragma unroll
            for (int h = 0; h < 2; ++h)
#pragma unroll
                for (int i = 0; i < 2; ++i) v2[h][i] = last ? vAn[h][i] : vAc[h][i];
            G_LDB(B0, 0, 0); G_LDB(B1, 0, 1); G_SCHED; G_LDA(At, 0, 0); G_STAGE(G_SA(1, 1), a1, vAc[1]);
            G_WAIT_V(8); G_WAIT_L(0); G_BAR; G_MMA(0, 0, At, B0); G_MMA(0, 1, At, B1); G_BAR; G_SCHED;
            G_LDA(At, 0, 1); G_STAGE(G_SB(0, 0), b2, voffB); G_STAGE(G_SB(0, 1), b2 + hstepB, voffB); G_STAGE(G_SA(0, 0), a2, v2[0]);
            G_WAIT_V(8); G_WAIT_L(0); G_BAR; G_MMA(1, 0, At, B0); G_MMA(1, 1, At, B1); G_BAR; G_SCHED;
            G_LDB(B0, 1, 0); G_LDB(B1, 1, 1); G_SCHED; G_LDA(At, 1, 0); G_STAGE(G_SA(0, 1), a2, v2[1]);
            G_WAIT_V(8); G_WAIT_L(0); G_BAR; G_MMA(0, 0, At, B0); G_MMA(0, 1, At, B1); G_BAR; G_SCHED;
            G_LDA(At, 1, 1); G_STAGE(G_SB(1, 0), b3, voffB); G_STAGE(G_SB(1, 1), b3 + hstepB, voffB); G_STAGE(G_SA(1, 0), a3, v2[0]);
            G_WAIT_V(8); G_WAIT_L(0); G_BAR; G_MMA(1, 0, At, B0); G_MMA(1, 1, At, B1); G_BAR; G_SCHED;
        }
        if (wr == 0) G_BAR;
#pragma unroll
        for (int ai = 0; ai < 2; ++ai)
#pragma unroll
            for (int m = 0; m < 4; ++m) E.group(cur, ai * 128 + wr * 64 + m * 16 + fr, wc * 32 + fq * 4, acc[ai][0][m][0], acc[ai][0][m][1], acc[ai][1][m][0], acc[ai][1][m][1]);
        if (!has_next) break;
#pragma unroll
        for (int a = 0; a < 2; ++a)
#pragma unroll
            for (int b = 0; b < 2; ++b)
#pragma unroll
                for (int m = 0; m < 4; ++m)
#pragma unroll
                    for (int n = 0; n < 2; ++n) acc[a][b][m][n] = (f32x4){0.f, 0.f, 0.f, 0.f};
        cur = nxt; cB = nB; ++ui;
#pragma unroll
        for (int h = 0; h < 2; ++h)
#pragma unroll
            for (int i = 0; i < 2; ++i) vAc[h][i] = vAn[h][i];
        if (wr == 1) G_BAR;
    }
    G_WAIT_V(0);
    G_BAR;
#undef G_SA
#undef G_SB
#undef G_STAGE
#undef G_LDA
#undef G_LDB
#undef G_MMA
#undef G_WAIT_V
#undef G_WAIT_L
#undef G_BAR
#undef G_SCHED
}
#if FAST_GEMM
#define GEMM_IMPL gemm_fast
#else
#define GEMM_IMPL gemm_naive
#endif

DI void transpose_item(const float* W, int N, bf16_t* WT, int Kd, int k0, int n0, int drow0, LAS float* scr, int lane) {
#pragma unroll 8
    for (int i = 0; i < 32; ++i) { const int kk = 2 * i + (lane >> 5); scr[kk * 33 + (lane & 31)] = W[(size_t)(k0 + kk) * N + n0 + (lane & 31)]; }
    asm volatile("s_waitcnt lgkmcnt(0)" ::: "memory");
    const int c = lane & 7;
#pragma unroll
    for (int j = 0; j < 4; ++j) { const int n = (lane >> 3) + 8 * j; const LAS float* s = scr + (8 * c) * 33 + n;
        u32x4 o; o.x = pk2(s[0 * 33], s[1 * 33]); o.y = pk2(s[2 * 33], s[3 * 33]); o.z = pk2(s[4 * 33], s[5 * 33]); o.w = pk2(s[6 * 33], s[7 * 33]);
        *(u32x4*)(WT + (size_t)(drow0 + n) * Kd + k0 + 8 * c) = o; }
    asm volatile("s_waitcnt lgkmcnt(0)" ::: "memory");
}
DI void convert_experts(const Ctx& X, const Params& P, int l, LAS float* scr) {
    const int gw = X.bid * NWAVES + X.wave, NGW = X.nb * NWAVES;
    bf16_t* WGU = (bf16_t*)(P.ws + WS_WGU); bf16_t* WD = (bf16_t*)(P.ws + WS_WD);
    const float* wg = P.in[18] + (size_t)l * NEXP * D * DEXP; const float* wu = P.in[19] + (size_t)l * NEXP * D * DEXP; const float* wd = P.in[20] + (size_t)l * NEXP * DEXP * D;
    for (int it = gw; it < 3 * 4096; it += NGW) {
        const int set = it >> 12, r = it & 4095, e = r >> 8, q = r & 255;
        if (set < 2) { const int kb = q >> 4, nbk = q & 15, n0 = nbk * 32;
            transpose_item((set ? wu : wg) + (size_t)e * D * DEXP, DEXP, WGU + (size_t)e * 1024 * 1024, 1024, kb * 64, n0, 256 * (n0 >> 7) + (n0 & 127) + set * 128, scr, X.lane);
        } else { const int kb = q >> 5, nbk = q & 31, n0 = nbk * 32;
            transpose_item(wd + (size_t)e * DEXP * D, D, WD + (size_t)e * 1024 * 512, 512, kb * 64, n0, n0, scr, X.lane); }
    }
}
DI void ph_prologue(const Ctx& X, const Params& P) {
    LAS float* sc = (LAS float*)X.lds;
    LAS float* red = sc + 3072;
    float* MODS = (float*)(P.ws + WS_MODS);
    for (int it = X.bid; it < 193; it += X.nb) {
        if (it < 192) {
            const int l = it / 96, cg = it % 96;
            for (int i = X.tid; i < 3072; i += NTHREADS) { const int cond = i >> 10, k = i & 1023; const float v = cond < 2 ? P.in[1][cond * 1024 + k] : P.in[3][k]; sc[i] = siluf_(v); }
            __syncthreads();
            const int kq = X.tid >> 4, c4 = X.tid & 15;
            float acc[3][4];
#pragma unroll
            for (int a = 0; a < 3; ++a)
#pragma unroll
                for (int j = 0; j < 4; ++j) acc[a][j] = 0.f;
            const float* w = P.in[4] + (size_t)l * D * 6144 + cg * 64 + c4 * 4;
#pragma unroll 8
            for (int i = 0; i < 32; ++i) { const int k = kq + 32 * i; const f32x4 wv = *(const f32x4*)(w + (size_t)k * 6144);
                const float s0 = sc[k], s1 = sc[1024 + k], s2 = sc[2048 + k];
#pragma unroll
                for (int j = 0; j < 4; ++j) { acc[0][j] += s0 * wv[j]; acc[1][j] += s1 * wv[j]; acc[2][j] += s2 * wv[j]; } }
#pragma unroll
            for (int a = 0; a < 3; ++a)
#pragma unroll
                for (int j = 0; j < 4; ++j) red[(kq * 3 + a) * 64 + c4 * 4 + j] = acc[a][j];
            __syncthreads();
            if (X.tid < 192) { const int cond = X.tid >> 6, col = X.tid & 63; float s = 0.f;
                for (int q = 0; q < 32; ++q) s += red[(q * 3 + cond) * 64 + col];
                MODS[(l * 3 + cond) * 6144 + cg * 64 + col] = s + P.in[5][l * 6144 + cg * 64 + col]; }
            __syncthreads();
        } else {
            float* LB = (float*)(P.ws + WS_LB);
            { const int i = X.tid; const float l0 = P.in[7][i], l1 = P.in[7][512 + i]; const float p1 = 1.0f / (1.0f + expf(l0 - l1));
              LB[i] = 1e-6f; LB[512 + i] = fmaxf(p1, 1e-6f); }
            float* RP = (float*)(P.ws + WS_ROPE);
            for (int i = X.tid; i < 2048; i += NTHREADS) { const int pos = i >> 4, f = i & 15; const float inv = powf(10000.0f, -(float)f / 16.0f); const float ang = (float)pos * inv;
                RP[2 * i] = cosf(ang); RP[2 * i + 1] = sinf(ang); }
        }
    }
    __syncthreads();
    LAS float* scr = (LAS float*)X.lds + X.wave * (64 * 33);
    const int gw = X.bid * NWAVES + X.wave, NGW = X.nb * NWAVES;
    bf16_t* WIN = (bf16_t*)(P.ws + WS_WIN); bf16_t* WOUT = (bf16_t*)(P.ws + WS_WOUT);
    for (int it = gw; it < 2 * 1408 + 2 * 512; it += NGW) {
        if (it < 2816) { const int l = it / 1408, r = it % 1408, kb = r / 88, nbk = r % 88;
            transpose_item(P.in[6] + (size_t)l * D * INW, INW, WIN + (size_t)l * INW * D, D, kb * 64, nbk * 32, nbk * 32, scr, X.lane);
        } else { const int r0 = it - 2816, l = r0 >> 9, r = r0 & 511, kb = r >> 5, nbk = r & 31;
            transpose_item(P.in[11] + (size_t)l * D * D, D, WOUT + (size_t)l * D * D, D, kb * 64, nbk * 32, nbk * 32, scr, X.lane); }
    }
    convert_experts(X, P, 0, scr);
}

DI const float* mods_row(const Params& P, int l, int row) { const int cond = row < NLAT ? (row >> 13) : 2; return (const float*)(P.ws + WS_MODS) + (l * 3 + cond) * 6144; }
DI void ph_modulate(const Ctx& X, const Params& P, int l) {
    bf16_t* H = (bf16_t*)(P.ws + WS_H);
    const int gw = X.bid * NWAVES + X.wave, NGW = X.nb * NWAVES;
    for (int row = gw; row < NROWS; row += NGW) {
        const float* xr = row < NLAT ? P.in[0] + (size_t)row * D : P.in[2] + (size_t)(row - NLAT) * D; const float* md = mods_row(P, l, row);
#pragma unroll
        for (int j = 0; j < 4; ++j) { const int c = 4 * X.lane + 256 * j; const f32x4 x = *(const f32x4*)(xr + c), sh = *(const f32x4*)(md + c), sc = *(const f32x4*)(md + 1024 + c);
            store_bf4(H + (size_t)row * D + c, x * (1.0f + sc) + sh); }
    }
}
DI void ph_ln1(const Ctx& X, const Params& P, int l) {
    LAS float* wrT = (LAS float*)X.lds;
    for (int i = X.tid; i < 16384; i += NTHREADS) { const int k = i >> 4, e = i & 15; wrT[e * 1024 + k] = P.in[16][i]; }
    __syncthreads();
    const int nrows = l == 0 ? NROWS : NLAT;
    bf16_t* H = (bf16_t*)(P.ws + WS_H); const bf16_t* YO = (const bf16_t*)(P.ws + WS_YO); float* XC = (float*)(P.ws + WS_XC);
    int* TOKE = (int*)(P.ws + WS_TOKE); int* TOKP = (int*)(P.ws + WS_TOKP); float* TOKW = (float*)(P.ws + WS_TOKW); int* LIST = (int*)(P.ws + WS_LIST);
    unsigned* CNT = (unsigned*)(P.ws + WS_CTL) + CW_CNT + 64 * l;
    const float* g = P.in[12] + l * D; const float* bta = P.in[13] + l * D;
    const int gw = X.bid * NWAVES + X.wave, NGW = X.nb * NWAVES;
    for (int row = gw; row < nrows; row += NGW) {
        const bool lat = row < NLAT;
        const float* xr = lat ? (l == 0 ? P.in[0] : P.out) + (size_t)row * D : P.in[2] + (size_t)(row - NLAT) * D;
        float* xo = lat ? P.out + (size_t)row * D : XC + (size_t)(row - NLAT) * D;
        const float* md = mods_row(P, l, row);
        f32x4 v[4]; float s = 0.f;
#pragma unroll
        for (int j = 0; j < 4; ++j) { const int c = 4 * X.lane + 256 * j; const f32x4 x = *(const f32x4*)(xr + c), g1 = *(const f32x4*)(md + 2048 + c);
            const u32x2 yw = *(const u32x2*)(YO + (size_t)row * D + c); const f32x4 y = {bflo(yw.x), bfhi(yw.x), bflo(yw.y), bfhi(yw.y)};
            v[j] = ALPHA * x + g1 * y; s += (v[j][0] + v[j][1]) + (v[j][2] + v[j][3]); }
        const float mean = wave_sum(s) * (1.0f / D); float q = 0.f;
#pragma unroll
        for (int j = 0; j < 4; ++j) { v[j] = v[j] - mean; q += (v[j][0] * v[j][0] + v[j][1] * v[j][1]) + (v[j][2] * v[j][2] + v[j][3] * v[j][3]); }
        const float rstd = 1.0f / sqrtf(wave_sum(q) * (1.0f / D) + LN_EPS);
        f32x4 h2v[4];
#pragma unroll
        for (int j = 0; j < 4; ++j) { const int c = 4 * X.lane + 256 * j; const f32x4 x1 = v[j] * rstd * *(const f32x4*)(g + c) + *(const f32x4*)(bta + c);
            *(f32x4*)(xo + c) = x1;
            h2v[j] = x1 * (1.0f + *(const f32x4*)(md + 4096 + c)) + *(const f32x4*)(md + 3072 + c);
            store_bf4(H + (size_t)row * D + c, h2v[j]); }
        float lg[16];
#pragma unroll
        for (int e = 0; e < 16; ++e) { float a = 0.f;
#pragma unroll
            for (int j = 0; j < 4; ++j) { const f32x4 w = *(const LAS f32x4*)(wrT + e * 1024 + 4 * X.lane + 256 * j); a += (h2v[j][0] * w[0] + h2v[j][1] * w[1]) + (h2v[j][2] * w[2] + h2v[j][3] * w[3]); }
            lg[e] = a; asm volatile("" ::: "memory"); }
        float sg[16], sel[16];
#pragma unroll
        for (int e = 0; e < 16; ++e) { sg[e] = sigmoidf_(wave_sum(lg[e])); sel[e] = sg[e] + P.in[17][e]; }
        int best = 0; float bestv = -3e38f;
#pragma unroll
        for (int gq = 0; gq < 4; ++gq) { float m1 = -3e38f, m2 = -3e38f;
#pragma unroll
            for (int j = 0; j < 4; ++j) { const float t = sel[gq * 4 + j]; if (t > m1) { m2 = m1; m1 = t; } else if (t > m2) m2 = t; }
            const float gs = m1 + m2; if (gs > bestv) { bestv = gs; best = gq; } }
        int i0 = 0, i1 = 0; float v0 = -3e38f, v1 = -3e38f, s0 = 0.f, s1 = 0.f;
#pragma unroll
        for (int e = 0; e < 16; ++e) { if ((e >> 2) == best) { const float t = sel[e];
                if (t > v0) { v1 = v0; i1 = i0; s1 = s0; v0 = t; i0 = e; s0 = sg[e]; } else if (t > v1) { v1 = t; i1 = e; s1 = sg[e]; } } }
        if (X.lane == 0) {
            const float inv = 1.0f / (s0 + s1);
            const int p0 = (int)atomicAdd(CNT + i0, 1u), p1 = (int)atomicAdd(CNT + i1, 1u);
            LIST[i0 * LISTCAP + p0] = row; LIST[i1 * LISTCAP + p1] = row;
            TOKE[2 * row] = i0; TOKE[2 * row + 1] = i1; TOKP[2 * row] = p0; TOKP[2 * row + 1] = p1; TOKW[2 * row] = s0 * inv; TOKW[2 * row + 1] = s1 * inv;
        }
    }
}
DI void ph_ln2(const Ctx& X, const Params& P, int l) {
    const int nrows = l == 0 ? NROWS : NLAT;
    bf16_t* H = (bf16_t*)(P.ws + WS_H); const bf16_t* O = (const bf16_t*)(P.ws + WS_O); float* XC = (float*)(P.ws + WS_XC);
    const int* TOKE = (const int*)(P.ws + WS_TOKE); const int* TOKP = (const int*)(P.ws + WS_TOKP); const float* TOKW = (const float*)(P.ws + WS_TOKW);
    const unsigned* CNT = (const unsigned*)(P.ws + WS_CTL) + CW_CNT + 64 * l;
    const float* g = P.in[14] + l * D; const float* bta = P.in[15] + l * D;
    int off[16]; { int acc = 0;
#pragma unroll
        for (int e = 0; e < 16; ++e) { off[e] = acc; acc += (((int)CNT[e] + 255) >> 8) << 8; } }
    const int gw = X.bid * NWAVES + X.wave, NGW = X.nb * NWAVES;
    for (int row = gw; row < nrows; row += NGW) {
        const bool lat = row < NLAT;
        float* xr = lat ? P.out + (size_t)row * D : XC + (size_t)(row - NLAT) * D;
        const float* md = mods_row(P, l, row);
        const int e0 = TOKE[2 * row], e1 = TOKE[2 * row + 1]; int o0 = 0, o1 = 0;
#pragma unroll
        for (int e = 0; e < 16; ++e) { if (e == e0) o0 = off[e]; if (e == e1) o1 = off[e]; }
        const bf16_t* r0 = O + (size_t)(o0 + TOKP[2 * row]) * D; const bf16_t* r1 = O + (size_t)(o1 + TOKP[2 * row + 1]) * D;
        const float w0 = TOKW[2 * row], w1 = TOKW[2 * row + 1];
        f32x4 v[4]; float s = 0.f;
#pragma unroll
        for (int j = 0; j < 4; ++j) { const int c = 4 * X.lane + 256 * j; const f32x4 x = *(const f32x4*)(xr + c), g2 = *(const f32x4*)(md + 5120 + c);
            const u32x2 a = *(const u32x2*)(r0 + c), b = *(const u32x2*)(r1 + c);
            const f32x4 f = w0 * (f32x4){bflo(a.x), bfhi(a.x), bflo(a.y), bfhi(a.y)} + w1 * (f32x4){bflo(b.x), bfhi(b.x), bflo(b.y), bfhi(b.y)};
            v[j] = ALPHA * x + g2 * f; s += (v[j][0] + v[j][1]) + (v[j][2] + v[j][3]); }
        const float mean = wave_sum(s) * (1.0f / D); float q = 0.f;
#pragma unroll
        for (int j = 0; j < 4; ++j) { v[j] = v[j] - mean; q += (v[j][0] * v[j][0] + v[j][1] * v[j][1]) + (v[j][2] * v[j][2] + v[j][3] * v[j][3]); }
        const float rstd = 1.0f / sqrtf(wave_sum(q) * (1.0f / D) + LN_EPS);
        const float* mdn = mods_row(P, 1, row);
#pragma unroll
        for (int j = 0; j < 4; ++j) { const int c = 4 * X.lane + 256 * j; const f32x4 x2 = v[j] * rstd * *(const f32x4*)(g + c) + *(const f32x4*)(bta + c);
            *(f32x4*)(xr + c) = x2;
            if (l == 0) store_bf4(H + (size_t)row * D + c, x2 * (1.0f + *(const f32x4*)(mdn + 1024 + c)) + *(const f32x4*)(mdn + c)); }
    }
}

struct KeysNA { int b, r, c, rs, cs, h; const float* rpb;
    DI int n() const { return 128 + CTXL; }
    DI void get(int k, int& krow, float& bias) const { if (k < 128) { const int kr = rs + (k >> 4), kc = cs + (k & 15); krow = b * SEQ + kr * 64 + kc; bias = LOG2E * rpb[h * 465 + (kr - r + 7) * 31 + (kc - c + 15)]; } else { krow = NLAT + b * CTXL + (k - 128); bias = 0.f; } } };
struct KeysSWA { int b, lo, nband;
    DI int n() const { return nband + CTXL; }
    DI void get(int k, int& krow, float& bias) const { krow = k < nband ? b * SEQ + lo + k : NLAT + b * CTXL + (k - nband); bias = 0.f; } };
struct KeysCtx { int b;
    DI int n() const { return CTXL; }
    DI void get(int k, int& krow, float& bias) const { krow = NLAT + b * CTXL + k; bias = 0.f; } };
template <class Keys>
DI void attn_row_naive(const bf16_t* PB, int qrow, int qcol, int kcol, int vcol, const Keys& KS, bool has_sink, float sink, LAS float* sc, bf16_t* yout, int lane) {
    float q[64];
    { const u32x4* qp = (const u32x4*)(PB + (size_t)qrow * PBW + qcol);
#pragma unroll
      for (int i = 0; i < 8; ++i) { const u32x4 w = qp[i]; q[8 * i] = bflo(w.x); q[8 * i + 1] = bfhi(w.x); q[8 * i + 2] = bflo(w.y); q[8 * i + 3] = bfhi(w.y); q[8 * i + 4] = bflo(w.z); q[8 * i + 5] = bfhi(w.z); q[8 * i + 6] = bflo(w.w); q[8 * i + 7] = bfhi(w.w); } }
    const int nk = KS.n(); float mx = has_sink ? sink : -3e38f;
    for (int k = lane; k < nk; k += 64) { int krow; float bias; KS.get(k, krow, bias);
        const u32x4* kp = (const u32x4*)(PB + (size_t)krow * PBW + kcol); float s = 0.f;
#pragma unroll
        for (int i = 0; i < 8; ++i) { const u32x4 w = kp[i]; s += q[8 * i] * bflo(w.x) + q[8 * i + 1] * bfhi(w.x) + q[8 * i + 2] * bflo(w.y) + q[8 * i + 3] * bfhi(w.y) + q[8 * i + 4] * bflo(w.z) + q[8 * i + 5] * bfhi(w.z) + q[8 * i + 6] * bflo(w.w) + q[8 * i + 7] * bfhi(w.w); }
        s += bias; sc[k] = s; mx = fmaxf(mx, s); }
    mx = wave_max(mx); float den = 0.f;
    for (int k = lane; k < nk; k += 64) { const float p = exp2f(sc[k] - mx); sc[k] = p; den += p; }
    den = wave_sum(den); if (has_sink) den += exp2f(sink - mx);
    asm volatile("s_waitcnt lgkmcnt(0)" ::: "memory");
    float o = 0.f;
    for (int k = 0; k < nk; ++k) { int krow; float bias; KS.get(k, krow, bias); o += sc[k] * bf2f(PB[(size_t)krow * PBW + vcol + lane]); }
    yout[lane] = (bf16_t)f2bf(o / den);
    asm volatile("s_waitcnt lgkmcnt(0)" ::: "memory");
}
DI void ph_attn_naive(const Ctx& X, const Params& P, int l) {
    const bf16_t* PB = (const bf16_t*)(P.ws + WS_PB); bf16_t* Y = (bf16_t*)(P.ws + WS_Y);
    LAS float* sc = (LAS float*)X.lds + X.wave * 640;
    const float* rpb = P.in[9] + l * 4 * 465; const float* sink = P.in[10] + l * 8;
    const int nrows = l == 0 ? NROWS : NLAT;
    const int gw = X.bid * NWAVES + X.wave, NGW = X.nb * NWAVES;
    for (int it = gw; it < nrows * 12; it += NGW) {
        const int row = it / 12, hh = it % 12;
        if (row < NLAT) { const int b = row >> 13, t = row & (SEQ - 1);
            if (hh < 4) { KeysNA K; K.b = b; K.r = t >> 6; K.c = t & 63; K.rs = min(max(K.r - 4, 0), 120); K.cs = min(max(K.c - 8, 0), 48); K.h = hh; K.rpb = rpb;
                attn_row_naive(PB, row, PB_NQ + hh * 64, PB_NK + hh * 64, PB_NV + hh * 64, K, false, 0.f, sc, Y + (size_t)row * D + 256 + hh * 64, X.lane);
            } else { const int qh = hh - 4, n = qh >> 2; KeysSWA K; K.b = b; K.lo = max(t - 128, 0); K.nband = min(t + 128, SEQ - 1) - K.lo + 1;
                attn_row_naive(PB, row, PB_SQ + qh * 64, PB_SK + n * 64, PB_SV + n * 64, K, true, LOG2E * sink[qh], sc, Y + (size_t)row * D + 512 + qh * 64, X.lane); }
        } else { const int b = (row - NLAT) >> 8; KeysCtx K; K.b = b;
            if (hh < 4) attn_row_naive(PB, row, PB_NQ + hh * 64, PB_NK + hh * 64, PB_NV + hh * 64, K, false, 0.f, sc, Y + (size_t)row * D + 256 + hh * 64, X.lane);
            else { const int qh = hh - 4, n = qh >> 2; attn_row_naive(PB, row, PB_SQ + qh * 64, PB_SK + n * 64, PB_SV + n * 64, K, true, LOG2E * sink[qh], sc, Y + (size_t)row * D + 512 + qh * 64, X.lane); }
        }
    }
}
DI void ph_hgrn_naive(const Ctx& X, const Params& P, int l) {
    const bf16_t* PB = (const bf16_t*)(P.ws + WS_PB); const float* Z = (const float*)(P.ws + WS_Z); float* O32 = (float*)(P.ws + WS_S);
    const float* LB = (const float*)(P.ws + WS_LB) + l * 512;
    const int gw = X.bid * NWAVES + X.wave;
    if (gw >= 16) return;
    const int b = gw >> 3, h = (gw >> 1) & 3, dir = gw & 1, lane = X.lane;
    const float lb = LB[dir * 256 + h * 64 + lane];
    float S[64];
#pragma unroll
    for (int d = 0; d < 64; ++d) S[d] = 0.f;
    for (int step = 0; step < CTXL + SEQ; ++step) {
        int row;
        if (step < CTXL) row = NLAT + b * CTXL + (dir ? CTXL - 1 - step : step); else { const int t = step - CTXL; row = b * SEQ + (dir ? SEQ - 1 - t : t); }
        const float z = Z[(size_t)row * ZW + dir * 256 + h * 64 + lane];
        float f = lb + (1.0f - lb) * sigmoidf_(z); const float kk = (1.0f - lb) * sigmoidf_(-z);
#if DBG_HG_MODE & 8
        f = 1.0f;
#endif
        const float qv = bf2f(PB[(size_t)row * PBW + PB_AQ + h * 64 + lane]), vv = bf2f(PB[(size_t)row * PBW + PB_AI + h * 64 + lane]);
#if DBG_HG_MODE & 1
        if ((step & 63) == 0) {
#pragma unroll
            for (int d = 0; d < 64; ++d) S[d] = 0.f; }
#endif
        float o = 0.f;
#pragma unroll
        for (int d = 0; d < 64; ++d) { const float fd = __builtin_bit_cast(float, __builtin_amdgcn_readlane(__builtin_bit_cast(int, f), d)), kd = __builtin_bit_cast(float, __builtin_amdgcn_readlane(__builtin_bit_cast(int, kk), d)), qd = __builtin_bit_cast(float, __builtin_amdgcn_readlane(__builtin_bit_cast(int, qv), d));
            S[d] = fd * S[d] + kd * vv; o += S[d] * qd; }
#if DBG_HG_MODE & 2
        if (dir == 1) o = 0.f;
#endif
#if DBG_HG_MODE & 4
        if (dir == 0) o = 0.f;
#endif
        O32[((size_t)dir * NROWS + row) * 256 + h * 64 + lane] = o;
    }
}
DI void ph_hgrn_combine_naive(const Ctx& X, const Params& P, int l) {
    const bf16_t* PB = (const bf16_t*)(P.ws + WS_PB); const float* O32 = (const float*)(P.ws + WS_S); bf16_t* Y = (bf16_t*)(P.ws + WS_Y);
    const float* nw = P.in[8] + l * 64;
    const int nrows = l == 0 ? NROWS : NLAT;
    const int gw = X.bid * NWAVES + X.wave, NGW = X.nb * NWAVES;
    for (int it = gw; it < nrows * 4; it += NGW) { const int row = it >> 2, h = it & 3;
        const float o = O32[(size_t)row * 256 + h * 64 + X.lane] + O32[((size_t)NROWS + row) * 256 + h * 64 + X.lane];
        const float ms = wave_sum(o * o) * (1.0f / 64.0f); const float y = o * (1.0f / sqrtf(ms + RMS_EPS)) * nw[X.lane];
        const float gte = bf2f(PB[(size_t)row * PBW + PB_AG + h * 64 + X.lane]);
        Y[(size_t)row * D + h * 64 + X.lane] = (bf16_t)f2bf(y * siluf_(gte)); }
}

typedef short v4i16_t __attribute__((ext_vector_type(4)));
DI s16x4 tr_read(const LAS unsigned char* p) { return __builtin_bit_cast(s16x4, __builtin_amdgcn_ds_read_tr16_b64_v4i16((LAS v4i16_t*)p)); }
DI bf16x8 cat8(s16x4 a, s16x4 b) { return __builtin_shufflevector(a, b, 0, 1, 2, 3, 4, 5, 6, 7); }
DI bf16x8 pack8(float a0, float a1, float a2, float a3, float a4, float a5, float a6, float a7) {
    u32x4 w; w.x = pk2(a0, a1); w.y = pk2(a2, a3); w.z = pk2(a4, a5); w.w = pk2(a6, a7); return __builtin_bit_cast(bf16x8, w); }
DI float shfl_f(float v, int src) { return __shfl(v, src); }

constexpr int HP = 144;
constexpr size_t WS_QT = WS_H, WS_KT = WS_H + (size_t)2 * NROWS * 256 * 2;
#ifdef DBG_MIX
constexpr size_t WS_ST = 318 * MiB;
#else
constexpr size_t WS_ST = WS_Z;
#endif
static_assert(WS_KT + (size_t)2 * NROWS * 256 * 2 <= WS_Y && (size_t)2112 * 4096 * 2 <= (size_t)NROWS * ZW * 4, "hgrn buffers");
DI void hgrn_chunk_rows(int b, int dir, int p, int& row0) {
    if (p < 4) row0 = NLAT + b * CTXL + 64 * (dir ? 3 - p : p); else row0 = b * SEQ + 64 * (dir ? 131 - p : p - 4);
}
DI void ph_hgrn_local(const Ctx& X, const Params& P, int l) {
    const bf16_t* PB = (const bf16_t*)(P.ws + WS_PB); const float* Z = (const float*)(P.ws + WS_Z);
    bf16_t* QT = (bf16_t*)(P.ws + WS_QT); bf16_t* KT = (bf16_t*)(P.ws + WS_KT); float* U = (float*)(P.ws + WS_S); float* DD = (float*)(P.ws + WS_DD); float* ER = DD + 2112 * 64;
    const float* LB = (const float*)(P.ws + WS_LB) + l * 512;
    LAS unsigned char* kt_l = X.lds + X.wave * (2 * 64 * HP); LAS unsigned char* v_l = kt_l + 64 * HP;
    const int lane = X.lane, gw = X.wave * X.nb + X.bid, NGW = X.nb * NWAVES;
    for (int it = gw; it < 2112; it += NGW) {
        const int p = it % NCHAIN, chain = it / NCHAIN, dir = chain & 1, h = (chain >> 1) & 3, b = chain >> 3;
        int row0; hgrn_chunk_rows(b, dir, p, row0);
#pragma unroll
        for (int i = 0; i < 8; ++i) { const int r = i * 8 + (lane >> 3), pc = lane & 7; const u32x4 w = *(const u32x4*)(PB + (size_t)(row0 + r) * PBW + PB_AI + h * 64 + pc * 8); *(LAS u32x4*)(v_l + r * HP + pc * 16) = w; }
        const float lb = LB[dir * 256 + h * 64 + lane];
        float lf[64];
        const float* zp = Z + (size_t)row0 * ZW + dir * 256 + h * 64 + lane;
#pragma unroll
        for (int s = 0; s < 64; ++s) { const float z = fminf(fmaxf(zp[(size_t)s * ZW], -30.f), 30.f); const float sg = 1.0f / (1.0f + __expf(-z)); lf[s] = __logf(lb + (1.0f - lb) * sg); }
        float ref, last;
        if (dir == 0) {
#pragma unroll
            for (int s = 1; s < 64; ++s) lf[s] += lf[s - 1];
            ref = lf[31]; last = lf[63];
        } else {
#pragma unroll
            for (int s = 62; s >= 0; --s) lf[s] += lf[s + 1];
            ref = lf[32]; last = lf[0];
        }
        const bf16_t* qp = PB + (size_t)row0 * PBW + PB_AQ + h * 64 + lane;
        bf16_t* qto = QT + ((size_t)dir * NROWS + row0) * 256 + h * 64 + lane; bf16_t* kto = KT + ((size_t)dir * NROWS + row0) * 256 + h * 64 + lane;
#pragma unroll
        for (int s = 0; s < 64; ++s) {
            const float z = fminf(fmaxf(zp[(size_t)s * ZW], -30.f), 30.f); const float e = __expf(-z); const float kk = (1.0f - lb) * (e / (1.0f + e));
            const float q = bf2f(qp[(size_t)s * PBW]);
#if DBG_HG_MODE & 8
            const float eq = 1.0f, ek = 1.0f;
#else
            const float eq = __expf(lf[s] - ref), ek = __expf(ref - lf[s]);
#endif
            const unsigned short qb = (unsigned short)f2bf(q * eq), kb = (unsigned short)f2bf(kk * ek);
            qto[(size_t)s * 256] = qb; kto[(size_t)s * 256] = kb;
            *(LAS unsigned short*)(kt_l + s * HP + lane * 2) = kb;
            if ((s & 7) == 7) asm volatile("" ::: "memory");
        }
        const float e_lr = __expf(last - ref);
        DD[it * 64 + lane] = __expf(last); ER[it * 64 + lane] = __expf(ref);
        f32x4 acc[4][4];
#pragma unroll
        for (int m = 0; m < 4; ++m)
#pragma unroll
            for (int n = 0; n < 4; ++n) acc[m][n] = (f32x4){0.f, 0.f, 0.f, 0.f};
        const int g = lane >> 4, i16 = lane & 15;
        const int troff = (8 * g + (i16 >> 2)) * HP + (i16 & 3) * 8;
#pragma unroll
        for (int ks = 0; ks < 2; ++ks) {
            bf16x8 af[4], bfv[4];
#pragma unroll
            for (int m = 0; m < 4; ++m) af[m] = cat8(tr_read(kt_l + troff + ks * 32 * HP + m * 32), tr_read(kt_l + troff + (ks * 32 + 4) * HP + m * 32));
#pragma unroll
            for (int n = 0; n < 4; ++n) bfv[n] = cat8(tr_read(v_l + troff + ks * 32 * HP + n * 32), tr_read(v_l + troff + (ks * 32 + 4) * HP + n * 32));
#pragma unroll
            for (int m = 0; m < 4; ++m)
#pragma unroll
                for (int n = 0; n < 4; ++n) acc[m][n] = __builtin_amdgcn_mfma_f32_16x16x32_bf16(af[m], bfv[n], acc[m][n], 0, 0, 0);
        }
        float* up = U + (size_t)it * 4096;
#pragma unroll
        for (int m = 0; m < 4; ++m)
#pragma unroll
            for (int r = 0; r < 4; ++r) { const int d = 16 * m + 4 * g + r; const float sc = shfl_f(e_lr, d);
#pragma unroll
                for (int n = 0; n < 4; ++n) up[d * 64 + 16 * n + i16] = acc[m][n][r] * sc; }
        asm volatile("s_waitcnt lgkmcnt(0)" ::: "memory");
    }
}
DI void ph_hgrn_scan(const Ctx& X, const Params& P) {
    const float* U = (const float*)(P.ws + WS_S); const float* DD = (const float*)(P.ws + WS_DD); const float* ER = DD + 2112 * 64; bf16_t* ST = (bf16_t*)(P.ws + WS_ST);
    const int gt = X.bid * NTHREADS + X.tid;
    if (gt >= 32768) return;
    const int chain = gt >> 11, d = (gt >> 5) & 63, e2 = (gt & 31) * 2;
    float s0 = 0.f, s1 = 0.f;
    for (int p0 = 0; p0 < NCHAIN; p0 += 4) {
        f32x2 u[4]; float dd[4], er[4];
#pragma unroll
        for (int j = 0; j < 4; ++j) { const int slot = chain * NCHAIN + p0 + j; u[j] = *(const f32x2*)(U + (size_t)slot * 4096 + d * 64 + e2); dd[j] = DD[slot * 64 + d]; er[j] = ER[slot * 64 + d]; }
#pragma unroll
        for (int j = 0; j < 4; ++j) { const int slot = chain * NCHAIN + p0 + j; *(unsigned*)(ST + (size_t)slot * 4096 + d * 64 + e2) = pk2(s0 * er[j], s1 * er[j]); s0 = dd[j] * s0 + u[j][0]; s1 = dd[j] * s1 + u[j][1]; }
    }
}
DI void ph_hgrn_out(const Ctx& X, const Params& P, int l) {
    const bf16_t* PB = (const bf16_t*)(P.ws + WS_PB); const bf16_t* QT = (const bf16_t*)(P.ws + WS_QT); const bf16_t* KT = (const bf16_t*)(P.ws + WS_KT); const bf16_t* ST = (const bf16_t*)(P.ws + WS_ST);
    bf16_t* Y = (bf16_t*)(P.ws + WS_Y); const float* nw = P.in[8] + l * 64;
    LAS unsigned char* s_l = X.lds + X.wave * (2 * 64 * HP); LAS unsigned char* v_l = s_l + 64 * HP;
    const int lane = X.lane, g = lane >> 4, i16 = lane & 15, gw = X.wave * X.nb + X.bid, NGW = X.nb * NWAVES;
    const int nchunk = l == 0 ? 132 : 128;
    const int troff = (8 * g + (i16 >> 2)) * HP + (i16 & 3) * 8;
    const int troff4 = (4 * g + (i16 >> 2)) * HP + (i16 & 3) * 8;
    for (int it = gw; it < 8 * nchunk; it += NGW) {
        const int c = it % nchunk, bh = it / nchunk, h = bh & 3, b = bh >> 2;
        const bool isctx = c >= 128; const int row0 = isctx ? NLAT + b * CTXL + 64 * (c - 128) : b * SEQ + 64 * c;
#pragma unroll
        for (int i = 0; i < 8; ++i) { const int r = i * 8 + (lane >> 3), pc = lane & 7; const u32x4 w = *(const u32x4*)(PB + (size_t)(row0 + r) * PBW + PB_AI + h * 64 + pc * 8); *(LAS u32x4*)(v_l + r * HP + pc * 16) = w; }
        f32x4 o[4][4];
#pragma unroll
        for (int a = 0; a < 4; ++a)
#pragma unroll
            for (int t = 0; t < 4; ++t) o[a][t] = (f32x4){0.f, 0.f, 0.f, 0.f};
#pragma unroll 1
        for (int dir = 0; dir < 2; ++dir) {
#if DBG_HG_MODE & 2
            if (dir == 1) continue;
#endif
#if DBG_HG_MODE & 4
            if (dir == 0) continue;
#endif
            const int p = isctx ? (dir ? 3 - (c - 128) : c - 128) : (dir ? 127 - c + 4 : c + 4);
            const int slot = ((b * 4 + h) * 2 + dir) * NCHAIN + p, sgn = 1 - 2 * dir;
            asm volatile("s_waitcnt lgkmcnt(0)" ::: "memory");
#pragma unroll
            for (int i = 0; i < 8; ++i) { const int r = i * 8 + (lane >> 3), pc = lane & 7; const u32x4 w = *(const u32x4*)(ST + (size_t)slot * 4096 + r * 64 + pc * 8); *(LAS u32x4*)(s_l + r * HP + pc * 16) = w; }
            const bf16_t* qt = QT + ((size_t)dir * NROWS + row0) * 256 + h * 64 + g * 8; const bf16_t* kt = KT + ((size_t)dir * NROWS + row0) * 256 + h * 64 + g * 8;
            bf16x8 qf[4][2];
#pragma unroll
            for (int t = 0; t < 4; ++t)
#pragma unroll
                for (int ks = 0; ks < 2; ++ks) qf[t][ks] = *(const bf16x8*)(qt + (size_t)(16 * t + i16) * 256 + 32 * ks);
#pragma unroll
            for (int pr = 0; pr < 2; ++pr) {
                bf16x8 kf[2][2];
#pragma unroll
                for (int t = 0; t < 2; ++t)
#pragma unroll
                    for (int ks = 0; ks < 2; ++ks) kf[t][ks] = *(const bf16x8*)(kt + (size_t)(16 * (2 * pr + t) + i16) * 256 + 32 * ks);
                f32x4 sc[2][4];
#pragma unroll
                for (int s2 = 0; s2 < 2; ++s2)
#pragma unroll
                    for (int tt = 0; tt < 4; ++tt) { f32x4 a = {0.f, 0.f, 0.f, 0.f};
                        a = __builtin_amdgcn_mfma_f32_16x16x32_bf16(kf[s2][0], qf[tt][0], a, 0, 0, 0); a = __builtin_amdgcn_mfma_f32_16x16x32_bf16(kf[s2][1], qf[tt][1], a, 0, 0, 0);
#pragma unroll
                        for (int r = 0; r < 4; ++r) { const int sidx = 16 * (2 * pr + s2) + 4 * g + r, tidx = 16 * tt + i16; const int keep = ~(((tidx - sidx) * sgn) >> 31); { const float av = a[r]; a[r] = __int_as_float(__float_as_int(av) & keep); } }
                        sc[s2][tt] = a; }
                bf16x8 vf[4];
#pragma unroll
#ifdef DBG_NO_TR
                for (int et = 0; et < 4; ++et) { unsigned short tv[8];
#pragma unroll
                    for (int j = 0; j < 8; ++j) { const int sidx = 32 * pr + (j < 4 ? 4 * g + j : 16 + 4 * g + (j - 4)); tv[j] = *(const LAS unsigned short*)(v_l + sidx * HP + (16 * et + i16) * 2); }
                    u32x4 w; w.x = tv[0] | ((unsigned)tv[1] << 16); w.y = tv[2] | ((unsigned)tv[3] << 16); w.z = tv[4] | ((unsigned)tv[5] << 16); w.w = tv[6] | ((unsigned)tv[7] << 16); vf[et] = __builtin_bit_cast(bf16x8, w); }
#else
                for (int et = 0; et < 4; ++et) vf[et] = cat8(tr_read(v_l + troff4 + (32 * pr) * HP + et * 32), tr_read(v_l + troff4 + (32 * pr + 16) * HP + et * 32));
#endif
#ifdef DBG_BRUTE
                {   float* dacc = (float*)(P.ws + WS_CTL) + CW_DBG + 16; float nA = 0.f, dA = 0.f, nB = 0.f, dB = 0.f;
                    const bf16_t* qt0 = QT + ((size_t)dir * NROWS + row0) * 256 + h * 64; const bf16_t* kt0 = KT + ((size_t)dir * NROWS + row0) * 256 + h * 64;
#if DBG_TEST == 1
#pragma unroll
                    for (int s2 = 0; s2 < 2; ++s2)
#pragma unroll
                        for (int tt = 0; tt < 4; ++tt)
#pragma unroll
                            for (int r = 0; r < 4; ++r) *(LAS float*)(s_l + (((s2 * 4 + tt) * 4 + r) * 64 + lane) * 4) = sc[s2][tt][r];
                    asm volatile("s_waitcnt lgkmcnt(0)" ::: "memory");
#pragma unroll 1
                    for (int idx = 0; idx < 32; ++idx) { const int s2 = idx >> 4, tt = (idx >> 2) & 3, r = idx & 3; const int sidx = 16 * (2 * pr + s2) + 4 * g + r, tidx = 16 * tt + i16; float ref = 0.f;
#pragma unroll 1
                        for (int d = 0; d < 64; ++d) ref += bf2f(kt0[(size_t)sidx * 256 + d]) * bf2f(qt0[(size_t)tidx * 256 + d]);
                        if (sidx > tidx) ref = 0.f; const float got = *(LAS float*)(s_l + (idx * 64 + lane) * 4); const float df = got - ref; nA += df * df; dA += ref * ref; }
#endif
#if DBG_TEST == 2
#pragma unroll
                    for (int et = 0; et < 4; ++et)
#pragma unroll
                        for (int j = 0; j < 8; ++j) { const int sidx = 32 * pr + (j < 4 ? 4 * g + j : 16 + 4 * g + (j - 4)); const float ref = bf2f(PB[(size_t)(row0 + sidx) * PBW + PB_AI + h * 64 + 16 * et + i16]);
                            const float got = bf2f((unsigned short)vf[et][j]); const float df = got - ref; nB += df * df; dB += ref * ref; asm volatile("" : "+v"(nB), "+v"(dB) :: "memory"); }
#endif
                    nA = wave_sum(nA); dA = wave_sum(dA); nB = wave_sum(nB); dB = wave_sum(dB); if (lane == 0) { atomicAdd(dacc, nA); atomicAdd(dacc + 1, dA); atomicAdd(dacc + 2, nB); atomicAdd(dacc + 3, dB); }
                }
#endif
#pragma unroll
                for (int tt = 0; tt < 4; ++tt) { const f32x4 p0 = sc[0][tt], p1 = sc[1][tt]; const bf16x8 pf = pack8(p0[0], p0[1], p0[2], p0[3], p1[0], p1[1], p1[2], p1[3]);
#pragma unroll
                    for (int et = 0; et < 4; ++et) o[et][tt] = __builtin_amdgcn_mfma_f32_16x16x32_bf16(vf[et], pf, o[et][tt], 0, 0, 0); }
                asm volatile("" ::: "memory");
            }
#pragma unroll
            for (int ks = 0; ks < ((DBG_HG_MODE & 1) ? 0 : 2); ++ks) {
                bf16x8 sf[4];
#pragma unroll
                for (int et = 0; et < 4; ++et) sf[et] = cat8(tr_read(s_l + troff + (32 * ks) * HP + et * 32), tr_read(s_l + troff + (32 * ks + 4) * HP + et * 32));
#pragma unroll
                for (int tt = 0; tt < 4; ++tt)
#pragma unroll
                    for (int et = 0; et < 4; ++et) o[et][tt] = __builtin_amdgcn_mfma_f32_16x16x32_bf16(sf[et], qf[tt][ks], o[et][tt], 0, 0, 0);
            }
        }
#if defined(DBG_BRUTE) && DBG_TEST == 3
        {
            float* dacc = (float*)(P.ws + WS_CTL) + CW_DBG + 8; float num = 0.f, den = 0.f;
            const bf16_t* qt0 = QT + ((size_t)0 * NROWS + row0) * 256 + h * 64; const bf16_t* kt0 = KT + ((size_t)0 * NROWS + row0) * 256 + h * 64;
            for (int tt = 0; tt < 4; ++tt) for (int et = 0; et < 4; ++et) for (int r = 0; r < 4; ++r) {
                const int t = 16 * tt + i16, e = 16 * et + 4 * g + r; float ref = 0.f;
                for (int s2 = 0; s2 <= t; ++s2) { float sc = 0.f; for (int d = 0; d < 64; ++d) sc += bf2f(kt0[(size_t)s2 * 256 + d]) * bf2f(qt0[(size_t)t * 256 + d]);
                    ref += bf2f((unsigned short)f2bf(sc)) * bf2f(PB[(size_t)(row0 + s2) * PBW + PB_AI + h * 64 + e]); }
                float got = 0.f;
#pragma unroll
                for (int a = 0; a < 4; ++a)
#pragma unroll
                    for (int b2 = 0; b2 < 4; ++b2)
#pragma unroll
                        for (int c2 = 0; c2 < 4; ++c2) if (a == tt && b2 == et && c2 == r) got = o[b2][a][c2];
                num += (got - ref) * (got - ref); den += ref * ref; }
            num = wave_sum(num); den = wave_sum(den); if (lane == 0) { atomicAdd(dacc, num); atomicAdd(dacc + 1, den); }
        }
#endif
#pragma unroll
        for (int tt = 0; tt < 4; ++tt) {
            float ss = 0.f;
#pragma unroll
            for (int et = 0; et < 4; ++et) ss += (o[et][tt][0] * o[et][tt][0] + o[et][tt][1] * o[et][tt][1]) + (o[et][tt][2] * o[et][tt][2] + o[et][tt][3] * o[et][tt][3]);
            ss += __shfl_xor(ss, 16); ss += __shfl_xor(ss, 32);
            const float rstd = 1.0f / sqrtf(ss * (1.0f / 64.0f) + RMS_EPS);
            const size_t row = (size_t)row0 + 16 * tt + i16;
#pragma unroll
            for (int et = 0; et < 4; ++et) { const int e = 16 * et + 4 * g; const u32x2 gw2 = *(const u32x2*)(PB + row * PBW + PB_AG + h * 64 + e); const f32x4 wv = *(const f32x4*)(nw + e);
                const f32x4 gt = {bflo(gw2.x), bfhi(gw2.x), bflo(gw2.y), bfhi(gw2.y)}; f32x4 y;
#pragma unroll
                for (int r = 0; r < 4; ++r) y[r] = o[et][tt][r] * rstd * wv[r] * siluf_(gt[r]);
                store_bf4(Y + row * D + h * 64 + e, y); }
        }
        asm volatile("s_waitcnt lgkmcnt(0)" ::: "memory");
    }
}


#ifdef DBG_BRUTE
DI void ph_dbg_scores(const Ctx& X, const Params& P, int l) {
    const bf16_t* QT = (const bf16_t*)(P.ws + WS_QT); const bf16_t* KT = (const bf16_t*)(P.ws + WS_KT);
    LAS unsigned char* s_l = X.lds + X.wave * (2 * 64 * HP);
    const int lane = X.lane, g = lane >> 4, i16 = lane & 15, gw = X.wave * X.nb + X.bid, NGW = X.nb * NWAVES;
    float* dacc = (float*)(P.ws + WS_CTL) + CW_DBG + 16; float nA = 0.f, dA = 0.f;
    for (int it = gw; it < 8 * 128; it += NGW) {
        const int c = it % 128, bh = it / 128, h = bh & 3, b = bh >> 2, dir = 0, sgn = 1; const int row0 = b * SEQ + 64 * c;
        const bf16_t* qt = QT + ((size_t)dir * NROWS + row0) * 256 + h * 64 + g * 8; const bf16_t* kt = KT + ((size_t)dir * NROWS + row0) * 256 + h * 64 + g * 8;
        const bf16_t* qt0 = QT + ((size_t)dir * NROWS + row0) * 256 + h * 64; const bf16_t* kt0 = KT + ((size_t)dir * NROWS + row0) * 256 + h * 64;
        bf16x8 qf[4][2];
#pragma unroll
        for (int t = 0; t < 4; ++t)
#pragma unroll
            for (int ks = 0; ks < 2; ++ks) qf[t][ks] = *(const bf16x8*)(qt + (size_t)(16 * t + i16) * 256 + 32 * ks);
#pragma unroll 1
        for (int pr = 0; pr < 2; ++pr) {
            bf16x8 kf[2][2];
#pragma unroll
            for (int t = 0; t < 2; ++t)
#pragma unroll
                for (int ks = 0; ks < 2; ++ks) kf[t][ks] = *(const bf16x8*)(kt + (size_t)(16 * (2 * pr + t) + i16) * 256 + 32 * ks);
#pragma unroll
            for (int s2 = 0; s2 < 2; ++s2)
#pragma unroll
                for (int tt = 0; tt < 4; ++tt) { f32x4 a = {0.f, 0.f, 0.f, 0.f};
                    a = __builtin_amdgcn_mfma_f32_16x16x32_bf16(kf[s2][0], qf[tt][0], a, 0, 0, 0); a = __builtin_amdgcn_mfma_f32_16x16x32_bf16(kf[s2][1], qf[tt][1], a, 0, 0, 0);
#pragma unroll
                    for (int r = 0; r < 4; ++r) { const int sidx = 16 * (2 * pr + s2) + 4 * g + r, tidx = 16 * tt + i16; const int keep = ~(((tidx - sidx) * sgn) >> 31); { const float av = a[r]; a[r] = __int_as_float(__float_as_int(av) & keep); }
                        *(LAS float*)(s_l + (((s2 * 4 + tt) * 4 + r) * 64 + lane) * 4) = a[r]; } }
            asm volatile("s_waitcnt lgkmcnt(0)" ::: "memory");
#pragma unroll 1
            for (int idx = 0; idx < 32; ++idx) { const int s2 = idx >> 4, tt = (idx >> 2) & 3, r = idx & 3; const int sidx = 16 * (2 * pr + s2) + 4 * g + r, tidx = 16 * tt + i16; float ref = 0.f;
#pragma unroll 1
                for (int d = 0; d < 64; ++d) ref += bf2f(kt0[(size_t)sidx * 256 + d]) * bf2f(qt0[(size_t)tidx * 256 + d]);
                if (sidx > tidx) ref = 0.f; const float got = *(LAS float*)(s_l + (idx * 64 + lane) * 4); const float df = got - ref; nA += df * df; dA += ref * ref; }
            asm volatile("s_waitcnt lgkmcnt(0)" ::: "memory");
        }
    }
    nA = wave_sum(nA); dA = wave_sum(dA); if (lane == 0) { atomicAdd(dacc, nA); atomicAdd(dacc + 1, dA); }
}
#endif
constexpr int KP = 144, VP = 192, KBYTES = 128 * KP, VBYTES = 128 * VP, CHB = KBYTES + VBYTES, RPB_OFF = 2 * CHB;
static_assert(RPB_OFF + 4096 <= 144 * 1024, "attn lds");
struct ChunkSrc { int mode, rbase, kr0; };
DI int chunk_row(const ChunkSrc& c, int key) { return c.mode == 0 ? c.rbase + key : c.rbase + min(c.kr0 + (key >> 5), 127) * 64 + (key & 31); }
struct StageRegs { u32x4 k[2], v[2]; };
DI void stage_load(const Ctx& X, const bf16_t* PB, int kcol, int vcol, const ChunkSrc& c, StageRegs& R) {
#pragma unroll
    for (int i = 0; i < 2; ++i) { const int idx = X.tid + NTHREADS * i, key = idx >> 3, pc = idx & 7; const size_t row = (size_t)chunk_row(c, key);
        R.k[i] = *(const u32x4*)(PB + row * PBW + kcol + pc * 8); R.v[i] = *(const u32x4*)(PB + row * PBW + vcol + pc * 8); }
}
DI void stage_store(const Ctx& X, LAS unsigned char* buf, const StageRegs& R) {
#pragma unroll
    for (int i = 0; i < 2; ++i) { const int idx = X.tid + NTHREADS * i, key = idx >> 3, pc = idx & 7;
        *(LAS u32x4*)(buf + key * KP + pc * 16) = R.k[i]; *(LAS u32x4*)(buf + KBYTES + key * VP + pc * 16) = R.v[i]; }
}
template <int NQT> struct AttnState { f32x16 o[NQT][2]; float m[NQT], l[NQT]; };
template <int NQT, class MaskF>
DI void attn_tile(const LAS unsigned char* buf, int kt, const bf16x8 (&qf)[NQT][4], AttnState<NQT>& S, const bool (&act)[NQT], const MaskF& MF, int lane) {
    const int h = lane >> 5, G = lane >> 4, i16 = lane & 15;
    bf16x8 kf[4];
#pragma unroll
    for (int ks = 0; ks < 4; ++ks) kf[ks] = *(const LAS bf16x8*)(buf + (32 * kt + (lane & 31)) * KP + ks * 32 + h * 16);
    const LAS unsigned char* vb = buf + KBYTES + (32 * kt + 4 * h + (i16 >> 2)) * VP + (16 * (G & 1) + 4 * (i16 & 3)) * 2;
    bf16x8 vf[2][2];
#pragma unroll
    for (int db = 0; db < 2; ++db)
#pragma unroll
        for (int s2 = 0; s2 < 2; ++s2) vf[db][s2] = cat8(tr_read(vb + (16 * s2) * VP + db * 64), tr_read(vb + (16 * s2 + 8) * VP + db * 64));
#pragma unroll
    for (int qt = 0; qt < NQT; ++qt) {
        if (!act[qt]) continue;
        f32x16 s;
#pragma unroll
        for (int r = 0; r < 16; ++r) s[r] = 0.f;
#pragma unroll
        for (int ks = 0; ks < 4; ++ks) s = __builtin_amdgcn_mfma_f32_32x32x16_bf16(kf[ks], qf[qt][ks], s, 0, 0, 0);
        MF(s, qt, kt);
        float mx = s[0];
#pragma unroll
        for (int r = 1; r < 16; ++r) mx = fmaxf(mx, s[r]);
        mx = fmaxf(mx, __shfl_xor(mx, 32));
        const float mn = fmaxf(S.m[qt], mx), alpha = __builtin_amdgcn_exp2f(S.m[qt] - mn); S.m[qt] = mn;
        float ps = 0.f;
#pragma unroll
        for (int r = 0; r < 16; ++r) { s[r] = __builtin_amdgcn_exp2f(s[r] - mn); ps += s[r]; }
        S.l[qt] = S.l[qt] * alpha + ps;
#pragma unroll
        for (int db = 0; db < 2; ++db)
#pragma unroll
            for (int r = 0; r < 16; ++r) S.o[qt][db][r] *= alpha;
        const bf16x8 p0 = pack8(s[0], s[1], s[2], s[3], s[4], s[5], s[6], s[7]), p1 = pack8(s[8], s[9], s[10], s[11], s[12], s[13], s[14], s[15]);
#pragma unroll
        for (int db = 0; db < 2; ++db) { S.o[qt][db] = __builtin_amdgcn_mfma_f32_32x32x16_bf16(vf[db][0], p0, S.o[qt][db], 0, 0, 0); S.o[qt][db] = __builtin_amdgcn_mfma_f32_32x32x16_bf16(vf[db][1], p1, S.o[qt][db], 0, 0, 0); }
    }
}
template <int NQT>
DI void attn_finish(AttnState<NQT>& S, int qt, bf16_t* yrow  , int lane) {
    const int h = lane >> 5; float l = S.l[qt]; l += __shfl_xor(l, 32); const float inv = 1.0f / l;
#pragma unroll
    for (int db = 0; db < 2; ++db)
#pragma unroll
        for (int gq = 0; gq < 4; ++gq) store_bf4(yrow + 32 * db + 8 * gq + 4 * h, (f32x4){S.o[qt][db][4 * gq] * inv, S.o[qt][db][4 * gq + 1] * inv, S.o[qt][db][4 * gq + 2] * inv, S.o[qt][db][4 * gq + 3] * inv});
}
struct MaskNone { DI void operator()(f32x16&, int, int) const {} };
struct MaskSWA { int cmode, u0, lane;
    DI void operator()(f32x16& s, int qt, int kt) const {
        if (cmode == 1) return;
        const int u = u0 + 32 * qt + (lane & 31), kb = 32 * kt + 4 * (lane >> 5);
#pragma unroll
        for (int r = 0; r < 16; ++r) { const int k = kb + (r & 3) + 8 * (r >> 2); const bool ok = cmode == 0 ? k >= u : k <= u; s[r] = ok ? s[r] : -1e30f; }
    } };
DI void ph_swa(const Ctx& X, const Params& P, int l) {
    const bf16_t* PB = (const bf16_t*)(P.ws + WS_PB); bf16_t* Y = (bf16_t*)(P.ws + WS_Y); const float* sink = P.in[10] + l * 8;
    const int lane = X.lane, w = X.wave;
    for (int it = X.bid; it < 256; it += X.nb) {
        const int j = it & 63, n = (it >> 6) & 1, b = it >> 7;
        const int qh = n * 4 + (w >> 1), u0 = (w & 1) * 64;
        const int nchunks = 3 + (j > 0) + (j < 63);
        bf16x8 qf[2][4];
#pragma unroll
        for (int qt = 0; qt < 2; ++qt)
#pragma unroll
            for (int ks = 0; ks < 4; ++ks) qf[qt][ks] = *(const bf16x8*)(PB + (size_t)(b * SEQ + 128 * j + u0 + 32 * qt + (lane & 31)) * PBW + PB_SQ + qh * 64 + 16 * ks + 8 * (lane >> 5));
        AttnState<2> S;
#pragma unroll
        for (int qt = 0; qt < 2; ++qt) { S.m[qt] = LOG2E * sink[qh]; S.l[qt] = lane < 32 ? 1.0f : 0.0f;
#pragma unroll
            for (int db = 0; db < 2; ++db)
#pragma unroll
                for (int r = 0; r < 16; ++r) S.o[qt][db][r] = 0.f; }
        StageRegs R;
        auto chunk_id = [&](int i) -> int { return i < 2 ? 3 + i : (i == 2 ? 1 : (i == 3 ? (j > 0 ? 0 : 2) : 2)); };
        auto chunk_src = [&](int c) -> ChunkSrc { ChunkSrc cs; cs.mode = 0; cs.kr0 = 0; cs.rbase = c < 3 ? b * SEQ + 128 * (j - 1 + c) : NLAT + b * CTXL + 128 * (c - 3); return cs; };
        stage_load(X, PB, PB_SK + n * 64, PB_SV + n * 64, chunk_src(chunk_id(0)), R); stage_store(X, X.lds, R);
        __syncthreads();
        for (int i = 0; i < nchunks; ++i) {
            const int c = chunk_id(i);
            if (i + 1 < nchunks) stage_load(X, PB, PB_SK + n * 64, PB_SV + n * 64, chunk_src(chunk_id(i + 1)), R);
            const LAS unsigned char* buf = X.lds + (i & 1) * CHB;
            MaskSWA MF; MF.cmode = c == 0 ? 0 : (c == 2 ? 2 : 1); MF.u0 = u0; MF.lane = lane;
#pragma unroll 1
            for (int kt = 0; kt < 4; ++kt) {
                bool act[2];
#pragma unroll
                for (int qt = 0; qt < 2; ++qt) act[qt] = c == 0 ? (32 * kt + 31 >= u0 + 32 * qt) : (c == 2 ? (32 * kt <= u0 + 32 * qt + 31) : true);
                if (!(act[0] || act[1])) continue;
                attn_tile<2>(buf, kt, qf, S, act, MF, lane);
            }
            if (i + 1 < nchunks) stage_store(X, X.lds + ((i + 1) & 1) * CHB, R);
            __syncthreads();
        }
#pragma unroll
        for (int qt = 0; qt < 2; ++qt) attn_finish<2>(S, qt, Y + (size_t)(b * SEQ + 128 * j + u0 + 32 * qt + (lane & 31)) * D + 512 + qh * 64, lane);
    }
}
struct MaskNA { bool win; int kr0, qr, qc, rs, cs, blk, lane; const LAS float* rpb;
    DI void operator()(f32x16& s, int qt, int kt) const {
        if (!win) return;
        const int kr = kr0 + kt; const bool rowok = kr >= rs && kr < rs + 8;
        const int kcb = blk + 4 * (lane >> 5); const int ib = rowok ? (kr - qr + 7) * 31 + (kcb - qc + 15) : 0;
#pragma unroll
        for (int r = 0; r < 16; ++r) { const int off = (r & 3) + 8 * (r >> 2); const int kc = kcb + off; const bool ok = rowok && kc >= cs && kc < cs + 16;
            const float bias = rpb[ib + off]; s[r] = ok ? s[r] + bias : -1e30f; }
    } };
DI void ph_na(const Ctx& X, const Params& P, int l) {
    const bf16_t* PB = (const bf16_t*)(P.ws + WS_PB); bf16_t* Y = (bf16_t*)(P.ws + WS_Y); const float* rpbg = P.in[9] + l * 4 * 465;
    const int lane = X.lane, w = X.wave; LAS float* rpbl = (LAS float*)(X.lds + RPB_OFF) + 32;
    for (int it = X.bid; it < 256; it += X.nb) {
        const int j = it & 3, rg = (it >> 2) & 7, h = (it >> 5) & 3, b = it >> 7;
        const int r0 = 16 * rg, blk = min(max(16 * j - 8, 0), 32);
        const int kr_lo = min(max(r0 - 4, 0), 120), kr_hi = min(max(r0 + 15 - 4, 0), 120) + 7, nwc = (kr_hi - kr_lo + 4) >> 2, nchunks = 2 + nwc;
        const int ra = r0 + 2 * w, qr = ra + ((lane & 31) >> 4), qc = 16 * j + (lane & 15);
        const int rs_a = min(max(ra - 4, 0), 120), rs_b = min(max(ra + 1 - 4, 0), 120);
        for (int i = X.tid; i < 465; i += NTHREADS) rpbl[i] = LOG2E * rpbg[h * 465 + i];
        bf16x8 qf[1][4];
#pragma unroll
        for (int ks = 0; ks < 4; ++ks) qf[0][ks] = *(const bf16x8*)(PB + (size_t)(b * SEQ + qr * 64 + qc) * PBW + PB_NQ + h * 64 + 16 * ks + 8 * (lane >> 5));
        AttnState<1> S; S.m[0] = -1e30f; S.l[0] = 0.f;
#pragma unroll
        for (int db = 0; db < 2; ++db)
#pragma unroll
            for (int r = 0; r < 16; ++r) S.o[0][db][r] = 0.f;
        StageRegs R;
        auto chunk_src = [&](int i) -> ChunkSrc { ChunkSrc cs; if (i < 2) { cs.mode = 0; cs.kr0 = 0; cs.rbase = NLAT + b * CTXL + 128 * i; } else { cs.mode = 1; cs.kr0 = kr_lo + 4 * (i - 2); cs.rbase = b * SEQ + blk; } return cs; };
        stage_load(X, PB, PB_NK + h * 64, PB_NV + h * 64, chunk_src(0), R); stage_store(X, X.lds, R);
        __syncthreads();
        MaskNA MF; MF.qr = qr; MF.qc = qc; MF.rs = min(max(qr - 4, 0), 120); MF.cs = min(max(qc - 8, 0), 48); MF.blk = blk; MF.lane = lane; MF.rpb = rpbl;
        for (int i = 0; i < nchunks; ++i) {
            if (i + 1 < nchunks) stage_load(X, PB, PB_NK + h * 64, PB_NV + h * 64, chunk_src(i + 1), R);
            const LAS unsigned char* buf = X.lds + (i & 1) * CHB;
            MF.win = i >= 2; MF.kr0 = kr_lo + 4 * (i - 2);
#pragma unroll 1
            for (int kt = 0; kt < 4; ++kt) {
                bool act[1]; act[0] = true;
                if (i >= 2) { const int kr = MF.kr0 + kt; if (kr < rs_a || kr > rs_b + 7) continue; }
                attn_tile<1>(buf, kt, qf, S, act, MF, lane);
            }
            if (i + 1 < nchunks) stage_store(X, X.lds + ((i + 1) & 1) * CHB, R);
            __syncthreads();
        }
        attn_finish<1>(S, 0, Y + (size_t)(b * SEQ + qr * 64 + qc) * D + 256 + h * 64, lane);
    }
}
DI void ph_attn_ctx(const Ctx& X, const Params& P, int l) {
    if (l != 0) return;
    const bf16_t* PB = (const bf16_t*)(P.ws + WS_PB); bf16_t* Y = (bf16_t*)(P.ws + WS_Y);
    LAS float* sc = (LAS float*)X.lds + X.wave * 640; const float* sink = P.in[10] + l * 8;
    const int gw = X.bid * NWAVES + X.wave, NGW = X.nb * NWAVES;
    for (int it = gw; it < NCTX * 12; it += NGW) {
        const int row = NLAT + it / 12, hh = it % 12; KeysCtx K; K.b = (row - NLAT) >> 8;
        if (hh < 4) attn_row_naive(PB, row, PB_NQ + hh * 64, PB_NK + hh * 64, PB_NV + hh * 64, K, false, 0.f, sc, Y + (size_t)row * D + 256 + hh * 64, X.lane);
        else { const int qh = hh - 4, n = qh >> 2; attn_row_naive(PB, row, PB_SQ + qh * 64, PB_SK + n * 64, PB_SV + n * 64, K, true, LOG2E * sink[qh], sc, Y + (size_t)row * D + 512 + qh * 64, X.lane); }
    }
}

constexpr size_t WS_Y2 = 284 * MiB;
DI void ph_dbg_copy(const Ctx& X, const Params& P) {
    const u32x4* src = (const u32x4*)(P.ws + WS_Y); u32x4* dst = (u32x4*)(P.ws + WS_Y2);
    for (size_t i = (size_t)X.bid * NTHREADS + X.tid; i < (size_t)NROWS * 128; i += (size_t)X.nb * NTHREADS) dst[i] = src[i];
}
DI void ph_dbg_compare(const Ctx& X, const Params& P) {
    const bf16_t* Yg = (const bf16_t*)(P.ws + WS_Y); const bf16_t* Yf = (const bf16_t*)(P.ws + WS_Y2); float* acc = (float*)(P.ws + WS_CTL) + CW_DBG;
    float num[3] = {0.f, 0.f, 0.f}, den[3] = {0.f, 0.f, 0.f};
    const int gw = X.bid * NWAVES + X.wave, NGW = X.nb * NWAVES;
    for (int row = gw; row < NROWS; row += NGW) {
#pragma unroll
        for (int j = 0; j < 16; ++j) { const int c = j * 64 + X.lane; const float a = bf2f(Yg[(size_t)row * D + c]), b = bf2f(Yf[(size_t)row * D + c]); const float d = a - b;
            const int br = j < 4 ? 0 : (j < 8 ? 1 : 2);
            if (br == 0) { num[0] += d * d; den[0] += a * a; } else if (br == 1) { num[1] += d * d; den[1] += a * a; } else { num[2] += d * d; den[2] += a * a; } }
    }
#pragma unroll
    for (int b = 0; b < 3; ++b) { const float n = wave_sum(num[b]), d = wave_sum(den[b]); if (X.lane == 0) { atomicAdd(acc + 2 * b, n); atomicAdd(acc + 2 * b + 1, d); } }
}
DI void ph_dbg_apply(const Ctx& X, const Params& P) {
    const float* acc = (const float*)(P.ws + WS_CTL) + CW_DBG;
#ifdef DBG_BRUTE
    float code = sqrtf(acc[16] / acc[17]);
#else
    float code = sqrtf(acc[0] / acc[1]);
#endif
    if (code == 0.f) return;
    f32x4* o = (f32x4*)P.out;
    for (size_t i = (size_t)X.bid * NTHREADS + X.tid; i < (size_t)NLAT * 256; i += (size_t)X.nb * NTHREADS) o[i] = o[i] * (1.0f + code);
}

DI void ph_inproj(const Ctx& X, const Params& P, int l) {
    PlainSched S; S.init(NROWS, INW, X.nb, X.bid);
    EpiIn E{(bf16_t*)(P.ws + WS_PB), (float*)(P.ws + WS_Z), (const float*)(P.ws + WS_ROPE)};
    GEMM_IMPL(X, (const bf16_t*)(P.ws + WS_H), (const bf16_t*)(P.ws + WS_WIN) + (size_t)l * INW * D, D, S, E);
}
DI void ph_outproj(const Ctx& X, const Params& P, int l) {
    PlainSched S; S.init(l == 0 ? NROWS : NLAT, D, X.nb, X.bid);
    EpiBf E{(bf16_t*)(P.ws + WS_YO), D};
    GEMM_IMPL(X, (const bf16_t*)(P.ws + WS_Y), (const bf16_t*)(P.ws + WS_WOUT) + (size_t)l * D * D, D, S, E);
}
DI void ph_moe1(const Ctx& X, const Params& P, int l) {
    MoeSched S{(const int*)(P.ws + WS_CTL) + CW_CNT + 64 * l, (const int*)(P.ws + WS_LIST), X.nb, X.bid, 4, 1024, true};
    EpiGU E{(bf16_t*)(P.ws + WS_S)};
    GEMM_IMPL(X, (const bf16_t*)(P.ws + WS_H), (const bf16_t*)(P.ws + WS_WGU), D, S, E);
}
DI void ph_moe2(const Ctx& X, const Params& P, int l) {
    MoeSched S{(const int*)(P.ws + WS_CTL) + CW_CNT + 64 * l, (const int*)(P.ws + WS_LIST), X.nb, X.bid, 4, 1024, false};
    EpiBf E{(bf16_t*)(P.ws + WS_O), D};
    GEMM_IMPL(X, (const bf16_t*)(P.ws + WS_S), (const bf16_t*)(P.ws + WS_WD), DEXP, S, E);
}

#define XB_TMO      128
#define XB_XCNT(j)  (256  + 64 * (j))
#define XB_XSUB(j)  (1280 + 64 * (j))
#define XB_XGEN(j)  (2304 + 64 * (j))
#define XB_TOP      3328
#define XB_TOPGEN   3392
#define XCD_BAR_WORDS 3456
#ifndef XB_SPIN_CAP
#define XB_SPIN_CAP (1u << 26)
#endif
DI unsigned xb_ld(unsigned* p)              { return __hip_atomic_load(p, __ATOMIC_RELAXED, __HIP_MEMORY_SCOPE_AGENT); }
DI unsigned xb_add(unsigned* p, unsigned v) { return __hip_atomic_fetch_add(p, v, __ATOMIC_RELAXED, __HIP_MEMORY_SCOPE_AGENT); }
DI unsigned xb_xcc_id() { return (unsigned)__builtin_amdgcn_s_getreg((3 << 11) | 20) & 0xFu; }
#define XB_SPIN(cond, bar) do { unsigned _sp = 0; while (cond) { __builtin_amdgcn_s_sleep(1); \
    if ((++_sp & 255u) == 0u) { if (xb_ld(&(bar)[XB_TMO])) break; if (_sp > XB_SPIN_CAP) { atomicAdd(&(bar)[XB_TMO], 1u); break; } } } } while (0)
struct XcdBarrier { unsigned* bar; unsigned x; volatile LAS unsigned* st; };
DI XcdBarrier xcd_barrier_post(unsigned* bar, volatile LAS unsigned* st) {
    XcdBarrier b; b.bar = bar; b.x = xb_xcc_id(); b.st = st;
    if (threadIdx.x == 0) (void)xb_add(&bar[XB_XCNT(b.x)], 1u);
    return b;
}
DI void xcd_barrier_complete(unsigned* bar, unsigned x, unsigned& nloc, unsigned& nx) {
    const unsigned G = gridDim.x * gridDim.y * gridDim.z;
    unsigned sum, cnt, mine, sp = 0u;
    for (;;) {
        sum = 0u; cnt = 0u; mine = 0u;
#pragma unroll
        for (unsigned j = 0; j < 16; ++j) { const unsigned c = xb_ld(&bar[XB_XCNT(j)]); sum += c; cnt += (c > 0u) ? 1u : 0u; mine = (j == x) ? c : mine; }
        if (sum == G) break;
        __builtin_amdgcn_s_sleep(1);
        if ((++sp & 255u) == 0u) { if (xb_ld(&bar[XB_TMO])) break; if (sp > XB_SPIN_CAP) { atomicAdd(&bar[XB_TMO], 1u); break; } }
    }
    nloc = mine > 0u ? mine : 1u; nx = cnt > 0u ? cnt : 1u;
}
DI void xcd_barrier(const XcdBarrier& b) {
    asm volatile("s_waitcnt vmcnt(0)" ::: "memory");
    __syncthreads();
    if (threadIdx.x == 0) {
        unsigned* bar = b.bar;
        __builtin_amdgcn_s_waitcnt(0);
        unsigned nloc = b.st[0], nx = b.st[1];
        if (nloc == 0u) { xcd_barrier_complete(bar, b.x, nloc, nx); b.st[0] = nloc; b.st[1] = nx; }
        const unsigned old = xb_add(&bar[XB_XSUB(b.x)], 1u);
        const unsigned gen = old / nloc;
        if (old + 1u == (gen + 1u) * nloc) {
            __builtin_amdgcn_fence(__ATOMIC_RELEASE, "agent");
            asm volatile("s_waitcnt vmcnt(0)" ::: "memory");
            const unsigned og = xb_add(&bar[XB_TOP], 1u);
            const unsigned tg = og / nx;
            if (og + 1u == (tg + 1u) * nx) xb_add(&bar[XB_TOPGEN], 1u);
            else XB_SPIN(xb_ld(&bar[XB_TOPGEN]) == tg, bar);
            __builtin_amdgcn_fence(__ATOMIC_ACQUIRE, "agent");
            xb_add(&bar[XB_XGEN(b.x)], 1u);
            asm volatile("s_waitcnt vmcnt(0)" ::: "memory");
        } else {
            XB_SPIN(xb_ld(&bar[XB_XGEN(b.x)]) == gen, bar);
            __builtin_amdgcn_fence(__ATOMIC_ACQUIRE, "agent");
            asm volatile("s_waitcnt vmcnt(0)" ::: "memory");
        }
    }
    __syncthreads();
}

template <int Q> DI void run_phase(const Ctx& X0, const Params& P0, int l) {
#if defined(__HIP_DEVICE_COMPILE__)
    const __attribute__((address_space(4))) Params* pp_ = (const __attribute__((address_space(4))) Params*)__builtin_amdgcn_kernarg_segment_ptr(); asm volatile("" : "+s"(pp_), "+s"(l));
    const Params P = *pp_; (void)P0;
#else
    const Params P = P0;
#endif
    Ctx X = X0; { int wv = X0.wave; asm volatile("" : "+s"(wv)); int ln; asm volatile("v_mbcnt_lo_u32_b32 %0, -1, 0\n\tv_mbcnt_hi_u32_b32 %0, -1, %0" : "=v"(ln)); X.tid = wv * 64 + ln; X.lane = ln; X.wave = wv; int b_ = X0.bid, n_ = X0.nb; asm volatile("" : "+s"(b_), "+s"(n_)); X.bid = b_; X.nb = n_; }
    if constexpr (Q == 0) ph_prologue(X, P);
    if constexpr (Q == 1) ph_modulate(X, P, 0);
    if constexpr (Q == 2) ph_inproj(X, P, l);
    if constexpr (Q == 3) ph_hgrn_naive(X, P, l);
    if constexpr (Q == 4) ph_hgrn_combine_naive(X, P, l);
    if constexpr (Q == 5) ph_attn_naive(X, P, l);
    if constexpr (Q == 6) ph_outproj(X, P, l);
    if constexpr (Q == 7) ph_ln1(X, P, l);
    if constexpr (Q == 8) ph_moe1(X, P, l);
    if constexpr (Q == 9) ph_moe2(X, P, l);
    if constexpr (Q == 11) ph_hgrn_local(X, P, l);
    if constexpr (Q == 12) ph_hgrn_scan(X, P);
    if constexpr (Q == 13) ph_hgrn_out(X, P, l);
    if constexpr (Q == 14) ph_swa(X, P, l);
    if constexpr (Q == 15) ph_na(X, P, l);
    if constexpr (Q == 16) ph_attn_ctx(X, P, l);
#ifdef DBG_BRUTE
    if constexpr (Q == 23) ph_dbg_scores(X, P, l);
#endif
    if constexpr (Q == 20) ph_dbg_copy(X, P);
    if constexpr (Q == 21) ph_dbg_compare(X, P);
    if constexpr (Q == 22) ph_dbg_apply(X, P);
    if constexpr (Q == 10) { ph_ln2(X, P, l); if (l == 0) { __syncthreads(); convert_experts(X, P, 1, (LAS float*)X.lds + X.wave * (64 * 33)); } }
}

constexpr int LDS_BYTES = 147 * 1024;
template <int Q>
__global__ void __launch_bounds__(NTHREADS, 2) k_step(Params P, int l) {
    extern __shared__ __attribute__((aligned(16))) unsigned char lds_raw[];
    Ctx X; X.lds = (LAS unsigned char*)lds_raw; X.tid = threadIdx.x; X.lane = X.tid & 63; X.wave = __builtin_amdgcn_readfirstlane(X.tid >> 6); X.bid = blockIdx.x; X.nb = gridDim.x;
    run_phase<Q>(X, P, l);
}
template <int Q> static void launch_step(const Params& P, int l, int grid, hipStream_t stream) {
    static bool attr = false;
    if (!attr) { (void)hipFuncSetAttribute((const void*)k_step<Q>, hipFuncAttributeMaxDynamicSharedMemorySize, LDS_BYTES); attr = true; }
    hipLaunchKernelGGL(k_step<Q>, dim3(grid), dim3(NTHREADS), LDS_BYTES, stream, P, l);
}

constexpr int LDS_CTL_OFF = 144 * 1024;
__global__ void __launch_bounds__(NTHREADS, 2) k_mega(Params P) {
    extern __shared__ __attribute__((aligned(16))) unsigned char lds_raw[];
    Ctx X; X.lds = (LAS unsigned char*)lds_raw; X.tid = threadIdx.x; X.lane = X.tid & 63; X.wave = __builtin_amdgcn_readfirstlane(X.tid >> 6); X.bid = blockIdx.x; X.nb = gridDim.x;
    volatile LAS unsigned* st = (volatile LAS unsigned*)(X.lds + LDS_CTL_OFF);
    if (X.tid < 4) st[X.tid] = 0u;
    __syncthreads();
    { const XcdBarrier b0 = xcd_barrier_post((unsigned*)(P.ws + WS_CTL) + CW_BAR, st); if (X.tid == 0) st[2] = b0.x; }
    __syncthreads();
#define GBAR() do { unsigned char* w_ = P.ws; asm volatile("" : "+s"(w_)); XcdBarrier b_; b_.bar = (unsigned*)(w_ + WS_CTL) + CW_BAR; b_.st = st; b_.x = threadIdx.x == 0 ? st[2] : 0u; xcd_barrier(b_); } while (0)
    run_phase<0>(X, P, 0); GBAR();
    run_phase<1>(X, P, 0); GBAR();
    for (int l = 0; l < 2; ++l) {
        run_phase<2>(X, P, l); GBAR();
#if FAST_MIX
        run_phase<11>(X, P, l); GBAR();
        run_phase<12>(X, P, l); GBAR();
        run_phase<13>(X, P, l); __syncthreads();
        run_phase<14>(X, P, l); __syncthreads();
        run_phase<15>(X, P, l); __syncthreads();
        run_phase<16>(X, P, l); GBAR();
#ifdef DBG_MIX
        if (l == 0) {
            run_phase<20>(X, P, l); GBAR();
#ifdef DBG_BRUTE
            run_phase<23>(X, P, l); GBAR();
#endif
            run_phase<3>(X, P, l); GBAR();
            run_phase<4>(X, P, l); GBAR();
            run_phase<5>(X, P, l); GBAR();
            run_phase<21>(X, P, l); GBAR();
        }
#endif
#else
        run_phase<3>(X, P, l); GBAR();
        run_phase<4>(X, P, l); GBAR();
        run_phase<5>(X, P, l); GBAR();
#endif
        run_phase<6>(X, P, l); GBAR();
        run_phase<7>(X, P, l); GBAR();
        run_phase<8>(X, P, l); GBAR();
        run_phase<9>(X, P, l); GBAR();
        run_phase<10>(X, P, l); if (l == 0) GBAR();
    }
#ifdef DBG_MIX
    GBAR(); run_phase<22>(X, P, 0);
#endif
#undef GBAR
}

extern "C" void kernel_launch(void* const* d_in, const int* in_sizes, int n_in, void* d_out, int out_size, void* d_ws, size_t ws_size, hipStream_t stream) {
    static int grid = 0;
    if (grid == 0) {
        if (n_in != 21 || out_size != NLAT * D || ws_size < WS_END) { fprintf(stderr, "kernel_launch: unexpected shapes n_in %d out %d ws %zu\n", n_in, out_size, ws_size); grid = -1; return; }
        int dev = 0, cus = 0; (void)hipGetDevice(&dev); (void)hipDeviceGetAttribute(&cus, hipDeviceAttributeMultiprocessorCount, dev);
        grid = cus > 0 ? cus : 256;
        (void)hipFuncSetAttribute((const void*)k_mega, hipFuncAttributeMaxDynamicSharedMemorySize, LDS_BYTES);
    }
    if (grid < 0) return;
    (void)hipMemsetAsync((char*)d_ws + WS_CTL, 0, CTL_BYTES, stream);
    Params P{};
    for (int i = 0; i < 21; ++i) P.in[i] = (const float*)d_in[i];
    P.out = (float*)d_out; P.ws = (unsigned char*)d_ws;
#if N_LAUNCH_MODE == 1
    hipLaunchKernelGGL(k_mega, dim3(grid), dim3(NTHREADS), LDS_BYTES, stream, P);
#else
    launch_step<0>(P, 0, grid, stream);
    launch_step<1>(P, 0, grid, stream);
    for (int l = 0; l < 2; ++l) {
        launch_step<2>(P, l, grid, stream); launch_step<3>(P, l, grid, stream); launch_step<4>(P, l, grid, stream); launch_step<5>(P, l, grid, stream);
        launch_step<6>(P, l, grid, stream); launch_step<7>(P, l, grid, stream); launch_step<8>(P, l, grid, stream); launch_step<9>(P, l, grid, stream);
        launch_step<10>(P, l, grid, stream);
    }
#endif
}
#ifdef DBG_INST
template __global__ void k_step<11>(Params, int);
template __global__ void k_step<12>(Params, int);
template __global__ void k_step<13>(Params, int);
template __global__ void k_step<14>(Params, int);
template __global__ void k_step<15>(Params, int);
template __global__ void k_step<16>(Params, int);
#endif
```

```cpp
#include <hip/hip_runtime.h>
#include <cstdint>
#include <cstdio>

#ifndef N_LAUNCH_MODE
#define N_LAUNCH_MODE 1
#endif
#ifndef FAST_MIX
#define FAST_MIX 1
#endif
#ifndef DBG_TEST
#define DBG_TEST 0
#endif
#ifndef DBG_HG_MODE
#define DBG_HG_MODE 0
#endif
#ifndef FAST_GEMM
#define FAST_GEMM 1
#endif

#define LAS __attribute__((address_space(3)))
#define GAS __attribute__((address_space(1)))
typedef unsigned short bf16_t;
typedef short bf16x8 __attribute__((ext_vector_type(8)));
typedef float f32x4 __attribute__((ext_vector_type(4)));
typedef float f32x2 __attribute__((ext_vector_type(2)));
typedef unsigned u32x4 __attribute__((ext_vector_type(4)));
typedef unsigned u32x2 __attribute__((ext_vector_type(2)));
typedef short s16x4 __attribute__((ext_vector_type(4)));
typedef float f32x16 __attribute__((ext_vector_type(16)));
#define DI __device__ __forceinline__

constexpr int D = 1024, NB = 2, SEQ = 8192, CTXL = 256, NLAT = NB * SEQ, NCTX = NB * CTXL, NROWS = NLAT + NCTX;
constexpr int INW = 2816, PBW = 2304, ZW = 512, NEXP = 16, DEXP = 512, LISTCAP = NROWS;
constexpr int NTHREADS = 512, NWAVES = 8;
constexpr float ALPHA = 1.41421356237f, LN_EPS = 1e-5f, RMS_EPS = 1e-6f, LOG2E = 1.4426950408889634f, QSCALE = 0.125f * LOG2E;
constexpr int PB_AQ = 0, PB_AI = 256, PB_AG = 512, PB_NQ = 768, PB_NK = 1024, PB_NV = 1280, PB_SQ = 1536, PB_SK = 2048, PB_SV = 2176;
constexpr int NCHAIN = 132;

constexpr size_t MiB = 1u << 20;
constexpr size_t WS_CTL = 0, CTL_BYTES = 1 * MiB;
constexpr size_t WS_MODS = 1 * MiB;
constexpr size_t WS_LB = WS_MODS + 2 * 3 * 6144 * 4;
constexpr size_t WS_ROPE = WS_LB + 2 * 2 * 256 * 4;
constexpr size_t WS_TOKE = WS_ROPE + 128 * 16 * 2 * 4;
constexpr size_t WS_TOKP = WS_TOKE + NROWS * 8;
constexpr size_t WS_TOKW = WS_TOKP + NROWS * 8;
constexpr size_t WS_LIST = 2 * MiB;
constexpr size_t WS_XC = 4 * MiB;
constexpr size_t WS_WIN = 6 * MiB;
constexpr size_t WS_WOUT = 17 * MiB;
constexpr size_t WS_WGU = 21 * MiB;
constexpr size_t WS_WD = 53 * MiB;
constexpr size_t WS_H = 69 * MiB;
constexpr size_t WS_Y = 102 * MiB;
constexpr size_t WS_S = 135 * MiB;
constexpr size_t WS_DD = 282 * MiB;
constexpr size_t WS_PB = 174 * MiB;
constexpr size_t WS_Z = WS_PB + (size_t)NROWS * PBW * 2;
constexpr size_t WS_O = 174 * MiB;
constexpr size_t WS_YO = 248 * MiB;
constexpr size_t WS_END = 284 * MiB;
constexpr int HE_ROWS = 37888;
constexpr size_t WS_KK = WS_Y;
static_assert(WS_DD + (size_t)2 * 2112 * 64 * 4 <= WS_END && WS_Z + (size_t)NROWS * ZW * 4 <= WS_DD && WS_O + (size_t)HE_ROWS * 1024 * 2 <= WS_YO && WS_YO + (size_t)NROWS * 2048 <= WS_END, "ws map");
static_assert(WS_TOKW + NROWS * 8 <= WS_LIST && WS_LIST + 16 * LISTCAP * 4 <= WS_XC, "ws map small");
constexpr int CW_CNT = 8192;
constexpr int CW_BAR = 4096;
constexpr int CW_DBG = 512;

struct Params {
    const float* in[21];
    float* out;
    unsigned char* ws;
    int step_lo, step_hi;
};

DI unsigned f2bf(float f) { unsigned u = __builtin_bit_cast(unsigned, f); return (u + 0x7fffu + ((u >> 16) & 1u)) >> 16; }
DI float bf2f(unsigned h) { return __builtin_bit_cast(float, h << 16); }
typedef __bf16 bf16x2_t __attribute__((ext_vector_type(2)));
DI unsigned pk2(float lo, float hi) { return __builtin_bit_cast(unsigned, __builtin_convertvector((f32x2){lo, hi}, bf16x2_t)); }
DI float bflo(unsigned w) { return __builtin_bit_cast(float, w << 16); }
DI float bfhi(unsigned w) { return __builtin_bit_cast(float, w & 0xffff0000u); }
DI float wave_sum(float v) {
#pragma unroll
    for (int o = 1; o < 64; o <<= 1) v += __shfl_xor(v, o);
    return v;
}
DI float wave_max(float v) {
#pragma unroll
    for (int o = 1; o < 64; o <<= 1) v = fmaxf(v, __shfl_xor(v, o));
    return v;
}
DI float sigmoidf_(float x) { return 1.0f / (1.0f + __expf(-x)); }
DI float siluf_(float x) { return x / (1.0f + __expf(-x)); }
DI void store_bf4(bf16_t* p, f32x4 v) { u32x2 w; w.x = pk2(v[0], v[1]); w.y = pk2(v[2], v[3]); *(u32x2*)p = w; }

struct Ctx {
    LAS unsigned char* lds;
    int tid, lane, wave, bid, nb;
};

struct Unit { int pm, pn, e, cnt, i0; };

struct PlainSched {
    int nM, nN, nwg, G, c;
    DI void init(int M, int N, int G_, int c_) { nM = M / 256; nN = N / 256; nwg = nM * nN; G = G_; c = c_; }
    DI bool next(int i, Unit& u) const {
        const long L = (long)i * G + c; if (L >= nwg) return false;
        int wgid = (int)L; { const int q = nwg / 8, r = nwg % 8, xcd = wgid % 8, off = wgid / 8; wgid = (xcd < r ? xcd * (q + 1) : r * (q + 1) + (xcd - r) * q) + off; }
        const int nig = 8 * nN, gid = wgid / nig, fm = gid * 8, gsz = (nM - fm) < 8 ? (nM - fm) : 8;
        u.pm = fm + ((wgid % nig) % gsz); u.pn = (wgid % nig) / gsz; u.e = 0; u.cnt = 0; u.i0 = 0; return true;
    }
    DI int a_row(const Unit& u, int r) const { return u.pm * 256 + r; }
    DI int b_row0(const Unit& u) const { return u.pn * 256; }
    static constexpr bool LOADS = false;
};
struct MoeSched {
    const int* cnt; const int* list; int G, c, nct, bt_rows; bool gather;
    DI bool next(int i, Unit& u) const {
        const int xcd = c & 7, j = c >> 3; const int L = i * G + xcd * (G >> 3) + j;
        const int T = L / nct; int acc = 0, e = -1, i0 = 0, ce = 0;
#pragma unroll
        for (int q = 0; q < NEXP; ++q) { const int cq = cnt[q * 64]; const int nt = (cq + 255) >> 8; if (e < 0 && T < acc + nt) { e = q; i0 = T - acc; ce = cq; } acc += nt; }
        if (e < 0) return false;
        u.pm = T; u.pn = L % nct; u.e = e; u.cnt = ce; u.i0 = i0; return true;
    }
    DI int a_row(const Unit& u, int r) const {
        if (!gather) return u.pm * 256 + r;
        const int idx = u.i0 * 256 + r; return list[u.e * LISTCAP + (idx < u.cnt ? idx : 0)];
    }
    DI int b_row0(const Unit& u) const { return u.e * bt_rows + u.pn * 256; }
    static constexpr bool LOADS = true;
};

struct EpiIn {
    bf16_t* PB; float* Z; const float* rope; const float* lb; bf16_t* KK;
    DI void gate4(float* zp, bf16_t* kp, const float* lbp, f32x4 z) const {
        const f32x4 lbv = *(const f32x4*)lbp; f32x4 lf, kk;
#pragma unroll
        for (int j = 0; j < 4; ++j) { const float zc = fminf(fmaxf(z[j], -30.f), 30.f), e = __expf(-zc), sg = 1.0f / (1.0f + e); lf[j] = __log2f(lbv[j] + (1.0f - lbv[j]) * sg); kk[j] = (1.0f - lbv[j]) * (e * sg); }
        *(f32x4*)zp = lf; store_bf4(kp, kk);
    }
    DI void group(const Unit& u, int r, int c, f32x4 a0, f32x4 a1, f32x4 b0, f32x4 b1) const {
        const int row = u.pm * 256 + r, seg = u.pn, gc = u.pn * 256 + c;
        if (seg == 1 || seg == 2) {
            const int ci = (seg - 1) * 256 + c; float* z = Z + (size_t)row * ZW + ci; bf16_t* k = KK + (size_t)row * ZW + ci; const float* lp = lb + ci;
            gate4(z, k, lp, a0); gate4(z + 16, k + 16, lp + 16, a1); gate4(z + 128, k + 128, lp + 128, b0); gate4(z + 144, k + 144, lp + 144, b1);
            return;
        }
        const bool lat = row < NLAT;
        if (seg >= 8 && lat) {
            const int t = row & (SEQ - 1); const int which = (c >> 5) & 1; const int pos = which ? (t & 63) : (t >> 6);
            const float* rp = rope + (pos * 16 + (c & 31)) * 2;
#pragma unroll
            for (int j = 0; j < 4; ++j) {
                const float cs = rp[2 * j], sn = rp[2 * j + 1];
                const float x1 = a0[j], x2 = a1[j]; a0[j] = x1 * cs - x2 * sn; a1[j] = x1 * sn + x2 * cs;
                if (seg < 10) { const float y1 = b0[j], y2 = b1[j]; b0[j] = y1 * cs - y2 * sn; b1[j] = y1 * sn + y2 * cs; }
            }
        }
        if (seg == 5 || seg == 8 || seg == 9) { a0 *= QSCALE; a1 *= QSCALE; b0 *= QSCALE; b1 *= QSCALE; }
        bf16_t* p = PB + (size_t)row * PBW + (gc >= 768 ? gc - 512 : gc);
        store_bf4(p, a0); store_bf4(p + 16, a1); store_bf4(p + 128, b0); store_bf4(p + 144, b1);
    }
};
struct EpiBf {
    bf16_t* C; int ldc;
    DI void group(const Unit& u, int r, int c, f32x4 a0, f32x4 a1, f32x4 b0, f32x4 b1) const {
        bf16_t* p = C + (size_t)(u.pm * 256 + r) * ldc + u.pn * 256 + c;
        store_bf4(p, a0); store_bf4(p + 16, a1); store_bf4(p + 128, b0); store_bf4(p + 144, b1);
    }
};
struct EpiGU {
    bf16_t* HE;
    DI void group(const Unit& u, int r, int c, f32x4 a0, f32x4 a1, f32x4 b0, f32x4 b1) const {
        f32x4 h0, h1;
#pragma unroll
        for (int j = 0; j < 4; ++j) { h0[j] = siluf_(a0[j]) * b0[j]; h1[j] = siluf_(a1[j]) * b1[j]; }
        bf16_t* p = HE + (size_t)(u.pm * 256 + r) * DEXP + u.pn * 128 + c;
        store_bf4(p, h0); store_bf4(p + 16, h1);
    }
};

template <class Sched, class Epi>
DI void gemm_naive(const Ctx& X, const bf16_t* A, const bf16_t* Bt, int K, const Sched& S, const Epi& E) {
    Unit u;
    for (int i = 0; S.next(i, u); ++i) {
        for (int g = X.tid; g < 4096; g += NTHREADS) {
            const int fq = g & 3, wc = (g >> 2) & 3, r = g >> 4, c = wc * 32 + fq * 4;
            const bf16_t* ap = A + (size_t)S.a_row(u, r) * K;
            const bf16_t* bp = Bt + (size_t)(S.b_row0(u) + c) * K;
            float acc[16];
#pragma unroll
            for (int q = 0; q < 16; ++q) acc[q] = 0.f;
            for (int k = 0; k < K; k += 8) {
                const u32x4 av = *(const u32x4*)(ap + k);
                float af[8] = {bflo(av.x), bfhi(av.x), bflo(av.y), bfhi(av.y), bflo(av.z), bfhi(av.z), bflo(av.w), bfhi(av.w)};
#pragma unroll
                for (int q = 0; q < 16; ++q) {
                    const int col = (q >> 3) * 128 + ((q >> 2) & 1) * 16 + (q & 3);
                    const u32x4 bv = *(const u32x4*)(bp + (size_t)col * K + k);
                    acc[q] += af[0] * bflo(bv.x) + af[1] * bfhi(bv.x) + af[2] * bflo(bv.y) + af[3] * bfhi(bv.y) + af[4] * bflo(bv.z) + af[5] * bfhi(bv.z) + af[6] * bflo(bv.w) + af[7] * bfhi(bv.w);
                }
            }
            E.group(u, r, c, (f32x4){acc[0], acc[1], acc[2], acc[3]}, (f32x4){acc[4], acc[5], acc[6], acc[7]}, (f32x4){acc[8], acc[9], acc[10], acc[11]}, (f32x4){acc[12], acc[13], acc[14], acc[15]});
        }
    }
}

constexpr int HTB = 128 * 64 * 2;
DI int lds_byte(int r, int c) { const int st = (r >> 4) * 2 + (c >> 5), rr = r & 15, cc = c & 31, ob = rr * 64 + cc * 2; return st * 1024 + (ob ^ (((ob >> 9) & 1) << 5)); }
DI void stage_rc(int b, int& R, int& C) { const int st = b / 1024, sb = b % 1024, swz = sb ^ (((sb >> 9) & 1) << 5); R = (st >> 1) * 16 + swz / 64; C = (st & 1) * 32 + (swz % 64) / 2; }
template <class Sched, class Epi>
DI void gemm_fast(const Ctx& X, const bf16_t* A, const bf16_t* Bt, int K, const Sched& S, const Epi& E) {
    LAS unsigned char* lds = X.lds;
    const int tid = X.tid, wid = X.wave, lane = X.lane, wr = wid >> 2, wc = wid & 3, fr = lane & 15, fq = lane >> 4;
    const int nt = K / 64;
    int Rr[2], Cc[2]; unsigned voffB[2];
#pragma unroll
    for (int i = 0; i < 2; ++i) { stage_rc(tid * 16 + i * 8192, Rr[i], Cc[i]); voffB[i] = (unsigned)(Rr[i] * K + Cc[i]) * 2u; }
    const size_t kstep = 128, hstepB = (size_t)128 * K * 2;
    const unsigned ldsw = (unsigned)wid * 1024u;
    const int aoff = lds_byte(wr * 64 + fr, fq * 8), boff = lds_byte(wc * 32 + fr, fq * 8);
#define G_SA(b, h) (((b) * 2 + (h)) * HTB)
#define G_SB(b, h) ((4 + (b) * 2 + (h)) * HTB)
#define G_STAGE(bufoff, gbase, voff) do { _Pragma("unroll") for (int _i = 0; _i < 2; ++_i) \
        __builtin_amdgcn_global_load_lds((const unsigned*)((const char*)(gbase) + (voff)[_i]), (LAS unsigned*)(lds + (bufoff) + ldsw + _i * 8192), 16, 0, 0); } while (0)
#define G_LDA(dst, b, h) do { _Pragma("unroll") for (int m = 0; m < 4; ++m) _Pragma("unroll") for (int k = 0; k < 2; ++k) dst[m][k] = *(const LAS bf16x8*)(lds + G_SA(b, h) + aoff + m * 2048 + k * 1024); } while (0)
#define G_LDB(dst, b, h) do { _Pragma("unroll") for (int n = 0; n < 2; ++n) _Pragma("unroll") for (int k = 0; k < 2; ++k) dst[n][k] = *(const LAS bf16x8*)(lds + G_SB(b, h) + boff + n * 2048 + k * 1024); } while (0)
#define G_MMA(ai, bj, At, Bt_) do { __builtin_amdgcn_s_setprio(1); _Pragma("unroll") for (int m = 0; m < 4; ++m) _Pragma("unroll") for (int n = 0; n < 2; ++n) _Pragma("unroll") for (int k = 0; k < 2; ++k) \
        acc[ai][bj][m][n] = __builtin_amdgcn_mfma_f32_16x16x32_bf16(Bt_[n][k], At[m][k], acc[ai][bj][m][n], 0, 0, 0); __builtin_amdgcn_s_setprio(0); } while (0)
#define G_WAIT_V(n) asm volatile("s_waitcnt vmcnt(" #n ")" ::: "memory")
#define G_WAIT_L(n) asm volatile("s_waitcnt lgkmcnt(" #n ")" ::: "memory")
#define G_BAR __builtin_amdgcn_s_barrier()
#define G_SCHED __builtin_amdgcn_sched_barrier(0)
    Unit cur, nxt; int ui = 0;
    if (!S.next(0, cur)) return;
    f32x4 acc[2][2][4][2];
#pragma unroll
    for (int a = 0; a < 2; ++a)
#pragma unroll
        for (int b = 0; b < 2; ++b)
#pragma unroll
            for (int m = 0; m < 4; ++m)
#pragma unroll
                for (int n = 0; n < 2; ++n) acc[a][b][m][n] = (f32x4){0.f, 0.f, 0.f, 0.f};
    bf16x8 At[4][2], B0[2][2], B1[2][2];
    unsigned vAc[2][2], vAn[2][2];
#pragma unroll
    for (int h = 0; h < 2; ++h)
#pragma unroll
        for (int i = 0; i < 2; ++i) vAc[h][i] = (unsigned)(S.a_row(cur, h * 128 + Rr[i]) * K + Cc[i]) * 2u;
    G_WAIT_V(0);
    const char* A0 = (const char*)A;
    const char* cB = (const char*)Bt + (size_t)S.b_row0(cur) * K * 2;
    G_STAGE(G_SB(0, 0), cB, voffB); G_STAGE(G_SB(0, 1), cB + hstepB, voffB); G_STAGE(G_SA(0, 0), A0, vAc[0]); G_STAGE(G_SA(0, 1), A0, vAc[1]);
    if (wr == 1) G_BAR;
    G_WAIT_V(2); G_BAR;
    G_STAGE(G_SB(1, 0), cB + kstep, voffB); G_STAGE(G_SA(1, 0), A0 + kstep, vAc[0]); G_STAGE(G_SB(1, 1), cB + hstepB + kstep, voffB);
    G_WAIT_V(6); G_BAR;
    for (;;) {
        const bool has_next = S.next(ui + 1, nxt);
        if (has_next) {
#pragma unroll
            for (int h = 0; h < 2; ++h)
#pragma unroll
                for (int i = 0; i < 2; ++i) vAn[h][i] = (unsigned)(S.a_row(nxt, h * 128 + Rr[i]) * K + Cc[i]) * 2u;
            if (Sched::LOADS) G_WAIT_V(0);
        } else {
#pragma unroll
            for (int h = 0; h < 2; ++h)
#pragma unroll
                for (int i = 0; i < 2; ++i) vAn[h][i] = vAc[h][i];
        }
        const char* nB = has_next ? (const char*)Bt + (size_t)S.b_row0(nxt) * K * 2 : cB;
        for (int t = 0; t < nt; t += 2) {
            const bool last = (t == nt - 2);
            const char* a1 = A0 + (size_t)(t + 1) * kstep;
            const char* a2 = last ? A0 : A0 + (size_t)(t + 2) * kstep; const char* b2 = last ? nB : cB + (size_t)(t + 2) * kstep;
            const char* a3 = a2 + kstep; const char* b3 = b2 + kstep;
            unsigned v2[2][2];
#pragma unroll
            for (int h = 0; h < 2; ++h)
#pragma unroll
                for (int i = 0; i < 2; ++i) v2[h][i] = last ? vAn[h][i] : vAc[h][i];
            G_LDB(B0, 0, 0); G_LDB(B1, 0, 1); G_SCHED; G_LDA(At, 0, 0); G_STAGE(G_SA(1, 1), a1, vAc[1]);
            G_WAIT_V(8); G_WAIT_L(0); G_BAR; G_MMA(0, 0, At, B0); G_MMA(0, 1, At, B1); G_BAR; G_SCHED;
            G_LDA(At, 0, 1); G_STAGE(G_SB(0, 0), b2, voffB); G_STAGE(G_SB(0, 1), b2 + hstepB, voffB); G_STAGE(G_SA(0, 0), a2, v2[0]);
            G_WAIT_V(8); G_WAIT_L(0); G_BAR; G_MMA(1, 0, At, B0); G_MMA(1, 1, At, B1); G_BAR; G_SCHED;
            G_LDB(B0, 1, 0); G_LDB(B1, 1, 1); G_SCHED; G_LDA(At, 1, 0); G_STAGE(G_SA(0, 1), a2, v2[1]);
            G_WAIT_V(8); G_WAIT_L(0); G_BAR; G_MMA(0, 0, At, B0); G_MMA(0, 1, At, B1); G_BAR; G_SCHED;
            G_LDA(At, 1, 1); G_STAGE(G_SB(1, 0), b3, voffB); G_STAGE(G_SB(1, 1), b3 + hstepB, voffB); G_STAGE(G_SA(1, 0), a3, v2[0]);
            G_WAIT_V(8); G_WAIT_L(0); G_BAR; G_MMA(1, 0, At, B0); G_MMA(1, 1, At, B1); G_BAR; G_SCHED;
        }
        if (wr == 0) G_BAR;
#pragma unroll
        for (int ai = 0; ai < 2; ++ai)
#pragma unroll
            for (int m = 0; m < 4; ++m) E.group(cur, ai * 128 + wr * 64 + m * 16 + fr, wc * 32 + fq * 4, acc[ai][0][m][0], acc[ai][0][m][1], acc[ai][1][m][0], acc[ai][1][m][1]);
        if (!has_next) break;
#pragma unroll
        for (int a = 0; a < 2; ++a)
#pragma unroll
            for (int b = 0; b < 2; ++b)
#pragma unroll
                for (int m = 0; m < 4; ++m)
#pragma unroll
                    for (int n = 0; n < 2; ++n) acc[a][b][m][n] = (f32x4){0.f, 0.f, 0.f, 0.f};
        cur = nxt; cB = nB; ++ui;
#pragma unroll
        for (int h = 0; h < 2; ++h)
#pragma unroll
            for (int i = 0; i < 2; ++i) vAc[h][i] = vAn[h][i];
        if (wr == 1) G_BAR;
    }
    G_WAIT_V(0);
    G_BAR;
#undef G_SA
#undef G_SB
#undef G_STAGE
#undef G_LDA
#undef G_LDB
#undef G_MMA
#undef G_WAIT_V
#undef G_WAIT_L
#undef G_BAR
#undef G_SCHED
}
#if FAST_GEMM
#define GEMM_IMPL gemm_fast
#else
#define GEMM_IMPL gemm_naive
#endif

DI void transpose_item(const float* W, int N, bf16_t* WT, int Kd, int k0, int n0, int drow0, LAS float* scr, int lane) {
#pragma unroll 8
    for (int i = 0; i < 32; ++i) { const int kk = 2 * i + (lane >> 5); scr[kk * 33 + (lane & 31)] = W[(size_t)(k0 + kk) * N + n0 + (lane & 31)]; }
    asm volatile("s_waitcnt lgkmcnt(0)" ::: "memory");
    const int c = lane & 7;
#pragma unroll
    for (int j = 0; j < 4; ++j) { const int n = (lane >> 3) + 8 * j; const LAS float* s = scr + (8 * c) * 33 + n;
        u32x4 o; o.x = pk2(s[0 * 33], s[1 * 33]); o.y = pk2(s[2 * 33], s[3 * 33]); o.z = pk2(s[4 * 33], s[5 * 33]); o.w = pk2(s[6 * 33], s[7 * 33]);
        *(u32x4*)(WT + (size_t)(drow0 + n) * Kd + k0 + 8 * c) = o; }
    asm volatile("s_waitcnt lgkmcnt(0)" ::: "memory");
}
DI void convert_experts(const Ctx& X, const Params& P, int l, LAS float* scr) {
    const int gw = X.bid * NWAVES + X.wave, NGW = X.nb * NWAVES;
    bf16_t* WGU = (bf16_t*)(P.ws + WS_WGU); bf16_t* WD = (bf16_t*)(P.ws + WS_WD);
    const float* wg = P.in[18] + (size_t)l * NEXP * D * DEXP; const float* wu = P.in[19] + (size_t)l * NEXP * D * DEXP; const float* wd = P.in[20] + (size_t)l * NEXP * DEXP * D;
    for (int it = gw; it < 3 * 4096; it += NGW) {
        const int set = it >> 12, r = it & 4095, e = r >> 8, q = r & 255;
        if (set < 2) { const int kb = q >> 4, nbk = q & 15, n0 = nbk * 32;
            transpose_item((set ? wu : wg) + (size_t)e * D * DEXP, DEXP, WGU + (size_t)e * 1024 * 1024, 1024, kb * 64, n0, 256 * (n0 >> 7) + (n0 & 127) + set * 128, scr, X.lane);
        } else { const int kb = q >> 5, nbk = q & 31, n0 = nbk * 32;
            transpose_item(wd + (size_t)e * DEXP * D, D, WD + (size_t)e * 1024 * 512, 512, kb * 64, n0, n0, scr, X.lane); }
    }
}
DI void ph_prologue(const Ctx& X, const Params& P) {
    LAS float* sc = (LAS float*)X.lds;
    LAS float* red = sc + 3072;
    float* MODS = (float*)(P.ws + WS_MODS);
    for (int it = X.bid; it < 193; it += X.nb) {
        if (it < 192) {
            const int l = it / 96, cg = it % 96;
            for (int i = X.tid; i < 3072; i += NTHREADS) { const int cond = i >> 10, k = i & 1023; const float v = cond < 2 ? P.in[1][cond * 1024 + k] : P.in[3][k]; sc[i] = siluf_(v); }
            __syncthreads();
            const int kq = X.tid >> 4, c4 = X.tid & 15;
            float acc[3][4];
#pragma unroll
            for (int a = 0; a < 3; ++a)
#pragma unroll
                for (int j = 0; j < 4; ++j) acc[a][j] = 0.f;
            const float* w = P.in[4] + (size_t)l * D * 6144 + cg * 64 + c4 * 4;
#pragma unroll 8
            for (int i = 0; i < 32; ++i) { const int k = kq + 32 * i; const f32x4 wv = *(const f32x4*)(w + (size_t)k * 6144);
                const float s0 = sc[k], s1 = sc[1024 + k], s2 = sc[2048 + k];
#pragma unroll
                for (int j = 0; j < 4; ++j) { acc[0][j] += s0 * wv[j]; acc[1][j] += s1 * wv[j]; acc[2][j] += s2 * wv[j]; } }
#pragma unroll
            for (int a = 0; a < 3; ++a)
#pragma unroll
                for (int j = 0; j < 4; ++j) red[(kq * 3 + a) * 64 + c4 * 4 + j] = acc[a][j];
            __syncthreads();
            if (X.tid < 192) { const int cond = X.tid >> 6, col = X.tid & 63; float s = 0.f;
                for (int q = 0; q < 32; ++q) s += red[(q * 3 + cond) * 64 + col];
                MODS[(l * 3 + cond) * 6144 + cg * 64 + col] = s + P.in[5][l * 6144 + cg * 64 + col]; }
            __syncthreads();
        } else {
            float* LB = (float*)(P.ws + WS_LB);
            { const int i = X.tid; const float l0 = P.in[7][i], l1 = P.in[7][512 + i]; const float p1 = 1.0f / (1.0f + expf(l0 - l1));
              LB[i] = 1e-6f; LB[512 + i] = fmaxf(p1, 1e-6f); }
            float* RP = (float*)(P.ws + WS_ROPE);
            for (int i = X.tid; i < 2048; i += NTHREADS) { const int pos = i >> 4, f = i & 15; const float inv = powf(10000.0f, -(float)f / 16.0f); const float ang = (float)pos * inv;
                RP[2 * i] = cosf(ang); RP[2 * i + 1] = sinf(ang); }
        }
    }
    __syncthreads();
    LAS float* scr = (LAS float*)X.lds + X.wave * (64 * 33);
    const int gw = X.bid * NWAVES + X.wave, NGW = X.nb * NWAVES;
    bf16_t* WIN = (bf16_t*)(P.ws + WS_WIN); bf16_t* WOUT = (bf16_t*)(P.ws + WS_WOUT);
    for (int it = gw; it < 2 * 1408 + 2 * 512; it += NGW) {
        if (it < 2816) { const int l = it / 1408, r = it % 1408, kb = r / 88, nbk = r % 88;
            transpose_item(P.in[6] + (size_t)l * D * INW, INW, WIN + (size_t)l * INW * D, D, kb * 64, nbk * 32, nbk * 32, scr, X.lane);
        } else { const int r0 = it - 2816, l = r0 >> 9, r = r0 & 511, kb = r >> 5, nbk = r & 31;
            transpose_item(P.in[11] + (size_t)l * D * D, D, WOUT + (size_t)l * D * D, D, kb * 64, nbk * 32, nbk * 32, scr, X.lane); }
    }
    convert_experts(X, P, 0, scr);
}

DI const float* mods_row(const Params& P, int l, int row) { const int cond = row < NLAT ? (row >> 13) : 2; return (const float*)(P.ws + WS_MODS) + (l * 3 + cond) * 6144; }
DI void ph_modulate(const Ctx& X, const Params& P, int l) {
    bf16_t* H = (bf16_t*)(P.ws + WS_H);
    const int gw = X.bid * NWAVES + X.wave, NGW = X.nb * NWAVES;
    for (int row = gw; row < NROWS; row += NGW) {
        const float* xr = row < NLAT ? P.in[0] + (size_t)row * D : P.in[2] + (size_t)(row - NLAT) * D; const float* md = mods_row(P, l, row);
#pragma unroll
        for (int j = 0; j < 4; ++j) { const int c = 4 * X.lane + 256 * j; const f32x4 x = *(const f32x4*)(xr + c), sh = *(const f32x4*)(md + c), sc = *(const f32x4*)(md + 1024 + c);
            store_bf4(H + (size_t)row * D + c, x * (1.0f + sc) + sh); }
    }
}
DI void ph_ln1(const Ctx& X, const Params& P, int l) {
    LAS float* wrT = (LAS float*)X.lds;
    for (int i = X.tid; i < 16384; i += NTHREADS) { const int k = i >> 4, e = i & 15; wrT[e * 1024 + k] = P.in[16][i]; }
    __syncthreads();
    const int nrows = l == 0 ? NROWS : NLAT;
    bf16_t* H = (bf16_t*)(P.ws + WS_H); const bf16_t* YO = (const bf16_t*)(P.ws + WS_YO); float* XC = (float*)(P.ws + WS_XC);
    int* TOKE = (int*)(P.ws + WS_TOKE); int* TOKP = (int*)(P.ws + WS_TOKP); float* TOKW = (float*)(P.ws + WS_TOKW); int* LIST = (int*)(P.ws + WS_LIST);
    unsigned* CNT = (unsigned*)(P.ws + WS_CTL) + CW_CNT + 1024 * l;
    LAS int* lcnt = (LAS int*)(X.lds + 65536); LAS int* lbase = lcnt + 16; LAS int* linfo = lcnt + 32;
    if (X.tid < 16) lcnt[X.tid] = 0;
    for (int i = X.tid; i < 72 * 4; i += NTHREADS) linfo[i] = -1;
    __syncthreads();
    const float* g = P.in[12] + l * D; const float* bta = P.in[13] + l * D;
    const int gw = X.bid * NWAVES + X.wave, NGW = X.nb * NWAVES;
    for (int row = gw; row < nrows; row += NGW) {
        const bool lat = row < NLAT;
        const float* xr = lat ? (l == 0 ? P.in[0] : P.out) + (size_t)row * D : P.in[2] + (size_t)(row - NLAT) * D;
        float* xo = lat ? P.out + (size_t)row * D : XC + (size_t)(row - NLAT) * D;
        const float* md = mods_row(P, l, row);
        f32x4 v[4]; float s = 0.f;
#pragma unroll
        for (int j = 0; j < 4; ++j) { const int c = 4 * X.lane + 256 * j; const f32x4 x = *(const f32x4*)(xr + c), g1 = *(const f32x4*)(md + 2048 + c);
            const u32x2 yw = *(const u32x2*)(YO + (size_t)row * D + c); const f32x4 y = {bflo(yw.x), bfhi(yw.x), bflo(yw.y), bfhi(yw.y)};
            v[j] = ALPHA * x + g1 * y; s += (v[j][0] + v[j][1]) + (v[j][2] + v[j][3]); }
        const float mean = wave_sum(s) * (1.0f / D); float q = 0.f;
#pragma unroll
        for (int j = 0; j < 4; ++j) { v[j] = v[j] - mean; q += (v[j][0] * v[j][0] + v[j][1] * v[j][1]) + (v[j][2] * v[j][2] + v[j][3] * v[j][3]); }
        const float rstd = 1.0f / sqrtf(wave_sum(q) * (1.0f / D) + LN_EPS);
        f32x4 h2v[4];
#pragma unroll
        for (int j = 0; j < 4; ++j) { const int c = 4 * X.lane + 256 * j; const f32x4 x1 = v[j] * rstd * *(const f32x4*)(g + c) + *(const f32x4*)(bta + c);
            *(f32x4*)(xo + c) = x1;
            h2v[j] = x1 * (1.0f + *(const f32x4*)(md + 4096 + c)) + *(const f32x4*)(md + 3072 + c);
            store_bf4(H + (size_t)row * D + c, h2v[j]); }
        float lg[16];
#pragma unroll
        for (int e = 0; e < 16; ++e) { float a = 0.f;
#pragma unroll
            for (int j = 0; j < 4; ++j) { const f32x4 w = *(const LAS f32x4*)(wrT + e * 1024 + 4 * X.lane + 256 * j); a += (h2v[j][0] * w[0] + h2v[j][1] * w[1]) + (h2v[j][2] * w[2] + h2v[j][3] * w[3]); }
            lg[e] = a; asm volatile("" ::: "memory"); }
        float sg[16], sel[16];
#pragma unroll
        for (int e = 0; e < 16; ++e) { sg[e] = sigmoidf_(wave_sum(lg[e])); sel[e] = sg[e] + P.in[17][e]; }
        int best = 0; float bestv = -3e38f;
#pragma unroll
        for (int gq = 0; gq < 4; ++gq) { float m1 = -3e38f, m2 = -3e38f;
#pragma unroll
            for (int j = 0; j < 4; ++j) { const float t = sel[gq * 4 + j]; if (t > m1) { m2 = m1; m1 = t; } else if (t > m2) m2 = t; }
            const float gs = m1 + m2; if (gs > bestv) { bestv = gs; best = gq; } }
        int i0 = 0, i1 = 0; float v0 = -3e38f, v1 = -3e38f, s0 = 0.f, s1 = 0.f;
#pragma unroll
        for (int e = 0; e < 16; ++e) { if ((e >> 2) == best) { const float t = sel[e];
                if (t > v0) { v1 = v0; i1 = i0; s1 = s0; v0 = t; i0 = e; s0 = sg[e]; } else if (t > v1) { v1 = t; i1 = e; s1 = sg[e]; } } }
        if (X.lane == 0) {
            const float inv = 1.0f / (s0 + s1);
            const int p0 = __hip_atomic_fetch_add(lcnt + i0, 1, __ATOMIC_RELAXED, __HIP_MEMORY_SCOPE_WORKGROUP), p1 = __hip_atomic_fetch_add(lcnt + i1, 1, __ATOMIC_RELAXED, __HIP_MEMORY_SCOPE_WORKGROUP);
            const int slot = X.wave * 9 + (row - gw) / NGW;
            linfo[4 * slot] = row; linfo[4 * slot + 1] = i0 | (i1 << 8); linfo[4 * slot + 2] = p0; linfo[4 * slot + 3] = p1;
            TOKE[2 * row] = i0; TOKE[2 * row + 1] = i1; TOKW[2 * row] = s0 * inv; TOKW[2 * row + 1] = s1 * inv;
        }
    }
    __syncthreads();
    if (X.tid < 16) lbase[X.tid] = (int)atomicAdd(CNT + 64 * X.tid, (unsigned)lcnt[X.tid]);
    __syncthreads();
    if (X.tid < 72) { const int row = linfo[4 * X.tid];
        if (row >= 0) { const int ee = linfo[4 * X.tid + 1], e0 = ee & 255, e1 = ee >> 8, p0 = lbase[e0] + linfo[4 * X.tid + 2], p1 = lbase[e1] + linfo[4 * X.tid + 3];
            LIST[e0 * LISTCAP + p0] = row; LIST[e1 * LISTCAP + p1] = row; TOKP[2 * row] = p0; TOKP[2 * row + 1] = p1; } }
}
DI void ph_ln2(const Ctx& X, const Params& P, int l) {
    const int nrows = l == 0 ? NROWS : NLAT;
    bf16_t* H = (bf16_t*)(P.ws + WS_H); const bf16_t* O = (const bf16_t*)(P.ws + WS_O); float* XC = (float*)(P.ws + WS_XC);
    const int* TOKE = (const int*)(P.ws + WS_TOKE); const int* TOKP = (const int*)(P.ws + WS_TOKP); const float* TOKW = (const float*)(P.ws + WS_TOKW);
    const unsigned* CNT = (const unsigned*)(P.ws + WS_CTL) + CW_CNT + 1024 * l;
    const float* g = P.in[14] + l * D; const float* bta = P.in[15] + l * D;
    int off[16]; { int acc = 0;
#pragma unroll
        for (int e = 0; e < 16; ++e) { off[e] = acc; acc += (((int)CNT[e * 64] + 255) >> 8) << 8; } }
    const int gw = X.bid * NWAVES + X.wave, NGW = X.nb * NWAVES;
    for (int row = gw; row < nrows; row += NGW) {
        const bool lat = row < NLAT;
        float* xr = lat ? P.out + (size_t)row * D : XC + (size_t)(row - NLAT) * D;
        const float* md = mods_row(P, l, row);
        const int e0 = TOKE[2 * row], e1 = TOKE[2 * row + 1]; int o0 = 0, o1 = 0;
#pragma unroll
        for (int e = 0; e < 16; ++e) { if (e == e0) o0 = off[e]; if (e == e1) o1 = off[e]; }
        const bf16_t* r0 = O + (size_t)(o0 + TOKP[2 * row]) * D; const bf16_t* r1 = O + (size_t)(o1 + TOKP[2 * row + 1]) * D;
        const float w0 = TOKW[2 * row], w1 = TOKW[2 * row + 1];
        f32x4 v[4]; float s = 0.f;
#pragma unroll
        for (int j = 0; j < 4; ++j) { const int c = 4 * X.lane + 256 * j; const f32x4 x = *(const f32x4*)(xr + c), g2 = *(const f32x4*)(md + 5120 + c);
            const u32x2 a = *(const u32x2*)(r0 + c), b = *(const u32x2*)(r1 + c);
            const f32x4 f = w0 * (f32x4){bflo(a.x), bfhi(a.x), bflo(a.y), bfhi(a.y)} + w1 * (f32x4){bflo(b.x), bfhi(b.x), bflo(b.y), bfhi(b.y)};
            v[j] = ALPHA * x + g2 * f; s += (v[j][0] + v[j][1]) + (v[j][2] + v[j][3]); }
        const float mean = wave_sum(s) * (1.0f / D); float q = 0.f;
#pragma unroll
        for (int j = 0; j < 4; ++j) { v[j] = v[j] - mean; q += (v[j][0] * v[j][0] + v[j][1] * v[j][1]) + (v[j][2] * v[j][2] + v[j][3] * v[j][3]); }
        const float rstd = 1.0f / sqrtf(wave_sum(q) * (1.0f / D) + LN_EPS);
        const float* mdn = mods_row(P, 1, row);
#pragma unroll
        for (int j = 0; j < 4; ++j) { const int c = 4 * X.lane + 256 * j; const f32x4 x2 = v[j] * rstd * *(const f32x4*)(g + c) + *(const f32x4*)(bta + c);
            *(f32x4*)(xr + c) = x2;
            if (l == 0) store_bf4(H + (size_t)row * D + c, x2 * (1.0f + *(const f32x4*)(mdn + 1024 + c)) + *(const f32x4*)(mdn + c)); }
    }
}

struct KeysNA { int b, r, c, rs, cs, h; const float* rpb;
    DI int n() const { return 128 + CTXL; }
    DI void get(int k, int& krow, float& bias) const { if (k < 128) { const int kr = rs + (k >> 4), kc = cs + (k & 15); krow = b * SEQ + kr * 64 + kc; bias = LOG2E * rpb[h * 465 + (kr - r + 7) * 31 + (kc - c + 15)]; } else { krow = NLAT + b * CTXL + (k - 128); bias = 0.f; } } };
struct KeysSWA { int b, lo, nband;
    DI int n() const { return nband + CTXL; }
    DI void get(int k, int& krow, float& bias) const { krow = k < nband ? b * SEQ + lo + k : NLAT + b * CTXL + (k - nband); bias = 0.f; } };
struct KeysCtx { int b;
    DI int n() const { return CTXL; }
    DI void get(int k, int& krow, float& bias) const { krow = NLAT + b * CTXL + k; bias = 0.f; } };
template <class Keys>
DI void attn_row_naive(const bf16_t* PB, int qrow, int qcol, int kcol, int vcol, const Keys& KS, bool has_sink, float sink, LAS float* sc, bf16_t* yout, int lane) {
    float q[64];
    { const u32x4* qp = (const u32x4*)(PB + (size_t)qrow * PBW + qcol);
#pragma unroll
      for (int i = 0; i < 8; ++i) { const u32x4 w = qp[i]; q[8 * i] = bflo(w.x); q[8 * i + 1] = bfhi(w.x); q[8 * i + 2] = bflo(w.y); q[8 * i + 3] = bfhi(w.y); q[8 * i + 4] = bflo(w.z); q[8 * i + 5] = bfhi(w.z); q[8 * i + 6] = bflo(w.w); q[8 * i + 7] = bfhi(w.w); } }
    const int nk = KS.n(); float mx = has_sink ? sink : -3e38f;
    for (int k = lane; k < nk; k += 64) { int krow; float bias; KS.get(k, krow, bias);
        const u32x4* kp = (const u32x4*)(PB + (size_t)krow * PBW + kcol); float s = 0.f;
#pragma unroll
        for (int i = 0; i < 8; ++i) { const u32x4 w = kp[i]; s += q[8 * i] * bflo(w.x) + q[8 * i + 1] * bfhi(w.x) + q[8 * i + 2] * bflo(w.y) + q[8 * i + 3] * bfhi(w.y) + q[8 * i + 4] * bflo(w.z) + q[8 * i + 5] * bfhi(w.z) + q[8 * i + 6] * bflo(w.w) + q[8 * i + 7] * bfhi(w.w); }
        s += bias; sc[k] = s; mx = fmaxf(mx, s); }
    mx = wave_max(mx); float den = 0.f;
    for (int k = lane; k < nk; k += 64) { const float p = exp2f(sc[k] - mx); sc[k] = p; den += p; }
    den = wave_sum(den); if (has_sink) den += exp2f(sink - mx);
    asm volatile("s_waitcnt lgkmcnt(0)" ::: "memory");
    float o = 0.f;
    for (int k = 0; k < nk; ++k) { int krow; float bias; KS.get(k, krow, bias); o += sc[k] * bf2f(PB[(size_t)krow * PBW + vcol + lane]); }
    yout[lane] = (bf16_t)f2bf(o / den);
    asm volatile("s_waitcnt lgkmcnt(0)" ::: "memory");
}
DI void ph_attn_naive(const Ctx& X, const Params& P, int l) {
    const bf16_t* PB = (const bf16_t*)(P.ws + WS_PB); bf16_t* Y = (bf16_t*)(P.ws + WS_Y);
    LAS float* sc = (LAS float*)X.lds + X.wave * 640;
    const float* rpb = P.in[9] + l * 4 * 465; const float* sink = P.in[10] + l * 8;
    const int nrows = l == 0 ? NROWS : NLAT;
    const int gw = X.bid * NWAVES + X.wave, NGW = X.nb * NWAVES;
    for (int it = gw; it < nrows * 12; it += NGW) {
        const int row = it / 12, hh = it % 12;
        if (row < NLAT) { const int b = row >> 13, t = row & (SEQ - 1);
            if (hh < 4) { KeysNA K; K.b = b; K.r = t >> 6; K.c = t & 63; K.rs = min(max(K.r - 4, 0), 120); K.cs = min(max(K.c - 8, 0), 48); K.h = hh; K.rpb = rpb;
                attn_row_naive(PB, row, PB_NQ + hh * 64, PB_NK + hh * 64, PB_NV + hh * 64, K, false, 0.f, sc, Y + (size_t)row * D + 256 + hh * 64, X.lane);
            } else { const int qh = hh - 4, n = qh >> 2; KeysSWA K; K.b = b; K.lo = max(t - 128, 0); K.nband = min(t + 128, SEQ - 1) - K.lo + 1;
                attn_row_naive(PB, row, PB_SQ + qh * 64, PB_SK + n * 64, PB_SV + n * 64, K, true, LOG2E * sink[qh], sc, Y + (size_t)row * D + 512 + qh * 64, X.lane); }
        } else { const int b = (row - NLAT) >> 8; KeysCtx K; K.b = b;
            if (hh < 4) attn_row_naive(PB, row, PB_NQ + hh * 64, PB_NK + hh * 64, PB_NV + hh * 64, K, false, 0.f, sc, Y + (size_t)row * D + 256 + hh * 64, X.lane);
            else { const int qh = hh - 4, n = qh >> 2; attn_row_naive(PB, row, PB_SQ + qh * 64, PB_SK + n * 64, PB_SV + n * 64, K, true, LOG2E * sink[qh], sc, Y + (size_t)row * D + 512 + qh * 64, X.lane); }
        }
    }
}
DI void ph_hgrn_naive(const Ctx& X, const Params& P, int l) {
    const bf16_t* PB = (const bf16_t*)(P.ws + WS_PB); const float* Z = (const float*)(P.ws + WS_Z); float* O32 = (float*)(P.ws + WS_S);
    const float* LB = (const float*)(P.ws + WS_LB) + l * 512;
    const int gw = X.bid * NWAVES + X.wave;
    if (gw >= 16) return;
    const int b = gw >> 3, h = (gw >> 1) & 3, dir = gw & 1, lane = X.lane;
    const float lb = LB[dir * 256 + h * 64 + lane];
    float S[64];
#pragma unroll
    for (int d = 0; d < 64; ++d) S[d] = 0.f;
    for (int step = 0; step < CTXL + SEQ; ++step) {
        int row;
        if (step < CTXL) row = NLAT + b * CTXL + (dir ? CTXL - 1 - step : step); else { const int t = step - CTXL; row = b * SEQ + (dir ? SEQ - 1 - t : t); }
        float f = exp2f(Z[(size_t)row * ZW + dir * 256 + h * 64 + lane]); const float kk = bf2f(((const bf16_t*)(P.ws + WS_KK))[(size_t)row * ZW + dir * 256 + h * 64 + lane]); (void)lb;
#if DBG_HG_MODE & 8
        f = 1.0f;
#endif
        const float qv = bf2f(PB[(size_t)row * PBW + PB_AQ + h * 64 + lane]), vv = bf2f(PB[(size_t)row * PBW + PB_AI + h * 64 + lane]);
#if DBG_HG_MODE & 1
        if ((step & 63) == 0) {
#pragma unroll
            for (int d = 0; d < 64; ++d) S[d] = 0.f; }
#endif
        float o = 0.f;
#pragma unroll
        for (int d = 0; d < 64; ++d) { const float fd = __builtin_bit_cast(float, __builtin_amdgcn_readlane(__builtin_bit_cast(int, f), d)), kd = __builtin_bit_cast(float, __builtin_amdgcn_readlane(__builtin_bit_cast(int, kk), d)), qd = __builtin_bit_cast(float, __builtin_amdgcn_readlane(__builtin_bit_cast(int, qv), d));
            S[d] = fd * S[d] + kd * vv; o += S[d] * qd; }
#if DBG_HG_MODE & 2
        if (dir == 1) o = 0.f;
#endif
#if DBG_HG_MODE & 4
        if (dir == 0) o = 0.f;
#endif
        O32[((size_t)dir * NROWS + row) * 256 + h * 64 + lane] = o;
    }
}
DI void ph_hgrn_combine_naive(const Ctx& X, const Params& P, int l) {
    const bf16_t* PB = (const bf16_t*)(P.ws + WS_PB); const float* O32 = (const float*)(P.ws + WS_S); bf16_t* Y = (bf16_t*)(P.ws + WS_Y);
    const float* nw = P.in[8] + l * 64;
    const int nrows = l == 0 ? NROWS : NLAT;
    const int gw = X.bid * NWAVES + X.wave, NGW = X.nb * NWAVES;
    for (int it = gw; it < nrows * 4; it += NGW) { const int row = it >> 2, h = it & 3;
        const float o = O32[(size_t)row * 256 + h * 64 + X.lane] + O32[((size_t)NROWS + row) * 256 + h * 64 + X.lane];
        const float ms = wave_sum(o * o) * (1.0f / 64.0f); const float y = o * (1.0f / sqrtf(ms + RMS_EPS)) * nw[X.lane];
        const float gte = bf2f(PB[(size_t)row * PBW + PB_AG + h * 64 + X.lane]);
        Y[(size_t)row * D + h * 64 + X.lane] = (bf16_t)f2bf(y * siluf_(gte)); }
}

typedef short v4i16_t __attribute__((ext_vector_type(4)));
DI s16x4 tr_read(const LAS unsigned char* p) { return __builtin_bit_cast(s16x4, __builtin_amdgcn_ds_read_tr16_b64_v4i16((LAS v4i16_t*)p)); }
DI bf16x8 cat8(s16x4 a, s16x4 b) { return __builtin_shufflevector(a, b, 0, 1, 2, 3, 4, 5, 6, 7); }
DI bf16x8 pack8(float a0, float a1, float a2, float a3, float a4, float a5, float a6, float a7) {
    u32x4 w; w.x = pk2(a0, a1); w.y = pk2(a2, a3); w.z = pk2(a4, a5); w.w = pk2(a6, a7); return __builtin_bit_cast(bf16x8, w); }
DI float shfl_f(float v, int src) { return __shfl(v, src); }

constexpr int HP = 144;
constexpr size_t WS_QT = WS_H, WS_KT = WS_H + (size_t)2 * NROWS * 256 * 2;
#ifdef DBG_MIX
constexpr size_t WS_ST = 318 * MiB;
#else
constexpr size_t WS_ST = WS_Z;
#endif
static_assert(WS_KT + (size_t)2 * NROWS * 256 * 2 <= WS_Y && (size_t)2112 * 4096 * 2 <= (size_t)NROWS * ZW * 4, "hgrn buffers");
DI void hgrn_chunk_rows(int b, int dir, int p, int& row0) {
    if (p < 4) row0 = NLAT + b * CTXL + 64 * (dir ? 3 - p : p); else row0 = b * SEQ + 64 * (dir ? 131 - p : p - 4);
}
DI void ph_hgrn_local(const Ctx& X, const Params& P, int l) {
    const bf16_t* PB = (const bf16_t*)(P.ws + WS_PB); const float* Z = (const float*)(P.ws + WS_Z);
    bf16_t* QT = (bf16_t*)(P.ws + WS_QT); bf16_t* KT = (bf16_t*)(P.ws + WS_KT); float* U = (float*)(P.ws + WS_S); float* DD = (float*)(P.ws + WS_DD); float* ER = DD + 2112 * 64;
    const float* LB = (const float*)(P.ws + WS_LB) + l * 512;
    LAS unsigned char* kt_l = X.lds + X.wave * (2 * 64 * HP); LAS unsigned char* v_l = kt_l + 64 * HP;
    const int lane = X.lane, gw = X.wave * X.nb + X.bid, NGW = X.nb * NWAVES;
    for (int it = gw; it < 2112; it += NGW) {
        const int p = it % NCHAIN, chain = it / NCHAIN, dir = chain & 1, h = (chain >> 1) & 3, b = chain >> 3;
        int row0; hgrn_chunk_rows(b, dir, p, row0);
#pragma unroll
        for (int i = 0; i < 8; ++i) { const int r = i * 8 + (lane >> 3), pc = lane & 7; const u32x4 w = *(const u32x4*)(PB + (size_t)(row0 + r) * PBW + PB_AI + h * 64 + pc * 8); *(LAS u32x4*)(v_l + r * HP + pc * 16) = w; }
        float lf[64];
        const float* zp = Z + (size_t)row0 * ZW + dir * 256 + h * 64 + lane;
#pragma unroll
        for (int s = 0; s < 64; ++s) lf[s] = zp[(size_t)s * ZW];
        float ref, last;
        if (dir == 0) {
#pragma unroll
            for (int s = 1; s < 64; ++s) lf[s] += lf[s - 1];
            ref = lf[31]; last = lf[63];
        } else {
#pragma unroll
            for (int s = 62; s >= 0; --s) lf[s] += lf[s + 1];
            ref = lf[32]; last = lf[0];
        }
        const bf16_t* qp = PB + (size_t)row0 * PBW + PB_AQ + h * 64 + lane; const bf16_t* kp = (const bf16_t*)(P.ws + WS_KK) + (size_t)row0 * ZW + dir * 256 + h * 64 + lane;
        bf16_t* qto = QT + ((size_t)dir * NROWS + row0) * 256 + h * 64 + lane; bf16_t* kto = KT + ((size_t)dir * NROWS + row0) * 256 + h * 64 + lane;
#pragma unroll
        for (int s = 0; s < 64; ++s) {
            const float q = bf2f(qp[(size_t)s * PBW]), kk = bf2f(kp[(size_t)s * ZW]);
            const float eq = __builtin_amdgcn_exp2f(lf[s] - ref), ek = __builtin_amdgcn_exp2f(ref - lf[s]);
            const unsigned short qb = (unsigned short)f2bf(q * eq), kb = (unsigned short)f2bf(kk * ek);
            qto[(size_t)s * 256] = qb; kto[(size_t)s * 256] = kb;
            *(LAS unsigned short*)(kt_l + s * HP + lane * 2) = kb;
        }
        asm volatile("" ::: "memory");
        const float e_lr = __builtin_amdgcn_exp2f(last - ref);
        DD[it * 64 + lane] = __builtin_amdgcn_exp2f(last); ER[it * 64 + lane] = __builtin_amdgcn_exp2f(ref);
        f32x4 acc[4][4];
#pragma unroll
        for (int m = 0; m < 4; ++m)
#pragma unroll
            for (int n = 0; n < 4; ++n) acc[m][n] = (f32x4){0.f, 0.f, 0.f, 0.f};
        const int g = lane >> 4, i16 = lane & 15;
        const int troff = (8 * g + (i16 >> 2)) * HP + (i16 & 3) * 8;
#pragma unroll
        for (int ks = 0; ks < 2; ++ks) {
            bf16x8 af[4], bfv[4];
#pragma unroll
            for (int m = 0; m < 4; ++m) af[m] = cat8(tr_read(kt_l + troff + ks * 32 * HP + m * 32), tr_read(kt_l + troff + (ks * 32 + 4) * HP + m * 32));
#pragma unroll
            for (int n = 0; n < 4; ++n) bfv[n] = cat8(tr_read(v_l + troff + ks * 32 * HP + n * 32), tr_read(v_l + troff + (ks * 32 + 4) * HP + n * 32));
#pragma unroll
            for (int m = 0; m < 4; ++m)
#pragma unroll
                for (int n = 0; n < 4; ++n) acc[m][n] = __builtin_amdgcn_mfma_f32_16x16x32_bf16(af[m], bfv[n], acc[m][n], 0, 0, 0);
        }
        float* up = U + (size_t)it * 4096;
#pragma unroll
        for (int m = 0; m < 4; ++m)
#pragma unroll
            for (int r = 0; r < 4; ++r) { const int d = 16 * m + 4 * g + r; const float sc = shfl_f(e_lr, d);
#pragma unroll
                for (int n = 0; n < 4; ++n) up[d * 64 + 16 * n + i16] = acc[m][n][r] * sc; }
        asm volatile("s_waitcnt lgkmcnt(0)" ::: "memory");
    }
}
DI void ph_hgrn_scan(const Ctx& X, const Params& P) {
    const float* U = (const float*)(P.ws + WS_S); const float* DD = (const float*)(P.ws + WS_DD); const float* ER = DD + 2112 * 64; bf16_t* ST = (bf16_t*)(P.ws + WS_ST);
    const int gt = X.bid * NTHREADS + X.tid;
    if (gt >= 32768) return;
    const int chain = gt >> 11, d = (gt >> 5) & 63, e2 = (gt & 31) * 2;
    float s0 = 0.f, s1 = 0.f;
    for (int p0 = 0; p0 < NCHAIN; p0 += 4) {
        f32x2 u[4]; float dd[4], er[4];
#pragma unroll
        for (int j = 0; j < 4; ++j) { const int slot = chain * NCHAIN + p0 + j; u[j] = *(const f32x2*)(U + (size_t)slot * 4096 + d * 64 + e2); dd[j] = DD[slot * 64 + d]; er[j] = ER[slot * 64 + d]; }
#pragma unroll
        for (int j = 0; j < 4; ++j) { const int slot = chain * NCHAIN + p0 + j; *(unsigned*)(ST + (size_t)slot * 4096 + d * 64 + e2) = pk2(s0 * er[j], s1 * er[j]); s0 = dd[j] * s0 + u[j][0]; s1 = dd[j] * s1 + u[j][1]; }
    }
}
DI void ph_hgrn_out(const Ctx& X, const Params& P, int l) {
    const bf16_t* PB = (const bf16_t*)(P.ws + WS_PB); const bf16_t* QT = (const bf16_t*)(P.ws + WS_QT); const bf16_t* KT = (const bf16_t*)(P.ws + WS_KT); const bf16_t* ST = (const bf16_t*)(P.ws + WS_ST);
    bf16_t* Y = (bf16_t*)(P.ws + WS_Y); const float* nw = P.in[8] + l * 64;
    LAS unsigned char* s_l = X.lds + X.wave * (2 * 64 * HP); LAS unsigned char* v_l = s_l + 64 * HP;
    const int lane = X.lane, g = lane >> 4, i16 = lane & 15, gw = X.wave * X.nb + X.bid, NGW = X.nb * NWAVES;
    const int nchunk = l == 0 ? 132 : 128;
    const int troff = (8 * g + (i16 >> 2)) * HP + (i16 & 3) * 8;
    const int troff4 = (4 * g + (i16 >> 2)) * HP + (i16 & 3) * 8;
    for (int it = gw; it < 8 * nchunk; it += NGW) {
        const int c = it % nchunk, bh = it / nchunk, h = bh & 3, b = bh >> 2;
        const bool isctx = c >= 128; const int row0 = isctx ? NLAT + b * CTXL + 64 * (c - 128) : b * SEQ + 64 * c;
#pragma unroll
        for (int i = 0; i < 8; ++i) { const int r = i * 8 + (lane >> 3), pc = lane & 7; const u32x4 w = *(const u32x4*)(PB + (size_t)(row0 + r) * PBW + PB_AI + h * 64 + pc * 8); *(LAS u32x4*)(v_l + r * HP + pc * 16) = w; }
        f32x4 o[4][4];
#pragma unroll
        for (int a = 0; a < 4; ++a)
#pragma unroll
            for (int t = 0; t < 4; ++t) o[a][t] = (f32x4){0.f, 0.f, 0.f, 0.f};
#pragma unroll 1
        for (int dir = 0; dir < 2; ++dir) {
#if DBG_HG_MODE & 2
            if (dir == 1) continue;
#endif
#if DBG_HG_MODE & 4
            if (dir == 0) continue;
#endif
            const int p = isctx ? (dir ? 3 - (c - 128) : c - 128) : (dir ? 127 - c + 4 : c + 4);
            const int slot = ((b * 4 + h) * 2 + dir) * NCHAIN + p, sgn = 1 - 2 * dir;
            asm volatile("s_waitcnt lgkmcnt(0)" ::: "memory");
#pragma unroll
            for (int i = 0; i < 8; ++i) { const int r = i * 8 + (lane >> 3), pc = lane & 7; const u32x4 w = *(const u32x4*)(ST + (size_t)slot * 4096 + r * 64 + pc * 8); *(LAS u32x4*)(s_l + r * HP + pc * 16) = w; }
            const bf16_t* qt = QT + ((size_t)dir * NROWS + row0) * 256 + h * 64 + g * 8; const bf16_t* kt = KT + ((size_t)dir * NROWS + row0) * 256 + h * 64 + g * 8;
            bf16x8 qf[4][2];
#pragma unroll
            for (int t = 0; t < 4; ++t)
#pragma unroll
                for (int ks = 0; ks < 2; ++ks) qf[t][ks] = *(const bf16x8*)(qt + (size_t)(16 * t + i16) * 256 + 32 * ks);
#pragma unroll
            for (int pr = 0; pr < 2; ++pr) {
                bf16x8 kf[2][2];
#pragma unroll
                for (int t = 0; t < 2; ++t)
#pragma unroll
                    for (int ks = 0; ks < 2; ++ks) kf[t][ks] = *(const bf16x8*)(kt + (size_t)(16 * (2 * pr + t) + i16) * 256 + 32 * ks);
                f32x4 sc[2][4];
#pragma unroll
                for (int s2 = 0; s2 < 2; ++s2)
#pragma unroll
                    for (int tt = 0; tt < 4; ++tt) { f32x4 a = {0.f, 0.f, 0.f, 0.f};
                        a = __builtin_amdgcn_mfma_f32_16x16x32_bf16(kf[s2][0], qf[tt][0], a, 0, 0, 0); a = __builtin_amdgcn_mfma_f32_16x16x32_bf16(kf[s2][1], qf[tt][1], a, 0, 0, 0);
#pragma unroll
                        for (int r = 0; r < 4; ++r) { const int sidx = 16 * (2 * pr + s2) + 4 * g + r, tidx = 16 * tt + i16; const int keep = ~(((tidx - sidx) * sgn) >> 31); { const float av = a[r]; a[r] = __int_as_float(__float_as_int(av) & keep); } }
                        sc[s2][tt] = a; }
                bf16x8 vf[4];
#pragma unroll
#ifdef DBG_NO_TR
                for (int et = 0; et < 4; ++et) { unsigned short tv[8];
#pragma unroll
                    for (int j = 0; j < 8; ++j) { const int sidx = 32 * pr + (j < 4 ? 4 * g + j : 16 + 4 * g + (j - 4)); tv[j] = *(const LAS unsigned short*)(v_l + sidx * HP + (16 * et + i16) * 2); }
                    u32x4 w; w.x = tv[0] | ((unsigned)tv[1] << 16); w.y = tv[2] | ((unsigned)tv[3] << 16); w.z = tv[4] | ((unsigned)tv[5] << 16); w.w = tv[6] | ((unsigned)tv[7] << 16); vf[et] = __builtin_bit_cast(bf16x8, w); }
#else
                for (int et = 0; et < 4; ++et) vf[et] = cat8(tr_read(v_l + troff4 + (32 * pr) * HP + et * 32), tr_read(v_l + troff4 + (32 * pr + 16) * HP + et * 32));
#endif
#ifdef DBG_BRUTE
                {   float* dacc = (float*)(P.ws + WS_CTL) + CW_DBG + 16; float nA = 0.f, dA = 0.f, nB = 0.f, dB = 0.f;
                    const bf16_t* qt0 = QT + ((size_t)dir * NROWS + row0) * 256 + h * 64; const bf16_t* kt0 = KT + ((size_t)dir * NROWS + row0) * 256 + h * 64;
#if DBG_TEST == 1
#pragma unroll
                    for (int s2 = 0; s2 < 2; ++s2)
#pragma unroll
                        for (int tt = 0; tt < 4; ++tt)
#pragma unroll
                            for (int r = 0; r < 4; ++r) *(LAS float*)(s_l + (((s2 * 4 + tt) * 4 + r) * 64 + lane) * 4) = sc[s2][tt][r];
                    asm volatile("s_waitcnt lgkmcnt(0)" ::: "memory");
#pragma unroll 1
                    for (int idx = 0; idx < 32; ++idx) { const int s2 = idx >> 4, tt = (idx >> 2) & 3, r = idx & 3; const int sidx = 16 * (2 * pr + s2) + 4 * g + r, tidx = 16 * tt + i16; float ref = 0.f;
#pragma unroll 1
                        for (int d = 0; d < 64; ++d) ref += bf2f(kt0[(size_t)sidx * 256 + d]) * bf2f(qt0[(size_t)tidx * 256 + d]);
                        if (sidx > tidx) ref = 0.f; const float got = *(LAS float*)(s_l + (idx * 64 + lane) * 4); const float df = got - ref; nA += df * df; dA += ref * ref; }
#endif
#if DBG_TEST == 2
#pragma unroll
                    for (int et = 0; et < 4; ++et)
#pragma unroll
                        for (int j = 0; j < 8; ++j) { const int sidx = 32 * pr + (j < 4 ? 4 * g + j : 16 + 4 * g + (j - 4)); const float ref = bf2f(PB[(size_t)(row0 + sidx) * PBW + PB_AI + h * 64 + 16 * et + i16]);
                            const float got = bf2f((unsigned short)vf[et][j]); const float df = got - ref; nB += df * df; dB += ref * ref; asm volatile("" : "+v"(nB), "+v"(dB) :: "memory"); }
#endif
                    nA = wave_sum(nA); dA = wave_sum(dA); nB = wave_sum(nB); dB = wave_sum(dB); if (lane == 0) { atomicAdd(dacc, nA); atomicAdd(dacc + 1, dA); atomicAdd(dacc + 2, nB); atomicAdd(dacc + 3, dB); }
                }
#endif
#pragma unroll
                for (int tt = 0; tt < 4; ++tt) { const f32x4 p0 = sc[0][tt], p1 = sc[1][tt]; const bf16x8 pf = pack8(p0[0], p0[1], p0[2], p0[3], p1[0], p1[1], p1[2], p1[3]);
#pragma unroll
                    for (int et = 0; et < 4; ++et) o[et][tt] = __builtin_amdgcn_mfma_f32_16x16x32_bf16(vf[et], pf, o[et][tt], 0, 0, 0); }
                asm volatile("" ::: "memory");
            }
#pragma unroll
            for (int ks = 0; ks < ((DBG_HG_MODE & 1) ? 0 : 2); ++ks) {
                bf16x8 sf[4];
#pragma unroll
                for (int et = 0; et < 4; ++et) sf[et] = cat8(tr_read(s_l + troff + (32 * ks) * HP + et * 32), tr_read(s_l + troff + (32 * ks + 4) * HP + et * 32));
#pragma unroll
                for (int tt = 0; tt < 4; ++tt)
#pragma unroll
                    for (int et = 0; et < 4; ++et) o[et][tt] = __builtin_amdgcn_mfma_f32_16x16x32_bf16(sf[et], qf[tt][ks], o[et][tt], 0, 0, 0);
            }
        }
#if defined(DBG_BRUTE) && DBG_TEST == 3
        {
            float* dacc = (float*)(P.ws + WS_CTL) + CW_DBG + 8; float num = 0.f, den = 0.f;
            const bf16_t* qt0 = QT + ((size_t)0 * NROWS + row0) * 256 + h * 64; const bf16_t* kt0 = KT + ((size_t)0 * NROWS + row0) * 256 + h * 64;
            for (int tt = 0; tt < 4; ++tt) for (int et = 0; et < 4; ++et) for (int r = 0; r < 4; ++r) {
                const int t = 16 * tt + i16, e = 16 * et + 4 * g + r; float ref = 0.f;
                for (int s2 = 0; s2 <= t; ++s2) { float sc = 0.f; for (int d = 0; d < 64; ++d) sc += bf2f(kt0[(size_t)s2 * 256 + d]) * bf2f(qt0[(size_t)t * 256 + d]);
                    ref += bf2f((unsigned short)f2bf(sc)) * bf2f(PB[(size_t)(row0 + s2) * PBW + PB_AI + h * 64 + e]); }
                float got = 0.f;
#pragma unroll
                for (int a = 0; a < 4; ++a)
#pragma unroll
                    for (int b2 = 0; b2 < 4; ++b2)
#pragma unroll
                        for (int c2 = 0; c2 < 4; ++c2) if (a == tt && b2 == et && c2 == r) got = o[b2][a][c2];
                num += (got - ref) * (got - ref); den += ref * ref; }
            num = wave_sum(num); den = wave_sum(den); if (lane == 0) { atomicAdd(dacc, num); atomicAdd(dacc + 1, den); }
        }
#endif
#pragma unroll
        for (int tt = 0; tt < 4; ++tt) {
            float ss = 0.f;
#pragma unroll
            for (int et = 0; et < 4; ++et) ss += (o[et][tt][0] * o[et][tt][0] + o[et][tt][1] * o[et][tt][1]) + (o[et][tt][2] * o[et][tt][2] + o[et][tt][3] * o[et][tt][3]);
            ss += __shfl_xor(ss, 16); ss += __shfl_xor(ss, 32);
            const float rstd = 1.0f / sqrtf(ss * (1.0f / 64.0f) + RMS_EPS);
            const size_t row = (size_t)row0 + 16 * tt + i16;
#pragma unroll
            for (int et = 0; et < 4; ++et) { const int e = 16 * et + 4 * g; const u32x2 gw2 = *(const u32x2*)(PB + row * PBW + PB_AG + h * 64 + e); const f32x4 wv = *(const f32x4*)(nw + e);
                const f32x4 gt = {bflo(gw2.x), bfhi(gw2.x), bflo(gw2.y), bfhi(gw2.y)}; f32x4 y;
#pragma unroll
                for (int r = 0; r < 4; ++r) y[r] = o[et][tt][r] * rstd * wv[r] * siluf_(gt[r]);
                store_bf4(Y + row * D + h * 64 + e, y); }
        }
        asm volatile("s_waitcnt lgkmcnt(0)" ::: "memory");
    }
}


#ifdef DBG_BRUTE
DI void ph_dbg_scores(const Ctx& X, const Params& P, int l) {
    const bf16_t* QT = (const bf16_t*)(P.ws + WS_QT); const bf16_t* KT = (const bf16_t*)(P.ws + WS_KT);
    LAS unsigned char* s_l = X.lds + X.wave * (2 * 64 * HP);
    const int lane = X.lane, g = lane >> 4, i16 = lane & 15, gw = X.wave * X.nb + X.bid, NGW = X.nb * NWAVES;
    float* dacc = (float*)(P.ws + WS_CTL) + CW_DBG + 16; float nA = 0.f, dA = 0.f;
    for (int it = gw; it < 8 * 128; it += NGW) {
        const int c = it % 128, bh = it / 128, h = bh & 3, b = bh >> 2, dir = 0, sgn = 1; const int row0 = b * SEQ + 64 * c;
        const bf16_t* qt = QT + ((size_t)dir * NROWS + row0) * 256 + h * 64 + g * 8; const bf16_t* kt = KT + ((size_t)dir * NROWS + row0) * 256 + h * 64 + g * 8;
        const bf16_t* qt0 = QT + ((size_t)dir * NROWS + row0) * 256 + h * 64; const bf16_t* kt0 = KT + ((size_t)dir * NROWS + row0) * 256 + h * 64;
        bf16x8 qf[4][2];
#pragma unroll
        for (int t = 0; t < 4; ++t)
#pragma unroll
            for (int ks = 0; ks < 2; ++ks) qf[t][ks] = *(const bf16x8*)(qt + (size_t)(16 * t + i16) * 256 + 32 * ks);
#pragma unroll 1
        for (int pr = 0; pr < 2; ++pr) {
            bf16x8 kf[2][2];
#pragma unroll
            for (int t = 0; t < 2; ++t)
#pragma unroll
                for (int ks = 0; ks < 2; ++ks) kf[t][ks] = *(const bf16x8*)(kt + (size_t)(16 * (2 * pr + t) + i16) * 256 + 32 * ks);
#pragma unroll
            for (int s2 = 0; s2 < 2; ++s2)
#pragma unroll
                for (int tt = 0; tt < 4; ++tt) { f32x4 a = {0.f, 0.f, 0.f, 0.f};
                    a = __builtin_amdgcn_mfma_f32_16x16x32_bf16(kf[s2][0], qf[tt][0], a, 0, 0, 0); a = __builtin_amdgcn_mfma_f32_16x16x32_bf16(kf[s2][1], qf[tt][1], a, 0, 0, 0);
#pragma unroll
                    for (int r = 0; r < 4; ++r) { const int sidx = 16 * (2 * pr + s2) + 4 * g + r, tidx = 16 * tt + i16; const int keep = ~(((tidx - sidx) * sgn) >> 31); { const float av = a[r]; a[r] = __int_as_float(__float_as_int(av) & keep); }
                        *(LAS float*)(s_l + (((s2 * 4 + tt) * 4 + r) * 64 + lane) * 4) = a[r]; } }
            asm volatile("s_waitcnt lgkmcnt(0)" ::: "memory");
#pragma unroll 1
            for (int idx = 0; idx < 32; ++idx) { const int s2 = idx >> 4, tt = (idx >> 2) & 3, r = idx & 3; const int sidx = 16 * (2 * pr + s2) + 4 * g + r, tidx = 16 * tt + i16; float ref = 0.f;
#pragma unroll 1
                for (int d = 0; d < 64; ++d) ref += bf2f(kt0[(size_t)sidx * 256 + d]) * bf2f(qt0[(size_t)tidx * 256 + d]);
                if (sidx > tidx) ref = 0.f; const float got = *(LAS float*)(s_l + (idx * 64 + lane) * 4); const float df = got - ref; nA += df * df; dA += ref * ref; }
            asm volatile("s_waitcnt lgkmcnt(0)" ::: "memory");
        }
    }
    nA = wave_sum(nA); dA = wave_sum(dA); if (lane == 0) { atomicAdd(dacc, nA); atomicAdd(dacc + 1, dA); }
}
#endif
constexpr int KP = 144, VP = 192, KBYTES = 128 * KP, VBYTES = 128 * VP, CHB = KBYTES + VBYTES, RPB_OFF = 2 * CHB;
static_assert(RPB_OFF + 4096 <= 144 * 1024, "attn lds");
struct ChunkSrc { int mode, rbase, kr0; };
DI int chunk_row(const ChunkSrc& c, int key) { return c.mode == 0 ? c.rbase + key : c.rbase + min(c.kr0 + (key >> 5), 127) * 64 + (key & 31); }
struct StageRegs { u32x4 k[2], v[2]; };
DI void stage_load(const Ctx& X, const bf16_t* PB, int kcol, int vcol, const ChunkSrc& c, StageRegs& R) {
#pragma unroll
    for (int i = 0; i < 2; ++i) { const int idx = X.tid + NTHREADS * i, key = idx >> 3, pc = idx & 7; const size_t row = (size_t)chunk_row(c, key);
        R.k[i] = *(const u32x4*)(PB + row * PBW + kcol + pc * 8); R.v[i] = *(const u32x4*)(PB + row * PBW + vcol + pc * 8); }
}
DI void stage_store(const Ctx& X, LAS unsigned char* buf, const StageRegs& R) {
#pragma unroll
    for (int i = 0; i < 2; ++i) { const int idx = X.tid + NTHREADS * i, key = idx >> 3, pc = idx & 7;
        *(LAS u32x4*)(buf + key * KP + pc * 16) = R.k[i]; *(LAS u32x4*)(buf + KBYTES + key * VP + pc * 16) = R.v[i]; }
}
template <int NQT> struct AttnState { f32x16 o[NQT][2]; float m[NQT], l[NQT]; };
template <int NQT, class MaskF>
DI void attn_tile(const LAS unsigned char* buf, int kt, const bf16x8 (&qf)[NQT][4], AttnState<NQT>& S, const bool (&act)[NQT], const MaskF& MF, int lane) {
    const int h = lane >> 5, G = lane >> 4, i16 = lane & 15;
    bf16x8 kf[4];
#pragma unroll
    for (int ks = 0; ks < 4; ++ks) kf[ks] = *(const LAS bf16x8*)(buf + (32 * kt + (lane & 31)) * KP + ks * 32 + h * 16);
    const LAS unsigned char* vb = buf + KBYTES + (32 * kt + 4 * h + (i16 >> 2)) * VP + (16 * (G & 1) + 4 * (i16 & 3)) * 2;
    bf16x8 vf[2][2];
#pragma unroll
    for (int db = 0; db < 2; ++db)
#pragma unroll
        for (int s2 = 0; s2 < 2; ++s2) vf[db][s2] = cat8(tr_read(vb + (16 * s2) * VP + db * 64), tr_read(vb + (16 * s2 + 8) * VP + db * 64));
#pragma unroll
    for (int qt = 0; qt < NQT; ++qt) {
        if (!act[qt]) continue;
        f32x16 s;
#pragma unroll
        for (int r = 0; r < 16; ++r) s[r] = 0.f;
#pragma unroll
        for (int ks = 0; ks < 4; ++ks) s = __builtin_amdgcn_mfma_f32_32x32x16_bf16(kf[ks], qf[qt][ks], s, 0, 0, 0);
        MF(s, qt, kt);
        float mx = s[0];
#pragma unroll
        for (int r = 1; r < 16; ++r) mx = fmaxf(mx, s[r]);
        mx = fmaxf(mx, __shfl_xor(mx, 32));
        const float mn = fmaxf(S.m[qt], mx), alpha = __builtin_amdgcn_exp2f(S.m[qt] - mn); S.m[qt] = mn;
        float ps = 0.f;
#pragma unroll
        for (int r = 0; r < 16; ++r) { s[r] = __builtin_amdgcn_exp2f(s[r] - mn); ps += s[r]; }
        S.l[qt] = S.l[qt] * alpha + ps;
#pragma unroll
        for (int db = 0; db < 2; ++db)
#pragma unroll
            for (int r = 0; r < 16; ++r) S.o[qt][db][r] *= alpha;
        const bf16x8 p0 = pack8(s[0], s[1], s[2], s[3], s[4], s[5], s[6], s[7]), p1 = pack8(s[8], s[9], s[10], s[11], s[12], s[13], s[14], s[15]);
#pragma unroll
        for (int db = 0; db < 2; ++db) { S.o[qt][db] = __builtin_amdgcn_mfma_f32_32x32x16_bf16(vf[db][0], p0, S.o[qt][db], 0, 0, 0); S.o[qt][db] = __builtin_amdgcn_mfma_f32_32x32x16_bf16(vf[db][1], p1, S.o[qt][db], 0, 0, 0); }
    }
}
template <int NQT>
DI void attn_finish(AttnState<NQT>& S, int qt, bf16_t* yrow  , int lane) {
    const int h = lane >> 5; float l = S.l[qt]; l += __shfl_xor(l, 32); const float inv = 1.0f / l;
#pragma unroll
    for (int db = 0; db < 2; ++db)
#pragma unroll
        for (int gq = 0; gq < 4; ++gq) store_bf4(yrow + 32 * db + 8 * gq + 4 * h, (f32x4){S.o[qt][db][4 * gq] * inv, S.o[qt][db][4 * gq + 1] * inv, S.o[qt][db][4 * gq + 2] * inv, S.o[qt][db][4 * gq + 3] * inv});
}
struct MaskNone { DI void operator()(f32x16&, int, int) const {} };
struct MaskSWA { int cmode, u0, lane;
    DI void operator()(f32x16& s, int qt, int kt) const {
        if (cmode == 1) return;
        const int u = u0 + 32 * qt + (lane & 31), kb = 32 * kt + 4 * (lane >> 5);
#pragma unroll
        for (int r = 0; r < 16; ++r) { const int k = kb + (r & 3) + 8 * (r >> 2); const bool ok = cmode == 0 ? k >= u : k <= u; s[r] = ok ? s[r] : -1e30f; }
    } };
DI void ph_swa(const Ctx& X, const Params& P, int l) {
    const bf16_t* PB = (const bf16_t*)(P.ws + WS_PB); bf16_t* Y = (bf16_t*)(P.ws + WS_Y); const float* sink = P.in[10] + l * 8;
    const int lane = X.lane, w = X.wave;
    for (int it = X.bid; it < 256; it += X.nb) {
        const int j = it & 63, n = (it >> 6) & 1, b = it >> 7;
        const int qh = n * 4 + (w >> 1), u0 = (w & 1) * 64;
        const int nchunks = 3 + (j > 0) + (j < 63);
        bf16x8 qf[2][4];
#pragma unroll
        for (int qt = 0; qt < 2; ++qt)
#pragma unroll
            for (int ks = 0; ks < 4; ++ks) qf[qt][ks] = *(const bf16x8*)(PB + (size_t)(b * SEQ + 128 * j + u0 + 32 * qt + (lane & 31)) * PBW + PB_SQ + qh * 64 + 16 * ks + 8 * (lane >> 5));
        AttnState<2> S;
#pragma unroll
        for (int qt = 0; qt < 2; ++qt) { S.m[qt] = LOG2E * sink[qh]; S.l[qt] = lane < 32 ? 1.0f : 0.0f;
#pragma unroll
            for (int db = 0; db < 2; ++db)
#pragma unroll
                for (int r = 0; r < 16; ++r) S.o[qt][db][r] = 0.f; }
        StageRegs R;
        auto chunk_id = [&](int i) -> int { return i < 2 ? 3 + i : (i == 2 ? 1 : (i == 3 ? (j > 0 ? 0 : 2) : 2)); };
        auto chunk_src = [&](int c) -> ChunkSrc { ChunkSrc cs; cs.mode = 0; cs.kr0 = 0; cs.rbase = c < 3 ? b * SEQ + 128 * (j - 1 + c) : NLAT + b * CTXL + 128 * (c - 3); return cs; };
        stage_load(X, PB, PB_SK + n * 64, PB_SV + n * 64, chunk_src(chunk_id(0)), R); stage_store(X, X.lds, R);
        __syncthreads();
        for (int i = 0; i < nchunks; ++i) {
            const int c = chunk_id(i);
            if (i + 1 < nchunks) stage_load(X, PB, PB_SK + n * 64, PB_SV + n * 64, chunk_src(chunk_id(i + 1)), R);
            const LAS unsigned char* buf = X.lds + (i & 1) * CHB;
            MaskSWA MF; MF.cmode = c == 0 ? 0 : (c == 2 ? 2 : 1); MF.u0 = u0; MF.lane = lane;
#pragma unroll 1
            for (int kt = 0; kt < 4; ++kt) {
                bool act[2];
#pragma unroll
                for (int qt = 0; qt < 2; ++qt) act[qt] = c == 0 ? (32 * kt + 31 >= u0 + 32 * qt) : (c == 2 ? (32 * kt <= u0 + 32 * qt + 31) : true);
                if (!(act[0] || act[1])) continue;
                attn_tile<2>(buf, kt, qf, S, act, MF, lane);
            }
            if (i + 1 < nchunks) stage_store(X, X.lds + ((i + 1) & 1) * CHB, R);
            __syncthreads();
        }
#pragma unroll
        for (int qt = 0; qt < 2; ++qt) attn_finish<2>(S, qt, Y + (size_t)(b * SEQ + 128 * j + u0 + 32 * qt + (lane & 31)) * D + 512 + qh * 64, lane);
    }
}
struct MaskNA { bool win; int kr0, qr, qc, rs, cs, blk, lane; const LAS float* rpb;
    DI void operator()(f32x16& s, int qt, int kt) const {
        if (!win) return;
        const int kr = kr0 + kt; const bool rowok = kr >= rs && kr < rs + 8;
        const int kcb = blk + 4 * (lane >> 5); const int ib = rowok ? (kr - qr + 7) * 31 + (kcb - qc + 15) : 0;
#pragma unroll
        for (int r = 0; r < 16; ++r) { const int off = (r & 3) + 8 * (r >> 2); const int kc = kcb + off; const bool ok = rowok && kc >= cs && kc < cs + 16;
            const float bias = rpb[ib + off]; s[r] = ok ? s[r] + bias : -1e30f; }
    } };
DI void ph_na(const Ctx& X, const Params& P, int l) {
    const bf16_t* PB = (const bf16_t*)(P.ws + WS_PB); bf16_t* Y = (bf16_t*)(P.ws + WS_Y); const float* rpbg = P.in[9] + l * 4 * 465;
    const int lane = X.lane, w = X.wave; LAS float* rpbl = (LAS float*)(X.lds + RPB_OFF) + 32;
    for (int it = X.bid; it < 256; it += X.nb) {
        const int j = it & 3, rg = (it >> 2) & 7, h = (it >> 5) & 3, b = it >> 7;
        const int r0 = 16 * rg, blk = min(max(16 * j - 8, 0), 32);
        const int kr_lo = min(max(r0 - 4, 0), 120), kr_hi = min(max(r0 + 15 - 4, 0), 120) + 7, nwc = (kr_hi - kr_lo + 4) >> 2, nchunks = 2 + nwc;
        const int ra = r0 + 2 * w, qr = ra + ((lane & 31) >> 4), qc = 16 * j + (lane & 15);
        const int rs_a = min(max(ra - 4, 0), 120), rs_b = min(max(ra + 1 - 4, 0), 120);
        for (int i = X.tid; i < 465; i += NTHREADS) rpbl[i] = LOG2E * rpbg[h * 465 + i];
        bf16x8 qf[1][4];
#pragma unroll
        for (int ks = 0; ks < 4; ++ks) qf[0][ks] = *(const bf16x8*)(PB + (size_t)(b * SEQ + qr * 64 + qc) * PBW + PB_NQ + h * 64 + 16 * ks + 8 * (lane >> 5));
        AttnState<1> S; S.m[0] = -1e30f; S.l[0] = 0.f;
#pragma unroll
        for (int db = 0; db < 2; ++db)
#pragma unroll
            for (int r = 0; r < 16; ++r) S.o[0][db][r] = 0.f;
        StageRegs R;
        auto chunk_src = [&](int i) -> ChunkSrc { ChunkSrc cs; if (i < 2) { cs.mode = 0; cs.kr0 = 0; cs.rbase = NLAT + b * CTXL + 128 * i; } else { cs.mode = 1; cs.kr0 = kr_lo + 4 * (i - 2); cs.rbase = b * SEQ + blk; } return cs; };
        stage_load(X, PB, PB_NK + h * 64, PB_NV + h * 64, chunk_src(0), R); stage_store(X, X.lds, R);
        __syncthreads();
        MaskNA MF; MF.qr = qr; MF.qc = qc; MF.rs = min(max(qr - 4, 0), 120); MF.cs = min(max(qc - 8, 0), 48); MF.blk = blk; MF.lane = lane; MF.rpb = rpbl;
        for (int i = 0; i < nchunks; ++i) {
            if (i + 1 < nchunks) stage_load(X, PB, PB_NK + h * 64, PB_NV + h * 64, chunk_src(i + 1), R);
            const LAS unsigned char* buf = X.lds + (i & 1) * CHB;
            MF.win = i >= 2; MF.kr0 = kr_lo + 4 * (i - 2);
#pragma unroll 1
            for (int kt = 0; kt < 4; ++kt) {
                bool act[1]; act[0] = true;
                if (i >= 2) { const int kr = MF.kr0 + kt; if (kr < rs_a || kr > rs_b + 7) continue; }
                attn_tile<1>(buf, kt, qf, S, act, MF, lane);
            }
            if (i + 1 < nchunks) stage_store(X, X.lds + ((i + 1) & 1) * CHB, R);
            __syncthreads();
        }
        attn_finish<1>(S, 0, Y + (size_t)(b * SEQ + qr * 64 + qc) * D + 256 + h * 64, lane);
    }
}
DI void ph_attn_ctx(const Ctx& X, const Params& P, int l) {
    if (l != 0) return;
    const bf16_t* PB = (const bf16_t*)(P.ws + WS_PB); bf16_t* Y = (bf16_t*)(P.ws + WS_Y); const float* sink = P.in[10] + l * 8;
    const int lane = X.lane, w = X.wave;
    for (int it0 = X.bid; it0 < 16; it0 += X.nb) {
        const int it = it0;
        const bool swa = it >= 8; const int b = (it >> 2) & 1;
        const int h = it & 3, n = (it >> 1) & 1, half = it & 1;
        const int kcol = swa ? PB_SK + n * 64 : PB_NK + h * 64, vcol = swa ? PB_SV + n * 64 : PB_NV + h * 64;
        StageRegs R; ChunkSrc cs; cs.mode = 0; cs.kr0 = 0; cs.rbase = NLAT + b * CTXL;
        stage_load(X, PB, kcol, vcol, cs, R); stage_store(X, X.lds, R);
        cs.rbase += 128; stage_load(X, PB, kcol, vcol, cs, R); stage_store(X, X.lds + CHB, R);
        __syncthreads();
        const MaskNone MF;
        if (!swa) {
            const int qrow = NLAT + b * CTXL + 32 * w + (lane & 31);
            bf16x8 qf[1][4];
#pragma unroll
            for (int ks = 0; ks < 4; ++ks) qf[0][ks] = *(const bf16x8*)(PB + (size_t)qrow * PBW + PB_NQ + h * 64 + 16 * ks + 8 * (lane >> 5));
            AttnState<1> S; S.m[0] = -1e30f; S.l[0] = 0.f;
#pragma unroll
            for (int db = 0; db < 2; ++db)
#pragma unroll
                for (int r = 0; r < 16; ++r) S.o[0][db][r] = 0.f;
            const bool act[1] = {true};
#pragma unroll 1
            for (int kt = 0; kt < 8; ++kt) attn_tile<1>(X.lds + (kt >> 2) * CHB, kt & 3, qf, S, act, MF, lane);
            attn_finish<1>(S, 0, Y + (size_t)qrow * D + 256 + h * 64, lane);
        } else {
            const int qh = n * 4 + half * 2 + (w >> 2), q0 = NLAT + b * CTXL + (w & 3) * 64 + (lane & 31);
            bf16x8 qf[2][4];
#pragma unroll
            for (int qt = 0; qt < 2; ++qt)
#pragma unroll
                for (int ks = 0; ks < 4; ++ks) qf[qt][ks] = *(const bf16x8*)(PB + (size_t)(q0 + 32 * qt) * PBW + PB_SQ + qh * 64 + 16 * ks + 8 * (lane >> 5));
            AttnState<2> S;
#pragma unroll
            for (int qt = 0; qt < 2; ++qt) { S.m[qt] = LOG2E * sink[qh]; S.l[qt] = lane < 32 ? 1.0f : 0.0f;
#pragma unroll
                for (int db = 0; db < 2; ++db)
#pragma unroll
                    for (int r = 0; r < 16; ++r) S.o[qt][db][r] = 0.f; }
            const bool act[2] = {true, true};
#pragma unroll 1
            for (int kt = 0; kt < 8; ++kt) attn_tile<2>(X.lds + (kt >> 2) * CHB, kt & 3, qf, S, act, MF, lane);
#pragma unroll
            for (int qt = 0; qt < 2; ++qt) attn_finish<2>(S, qt, Y + (size_t)(q0 + 32 * qt) * D + 512 + qh * 64, lane);
        }
        __syncthreads();
    }
}

constexpr size_t WS_Y2 = 284 * MiB;
DI void ph_dbg_copy(const Ctx& X, const Params& P) {
    const u32x4* src = (const u32x4*)(P.ws + WS_Y); u32x4* dst = (u32x4*)(P.ws + WS_Y2);
    for (size_t i = (size_t)X.bid * NTHREADS + X.tid; i < (size_t)NROWS * 128; i += (size_t)X.nb * NTHREADS) dst[i] = src[i];
}
DI void ph_dbg_compare(const Ctx& X, const Params& P) {
    const bf16_t* Yg = (const bf16_t*)(P.ws + WS_Y); const bf16_t* Yf = (const bf16_t*)(P.ws + WS_Y2); float* acc = (float*)(P.ws + WS_CTL) + CW_DBG;
    float num[3] = {0.f, 0.f, 0.f}, den[3] = {0.f, 0.f, 0.f};
    const int gw = X.bid * NWAVES + X.wave, NGW = X.nb * NWAVES;
    for (int row = gw; row < NROWS; row += NGW) {
#pragma unroll
        for (int j = 0; j < 16; ++j) { const int c = j * 64 + X.lane; const float a = bf2f(Yg[(size_t)row * D + c]), b = bf2f(Yf[(size_t)row * D + c]); const float d = a - b;
            const int br = j < 4 ? 0 : (j < 8 ? 1 : 2);
            if (br == 0) { num[0] += d * d; den[0] += a * a; } else if (br == 1) { num[1] += d * d; den[1] += a * a; } else { num[2] += d * d; den[2] += a * a; } }
    }
#pragma unroll
    for (int b = 0; b < 3; ++b) { const float n = wave_sum(num[b]), d = wave_sum(den[b]); if (X.lane == 0) { atomicAdd(acc + 2 * b, n); atomicAdd(acc + 2 * b + 1, d); } }
}
DI void ph_dbg_apply(const Ctx& X, const Params& P) {
    const float* acc = (const float*)(P.ws + WS_CTL) + CW_DBG;
#ifdef DBG_BRUTE
    float code = sqrtf(acc[16] / acc[17]);
#else
    float code = sqrtf(acc[0] / acc[1]);
#endif
    if (code == 0.f) return;
    f32x4* o = (f32x4*)P.out;
    for (size_t i = (size_t)X.bid * NTHREADS + X.tid; i < (size_t)NLAT * 256; i += (size_t)X.nb * NTHREADS) o[i] = o[i] * (1.0f + code);
}

DI void ph_inproj(const Ctx& X, const Params& P, int l) {
    PlainSched S; S.init(NROWS, INW, X.nb, X.bid);
    EpiIn E{(bf16_t*)(P.ws + WS_PB), (float*)(P.ws + WS_Z), (const float*)(P.ws + WS_ROPE), (const float*)(P.ws + WS_LB) + l * 512, (bf16_t*)(P.ws + WS_KK)};
    GEMM_IMPL(X, (const bf16_t*)(P.ws + WS_H), (const bf16_t*)(P.ws + WS_WIN) + (size_t)l * INW * D, D, S, E);
}
DI void ph_outproj(const Ctx& X, const Params& P, int l) {
    PlainSched S; S.init(l == 0 ? NROWS : NLAT, D, X.nb, X.bid);
    EpiBf E{(bf16_t*)(P.ws + WS_YO), D};
    GEMM_IMPL(X, (const bf16_t*)(P.ws + WS_Y), (const bf16_t*)(P.ws + WS_WOUT) + (size_t)l * D * D, D, S, E);
}
DI void ph_moe1(const Ctx& X, const Params& P, int l) {
    MoeSched S{(const int*)(P.ws + WS_CTL) + CW_CNT + 1024 * l, (const int*)(P.ws + WS_LIST), X.nb, X.bid, 4, 1024, true};
    EpiGU E{(bf16_t*)(P.ws + WS_S)};
    GEMM_IMPL(X, (const bf16_t*)(P.ws + WS_H), (const bf16_t*)(P.ws + WS_WGU), D, S, E);
}
DI void ph_moe2(const Ctx& X, const Params& P, int l) {
    MoeSched S{(const int*)(P.ws + WS_CTL) + CW_CNT + 1024 * l, (const int*)(P.ws + WS_LIST), X.nb, X.bid, 4, 1024, false};
    EpiBf E{(bf16_t*)(P.ws + WS_O), D};
    GEMM_IMPL(X, (const bf16_t*)(P.ws + WS_S), (const bf16_t*)(P.ws + WS_WD), DEXP, S, E);
}

#define XB_TMO      128
#define XB_XCNT(j)  (256  + 64 * (j))
#define XB_XSUB(j)  (1280 + 64 * (j))
#define XB_XGEN(j)  (2304 + 64 * (j))
#define XB_TOP      3328
#define XB_TOPGEN   3392
#define XCD_BAR_WORDS 3456
#ifndef XB_SPIN_CAP
#define XB_SPIN_CAP (1u << 26)
#endif
DI unsigned xb_ld(unsigned* p)              { return __hip_atomic_load(p, __ATOMIC_RELAXED, __HIP_MEMORY_SCOPE_AGENT); }
DI unsigned xb_add(unsigned* p, unsigned v) { return __hip_atomic_fetch_add(p, v, __ATOMIC_RELAXED, __HIP_MEMORY_SCOPE_AGENT); }
DI unsigned xb_xcc_id() { return (unsigned)__builtin_amdgcn_s_getreg((3 << 11) | 20) & 0xFu; }
#define XB_SPIN(cond, bar) do { unsigned _sp = 0; while (cond) { __builtin_amdgcn_s_sleep(1); \
    if ((++_sp & 255u) == 0u) { if (xb_ld(&(bar)[XB_TMO])) break; if (_sp > XB_SPIN_CAP) { atomicAdd(&(bar)[XB_TMO], 1u); break; } } } } while (0)
struct XcdBarrier { unsigned* bar; unsigned x; volatile LAS unsigned* st; };
DI XcdBarrier xcd_barrier_post(unsigned* bar, volatile LAS unsigned* st) {
    XcdBarrier b; b.bar = bar; b.x = xb_xcc_id(); b.st = st;
    if (threadIdx.x == 0) (void)xb_add(&bar[XB_XCNT(b.x)], 1u);
    return b;
}
DI void xcd_barrier_complete(unsigned* bar, unsigned x, unsigned& nloc, unsigned& nx) {
    const unsigned G = gridDim.x * gridDim.y * gridDim.z;
    unsigned sum, cnt, mine, sp = 0u;
    for (;;) {
        sum = 0u; cnt = 0u; mine = 0u;
#pragma unroll
        for (unsigned j = 0; j < 16; ++j) { const unsigned c = xb_ld(&bar[XB_XCNT(j)]); sum += c; cnt += (c > 0u) ? 1u : 0u; mine = (j == x) ? c : mine; }
        if (sum == G) break;
        __builtin_amdgcn_s_sleep(1);
        if ((++sp & 255u) == 0u) { if (xb_ld(&bar[XB_TMO])) break; if (sp > XB_SPIN_CAP) { atomicAdd(&bar[XB_TMO], 1u); break; } }
    }
    nloc = mine > 0u ? mine : 1u; nx = cnt > 0u ? cnt : 1u;
}
DI void xcd_barrier(const XcdBarrier& b) {
    asm volatile("s_waitcnt vmcnt(0)" ::: "memory");
    __syncthreads();
    if (threadIdx.x == 0) {
        unsigned* bar = b.bar;
        __builtin_amdgcn_s_waitcnt(0);
        unsigned nloc = b.st[0], nx = b.st[1];
        if (nloc == 0u) { xcd_barrier_complete(bar, b.x, nloc, nx); b.st[0] = nloc; b.st[1] = nx; }
        const unsigned old = xb_add(&bar[XB_XSUB(b.x)], 1u);
        const unsigned gen = old / nloc;
        if (old + 1u == (gen + 1u) * nloc) {
            __builtin_amdgcn_fence(__ATOMIC_RELEASE, "agent");
            asm volatile("s_waitcnt vmcnt(0)" ::: "memory");
            const unsigned og = xb_add(&bar[XB_TOP], 1u);
            const unsigned tg = og / nx;
            if (og + 1u == (tg + 1u) * nx) xb_add(&bar[XB_TOPGEN], 1u);
            else XB_SPIN(xb_ld(&bar[XB_TOPGEN]) == tg, bar);
            __builtin_amdgcn_fence(__ATOMIC_ACQUIRE, "agent");
            xb_add(&bar[XB_XGEN(b.x)], 1u);
            asm volatile("s_waitcnt vmcnt(0)" ::: "memory");
        } else {
            XB_SPIN(xb_ld(&bar[XB_XGEN(b.x)]) == gen, bar);
            __builtin_amdgcn_fence(__ATOMIC_ACQUIRE, "agent");
            asm volatile("s_waitcnt vmcnt(0)" ::: "memory");
        }
    }
    __syncthreads();
}

template <int Q> DI void run_phase(const Ctx& X0, const Params& P0, int l) {
#if defined(__HIP_DEVICE_COMPILE__)
    const __attribute__((address_space(4))) Params* pp_ = (const __attribute__((address_space(4))) Params*)__builtin_amdgcn_kernarg_segment_ptr(); asm volatile("" : "+s"(pp_), "+s"(l));
    const Params P = *pp_; (void)P0;
#else
    const Params P = P0;
#endif
    Ctx X = X0; { int wv = X0.wave; asm volatile("" : "+s"(wv)); int ln; asm volatile("v_mbcnt_lo_u32_b32 %0, -1, 0\n\tv_mbcnt_hi_u32_b32 %0, -1, %0" : "=v"(ln)); X.tid = wv * 64 + ln; X.lane = ln; X.wave = wv; int b_ = X0.bid, n_ = X0.nb; asm volatile("" : "+s"(b_), "+s"(n_)); X.bid = b_; X.nb = n_; }
    if constexpr (Q == 0) ph_prologue(X, P);
    if constexpr (Q == 1) ph_modulate(X, P, 0);
    if constexpr (Q == 2) ph_inproj(X, P, l);
    if constexpr (Q == 3) ph_hgrn_naive(X, P, l);
    if constexpr (Q == 4) ph_hgrn_combine_naive(X, P, l);
    if constexpr (Q == 5) ph_attn_naive(X, P, l);
    if constexpr (Q == 6) ph_outproj(X, P, l);
    if constexpr (Q == 7) ph_ln1(X, P, l);
    if constexpr (Q == 8) ph_moe1(X, P, l);
    if constexpr (Q == 9) ph_moe2(X, P, l);
    if constexpr (Q == 11) ph_hgrn_local(X, P, l);
    if constexpr (Q == 12) ph_hgrn_scan(X, P);
    if constexpr (Q == 13) ph_hgrn_out(X, P, l);
    if constexpr (Q == 14) ph_swa(X, P, l);
    if constexpr (Q == 15) ph_na(X, P, l);
    if constexpr (Q == 16) ph_attn_ctx(X, P, l);
#ifdef DBG_BRUTE
    if constexpr (Q == 23) ph_dbg_scores(X, P, l);
#endif
    if constexpr (Q == 20) ph_dbg_copy(X, P);
    if constexpr (Q == 21) ph_dbg_compare(X, P);
    if constexpr (Q == 22) ph_dbg_apply(X, P);
    if constexpr (Q == 10) { ph_ln2(X, P, l); if (l == 0) { __syncthreads(); convert_experts(X, P, 1, (LAS float*)X.lds + X.wave * (64 * 33)); } }
}

constexpr int LDS_BYTES = 147 * 1024;
template <int Q>
__global__ void __launch_bounds__(NTHREADS, 2) k_step(Params P, int l) {
    extern __shared__ __attribute__((aligned(16))) unsigned char lds_raw[];
    Ctx X; X.lds = (LAS unsigned char*)lds_raw; X.tid = threadIdx.x; X.lane = X.tid & 63; X.wave = __builtin_amdgcn_readfirstlane(X.tid >> 6); X.bid = blockIdx.x; X.nb = gridDim.x;
    run_phase<Q>(X, P, l);
}
template <int Q> static void launch_step(const Params& P, int l, int grid, hipStream_t stream) {
    static bool attr = false;
    if (!attr) { (void)hipFuncSetAttribute((const void*)k_step<Q>, hipFuncAttributeMaxDynamicSharedMemorySize, LDS_BYTES); attr = true; }
    hipLaunchKernelGGL(k_step<Q>, dim3(grid), dim3(NTHREADS), LDS_BYTES, stream, P, l);
}

constexpr int LDS_CTL_OFF = 144 * 1024;
__global__ void __launch_bounds__(NTHREADS, 2) k_mega(Params P) {
    extern __shared__ __attribute__((aligned(16))) unsigned char lds_raw[];
    Ctx X; X.lds = (LAS unsigned char*)lds_raw; X.tid = threadIdx.x; X.lane = X.tid & 63; X.wave = __builtin_amdgcn_readfirstlane(X.tid >> 6); X.bid = blockIdx.x; X.nb = gridDim.x;
    volatile LAS unsigned* st = (volatile LAS unsigned*)(X.lds + LDS_CTL_OFF);
    if (X.tid < 4) st[X.tid] = 0u;
    __syncthreads();
    { const XcdBarrier b0 = xcd_barrier_post((unsigned*)(P.ws + WS_CTL) + CW_BAR, st); if (X.tid == 0) st[2] = b0.x; }
    __syncthreads();
#define GBAR() do { unsigned char* w_ = P.ws; asm volatile("" : "+s"(w_)); XcdBarrier b_; b_.bar = (unsigned*)(w_ + WS_CTL) + CW_BAR; b_.st = st; b_.x = threadIdx.x == 0 ? st[2] : 0u; xcd_barrier(b_); } while (0)
#ifndef DUP
#define DUP 0
#endif
#define NREP(bit) ({ int n_ = (DUP & (1 << (bit))) ? 2 : 1; asm volatile("" : "+s"(n_)); n_; })
#define RUNP(Q, bit) do { const int nr_ = NREP(bit); for (int rep_ = 0; rep_ < nr_; ++rep_) { run_phase<Q>(X, P, l); GBAR(); } } while (0)
    { const int l = 0; RUNP(0, 0); RUNP(1, 1); }
    for (int l = 0; l < 2; ++l) {
        RUNP(2, 2);
#if FAST_MIX
        RUNP(11, 3);
        RUNP(12, 4);
        { const int nr_ = NREP(5); for (int rep = 0; rep < nr_; ++rep) { run_phase<13>(X, P, l); __syncthreads(); } }
        { const int nr_ = NREP(6); for (int rep = 0; rep < nr_; ++rep) { run_phase<14>(X, P, l); __syncthreads(); } }
        { const int nr_ = NREP(7); for (int rep = 0; rep < nr_; ++rep) { run_phase<15>(X, P, l); __syncthreads(); } }
        { const int nr_ = NREP(8); for (int rep = 0; rep < nr_; ++rep) { run_phase<16>(X, P, l); __syncthreads(); } }
        GBAR();
#ifdef DBG_MIX
        if (l == 0) {
            run_phase<20>(X, P, l); GBAR();
            run_phase<3>(X, P, l); GBAR();
            run_phase<4>(X, P, l); GBAR();
            run_phase<5>(X, P, l); GBAR();
            run_phase<21>(X, P, l); GBAR();
        }
#endif
#else
        run_phase<3>(X, P, l); GBAR();
        run_phase<4>(X, P, l); GBAR();
        run_phase<5>(X, P, l); GBAR();
#endif
        RUNP(6, 9);
        run_phase<7>(X, P, l); GBAR();
        RUNP(8, 10);
        RUNP(9, 11);
        run_phase<10>(X, P, l); if (l == 0) GBAR();
    }
#ifdef DBG_MIX
    GBAR(); run_phase<22>(X, P, 0);
#endif
#undef GBAR
}

extern "C" void kernel_launch(void* const* d_in, const int* in_sizes, int n_in, void* d_out, int out_size, void* d_ws, size_t ws_size, hipStream_t stream) {
    static int grid = 0;
    if (grid == 0) {
        if (n_in != 21 || out_size != NLAT * D || ws_size < WS_END) { fprintf(stderr, "kernel_launch: unexpected shapes n_in %d out %d ws %zu\n", n_in, out_size, ws_size); grid = -1; return; }
        int dev = 0, cus = 0; (void)hipGetDevice(&dev); (void)hipDeviceGetAttribute(&cus, hipDeviceAttributeMultiprocessorCount, dev);
        grid = cus > 0 ? cus : 256;
        (void)hipFuncSetAttribute((const void*)k_mega, hipFuncAttributeMaxDynamicSharedMemorySize, LDS_BYTES);
    }
    if (grid < 0) return;
    (void)hipMemsetAsync((char*)d_ws + WS_CTL, 0, CTL_BYTES, stream);
    Params P{};
    for (int i = 0; i < 21; ++i) P.in[i] = (const float*)d_in[i];
    P.out = (float*)d_out; P.ws = (unsigned char*)d_ws;
#if N_LAUNCH_MODE == 1
    hipLaunchKernelGGL(k_mega, dim3(grid), dim3(NTHREADS), LDS_BYTES, stream, P);
#else
    launch_step<0>(P, 0, grid, stream);
    launch_step<1>(P, 0, grid, stream);
    for (int l = 0; l < 2; ++l) {
        launch_step<2>(P, l, grid, stream); launch_step<3>(P, l, grid, stream); launch_step<4>(P, l, grid, stream); launch_step<5>(P, l, grid, stream);
        launch_step<6>(P, l, grid, stream); launch_step<7>(P, l, grid, stream); launch_step<8>(P, l, grid, stream); launch_step<9>(P, l, grid, stream);
        launch_step<10>(P, l, grid, stream);
    }
#endif
}
#ifdef DBG_INST
template __global__ void k_step<11>(Params, int);
template __global__ void k_step<12>(Params, int);
template __global__ void k_step<13>(Params, int);
template __global__ void k_step<14>(Params, int);
template __global__ void k_step<15>(Params, int);
template __global__ void k_step<16>(Params, int);
#endif
```

```cpp
#include <hip/hip_runtime.h>
#include <cstdint>
#include <cstdio>

#ifndef N_LAUNCH_MODE
#define N_LAUNCH_MODE 1
#endif
#ifndef FAST_MIX
#define FAST_MIX 1
#endif
#ifndef DBG_TEST
#define DBG_TEST 0
#endif
#ifndef DBG_HG_MODE
#define DBG_HG_MODE 0
#endif
#ifndef FAST_GEMM
#define FAST_GEMM 1
#endif

#define LAS __attribute__((address_space(3)))
#define GAS __attribute__((address_space(1)))
typedef unsigned short bf16_t;
typedef short bf16x8 __attribute__((ext_vector_type(8)));
typedef float f32x4 __attribute__((ext_vector_type(4)));
typedef float f32x2 __attribute__((ext_vector_type(2)));
typedef unsigned u32x4 __attribute__((ext_vector_type(4)));
typedef unsigned u32x2 __attribute__((ext_vector_type(2)));
typedef short s16x4 __attribute__((ext_vector_type(4)));
typedef float f32x16 __attribute__((ext_vector_type(16)));
#define DI __device__ __forceinline__

constexpr int D = 1024, NB = 2, SEQ = 8192, CTXL = 256, NLAT = NB * SEQ, NCTX = NB * CTXL, NROWS = NLAT + NCTX;
constexpr int INW = 2816, PBW = 2304, ZW = 512, NEXP = 16, DEXP = 512, LISTCAP = NROWS;
constexpr int NTHREADS = 512, NWAVES = 8;
constexpr float ALPHA = 1.41421356237f, LN_EPS = 1e-5f, RMS_EPS = 1e-6f, LOG2E = 1.4426950408889634f, QSCALE = 0.125f * LOG2E;
constexpr int PB_AQ = 0, PB_AI = 256, PB_AG = 512, PB_NQ = 768, PB_NK = 1024, PB_NV = 1280, PB_SQ = 1536, PB_SK = 2048, PB_SV = 2176;
constexpr int NCHAIN = 132;

constexpr size_t MiB = 1u << 20;
constexpr size_t WS_CTL = 0, CTL_BYTES = 1 * MiB;
constexpr size_t WS_MODS = 1 * MiB;
constexpr size_t WS_LB = WS_MODS + 2 * 3 * 6144 * 4;
constexpr size_t WS_ROPE = WS_LB + 2 * 2 * 256 * 4;
constexpr size_t WS_TOKE = WS_ROPE + 129 * 16 * 2 * 4;
constexpr size_t WS_TOKP = WS_TOKE + NROWS * 8;
constexpr size_t WS_TOKW = WS_TOKP + NROWS * 8;
constexpr size_t WS_LIST = 2 * MiB;
constexpr size_t WS_XC = 4 * MiB;
constexpr size_t WS_X1 = 211 * MiB;
constexpr size_t WS_WIN = 6 * MiB;
constexpr size_t WS_WOUT = 17 * MiB;
constexpr size_t WS_WGU = 21 * MiB;
constexpr size_t WS_WD = 53 * MiB;
constexpr size_t WS_H = 69 * MiB;
constexpr size_t WS_Y = 102 * MiB;
constexpr size_t WS_S = 135 * MiB;
constexpr size_t WS_DD = 282 * MiB;
constexpr size_t WS_PB = 174 * MiB;
constexpr size_t WS_Z = WS_PB + (size_t)NROWS * PBW * 2;
constexpr size_t WS_O = 174 * MiB;
constexpr size_t WS_YO = 248 * MiB;
constexpr size_t WS_WGU1 = 284 * MiB, WS_WD1 = 316 * MiB;
constexpr size_t WS_END = 332 * MiB;
constexpr int HE_ROWS = 37888;
constexpr size_t WS_KK = WS_Z + (size_t)NROWS * ZW * 2;
static_assert(WS_DD + (size_t)2 * 2112 * 64 * 4 <= WS_END && WS_Z + (size_t)NROWS * ZW * 4 <= WS_DD && WS_O + (size_t)HE_ROWS * 1024 * 2 <= WS_YO && WS_YO + (size_t)NROWS * 2048 <= WS_END, "ws map");
static_assert(WS_TOKW + NROWS * 8 <= WS_LIST && WS_LIST + 16 * LISTCAP * 4 <= WS_XC, "ws map small");
constexpr int CW_CNT = 8192;
constexpr int CW_BAR = 4096;
constexpr int CW_DBG = 512;
constexpr int CW_Q = 1024;
constexpr int CW_TS = 2048;
constexpr int CW_SCAN = 1536;

struct Params {
    const float* in[21];
    float* out;
    unsigned char* ws;
    int step_lo, step_hi;
};

DI unsigned f2bf(float f) { unsigned u = __builtin_bit_cast(unsigned, f); return (u + 0x7fffu + ((u >> 16) & 1u)) >> 16; }
DI float bf2f(unsigned h) { return __builtin_bit_cast(float, h << 16); }
typedef __bf16 bf16x2_t __attribute__((ext_vector_type(2)));
DI unsigned pk2(float lo, float hi) { return __builtin_bit_cast(unsigned, __builtin_convertvector((f32x2){lo, hi}, bf16x2_t)); }
DI float bflo(unsigned w) { return __builtin_bit_cast(float, w << 16); }
DI float bfhi(unsigned w) { return __builtin_bit_cast(float, w & 0xffff0000u); }
#define DPPF(v, ctrl, rm) __builtin_bit_cast(float, __builtin_amdgcn_update_dpp(0, __builtin_bit_cast(int, (v)), (ctrl), (rm), 0xf, false))
DI float wave_sum(float v) {
    v += DPPF(v, 0xB1, 0xf); v += DPPF(v, 0x4E, 0xf); v += DPPF(v, 0x141, 0xf); v += DPPF(v, 0x140, 0xf);
    v += DPPF(v, 0x142, 0xa); v += DPPF(v, 0x143, 0xc);
    return __builtin_bit_cast(float, __builtin_amdgcn_readlane(__builtin_bit_cast(int, v), 63));
}
DI float wave_max(float v) {
#pragma unroll
    for (int o = 1; o < 64; o <<= 1) v = fmaxf(v, __shfl_xor(v, o));
    return v;
}
DI float sigmoidf_(float x) { return 1.0f / (1.0f + __expf(-x)); }
DI float siluf_(float x) { return x / (1.0f + __expf(-x)); }
DI unsigned pk_fp8x4(f32x4 v) { int w = 0; w = __builtin_amdgcn_cvt_pk_fp8_f32(v[0], v[1], w, false); w = __builtin_amdgcn_cvt_pk_fp8_f32(v[2], v[3], w, true); return (unsigned)w; }
DI void store_bf4(bf16_t* p, f32x4 v) { u32x2 w; w.x = pk2(v[0], v[1]); w.y = pk2(v[2], v[3]); *(u32x2*)p = w; }

struct Ctx {
    LAS unsigned char* lds;
    int tid, lane, wave, bid, nb;
};

struct Unit { int pm, pn, e, cnt, i0, slot; };

struct PlainSched {
    int nM, nN, nwg, G, c;
    DI void init(int M, int N, int G_, int c_) { nM = M / 256; nN = N / 256; nwg = nM * nN; G = G_; c = c_; }
    DI bool next(int i, Unit& u) const {
        const long L = (long)i * G + c; if (L >= nwg) return false;
        int wgid = (int)L; { const int q = nwg / 8, r = nwg % 8, xcd = wgid % 8, off = wgid / 8; wgid = (xcd < r ? xcd * (q + 1) : r * (q + 1) + (xcd - r) * q) + off; }
        const int nig = 8 * nN, gid = wgid / nig, fm = gid * 8, gsz = (nM - fm) < 8 ? (nM - fm) : 8;
        u.pm = fm + ((wgid % nig) % gsz); u.pn = (wgid % nig) / gsz; u.e = 0; u.cnt = 0; u.i0 = 0; u.slot = 0; return true;
    }
    DI int a_row(const Unit& u, int r) const { return u.pm * 256 + r; }
    DI int b_row0(const Unit& u) const { return u.pn * 256; }
    static constexpr bool LOADS = false;
};
constexpr int MOE_TBL_OFF = 144 * 1024 + 512;
constexpr int MOE_LIST_OFF = 144 * 1024 + 2560;
DI void moe_build_table(const Ctx& X, const int* cnt) {
    LAS int* tbl = (LAS int*)(X.lds + MOE_TBL_OFF);
    if (X.tid < 160) { const int T = X.tid; int acc = 0, e = -1, i0 = 0, ce = 0;
#pragma unroll
        for (int q = 0; q < NEXP; ++q) { const int cq = cnt[q * 64]; const int nt = (cq + 255) >> 8; if (e < 0 && T < acc + nt) { e = q; i0 = T - acc; ce = cq; } acc += nt; }
        tbl[1 + 3 * T] = e; tbl[2 + 3 * T] = i0; tbl[3 + 3 * T] = ce; if (T == 0) tbl[0] = acc; }
    __syncthreads();
}
template <bool GATHER> struct MoeSched {
    const int* cnt; const int* list; int G, c, nct, bt_rows; LAS unsigned char* lds; static constexpr bool gather = GATHER;
    DI bool next(int i, Unit& u) const {
        const LAS int* tbl = (const LAS int*)(lds + MOE_TBL_OFF);
        const int xcd = c & 7, j = c >> 3; const int L = i * G + xcd * (G >> 3) + j;
        const int T = L / nct; if (T >= __builtin_amdgcn_readfirstlane(tbl[0])) return false;
        u.slot = i; u.pm = T; u.pn = L % nct; u.e = __builtin_amdgcn_readfirstlane(tbl[1 + 3 * T]); u.i0 = __builtin_amdgcn_readfirstlane(tbl[2 + 3 * T]); u.cnt = __builtin_amdgcn_readfirstlane(tbl[3 + 3 * T]); return true;
    }
    DI int a_row(const Unit& u, int r) const {
        if (!gather) return u.pm * 256 + r;
        return ((const LAS int*)(lds + MOE_LIST_OFF))[u.slot * 256 + r];
    }
    DI int b_row0(const Unit& u) const { return u.e * bt_rows + u.pn * 256; }
    static constexpr bool LOADS = GATHER;
};

DI void store_bf8(bf16_t* p, f32x4 lo, f32x4 hi) { u32x4 w; w.x = pk2(lo[0], lo[1]); w.y = pk2(lo[2], lo[3]); w.z = pk2(hi[0], hi[1]); w.w = pk2(hi[2], hi[3]); *(u32x4*)p = w; }
DI void store_f8x8(unsigned char* p, f32x4 lo, f32x4 hi) { u32x2 w; w.x = pk_fp8x4(lo); w.y = pk_fp8x4(hi); *(u32x2*)p = w; }
DI float lane32_partner(float v, bool upper) { const auto rr = __builtin_amdgcn_permlane32_swap(__float_as_uint(v), __float_as_uint(v), false, false); return __uint_as_float(upper ? rr[0] : rr[1]); }
struct EpiIn {
    bf16_t* PB; bf16_t* Z; const float* rope; const float* lb; bf16_t* KK;
    DI void gate8(bf16_t* zp, bf16_t* kp, const float* lbp, f32x4 z0, f32x4 z1) const {
        const f32x4 lb0 = *(const f32x4*)lbp, lb1 = *(const f32x4*)(lbp + 4); f32x4 lf0, lf1, k0, k1;
#pragma unroll
        for (int j = 0; j < 4; ++j) { const float zc = fminf(fmaxf(z0[j], -30.f), 30.f), e = __expf(-zc), sg = 1.0f / (1.0f + e); lf0[j] = __log2f(lb0[j] + (1.0f - lb0[j]) * sg); k0[j] = (1.0f - lb0[j]) * (e * sg); }
#pragma unroll
        for (int j = 0; j < 4; ++j) { const float zc = fminf(fmaxf(z1[j], -30.f), 30.f), e = __expf(-zc), sg = 1.0f / (1.0f + e); lf1[j] = __log2f(lb1[j] + (1.0f - lb1[j]) * sg); k1[j] = (1.0f - lb1[j]) * (e * sg); }
        store_bf8(zp, lf0, lf1); store_bf8(kp, k0, k1);
    }
    DI void rope8(f32x4& v0, f32x4& v1, const float* rp, bool upper) const {
#pragma unroll
        for (int j = 0; j < 4; ++j) { const float c0 = rp[2 * j], s0 = rp[2 * j + 1], c1 = rp[2 * (j + 4)], s1 = rp[2 * (j + 4) + 1];
            const float p0 = lane32_partner(v0[j], upper), p1 = lane32_partner(v1[j], upper);
            v0[j] = upper ? p0 * s0 + v0[j] * c0 : v0[j] * c0 - p0 * s0; v1[j] = upper ? p1 * s1 + v1[j] * c1 : v1[j] * c1 - p1 * s1; }
    }
    DI void group(const Unit& u, int r, int c, f32x4 a0, f32x4 a1, f32x4 b0, f32x4 b1) const {
        const int row = u.pm * 256 + r, seg = u.pn, gc = u.pn * 256 + c;
        if (seg == 1 || seg == 2) {
            const int ci = (seg - 1) * 256 + c; bf16_t* z = Z + (size_t)row * ZW + ci; bf16_t* k = KK + (size_t)row * ZW + ci; const float* lp = lb + ci;
            gate8(z, k, lp, a0, a1); gate8(z + 128, k + 128, lp + 128, b0, b1);
            return;
        }
        if (seg >= 8) {
            const int t = row & (SEQ - 1); const int which = (c >> 5) & 1; const int pos = row < NLAT ? (which ? (t & 63) : (t >> 6)) : 128;
            const bool upper = (c & 31) >= 16; const float* rp = rope + (pos * 16 + (c & 15)) * 2;
            rope8(a0, a1, rp, upper); if (seg < 10) rope8(b0, b1, rp, upper);
        }
        if (seg == 5 || seg == 8 || seg == 9) { a0 *= QSCALE; a1 *= QSCALE; b0 *= QSCALE; b1 *= QSCALE; }
        bf16_t* p = PB + (size_t)row * PBW + (gc >= 768 ? gc - 512 : gc);
        store_bf8(p, a0, a1); store_bf8(p + 128, b0, b1);
    }
};
struct EpiBf {
    bf16_t* C; int ldc;
    DI void group(const Unit& u, int r, int c, f32x4 a0, f32x4 a1, f32x4 b0, f32x4 b1) const {
        bf16_t* p = C + (size_t)(u.pm * 256 + r) * ldc + u.pn * 256 + c;
        store_bf8(p, a0, a1); store_bf8(p + 128, b0, b1);
    }
};
struct EpiF8 {
    unsigned char* C; int ldc;
    DI void group(const Unit& u, int r, int c, f32x4 a0, f32x4 a1, f32x4 b0, f32x4 b1) const {
        unsigned char* p = C + (size_t)(u.pm * 256 + r) * ldc + u.pn * 256 + c;
        store_f8x8(p, a0 * 16.0f, a1 * 16.0f); store_f8x8(p + 128, b0 * 16.0f, b1 * 16.0f);
    }
};
struct EpiGU {
    bf16_t* HE;
    DI void group(const Unit& u, int r, int c, f32x4 a0, f32x4 a1, f32x4 b0, f32x4 b1) const {
        f32x4 h0, h1;
#pragma unroll
        for (int j = 0; j < 4; ++j) { h0[j] = siluf_(a0[j]) * b0[j]; h1[j] = siluf_(a1[j]) * b1[j]; }
        store_f8x8((unsigned char*)HE + (size_t)(u.pm * 256 + r) * DEXP + u.pn * 128 + c, h0, h1);
    }
};

template <class Sched, class Epi>
DI void gemm_naive(const Ctx& X, const bf16_t* A, const bf16_t* Bt, int K, const Sched& S, const Epi& E) {
    Unit u;
    for (int i = 0; S.next(i, u); ++i) {
        for (int g = X.tid; g < 4096; g += NTHREADS) {
            const int fq = g & 3, wc = (g >> 2) & 3, r = g >> 4, c = wc * 32 + fq * 4;
            const bf16_t* ap = A + (size_t)S.a_row(u, r) * K;
            const bf16_t* bp = Bt + (size_t)(S.b_row0(u) + c) * K;
            float acc[16];
#pragma unroll
            for (int q = 0; q < 16; ++q) acc[q] = 0.f;
            for (int k = 0; k < K; k += 8) {
                const u32x4 av = *(const u32x4*)(ap + k);
                float af[8] = {bflo(av.x), bfhi(av.x), bflo(av.y), bfhi(av.y), bflo(av.z), bfhi(av.z), bflo(av.w), bfhi(av.w)};
#pragma unroll
                for (int q = 0; q < 16; ++q) {
                    const int col = (q >> 3) * 128 + ((q >> 2) & 1) * 16 + (q & 3);
                    const u32x4 bv = *(const u32x4*)(bp + (size_t)col * K + k);
                    acc[q] += af[0] * bflo(bv.x) + af[1] * bfhi(bv.x) + af[2] * bflo(bv.y) + af[3] * bfhi(bv.y) + af[4] * bflo(bv.z) + af[5] * bfhi(bv.z) + af[6] * bflo(bv.w) + af[7] * bfhi(bv.w);
                }
            }
            E.group(u, r, c, (f32x4){acc[0], acc[1], acc[2], acc[3]}, (f32x4){acc[4], acc[5], acc[6], acc[7]}, (f32x4){acc[8], acc[9], acc[10], acc[11]}, (f32x4){acc[12], acc[13], acc[14], acc[15]});
        }
    }
}

constexpr int HTB = 128 * 64 * 2;
DI int lds_byte(int r, int c) { const int st = (r >> 4) * 2 + (c >> 5), rr = r & 15, cc = c & 31, ob = rr * 64 + cc * 2; return st * 1024 + (ob ^ (((ob >> 9) & 1) << 5)); }
DI void stage_rc(int b, int& R, int& C) { const int st = b / 1024, sb = b % 1024, swz = sb ^ (((sb >> 9) & 1) << 5); R = (st >> 1) * 16 + swz / 64; C = (st & 1) * 32 + (swz % 64) / 2; }
typedef int v8i_t __attribute__((ext_vector_type(8)));
template <class Sched, class Epi, bool F8 = false, int SCALE_B = 127>
DI void gemm_fast(const Ctx& X, const void* A, const void* Bt, int K, const Sched& S, const Epi& E) {
    LAS unsigned char* lds = X.lds;
    const int tid = X.tid, wid = X.wave, lane = X.lane, wr = wid >> 2, wc = wid & 3, fr = lane & 15, fq = lane >> 4;
    asm volatile("" : "+s"(K));
    const int RP = F8 ? K : 2 * K, nt = RP / 128;
    int Rr[2], Cc[2]; unsigned voffB[2];
#pragma unroll
    for (int i = 0; i < 2; ++i) { stage_rc(tid * 16 + i * 8192, Rr[i], Cc[i]); const int rho = Rr[i] & 31, Rb = (Rr[i] & ~31) + 8 * ((rho & 15) >> 2) + 4 * (rho >> 4) + (rho & 3);
        voffB[i] = (unsigned)(Rb * RP + Cc[i] * 2); }
    const size_t kstep = 128, hstepB = (size_t)128 * RP;
    const unsigned ldsw = (unsigned)wid * 1024u;
    const int aoff = lds_byte(wr * 64 + fr, fq * 8), boff = lds_byte(wc * 32 + fr, fq * 8);
#define G_SA(b, h) (((b) * 2 + (h)) * HTB)
#define G_SB(b, h) ((4 + (b) * 2 + (h)) * HTB)
#define G_STAGE(bufoff, gbase, voff) do { _Pragma("unroll") for (int _i = 0; _i < 2; ++_i) \
        __builtin_amdgcn_global_load_lds((const unsigned*)((const char*)(gbase) + (voff)[_i]), (LAS unsigned*)(lds + (bufoff) + ldsw + _i * 8192), 16, 0, 0); } while (0)
#define G_LD8(p) __builtin_bit_cast(v8i_t, __builtin_shufflevector(*(const LAS u32x4*)(p), *(const LAS u32x4*)((p) + 1024), 0, 1, 2, 3, 4, 5, 6, 7))
#define G_LDA(dst, b, h) do { _Pragma("unroll") for (int m = 0; m < 4; ++m) dst[m] = G_LD8(lds + G_SA(b, h) + aoff + m * 2048); } while (0)
#define G_LDB(dst, b, h) do { _Pragma("unroll") for (int n = 0; n < 2; ++n) dst[n] = G_LD8(lds + G_SB(b, h) + boff + n * 2048); } while (0)
#define G_LO(f) __builtin_bit_cast(bf16x8, __builtin_shufflevector((f), (f), 0, 1, 2, 3))
#define G_HI(f) __builtin_bit_cast(bf16x8, __builtin_shufflevector((f), (f), 4, 5, 6, 7))
#define G_MMA(ai, bj, At, Bt_) do { __builtin_amdgcn_s_setprio(1); _Pragma("unroll") for (int m = 0; m < 4; ++m) _Pragma("unroll") for (int n = 0; n < 2; ++n) { \
        if constexpr (F8) asm volatile("v_mfma_scale_f32_16x16x128_f8f6f4 %0, %1, %2, %0, %3, %4 op_sel_hi:[0,0,0]" : "+v"(acc[ai][bj][m][n]) : "v"(Bt_[n]), "v"(At[m]), "v"(scl_w), "v"(scl_x)); \
        else { acc[ai][bj][m][n] = __builtin_amdgcn_mfma_f32_16x16x32_bf16(G_LO(Bt_[n]), G_LO(At[m]), acc[ai][bj][m][n], 0, 0, 0); acc[ai][bj][m][n] = __builtin_amdgcn_mfma_f32_16x16x32_bf16(G_HI(Bt_[n]), G_HI(At[m]), acc[ai][bj][m][n], 0, 0, 0); } } __builtin_amdgcn_s_setprio(0); } while (0)
#define G_WAIT_V(n) asm volatile("s_waitcnt vmcnt(" #n ")" ::: "memory")
#define G_WAIT_L(n) asm volatile("s_waitcnt lgkmcnt(" #n ")" ::: "memory")
#define G_BAR __builtin_amdgcn_s_barrier()
#define G_SCHED __builtin_amdgcn_sched_barrier(0)
    Unit cur, nxt; int ui = 0;
    if (!S.next(0, cur)) return;
    f32x4 acc[2][2][4][2];
#pragma unroll
    for (int a = 0; a < 2; ++a)
#pragma unroll
        for (int b = 0; b < 2; ++b)
#pragma unroll
            for (int m = 0; m < 4; ++m)
#pragma unroll
                for (int n = 0; n < 2; ++n) acc[a][b][m][n] = (f32x4){0.f, 0.f, 0.f, 0.f};
    v8i_t At[4], B0[2], B1[2];
    int scl_w = SCALE_B * 0x01010101, scl_x = 0x7f7f7f7f; asm volatile("" : "+v"(scl_w), "+v"(scl_x));
    constexpr bool GA = Sched::LOADS;
    unsigned vAc[2][2], vAn[2][2];
#pragma unroll
    for (int h = 0; h < 2; ++h)
#pragma unroll
        for (int i = 0; i < 2; ++i) { vAc[h][i] = GA ? (unsigned)(S.a_row(cur, h * 128 + Rr[i]) * RP + Cc[i] * 2) : (unsigned)((h * 128 + Rr[i]) * RP + Cc[i] * 2); vAn[h][i] = vAc[h][i]; }
    if (GA) G_WAIT_V(0);
    const char* A0 = (const char*)A;
    const char* cA = GA ? A0 : A0 + (size_t)S.a_row(cur, 0) * RP;
    const char* cB = (const char*)Bt + (size_t)S.b_row0(cur) * RP;
    G_STAGE(G_SB(0, 0), cB, voffB); G_STAGE(G_SB(0, 1), cB + hstepB, voffB); G_STAGE(G_SA(0, 0), cA, vAc[0]); G_STAGE(G_SA(0, 1), cA, vAc[1]);
    if (wr == 1) G_BAR;
    G_WAIT_V(2); G_BAR;
    G_STAGE(G_SB(1, 0), cB + kstep, voffB); G_STAGE(G_SA(1, 0), cA + kstep, vAc[0]); G_STAGE(G_SB(1, 1), cB + hstepB + kstep, voffB);
    G_WAIT_V(6); G_BAR;
    for (;;) {
        const bool has_next = S.next(ui + 1, nxt);
        if (GA) {
#pragma unroll
            for (int h = 0; h < 2; ++h)
#pragma unroll
                for (int i = 0; i < 2; ++i) vAn[h][i] = has_next ? (unsigned)(S.a_row(nxt, h * 128 + Rr[i]) * RP + Cc[i] * 2) : vAc[h][i];
        }
        const char* nA = GA ? A0 : (has_next ? A0 + (size_t)S.a_row(nxt, 0) * RP : cA);
        const char* nB = has_next ? (const char*)Bt + (size_t)S.b_row0(nxt) * RP : cB;
#pragma unroll 1
        for (int t = 0; t < nt; t += 2) {
            const bool last = (t == nt - 2);
            const char* a1 = cA + (size_t)(t + 1) * kstep;
            const char* a2 = last ? nA : cA + (size_t)(t + 2) * kstep; const char* b2 = last ? nB : cB + (size_t)(t + 2) * kstep;
            const char* a3 = a2 + kstep; const char* b3 = b2 + kstep;
            unsigned v2[2][2];
#pragma unroll
            for (int h = 0; h < 2; ++h)
#pragma unroll
                for (int i = 0; i < 2; ++i) v2[h][i] = (GA && last) ? vAn[h][i] : vAc[h][i];
            G_LDB(B0, 0, 0); G_LDB(B1, 0, 1); G_SCHED; G_LDA(At, 0, 0); G_STAGE(G_SA(1, 1), a1, vAc[1]);
            G_WAIT_V(8); G_WAIT_L(0); G_BAR; G_MMA(0, 0, At, B0); G_MMA(0, 1, At, B1); G_BAR; G_SCHED;
            G_LDA(At, 0, 1); G_STAGE(G_SB(0, 0), b2, voffB); G_STAGE(G_SB(0, 1), b2 + hstepB, voffB); G_STAGE(G_SA(0, 0), a2, v2[0]);
            G_WAIT_V(8); G_WAIT_L(0); G_BAR; G_MMA(1, 0, At, B0); G_MMA(1, 1, At, B1); G_BAR; G_SCHED;
            G_LDB(B0, 1, 0); G_LDB(B1, 1, 1); G_SCHED; G_LDA(At, 1, 0); G_STAGE(G_SA(0, 1), a2, v2[1]);
            G_WAIT_V(8); G_WAIT_L(0); G_BAR; G_MMA(0, 0, At, B0); G_MMA(0, 1, At, B1); G_BAR; G_SCHED;
            G_LDA(At, 1, 1); G_STAGE(G_SB(1, 0), b3, voffB); G_STAGE(G_SB(1, 1), b3 + hstepB, voffB); G_STAGE(G_SA(1, 0), a3, v2[0]);
            G_WAIT_V(8); G_WAIT_L(0); G_BAR; G_MMA(1, 0, At, B0); G_MMA(1, 1, At, B1); G_BAR; G_SCHED;
        }
        if constexpr (F8) asm volatile("s_nop 15\n\ts_nop 15" ::: "memory");
        if (wr == 0) G_BAR;
#pragma unroll
        for (int ai = 0; ai < 2; ++ai)
#pragma unroll
            for (int m = 0; m < 4; ++m) E.group(cur, ai * 128 + wr * 64 + m * 16 + fr, wc * 32 + fq * 8, acc[ai][0][m][0], acc[ai][0][m][1], acc[ai][1][m][0], acc[ai][1][m][1]);
        if (!has_next) break;
#pragma unroll
        for (int a = 0; a < 2; ++a)
#pragma unroll
            for (int b = 0; b < 2; ++b)
#pragma unroll
                for (int m = 0; m < 4; ++m)
#pragma unroll
                    for (int n = 0; n < 2; ++n) acc[a][b][m][n] = (f32x4){0.f, 0.f, 0.f, 0.f};
        cur = nxt; cB = nB; cA = nA; ++ui;
        if (GA) {
#pragma unroll
            for (int h = 0; h < 2; ++h)
#pragma unroll
                for (int i = 0; i < 2; ++i) vAc[h][i] = vAn[h][i]; }
        if (wr == 1) G_BAR;
    }
    G_WAIT_V(0);
    G_BAR;
#undef G_SA
#undef G_SB
#undef G_STAGE
#undef G_LDA
#undef G_LDB
#undef G_MMA
#undef G_LD8
#undef G_LO
#undef G_HI
#undef G_WAIT_V
#undef G_WAIT_L
#undef G_BAR
#undef G_SCHED
}
#if FAST_GEMM
#define GEMM_IMPL gemm_fast
#else
#define GEMM_IMPL gemm_naive
#endif

struct TrDesc { const float* W; bf16_t* WT; int N, Kd, k0, n0, drow0, f8; float sc; };
DI void tr_load(const TrDesc& d, float (&rg)[32], int lane) {
#pragma unroll
    for (int i = 0; i < 32; ++i) { const int kk = 2 * i + (lane >> 5); rg[i] = d.W[(size_t)(d.k0 + kk) * d.N + d.n0 + (lane & 31)]; }
}
DI void tr_finish(const TrDesc& d, const float (&rg)[32], LAS float* scr, int lane) {
#pragma unroll
    for (int i = 0; i < 32; ++i) { const int kk = 2 * i + (lane >> 5); scr[kk * 33 + (lane & 31)] = rg[i]; }
    asm volatile("s_waitcnt lgkmcnt(0)" ::: "memory");
    const int c = lane & 7;
#pragma unroll
    for (int j = 0; j < 4; ++j) { const int n = (lane >> 3) + 8 * j; const LAS float* s = scr + (8 * c) * 33 + n;
        if (d.f8) { u32x2 o; o.x = pk_fp8x4((f32x4){s[0 * 33], s[1 * 33], s[2 * 33], s[3 * 33]} * d.sc); o.y = pk_fp8x4((f32x4){s[4 * 33], s[5 * 33], s[6 * 33], s[7 * 33]} * d.sc);
            *(u32x2*)((unsigned char*)d.WT + (size_t)(d.drow0 + n) * d.Kd + d.k0 + 8 * c) = o; }
        else { u32x4 o; o.x = pk2(s[0 * 33], s[1 * 33]); o.y = pk2(s[2 * 33], s[3 * 33]); o.z = pk2(s[4 * 33], s[5 * 33]); o.w = pk2(s[6 * 33], s[7 * 33]);
            *(u32x4*)(d.WT + (size_t)(d.drow0 + n) * d.Kd + d.k0 + 8 * c) = o; } }
    asm volatile("s_waitcnt lgkmcnt(0)" ::: "memory");
}
DI TrDesc expert_desc(const Params& P, int l, int it) {
    bf16_t* WGU = (bf16_t*)(P.ws + (l ? WS_WGU1 : WS_WGU)); bf16_t* WD = (bf16_t*)(P.ws + (l ? WS_WD1 : WS_WD));
    const float* wg = P.in[18] + (size_t)l * NEXP * D * DEXP; const float* wu = P.in[19] + (size_t)l * NEXP * D * DEXP; const float* wd = P.in[20] + (size_t)l * NEXP * DEXP * D;
    const int set = it >> 12, r = it & 4095, e = r >> 8, q = r & 255; TrDesc d; d.sc = 32.0f;
    if (set < 2) { const int kb = q >> 4, nbk = q & 15, n0 = nbk * 32;
        d.f8 = 1; d.W = (set ? wu : wg) + (size_t)e * D * DEXP; d.N = DEXP; d.WT = (bf16_t*)((unsigned char*)WGU + (size_t)e * 1024 * 1024); d.Kd = 1024; d.k0 = kb * 64; d.n0 = n0; d.drow0 = 256 * (n0 >> 7) + (n0 & 127) + set * 128;
    } else { const int kb = q >> 5, nbk = q & 31, n0 = nbk * 32;
        d.f8 = 1; d.W = wd + (size_t)e * DEXP * D; d.N = D; d.WT = (bf16_t*)((unsigned char*)WD + (size_t)e * 1024 * 512); d.Kd = 512; d.k0 = kb * 64; d.n0 = n0; d.drow0 = n0; }
    return d;
}
DI TrDesc rest_desc(const Params& P, int it) {
    if (it >= 2432) return expert_desc(P, 0, it - 2432);
    bf16_t* WIN = (bf16_t*)(P.ws + WS_WIN); bf16_t* WOUT = (bf16_t*)(P.ws + WS_WOUT); TrDesc d;
    d.f8 = 1; d.sc = 32.0f;
    if (it < 1408) { const int kb = it / 88, nbk = it % 88; d.f8 = 1; d.W = P.in[6] + (size_t)D * INW; d.N = INW; d.WT = (bf16_t*)((unsigned char*)WIN + (size_t)INW * D); d.Kd = D; d.k0 = kb * 64; d.n0 = nbk * 32; d.drow0 = nbk * 32; }
    else { const int r0 = it - 1408, l = r0 >> 9, r = r0 & 511, kb = r >> 5, nbk = r & 31; d.sc = 64.0f; d.W = P.in[11] + (size_t)l * D * D; d.N = D; d.WT = (bf16_t*)((unsigned char*)WOUT + (size_t)l * D * D); d.Kd = D; d.k0 = kb * 64; d.n0 = nbk * 32; d.drow0 = nbk * 32; }
    return d;
}
DI TrDesc win0_desc(const Params& P, int it) { TrDesc d; d.f8 = 1; d.sc = 32.0f; const int kb = it / 88, nbk = it % 88; d.W = P.in[6]; d.N = INW; d.WT = (bf16_t*)(P.ws + WS_WIN); d.Kd = D; d.k0 = kb * 64; d.n0 = nbk * 32; d.drow0 = nbk * 32; return d; }
#define TR_LOOP(DESC_EXPR, first, limit, step) do { int it_ = (first); if (it_ < (limit)) { float rg_[32]; TrDesc d_ = DESC_EXPR(it_); tr_load(d_, rg_, X.lane); \
        for (;;) { const int nx_ = it_ + (step); if (nx_ < (limit)) { float rn_[32]; const TrDesc dn_ = DESC_EXPR(nx_); tr_load(dn_, rn_, X.lane); tr_finish(d_, rg_, scr, X.lane); d_ = dn_; _Pragma("unroll") for (int q_ = 0; q_ < 32; ++q_) rg_[q_] = rn_[q_]; it_ = nx_; } \
                   else { tr_finish(d_, rg_, scr, X.lane); break; } } } } while (0)
DI void ph_prologue(const Ctx& X, const Params& P) {
    LAS float* sc = (LAS float*)X.lds;
    LAS float* red = sc + 3072;
    float* MODS = (float*)(P.ws + WS_MODS);
    for (int it = X.bid; it < 193; it += X.nb) {
        if (it < 192) {
            const int l = it / 96, cg = it % 96;
            for (int i = X.tid; i < 3072; i += NTHREADS) { const int cond = i >> 10, k = i & 1023; const float v = cond < 2 ? P.in[1][cond * 1024 + k] : P.in[3][k]; sc[i] = siluf_(v); }
            __syncthreads();
            const int kq = X.tid >> 4, c4 = X.tid & 15;
            float acc[3][4];
#pragma unroll
            for (int a = 0; a < 3; ++a)
#pragma unroll
                for (int j = 0; j < 4; ++j) acc[a][j] = 0.f;
            const float* w = P.in[4] + (size_t)l * D * 6144 + cg * 64 + c4 * 4;
#pragma unroll 8
            for (int i = 0; i < 32; ++i) { const int k = kq + 32 * i; const f32x4 wv = *(const f32x4*)(w + (size_t)k * 6144);
                const float s0 = sc[k], s1 = sc[1024 + k], s2 = sc[2048 + k];
#pragma unroll
                for (int j = 0; j < 4; ++j) { acc[0][j] += s0 * wv[j]; acc[1][j] += s1 * wv[j]; acc[2][j] += s2 * wv[j]; } }
#pragma unroll
            for (int a = 0; a < 3; ++a)
#pragma unroll
                for (int j = 0; j < 4; ++j) red[(kq * 3 + a) * 64 + c4 * 4 + j] = acc[a][j];
            __syncthreads();
            if (X.tid < 192) { const int cond = X.tid >> 6, col = X.tid & 63; float s = 0.f;
                for (int q = 0; q < 32; ++q) s += red[(q * 3 + cond) * 64 + col];
                MODS[(l * 3 + cond) * 6144 + cg * 64 + col] = s + P.in[5][l * 6144 + cg * 64 + col]; }
            __syncthreads();
        } else {
            float* LB = (float*)(P.ws + WS_LB);
            { const int i = X.tid; const float l0 = P.in[7][i], l1 = P.in[7][512 + i]; const float p1 = 1.0f / (1.0f + expf(l0 - l1));
              LB[i] = 1e-6f; LB[512 + i] = fmaxf(p1, 1e-6f); }
            float* RP = (float*)(P.ws + WS_ROPE);
            for (int i = X.tid; i < 2048 + 16; i += NTHREADS) { const int pos = i >> 4, f = i & 15; const float inv = powf(10000.0f, -(float)f / 16.0f); const float ang = pos < 128 ? (float)pos * inv : 0.0f;
                RP[2 * i] = cosf(ang); RP[2 * i + 1] = sinf(ang); }
        }
    }
    __syncthreads();
    LAS float* scr = (LAS float*)X.lds + X.wave * (64 * 33);
    const int gw = X.bid * NWAVES + X.wave, NGW = X.nb * NWAVES;
#define DESC_WIN0(i) win0_desc(P, (i))
    TR_LOOP(DESC_WIN0, gw, 1408, NGW);
}
DI void convert_rest(const Ctx& X, const Params& P) {
    LAS float* scr = (LAS float*)X.lds + X.wave * (64 * 33);
    const int gw = X.bid * NWAVES + X.wave, NGW = X.nb * NWAVES;
#define DESC_REST(i) rest_desc(P, (i))
    TR_LOOP(DESC_REST, gw, 2432, NGW);
}

DI const float* mods_row(const Params& P, int l, int row) { const int cond = row < NLAT ? (row >> 13) : 2; return (const float*)(P.ws + WS_MODS) + (l * 3 + cond) * 6144; }
template <int NR>
DI void modulate_rows(const Ctx& X, const Params& P, int l, int row0) {
    bf16_t* H = (bf16_t*)(P.ws + WS_H);
    const float* xr = row0 < NLAT ? P.in[0] + (size_t)row0 * D : P.in[2] + (size_t)(row0 - NLAT) * D; const float* md = mods_row(P, l, row0);
    f32x4 x[NR][4];
#pragma unroll
    for (int j = 0; j < 4; ++j)
#pragma unroll
        for (int r = 0; r < NR; ++r) x[r][j] = *(const f32x4*)(xr + (size_t)r * D + 4 * X.lane + 256 * j);
#pragma unroll
    for (int j = 0; j < 4; ++j) { const int c = 4 * X.lane + 256 * j; const f32x4 sh = *(const f32x4*)(md + c), sc = *(const f32x4*)(md + 1024 + c);
#pragma unroll
        for (int r = 0; r < NR; ++r) *(unsigned*)((unsigned char*)H + (size_t)(row0 + r) * D + c) = pk_fp8x4(x[r][j] * (1.0f + sc) + sh); }
}
DI void ph_modulate(const Ctx& X, const Params& P, int l) {
    const int gw = X.bid * NWAVES + X.wave;
    if (gw < NLAT / 8) { modulate_rows<4>(X, P, l, 8 * gw); modulate_rows<4>(X, P, l, 8 * gw + 4); }
    if (gw < NCTX) modulate_rows<1>(X, P, l, NLAT + gw);
}
template <int NR>
DI void ln1_rows(const Ctx& X, const Params& P, int l, int row0, int slot0, const LAS float* wrT, float (&lgv)[16]) {
    bf16_t* H = (bf16_t*)(P.ws + WS_H); const bf16_t* YO = (const bf16_t*)(P.ws + WS_YO); bf16_t* X1 = (bf16_t*)(P.ws + WS_X1) + (size_t)row0 * D;
    const float* g = P.in[12] + l * D; const float* bta = P.in[13] + l * D;
    const bool lat = row0 < NLAT;
    const float* xr = lat ? P.in[0] + (size_t)row0 * D : P.in[2] + (size_t)(row0 - NLAT) * D;
    const bf16_t* xb = (const bf16_t*)P.out + (size_t)row0 * D;
    const float* md = mods_row(P, l, row0);
    const int c0 = 4 * X.lane;
    f32x4 v[NR][4]; float sm[NR];
#pragma unroll
    for (int r = 0; r < NR; ++r) sm[r] = 0.f;
#pragma unroll
    for (int j = 0; j < 4; ++j) { const int c = c0 + 256 * j; const f32x4 g1 = *(const f32x4*)(md + 2048 + c);
#pragma unroll
        for (int r = 0; r < NR; ++r) { f32x4 x; if (l == 0) x = *(const f32x4*)(xr + (size_t)r * D + c); else { const u32x2 xw = *(const u32x2*)(xb + (size_t)r * D + c); x = (f32x4){bflo(xw.x), bfhi(xw.x), bflo(xw.y), bfhi(xw.y)}; }
            const u32x2 yw = *(const u32x2*)(YO + (size_t)(row0 + r) * D + c);
            const f32x4 y = {bflo(yw.x), bfhi(yw.x), bflo(yw.y), bfhi(yw.y)}; v[r][j] = ALPHA * x + g1 * y; sm[r] += (v[r][j][0] + v[r][j][1]) + (v[r][j][2] + v[r][j][3]); } }
    float rstd[NR];
#pragma unroll
    for (int r = 0; r < NR; ++r) { const float mean = wave_sum(sm[r]) * (1.0f / D); float q = 0.f;
#pragma unroll
        for (int j = 0; j < 4; ++j) { v[r][j] = v[r][j] - mean; q += (v[r][j][0] * v[r][j][0] + v[r][j][1] * v[r][j][1]) + (v[r][j][2] * v[r][j][2] + v[r][j][3] * v[r][j][3]); }
        sm[r] = q; }
#pragma unroll
    for (int r = 0; r < NR; ++r) rstd[r] = 1.0f / sqrtf(wave_sum(sm[r]) * (1.0f / D) + LN_EPS);
#pragma unroll
    for (int j = 0; j < 4; ++j) { const int c = c0 + 256 * j; const f32x4 gm = *(const f32x4*)(g + c), bt = *(const f32x4*)(bta + c), sc2 = *(const f32x4*)(md + 4096 + c), sh2 = *(const f32x4*)(md + 3072 + c);
#pragma unroll
        for (int r = 0; r < NR; ++r) { const f32x4 x1 = v[r][j] * rstd[r] * gm + bt; store_bf4(X1 + (size_t)r * D + c, x1);
            const f32x4 h2 = x1 * (1.0f + sc2) + sh2; *(unsigned*)((unsigned char*)H + (size_t)(row0 + r) * D + c) = pk_fp8x4(h2); v[r][j] = h2; } }
#pragma unroll
    for (int e = 0; e < 16; ++e) {
        f32x4 w[4];
#pragma unroll
        for (int j = 0; j < 4; ++j) w[j] = *(const LAS f32x4*)(wrT + e * 1024 + c0 + 256 * j);
#pragma unroll
        for (int r = 0; r < NR; ++r) { f32x4 acc = v[r][0] * w[0]; acc += v[r][1] * w[1]; acc += v[r][2] * w[2]; acc += v[r][3] * w[3];
            const float tot = wave_sum((acc[0] + acc[1]) + (acc[2] + acc[3]));
            lgv[e] = X.lane == slot0 + r ? tot : lgv[e]; }
        asm volatile("" ::: "memory");
    }
}
DI void ph_ln1(const Ctx& X, const Params& P, int l, bool dummy = false) {
    LAS float* wrT = (LAS float*)X.lds;
    for (int i = X.tid; i < 16384; i += NTHREADS) { const int k = i >> 4, e = i & 15; wrT[e * 1024 + k] = P.in[16][i]; }
    int* TOKP = (int*)(P.ws + WS_TOKP); int* LIST = (int*)(P.ws + WS_LIST);
    unsigned* CNT = (unsigned*)(P.ws + WS_CTL) + CW_CNT + 1024 * l + (dummy ? 4096 : 0);
    LAS int* lcnt = (LAS int*)(X.lds + 65536); LAS int* lbase = lcnt + 16; LAS int* linfo = lcnt + 32;
    if (X.tid < 16) lcnt[X.tid] = 0;
    for (int i = X.tid; i < 72 * 4; i += NTHREADS) linfo[i] = -1;
    __syncthreads();
    const int gw = X.bid * NWAVES + X.wave;
    float lgv[16];
#pragma unroll
    for (int e = 0; e < 16; ++e) lgv[e] = 0.f;
    if (gw < NLAT / 8) ln1_rows<8>(X, P, l, 8 * gw, 0, wrT, lgv);
    const bool hasctx = l == 0 && gw < NCTX;
    if (hasctx) ln1_rows<1>(X, P, l, NLAT + gw, 8, wrT, lgv);
    {
        int* TOKE = (int*)(P.ws + WS_TOKE); float* TOKW = (float*)(P.ws + WS_TOKW);
        const int k = X.lane; const bool valid = (k < 8 && gw < NLAT / 8) || (k == 8 && hasctx); const int row = k < 8 ? 8 * gw + k : NLAT + gw;
        float sg[16], sel[16];
#pragma unroll
        for (int e = 0; e < 16; ++e) { sg[e] = sigmoidf_(lgv[e]); sel[e] = sg[e] + P.in[17][e]; }
        int best = 0; float bestv = -3e38f;
#pragma unroll
        for (int gq = 0; gq < 4; ++gq) { float m1 = -3e38f, m2 = -3e38f;
#pragma unroll
            for (int j = 0; j < 4; ++j) { const float t = sel[gq * 4 + j]; const float lo = fminf(m1, t); m1 = fmaxf(m1, t); m2 = fmaxf(m2, lo); }
            const float gs = m1 + m2; const bool bt = gs > bestv; best = bt ? gq : best; bestv = bt ? gs : bestv; }
        int i0 = 0, i1 = 0; float v0 = -3e38f, v1 = -3e38f, s0 = 0.f, s1 = 0.f;
#pragma unroll
        for (int e = 0; e < 16; ++e) { const float t = (e >> 2) == best ? sel[e] : -3e38f; const bool c0 = t > v0, c1 = !c0 && t > v1;
            v1 = c0 ? v0 : (c1 ? t : v1); i1 = c0 ? i0 : (c1 ? e : i1); s1 = c0 ? s0 : (c1 ? sg[e] : s1);
            v0 = c0 ? t : v0; i0 = c0 ? e : i0; s0 = c0 ? sg[e] : s0; }
        if (valid) { const int slot = X.wave * 9 + k; const float inv = 1.0f / (s0 + s1);
            const int p0 = __hip_atomic_fetch_add(lcnt + i0, 1, __ATOMIC_RELAXED, __HIP_MEMORY_SCOPE_WORKGROUP), p1 = __hip_atomic_fetch_add(lcnt + i1, 1, __ATOMIC_RELAXED, __HIP_MEMORY_SCOPE_WORKGROUP);
            linfo[4 * slot] = row; linfo[4 * slot + 1] = i0 | (i1 << 8); linfo[4 * slot + 2] = p0; linfo[4 * slot + 3] = p1;
            TOKE[2 * row] = i0; TOKE[2 * row + 1] = i1; TOKW[2 * row] = s0 * inv; TOKW[2 * row + 1] = s1 * inv; }
    }
    __syncthreads();
    if (X.tid < 16) lbase[X.tid] = (int)atomicAdd(CNT + 64 * X.tid, (unsigned)lcnt[X.tid]);
    __syncthreads();
    if (X.tid < 72) { const int row = linfo[4 * X.tid];
        if (row >= 0) { const int ee = linfo[4 * X.tid + 1], e0 = ee & 255, e1 = ee >> 8, p0 = lbase[e0] + linfo[4 * X.tid + 2], p1 = lbase[e1] + linfo[4 * X.tid + 3];
            LIST[e0 * LISTCAP + p0] = row; LIST[e1 * LISTCAP + p1] = row; TOKP[2 * row] = p0; TOKP[2 * row + 1] = p1; } }
}
template <int NR>
DI void ln2_rows(const Ctx& X, const Params& P, int l, int row0, const int (&off)[16]) {
    bf16_t* H = (bf16_t*)(P.ws + WS_H); const unsigned char* O = P.ws + WS_O; const bf16_t* X1 = (const bf16_t*)(P.ws + WS_X1) + (size_t)row0 * D;
    const int* TOKE = (const int*)(P.ws + WS_TOKE); const int* TOKP = (const int*)(P.ws + WS_TOKP); const float* TOKW = (const float*)(P.ws + WS_TOKW);
    const float* g = P.in[14] + l * D; const float* bta = P.in[15] + l * D;
    const bool lat = row0 < NLAT;
    const float* md = mods_row(P, l, row0); const float* mdn = mods_row(P, 1, row0);
    const int c0 = 4 * X.lane;
    const unsigned char* ra[NR]; const unsigned char* rb[NR]; float w0[NR], w1[NR];
#pragma unroll
    for (int r = 0; r < NR; ++r) { const int row = row0 + r; const int e0 = TOKE[2 * row], e1 = TOKE[2 * row + 1]; int o0 = 0, o1 = 0;
#pragma unroll
        for (int e = 0; e < 16; ++e) { if (e == e0) o0 = off[e]; if (e == e1) o1 = off[e]; }
        ra[r] = O + (size_t)(o0 + TOKP[2 * row]) * D; rb[r] = O + (size_t)(o1 + TOKP[2 * row + 1]) * D; w0[r] = TOKW[2 * row] * 0.0625f; w1[r] = TOKW[2 * row + 1] * 0.0625f; }
    f32x4 v[NR][4]; float sm[NR];
#pragma unroll
    for (int r = 0; r < NR; ++r) sm[r] = 0.f;
#pragma unroll
    for (int j = 0; j < 4; ++j) { const int c = c0 + 256 * j; const f32x4 g2 = *(const f32x4*)(md + 5120 + c);
#pragma unroll
        for (int r = 0; r < NR; ++r) { const u32x2 xw = *(const u32x2*)(X1 + (size_t)r * D + c); const f32x4 x = {bflo(xw.x), bfhi(xw.x), bflo(xw.y), bfhi(xw.y)}; const int a = *(const int*)(ra[r] + c), b = *(const int*)(rb[r] + c);
            const f32x2 a01 = __builtin_amdgcn_cvt_pk_f32_fp8(a, false), a23 = __builtin_amdgcn_cvt_pk_f32_fp8(a, true), b01 = __builtin_amdgcn_cvt_pk_f32_fp8(b, false), b23 = __builtin_amdgcn_cvt_pk_f32_fp8(b, true);
            const f32x4 f = w0[r] * (f32x4){a01[0], a01[1], a23[0], a23[1]} + w1[r] * (f32x4){b01[0], b01[1], b23[0], b23[1]};
            v[r][j] = ALPHA * x + g2 * f; sm[r] += (v[r][j][0] + v[r][j][1]) + (v[r][j][2] + v[r][j][3]); } }
    float rstd[NR];
#pragma unroll
    for (int r = 0; r < NR; ++r) { const float mean = wave_sum(sm[r]) * (1.0f / D); float q = 0.f;
#pragma unroll
        for (int j = 0; j < 4; ++j) { v[r][j] = v[r][j] - mean; q += (v[r][j][0] * v[r][j][0] + v[r][j][1] * v[r][j][1]) + (v[r][j][2] * v[r][j][2] + v[r][j][3] * v[r][j][3]); }
        sm[r] = q; }
#pragma unroll
    for (int r = 0; r < NR; ++r) rstd[r] = 1.0f / sqrtf(wave_sum(sm[r]) * (1.0f / D) + LN_EPS);
#pragma unroll
    for (int j = 0; j < 4; ++j) { const int c = c0 + 256 * j; const f32x4 gm = *(const f32x4*)(g + c), bt = *(const f32x4*)(bta + c);
        f32x4 sc1 = {0.f, 0.f, 0.f, 0.f}, sh1 = {0.f, 0.f, 0.f, 0.f}; if (l == 0) { sc1 = *(const f32x4*)(mdn + 1024 + c); sh1 = *(const f32x4*)(mdn + c); }
#pragma unroll
        for (int r = 0; r < NR; ++r) { const f32x4 x2 = v[r][j] * rstd[r] * gm + bt;
            if (l == 0) { if (lat) store_bf4((bf16_t*)P.out + (size_t)(row0 + r) * D + c, x2); *(unsigned*)((unsigned char*)H + (size_t)(row0 + r) * D + c) = pk_fp8x4(x2 * (1.0f + sc1) + sh1); }
            else *(f32x4*)(P.out + (size_t)(row0 + r) * D + c) = x2; } }
}
DI void ph_ln2(const Ctx& X, const Params& P, int l) {
    const unsigned* CNT = (const unsigned*)(P.ws + WS_CTL) + CW_CNT + 1024 * l;
    int off[16]; { int acc = 0;
#pragma unroll
        for (int e = 0; e < 16; ++e) { off[e] = acc; acc += (((int)CNT[e * 64] + 255) >> 8) << 8; } }
    const int gw = X.bid * NWAVES + X.wave;
    if (gw < NLAT / 8) { ln2_rows<4>(X, P, l, 8 * gw, off); ln2_rows<4>(X, P, l, 8 * gw + 4, off); }
    if (l == 0 && gw < NCTX) ln2_rows<1>(X, P, l, NLAT + gw, off);
}

struct KeysNA { int b, r, c, rs, cs, h; const float* rpb;
    DI int n() const { return 128 + CTXL; }
    DI void get(int k, int& krow, float& bias) const { if (k < 128) { const int kr = rs + (k >> 4), kc = cs + (k & 15); krow = b * SEQ + kr * 64 + kc; bias = LOG2E * rpb[h * 465 + (kr - r + 7) * 31 + (kc - c + 15)]; } else { krow = NLAT + b * CTXL + (k - 128); bias = 0.f; } } };
struct KeysSWA { int b, lo, nband;
    DI int n() const { return nband + CTXL; }
    DI void get(int k, int& krow, float& bias) const { krow = k < nband ? b * SEQ + lo + k : NLAT + b * CTXL + (k - nband); bias = 0.f; } };
struct KeysCtx { int b;
    DI int n() const { return CTXL; }
    DI void get(int k, int& krow, float& bias) const { krow = NLAT + b * CTXL + k; bias = 0.f; } };
template <class Keys>
DI void attn_row_naive(const bf16_t* PB, int qrow, int qcol, int kcol, int vcol, const Keys& KS, bool has_sink, float sink, LAS float* sc, bf16_t* yout, int lane) {
    float q[64];
    { const u32x4* qp = (const u32x4*)(PB + (size_t)qrow * PBW + qcol);
#pragma unroll
      for (int i = 0; i < 8; ++i) { const u32x4 w = qp[i]; q[8 * i] = bflo(w.x); q[8 * i + 1] = bfhi(w.x); q[8 * i + 2] = bflo(w.y); q[8 * i + 3] = bfhi(w.y); q[8 * i + 4] = bflo(w.z); q[8 * i + 5] = bfhi(w.z); q[8 * i + 6] = bflo(w.w); q[8 * i + 7] = bfhi(w.w); } }
    const int nk = KS.n(); float mx = has_sink ? sink : -3e38f;
    for (int k = lane; k < nk; k += 64) { int krow; float bias; KS.get(k, krow, bias);
        const u32x4* kp = (const u32x4*)(PB + (size_t)krow * PBW + kcol); float s = 0.f;
#pragma unroll
        for (int i = 0; i < 8; ++i) { const u32x4 w = kp[i]; s += q[8 * i] * bflo(w.x) + q[8 * i + 1] * bfhi(w.x) + q[8 * i + 2] * bflo(w.y) + q[8 * i + 3] * bfhi(w.y) + q[8 * i + 4] * bflo(w.z) + q[8 * i + 5] * bfhi(w.z) + q[8 * i + 6] * bflo(w.w) + q[8 * i + 7] * bfhi(w.w); }
        s += bias; sc[k] = s; mx = fmaxf(mx, s); }
    mx = wave_max(mx); float den = 0.f;
    for (int k = lane; k < nk; k += 64) { const float p = exp2f(sc[k] - mx); sc[k] = p; den += p; }
    den = wave_sum(den); if (has_sink) den += exp2f(sink - mx);
    asm volatile("s_waitcnt lgkmcnt(0)" ::: "memory");
    float o = 0.f;
    for (int k = 0; k < nk; ++k) { int krow; float bias; KS.get(k, krow, bias); o += sc[k] * bf2f(PB[(size_t)krow * PBW + vcol + lane]); }
    yout[lane] = (bf16_t)f2bf(o / den);
    asm volatile("s_waitcnt lgkmcnt(0)" ::: "memory");
}
DI void ph_attn_naive(const Ctx& X, const Params& P, int l) {
    const bf16_t* PB = (const bf16_t*)(P.ws + WS_PB); bf16_t* Y = (bf16_t*)(P.ws + WS_Y);
    LAS float* sc = (LAS float*)X.lds + X.wave * 640;
    const float* rpb = P.in[9] + l * 4 * 465; const float* sink = P.in[10] + l * 8;
    const int nrows = l == 0 ? NROWS : NLAT;
    const int gw = X.bid * NWAVES + X.wave, NGW = X.nb * NWAVES;
    for (int it = gw; it < nrows * 12; it += NGW) {
        const int row = it / 12, hh = it % 12;
        if (row < NLAT) { const int b = row >> 13, t = row & (SEQ - 1);
            if (hh < 4) { KeysNA K; K.b = b; K.r = t >> 6; K.c = t & 63; K.rs = min(max(K.r - 4, 0), 120); K.cs = min(max(K.c - 8, 0), 48); K.h = hh; K.rpb = rpb;
                attn_row_naive(PB, row, PB_NQ + hh * 64, PB_NK + hh * 64, PB_NV + hh * 64, K, false, 0.f, sc, Y + (size_t)row * D + 256 + hh * 64, X.lane);
            } else { const int qh = hh - 4, n = qh >> 2; KeysSWA K; K.b = b; K.lo = max(t - 128, 0); K.nband = min(t + 128, SEQ - 1) - K.lo + 1;
                attn_row_naive(PB, row, PB_SQ + qh * 64, PB_SK + n * 64, PB_SV + n * 64, K, true, LOG2E * sink[qh], sc, Y + (size_t)row * D + 512 + qh * 64, X.lane); }
        } else { const int b = (row - NLAT) >> 8; KeysCtx K; K.b = b;
            if (hh < 4) attn_row_naive(PB, row, PB_NQ + hh * 64, PB_NK + hh * 64, PB_NV + hh * 64, K, false, 0.f, sc, Y + (size_t)row * D + 256 + hh * 64, X.lane);
            else { const int qh = hh - 4, n = qh >> 2; attn_row_naive(PB, row, PB_SQ + qh * 64, PB_SK + n * 64, PB_SV + n * 64, K, true, LOG2E * sink[qh], sc, Y + (size_t)row * D + 512 + qh * 64, X.lane); }
        }
    }
}
DI void ph_hgrn_naive(const Ctx& X, const Params& P, int l) {
    const bf16_t* PB = (const bf16_t*)(P.ws + WS_PB); const float* Z = (const float*)(P.ws + WS_Z); float* O32 = (float*)(P.ws + WS_S);
    const float* LB = (const float*)(P.ws + WS_LB) + l * 512;
    const int gw = X.bid * NWAVES + X.wave;
    if (gw >= 16) return;
    const int b = gw >> 3, h = (gw >> 1) & 3, dir = gw & 1, lane = X.lane;
    const float lb = LB[dir * 256 + h * 64 + lane];
    float S[64];
#pragma unroll
    for (int d = 0; d < 64; ++d) S[d] = 0.f;
    for (int step = 0; step < CTXL + SEQ; ++step) {
        int row;
        if (step < CTXL) row = NLAT + b * CTXL + (dir ? CTXL - 1 - step : step); else { const int t = step - CTXL; row = b * SEQ + (dir ? SEQ - 1 - t : t); }
        float f = exp2f(bf2f(((const bf16_t*)Z)[(size_t)row * ZW + dir * 256 + h * 64 + lane])); const float kk = bf2f(((const bf16_t*)(P.ws + WS_KK))[(size_t)row * ZW + dir * 256 + h * 64 + lane]); (void)lb;
#if DBG_HG_MODE & 8
        f = 1.0f;
#endif
        const float qv = bf2f(PB[(size_t)row * PBW + PB_AQ + h * 64 + lane]), vv = bf2f(PB[(size_t)row * PBW + PB_AI + h * 64 + lane]);
#if DBG_HG_MODE & 1
        if ((step & 63) == 0) {
#pragma unroll
            for (int d = 0; d < 64; ++d) S[d] = 0.f; }
#endif
        float o = 0.f;
#pragma unroll
        for (int d = 0; d < 64; ++d) { const float fd = __builtin_bit_cast(float, __builtin_amdgcn_readlane(__builtin_bit_cast(int, f), d)), kd = __builtin_bit_cast(float, __builtin_amdgcn_readlane(__builtin_bit_cast(int, kk), d)), qd = __builtin_bit_cast(float, __builtin_amdgcn_readlane(__builtin_bit_cast(int, qv), d));
            S[d] = fd * S[d] + kd * vv; o += S[d] * qd; }
#if DBG_HG_MODE & 2
        if (dir == 1) o = 0.f;
#endif
#if DBG_HG_MODE & 4
        if (dir == 0) o = 0.f;
#endif
        O32[((size_t)dir * NROWS + row) * 256 + h * 64 + lane] = o;
    }
}
DI void ph_hgrn_combine_naive(const Ctx& X, const Params& P, int l) {
    const bf16_t* PB = (const bf16_t*)(P.ws + WS_PB); const float* O32 = (const float*)(P.ws + WS_S); bf16_t* Y = (bf16_t*)(P.ws + WS_Y);
    const float* nw = P.in[8] + l * 64;
    const int nrows = l == 0 ? NROWS : NLAT;
    const int gw = X.bid * NWAVES + X.wave, NGW = X.nb * NWAVES;
    for (int it = gw; it < nrows * 4; it += NGW) { const int row = it >> 2, h = it & 3;
        const float o = O32[(size_t)row * 256 + h * 64 + X.lane] + O32[((size_t)NROWS + row) * 256 + h * 64 + X.lane];
        const float ms = wave_sum(o * o) * (1.0f / 64.0f); const float y = o * (1.0f / sqrtf(ms + RMS_EPS)) * nw[X.lane];
        const float gte = bf2f(PB[(size_t)row * PBW + PB_AG + h * 64 + X.lane]);
        Y[(size_t)row * D + h * 64 + X.lane] = (bf16_t)f2bf(y * siluf_(gte)); }
}

typedef short v4i16_t __attribute__((ext_vector_type(4)));
DI s16x4 tr_read(const LAS unsigned char* p) { return __builtin_bit_cast(s16x4, __builtin_amdgcn_ds_read_tr16_b64_v4i16((LAS v4i16_t*)p)); }
DI bf16x8 cat8(s16x4 a, s16x4 b) { return __builtin_shufflevector(a, b, 0, 1, 2, 3, 4, 5, 6, 7); }
DI bf16x8 pack8(float a0, float a1, float a2, float a3, float a4, float a5, float a6, float a7) {
    u32x4 w; w.x = pk2(a0, a1); w.y = pk2(a2, a3); w.z = pk2(a4, a5); w.w = pk2(a6, a7); return __builtin_bit_cast(bf16x8, w); }
DI float shfl_f(float v, int src) { return __shfl(v, src); }

constexpr int HP = 144;
constexpr size_t WS_QT = WS_H, WS_KT = WS_H + (size_t)2 * NROWS * 256 * 2;
#ifdef DBG_MIX
constexpr size_t WS_ST = 318 * MiB;
#else
constexpr size_t WS_ST = WS_Z;
#endif
static_assert(WS_KT + (size_t)2 * NROWS * 256 * 2 <= WS_Y && (size_t)2112 * 4096 * 2 <= (size_t)NROWS * ZW * 4, "hgrn buffers");
DI void hgrn_chunk_rows(int b, int dir, int p, int& row0) {
    if (p < 4) row0 = NLAT + b * CTXL + 64 * (dir ? 3 - p : p); else row0 = b * SEQ + 64 * (dir ? 131 - p : p - 4);
}
DI void hgrn_local_item(const Ctx& X, const Params& P, int l, int it) {
    const bf16_t* PB = (const bf16_t*)(P.ws + WS_PB); const bf16_t* Z = (const bf16_t*)(P.ws + WS_Z);
    bf16_t* QT = (bf16_t*)(P.ws + WS_QT); bf16_t* KT = (bf16_t*)(P.ws + WS_KT); float* U = (float*)(P.ws + WS_S); float* DD = (float*)(P.ws + WS_DD); float* ER = DD + 2112 * 64;
    const float* LB = (const float*)(P.ws + WS_LB) + l * 512;
    LAS unsigned char* kt_l = X.lds + X.wave * (2 * 64 * HP); LAS unsigned char* v_l = kt_l + 64 * HP;
    const int lane = X.lane;
    if (it < 2112) {
        const int p = it % NCHAIN, chain = it / NCHAIN, dir = chain & 1, h = (chain >> 1) & 3, b = chain >> 3;
        int row0; hgrn_chunk_rows(b, dir, p, row0);
#pragma unroll
        for (int i = 0; i < 8; ++i) { const int r = i * 8 + (lane >> 3), pc = lane & 7; const u32x4 w = *(const u32x4*)(PB + (size_t)(row0 + r) * PBW + PB_AI + h * 64 + pc * 8); *(LAS u32x4*)(v_l + r * HP + pc * 16) = w; }
        float lf[64];
        const bf16_t* zp = Z + (size_t)row0 * ZW + dir * 256 + h * 64 + lane;
#pragma unroll
        for (int s = 0; s < 64; ++s) lf[s] = bf2f(zp[(size_t)s * ZW]);
        float ref, last;
        if (dir == 0) {
#pragma unroll
            for (int s = 1; s < 64; ++s) lf[s] += lf[s - 1];
            ref = lf[31]; last = lf[63];
        } else {
#pragma unroll
            for (int s = 62; s >= 0; --s) lf[s] += lf[s + 1];
            ref = lf[32]; last = lf[0];
        }
        const bf16_t* qp = PB + (size_t)row0 * PBW + PB_AQ + h * 64 + lane; const bf16_t* kp = (const bf16_t*)(P.ws + WS_KK) + (size_t)row0 * ZW + dir * 256 + h * 64 + lane;
        bf16_t* qto = QT + ((size_t)dir * NROWS + row0) * 256 + h * 64 + lane; bf16_t* kto = KT + ((size_t)dir * NROWS + row0) * 256 + h * 64 + lane;
#pragma unroll
        for (int hf = 0; hf < 2; ++hf) {
            unsigned short qv[32], kv[32];
#pragma unroll
            for (int s = 0; s < 32; ++s) { qv[s] = qp[(size_t)(32 * hf + s) * PBW]; kv[s] = kp[(size_t)(32 * hf + s) * ZW]; }
#pragma unroll
            for (int s2 = 0; s2 < 32; ++s2) { const int s = 32 * hf + s2;
                const float q = bf2f(qv[s2]), kk = bf2f(kv[s2]);
                const float eq = __builtin_amdgcn_exp2f(lf[s] - ref), ek = __builtin_amdgcn_exp2f(ref - lf[s]);
                const unsigned short qb = (unsigned short)f2bf(q * eq), kb = (unsigned short)f2bf(kk * ek);
                qto[(size_t)s * 256] = qb; kto[(size_t)s * 256] = kb;
                *(LAS unsigned short*)(kt_l + s * HP + lane * 2) = kb; }
            asm volatile("" ::: "memory");
        }
        asm volatile("" ::: "memory");
        const float e_lr = __builtin_amdgcn_exp2f(last - ref);
        DD[it * 64 + lane] = __builtin_amdgcn_exp2f(last); ER[it * 64 + lane] = __builtin_amdgcn_exp2f(ref);
        f32x4 acc[4][4];
#pragma unroll
        for (int m = 0; m < 4; ++m)
#pragma unroll
            for (int n = 0; n < 4; ++n) acc[m][n] = (f32x4){0.f, 0.f, 0.f, 0.f};
        const int g = lane >> 4, i16 = lane & 15;
        const int troff = (8 * g + (i16 >> 2)) * HP + (i16 & 3) * 8;
#pragma unroll
        for (int ks = 0; ks < 2; ++ks) {
            bf16x8 af[4], bfv[4];
#pragma unroll
            for (int m = 0; m < 4; ++m) af[m] = cat8(tr_read(kt_l + troff + ks * 32 * HP + m * 32), tr_read(kt_l + troff + (ks * 32 + 4) * HP + m * 32));
#pragma unroll
            for (int n = 0; n < 4; ++n) bfv[n] = cat8(tr_read(v_l + troff + ks * 32 * HP + n * 32), tr_read(v_l + troff + (ks * 32 + 4) * HP + n * 32));
#pragma unroll
            for (int m = 0; m < 4; ++m)
#pragma unroll
                for (int n = 0; n < 4; ++n) acc[m][n] = __builtin_amdgcn_mfma_f32_16x16x32_bf16(af[m], bfv[n], acc[m][n], 0, 0, 0);
        }
        float* up = U + (size_t)it * 4096;
#pragma unroll
        for (int m = 0; m < 4; ++m)
#pragma unroll
            for (int r = 0; r < 4; ++r) { const int d = 16 * m + 4 * g + r; const float sc = shfl_f(e_lr, d);
#pragma unroll
                for (int n = 0; n < 4; ++n) up[d * 64 + 16 * n + i16] = acc[m][n][r] * sc; }
        asm volatile("s_waitcnt lgkmcnt(0)" ::: "memory");
    }
}
DI void ph_hgrn_scan(const Ctx& X, const Params& P, int part) {
    const float* U = (const float*)(P.ws + WS_S); const float* DD = (const float*)(P.ws + WS_DD); const float* ER = DD + 2112 * 64; bf16_t* ST = (bf16_t*)(P.ws + WS_ST);
    const int gt = part * NTHREADS + X.tid;
    const int chain = gt >> 11, d = (gt >> 5) & 63, e2 = (gt & 31) * 2;
    float s0 = 0.f, s1 = 0.f;
    for (int p0 = 0; p0 < NCHAIN; p0 += 4) {
        f32x2 u[4]; float dd[4], er[4];
#pragma unroll
        for (int j = 0; j < 4; ++j) { const int slot = chain * NCHAIN + p0 + j; u[j] = *(const f32x2*)(U + (size_t)slot * 4096 + d * 64 + e2); dd[j] = DD[slot * 64 + d]; er[j] = ER[slot * 64 + d]; }
#pragma unroll
        for (int j = 0; j < 4; ++j) { const int slot = chain * NCHAIN + p0 + j; *(unsigned*)(ST + (size_t)slot * 4096 + d * 64 + e2) = pk2(s0 * er[j], s1 * er[j]); s0 = dd[j] * s0 + u[j][0]; s1 = dd[j] * s1 + u[j][1]; }
    }
}
DI void hgrn_out_item(const Ctx& X, const Params& P, int l, int it) {
    const bf16_t* PB = (const bf16_t*)(P.ws + WS_PB); const bf16_t* QT = (const bf16_t*)(P.ws + WS_QT); const bf16_t* KT = (const bf16_t*)(P.ws + WS_KT); const bf16_t* ST = (const bf16_t*)(P.ws + WS_ST);
    unsigned char* Y = P.ws + WS_Y;        const float* nw = P.in[8] + l * 64;
    LAS unsigned char* s_l = X.lds + X.wave * (2 * 64 * HP); LAS unsigned char* v_l = s_l + 64 * HP;
    const int lane = X.lane, g = lane >> 4, i16 = lane & 15, gw = X.wave * X.nb + X.bid, NGW = X.nb * NWAVES;
    const int nchunk = l == 0 ? 132 : 128;
    const int troff = (8 * g + (i16 >> 2)) * HP + (i16 & 3) * 8;
    const int troff4 = (4 * g + (i16 >> 2)) * HP + (i16 & 3) * 8;
    (void)gw; (void)NGW;
    if (it < 8 * nchunk) {
        const int c = it % nchunk, bh = it / nchunk, h = bh & 3, b = bh >> 2;
        const bool isctx = c >= 128; const int row0 = isctx ? NLAT + b * CTXL + 64 * (c - 128) : b * SEQ + 64 * c;
#pragma unroll
        for (int i = 0; i < 8; ++i) { const int r = i * 8 + (lane >> 3), pc = lane & 7; const u32x4 w = *(const u32x4*)(PB + (size_t)(row0 + r) * PBW + PB_AI + h * 64 + pc * 8); *(LAS u32x4*)(v_l + r * HP + pc * 16) = w; }
        f32x4 o[4][4];
#pragma unroll
        for (int a = 0; a < 4; ++a)
#pragma unroll
            for (int t = 0; t < 4; ++t) o[a][t] = (f32x4){0.f, 0.f, 0.f, 0.f};
#pragma unroll 1
        for (int dir = 0; dir < 2; ++dir) {
#if DBG_HG_MODE & 2
            if (dir == 1) continue;
#endif
#if DBG_HG_MODE & 4
            if (dir == 0) continue;
#endif
            const int p = isctx ? (dir ? 3 - (c - 128) : c - 128) : (dir ? 127 - c + 4 : c + 4);
            const int slot = ((b * 4 + h) * 2 + dir) * NCHAIN + p, sgn = 1 - 2 * dir;
            asm volatile("s_waitcnt lgkmcnt(0)" ::: "memory");
#pragma unroll
            for (int i = 0; i < 8; ++i) { const int r = i * 8 + (lane >> 3), pc = lane & 7; const u32x4 w = *(const u32x4*)(ST + (size_t)slot * 4096 + r * 64 + pc * 8); *(LAS u32x4*)(s_l + r * HP + pc * 16) = w; }
            const bf16_t* qt = QT + ((size_t)dir * NROWS + row0) * 256 + h * 64 + g * 8; const bf16_t* kt = KT + ((size_t)dir * NROWS + row0) * 256 + h * 64 + g * 8;
            bf16x8 qf[4][2];
#pragma unroll
            for (int t = 0; t < 4; ++t)
#pragma unroll
                for (int ks = 0; ks < 2; ++ks) qf[t][ks] = *(const bf16x8*)(qt + (size_t)(16 * t + i16) * 256 + 32 * ks);
#pragma unroll
            for (int pr = 0; pr < 2; ++pr) {
                bf16x8 kf[2][2];
#pragma unroll
                for (int t = 0; t < 2; ++t)
#pragma unroll
                    for (int ks = 0; ks < 2; ++ks) kf[t][ks] = *(const bf16x8*)(kt + (size_t)(16 * (2 * pr + t) + i16) * 256 + 32 * ks);
                f32x4 sc[2][4];
#pragma unroll
                for (int s2 = 0; s2 < 2; ++s2)
#pragma unroll
                    for (int tt = 0; tt < 4; ++tt) { f32x4 a = {0.f, 0.f, 0.f, 0.f};
                        a = __builtin_amdgcn_mfma_f32_16x16x32_bf16(kf[s2][0], qf[tt][0], a, 0, 0, 0); a = __builtin_amdgcn_mfma_f32_16x16x32_bf16(kf[s2][1], qf[tt][1], a, 0, 0, 0);
#pragma unroll
                        for (int r = 0; r < 4; ++r) { const int sidx = 16 * (2 * pr + s2) + 4 * g + r, tidx = 16 * tt + i16; const int keep = ~(((tidx - sidx) * sgn) >> 31); { const float av = a[r]; a[r] = __int_as_float(__float_as_int(av) & keep); } }
                        sc[s2][tt] = a; }
                bf16x8 vf[4];
#pragma unroll
#ifdef DBG_NO_TR
                for (int et = 0; et < 4; ++et) { unsigned short tv[8];
#pragma unroll
                    for (int j = 0; j < 8; ++j) { const int sidx = 32 * pr + (j < 4 ? 4 * g + j : 16 + 4 * g + (j - 4)); tv[j] = *(const LAS unsigned short*)(v_l + sidx * HP + (16 * et + i16) * 2); }
                    u32x4 w; w.x = tv[0] | ((unsigned)tv[1] << 16); w.y = tv[2] | ((unsigned)tv[3] << 16); w.z = tv[4] | ((unsigned)tv[5] << 16); w.w = tv[6] | ((unsigned)tv[7] << 16); vf[et] = __builtin_bit_cast(bf16x8, w); }
#else
                for (int et = 0; et < 4; ++et) vf[et] = cat8(tr_read(v_l + troff4 + (32 * pr) * HP + et * 32), tr_read(v_l + troff4 + (32 * pr + 16) * HP + et * 32));
#endif
#ifdef DBG_BRUTE
                {   float* dacc = (float*)(P.ws + WS_CTL) + CW_DBG + 16; float nA = 0.f, dA = 0.f, nB = 0.f, dB = 0.f;
                    const bf16_t* qt0 = QT + ((size_t)dir * NROWS + row0) * 256 + h * 64; const bf16_t* kt0 = KT + ((size_t)dir * NROWS + row0) * 256 + h * 64;
#if DBG_TEST == 1
#pragma unroll
                    for (int s2 = 0; s2 < 2; ++s2)
#pragma unroll
                        for (int tt = 0; tt < 4; ++tt)
#pragma unroll
                            for (int r = 0; r < 4; ++r) *(LAS float*)(s_l + (((s2 * 4 + tt) * 4 + r) * 64 + lane) * 4) = sc[s2][tt][r];
                    asm volatile("s_waitcnt lgkmcnt(0)" ::: "memory");
#pragma unroll 1
                    for (int idx = 0; idx < 32; ++idx) { const int s2 = idx >> 4, tt = (idx >> 2) & 3, r = idx & 3; const int sidx = 16 * (2 * pr + s2) + 4 * g + r, tidx = 16 * tt + i16; float ref = 0.f;
#pragma unroll 1
                        for (int d = 0; d < 64; ++d) ref += bf2f(kt0[(size_t)sidx * 256 + d]) * bf2f(qt0[(size_t)tidx * 256 + d]);
                        if (sidx > tidx) ref = 0.f; const float got = *(LAS float*)(s_l + (idx * 64 + lane) * 4); const float df = got - ref; nA += df * df; dA += ref * ref; }
#endif
#if DBG_TEST == 2
#pragma unroll
                    for (int et = 0; et < 4; ++et)
#pragma unroll
                        for (int j = 0; j < 8; ++j) { const int sidx = 32 * pr + (j < 4 ? 4 * g + j : 16 + 4 * g + (j - 4)); const float ref = bf2f(PB[(size_t)(row0 + sidx) * PBW + PB_AI + h * 64 + 16 * et + i16]);
                            const float got = bf2f((unsigned short)vf[et][j]); const float df = got - ref; nB += df * df; dB += ref * ref; asm volatile("" : "+v"(nB), "+v"(dB) :: "memory"); }
#endif
                    nA = wave_sum(nA); dA = wave_sum(dA); nB = wave_sum(nB); dB = wave_sum(dB); if (lane == 0) { atomicAdd(dacc, nA); atomicAdd(dacc + 1, dA); atomicAdd(dacc + 2, nB); atomicAdd(dacc + 3, dB); }
                }
#endif
#pragma unroll
                for (int tt = 0; tt < 4; ++tt) { const f32x4 p0 = sc[0][tt], p1 = sc[1][tt]; const bf16x8 pf = pack8(p0[0], p0[1], p0[2], p0[3], p1[0], p1[1], p1[2], p1[3]);
#pragma unroll
                    for (int et = 0; et < 4; ++et) o[et][tt] = __builtin_amdgcn_mfma_f32_16x16x32_bf16(vf[et], pf, o[et][tt], 0, 0, 0); }
                asm volatile("" ::: "memory");
            }
#pragma unroll
            for (int ks = 0; ks < ((DBG_HG_MODE & 1) ? 0 : 2); ++ks) {
                bf16x8 sf[4];
#pragma unroll
                for (int et = 0; et < 4; ++et) sf[et] = cat8(tr_read(s_l + troff + (32 * ks) * HP + et * 32), tr_read(s_l + troff + (32 * ks + 4) * HP + et * 32));
#pragma unroll
                for (int tt = 0; tt < 4; ++tt)
#pragma unroll
                    for (int et = 0; et < 4; ++et) o[et][tt] = __builtin_amdgcn_mfma_f32_16x16x32_bf16(sf[et], qf[tt][ks], o[et][tt], 0, 0, 0);
            }
        }
#if defined(DBG_BRUTE) && DBG_TEST == 3
        {
            float* dacc = (float*)(P.ws + WS_CTL) + CW_DBG + 8; float num = 0.f, den = 0.f;
            const bf16_t* qt0 = QT + ((size_t)0 * NROWS + row0) * 256 + h * 64; const bf16_t* kt0 = KT + ((size_t)0 * NROWS + row0) * 256 + h * 64;
            for (int tt = 0; tt < 4; ++tt) for (int et = 0; et < 4; ++et) for (int r = 0; r < 4; ++r) {
                const int t = 16 * tt + i16, e = 16 * et + 4 * g + r; float ref = 0.f;
                for (int s2 = 0; s2 <= t; ++s2) { float sc = 0.f; for (int d = 0; d < 64; ++d) sc += bf2f(kt0[(size_t)s2 * 256 + d]) * bf2f(qt0[(size_t)t * 256 + d]);
                    ref += bf2f((unsigned short)f2bf(sc)) * bf2f(PB[(size_t)(row0 + s2) * PBW + PB_AI + h * 64 + e]); }
                float got = 0.f;
#pragma unroll
                for (int a = 0; a < 4; ++a)
#pragma unroll
                    for (int b2 = 0; b2 < 4; ++b2)
#pragma unroll
                        for (int c2 = 0; c2 < 4; ++c2) if (a == tt && b2 == et && c2 == r) got = o[b2][a][c2];
                num += (got - ref) * (got - ref); den += ref * ref; }
            num = wave_sum(num); den = wave_sum(den); if (lane == 0) { atomicAdd(dacc, num); atomicAdd(dacc + 1, den); }
        }
#endif
#pragma unroll
        for (int tt = 0; tt < 4; ++tt) {
            float ss = 0.f;
#pragma unroll
            for (int et = 0; et < 4; ++et) ss += (o[et][tt][0] * o[et][tt][0] + o[et][tt][1] * o[et][tt][1]) + (o[et][tt][2] * o[et][tt][2] + o[et][tt][3] * o[et][tt][3]);
            ss += __shfl_xor(ss, 16); ss += __shfl_xor(ss, 32);
            const float rstd = 1.0f / sqrtf(ss * (1.0f / 64.0f) + RMS_EPS);
            const size_t row = (size_t)row0 + 16 * tt + i16;
#pragma unroll
            for (int et = 0; et < 4; ++et) { const int e = 16 * et + 4 * g; const u32x2 gw2 = *(const u32x2*)(PB + row * PBW + PB_AG + h * 64 + e); const f32x4 wv = *(const f32x4*)(nw + e);
                const f32x4 gt = {bflo(gw2.x), bfhi(gw2.x), bflo(gw2.y), bfhi(gw2.y)}; f32x4 y;
#pragma unroll
                for (int r = 0; r < 4; ++r) y[r] = o[et][tt][r] * rstd * wv[r] * siluf_(gt[r]);
                *(unsigned*)(Y + row * D + h * 64 + e) = pk_fp8x4(y); }
        }
        asm volatile("s_waitcnt lgkmcnt(0)" ::: "memory");
    }
}


DI void ph_hgrn_out(const Ctx& X, const Params& P, int l) { const int n = 8 * (l == 0 ? 132 : 128); for (int it = X.wave * X.nb + X.bid; it < n; it += X.nb * NWAVES) hgrn_out_item(X, P, l, it); }

#ifdef DBG_BRUTE
DI void ph_dbg_scores(const Ctx& X, const Params& P, int l) {
    const bf16_t* QT = (const bf16_t*)(P.ws + WS_QT); const bf16_t* KT = (const bf16_t*)(P.ws + WS_KT);
    LAS unsigned char* s_l = X.lds + X.wave * (2 * 64 * HP);
    const int lane = X.lane, g = lane >> 4, i16 = lane & 15, gw = X.wave * X.nb + X.bid, NGW = X.nb * NWAVES;
    float* dacc = (float*)(P.ws + WS_CTL) + CW_DBG + 16; float nA = 0.f, dA = 0.f;
    for (int it = gw; it < 8 * 128; it += NGW) {
        const int c = it % 128, bh = it / 128, h = bh & 3, b = bh >> 2, dir = 0, sgn = 1; const int row0 = b * SEQ + 64 * c;
        const bf16_t* qt = QT + ((size_t)dir * NROWS + row0) * 256 + h * 64 + g * 8; const bf16_t* kt = KT + ((size_t)dir * NROWS + row0) * 256 + h * 64 + g * 8;
        const bf16_t* qt0 = QT + ((size_t)dir * NROWS + row0) * 256 + h * 64; const bf16_t* kt0 = KT + ((size_t)dir * NROWS + row0) * 256 + h * 64;
        bf16x8 qf[4][2];
#pragma unroll
        for (int t = 0; t < 4; ++t)
#pragma unroll
            for (int ks = 0; ks < 2; ++ks) qf[t][ks] = *(const bf16x8*)(qt + (size_t)(16 * t + i16) * 256 + 32 * ks);
#pragma unroll 1
        for (int pr = 0; pr < 2; ++pr) {
            bf16x8 kf[2][2];
#pragma unroll
            for (int t = 0; t < 2; ++t)
#pragma unroll
                for (int ks = 0; ks < 2; ++ks) kf[t][ks] = *(const bf16x8*)(kt + (size_t)(16 * (2 * pr + t) + i16) * 256 + 32 * ks);
#pragma unroll
            for (int s2 = 0; s2 < 2; ++s2)
#pragma unroll
                for (int tt = 0; tt < 4; ++tt) { f32x4 a = {0.f, 0.f, 0.f, 0.f};
                    a = __builtin_amdgcn_mfma_f32_16x16x32_bf16(kf[s2][0], qf[tt][0], a, 0, 0, 0); a = __builtin_amdgcn_mfma_f32_16x16x32_bf16(kf[s2][1], qf[tt][1], a, 0, 0, 0);
#pragma unroll
                    for (int r = 0; r < 4; ++r) { const int sidx = 16 * (2 * pr + s2) + 4 * g + r, tidx = 16 * tt + i16; const int keep = ~(((tidx - sidx) * sgn) >> 31); { const float av = a[r]; a[r] = __int_as_float(__float_as_int(av) & keep); }
                        *(LAS float*)(s_l + (((s2 * 4 + tt) * 4 + r) * 64 + lane) * 4) = a[r]; } }
            asm volatile("s_waitcnt lgkmcnt(0)" ::: "memory");
#pragma unroll 1
            for (int idx = 0; idx < 32; ++idx) { const int s2 = idx >> 4, tt = (idx >> 2) & 3, r = idx & 3; const int sidx = 16 * (2 * pr + s2) + 4 * g + r, tidx = 16 * tt + i16; float ref = 0.f;
#pragma unroll 1
                for (int d = 0; d < 64; ++d) ref += bf2f(kt0[(size_t)sidx * 256 + d]) * bf2f(qt0[(size_t)tidx * 256 + d]);
                if (sidx > tidx) ref = 0.f; const float got = *(LAS float*)(s_l + (idx * 64 + lane) * 4); const float df = got - ref; nA += df * df; dA += ref * ref; }
            asm volatile("s_waitcnt lgkmcnt(0)" ::: "memory");
        }
    }
    nA = wave_sum(nA); dA = wave_sum(dA); if (lane == 0) { atomicAdd(dacc, nA); atomicAdd(dacc + 1, dA); }
}
#endif
constexpr int KP = 144, VP = 192, KBYTES = 128 * KP, VBYTES = 128 * VP, CHB = KBYTES + VBYTES, RPB_OFF = 2 * CHB;
static_assert(RPB_OFF + 4096 <= 144 * 1024, "attn lds");
struct ChunkSrc { int mode, rbase, kr0; };
DI int chunk_row(const ChunkSrc& c, int key) { return c.mode == 0 ? c.rbase + key : c.rbase + min(c.kr0 + (key >> 5), 127) * 64 + (key & 31); }
struct StageRegs { u32x4 k[2], v[2]; };
DI void stage_load(const Ctx& X, const bf16_t* PB, int kcol, int vcol, const ChunkSrc& c, StageRegs& R) {
#pragma unroll
    for (int i = 0; i < 2; ++i) { const int idx = X.tid + NTHREADS * i, key = idx >> 3, pc = idx & 7; const size_t row = (size_t)chunk_row(c, key);
        R.k[i] = *(const u32x4*)(PB + row * PBW + kcol + pc * 8); R.v[i] = *(const u32x4*)(PB + row * PBW + vcol + pc * 8); }
}
DI void stage_store(const Ctx& X, LAS unsigned char* buf, const StageRegs& R) {
#pragma unroll
    for (int i = 0; i < 2; ++i) { const int idx = X.tid + NTHREADS * i, key = idx >> 3, pc = idx & 7;
        *(LAS u32x4*)(buf + key * KP + pc * 16) = R.k[i]; *(LAS u32x4*)(buf + KBYTES + key * VP + pc * 16) = R.v[i]; }
}
template <int NQT> struct AttnState { f32x16 o[NQT][2]; float m[NQT], l[NQT]; };
template <int NQT, class MaskF>
DI void attn_tile_kv(const bf16x8 (&kf)[4], const LAS unsigned char* vt, int kt, const bf16x8 (&qf)[NQT][4], AttnState<NQT>& S, const bool (&act)[NQT], const MaskF& MF, int lane) {
    const int h = lane >> 5, G = lane >> 4, i16 = lane & 15;
    const LAS unsigned char* vb = vt + (4 * h + (i16 >> 2)) * VP + (16 * (G & 1) + 4 * (i16 & 3)) * 2;
    bf16x8 vf[2][2];
#pragma unroll
    for (int db = 0; db < 2; ++db)
#pragma unroll
        for (int s2 = 0; s2 < 2; ++s2) vf[db][s2] = cat8(tr_read(vb + (16 * s2) * VP + db * 64), tr_read(vb + (16 * s2 + 8) * VP + db * 64));
#pragma unroll
    for (int qt = 0; qt < NQT; ++qt) {
        if (!act[qt]) continue;
        f32x16 s;
#pragma unroll
        for (int r = 0; r < 16; ++r) s[r] = 0.f;
#pragma unroll
        for (int ks = 0; ks < 4; ++ks) s = __builtin_amdgcn_mfma_f32_32x32x16_bf16(kf[ks], qf[qt][ks], s, 0, 0, 0);
        MF(s, qt, kt);
        float mx = s[0];
#pragma unroll
        for (int r = 1; r < 16; ++r) mx = fmaxf(mx, s[r]);
        { const auto rr = __builtin_amdgcn_permlane32_swap(__float_as_uint(mx), __float_as_uint(mx), false, false); mx = fmaxf(__uint_as_float(rr[0]), __uint_as_float(rr[1])); }
        {
            const float mn = fmaxf(S.m[qt], mx), alpha = __builtin_amdgcn_exp2f(S.m[qt] - mn); S.m[qt] = mn; S.l[qt] *= alpha;
#pragma unroll
            for (int db = 0; db < 2; ++db)
#pragma unroll
                for (int r = 0; r < 16; ++r) S.o[qt][db][r] *= alpha;
        }
        const float mcur = S.m[qt]; float ps = 0.f;
#pragma unroll
        for (int r = 0; r < 16; ++r) { s[r] = __builtin_amdgcn_exp2f(s[r] - mcur); ps += s[r]; }
        S.l[qt] += ps;
        const bf16x8 p0 = pack8(s[0], s[1], s[2], s[3], s[4], s[5], s[6], s[7]), p1 = pack8(s[8], s[9], s[10], s[11], s[12], s[13], s[14], s[15]);
#pragma unroll
        for (int db = 0; db < 2; ++db) { S.o[qt][db] = __builtin_amdgcn_mfma_f32_32x32x16_bf16(vf[db][0], p0, S.o[qt][db], 0, 0, 0); S.o[qt][db] = __builtin_amdgcn_mfma_f32_32x32x16_bf16(vf[db][1], p1, S.o[qt][db], 0, 0, 0); }
    }
}
template <int NQT, class MaskF>
DI void attn_tile(const LAS unsigned char* buf, int kt, const bf16x8 (&qf)[NQT][4], AttnState<NQT>& S, const bool (&act)[NQT], const MaskF& MF, int lane) {
    bf16x8 kf[4];
#pragma unroll
    for (int ks = 0; ks < 4; ++ks) kf[ks] = *(const LAS bf16x8*)(buf + (32 * kt + (lane & 31)) * KP + ks * 32 + (lane >> 5) * 16);
    attn_tile_kv<NQT, MaskF>(kf, buf + KBYTES + 32 * kt * VP, kt, qf, S, act, MF, lane);
}
template <int NQT>
DI void attn_finish(AttnState<NQT>& S, int qt, unsigned char* yrow  , int lane) {
    const int h = lane >> 5; float l = S.l[qt]; { const auto rr = __builtin_amdgcn_permlane32_swap(__float_as_uint(l), __float_as_uint(l), false, false); l = __uint_as_float(rr[0]) + __uint_as_float(rr[1]); } const float inv = 1.0f / l;
#pragma unroll
    for (int db = 0; db < 2; ++db)
#pragma unroll
        for (int gq = 0; gq < 4; ++gq) *(unsigned*)(yrow + 32 * db + 8 * gq + 4 * h) = pk_fp8x4((f32x4){S.o[qt][db][4 * gq] * inv, S.o[qt][db][4 * gq + 1] * inv, S.o[qt][db][4 * gq + 2] * inv, S.o[qt][db][4 * gq + 3] * inv});
}
struct MaskNone { DI void operator()(f32x16&, int, int) const {} };
struct MaskSWA { int cmode, u0, lane;
    DI void operator()(f32x16& s, int qt, int kt) const {
        if (cmode == 1) return;
        const int u = u0 + 32 * qt + (lane & 31), kb = 32 * kt + 4 * (lane >> 5);
#pragma unroll
        for (int r = 0; r < 16; ++r) { const int k = kb + (r & 3) + 8 * (r >> 2); const bool ok = cmode == 0 ? k >= u : k <= u; s[r] = ok ? s[r] : -1e30f; }
    } };
DI void swa_item(const Ctx& X, const Params& P, int l, int it) {
    const bf16_t* PB = (const bf16_t*)(P.ws + WS_PB); unsigned char* Y = P.ws + WS_Y;        const float* sink = P.in[10] + l * 8;
    const int lane = X.lane, w = X.wave;
    {
        const int j = it & 63, n = (it >> 6) & 1, b = it >> 7;
        const int qh = n * 4 + (w >> 1), u0 = (w & 1) * 64;
        const int nchunks = 3 + (j > 0) + (j < 63);
        bf16x8 qf[2][4];
#pragma unroll
        for (int qt = 0; qt < 2; ++qt)
#pragma unroll
            for (int ks = 0; ks < 4; ++ks) qf[qt][ks] = *(const bf16x8*)(PB + (size_t)(b * SEQ + 128 * j + u0 + 32 * qt + (lane & 31)) * PBW + PB_SQ + qh * 64 + 16 * ks + 8 * (lane >> 5));
        AttnState<2> S;
#pragma unroll
        for (int qt = 0; qt < 2; ++qt) { S.m[qt] = LOG2E * sink[qh]; S.l[qt] = lane < 32 ? 1.0f : 0.0f;
#pragma unroll
            for (int db = 0; db < 2; ++db)
#pragma unroll
                for (int r = 0; r < 16; ++r) S.o[qt][db][r] = 0.f; }
        StageRegs R;
        auto chunk_id = [&](int i) -> int { return i < 2 ? 3 + i : (i == 2 ? 1 : (i == 3 ? (j > 0 ? 0 : 2) : 2)); };
        auto chunk_src = [&](int c) -> ChunkSrc { ChunkSrc cs; cs.mode = 0; cs.kr0 = 0; cs.rbase = c < 3 ? b * SEQ + 128 * (j - 1 + c) : NLAT + b * CTXL + 128 * (c - 3); return cs; };
        stage_load(X, PB, PB_SK + n * 64, PB_SV + n * 64, chunk_src(chunk_id(0)), R); stage_store(X, X.lds, R);
        __syncthreads();
        for (int i = 0; i < nchunks; ++i) {
            const int c = chunk_id(i);
            if (i + 1 < nchunks) stage_load(X, PB, PB_SK + n * 64, PB_SV + n * 64, chunk_src(chunk_id(i + 1)), R);
            const LAS unsigned char* buf = X.lds + (i & 1) * CHB;
            MaskSWA MF; MF.cmode = c == 0 ? 0 : (c == 2 ? 2 : 1); MF.u0 = u0; MF.lane = lane;
#pragma unroll 1
            for (int kt = 0; kt < 4; ++kt) {
                bool act[2];
#pragma unroll
                for (int qt = 0; qt < 2; ++qt) act[qt] = c == 0 ? (32 * kt + 31 >= u0 + 32 * qt) : (c == 2 ? (32 * kt <= u0 + 32 * qt + 31) : true);
                if (!(act[0] || act[1])) continue;
                attn_tile<2>(buf, kt, qf, S, act, MF, lane);
            }
            if (i + 1 < nchunks) stage_store(X, X.lds + ((i + 1) & 1) * CHB, R);
            __syncthreads();
        }
#pragma unroll
        for (int qt = 0; qt < 2; ++qt) attn_finish<2>(S, qt, Y + (size_t)(b * SEQ + 128 * j + u0 + 32 * qt + (lane & 31)) * D + 512 + qh * 64, lane);
    }
}
struct MaskNA { bool win; int kr0, qr, qc, rs, cs, blk, lane; const LAS float* rpb;
    DI void operator()(f32x16& s, int qt, int kt) const {
        if (!win) return;
        const int kr = kr0 + kt; const bool rowok = kr >= rs && kr < rs + 8;
        const int kcb = blk + 4 * (lane >> 5); const int ib = rowok ? (kr - qr + 7) * 31 + (kcb - qc + 15) : 0;
#pragma unroll
        for (int r = 0; r < 16; ++r) { const int off = (r & 3) + 8 * (r >> 2); const int kc = kcb + off; const bool ok = rowok && kc >= cs && kc < cs + 16;
            const float bias = rpb[ib + off]; s[r] = ok ? s[r] + bias : -1e30f; }
    } };
struct NaTileRegs { bf16x8 k[4]; u32x4 v[4]; };
DI void na_load(const bf16_t* PB, int h, int rowk  , int rowv  , int lane, NaTileRegs& R) {
    const bf16_t* kp = PB + (size_t)rowk * PBW + PB_NK + h * 64 + 8 * (lane >> 5);
#pragma unroll
    for (int ks = 0; ks < 4; ++ks) R.k[ks] = *(const bf16x8*)(kp + 16 * ks);
    const bf16_t* vp = PB + (size_t)rowv * PBW + PB_NV + h * 64 + (lane & 1) * 32;
#pragma unroll
    for (int i = 0; i < 4; ++i) R.v[i] = *(const u32x4*)(vp + 8 * i);
}
DI void na_item(const Ctx& X, const Params& P, int l, int it) {
    const bf16_t* PB = (const bf16_t*)(P.ws + WS_PB); unsigned char* Y = P.ws + WS_Y;        const float* rpbg = P.in[9] + l * 4 * 465;
    const int lane = X.lane, w = X.wave; LAS float* rpbl = (LAS float*)(X.lds + 8 * 32 * VP) + 32;
    LAS unsigned char* vt = X.lds + w * (32 * VP);
    const int j = it & 3, rg = (it >> 2) & 7, h = (it >> 5) & 3, b = it >> 7;
    const int r0 = 16 * rg, blk = min(max(16 * j - 8, 0), 32);
    const int ra = r0 + 2 * w, qr = ra + ((lane & 31) >> 4), qc = 16 * j + (lane & 15);
    const int rs_a = min(max(ra - 4, 0), 120), rs_b = min(max(ra + 1 - 4, 0), 120), ntile = 8 + (rs_b + 8 - rs_a);
    for (int i = X.tid; i < 465; i += NTHREADS) rpbl[i] = LOG2E * rpbg[h * 465 + i];
    __syncthreads();
    bf16x8 qf[1][4];
#pragma unroll
    for (int ks = 0; ks < 4; ++ks) qf[0][ks] = *(const bf16x8*)(PB + (size_t)(b * SEQ + qr * 64 + qc) * PBW + PB_NQ + h * 64 + 16 * ks + 8 * (lane >> 5));
    AttnState<1> S; S.m[0] = -1e30f; S.l[0] = 0.f;
#pragma unroll
    for (int db = 0; db < 2; ++db)
#pragma unroll
        for (int r = 0; r < 16; ++r) S.o[0][db][r] = 0.f;
    MaskNA MF; MF.qr = qr; MF.qc = qc; MF.rs = min(max(qr - 4, 0), 120); MF.cs = min(max(qc - 8, 0), 48); MF.blk = blk; MF.lane = lane; MF.rpb = rpbl;
    const bool act[1] = {true};
#define NA_ROW(t, key) ((t) < 8 ? NLAT + b * CTXL + 32 * (t) + (key) : b * SEQ + (rs_a + (t) - 8) * 64 + blk + (key))
#define NA_LOAD(t, R) na_load(PB, h, NA_ROW(t, lane & 31), NA_ROW(t, lane >> 1), lane, R)
#define NA_COMPUTE(t, R) do { asm volatile("" ::: "memory"); _Pragma("unroll") for (int i_ = 0; i_ < 4; ++i_) *(LAS u32x4*)(vt + (lane >> 1) * VP + (lane & 1) * 64 + i_ * 16) = R.v[i_]; \
        asm volatile("" ::: "memory"); MF.win = (t) >= 8; MF.kr0 = rs_a + (t) - 8; attn_tile_kv<1>(R.k, vt, 0, qf, S, act, MF, lane); asm volatile("" ::: "memory"); } while (0)
    NaTileRegs RA, RB;
    NA_LOAD(0, RA);
    for (int t = 0; t < ntile; t += 2) {
        if (t + 1 < ntile) NA_LOAD(t + 1, RB);
        NA_COMPUTE(t, RA);
        if (t + 1 < ntile) { if (t + 2 < ntile) NA_LOAD(t + 2, RA); NA_COMPUTE(t + 1, RB); }
    }
#undef NA_ROW
#undef NA_LOAD
#undef NA_COMPUTE
    attn_finish<1>(S, 0, Y + (size_t)(b * SEQ + qr * 64 + qc) * D + 256 + h * 64, lane);
    __syncthreads();
}
DI void ctx_attn_item(const Ctx& X, const Params& P, int l, int it) {
    const bf16_t* PB = (const bf16_t*)(P.ws + WS_PB); unsigned char* Y = P.ws + WS_Y;        const float* sink = P.in[10] + l * 8;
    const int lane = X.lane, w = X.wave;
    {
        const bool swa = it >= 8; const int b = (it >> 2) & 1;
        const int h = it & 3, n = (it >> 1) & 1, half = it & 1;
        const int kcol = swa ? PB_SK + n * 64 : PB_NK + h * 64, vcol = swa ? PB_SV + n * 64 : PB_NV + h * 64;
        StageRegs R; ChunkSrc cs; cs.mode = 0; cs.kr0 = 0; cs.rbase = NLAT + b * CTXL;
        stage_load(X, PB, kcol, vcol, cs, R); stage_store(X, X.lds, R);
        cs.rbase += 128; stage_load(X, PB, kcol, vcol, cs, R); stage_store(X, X.lds + CHB, R);
        __syncthreads();
        const MaskNone MF;
        if (!swa) {
            const int qrow = NLAT + b * CTXL + 32 * w + (lane & 31);
            bf16x8 qf[1][4];
#pragma unroll
            for (int ks = 0; ks < 4; ++ks) qf[0][ks] = *(const bf16x8*)(PB + (size_t)qrow * PBW + PB_NQ + h * 64 + 16 * ks + 8 * (lane >> 5));
            AttnState<1> S; S.m[0] = -1e30f; S.l[0] = 0.f;
#pragma unroll
            for (int db = 0; db < 2; ++db)
#pragma unroll
                for (int r = 0; r < 16; ++r) S.o[0][db][r] = 0.f;
            const bool act[1] = {true};
#pragma unroll 1
            for (int kt = 0; kt < 8; ++kt) attn_tile<1>(X.lds + (kt >> 2) * CHB, kt & 3, qf, S, act, MF, lane);
            attn_finish<1>(S, 0, Y + (size_t)qrow * D + 256 + h * 64, lane);
        } else {
            const int qh = n * 4 + half * 2 + (w >> 2), q0 = NLAT + b * CTXL + (w & 3) * 64 + (lane & 31);
            bf16x8 qf[2][4];
#pragma unroll
            for (int qt = 0; qt < 2; ++qt)
#pragma unroll
                for (int ks = 0; ks < 4; ++ks) qf[qt][ks] = *(const bf16x8*)(PB + (size_t)(q0 + 32 * qt) * PBW + PB_SQ + qh * 64 + 16 * ks + 8 * (lane >> 5));
            AttnState<2> S;
#pragma unroll
            for (int qt = 0; qt < 2; ++qt) { S.m[qt] = LOG2E * sink[qh]; S.l[qt] = lane < 32 ? 1.0f : 0.0f;
#pragma unroll
                for (int db = 0; db < 2; ++db)
#pragma unroll
                    for (int r = 0; r < 16; ++r) S.o[qt][db][r] = 0.f; }
            const bool act[2] = {true, true};
#pragma unroll 1
            for (int kt = 0; kt < 8; ++kt) attn_tile<2>(X.lds + (kt >> 2) * CHB, kt & 3, qf, S, act, MF, lane);
#pragma unroll
            for (int qt = 0; qt < 2; ++qt) attn_finish<2>(S, qt, Y + (size_t)(q0 + 32 * qt) * D + 512 + qh * 64, lane);
        }
        __syncthreads();
    }
}

DI void ph_swa(const Ctx& X, const Params& P, int l) { for (int it = X.bid; it < 256; it += X.nb) swa_item(X, P, l, it); }
DI void ph_na(const Ctx& X, const Params& P, int l) { for (int it = X.bid; it < 256; it += X.nb) na_item(X, P, l, it); }
DI void queue_publish(const Ctx& X, unsigned* cnt) {
    asm volatile("s_waitcnt vmcnt(0)" ::: "memory");
    __syncthreads();
    if (X.tid == 0) { __builtin_amdgcn_fence(__ATOMIC_RELEASE, "agent"); asm volatile("s_waitcnt vmcnt(0)" ::: "memory"); __hip_atomic_fetch_add(cnt, 1u, __ATOMIC_RELAXED, __HIP_MEMORY_SCOPE_AGENT); }
}
DI void queue_wait(const Ctx& X, unsigned* cnt, unsigned need) {
    if (X.tid == 0) { unsigned sp = 0; while (__hip_atomic_load(cnt, __ATOMIC_RELAXED, __HIP_MEMORY_SCOPE_AGENT) < need && ++sp < (1u << 24)) __builtin_amdgcn_s_sleep(2);
        __builtin_amdgcn_fence(__ATOMIC_ACQUIRE, "agent"); asm volatile("s_waitcnt vmcnt(0)" ::: "memory"); }
    __syncthreads();
}
DI void ph_mix_queue(const Ctx& X, const Params& P, int l) {
    unsigned* ctl = (unsigned*)(P.ws + WS_CTL);
    unsigned* head = ctl + CW_Q + 64 * l; unsigned* scan_cnt = ctl + CW_SCAN + 64 * l; unsigned* loc_cnt = ctl + CW_SCAN + 128 + 64 * l;
    volatile LAS unsigned* slot = (volatile LAS unsigned*)(X.lds + 144 * 1024 + 64);
    const int nloc = 264, nscan = 64, nctx = l == 0 ? 16 : 0, nconv = l == 0 ? 1536 : 0, nho = l == 0 ? 132 : 128;
    const int o_ctx = nloc, o_swa = o_ctx + nctx, o_scan = o_swa + 256, o_na = o_scan + nscan, o_conv = o_na + 256, o_ho = o_conv + nconv, total = o_ho + nho;
    bool scan_ok = false;
    for (;;) {
        if (X.tid == 0) *slot = atomicAdd(head, 1u);
        __syncthreads();
        const int it = (int)*slot;
        __syncthreads();
        if (it >= total) break;
        Ctx Xi = X; { int wv = X.wave; asm volatile("" : "+s"(wv)); int ln; asm volatile("v_mbcnt_lo_u32_b32 %0, -1, 0\n\tv_mbcnt_hi_u32_b32 %0, -1, %0" : "=v"(ln)); Xi.tid = wv * 64 + ln; Xi.lane = ln; Xi.wave = wv; }
        if (it < o_ctx) { hgrn_local_item(Xi, P, l, it * 8 + Xi.wave); queue_publish(Xi, loc_cnt); }
        else if (it < o_swa) ctx_attn_item(Xi, P, l, it - o_ctx);
        else if (it < o_scan) swa_item(Xi, P, l, it - o_swa);
        else if (it < o_na) { queue_wait(Xi, loc_cnt, (unsigned)nloc); ph_hgrn_scan(Xi, P, it - o_scan); queue_publish(Xi, scan_cnt); }
        else if (it < o_conv) na_item(Xi, P, l, it - o_na);
        else if (it < o_ho) { LAS float* scr = (LAS float*)X.lds + X.wave * (64 * 33); const int g = it - o_conv, lyr = g >= 768, f0 = (g - 768 * lyr) * 16 + X.wave;
#define DESC_EQ(i) expert_desc(P, lyr, (i))
            TR_LOOP(DESC_EQ, f0, f0 + 16, 8); __syncthreads(); }
        else { if (!scan_ok) { queue_wait(Xi, scan_cnt, (unsigned)nscan); scan_ok = true; }
            hgrn_out_item(Xi, P, l, (it - o_ho) * 8 + Xi.wave); __syncthreads(); }
    }
}
constexpr size_t WS_Y2 = 284 * MiB;
DI void ph_dbg_copy(const Ctx& X, const Params& P) {
    const u32x4* src = (const u32x4*)(P.ws + WS_Y); u32x4* dst = (u32x4*)(P.ws + WS_Y2);
    for (size_t i = (size_t)X.bid * NTHREADS + X.tid; i < (size_t)NROWS * 128; i += (size_t)X.nb * NTHREADS) dst[i] = src[i];
}
DI void ph_dbg_compare(const Ctx& X, const Params& P) {
    const bf16_t* Yg = (const bf16_t*)(P.ws + WS_Y); const bf16_t* Yf = (const bf16_t*)(P.ws + WS_Y2); float* acc = (float*)(P.ws + WS_CTL) + CW_DBG;
    float num[3] = {0.f, 0.f, 0.f}, den[3] = {0.f, 0.f, 0.f};
    const int gw = X.bid * NWAVES + X.wave, NGW = X.nb * NWAVES;
    for (int row = gw; row < NROWS; row += NGW) {
#pragma unroll
        for (int j = 0; j < 16; ++j) { const int c = j * 64 + X.lane; const float a = bf2f(Yg[(size_t)row * D + c]), b = bf2f(Yf[(size_t)row * D + c]); const float d = a - b;
            const int br = j < 4 ? 0 : (j < 8 ? 1 : 2);
            if (br == 0) { num[0] += d * d; den[0] += a * a; } else if (br == 1) { num[1] += d * d; den[1] += a * a; } else { num[2] += d * d; den[2] += a * a; } }
    }
#pragma unroll
    for (int b = 0; b < 3; ++b) { const float n = wave_sum(num[b]), d = wave_sum(den[b]); if (X.lane == 0) { atomicAdd(acc + 2 * b, n); atomicAdd(acc + 2 * b + 1, d); } }
}
DI void ph_dbg_apply(const Ctx& X, const Params& P) {
    const float* acc = (const float*)(P.ws + WS_CTL) + CW_DBG;
#ifdef DBG_BRUTE
    float code = sqrtf(acc[16] / acc[17]);
#else
    float code = sqrtf(acc[0] / acc[1]);
#endif
    if (code == 0.f) return;
    f32x4* o = (f32x4*)P.out;
    for (size_t i = (size_t)X.bid * NTHREADS + X.tid; i < (size_t)NLAT * 256; i += (size_t)X.nb * NTHREADS) o[i] = o[i] * (1.0f + code);
}

DI void ph_inproj(const Ctx& X, const Params& P, int l) {
    PlainSched S; S.init(NROWS, INW, X.nb, X.bid);
    EpiIn E{(bf16_t*)(P.ws + WS_PB), (bf16_t*)(P.ws + WS_Z), (const float*)(P.ws + WS_ROPE), (const float*)(P.ws + WS_LB) + l * 512, (bf16_t*)(P.ws + WS_KK)};
    gemm_fast<PlainSched, EpiIn, true, 122>(X, P.ws + WS_H, P.ws + WS_WIN + (size_t)l * INW * D, D, S, E);
}
struct EpiNull { DI void group(const Unit&, int, int, f32x4 a0, f32x4 a1, f32x4 b0, f32x4 b1) const { asm volatile("" :: "v"(a0), "v"(a1), "v"(b0), "v"(b1)); } };
DI void ph_inproj_plain(const Ctx& X, const Params& P, int l) {
    PlainSched S; S.init(NROWS, INW, X.nb, X.bid);
    EpiNull E;
    GEMM_IMPL(X, (const bf16_t*)(P.ws + WS_H), (const bf16_t*)(P.ws + WS_WIN) + (size_t)l * INW * D, D, S, E);
}
DI void small_gemm_item(const Ctx& X, const unsigned char* A, const unsigned char* Bt, bf16_t* C, int row0, int col0) {
    const int wm = X.wave >> 2, wn = X.wave & 3, fr = X.lane & 15, fq = X.lane >> 4;
    const unsigned char* ap = A + (size_t)(row0 + 16 * wm + fr) * D + 8 * fq; const unsigned char* bp = Bt + (size_t)(col0 + 16 * wn + fr) * D + 8 * fq;
    f32x4 acc = {0.f, 0.f, 0.f, 0.f};
#pragma unroll 1
    for (int k0 = 0; k0 < D; k0 += 512) {
        long af[16], bfv[16];
#pragma unroll
        for (int i = 0; i < 16; ++i) { af[i] = *(const long*)(ap + k0 + 32 * i); bfv[i] = *(const long*)(bp + k0 + 32 * i); }
#pragma unroll
        for (int i = 0; i < 16; ++i) acc = __builtin_amdgcn_mfma_f32_16x16x32_fp8_fp8(bfv[i], af[i], acc, 0, 0, 0);
    }
    store_bf4(C + (size_t)(row0 + 16 * wm + fr) * D + col0 + 16 * wn + 4 * fq, acc * (1.0f / 64.0f));
}
DI void ph_outproj(const Ctx& X, const Params& P, int l) {
    PlainSched S; S.init(NLAT, D, X.nb, X.bid);
    EpiBf E{(bf16_t*)(P.ws + WS_YO), D};
    gemm_fast<PlainSched, EpiBf, true, 121>(X, P.ws + WS_Y, P.ws + WS_WOUT + (size_t)l * D * D, D, S, E);
    if (l == 0) for (int it = X.bid; it < 256; it += X.nb)
        small_gemm_item(X, P.ws + WS_Y, P.ws + WS_WOUT, (bf16_t*)(P.ws + WS_YO), NLAT + 32 * (it >> 4), 64 * (it & 15));
}
DI void ph_moe1(const Ctx& X, const Params& P, int l) {
    moe_build_table(X, (const int*)(P.ws + WS_CTL) + CW_CNT + 1024 * l);
    MoeSched<true> S{(const int*)(P.ws + WS_CTL) + CW_CNT + 1024 * l, (const int*)(P.ws + WS_LIST), X.nb, X.bid, 4, 1024, X.lds};
    { LAS int* ll = (LAS int*)(X.lds + MOE_LIST_OFF); Unit u;
#pragma unroll 1
      for (int i = 0; i < 3; ++i) if (S.next(i, u) && X.tid < 256) { const int idx = u.i0 * 256 + X.tid; ll[i * 256 + X.tid] = S.list[u.e * LISTCAP + (idx < u.cnt ? idx : 0)]; }
      __syncthreads(); }
    EpiGU E{(bf16_t*)(P.ws + WS_S)};
    gemm_fast<MoeSched<true>, EpiGU, true, 122>(X, P.ws + WS_H, P.ws + (l ? WS_WGU1 : WS_WGU), D, S, E);
}
DI void ph_moe2(const Ctx& X, const Params& P, int l) {
    moe_build_table(X, (const int*)(P.ws + WS_CTL) + CW_CNT + 1024 * l);
    MoeSched<false> S{(const int*)(P.ws + WS_CTL) + CW_CNT + 1024 * l, (const int*)(P.ws + WS_LIST), X.nb, X.bid, 4, 1024, X.lds};
    EpiF8 E{P.ws + WS_O, D};
    gemm_fast<MoeSched<false>, EpiF8, true, 122>(X, P.ws + WS_S, P.ws + (l ? WS_WD1 : WS_WD), DEXP, S, E);
}

#define XB_TMO      128
#define XB_XCNT(j)  (256  + 64 * (j))
#define XB_XSUB(j)  (1280 + 64 * (j))
#define XB_XGEN(j)  (2304 + 64 * (j))
#define XB_TOP      3328
#define XB_TOPGEN   3392
#define XCD_BAR_WORDS 3456
#ifndef XB_SPIN_CAP
#define XB_SPIN_CAP (1u << 26)
#endif
DI unsigned xb_ld(unsigned* p)              { return __hip_atomic_load(p, __ATOMIC_RELAXED, __HIP_MEMORY_SCOPE_AGENT); }
DI unsigned xb_add(unsigned* p, unsigned v) { return __hip_atomic_fetch_add(p, v, __ATOMIC_RELAXED, __HIP_MEMORY_SCOPE_AGENT); }
DI unsigned xb_xcc_id() { return (unsigned)__builtin_amdgcn_s_getreg((3 << 11) | 20) & 0xFu; }
#define XB_SPIN(cond, bar) do { unsigned _sp = 0; while (cond) { __builtin_amdgcn_s_sleep(1); \
    if ((++_sp & 255u) == 0u) { if (xb_ld(&(bar)[XB_TMO])) break; if (_sp > XB_SPIN_CAP) { atomicAdd(&(bar)[XB_TMO], 1u); break; } } } } while (0)
struct XcdBarrier { unsigned* bar; unsigned x; volatile LAS unsigned* st; };
DI XcdBarrier xcd_barrier_post(unsigned* bar, volatile LAS unsigned* st) {
    XcdBarrier b; b.bar = bar; b.x = xb_xcc_id(); b.st = st;
    if (threadIdx.x == 0) (void)xb_add(&bar[XB_XCNT(b.x)], 1u);
    return b;
}
DI void xcd_barrier_complete(unsigned* bar, unsigned x, unsigned& nloc, unsigned& nx) {
    const unsigned G = gridDim.x * gridDim.y * gridDim.z;
    unsigned sum, cnt, mine, sp = 0u;
    for (;;) {
        sum = 0u; cnt = 0u; mine = 0u;
#pragma unroll
        for (unsigned j = 0; j < 16; ++j) { const unsigned c = xb_ld(&bar[XB_XCNT(j)]); sum += c; cnt += (c > 0u) ? 1u : 0u; mine = (j == x) ? c : mine; }
        if (sum == G) break;
        __builtin_amdgcn_s_sleep(1);
        if ((++sp & 255u) == 0u) { if (xb_ld(&bar[XB_TMO])) break; if (sp > XB_SPIN_CAP) { atomicAdd(&bar[XB_TMO], 1u); break; } }
    }
    nloc = mine > 0u ? mine : 1u; nx = cnt > 0u ? cnt : 1u;
}
DI void xcd_barrier(const XcdBarrier& b) {
    asm volatile("s_waitcnt vmcnt(0)" ::: "memory");
    __syncthreads();
    if (threadIdx.x == 0) {
        unsigned* bar = b.bar;
        __builtin_amdgcn_s_waitcnt(0);
        unsigned nloc = b.st[0], nx = b.st[1];
        if (nloc == 0u) { xcd_barrier_complete(bar, b.x, nloc, nx); b.st[0] = nloc; b.st[1] = nx; }
        const unsigned old = xb_add(&bar[XB_XSUB(b.x)], 1u);
        const unsigned gen = old / nloc;
        if (old + 1u == (gen + 1u) * nloc) {
            __builtin_amdgcn_fence(__ATOMIC_RELEASE, "agent");
            asm volatile("s_waitcnt vmcnt(0)" ::: "memory");
            const unsigned og = xb_add(&bar[XB_TOP], 1u);
            const unsigned tg = og / nx;
            if (og + 1u == (tg + 1u) * nx) xb_add(&bar[XB_TOPGEN], 1u);
            else XB_SPIN(xb_ld(&bar[XB_TOPGEN]) == tg, bar);
            __builtin_amdgcn_fence(__ATOMIC_ACQUIRE, "agent");
            xb_add(&bar[XB_XGEN(b.x)], 1u);
            asm volatile("s_waitcnt vmcnt(0)" ::: "memory");
        } else {
            XB_SPIN(xb_ld(&bar[XB_XGEN(b.x)]) == gen, bar);
            __builtin_amdgcn_fence(__ATOMIC_ACQUIRE, "agent");
            asm volatile("s_waitcnt vmcnt(0)" ::: "memory");
        }
    }
    __syncthreads();
}

template <int Q> DI void run_phase(const Ctx& X0, const Params& P0, int l) {
#if defined(__HIP_DEVICE_COMPILE__)
    const __attribute__((address_space(4))) Params* pp_ = (const __attribute__((address_space(4))) Params*)__builtin_amdgcn_kernarg_segment_ptr(); asm volatile("" : "+s"(pp_), "+s"(l));
    const Params P = *pp_; (void)P0;
#else
    const Params P = P0;
#endif
    Ctx X = X0; { int wv = X0.wave; asm volatile("" : "+s"(wv)); int ln; asm volatile("v_mbcnt_lo_u32_b32 %0, -1, 0\n\tv_mbcnt_hi_u32_b32 %0, -1, %0" : "=v"(ln)); X.tid = wv * 64 + ln; X.lane = ln; X.wave = wv; int b_ = X0.bid, n_ = X0.nb; asm volatile("" : "+s"(b_), "+s"(n_)); X.bid = b_; X.nb = n_; }
    if constexpr (Q == 0) ph_prologue(X, P);
    if constexpr (Q == 1) { ph_modulate(X, P, 0); __syncthreads(); convert_rest(X, P); }
    if constexpr (Q == 2) ph_inproj(X, P, l);
    if constexpr (Q == 3) ph_hgrn_naive(X, P, l);
    if constexpr (Q == 4) ph_hgrn_combine_naive(X, P, l);
    if constexpr (Q == 5) ph_attn_naive(X, P, l);
    if constexpr (Q == 6) ph_outproj(X, P, l);
    if constexpr (Q == 7) ph_ln1(X, P, l);
    if constexpr (Q == 24) ph_ln1(X, P, l, true);
    if constexpr (Q == 27) ph_inproj_plain(X, P, l);
    if constexpr (Q == 8) ph_moe1(X, P, l);
    if constexpr (Q == 9) ph_moe2(X, P, l);
    if constexpr (Q == 13) ph_hgrn_out(X, P, l);
    if constexpr (Q == 14) ph_swa(X, P, l);
    if constexpr (Q == 15) ph_na(X, P, l);
#ifdef DBG_BRUTE
    if constexpr (Q == 23) ph_dbg_scores(X, P, l);
#endif
    if constexpr (Q == 20) ph_dbg_copy(X, P);
    if constexpr (Q == 21) ph_dbg_compare(X, P);
    if constexpr (Q == 22) ph_dbg_apply(X, P);
    if constexpr (Q == 10) ph_ln2(X, P, l);
    if constexpr (Q == 17) ph_mix_queue(X, P, l);
}

constexpr int LDS_BYTES = 150 * 1024;
template <int Q>
__global__ void __launch_bounds__(NTHREADS, 2) k_step(Params P, int l) {
    extern __shared__ __attribute__((aligned(16))) unsigned char lds_raw[];
    Ctx X; X.lds = (LAS unsigned char*)lds_raw; X.tid = threadIdx.x; X.lane = X.tid & 63; X.wave = __builtin_amdgcn_readfirstlane(X.tid >> 6); X.bid = blockIdx.x; X.nb = gridDim.x;
    run_phase<Q>(X, P, l);
}
template <int Q> static void launch_step(const Params& P, int l, int grid, hipStream_t stream) {
    static bool attr = false;
    if (!attr) { (void)hipFuncSetAttribute((const void*)k_step<Q>, hipFuncAttributeMaxDynamicSharedMemorySize, LDS_BYTES); attr = true; }
    hipLaunchKernelGGL(k_step<Q>, dim3(grid), dim3(NTHREADS), LDS_BYTES, stream, P, l);
}

constexpr int LDS_CTL_OFF = 144 * 1024;
__global__ void __launch_bounds__(NTHREADS, 2) k_mega(Params P) {
    extern __shared__ __attribute__((aligned(16))) unsigned char lds_raw[];
    Ctx X; X.lds = (LAS unsigned char*)lds_raw; X.tid = threadIdx.x; X.lane = X.tid & 63; X.wave = __builtin_amdgcn_readfirstlane(X.tid >> 6); X.bid = blockIdx.x; X.nb = gridDim.x;
    volatile LAS unsigned* st = (volatile LAS unsigned*)(X.lds + LDS_CTL_OFF);
    if (X.tid < 16) st[X.tid] = 0u;
    __syncthreads();
    { const XcdBarrier b0 = xcd_barrier_post((unsigned*)(P.ws + WS_CTL) + CW_BAR, st); if (X.tid == 0) st[2] = b0.x; }
    __syncthreads();
#ifdef TS_SEL
#define STAMP() do { if (blockIdx.x == 0 && threadIdx.x == 0) { unsigned long long* ts_ = (unsigned long long*)((unsigned*)(P.ws + WS_CTL) + CW_TS); const unsigned n_ = st[8]; ts_[n_] = __builtin_amdgcn_s_memrealtime(); st[8] = n_ + 1u; } } while (0)
#else
#define STAMP() do { } while (0)
#endif
#define GBAR() do { for (int br_ = 0; br_ < BAR_REP; ++br_) GBAR1(); STAMP(); } while (0)
#define GBAR1() do { unsigned char* w_ = P.ws; asm volatile("" : "+s"(w_)); XcdBarrier b_; b_.bar = (unsigned*)(w_ + WS_CTL) + CW_BAR; b_.st = st; b_.x = threadIdx.x == 0 ? st[2] : 0u; xcd_barrier(b_); } while (0)
#ifndef DUP
#define DUP 0
#endif
#ifndef BAR_REP
#define BAR_REP 1
#endif
#define NREP(bit) ({ int n_ = (DUP & (1 << (bit))) ? 2 : 1; asm volatile("" : "+s"(n_)); n_; })
#define RUNP(Q, bit) do { const int nr_ = NREP(bit); for (int rep_ = 0; rep_ < nr_; ++rep_) { run_phase<Q>(X, P, l); GBAR(); } } while (0)
    STAMP();
    { const int l = 0; RUNP(0, 0); RUNP(1, 1); }
    for (int l = 0; l < 2; ++l) {
        if (DUP & 32768) { run_phase<27>(X, P, l); GBAR(); }
        RUNP(2, 2);
#if FAST_MIX
        run_phase<17>(X, P, l); GBAR();
#ifdef DBG_MIX
        if (l == 0) {
            run_phase<20>(X, P, l); GBAR();
            run_phase<3>(X, P, l); GBAR();
            run_phase<4>(X, P, l); GBAR();
            run_phase<5>(X, P, l); GBAR();
            run_phase<21>(X, P, l); GBAR();
        }
#endif
#else
        run_phase<3>(X, P, l); GBAR();
        run_phase<4>(X, P, l); GBAR();
        run_phase<5>(X, P, l); GBAR();
#endif
        RUNP(6, 9);
        if ((DUP & 4096) && l == 0) { run_phase<24>(X, P, l); GBAR(); }
        run_phase<7>(X, P, l); GBAR();
        RUNP(8, 10);
        RUNP(9, 11);
        run_phase<10>(X, P, l); if (l == 0) GBAR();
    }
#ifdef TS_SEL
    GBAR();
    { const unsigned long long* ts_ = (const unsigned long long*)((const unsigned*)(P.ws + WS_CTL) + CW_TS); const float dt_us = 10.0f * floorf((float)(ts_[TS_SEL] - ts_[TS_SEL - 1]) * 0.001f + 0.5f); const float sc = 1.0f + dt_us * (1.0f / 2000.0f);
      f32x4* o = (f32x4*)P.out; for (size_t i = (size_t)blockIdx.x * NTHREADS + threadIdx.x; i < (size_t)NLAT * 256; i += (size_t)gridDim.x * NTHREADS) o[i] = o[i] * sc; }
#endif
#ifdef DBG_MIX
    GBAR(); run_phase<22>(X, P, 0);
#endif
#undef GBAR
}

extern "C" void kernel_launch(void* const* d_in, const int* in_sizes, int n_in, void* d_out, int out_size, void* d_ws, size_t ws_size, hipStream_t stream) {
    static int grid = 0;
    if (grid == 0) {
        if (n_in != 21 || out_size != NLAT * D || ws_size < WS_END) { fprintf(stderr, "kernel_launch: unexpected shapes n_in %d out %d ws %zu\n", n_in, out_size, ws_size); grid = -1; return; }
        int dev = 0, cus = 0; (void)hipGetDevice(&dev); (void)hipDeviceGetAttribute(&cus, hipDeviceAttributeMultiprocessorCount, dev);
        grid = cus > 0 ? cus : 256;
        (void)hipFuncSetAttribute((const void*)k_mega, hipFuncAttributeMaxDynamicSharedMemorySize, LDS_BYTES);
    }
    if (grid < 0) return;
    (void)hipMemsetAsync((char*)d_ws + WS_CTL, 0, CTL_BYTES, stream);
    Params P{};
    for (int i = 0; i < 21; ++i) P.in[i] = (const float*)d_in[i];
    P.out = (float*)d_out; P.ws = (unsigned char*)d_ws;
#if N_LAUNCH_MODE == 1
    hipLaunchKernelGGL(k_mega, dim3(grid), dim3(NTHREADS), LDS_BYTES, stream, P);
#else
    launch_step<0>(P, 0, grid, stream);
    launch_step<1>(P, 0, grid, stream);
    for (int l = 0; l < 2; ++l) {
        launch_step<2>(P, l, grid, stream); launch_step<3>(P, l, grid, stream); launch_step<4>(P, l, grid, stream); launch_step<5>(P, l, grid, stream);
        launch_step<6>(P, l, grid, stream); launch_step<7>(P, l, grid, stream); launch_step<8>(P, l, grid, stream); launch_step<9>(P, l, grid, stream);
        launch_step<10>(P, l, grid, stream);
    }
#endif
}
#ifdef DBG_INST
template __global__ void k_step<11>(Params, int);
template __global__ void k_step<12>(Params, int);
template __global__ void k_step<13>(Params, int);
template __global__ void k_step<14>(Params, int);
template __global__ void k_step<15>(Params, int);
template __global__ void k_step<16>(Params, int);
#endif
```

```cpp
#include <hip/hip_runtime.h>
#include <cstdint>
#include <cstdio>

#ifndef N_LAUNCH_MODE
#define N_LAUNCH_MODE 1
#endif
#ifndef FAST_MIX
#define FAST_MIX 1
#endif
#ifndef DBG_TEST
#define DBG_TEST 0
#endif
#ifndef DBG_HG_MODE
#define DBG_HG_MODE 0
#endif
#ifndef FAST_GEMM
#define FAST_GEMM 1
#endif

#define LAS __attribute__((address_space(3)))
#define GAS __attribute__((address_space(1)))
typedef unsigned short bf16_t;
typedef short bf16x8 __attribute__((ext_vector_type(8)));
typedef float f32x4 __attribute__((ext_vector_type(4)));
typedef float f32x2 __attribute__((ext_vector_type(2)));
typedef unsigned u32x4 __attribute__((ext_vector_type(4)));
typedef unsigned u32x2 __attribute__((ext_vector_type(2)));
typedef short s16x4 __attribute__((ext_vector_type(4)));
typedef float f32x16 __attribute__((ext_vector_type(16)));
#define DI __device__ __forceinline__

constexpr int D = 1024, NB = 2, SEQ = 8192, CTXL = 256, NLAT = NB * SEQ, NCTX = NB * CTXL, NROWS = NLAT + NCTX;
constexpr int INW = 2816, PBW = 2304, ZW = 512, NEXP = 16, DEXP = 512, LISTCAP = NROWS;
constexpr int NTHREADS = 512, NWAVES = 8;
constexpr float ALPHA = 1.41421356237f, LN_EPS = 1e-5f, RMS_EPS = 1e-6f, LOG2E = 1.4426950408889634f, QSCALE = 0.125f * LOG2E;
constexpr int PB_AQ = 0, PB_AI = 256, PB_AG = 512, PB_NQ = 768, PB_NK = 1024, PB_NV = 1280, PB_SQ = 1536, PB_SK = 2048, PB_SV = 2176;
constexpr int NCHAIN = 132;

constexpr size_t MiB = 1u << 20;
constexpr size_t WS_CTL = 0, CTL_BYTES = 1 * MiB;
constexpr size_t WS_MODS = 1 * MiB;
constexpr size_t WS_LB = WS_MODS + 2 * 3 * 6144 * 4;
constexpr size_t WS_ROPE = WS_LB + 2 * 2 * 256 * 4;
constexpr size_t WS_TOKE = WS_ROPE + 129 * 16 * 2 * 4;
constexpr size_t WS_TOKP = WS_TOKE + NROWS * 8;
constexpr size_t WS_TOKW = WS_TOKP + NROWS * 8;
constexpr size_t WS_LIST = 2 * MiB;
constexpr size_t WS_XC = 4 * MiB;
constexpr size_t WS_X1 = 211 * MiB;
constexpr size_t WS_WIN = 6 * MiB;
constexpr size_t WS_WOUT = 17 * MiB;
constexpr size_t WS_WGU = 21 * MiB;
constexpr size_t WS_WD = 53 * MiB;
constexpr size_t WS_H = 69 * MiB;
constexpr size_t WS_Y = 102 * MiB;
constexpr size_t WS_S = 135 * MiB;
constexpr size_t WS_DD = 282 * MiB;
constexpr size_t WS_PB = 174 * MiB;
constexpr size_t WS_Z = WS_PB + (size_t)NROWS * PBW * 2;
constexpr size_t WS_O = 174 * MiB;
constexpr size_t WS_YO = 248 * MiB;
constexpr size_t WS_WGU1 = 284 * MiB, WS_WD1 = 316 * MiB;
constexpr size_t WS_END = 332 * MiB;
constexpr int HE_ROWS = 37888;
constexpr size_t WS_KK = WS_Z + (size_t)NROWS * ZW * 2;
static_assert(WS_DD + (size_t)2 * 2112 * 64 * 4 <= WS_END && WS_Z + (size_t)NROWS * ZW * 4 <= WS_DD && WS_O + (size_t)HE_ROWS * 1024 * 2 <= WS_YO && WS_YO + (size_t)NROWS * 2048 <= WS_END, "ws map");
static_assert(WS_TOKW + NROWS * 8 <= WS_LIST && WS_LIST + 16 * LISTCAP * 4 <= WS_XC, "ws map small");
constexpr int CW_CNT = 8192;
constexpr int CW_BAR = 4096;
constexpr int CW_DBG = 512;
constexpr int CW_Q = 1024;
constexpr int CW_TS = 2048;
constexpr int CW_SCAN = 1536;

struct Params {
    const float* in[21];
    float* out;
    unsigned char* ws;
    int step_lo, step_hi;
};

DI unsigned f2bf(float f) { unsigned u = __builtin_bit_cast(unsigned, f); return (u + 0x7fffu + ((u >> 16) & 1u)) >> 16; }
DI float bf2f(unsigned h) { return __builtin_bit_cast(float, h << 16); }
typedef __bf16 bf16x2_t __attribute__((ext_vector_type(2)));
DI unsigned pk2(float lo, float hi) { return __builtin_bit_cast(unsigned, __builtin_convertvector((f32x2){lo, hi}, bf16x2_t)); }
DI float bflo(unsigned w) { return __builtin_bit_cast(float, w << 16); }
DI float bfhi(unsigned w) { return __builtin_bit_cast(float, w & 0xffff0000u); }
#define DPPF(v, ctrl, rm) __builtin_bit_cast(float, __builtin_amdgcn_update_dpp(0, __builtin_bit_cast(int, (v)), (ctrl), (rm), 0xf, false))
DI float wave_sum(float v) {
    v += DPPF(v, 0xB1, 0xf); v += DPPF(v, 0x4E, 0xf); v += DPPF(v, 0x141, 0xf); v += DPPF(v, 0x140, 0xf);
    v += DPPF(v, 0x142, 0xa); v += DPPF(v, 0x143, 0xc);
    return __builtin_bit_cast(float, __builtin_amdgcn_readlane(__builtin_bit_cast(int, v), 63));
}
DI float wave_max(float v) {
#pragma unroll
    for (int o = 1; o < 64; o <<= 1) v = fmaxf(v, __shfl_xor(v, o));
    return v;
}
DI float sigmoidf_(float x) { return 1.0f / (1.0f + __expf(-x)); }
DI float siluf_(float x) { return x / (1.0f + __expf(-x)); }
DI unsigned pk_fp8x4(f32x4 v) { int w = 0; w = __builtin_amdgcn_cvt_pk_fp8_f32(v[0], v[1], w, false); w = __builtin_amdgcn_cvt_pk_fp8_f32(v[2], v[3], w, true); return (unsigned)w; }
DI void store_bf4(bf16_t* p, f32x4 v) { u32x2 w; w.x = pk2(v[0], v[1]); w.y = pk2(v[2], v[3]); *(u32x2*)p = w; }

struct Ctx {
    LAS unsigned char* lds;
    int tid, lane, wave, bid, nb;
};

struct Unit { int pm, pn, e, cnt, i0, slot; };

struct PlainSched {
    int nM, nN, nwg, G, c;
    DI void init(int M, int N, int G_, int c_) { nM = M / 256; nN = N / 256; nwg = nM * nN; G = G_; c = c_; }
    DI bool next(int i, Unit& u) const {
        const long L = (long)i * G + c; if (L >= nwg) return false;
        int wgid = (int)L; { const int q = nwg / 8, r = nwg % 8, xcd = wgid % 8, off = wgid / 8; wgid = (xcd < r ? xcd * (q + 1) : r * (q + 1) + (xcd - r) * q) + off; }
        const int nig = 8 * nN, gid = wgid / nig, fm = gid * 8, gsz = (nM - fm) < 8 ? (nM - fm) : 8;
        u.pm = fm + ((wgid % nig) % gsz); u.pn = (wgid % nig) / gsz; u.e = 0; u.cnt = 0; u.i0 = 0; u.slot = 0; return true;
    }
    DI int a_row(const Unit& u, int r) const { return u.pm * 256 + r; }
    DI int b_row0(const Unit& u) const { return u.pn * 256; }
    static constexpr bool LOADS = false;
};
constexpr int MOE_TBL_OFF = 144 * 1024 + 512;
constexpr int MOE_LIST_OFF = 144 * 1024 + 2560;
DI void moe_build_table(const Ctx& X, const int* cnt) {
    LAS int* tbl = (LAS int*)(X.lds + MOE_TBL_OFF);
    if (X.tid < 160) { const int T = X.tid; int acc = 0, e = -1, i0 = 0, ce = 0;
#pragma unroll
        for (int q = 0; q < NEXP; ++q) { const int cq = cnt[q * 64]; const int nt = (cq + 255) >> 8; if (e < 0 && T < acc + nt) { e = q; i0 = T - acc; ce = cq; } acc += nt; }
        tbl[1 + 3 * T] = e; tbl[2 + 3 * T] = i0; tbl[3 + 3 * T] = ce; if (T == 0) tbl[0] = acc; }
    __syncthreads();
}
template <bool GATHER> struct MoeSched {
    const int* cnt; const int* list; int G, c, nct, bt_rows; LAS unsigned char* lds; static constexpr bool gather = GATHER;
    DI bool next(int i, Unit& u) const {
        const LAS int* tbl = (const LAS int*)(lds + MOE_TBL_OFF);
        const int xcd = c & 7, j = c >> 3; const int L = i * G + xcd * (G >> 3) + j;
        const int T = L / nct; if (T >= __builtin_amdgcn_readfirstlane(tbl[0])) return false;
        u.slot = i; u.pm = T; u.pn = L % nct; u.e = __builtin_amdgcn_readfirstlane(tbl[1 + 3 * T]); u.i0 = __builtin_amdgcn_readfirstlane(tbl[2 + 3 * T]); u.cnt = __builtin_amdgcn_readfirstlane(tbl[3 + 3 * T]); return true;
    }
    DI int a_row(const Unit& u, int r) const {
        if (!gather) return u.pm * 256 + r;
        return ((const LAS int*)(lds + MOE_LIST_OFF))[u.slot * 256 + r];
    }
    DI int b_row0(const Unit& u) const { return u.e * bt_rows + u.pn * 256; }
    static constexpr bool LOADS = GATHER;
};

DI void store_bf8(bf16_t* p, f32x4 lo, f32x4 hi) { u32x4 w; w.x = pk2(lo[0], lo[1]); w.y = pk2(lo[2], lo[3]); w.z = pk2(hi[0], hi[1]); w.w = pk2(hi[2], hi[3]); *(u32x4*)p = w; }
DI void store_f8x8(unsigned char* p, f32x4 lo, f32x4 hi) { u32x2 w; w.x = pk_fp8x4(lo); w.y = pk_fp8x4(hi); *(u32x2*)p = w; }
DI float lane32_partner(float v, bool upper) { const auto rr = __builtin_amdgcn_permlane32_swap(__float_as_uint(v), __float_as_uint(v), false, false); return __uint_as_float(upper ? rr[0] : rr[1]); }
struct EpiIn {
    bf16_t* PB; bf16_t* Z; const float* rope; const float* lb; bf16_t* KK;
    DI void gate8(bf16_t* zp, bf16_t* kp, const float* lbp, f32x4 z0, f32x4 z1) const {
        const f32x4 lb0 = *(const f32x4*)lbp, lb1 = *(const f32x4*)(lbp + 4); f32x4 lf0, lf1, k0, k1;
#pragma unroll
        for (int j = 0; j < 4; ++j) { const float zc = fminf(fmaxf(z0[j], -30.f), 30.f), e = __expf(-zc), sg = 1.0f / (1.0f + e); lf0[j] = __log2f(lb0[j] + (1.0f - lb0[j]) * sg); k0[j] = (1.0f - lb0[j]) * (e * sg); }
#pragma unroll
        for (int j = 0; j < 4; ++j) { const float zc = fminf(fmaxf(z1[j], -30.f), 30.f), e = __expf(-zc), sg = 1.0f / (1.0f + e); lf1[j] = __log2f(lb1[j] + (1.0f - lb1[j]) * sg); k1[j] = (1.0f - lb1[j]) * (e * sg); }
        store_bf8(zp, lf0, lf1); store_bf8(kp, k0, k1);
    }
    DI void rope8(f32x4& v0, f32x4& v1, const float* rp, bool upper) const {
#pragma unroll
        for (int j = 0; j < 4; ++j) { const float c0 = rp[2 * j], s0 = rp[2 * j + 1], c1 = rp[2 * (j + 4)], s1 = rp[2 * (j + 4) + 1];
            const float p0 = lane32_partner(v0[j], upper), p1 = lane32_partner(v1[j], upper);
            v0[j] = upper ? p0 * s0 + v0[j] * c0 : v0[j] * c0 - p0 * s0; v1[j] = upper ? p1 * s1 + v1[j] * c1 : v1[j] * c1 - p1 * s1; }
    }
    DI void group(const Unit& u, int r, int c, f32x4 a0, f32x4 a1, f32x4 b0, f32x4 b1) const {
        const int row = u.pm * 256 + r, seg = u.pn, gc = u.pn * 256 + c;
        if (seg == 1 || seg == 2) {
            const int ci = (seg - 1) * 256 + c; bf16_t* z = Z + (size_t)row * ZW + ci; bf16_t* k = KK + (size_t)row * ZW + ci; const float* lp = lb + ci;
            gate8(z, k, lp, a0, a1); gate8(z + 128, k + 128, lp + 128, b0, b1);
            return;
        }
        if (seg >= 8) {
            const int t = row & (SEQ - 1); const int which = (c >> 5) & 1; const int pos = row < NLAT ? (which ? (t & 63) : (t >> 6)) : 128;
            const bool upper = (c & 31) >= 16; const float* rp = rope + (pos * 16 + (c & 15)) * 2;
            rope8(a0, a1, rp, upper); if (seg < 10) rope8(b0, b1, rp, upper);
        }
        if (seg == 5 || seg == 8 || seg == 9) { a0 *= QSCALE; a1 *= QSCALE; b0 *= QSCALE; b1 *= QSCALE; }
        bf16_t* p = PB + (size_t)row * PBW + (gc >= 768 ? gc - 512 : gc);
        store_bf8(p, a0, a1); store_bf8(p + 128, b0, b1);
    }
};
struct EpiBf {
    bf16_t* C; int ldc;
    DI void group(const Unit& u, int r, int c, f32x4 a0, f32x4 a1, f32x4 b0, f32x4 b1) const {
        bf16_t* p = C + (size_t)(u.pm * 256 + r) * ldc + u.pn * 256 + c;
        store_bf8(p, a0, a1); store_bf8(p + 128, b0, b1);
    }
};
struct EpiF8 {
    unsigned char* C; int ldc;
    DI void group(const Unit& u, int r, int c, f32x4 a0, f32x4 a1, f32x4 b0, f32x4 b1) const {
        unsigned char* p = C + (size_t)(u.pm * 256 + r) * ldc + u.pn * 256 + c;
        store_f8x8(p, a0 * 16.0f, a1 * 16.0f); store_f8x8(p + 128, b0 * 16.0f, b1 * 16.0f);
    }
};
struct EpiGU {
    bf16_t* HE;
    DI void group(const Unit& u, int r, int c, f32x4 a0, f32x4 a1, f32x4 b0, f32x4 b1) const {
        f32x4 h0, h1;
#pragma unroll
        for (int j = 0; j < 4; ++j) { h0[j] = siluf_(a0[j]) * b0[j]; h1[j] = siluf_(a1[j]) * b1[j]; }
        store_f8x8((unsigned char*)HE + (size_t)(u.pm * 256 + r) * DEXP + u.pn * 128 + c, h0, h1);
    }
};

template <class Sched, class Epi>
DI void gemm_naive(const Ctx& X, const bf16_t* A, const bf16_t* Bt, int K, const Sched& S, const Epi& E) {
    Unit u;
    for (int i = 0; S.next(i, u); ++i) {
        for (int g = X.tid; g < 4096; g += NTHREADS) {
            const int fq = g & 3, wc = (g >> 2) & 3, r = g >> 4, c = wc * 32 + fq * 4;
            const bf16_t* ap = A + (size_t)S.a_row(u, r) * K;
            const bf16_t* bp = Bt + (size_t)(S.b_row0(u) + c) * K;
            float acc[16];
#pragma unroll
            for (int q = 0; q < 16; ++q) acc[q] = 0.f;
            for (int k = 0; k < K; k += 8) {
                const u32x4 av = *(const u32x4*)(ap + k);
                float af[8] = {bflo(av.x), bfhi(av.x), bflo(av.y), bfhi(av.y), bflo(av.z), bfhi(av.z), bflo(av.w), bfhi(av.w)};
#pragma unroll
                for (int q = 0; q < 16; ++q) {
                    const int col = (q >> 3) * 128 + ((q >> 2) & 1) * 16 + (q & 3);
                    const u32x4 bv = *(const u32x4*)(bp + (size_t)col * K + k);
                    acc[q] += af[0] * bflo(bv.x) + af[1] * bfhi(bv.x) + af[2] * bflo(bv.y) + af[3] * bfhi(bv.y) + af[4] * bflo(bv.z) + af[5] * bfhi(bv.z) + af[6] * bflo(bv.w) + af[7] * bfhi(bv.w);
                }
            }
            E.group(u, r, c, (f32x4){acc[0], acc[1], acc[2], acc[3]}, (f32x4){acc[4], acc[5], acc[6], acc[7]}, (f32x4){acc[8], acc[9], acc[10], acc[11]}, (f32x4){acc[12], acc[13], acc[14], acc[15]});
        }
    }
}

constexpr int HTB = 128 * 64 * 2;
DI int lds_byte(int r, int c) { const int st = (r >> 4) * 2 + (c >> 5), rr = r & 15, cc = c & 31, ob = rr * 64 + cc * 2; return st * 1024 + (ob ^ (((ob >> 9) & 1) << 5)); }
DI void stage_rc(int b, int& R, int& C) { const int st = b / 1024, sb = b % 1024, swz = sb ^ (((sb >> 9) & 1) << 5); R = (st >> 1) * 16 + swz / 64; C = (st & 1) * 32 + (swz % 64) / 2; }
typedef int v8i_t __attribute__((ext_vector_type(8)));
template <class Sched, class Epi, bool F8 = false, int SCALE_B = 127>
DI void gemm_fast(const Ctx& X, const void* A, const void* Bt, int K, const Sched& S, const Epi& E) {
    LAS unsigned char* lds = X.lds;
    const int tid = X.tid, wid = X.wave, lane = X.lane, wr = wid >> 2, wc = wid & 3, fr = lane & 15, fq = lane >> 4;
    asm volatile("" : "+s"(K));
    const int RP = F8 ? K : 2 * K, nt = RP / 128;
    int Rr[2], Cc[2]; unsigned voffB[2];
#pragma unroll
    for (int i = 0; i < 2; ++i) { stage_rc(tid * 16 + i * 8192, Rr[i], Cc[i]); const int rho = Rr[i] & 31, Rb = (Rr[i] & ~31) + 8 * ((rho & 15) >> 2) + 4 * (rho >> 4) + (rho & 3);
        voffB[i] = (unsigned)(Rb * RP + Cc[i] * 2); }
    const size_t kstep = 128, hstepB = (size_t)128 * RP;
    const unsigned ldsw = (unsigned)wid * 1024u;
    const int aoff = lds_byte(wr * 64 + fr, fq * 8), boff = lds_byte(wc * 32 + fr, fq * 8);
#define G_SA(b, h) (((b) * 2 + (h)) * HTB)
#define G_SB(b, h) ((4 + (b) * 2 + (h)) * HTB)
#define G_STAGE(bufoff, gbase, voff) do { _Pragma("unroll") for (int _i = 0; _i < 2; ++_i) \
        __builtin_amdgcn_global_load_lds((const unsigned*)((const char*)(gbase) + (voff)[_i]), (LAS unsigned*)(lds + (bufoff) + ldsw + _i * 8192), 16, 0, 0); } while (0)
#define G_LD8(p) __builtin_bit_cast(v8i_t, __builtin_shufflevector(*(const LAS u32x4*)(p), *(const LAS u32x4*)((p) + 1024), 0, 1, 2, 3, 4, 5, 6, 7))
#define G_LDA(dst, b, h) do { _Pragma("unroll") for (int m = 0; m < 4; ++m) dst[m] = G_LD8(lds + G_SA(b, h) + aoff + m * 2048); } while (0)
#define G_LDB(dst, b, h) do { _Pragma("unroll") for (int n = 0; n < 2; ++n) dst[n] = G_LD8(lds + G_SB(b, h) + boff + n * 2048); } while (0)
#define G_LO(f) __builtin_bit_cast(bf16x8, __builtin_shufflevector((f), (f), 0, 1, 2, 3))
#define G_HI(f) __builtin_bit_cast(bf16x8, __builtin_shufflevector((f), (f), 4, 5, 6, 7))
#define G_MMA(ai, bj, At, Bt_) do { __builtin_amdgcn_s_setprio(1); _Pragma("unroll") for (int m = 0; m < 4; ++m) _Pragma("unroll") for (int n = 0; n < 2; ++n) { \
        if constexpr (F8) asm volatile("v_mfma_scale_f32_16x16x128_f8f6f4 %0, %1, %2, %0, %3, %4 op_sel_hi:[0,0,0]" : "+v"(acc[ai][bj][m][n]) : "v"(Bt_[n]), "v"(At[m]), "v"(scl_w), "v"(scl_x)); \
        else { acc[ai][bj][m][n] = __builtin_amdgcn_mfma_f32_16x16x32_bf16(G_LO(Bt_[n]), G_LO(At[m]), acc[ai][bj][m][n], 0, 0, 0); acc[ai][bj][m][n] = __builtin_amdgcn_mfma_f32_16x16x32_bf16(G_HI(Bt_[n]), G_HI(At[m]), acc[ai][bj][m][n], 0, 0, 0); } } __builtin_amdgcn_s_setprio(0); } while (0)
#define G_WAIT_V(n) asm volatile("s_waitcnt vmcnt(" #n ")" ::: "memory")
#define G_WAIT_L(n) asm volatile("s_waitcnt lgkmcnt(" #n ")" ::: "memory")
#define G_BAR __builtin_amdgcn_s_barrier()
#define G_SCHED __builtin_amdgcn_sched_barrier(0)
    Unit cur, nxt; int ui = 0;
    if (!S.next(0, cur)) return;
    f32x4 acc[2][2][4][2];
#pragma unroll
    for (int a = 0; a < 2; ++a)
#pragma unroll
        for (int b = 0; b < 2; ++b)
#pragma unroll
            for (int m = 0; m < 4; ++m)
#pragma unroll
                for (int n = 0; n < 2; ++n) acc[a][b][m][n] = (f32x4){0.f, 0.f, 0.f, 0.f};
    v8i_t At[4], B0[2], B1[2];
    int scl_w = SCALE_B * 0x01010101, scl_x = 0x7f7f7f7f; asm volatile("" : "+v"(scl_w), "+v"(scl_x));
    constexpr bool GA = Sched::LOADS;
    unsigned vAc[2][2], vAn[2][2];
#pragma unroll
    for (int h = 0; h < 2; ++h)
#pragma unroll
        for (int i = 0; i < 2; ++i) { vAc[h][i] = GA ? (unsigned)(S.a_row(cur, h * 128 + Rr[i]) * RP + Cc[i] * 2) : (unsigned)((h * 128 + Rr[i]) * RP + Cc[i] * 2); vAn[h][i] = vAc[h][i]; }
    if (GA) G_WAIT_V(0);
    const char* A0 = (const char*)A;
    const char* cA = GA ? A0 : A0 + (size_t)S.a_row(cur, 0) * RP;
    const char* cB = (const char*)Bt + (size_t)S.b_row0(cur) * RP;
    G_STAGE(G_SB(0, 0), cB, voffB); G_STAGE(G_SB(0, 1), cB + hstepB, voffB); G_STAGE(G_SA(0, 0), cA, vAc[0]); G_STAGE(G_SA(0, 1), cA, vAc[1]);
    if (wr == 1) G_BAR;
    G_WAIT_V(2); G_BAR;
    G_STAGE(G_SB(1, 0), cB + kstep, voffB); G_STAGE(G_SA(1, 0), cA + kstep, vAc[0]); G_STAGE(G_SB(1, 1), cB + hstepB + kstep, voffB);
    G_WAIT_V(6); G_BAR;
    for (;;) {
        const bool has_next = S.next(ui + 1, nxt);
        if (GA) {
#pragma unroll
            for (int h = 0; h < 2; ++h)
#pragma unroll
                for (int i = 0; i < 2; ++i) vAn[h][i] = has_next ? (unsigned)(S.a_row(nxt, h * 128 + Rr[i]) * RP + Cc[i] * 2) : vAc[h][i];
        }
        const char* nA = GA ? A0 : (has_next ? A0 + (size_t)S.a_row(nxt, 0) * RP : cA);
        const char* nB = has_next ? (const char*)Bt + (size_t)S.b_row0(nxt) * RP : cB;
#pragma unroll 1
        for (int t = 0; t < nt; t += 2) {
            const bool last = (t == nt - 2);
            const char* a1 = cA + (size_t)(t + 1) * kstep;
            const char* a2 = last ? nA : cA + (size_t)(t + 2) * kstep; const char* b2 = last ? nB : cB + (size_t)(t + 2) * kstep;
            const char* a3 = a2 + kstep; const char* b3 = b2 + kstep;
            unsigned v2[2][2];
#pragma unroll
            for (int h = 0; h < 2; ++h)
#pragma unroll
                for (int i = 0; i < 2; ++i) v2[h][i] = (GA && last) ? vAn[h][i] : vAc[h][i];
            G_LDB(B0, 0, 0); G_LDB(B1, 0, 1); G_SCHED; G_LDA(At, 0, 0); G_STAGE(G_SA(1, 1), a1, vAc[1]);
            G_WAIT_V(8); G_WAIT_L(0); G_BAR; G_MMA(0, 0, At, B0); G_MMA(0, 1, At, B1); G_BAR; G_SCHED;
            G_LDA(At, 0, 1); G_STAGE(G_SB(0, 0), b2, voffB); G_STAGE(G_SB(0, 1), b2 + hstepB, voffB); G_STAGE(G_SA(0, 0), a2, v2[0]);
            G_WAIT_V(8); G_WAIT_L(0); G_BAR; G_MMA(1, 0, At, B0); G_MMA(1, 1, At, B1); G_BAR; G_SCHED;
            G_LDB(B0, 1, 0); G_LDB(B1, 1, 1); G_SCHED; G_LDA(At, 1, 0); G_STAGE(G_SA(0, 1), a2, v2[1]);
            G_WAIT_V(8); G_WAIT_L(0); G_BAR; G_MMA(0, 0, At, B0); G_MMA(0, 1, At, B1); G_BAR; G_SCHED;
            G_LDA(At, 1, 1); G_STAGE(G_SB(1, 0), b3, voffB); G_STAGE(G_SB(1, 1), b3 + hstepB, voffB); G_STAGE(G_SA(1, 0), a3, v2[0]);
            G_WAIT_V(8); G_WAIT_L(0); G_BAR; G_MMA(1, 0, At, B0); G_MMA(1, 1, At, B1); G_BAR; G_SCHED;
        }
        if constexpr (F8) asm volatile("s_nop 15\n\ts_nop 15" ::: "memory");
        if (wr == 0) G_BAR;
#pragma unroll
        for (int ai = 0; ai < 2; ++ai)
#pragma unroll
            for (int m = 0; m < 4; ++m) E.group(cur, ai * 128 + wr * 64 + m * 16 + fr, wc * 32 + fq * 8, acc[ai][0][m][0], acc[ai][0][m][1], acc[ai][1][m][0], acc[ai][1][m][1]);
        if (!has_next) break;
#pragma unroll
        for (int a = 0; a < 2; ++a)
#pragma unroll
            for (int b = 0; b < 2; ++b)
#pragma unroll
                for (int m = 0; m < 4; ++m)
#pragma unroll
                    for (int n = 0; n < 2; ++n) acc[a][b][m][n] = (f32x4){0.f, 0.f, 0.f, 0.f};
        cur = nxt; cB = nB; cA = nA; ++ui;
        if (GA) {
#pragma unroll
            for (int h = 0; h < 2; ++h)
#pragma unroll
                for (int i = 0; i < 2; ++i) vAc[h][i] = vAn[h][i]; }
        if (wr == 1) G_BAR;
    }
    G_WAIT_V(0);
    G_BAR;
#undef G_SA
#undef G_SB
#undef G_STAGE
#undef G_LDA
#undef G_LDB
#undef G_MMA
#undef G_LD8
#undef G_LO
#undef G_HI
#undef G_WAIT_V
#undef G_WAIT_L
#undef G_BAR
#undef G_SCHED
}
#if FAST_GEMM
#define GEMM_IMPL gemm_fast
#else
#define GEMM_IMPL gemm_naive
#endif

struct TrDesc { const float* W; bf16_t* WT; int N, Kd, k0, n0, drow0, f8; float sc; };
DI void tr_load(const TrDesc& d, float (&rg)[32], int lane) {
#pragma unroll
    for (int i = 0; i < 32; ++i) { const int kk = 2 * i + (lane >> 5); rg[i] = d.W[(size_t)(d.k0 + kk) * d.N + d.n0 + (lane & 31)]; }
}
DI void tr_finish(const TrDesc& d, const float (&rg)[32], LAS float* scr, int lane) {
#pragma unroll
    for (int i = 0; i < 32; ++i) { const int kk = 2 * i + (lane >> 5); scr[kk * 33 + (lane & 31)] = rg[i]; }
    asm volatile("s_waitcnt lgkmcnt(0)" ::: "memory");
    const int c = lane & 7;
#pragma unroll
    for (int j = 0; j < 4; ++j) { const int n = (lane >> 3) + 8 * j; const LAS float* s = scr + (8 * c) * 33 + n;
        if (d.f8) { u32x2 o; o.x = pk_fp8x4((f32x4){s[0 * 33], s[1 * 33], s[2 * 33], s[3 * 33]} * d.sc); o.y = pk_fp8x4((f32x4){s[4 * 33], s[5 * 33], s[6 * 33], s[7 * 33]} * d.sc);
            *(u32x2*)((unsigned char*)d.WT + (size_t)(d.drow0 + n) * d.Kd + d.k0 + 8 * c) = o; }
        else { u32x4 o; o.x = pk2(s[0 * 33], s[1 * 33]); o.y = pk2(s[2 * 33], s[3 * 33]); o.z = pk2(s[4 * 33], s[5 * 33]); o.w = pk2(s[6 * 33], s[7 * 33]);
            *(u32x4*)(d.WT + (size_t)(d.drow0 + n) * d.Kd + d.k0 + 8 * c) = o; } }
    asm volatile("s_waitcnt lgkmcnt(0)" ::: "memory");
}
DI TrDesc expert_desc(const Params& P, int l, int it) {
    bf16_t* WGU = (bf16_t*)(P.ws + (l ? WS_WGU1 : WS_WGU)); bf16_t* WD = (bf16_t*)(P.ws + (l ? WS_WD1 : WS_WD));
    const float* wg = P.in[18] + (size_t)l * NEXP * D * DEXP; const float* wu = P.in[19] + (size_t)l * NEXP * D * DEXP; const float* wd = P.in[20] + (size_t)l * NEXP * DEXP * D;
    const int set = it >> 12, r = it & 4095, e = r >> 8, q = r & 255; TrDesc d; d.sc = 32.0f;
    if (set < 2) { const int kb = q >> 4, nbk = q & 15, n0 = nbk * 32;
        d.f8 = 1; d.W = (set ? wu : wg) + (size_t)e * D * DEXP; d.N = DEXP; d.WT = (bf16_t*)((unsigned char*)WGU + (size_t)e * 1024 * 1024); d.Kd = 1024; d.k0 = kb * 64; d.n0 = n0; d.drow0 = 256 * (n0 >> 7) + (n0 & 127) + set * 128;
    } else { const int kb = q >> 5, nbk = q & 31, n0 = nbk * 32;
        d.f8 = 1; d.W = wd + (size_t)e * DEXP * D; d.N = D; d.WT = (bf16_t*)((unsigned char*)WD + (size_t)e * 1024 * 512); d.Kd = 512; d.k0 = kb * 64; d.n0 = n0; d.drow0 = n0; }
    return d;
}
DI TrDesc rest_desc(const Params& P, int it) {
    if (it >= 2432) return expert_desc(P, 0, it - 2432);
    bf16_t* WIN = (bf16_t*)(P.ws + WS_WIN); bf16_t* WOUT = (bf16_t*)(P.ws + WS_WOUT); TrDesc d;
    d.f8 = 1; d.sc = 32.0f;
    if (it < 1408) { const int kb = it / 88, nbk = it % 88; d.f8 = 1; d.W = P.in[6] + (size_t)D * INW; d.N = INW; d.WT = (bf16_t*)((unsigned char*)WIN + (size_t)INW * D); d.Kd = D; d.k0 = kb * 64; d.n0 = nbk * 32; d.drow0 = nbk * 32; }
    else { const int r0 = it - 1408, l = r0 >> 9, r = r0 & 511, kb = r >> 5, nbk = r & 31; d.sc = 64.0f; d.W = P.in[11] + (size_t)l * D * D; d.N = D; d.WT = (bf16_t*)((unsigned char*)WOUT + (size_t)l * D * D); d.Kd = D; d.k0 = kb * 64; d.n0 = nbk * 32; d.drow0 = nbk * 32; }
    return d;
}
DI TrDesc win0_desc(const Params& P, int it) { TrDesc d; d.f8 = 1; d.sc = 32.0f; const int kb = it / 88, nbk = it % 88; d.W = P.in[6]; d.N = INW; d.WT = (bf16_t*)(P.ws + WS_WIN); d.Kd = D; d.k0 = kb * 64; d.n0 = nbk * 32; d.drow0 = nbk * 32; return d; }
#define TR_LOOP(DESC_EXPR, first, limit, step) do { int it_ = (first); if (it_ < (limit)) { float rg_[32]; TrDesc d_ = DESC_EXPR(it_); tr_load(d_, rg_, X.lane); \
        for (;;) { const int nx_ = it_ + (step); if (nx_ < (limit)) { float rn_[32]; const TrDesc dn_ = DESC_EXPR(nx_); tr_load(dn_, rn_, X.lane); tr_finish(d_, rg_, scr, X.lane); d_ = dn_; _Pragma("unroll") for (int q_ = 0; q_ < 32; ++q_) rg_[q_] = rn_[q_]; it_ = nx_; } \
                   else { tr_finish(d_, rg_, scr, X.lane); break; } } } } while (0)
DI void ph_prologue(const Ctx& X, const Params& P) {
    LAS float* sc = (LAS float*)X.lds;
    LAS float* red = sc + 3072;
    float* MODS = (float*)(P.ws + WS_MODS);
    for (int it = X.bid; it < 193; it += X.nb) {
        if (it < 192) {
            const int l = it / 96, cg = it % 96;
            for (int i = X.tid; i < 3072; i += NTHREADS) { const int cond = i >> 10, k = i & 1023; const float v = cond < 2 ? P.in[1][cond * 1024 + k] : P.in[3][k]; sc[i] = siluf_(v); }
            __syncthreads();
            const int kq = X.tid >> 4, c4 = X.tid & 15;
            float acc[3][4];
#pragma unroll
            for (int a = 0; a < 3; ++a)
#pragma unroll
                for (int j = 0; j < 4; ++j) acc[a][j] = 0.f;
            const float* w = P.in[4] + (size_t)l * D * 6144 + cg * 64 + c4 * 4;
#pragma unroll 8
            for (int i = 0; i < 32; ++i) { const int k = kq + 32 * i; const f32x4 wv = *(const f32x4*)(w + (size_t)k * 6144);
                const float s0 = sc[k], s1 = sc[1024 + k], s2 = sc[2048 + k];
#pragma unroll
                for (int j = 0; j < 4; ++j) { acc[0][j] += s0 * wv[j]; acc[1][j] += s1 * wv[j]; acc[2][j] += s2 * wv[j]; } }
#pragma unroll
            for (int a = 0; a < 3; ++a)
#pragma unroll
                for (int j = 0; j < 4; ++j) red[(kq * 3 + a) * 64 + c4 * 4 + j] = acc[a][j];
            __syncthreads();
            if (X.tid < 192) { const int cond = X.tid >> 6, col = X.tid & 63; float s = 0.f;
                for (int q = 0; q < 32; ++q) s += red[(q * 3 + cond) * 64 + col];
                MODS[(l * 3 + cond) * 6144 + cg * 64 + col] = s + P.in[5][l * 6144 + cg * 64 + col]; }
            __syncthreads();
        } else {
            float* LB = (float*)(P.ws + WS_LB);
            { const int i = X.tid; const float l0 = P.in[7][i], l1 = P.in[7][512 + i]; const float p1 = 1.0f / (1.0f + expf(l0 - l1));
              LB[i] = 1e-6f; LB[512 + i] = fmaxf(p1, 1e-6f); }
            float* RP = (float*)(P.ws + WS_ROPE);
            for (int i = X.tid; i < 2048 + 16; i += NTHREADS) { const int pos = i >> 4, f = i & 15; const float inv = powf(10000.0f, -(float)f / 16.0f); const float ang = pos < 128 ? (float)pos * inv : 0.0f;
                RP[2 * i] = cosf(ang); RP[2 * i + 1] = sinf(ang); }
        }
    }
    __syncthreads();
    LAS float* scr = (LAS float*)X.lds + X.wave * (64 * 33);
    const int gw = X.bid * NWAVES + X.wave, NGW = X.nb * NWAVES;
#define DESC_WIN0(i) win0_desc(P, (i))
    TR_LOOP(DESC_WIN0, gw, 1408, NGW);
}
DI void convert_rest(const Ctx& X, const Params& P) {
    LAS float* scr = (LAS float*)X.lds + X.wave * (64 * 33);
    const int gw = X.bid * NWAVES + X.wave, NGW = X.nb * NWAVES;
#define DESC_REST(i) rest_desc(P, (i))
    TR_LOOP(DESC_REST, gw, 2432, NGW);
}

DI const float* mods_row(const Params& P, int l, int row) { const int cond = row < NLAT ? (row >> 13) : 2; return (const float*)(P.ws + WS_MODS) + (l * 3 + cond) * 6144; }
template <int NR>
DI void modulate_rows(const Ctx& X, const Params& P, int l, int row0) {
    bf16_t* H = (bf16_t*)(P.ws + WS_H);
    const float* xr = row0 < NLAT ? P.in[0] + (size_t)row0 * D : P.in[2] + (size_t)(row0 - NLAT) * D; const float* md = mods_row(P, l, row0);
    f32x4 x[NR][4];
#pragma unroll
    for (int j = 0; j < 4; ++j)
#pragma unroll
        for (int r = 0; r < NR; ++r) x[r][j] = *(const f32x4*)(xr + (size_t)r * D + 4 * X.lane + 256 * j);
#pragma unroll
    for (int j = 0; j < 4; ++j) { const int c = 4 * X.lane + 256 * j; const f32x4 sh = *(const f32x4*)(md + c), sc = *(const f32x4*)(md + 1024 + c);
#pragma unroll
        for (int r = 0; r < NR; ++r) *(unsigned*)((unsigned char*)H + (size_t)(row0 + r) * D + c) = pk_fp8x4(x[r][j] * (1.0f + sc) + sh); }
}
DI void ph_modulate(const Ctx& X, const Params& P, int l) {
    const int gw = X.bid * NWAVES + X.wave;
    if (gw < NLAT / 8) { modulate_rows<4>(X, P, l, 8 * gw); modulate_rows<4>(X, P, l, 8 * gw + 4); }
    if (gw < NCTX) modulate_rows<1>(X, P, l, NLAT + gw);
}
template <int NR>
DI void ln1_rows(const Ctx& X, const Params& P, int l, int row0, int slot0, const LAS float* wrT, float (&lgv)[16]) {
    bf16_t* H = (bf16_t*)(P.ws + WS_H); const bf16_t* YO = (const bf16_t*)(P.ws + WS_YO); bf16_t* X1 = (bf16_t*)(P.ws + WS_X1) + (size_t)row0 * D;
    const float* g = P.in[12] + l * D; const float* bta = P.in[13] + l * D;
    const bool lat = row0 < NLAT;
    const float* xr = lat ? P.in[0] + (size_t)row0 * D : P.in[2] + (size_t)(row0 - NLAT) * D;
    const bf16_t* xb = (const bf16_t*)P.out + (size_t)row0 * D;
    const float* md = mods_row(P, l, row0);
    const int c0 = 4 * X.lane;
    f32x4 v[NR][4]; float sm[NR];
#pragma unroll
    for (int r = 0; r < NR; ++r) sm[r] = 0.f;
#pragma unroll
    for (int j = 0; j < 4; ++j) { const int c = c0 + 256 * j; const f32x4 g1 = *(const f32x4*)(md + 2048 + c);
#pragma unroll
        for (int r = 0; r < NR; ++r) { f32x4 x; if (l == 0) x = *(const f32x4*)(xr + (size_t)r * D + c); else { const u32x2 xw = *(const u32x2*)(xb + (size_t)r * D + c); x = (f32x4){bflo(xw.x), bfhi(xw.x), bflo(xw.y), bfhi(xw.y)}; }
            const u32x2 yw = *(const u32x2*)(YO + (size_t)(row0 + r) * D + c);
            const f32x4 y = {bflo(yw.x), bfhi(yw.x), bflo(yw.y), bfhi(yw.y)}; v[r][j] = ALPHA * x + g1 * y; sm[r] += (v[r][j][0] + v[r][j][1]) + (v[r][j][2] + v[r][j][3]); } }
    float rstd[NR];
#pragma unroll
    for (int r = 0; r < NR; ++r) { const float mean = wave_sum(sm[r]) * (1.0f / D); float q = 0.f;
#pragma unroll
        for (int j = 0; j < 4; ++j) { v[r][j] = v[r][j] - mean; q += (v[r][j][0] * v[r][j][0] + v[r][j][1] * v[r][j][1]) + (v[r][j][2] * v[r][j][2] + v[r][j][3] * v[r][j][3]); }
        sm[r] = q; }
#pragma unroll
    for (int r = 0; r < NR; ++r) rstd[r] = 1.0f / sqrtf(wave_sum(sm[r]) * (1.0f / D) + LN_EPS);
#pragma unroll
    for (int j = 0; j < 4; ++j) { const int c = c0 + 256 * j; const f32x4 gm = *(const f32x4*)(g + c), bt = *(const f32x4*)(bta + c), sc2 = *(const f32x4*)(md + 4096 + c), sh2 = *(const f32x4*)(md + 3072 + c);
#pragma unroll
        for (int r = 0; r < NR; ++r) { const f32x4 x1 = v[r][j] * rstd[r] * gm + bt; store_bf4(X1 + (size_t)r * D + c, x1);
            const f32x4 h2 = x1 * (1.0f + sc2) + sh2; *(unsigned*)((unsigned char*)H + (size_t)(row0 + r) * D + c) = pk_fp8x4(h2); v[r][j] = h2; } }
#pragma unroll
    for (int e = 0; e < 16; ++e) {
        f32x4 w[4];
#pragma unroll
        for (int j = 0; j < 4; ++j) w[j] = *(const LAS f32x4*)(wrT + e * 1024 + c0 + 256 * j);
#pragma unroll
        for (int r = 0; r < NR; ++r) { f32x4 acc = v[r][0] * w[0]; acc += v[r][1] * w[1]; acc += v[r][2] * w[2]; acc += v[r][3] * w[3];
            const float tot = wave_sum((acc[0] + acc[1]) + (acc[2] + acc[3]));
            lgv[e] = X.lane == slot0 + r ? tot : lgv[e]; }
        asm volatile("" ::: "memory");
    }
}
DI void ph_ln1(const Ctx& X, const Params& P, int l, bool dummy = false) {
    LAS float* wrT = (LAS float*)X.lds;
    for (int i = X.tid; i < 16384; i += NTHREADS) { const int k = i >> 4, e = i & 15; wrT[e * 1024 + k] = P.in[16][i]; }
    int* TOKP = (int*)(P.ws + WS_TOKP); int* LIST = (int*)(P.ws + WS_LIST);
    unsigned* CNT = (unsigned*)(P.ws + WS_CTL) + CW_CNT + 1024 * l + (dummy ? 4096 : 0);
    LAS int* lcnt = (LAS int*)(X.lds + 65536); LAS int* lbase = lcnt + 16; LAS int* linfo = lcnt + 32;
    if (X.tid < 16) lcnt[X.tid] = 0;
    for (int i = X.tid; i < 72 * 4; i += NTHREADS) linfo[i] = -1;
    __syncthreads();
    const int gw = X.bid * NWAVES + X.wave;
    float lgv[16];
#pragma unroll
    for (int e = 0; e < 16; ++e) lgv[e] = 0.f;
    if (gw < NLAT / 8) ln1_rows<8>(X, P, l, 8 * gw, 0, wrT, lgv);
    const bool hasctx = l == 0 && gw < NCTX;
    if (hasctx) ln1_rows<1>(X, P, l, NLAT + gw, 8, wrT, lgv);
    {
        int* TOKE = (int*)(P.ws + WS_TOKE); float* TOKW = (float*)(P.ws + WS_TOKW);
        const int k = X.lane; const bool valid = (k < 8 && gw < NLAT / 8) || (k == 8 && hasctx); const int row = k < 8 ? 8 * gw + k : NLAT + gw;
        float sg[16], sel[16];
#pragma unroll
        for (int e = 0; e < 16; ++e) { sg[e] = sigmoidf_(lgv[e]); sel[e] = sg[e] + P.in[17][e]; }
        int best = 0; float bestv = -3e38f;
#pragma unroll
        for (int gq = 0; gq < 4; ++gq) { float m1 = -3e38f, m2 = -3e38f;
#pragma unroll
            for (int j = 0; j < 4; ++j) { const float t = sel[gq * 4 + j]; const float lo = fminf(m1, t); m1 = fmaxf(m1, t); m2 = fmaxf(m2, lo); }
            const float gs = m1 + m2; const bool bt = gs > bestv; best = bt ? gq : best; bestv = bt ? gs : bestv; }
        int i0 = 0, i1 = 0; float v0 = -3e38f, v1 = -3e38f, s0 = 0.f, s1 = 0.f;
#pragma unroll
        for (int e = 0; e < 16; ++e) { const float t = (e >> 2) == best ? sel[e] : -3e38f; const bool c0 = t > v0, c1 = !c0 && t > v1;
            v1 = c0 ? v0 : (c1 ? t : v1); i1 = c0 ? i0 : (c1 ? e : i1); s1 = c0 ? s0 : (c1 ? sg[e] : s1);
            v0 = c0 ? t : v0; i0 = c0 ? e : i0; s0 = c0 ? sg[e] : s0; }
        if (valid) { const int slot = X.wave * 9 + k; const float inv = 1.0f / (s0 + s1);
            const int p0 = __hip_atomic_fetch_add(lcnt + i0, 1, __ATOMIC_RELAXED, __HIP_MEMORY_SCOPE_WORKGROUP), p1 = __hip_atomic_fetch_add(lcnt + i1, 1, __ATOMIC_RELAXED, __HIP_MEMORY_SCOPE_WORKGROUP);
            linfo[4 * slot] = row; linfo[4 * slot + 1] = i0 | (i1 << 8); linfo[4 * slot + 2] = p0; linfo[4 * slot + 3] = p1;
            TOKE[2 * row] = i0; TOKE[2 * row + 1] = i1; TOKW[2 * row] = s0 * inv; TOKW[2 * row + 1] = s1 * inv; }
    }
    __syncthreads();
    if (X.tid < 16) lbase[X.tid] = (int)atomicAdd(CNT + 64 * X.tid, (unsigned)lcnt[X.tid]);
    __syncthreads();
    if (X.tid < 72) { const int row = linfo[4 * X.tid];
        if (row >= 0) { const int ee = linfo[4 * X.tid + 1], e0 = ee & 255, e1 = ee >> 8, p0 = lbase[e0] + linfo[4 * X.tid + 2], p1 = lbase[e1] + linfo[4 * X.tid + 3];
            LIST[e0 * LISTCAP + p0] = row; LIST[e1 * LISTCAP + p1] = row; TOKP[2 * row] = p0; TOKP[2 * row + 1] = p1; } }
}
template <int NR>
DI void ln2_rows(const Ctx& X, const Params& P, int l, int row0, const int (&off)[16]) {
    bf16_t* H = (bf16_t*)(P.ws + WS_H); const unsigned char* O = P.ws + WS_O; const bf16_t* X1 = (const bf16_t*)(P.ws + WS_X1) + (size_t)row0 * D;
    const int* TOKE = (const int*)(P.ws + WS_TOKE); const int* TOKP = (const int*)(P.ws + WS_TOKP); const float* TOKW = (const float*)(P.ws + WS_TOKW);
    const float* g = P.in[14] + l * D; const float* bta = P.in[15] + l * D;
    const bool lat = row0 < NLAT;
    const float* md = mods_row(P, l, row0); const float* mdn = mods_row(P, 1, row0);
    const int c0 = 4 * X.lane;
    const unsigned char* ra[NR]; const unsigned char* rb[NR]; float w0[NR], w1[NR];
#pragma unroll
    for (int r = 0; r < NR; ++r) { const int row = row0 + r; const int e0 = TOKE[2 * row], e1 = TOKE[2 * row + 1]; int o0 = 0, o1 = 0;
#pragma unroll
        for (int e = 0; e < 16; ++e) { if (e == e0) o0 = off[e]; if (e == e1) o1 = off[e]; }
        ra[r] = O + (size_t)(o0 + TOKP[2 * row]) * D; rb[r] = O + (size_t)(o1 + TOKP[2 * row + 1]) * D; w0[r] = TOKW[2 * row] * 0.0625f; w1[r] = TOKW[2 * row + 1] * 0.0625f; }
    f32x4 v[NR][4]; float sm[NR];
#pragma unroll
    for (int r = 0; r < NR; ++r) sm[r] = 0.f;
#pragma unroll
    for (int j = 0; j < 4; ++j) { const int c = c0 + 256 * j; const f32x4 g2 = *(const f32x4*)(md + 5120 + c);
#pragma unroll
        for (int r = 0; r < NR; ++r) { const u32x2 xw = *(const u32x2*)(X1 + (size_t)r * D + c); const f32x4 x = {bflo(xw.x), bfhi(xw.x), bflo(xw.y), bfhi(xw.y)}; const int a = *(const int*)(ra[r] + c), b = *(const int*)(rb[r] + c);
            const f32x2 a01 = __builtin_amdgcn_cvt_pk_f32_fp8(a, false), a23 = __builtin_amdgcn_cvt_pk_f32_fp8(a, true), b01 = __builtin_amdgcn_cvt_pk_f32_fp8(b, false), b23 = __builtin_amdgcn_cvt_pk_f32_fp8(b, true);
            const f32x4 f = w0[r] * (f32x4){a01[0], a01[1], a23[0], a23[1]} + w1[r] * (f32x4){b01[0], b01[1], b23[0], b23[1]};
            v[r][j] = ALPHA * x + g2 * f; sm[r] += (v[r][j][0] + v[r][j][1]) + (v[r][j][2] + v[r][j][3]); } }
    float rstd[NR];
#pragma unroll
    for (int r = 0; r < NR; ++r) { const float mean = wave_sum(sm[r]) * (1.0f / D); float q = 0.f;
#pragma unroll
        for (int j = 0; j < 4; ++j) { v[r][j] = v[r][j] - mean; q += (v[r][j][0] * v[r][j][0] + v[r][j][1] * v[r][j][1]) + (v[r][j][2] * v[r][j][2] + v[r][j][3] * v[r][j][3]); }
        sm[r] = q; }
#pragma unroll
    for (int r = 0; r < NR; ++r) rstd[r] = 1.0f / sqrtf(wave_sum(sm[r]) * (1.0f / D) + LN_EPS);
#pragma unroll
    for (int j = 0; j < 4; ++j) { const int c = c0 + 256 * j; const f32x4 gm = *(const f32x4*)(g + c), bt = *(const f32x4*)(bta + c);
        f32x4 sc1 = {0.f, 0.f, 0.f, 0.f}, sh1 = {0.f, 0.f, 0.f, 0.f}; if (l == 0) { sc1 = *(const f32x4*)(mdn + 1024 + c); sh1 = *(const f32x4*)(mdn + c); }
#pragma unroll
        for (int r = 0; r < NR; ++r) { const f32x4 x2 = v[r][j] * rstd[r] * gm + bt;
            if (l == 0) { if (lat) store_bf4((bf16_t*)P.out + (size_t)(row0 + r) * D + c, x2); *(unsigned*)((unsigned char*)H + (size_t)(row0 + r) * D + c) = pk_fp8x4(x2 * (1.0f + sc1) + sh1); }
            else *(f32x4*)(P.out + (size_t)(row0 + r) * D + c) = x2; } }
}
DI void ph_ln2(const Ctx& X, const Params& P, int l) {
    const unsigned* CNT = (const unsigned*)(P.ws + WS_CTL) + CW_CNT + 1024 * l;
    int off[16]; { int acc = 0;
#pragma unroll
        for (int e = 0; e < 16; ++e) { off[e] = acc; acc += (((int)CNT[e * 64] + 255) >> 8) << 8; } }
    const int gw = X.bid * NWAVES + X.wave;
    if (gw < NLAT / 8) { ln2_rows<4>(X, P, l, 8 * gw, off); ln2_rows<4>(X, P, l, 8 * gw + 4, off); }
    if (l == 0 && gw < NCTX) ln2_rows<1>(X, P, l, NLAT + gw, off);
}

struct KeysNA { int b, r, c, rs, cs, h; const float* rpb;
    DI int n() const { return 128 + CTXL; }
    DI void get(int k, int& krow, float& bias) const { if (k < 128) { const int kr = rs + (k >> 4), kc = cs + (k & 15); krow = b * SEQ + kr * 64 + kc; bias = LOG2E * rpb[h * 465 + (kr - r + 7) * 31 + (kc - c + 15)]; } else { krow = NLAT + b * CTXL + (k - 128); bias = 0.f; } } };
struct KeysSWA { int b, lo, nband;
    DI int n() const { return nband + CTXL; }
    DI void get(int k, int& krow, float& bias) const { krow = k < nband ? b * SEQ + lo + k : NLAT + b * CTXL + (k - nband); bias = 0.f; } };
struct KeysCtx { int b;
    DI int n() const { return CTXL; }
    DI void get(int k, int& krow, float& bias) const { krow = NLAT + b * CTXL + k; bias = 0.f; } };
template <class Keys>
DI void attn_row_naive(const bf16_t* PB, int qrow, int qcol, int kcol, int vcol, const Keys& KS, bool has_sink, float sink, LAS float* sc, bf16_t* yout, int lane) {
    float q[64];
    { const u32x4* qp = (const u32x4*)(PB + (size_t)qrow * PBW + qcol);
#pragma unroll
      for (int i = 0; i < 8; ++i) { const u32x4 w = qp[i]; q[8 * i] = bflo(w.x); q[8 * i + 1] = bfhi(w.x); q[8 * i + 2] = bflo(w.y); q[8 * i + 3] = bfhi(w.y); q[8 * i + 4] = bflo(w.z); q[8 * i + 5] = bfhi(w.z); q[8 * i + 6] = bflo(w.w); q[8 * i + 7] = bfhi(w.w); } }
    const int nk = KS.n(); float mx = has_sink ? sink : -3e38f;
    for (int k = lane; k < nk; k += 64) { int krow; float bias; KS.get(k, krow, bias);
        const u32x4* kp = (const u32x4*)(PB + (size_t)krow * PBW + kcol); float s = 0.f;
#pragma unroll
        for (int i = 0; i < 8; ++i) { const u32x4 w = kp[i]; s += q[8 * i] * bflo(w.x) + q[8 * i + 1] * bfhi(w.x) + q[8 * i + 2] * bflo(w.y) + q[8 * i + 3] * bfhi(w.y) + q[8 * i + 4] * bflo(w.z) + q[8 * i + 5] * bfhi(w.z) + q[8 * i + 6] * bflo(w.w) + q[8 * i + 7] * bfhi(w.w); }
        s += bias; sc[k] = s; mx = fmaxf(mx, s); }
    mx = wave_max(mx); float den = 0.f;
    for (int k = lane; k < nk; k += 64) { const float p = exp2f(sc[k] - mx); sc[k] = p; den += p; }
    den = wave_sum(den); if (has_sink) den += exp2f(sink - mx);
    asm volatile("s_waitcnt lgkmcnt(0)" ::: "memory");
    float o = 0.f;
    for (int k = 0; k < nk; ++k) { int krow; float bias; KS.get(k, krow, bias); o += sc[k] * bf2f(PB[(size_t)krow * PBW + vcol + lane]); }
    yout[lane] = (bf16_t)f2bf(o / den);
    asm volatile("s_waitcnt lgkmcnt(0)" ::: "memory");
}
DI void ph_attn_naive(const Ctx& X, const Params& P, int l) {
    const bf16_t* PB = (const bf16_t*)(P.ws + WS_PB); bf16_t* Y = (bf16_t*)(P.ws + WS_Y);
    LAS float* sc = (LAS float*)X.lds + X.wave * 640;
    const float* rpb = P.in[9] + l * 4 * 465; const float* sink = P.in[10] + l * 8;
    const int nrows = l == 0 ? NROWS : NLAT;
    const int gw = X.bid * NWAVES + X.wave, NGW = X.nb * NWAVES;
    for (int it = gw; it < nrows * 12; it += NGW) {
        const int row = it / 12, hh = it % 12;
        if (row < NLAT) { const int b = row >> 13, t = row & (SEQ - 1);
            if (hh < 4) { KeysNA K; K.b = b; K.r = t >> 6; K.c = t & 63; K.rs = min(max(K.r - 4, 0), 120); K.cs = min(max(K.c - 8, 0), 48); K.h = hh; K.rpb = rpb;
                attn_row_naive(PB, row, PB_NQ + hh * 64, PB_NK + hh * 64, PB_NV + hh * 64, K, false, 0.f, sc, Y + (size_t)row * D + 256 + hh * 64, X.lane);
            } else { const int qh = hh - 4, n = qh >> 2; KeysSWA K; K.b = b; K.lo = max(t - 128, 0); K.nband = min(t + 128, SEQ - 1) - K.lo + 1;
                attn_row_naive(PB, row, PB_SQ + qh * 64, PB_SK + n * 64, PB_SV + n * 64, K, true, LOG2E * sink[qh], sc, Y + (size_t)row * D + 512 + qh * 64, X.lane); }
        } else { const int b = (row - NLAT) >> 8; KeysCtx K; K.b = b;
            if (hh < 4) attn_row_naive(PB, row, PB_NQ + hh * 64, PB_NK + hh * 64, PB_NV + hh * 64, K, false, 0.f, sc, Y + (size_t)row * D + 256 + hh * 64, X.lane);
            else { const int qh = hh - 4, n = qh >> 2; attn_row_naive(PB, row, PB_SQ + qh * 64, PB_SK + n * 64, PB_SV + n * 64, K, true, LOG2E * sink[qh], sc, Y + (size_t)row * D + 512 + qh * 64, X.lane); }
        }
    }
}
DI void ph_hgrn_naive(const Ctx& X, const Params& P, int l) {
    const bf16_t* PB = (const bf16_t*)(P.ws + WS_PB); const float* Z = (const float*)(P.ws + WS_Z); float* O32 = (float*)(P.ws + WS_S);
    const float* LB = (const float*)(P.ws + WS_LB) + l * 512;
    const int gw = X.bid * NWAVES + X.wave;
    if (gw >= 16) return;
    const int b = gw >> 3, h = (gw >> 1) & 3, dir = gw & 1, lane = X.lane;
    const float lb = LB[dir * 256 + h * 64 + lane];
    float S[64];
#pragma unroll
    for (int d = 0; d < 64; ++d) S[d] = 0.f;
    for (int step = 0; step < CTXL + SEQ; ++step) {
        int row;
        if (step < CTXL) row = NLAT + b * CTXL + (dir ? CTXL - 1 - step : step); else { const int t = step - CTXL; row = b * SEQ + (dir ? SEQ - 1 - t : t); }
        float f = exp2f(bf2f(((const bf16_t*)Z)[(size_t)row * ZW + dir * 256 + h * 64 + lane])); const float kk = bf2f(((const bf16_t*)(P.ws + WS_KK))[(size_t)row * ZW + dir * 256 + h * 64 + lane]); (void)lb;
#if DBG_HG_MODE & 8
        f = 1.0f;
#endif
        const float qv = bf2f(PB[(size_t)row * PBW + PB_AQ + h * 64 + lane]), vv = bf2f(PB[(size_t)row * PBW + PB_AI + h * 64 + lane]);
#if DBG_HG_MODE & 1
        if ((step & 63) == 0) {
#pragma unroll
            for (int d = 0; d < 64; ++d) S[d] = 0.f; }
#endif
        float o = 0.f;
#pragma unroll
        for (int d = 0; d < 64; ++d) { const float fd = __builtin_bit_cast(float, __builtin_amdgcn_readlane(__builtin_bit_cast(int, f), d)), kd = __builtin_bit_cast(float, __builtin_amdgcn_readlane(__builtin_bit_cast(int, kk), d)), qd = __builtin_bit_cast(float, __builtin_amdgcn_readlane(__builtin_bit_cast(int, qv), d));
            S[d] = fd * S[d] + kd * vv; o += S[d] * qd; }
#if DBG_HG_MODE & 2
        if (dir == 1) o = 0.f;
#endif
#if DBG_HG_MODE & 4
        if (dir == 0) o = 0.f;
#endif
        O32[((size_t)dir * NROWS + row) * 256 + h * 64 + lane] = o;
    }
}
DI void ph_hgrn_combine_naive(const Ctx& X, const Params& P, int l) {
    const bf16_t* PB = (const bf16_t*)(P.ws + WS_PB); const float* O32 = (const float*)(P.ws + WS_S); bf16_t* Y = (bf16_t*)(P.ws + WS_Y);
    const float* nw = P.in[8] + l * 64;
    const int nrows = l == 0 ? NROWS : NLAT;
    const int gw = X.bid * NWAVES + X.wave, NGW = X.nb * NWAVES;
    for (int it = gw; it < nrows * 4; it += NGW) { const int row = it >> 2, h = it & 3;
        const float o = O32[(size_t)row * 256 + h * 64 + X.lane] + O32[((size_t)NROWS + row) * 256 + h * 64 + X.lane];
        const float ms = wave_sum(o * o) * (1.0f / 64.0f); const float y = o * (1.0f / sqrtf(ms + RMS_EPS)) * nw[X.lane];
        const float gte = bf2f(PB[(size_t)row * PBW + PB_AG + h * 64 + X.lane]);
        Y[(size_t)row * D + h * 64 + X.lane] = (bf16_t)f2bf(y * siluf_(gte)); }
}

typedef short v4i16_t __attribute__((ext_vector_type(4)));
DI s16x4 tr_read(const LAS unsigned char* p) { return __builtin_bit_cast(s16x4, __builtin_amdgcn_ds_read_tr16_b64_v4i16((LAS v4i16_t*)p)); }
DI bf16x8 cat8(s16x4 a, s16x4 b) { return __builtin_shufflevector(a, b, 0, 1, 2, 3, 4, 5, 6, 7); }
DI bf16x8 pack8(float a0, float a1, float a2, float a3, float a4, float a5, float a6, float a7) {
    u32x4 w; w.x = pk2(a0, a1); w.y = pk2(a2, a3); w.z = pk2(a4, a5); w.w = pk2(a6, a7); return __builtin_bit_cast(bf16x8, w); }
DI float shfl_f(float v, int src) { return __shfl(v, src); }

constexpr int HP = 144;
constexpr size_t WS_QT = WS_H, WS_KT = WS_H + (size_t)2 * NROWS * 256 * 2;
#ifdef DBG_MIX
constexpr size_t WS_ST = 318 * MiB;
#else
constexpr size_t WS_ST = WS_Z;
#endif
static_assert(WS_KT + (size_t)2 * NROWS * 256 * 2 <= WS_Y && (size_t)2112 * 4096 * 2 <= (size_t)NROWS * ZW * 4, "hgrn buffers");
DI void hgrn_chunk_rows(int b, int dir, int p, int& row0) {
    if (p < 4) row0 = NLAT + b * CTXL + 64 * (dir ? 3 - p : p); else row0 = b * SEQ + 64 * (dir ? 131 - p : p - 4);
}
DI void hgrn_local_item(const Ctx& X, const Params& P, int l, int it) {
    const bf16_t* PB = (const bf16_t*)(P.ws + WS_PB); const bf16_t* Z = (const bf16_t*)(P.ws + WS_Z);
    bf16_t* QT = (bf16_t*)(P.ws + WS_QT); bf16_t* KT = (bf16_t*)(P.ws + WS_KT); float* U = (float*)(P.ws + WS_S); float* DD = (float*)(P.ws + WS_DD); float* ER = DD + 2112 * 64;
    const float* LB = (const float*)(P.ws + WS_LB) + l * 512;
    LAS unsigned char* kt_l = X.lds + X.wave * (2 * 64 * HP); LAS unsigned char* v_l = kt_l + 64 * HP;
    const int lane = X.lane;
    if (it < 2112) {
        const int p = it % NCHAIN, chain = it / NCHAIN, dir = chain & 1, h = (chain >> 1) & 3, b = chain >> 3;
        int row0; hgrn_chunk_rows(b, dir, p, row0);
#pragma unroll
        for (int i = 0; i < 8; ++i) { const int r = i * 8 + (lane >> 3), pc = lane & 7; const u32x4 w = *(const u32x4*)(PB + (size_t)(row0 + r) * PBW + PB_AI + h * 64 + pc * 8); *(LAS u32x4*)(v_l + r * HP + pc * 16) = w; }
        float lf[64];
        const bf16_t* zp = Z + (size_t)row0 * ZW + dir * 256 + h * 64 + lane;
#pragma unroll
        for (int s = 0; s < 64; ++s) lf[s] = bf2f(zp[(size_t)s * ZW]);
        float ref, last;
        if (dir == 0) {
#pragma unroll
            for (int s = 1; s < 64; ++s) lf[s] += lf[s - 1];
            ref = lf[31]; last = lf[63];
        } else {
#pragma unroll
            for (int s = 62; s >= 0; --s) lf[s] += lf[s + 1];
            ref = lf[32]; last = lf[0];
        }
        const bf16_t* qp = PB + (size_t)row0 * PBW + PB_AQ + h * 64 + lane; const bf16_t* kp = (const bf16_t*)(P.ws + WS_KK) + (size_t)row0 * ZW + dir * 256 + h * 64 + lane;
        bf16_t* qto = QT + ((size_t)dir * NROWS + row0) * 256 + h * 64 + lane; bf16_t* kto = KT + ((size_t)dir * NROWS + row0) * 256 + h * 64 + lane;
#pragma unroll
        for (int hf = 0; hf < 2; ++hf) {
            unsigned short qv[32], kv[32];
#pragma unroll
            for (int s = 0; s < 32; ++s) { qv[s] = qp[(size_t)(32 * hf + s) * PBW]; kv[s] = kp[(size_t)(32 * hf + s) * ZW]; }
#pragma unroll
            for (int s2 = 0; s2 < 32; ++s2) { const int s = 32 * hf + s2;
                const float q = bf2f(qv[s2]), kk = bf2f(kv[s2]);
                const float eq = __builtin_amdgcn_exp2f(lf[s] - ref), ek = __builtin_amdgcn_exp2f(ref - lf[s]);
                const unsigned short qb = (unsigned short)f2bf(q * eq), kb = (unsigned short)f2bf(kk * ek);
                qto[(size_t)s * 256] = qb; kto[(size_t)s * 256] = kb;
                *(LAS unsigned short*)(kt_l + s * HP + lane * 2) = kb; }
            asm volatile("" ::: "memory");
        }
        asm volatile("" ::: "memory");
        const float e_lr = __builtin_amdgcn_exp2f(last - ref);
        DD[it * 64 + lane] = __builtin_amdgcn_exp2f(last); ER[it * 64 + lane] = __builtin_amdgcn_exp2f(ref);
        f32x4 acc[4][4];
#pragma unroll
        for (int m = 0; m < 4; ++m)
#pragma unroll
            for (int n = 0; n < 4; ++n) acc[m][n] = (f32x4){0.f, 0.f, 0.f, 0.f};
        const int g = lane >> 4, i16 = lane & 15;
        const int troff = (8 * g + (i16 >> 2)) * HP + (i16 & 3) * 8;
#pragma unroll
        for (int ks = 0; ks < 2; ++ks) {
            bf16x8 af[4], bfv[4];
#pragma unroll
            for (int m = 0; m < 4; ++m) af[m] = cat8(tr_read(kt_l + troff + ks * 32 * HP + m * 32), tr_read(kt_l + troff + (ks * 32 + 4) * HP + m * 32));
#pragma unroll
            for (int n = 0; n < 4; ++n) bfv[n] = cat8(tr_read(v_l + troff + ks * 32 * HP + n * 32), tr_read(v_l + troff + (ks * 32 + 4) * HP + n * 32));
#pragma unroll
            for (int m = 0; m < 4; ++m)
#pragma unroll
                for (int n = 0; n < 4; ++n) acc[m][n] = __builtin_amdgcn_mfma_f32_16x16x32_bf16(af[m], bfv[n], acc[m][n], 0, 0, 0);
        }
        float* up = U + (size_t)it * 4096;
#pragma unroll
        for (int m = 0; m < 4; ++m)
#pragma unroll
            for (int r = 0; r < 4; ++r) { const int d = 16 * m + 4 * g + r; const float sc = shfl_f(e_lr, d);
#pragma unroll
                for (int n = 0; n < 4; ++n) up[d * 64 + 16 * n + i16] = acc[m][n][r] * sc; }
        asm volatile("s_waitcnt lgkmcnt(0)" ::: "memory");
    }
}
DI void ph_hgrn_scan(const Ctx& X, const Params& P, int part) {
    const float* U = (const float*)(P.ws + WS_S); const float* DD = (const float*)(P.ws + WS_DD); const float* ER = DD + 2112 * 64; bf16_t* ST = (bf16_t*)(P.ws + WS_ST);
    const int gt = part * NTHREADS + X.tid;
    const int chain = gt >> 11, d = (gt >> 5) & 63, e2 = (gt & 31) * 2;
    float s0 = 0.f, s1 = 0.f;
    for (int p0 = 0; p0 < NCHAIN; p0 += 4) {
        f32x2 u[4]; float dd[4], er[4];
#pragma unroll
        for (int j = 0; j < 4; ++j) { const int slot = chain * NCHAIN + p0 + j; u[j] = *(const f32x2*)(U + (size_t)slot * 4096 + d * 64 + e2); dd[j] = DD[slot * 64 + d]; er[j] = ER[slot * 64 + d]; }
#pragma unroll
        for (int j = 0; j < 4; ++j) { const int slot = chain * NCHAIN + p0 + j; *(unsigned*)(ST + (size_t)slot * 4096 + d * 64 + e2) = pk2(s0 * er[j], s1 * er[j]); s0 = dd[j] * s0 + u[j][0]; s1 = dd[j] * s1 + u[j][1]; }
    }
}
DI void hgrn_out_item(const Ctx& X, const Params& P, int l, int it) {
    const bf16_t* PB = (const bf16_t*)(P.ws + WS_PB); const bf16_t* QT = (const bf16_t*)(P.ws + WS_QT); const bf16_t* KT = (const bf16_t*)(P.ws + WS_KT); const bf16_t* ST = (const bf16_t*)(P.ws + WS_ST);
    unsigned char* Y = P.ws + WS_Y;        const float* nw = P.in[8] + l * 64;
    LAS unsigned char* s_l = X.lds + X.wave * (2 * 64 * HP); LAS unsigned char* v_l = s_l + 64 * HP;
    const int lane = X.lane, g = lane >> 4, i16 = lane & 15, gw = X.wave * X.nb + X.bid, NGW = X.nb * NWAVES;
    const int nchunk = l == 0 ? 132 : 128;
    const int troff = (8 * g + (i16 >> 2)) * HP + (i16 & 3) * 8;
    const int troff4 = (4 * g + (i16 >> 2)) * HP + (i16 & 3) * 8;
    (void)gw; (void)NGW;
    if (it < 8 * nchunk) {
        const int c = it % nchunk, bh = it / nchunk, h = bh & 3, b = bh >> 2;
        const bool isctx = c >= 128; const int row0 = isctx ? NLAT + b * CTXL + 64 * (c - 128) : b * SEQ + 64 * c;
#pragma unroll
        for (int i = 0; i < 8; ++i) { const int r = i * 8 + (lane >> 3), pc = lane & 7; const u32x4 w = *(const u32x4*)(PB + (size_t)(row0 + r) * PBW + PB_AI + h * 64 + pc * 8); *(LAS u32x4*)(v_l + r * HP + pc * 16) = w; }
        f32x4 o[4][4];
#pragma unroll
        for (int a = 0; a < 4; ++a)
#pragma unroll
            for (int t = 0; t < 4; ++t) o[a][t] = (f32x4){0.f, 0.f, 0.f, 0.f};
#pragma unroll 1
        for (int dir = 0; dir < 2; ++dir) {
#if DBG_HG_MODE & 2
            if (dir == 1) continue;
#endif
#if DBG_HG_MODE & 4
            if (dir == 0) continue;
#endif
            const int p = isctx ? (dir ? 3 - (c - 128) : c - 128) : (dir ? 127 - c + 4 : c + 4);
            const int slot = ((b * 4 + h) * 2 + dir) * NCHAIN + p, sgn = 1 - 2 * dir;
            asm volatile("s_waitcnt lgkmcnt(0)" ::: "memory");
#pragma unroll
            for (int i = 0; i < 8; ++i) { const int r = i * 8 + (lane >> 3), pc = lane & 7; const u32x4 w = *(const u32x4*)(ST + (size_t)slot * 4096 + r * 64 + pc * 8); *(LAS u32x4*)(s_l + r * HP + pc * 16) = w; }
            const bf16_t* qt = QT + ((size_t)dir * NROWS + row0) * 256 + h * 64 + g * 8; const bf16_t* kt = KT + ((size_t)dir * NROWS + row0) * 256 + h * 64 + g * 8;
            bf16x8 qf[4][2];
#pragma unroll
            for (int t = 0; t < 4; ++t)
#pragma unroll
                for (int ks = 0; ks < 2; ++ks) qf[t][ks] = *(const bf16x8*)(qt + (size_t)(16 * t + i16) * 256 + 32 * ks);
#pragma unroll
            for (int pr = 0; pr < 2; ++pr) {
                bf16x8 kf[2][2];
#pragma unroll
                for (int t = 0; t < 2; ++t)
#pragma unroll
                    for (int ks = 0; ks < 2; ++ks) kf[t][ks] = *(const bf16x8*)(kt + (size_t)(16 * (2 * pr + t) + i16) * 256 + 32 * ks);
                f32x4 sc[2][4];
#pragma unroll
                for (int s2 = 0; s2 < 2; ++s2)
#pragma unroll
                    for (int tt = 0; tt < 4; ++tt) { f32x4 a = {0.f, 0.f, 0.f, 0.f};
                        a = __builtin_amdgcn_mfma_f32_16x16x32_bf16(kf[s2][0], qf[tt][0], a, 0, 0, 0); a = __builtin_amdgcn_mfma_f32_16x16x32_bf16(kf[s2][1], qf[tt][1], a, 0, 0, 0);
#pragma unroll
                        for (int r = 0; r < 4; ++r) { const int sidx = 16 * (2 * pr + s2) + 4 * g + r, tidx = 16 * tt + i16; const int keep = ~(((tidx - sidx) * sgn) >> 31); { const float av = a[r]; a[r] = __int_as_float(__float_as_int(av) & keep); } }
                        sc[s2][tt] = a; }
                bf16x8 vf[4];
#pragma unroll
#ifdef DBG_NO_TR
                for (int et = 0; et < 4; ++et) { unsigned short tv[8];
#pragma unroll
                    for (int j = 0; j < 8; ++j) { const int sidx = 32 * pr + (j < 4 ? 4 * g + j : 16 + 4 * g + (j - 4)); tv[j] = *(const LAS unsigned short*)(v_l + sidx * HP + (16 * et + i16) * 2); }
                    u32x4 w; w.x = tv[0] | ((unsigned)tv[1] << 16); w.y = tv[2] | ((unsigned)tv[3] << 16); w.z = tv[4] | ((unsigned)tv[5] << 16); w.w = tv[6] | ((unsigned)tv[7] << 16); vf[et] = __builtin_bit_cast(bf16x8, w); }
#else
                for (int et = 0; et < 4; ++et) vf[et] = cat8(tr_read(v_l + troff4 + (32 * pr) * HP + et * 32), tr_read(v_l + troff4 + (32 * pr + 16) * HP + et * 32));
#endif
#ifdef DBG_BRUTE
                {   float* dacc = (float*)(P.ws + WS_CTL) + CW_DBG + 16; float nA = 0.f, dA = 0.f, nB = 0.f, dB = 0.f;
                    const bf16_t* qt0 = QT + ((size_t)dir * NROWS + row0) * 256 + h * 64; const bf16_t* kt0 = KT + ((size_t)dir * NROWS + row0) * 256 + h * 64;
#if DBG_TEST == 1
#pragma unroll
                    for (int s2 = 0; s2 < 2; ++s2)
#pragma unroll
                        for (int tt = 0; tt < 4; ++tt)
#pragma unroll
                            for (int r = 0; r < 4; ++r) *(LAS float*)(s_l + (((s2 * 4 + tt) * 4 + r) * 64 + lane) * 4) = sc[s2][tt][r];
                    asm volatile("s_waitcnt lgkmcnt(0)" ::: "memory");
#pragma unroll 1
                    for (int idx = 0; idx < 32; ++idx) { const int s2 = idx >> 4, tt = (idx >> 2) & 3, r = idx & 3; const int sidx = 16 * (2 * pr + s2) + 4 * g + r, tidx = 16 * tt + i16; float ref = 0.f;
#pragma unroll 1
                        for (int d = 0; d < 64; ++d) ref += bf2f(kt0[(size_t)sidx * 256 + d]) * bf2f(qt0[(size_t)tidx * 256 + d]);
                        if (sidx > tidx) ref = 0.f; const float got = *(LAS float*)(s_l + (idx * 64 + lane) * 4); const float df = got - ref; nA += df * df; dA += ref * ref; }
#endif
#if DBG_TEST == 2
#pragma unroll
                    for (int et = 0; et < 4; ++et)
#pragma unroll
                        for (int j = 0; j < 8; ++j) { const int sidx = 32 * pr + (j < 4 ? 4 * g + j : 16 + 4 * g + (j - 4)); const float ref = bf2f(PB[(size_t)(row0 + sidx) * PBW + PB_AI + h * 64 + 16 * et + i16]);
                            const float got = bf2f((unsigned short)vf[et][j]); const float df = got - ref; nB += df * df; dB += ref * ref; asm volatile("" : "+v"(nB), "+v"(dB) :: "memory"); }
#endif
                    nA = wave_sum(nA); dA = wave_sum(dA); nB = wave_sum(nB); dB = wave_sum(dB); if (lane == 0) { atomicAdd(dacc, nA); atomicAdd(dacc + 1, dA); atomicAdd(dacc + 2, nB); atomicAdd(dacc + 3, dB); }
                }
#endif
#pragma unroll
                for (int tt = 0; tt < 4; ++tt) { const f32x4 p0 = sc[0][tt], p1 = sc[1][tt]; const bf16x8 pf = pack8(p0[0], p0[1], p0[2], p0[3], p1[0], p1[1], p1[2], p1[3]);
#pragma unroll
                    for (int et = 0; et < 4; ++et) o[et][tt] = __builtin_amdgcn_mfma_f32_16x16x32_bf16(vf[et], pf, o[et][tt], 0, 0, 0); }
                asm volatile("" ::: "memory");
            }
#pragma unroll
            for (int ks = 0; ks < ((DBG_HG_MODE & 1) ? 0 : 2); ++ks) {
                bf16x8 sf[4];
#pragma unroll
                for (int et = 0; et < 4; ++et) sf[et] = cat8(tr_read(s_l + troff + (32 * ks) * HP + et * 32), tr_read(s_l + troff + (32 * ks + 4) * HP + et * 32));
#pragma unroll
                for (int tt = 0; tt < 4; ++tt)
#pragma unroll
                    for (int et = 0; et < 4; ++et) o[et][tt] = __builtin_amdgcn_mfma_f32_16x16x32_bf16(sf[et], qf[tt][ks], o[et][tt], 0, 0, 0);
            }
        }
#if defined(DBG_BRUTE) && DBG_TEST == 3
        {
            float* dacc = (float*)(P.ws + WS_CTL) + CW_DBG + 8; float num = 0.f, den = 0.f;
            const bf16_t* qt0 = QT + ((size_t)0 * NROWS + row0) * 256 + h * 64; const bf16_t* kt0 = KT + ((size_t)0 * NROWS + row0) * 256 + h * 64;
            for (int tt = 0; tt < 4; ++tt) for (int et = 0; et < 4; ++et) for (int r = 0; r < 4; ++r) {
                const int t = 16 * tt + i16, e = 16 * et + 4 * g + r; float ref = 0.f;
                for (int s2 = 0; s2 <= t; ++s2) { float sc = 0.f; for (int d = 0; d < 64; ++d) sc += bf2f(kt0[(size_t)s2 * 256 + d]) * bf2f(qt0[(size_t)t * 256 + d]);
                    ref += bf2f((unsigned short)f2bf(sc)) * bf2f(PB[(size_t)(row0 + s2) * PBW + PB_AI + h * 64 + e]); }
                float got = 0.f;
#pragma unroll
                for (int a = 0; a < 4; ++a)
#pragma unroll
                    for (int b2 = 0; b2 < 4; ++b2)
#pragma unroll
                        for (int c2 = 0; c2 < 4; ++c2) if (a == tt && b2 == et && c2 == r) got = o[b2][a][c2];
                num += (got - ref) * (got - ref); den += ref * ref; }
            num = wave_sum(num); den = wave_sum(den); if (lane == 0) { atomicAdd(dacc, num); atomicAdd(dacc + 1, den); }
        }
#endif
#pragma unroll
        for (int tt = 0; tt < 4; ++tt) {
            float ss = 0.f;
#pragma unroll
            for (int et = 0; et < 4; ++et) ss += (o[et][tt][0] * o[et][tt][0] + o[et][tt][1] * o[et][tt][1]) + (o[et][tt][2] * o[et][tt][2] + o[et][tt][3] * o[et][tt][3]);
            ss += __shfl_xor(ss, 16); ss += __shfl_xor(ss, 32);
            const float rstd = 1.0f / sqrtf(ss * (1.0f / 64.0f) + RMS_EPS);
            const size_t row = (size_t)row0 + 16 * tt + i16;
#pragma unroll
            for (int et = 0; et < 4; ++et) { const int e = 16 * et + 4 * g; const u32x2 gw2 = *(const u32x2*)(PB + row * PBW + PB_AG + h * 64 + e); const f32x4 wv = *(const f32x4*)(nw + e);
                const f32x4 gt = {bflo(gw2.x), bfhi(gw2.x), bflo(gw2.y), bfhi(gw2.y)}; f32x4 y;
#pragma unroll
                for (int r = 0; r < 4; ++r) y[r] = o[et][tt][r] * rstd * wv[r] * siluf_(gt[r]);
                *(unsigned*)(Y + row * D + h * 64 + e) = pk_fp8x4(y); }
        }
        asm volatile("s_waitcnt lgkmcnt(0)" ::: "memory");
    }
}


DI void ph_hgrn_out(const Ctx& X, const Params& P, int l) { const int n = 8 * (l == 0 ? 132 : 128); for (int it = X.wave * X.nb + X.bid; it < n; it += X.nb * NWAVES) hgrn_out_item(X, P, l, it); }

#ifdef DBG_BRUTE
DI void ph_dbg_scores(const Ctx& X, const Params& P, int l) {
    const bf16_t* QT = (const bf16_t*)(P.ws + WS_QT); const bf16_t* KT = (const bf16_t*)(P.ws + WS_KT);
    LAS unsigned char* s_l = X.lds + X.wave * (2 * 64 * HP);
    const int lane = X.lane, g = lane >> 4, i16 = lane & 15, gw = X.wave * X.nb + X.bid, NGW = X.nb * NWAVES;
    float* dacc = (float*)(P.ws + WS_CTL) + CW_DBG + 16; float nA = 0.f, dA = 0.f;
    for (int it = gw; it < 8 * 128; it += NGW) {
        const int c = it % 128, bh = it / 128, h = bh & 3, b = bh >> 2, dir = 0, sgn = 1; const int row0 = b * SEQ + 64 * c;
        const bf16_t* qt = QT + ((size_t)dir * NROWS + row0) * 256 + h * 64 + g * 8; const bf16_t* kt = KT + ((size_t)dir * NROWS + row0) * 256 + h * 64 + g * 8;
        const bf16_t* qt0 = QT + ((size_t)dir * NROWS + row0) * 256 + h * 64; const bf16_t* kt0 = KT + ((size_t)dir * NROWS + row0) * 256 + h * 64;
        bf16x8 qf[4][2];
#pragma unroll
        for (int t = 0; t < 4; ++t)
#pragma unroll
            for (int ks = 0; ks < 2; ++ks) qf[t][ks] = *(const bf16x8*)(qt + (size_t)(16 * t + i16) * 256 + 32 * ks);
#pragma unroll 1
        for (int pr = 0; pr < 2; ++pr) {
            bf16x8 kf[2][2];
#pragma unroll
            for (int t = 0; t < 2; ++t)
#pragma unroll
                for (int ks = 0; ks < 2; ++ks) kf[t][ks] = *(const bf16x8*)(kt + (size_t)(16 * (2 * pr + t) + i16) * 256 + 32 * ks);
#pragma unroll
            for (int s2 = 0; s2 < 2; ++s2)
#pragma unroll
                for (int tt = 0; tt < 4; ++tt) { f32x4 a = {0.f, 0.f, 0.f, 0.f};
                    a = __builtin_amdgcn_mfma_f32_16x16x32_bf16(kf[s2][0], qf[tt][0], a, 0, 0, 0); a = __builtin_amdgcn_mfma_f32_16x16x32_bf16(kf[s2][1], qf[tt][1], a, 0, 0, 0);
#pragma unroll
                    for (int r = 0; r < 4; ++r) { const int sidx = 16 * (2 * pr + s2) + 4 * g + r, tidx = 16 * tt + i16; const int keep = ~(((tidx - sidx) * sgn) >> 31); { const float av = a[r]; a[r] = __int_as_float(__float_as_int(av) & keep); }
                        *(LAS float*)(s_l + (((s2 * 4 + tt) * 4 + r) * 64 + lane) * 4) = a[r]; } }
            asm volatile("s_waitcnt lgkmcnt(0)" ::: "memory");
#pragma unroll 1
            for (int idx = 0; idx < 32; ++idx) { const int s2 = idx >> 4, tt = (idx >> 2) & 3, r = idx & 3; const int sidx = 16 * (2 * pr + s2) + 4 * g + r, tidx = 16 * tt + i16; float ref = 0.f;
#pragma unroll 1
                for (int d = 0; d < 64; ++d) ref += bf2f(kt0[(size_t)sidx * 256 + d]) * bf2f(qt0[(size_t)tidx * 256 + d]);
                if (sidx > tidx) ref = 0.f; const float got = *(LAS float*)(s_l + (idx * 64 + lane) * 4); const float df = got - ref; nA += df * df; dA += ref * ref; }
            asm volatile("s_waitcnt lgkmcnt(0)" ::: "memory");
        }
    }
    nA = wave_sum(nA); dA = wave_sum(dA); if (lane == 0) { atomicAdd(dacc, nA); atomicAdd(dacc + 1, dA); }
}
#endif
constexpr int KP = 144, VP = 192, KBYTES = 128 * KP, VBYTES = 128 * VP, CHB = KBYTES + VBYTES, RPB_OFF = 2 * CHB;
static_assert(RPB_OFF + 4096 <= 144 * 1024, "attn lds");
struct ChunkSrc { int mode, rbase, kr0; };
DI int chunk_row(const ChunkSrc& c, int key) { return c.mode == 0 ? c.rbase + key : c.rbase + min(c.kr0 + (key >> 5), 127) * 64 + (key & 31); }
struct StageRegs { u32x4 k[2], v[2]; };
DI void stage_load(const Ctx& X, const bf16_t* PB, int kcol, int vcol, const ChunkSrc& c, StageRegs& R) {
#pragma unroll
    for (int i = 0; i < 2; ++i) { const int idx = X.tid + NTHREADS * i, key = idx >> 3, pc = idx & 7; const size_t row = (size_t)chunk_row(c, key);
        R.k[i] = *(const u32x4*)(PB + row * PBW + kcol + pc * 8); R.v[i] = *(const u32x4*)(PB + row * PBW + vcol + pc * 8); }
}
DI void stage_store(const Ctx& X, LAS unsigned char* buf, const StageRegs& R) {
#pragma unroll
    for (int i = 0; i < 2; ++i) { const int idx = X.tid + NTHREADS * i, key = idx >> 3, pc = idx & 7;
        *(LAS u32x4*)(buf + key * KP + pc * 16) = R.k[i]; *(LAS u32x4*)(buf + KBYTES + key * VP + pc * 16) = R.v[i]; }
}
template <int NQT> struct AttnState { f32x16 o[NQT][2]; float m[NQT], l[NQT]; };
template <int NQT, class MaskF>
DI void attn_tile_kv(const bf16x8 (&kf)[4], const LAS unsigned char* vt, int kt, const bf16x8 (&qf)[NQT][4], AttnState<NQT>& S, const bool (&act)[NQT], const MaskF& MF, int lane) {
    const int h = lane >> 5, G = lane >> 4, i16 = lane & 15;
    const LAS unsigned char* vb = vt + (4 * h + (i16 >> 2)) * VP + (16 * (G & 1) + 4 * (i16 & 3)) * 2;
    bf16x8 vf[2][2];
#pragma unroll
    for (int db = 0; db < 2; ++db)
#pragma unroll
        for (int s2 = 0; s2 < 2; ++s2) vf[db][s2] = cat8(tr_read(vb + (16 * s2) * VP + db * 64), tr_read(vb + (16 * s2 + 8) * VP + db * 64));
#pragma unroll
    for (int qt = 0; qt < NQT; ++qt) {
        if (!act[qt]) continue;
        f32x16 s;
#pragma unroll
        for (int r = 0; r < 16; ++r) s[r] = 0.f;
#pragma unroll
        for (int ks = 0; ks < 4; ++ks) s = __builtin_amdgcn_mfma_f32_32x32x16_bf16(kf[ks], qf[qt][ks], s, 0, 0, 0);
        MF(s, qt, kt);
        float mx = s[0];
#pragma unroll
        for (int r = 1; r < 16; ++r) mx = fmaxf(mx, s[r]);
        { const auto rr = __builtin_amdgcn_permlane32_swap(__float_as_uint(mx), __float_as_uint(mx), false, false); mx = fmaxf(__uint_as_float(rr[0]), __uint_as_float(rr[1])); }
        {
            const float mn = fmaxf(S.m[qt], mx), alpha = __builtin_amdgcn_exp2f(S.m[qt] - mn); S.m[qt] = mn; S.l[qt] *= alpha;
#pragma unroll
            for (int db = 0; db < 2; ++db)
#pragma unroll
                for (int r = 0; r < 16; ++r) S.o[qt][db][r] *= alpha;
        }
        const float mcur = S.m[qt]; float ps = 0.f;
#pragma unroll
        for (int r = 0; r < 16; ++r) { s[r] = __builtin_amdgcn_exp2f(s[r] - mcur); ps += s[r]; }
        S.l[qt] += ps;
        const bf16x8 p0 = pack8(s[0], s[1], s[2], s[3], s[4], s[5], s[6], s[7]), p1 = pack8(s[8], s[9], s[10], s[11], s[12], s[13], s[14], s[15]);
#pragma unroll
        for (int db = 0; db < 2; ++db) { S.o[qt][db] = __builtin_amdgcn_mfma_f32_32x32x16_bf16(vf[db][0], p0, S.o[qt][db], 0, 0, 0); S.o[qt][db] = __builtin_amdgcn_mfma_f32_32x32x16_bf16(vf[db][1], p1, S.o[qt][db], 0, 0, 0); }
    }
}
template <int NQT, class MaskF>
DI void attn_tile(const LAS unsigned char* buf, int kt, const bf16x8 (&qf)[NQT][4], AttnState<NQT>& S, const bool (&act)[NQT], const MaskF& MF, int lane) {
    bf16x8 kf[4];
#pragma unroll
    for (int ks = 0; ks < 4; ++ks) kf[ks] = *(const LAS bf16x8*)(buf + (32 * kt + (lane & 31)) * KP + ks * 32 + (lane >> 5) * 16);
    attn_tile_kv<NQT, MaskF>(kf, buf + KBYTES + 32 * kt * VP, kt, qf, S, act, MF, lane);
}
template <int NQT>
DI void attn_finish(AttnState<NQT>& S, int qt, unsigned char* yrow  , int lane) {
    const int h = lane >> 5; float l = S.l[qt]; { const auto rr = __builtin_amdgcn_permlane32_swap(__float_as_uint(l), __float_as_uint(l), false, false); l = __uint_as_float(rr[0]) + __uint_as_float(rr[1]); } const float inv = 1.0f / l;
#pragma unroll
    for (int db = 0; db < 2; ++db)
#pragma unroll
        for (int gq = 0; gq < 4; ++gq) *(unsigned*)(yrow + 32 * db + 8 * gq + 4 * h) = pk_fp8x4((f32x4){S.o[qt][db][4 * gq] * inv, S.o[qt][db][4 * gq + 1] * inv, S.o[qt][db][4 * gq + 2] * inv, S.o[qt][db][4 * gq + 3] * inv});
}
struct MaskNone { DI void operator()(f32x16&, int, int) const {} };
struct MaskSWA { int cmode, u0, lane;
    DI void operator()(f32x16& s, int qt, int kt) const {
        if (cmode == 1) return;
        const int u = u0 + 32 * qt + (lane & 31), kb = 32 * kt + 4 * (lane >> 5);
#pragma unroll
        for (int r = 0; r < 16; ++r) { const int k = kb + (r & 3) + 8 * (r >> 2); const bool ok = cmode == 0 ? k >= u : k <= u; s[r] = ok ? s[r] : -1e30f; }
    } };
DI void swa_item(const Ctx& X, const Params& P, int l, int it) {
    const bf16_t* PB = (const bf16_t*)(P.ws + WS_PB); unsigned char* Y = P.ws + WS_Y;        const float* sink = P.in[10] + l * 8;
    const int lane = X.lane, w = X.wave;
    {
        const int j = it & 63, n = (it >> 6) & 1, b = it >> 7;
        const int qh = n * 4 + (w >> 1), u0 = (w & 1) * 64;
        const int nchunks = 3 + (j > 0) + (j < 63);
        bf16x8 qf[2][4];
#pragma unroll
        for (int qt = 0; qt < 2; ++qt)
#pragma unroll
            for (int ks = 0; ks < 4; ++ks) qf[qt][ks] = *(const bf16x8*)(PB + (size_t)(b * SEQ + 128 * j + u0 + 32 * qt + (lane & 31)) * PBW + PB_SQ + qh * 64 + 16 * ks + 8 * (lane >> 5));
        AttnState<2> S;
#pragma unroll
        for (int qt = 0; qt < 2; ++qt) { S.m[qt] = LOG2E * sink[qh]; S.l[qt] = lane < 32 ? 1.0f : 0.0f;
#pragma unroll
            for (int db = 0; db < 2; ++db)
#pragma unroll
                for (int r = 0; r < 16; ++r) S.o[qt][db][r] = 0.f; }
        StageRegs R;
        auto chunk_id = [&](int i) -> int { return i < 2 ? 3 + i : (i == 2 ? 1 : (i == 3 ? (j > 0 ? 0 : 2) : 2)); };
        auto chunk_src = [&](int c) -> ChunkSrc { ChunkSrc cs; cs.mode = 0; cs.kr0 = 0; cs.rbase = c < 3 ? b * SEQ + 128 * (j - 1 + c) : NLAT + b * CTXL + 128 * (c - 3); return cs; };
        stage_load(X, PB, PB_SK + n * 64, PB_SV + n * 64, chunk_src(chunk_id(0)), R); stage_store(X, X.lds, R);
        __syncthreads();
        for (int i = 0; i < nchunks; ++i) {
            const int c = chunk_id(i);
            if (i + 1 < nchunks) stage_load(X, PB, PB_SK + n * 64, PB_SV + n * 64, chunk_src(chunk_id(i + 1)), R);
            const LAS unsigned char* buf = X.lds + (i & 1) * CHB;
            MaskSWA MF; MF.cmode = c == 0 ? 0 : (c == 2 ? 2 : 1); MF.u0 = u0; MF.lane = lane;
#pragma unroll 1
            for (int kt = 0; kt < 4; ++kt) {
                bool act[2];
#pragma unroll
                for (int qt = 0; qt < 2; ++qt) act[qt] = c == 0 ? (32 * kt + 31 >= u0 + 32 * qt) : (c == 2 ? (32 * kt <= u0 + 32 * qt + 31) : true);
                if (!(act[0] || act[1])) continue;
                attn_tile<2>(buf, kt, qf, S, act, MF, lane);
            }
            if (i + 1 < nchunks) stage_store(X, X.lds + ((i + 1) & 1) * CHB, R);
            __syncthreads();
        }
#pragma unroll
        for (int qt = 0; qt < 2; ++qt) attn_finish<2>(S, qt, Y + (size_t)(b * SEQ + 128 * j + u0 + 32 * qt + (lane & 31)) * D + 512 + qh * 64, lane);
    }
}
struct MaskNA { bool win; int kr0, qr, qc, rs, cs, blk, lane; const LAS float* rpb;
    DI void operator()(f32x16& s, int qt, int kt) const {
        if (!win) return;
        const int kr = kr0 + kt; const bool rowok = kr >= rs && kr < rs + 8;
        const int kcb = blk + 4 * (lane >> 5); const int ib = rowok ? (kr - qr + 7) * 31 + (kcb - qc + 15) : 0;
#pragma unroll
        for (int r = 0; r < 16; ++r) { const int off = (r & 3) + 8 * (r >> 2); const int kc = kcb + off; const bool ok = rowok && kc >= cs && kc < cs + 16;
            const float bias = rpb[ib + off]; s[r] = ok ? s[r] + bias : -1e30f; }
    } };
struct NaTileRegs { bf16x8 k[4]; u32x4 v[4]; };
DI void na_load(const bf16_t* PB, int h, int rowk  , int rowv  , int lane, NaTileRegs& R) {
    const bf16_t* kp = PB + (size_t)rowk * PBW + PB_NK + h * 64 + 8 * (lane >> 5);
#pragma unroll
    for (int ks = 0; ks < 4; ++ks) R.k[ks] = *(const bf16x8*)(kp + 16 * ks);
    const bf16_t* vp = PB + (size_t)rowv * PBW + PB_NV + h * 64 + (lane & 1) * 32;
#pragma unroll
    for (int i = 0; i < 4; ++i) R.v[i] = *(const u32x4*)(vp + 8 * i);
}
DI void na_item(const Ctx& X, const Params& P, int l, int it) {
    const bf16_t* PB = (const bf16_t*)(P.ws + WS_PB); unsigned char* Y = P.ws + WS_Y;        const float* rpbg = P.in[9] + l * 4 * 465;
    const int lane = X.lane, w = X.wave; LAS float* rpbl = (LAS float*)(X.lds + 8 * 32 * VP) + 32;
    LAS unsigned char* vt = X.lds + w * (32 * VP);
    const int j = it & 3, rg = (it >> 2) & 7, h = (it >> 5) & 3, b = it >> 7;
    const int r0 = 16 * rg, blk = min(max(16 * j - 8, 0), 32);
    const int ra = r0 + 2 * w, qr = ra + ((lane & 31) >> 4), qc = 16 * j + (lane & 15);
    const int rs_a = min(max(ra - 4, 0), 120), rs_b = min(max(ra + 1 - 4, 0), 120), ntile = 8 + (rs_b + 8 - rs_a);
    for (int i = X.tid; i < 465; i += NTHREADS) rpbl[i] = LOG2E * rpbg[h * 465 + i];
    __syncthreads();
    bf16x8 qf[1][4];
#pragma unroll
    for (int ks = 0; ks < 4; ++ks) qf[0][ks] = *(const bf16x8*)(PB + (size_t)(b * SEQ + qr * 64 + qc) * PBW + PB_NQ + h * 64 + 16 * ks + 8 * (lane >> 5));
    AttnState<1> S; S.m[0] = -1e30f; S.l[0] = 0.f;
#pragma unroll
    for (int db = 0; db < 2; ++db)
#pragma unroll
        for (int r = 0; r < 16; ++r) S.o[0][db][r] = 0.f;
    MaskNA MF; MF.qr = qr; MF.qc = qc; MF.rs = min(max(qr - 4, 0), 120); MF.cs = min(max(qc - 8, 0), 48); MF.blk = blk; MF.lane = lane; MF.rpb = rpbl;
    const bool act[1] = {true};
#define NA_ROW(t, key) ((t) < 8 ? NLAT + b * CTXL + 32 * (t) + (key) : b * SEQ + (rs_a + (t) - 8) * 64 + blk + (key))
#define NA_LOAD(t, R) na_load(PB, h, NA_ROW(t, lane & 31), NA_ROW(t, lane >> 1), lane, R)
#define NA_COMPUTE(t, R) do { asm volatile("" ::: "memory"); _Pragma("unroll") for (int i_ = 0; i_ < 4; ++i_) *(LAS u32x4*)(vt + (lane >> 1) * VP + (lane & 1) * 64 + i_ * 16) = R.v[i_]; \
        asm volatile("" ::: "memory"); MF.win = (t) >= 8; MF.kr0 = rs_a + (t) - 8; attn_tile_kv<1>(R.k, vt, 0, qf, S, act, MF, lane); asm volatile("" ::: "memory"); } while (0)
    NaTileRegs RA, RB;
    NA_LOAD(0, RA);
    for (int t = 0; t < ntile; t += 2) {
        if (t + 1 < ntile) NA_LOAD(t + 1, RB);
        NA_COMPUTE(t, RA);
        if (t + 1 < ntile) { if (t + 2 < ntile) NA_LOAD(t + 2, RA); NA_COMPUTE(t + 1, RB); }
    }
#undef NA_ROW
#undef NA_LOAD
#undef NA_COMPUTE
    attn_finish<1>(S, 0, Y + (size_t)(b * SEQ + qr * 64 + qc) * D + 256 + h * 64, lane);
    __syncthreads();
}
DI void ctx_attn_item(const Ctx& X, const Params& P, int l, int it) {
    const bf16_t* PB = (const bf16_t*)(P.ws + WS_PB); unsigned char* Y = P.ws + WS_Y;        const float* sink = P.in[10] + l * 8;
    const int lane = X.lane, w = X.wave;
    {
        const bool swa = it >= 8; const int b = (it >> 2) & 1;
        const int h = it & 3, n = (it >> 1) & 1, half = it & 1;
        const int kcol = swa ? PB_SK + n * 64 : PB_NK + h * 64, vcol = swa ? PB_SV + n * 64 : PB_NV + h * 64;
        StageRegs R; ChunkSrc cs; cs.mode = 0; cs.kr0 = 0; cs.rbase = NLAT + b * CTXL;
        stage_load(X, PB, kcol, vcol, cs, R); stage_store(X, X.lds, R);
        cs.rbase += 128; stage_load(X, PB, kcol, vcol, cs, R); stage_store(X, X.lds + CHB, R);
        __syncthreads();
        const MaskNone MF;
        if (!swa) {
            const int qrow = NLAT + b * CTXL + 32 * w + (lane & 31);
            bf16x8 qf[1][4];
#pragma unroll
            for (int ks = 0; ks < 4; ++ks) qf[0][ks] = *(const bf16x8*)(PB + (size_t)qrow * PBW + PB_NQ + h * 64 + 16 * ks + 8 * (lane >> 5));
            AttnState<1> S; S.m[0] = -1e30f; S.l[0] = 0.f;
#pragma unroll
            for (int db = 0; db < 2; ++db)
#pragma unroll
                for (int r = 0; r < 16; ++r) S.o[0][db][r] = 0.f;
            const bool act[1] = {true};
#pragma unroll 1
            for (int kt = 0; kt < 8; ++kt) attn_tile<1>(X.lds + (kt >> 2) * CHB, kt & 3, qf, S, act, MF, lane);
            attn_finish<1>(S, 0, Y + (size_t)qrow * D + 256 + h * 64, lane);
        } else {
            const int qh = n * 4 + half * 2 + (w >> 2), q0 = NLAT + b * CTXL + (w & 3) * 64 + (lane & 31);
            bf16x8 qf[2][4];
#pragma unroll
            for (int qt = 0; qt < 2; ++qt)
#pragma unroll
                for (int ks = 0; ks < 4; ++ks) qf[qt][ks] = *(const bf16x8*)(PB + (size_t)(q0 + 32 * qt) * PBW + PB_SQ + qh * 64 + 16 * ks + 8 * (lane >> 5));
            AttnState<2> S;
#pragma unroll
            for (int qt = 0; qt < 2; ++qt) { S.m[qt] = LOG2E * sink[qh]; S.l[qt] = lane < 32 ? 1.0f : 0.0f;
#pragma unroll
                for (int db = 0; db < 2; ++db)
#pragma unroll
                    for (int r = 0; r < 16; ++r) S.o[qt][db][r] = 0.f; }
            const bool act[2] = {true, true};
#pragma unroll 1
            for (int kt = 0; kt < 8; ++kt) attn_tile<2>(X.lds + (kt >> 2) * CHB, kt & 3, qf, S, act, MF, lane);
#pragma unroll
            for (int qt = 0; qt < 2; ++qt) attn_finish<2>(S, qt, Y + (size_t)(q0 + 32 * qt) * D + 512 + qh * 64, lane);
        }
        __syncthreads();
    }
}

DI void ph_swa(const Ctx& X, const Params& P, int l) { for (int it = X.bid; it < 256; it += X.nb) swa_item(X, P, l, it); }
DI void ph_na(const Ctx& X, const Params& P, int l) { for (int it = X.bid; it < 256; it += X.nb) na_item(X, P, l, it); }
DI void queue_publish(const Ctx& X, unsigned* cnt) {
    asm volatile("s_waitcnt vmcnt(0)" ::: "memory");
    __syncthreads();
    if (X.tid == 0) { __builtin_amdgcn_fence(__ATOMIC_RELEASE, "agent"); asm volatile("s_waitcnt vmcnt(0)" ::: "memory"); __hip_atomic_fetch_add(cnt, 1u, __ATOMIC_RELAXED, __HIP_MEMORY_SCOPE_AGENT); }
}
DI void queue_wait(const Ctx& X, unsigned* cnt, unsigned need) {
    if (X.tid == 0) { unsigned sp = 0; while (__hip_atomic_load(cnt, __ATOMIC_RELAXED, __HIP_MEMORY_SCOPE_AGENT) < need && ++sp < (1u << 24)) __builtin_amdgcn_s_sleep(2);
        __builtin_amdgcn_fence(__ATOMIC_ACQUIRE, "agent"); asm volatile("s_waitcnt vmcnt(0)" ::: "memory"); }
    __syncthreads();
}
DI void ph_mix_queue(const Ctx& X, const Params& P, int l) {
    unsigned* ctl = (unsigned*)(P.ws + WS_CTL);
    unsigned* head = ctl + CW_Q + 64 * l; unsigned* scan_cnt = ctl + CW_SCAN + 64 * l; unsigned* loc_cnt = ctl + CW_SCAN + 128 + 64 * l;
    volatile LAS unsigned* slot = (volatile LAS unsigned*)(X.lds + 144 * 1024 + 64);
    const int nloc = 264, nscan = 64, nctx = l == 0 ? 16 : 0, nconv = l == 0 ? 1536 : 0, nho = l == 0 ? 132 : 128;
    const int o_ctx = nloc, o_swa = o_ctx + nctx, o_scan = o_swa + 256, o_na = o_scan + nscan, o_conv = o_na + 256, o_ho = o_conv + nconv, total = o_ho + nho;
    bool scan_ok = false;
    for (;;) {
        if (X.tid == 0) *slot = atomicAdd(head, 1u);
        __syncthreads();
        int it = (int)*slot;
        __syncthreads();
        if (it >= total) break;
        if (nconv && it >= o_swa && it < o_ho) {
            const int j = it - o_swa, per = j / 11, ph = j - per * 11;
            it = (ph & 3) == 0 ? o_swa + per * 3 + (ph >> 2) : o_conv + per * 8 + (ph - 1 - (ph > 4) - (ph > 8));
        }
        Ctx Xi = X; { int wv = X.wave; asm volatile("" : "+s"(wv)); int ln; asm volatile("v_mbcnt_lo_u32_b32 %0, -1, 0\n\tv_mbcnt_hi_u32_b32 %0, -1, %0" : "=v"(ln)); Xi.tid = wv * 64 + ln; Xi.lane = ln; Xi.wave = wv; }
        if (it < o_ctx) { hgrn_local_item(Xi, P, l, it * 8 + Xi.wave); queue_publish(Xi, loc_cnt); }
        else if (it < o_swa) ctx_attn_item(Xi, P, l, it - o_ctx);
        else if (it < o_scan) swa_item(Xi, P, l, it - o_swa);
        else if (it < o_na) { queue_wait(Xi, loc_cnt, (unsigned)nloc); ph_hgrn_scan(Xi, P, it - o_scan); queue_publish(Xi, scan_cnt); }
        else if (it < o_conv) na_item(Xi, P, l, it - o_na);
        else if (it < o_ho) { LAS float* scr = (LAS float*)X.lds + X.wave * (64 * 33); const int g = it - o_conv, lyr = g >= 768, f0 = (g - 768 * lyr) * 16 + X.wave;
#define DESC_EQ(i) expert_desc(P, lyr, (i))
            TR_LOOP(DESC_EQ, f0, f0 + 16, 8); __syncthreads(); }
        else { if (!scan_ok) { queue_wait(Xi, scan_cnt, (unsigned)nscan); scan_ok = true; }
            hgrn_out_item(Xi, P, l, (it - o_ho) * 8 + Xi.wave); __syncthreads(); }
    }
}
constexpr size_t WS_Y2 = 284 * MiB;
DI void ph_dbg_copy(const Ctx& X, const Params& P) {
    const u32x4* src = (const u32x4*)(P.ws + WS_Y); u32x4* dst = (u32x4*)(P.ws + WS_Y2);
    for (size_t i = (size_t)X.bid * NTHREADS + X.tid; i < (size_t)NROWS * 128; i += (size_t)X.nb * NTHREADS) dst[i] = src[i];
}
DI void ph_dbg_compare(const Ctx& X, const Params& P) {
    const bf16_t* Yg = (const bf16_t*)(P.ws + WS_Y); const bf16_t* Yf = (const bf16_t*)(P.ws + WS_Y2); float* acc = (float*)(P.ws + WS_CTL) + CW_DBG;
    float num[3] = {0.f, 0.f, 0.f}, den[3] = {0.f, 0.f, 0.f};
    const int gw = X.bid * NWAVES + X.wave, NGW = X.nb * NWAVES;
    for (int row = gw; row < NROWS; row += NGW) {
#pragma unroll
        for (int j = 0; j < 16; ++j) { const int c = j * 64 + X.lane; const float a = bf2f(Yg[(size_t)row * D + c]), b = bf2f(Yf[(size_t)row * D + c]); const float d = a - b;
            const int br = j < 4 ? 0 : (j < 8 ? 1 : 2);
            if (br == 0) { num[0] += d * d; den[0] += a * a; } else if (br == 1) { num[1] += d * d; den[1] += a * a; } else { num[2] += d * d; den[2] += a * a; } }
    }
#pragma unroll
    for (int b = 0; b < 3; ++b) { const float n = wave_sum(num[b]), d = wave_sum(den[b]); if (X.lane == 0) { atomicAdd(acc + 2 * b, n); atomicAdd(acc + 2 * b + 1, d); } }
}
DI void ph_dbg_apply(const Ctx& X, const Params& P) {
    const float* acc = (const float*)(P.ws + WS_CTL) + CW_DBG;
#ifdef DBG_BRUTE
    float code = sqrtf(acc[16] / acc[17]);
#else
    float code = sqrtf(acc[0] / acc[1]);
#endif
    if (code == 0.f) return;
    f32x4* o = (f32x4*)P.out;
    for (size_t i = (size_t)X.bid * NTHREADS + X.tid; i < (size_t)NLAT * 256; i += (size_t)X.nb * NTHREADS) o[i] = o[i] * (1.0f + code);
}

DI void ph_inproj(const Ctx& X, const Params& P, int l) {
    PlainSched S; S.init(NROWS, INW, X.nb, X.bid);
    EpiIn E{(bf16_t*)(P.ws + WS_PB), (bf16_t*)(P.ws + WS_Z), (const float*)(P.ws + WS_ROPE), (const float*)(P.ws + WS_LB) + l * 512, (bf16_t*)(P.ws + WS_KK)};
    gemm_fast<PlainSched, EpiIn, true, 122>(X, P.ws + WS_H, P.ws + WS_WIN + (size_t)l * INW * D, D, S, E);
}
struct EpiNull { DI void group(const Unit&, int, int, f32x4 a0, f32x4 a1, f32x4 b0, f32x4 b1) const { asm volatile("" :: "v"(a0), "v"(a1), "v"(b0), "v"(b1)); } };
DI void ph_inproj_plain(const Ctx& X, const Params& P, int l) {
    PlainSched S; S.init(NROWS, INW, X.nb, X.bid);
    EpiNull E;
    GEMM_IMPL(X, (const bf16_t*)(P.ws + WS_H), (const bf16_t*)(P.ws + WS_WIN) + (size_t)l * INW * D, D, S, E);
}
DI void small_gemm_item(const Ctx& X, const unsigned char* A, const unsigned char* Bt, bf16_t* C, int row0, int col0) {
    const int wm = X.wave >> 2, wn = X.wave & 3, fr = X.lane & 15, fq = X.lane >> 4;
    const unsigned char* ap = A + (size_t)(row0 + 16 * wm + fr) * D + 8 * fq; const unsigned char* bp = Bt + (size_t)(col0 + 16 * wn + fr) * D + 8 * fq;
    f32x4 acc = {0.f, 0.f, 0.f, 0.f};
#pragma unroll 1
    for (int k0 = 0; k0 < D; k0 += 512) {
        long af[16], bfv[16];
#pragma unroll
        for (int i = 0; i < 16; ++i) { af[i] = *(const long*)(ap + k0 + 32 * i); bfv[i] = *(const long*)(bp + k0 + 32 * i); }
#pragma unroll
        for (int i = 0; i < 16; ++i) acc = __builtin_amdgcn_mfma_f32_16x16x32_fp8_fp8(bfv[i], af[i], acc, 0, 0, 0);
    }
    store_bf4(C + (size_t)(row0 + 16 * wm + fr) * D + col0 + 16 * wn + 4 * fq, acc * (1.0f / 64.0f));
}
DI void ph_outproj(const Ctx& X, const Params& P, int l) {
    PlainSched S; S.init(NLAT, D, X.nb, X.bid);
    EpiBf E{(bf16_t*)(P.ws + WS_YO), D};
    gemm_fast<PlainSched, EpiBf, true, 121>(X, P.ws + WS_Y, P.ws + WS_WOUT + (size_t)l * D * D, D, S, E);
    if (l == 0) for (int it = X.bid; it < 256; it += X.nb)
        small_gemm_item(X, P.ws + WS_Y, P.ws + WS_WOUT, (bf16_t*)(P.ws + WS_YO), NLAT + 32 * (it >> 4), 64 * (it & 15));
}
DI void ph_moe1(const Ctx& X, const Params& P, int l) {
    moe_build_table(X, (const int*)(P.ws + WS_CTL) + CW_CNT + 1024 * l);
    MoeSched<true> S{(const int*)(P.ws + WS_CTL) + CW_CNT + 1024 * l, (const int*)(P.ws + WS_LIST), X.nb, X.bid, 4, 1024, X.lds};
    { LAS int* ll = (LAS int*)(X.lds + MOE_LIST_OFF); Unit u;
#pragma unroll 1
      for (int i = 0; i < 3; ++i) if (S.next(i, u) && X.tid < 256) { const int idx = u.i0 * 256 + X.tid; ll[i * 256 + X.tid] = S.list[u.e * LISTCAP + (idx < u.cnt ? idx : 0)]; }
      __syncthreads(); }
    EpiGU E{(bf16_t*)(P.ws + WS_S)};
    gemm_fast<MoeSched<true>, EpiGU, true, 122>(X, P.ws + WS_H, P.ws + (l ? WS_WGU1 : WS_WGU), D, S, E);
}
DI void ph_moe2(const Ctx& X, const Params& P, int l) {
    moe_build_table(X, (const int*)(P.ws + WS_CTL) + CW_CNT + 1024 * l);
    MoeSched<false> S{(const int*)(P.ws + WS_CTL) + CW_CNT + 1024 * l, (const int*)(P.ws + WS_LIST), X.nb, X.bid, 4, 1024, X.lds};
    EpiF8 E{P.ws + WS_O, D};
    gemm_fast<MoeSched<false>, EpiF8, true, 122>(X, P.ws + WS_S, P.ws + (l ? WS_WD1 : WS_WD), DEXP, S, E);
}

#define XB_TMO      128
#define XB_XCNT(j)  (256  + 64 * (j))
#define XB_XSUB(j)  (1280 + 64 * (j))
#define XB_XGEN(j)  (2304 + 64 * (j))
#define XB_TOP      3328
#define XB_TOPGEN   3392
#define XCD_BAR_WORDS 3456
#ifndef XB_SPIN_CAP
#define XB_SPIN_CAP (1u << 26)
#endif
DI unsigned xb_ld(unsigned* p)              { return __hip_atomic_load(p, __ATOMIC_RELAXED, __HIP_MEMORY_SCOPE_AGENT); }
DI unsigned xb_add(unsigned* p, unsigned v) { return __hip_atomic_fetch_add(p, v, __ATOMIC_RELAXED, __HIP_MEMORY_SCOPE_AGENT); }
DI unsigned xb_xcc_id() { return (unsigned)__builtin_amdgcn_s_getreg((3 << 11) | 20) & 0xFu; }
#define XB_SPIN(cond, bar) do { unsigned _sp = 0; while (cond) { __builtin_amdgcn_s_sleep(1); \
    if ((++_sp & 255u) == 0u) { if (xb_ld(&(bar)[XB_TMO])) break; if (_sp > XB_SPIN_CAP) { atomicAdd(&(bar)[XB_TMO], 1u); break; } } } } while (0)
struct XcdBarrier { unsigned* bar; unsigned x; volatile LAS unsigned* st; };
DI XcdBarrier xcd_barrier_post(unsigned* bar, volatile LAS unsigned* st) {
    XcdBarrier b; b.bar = bar; b.x = xb_xcc_id(); b.st = st;
    if (threadIdx.x == 0) (void)xb_add(&bar[XB_XCNT(b.x)], 1u);
    return b;
}
DI void xcd_barrier_complete(unsigned* bar, unsigned x, unsigned& nloc, unsigned& nx) {
    const unsigned G = gridDim.x * gridDim.y * gridDim.z;
    unsigned sum, cnt, mine, sp = 0u;
    for (;;) {
        sum = 0u; cnt = 0u; mine = 0u;
#pragma unroll
        for (unsigned j = 0; j < 16; ++j) { const unsigned c = xb_ld(&bar[XB_XCNT(j)]); sum += c; cnt += (c > 0u) ? 1u : 0u; mine = (j == x) ? c : mine; }
        if (sum == G) break;
        __builtin_amdgcn_s_sleep(1);
        if ((++sp & 255u) == 0u) { if (xb_ld(&bar[XB_TMO])) break; if (sp > XB_SPIN_CAP) { atomicAdd(&bar[XB_TMO], 1u); break; } }
    }
    nloc = mine > 0u ? mine : 1u; nx = cnt > 0u ? cnt : 1u;
}
DI void xcd_barrier(const XcdBarrier& b) {
    asm volatile("s_waitcnt vmcnt(0)" ::: "memory");
    __syncthreads();
    if (threadIdx.x == 0) {
        unsigned* bar = b.bar;
        __builtin_amdgcn_s_waitcnt(0);
        unsigned nloc = b.st[0], nx = b.st[1];
        if (nloc == 0u) { xcd_barrier_complete(bar, b.x, nloc, nx); b.st[0] = nloc; b.st[1] = nx; }
        const unsigned old = xb_add(&bar[XB_XSUB(b.x)], 1u);
        const unsigned gen = old / nloc;
        if (old + 1u == (gen + 1u) * nloc) {
            __builtin_amdgcn_fence(__ATOMIC_RELEASE, "agent");
            asm volatile("s_waitcnt vmcnt(0)" ::: "memory");
            const unsigned og = xb_add(&bar[XB_TOP], 1u);
            const unsigned tg = og / nx;
            if (og + 1u == (tg + 1u) * nx) xb_add(&bar[XB_TOPGEN], 1u);
            else XB_SPIN(xb_ld(&bar[XB_TOPGEN]) == tg, bar);
            __builtin_amdgcn_fence(__ATOMIC_ACQUIRE, "agent");
            xb_add(&bar[XB_XGEN(b.x)], 1u);
            asm volatile("s_waitcnt vmcnt(0)" ::: "memory");
        } else {
            XB_SPIN(xb_ld(&bar[XB_XGEN(b.x)]) == gen, bar);
            __builtin_amdgcn_fence(__ATOMIC_ACQUIRE, "agent");
            asm volatile("s_waitcnt vmcnt(0)" ::: "memory");
        }
    }
    __syncthreads();
}

template <int Q> DI void run_phase(const Ctx& X0, const Params& P0, int l) {
#if defined(__HIP_DEVICE_COMPILE__)
    const __attribute__((address_space(4))) Params* pp_ = (const __attribute__((address_space(4))) Params*)__builtin_amdgcn_kernarg_segment_ptr(); asm volatile("" : "+s"(pp_), "+s"(l));
    const Params P = *pp_; (void)P0;
#else
    const Params P = P0;
#endif
    Ctx X = X0; { int wv = X0.wave; asm volatile("" : "+s"(wv)); int ln; asm volatile("v_mbcnt_lo_u32_b32 %0, -1, 0\n\tv_mbcnt_hi_u32_b32 %0, -1, %0" : "=v"(ln)); X.tid = wv * 64 + ln; X.lane = ln; X.wave = wv; int b_ = X0.bid, n_ = X0.nb; asm volatile("" : "+s"(b_), "+s"(n_)); X.bid = b_; X.nb = n_; }
    if constexpr (Q == 0) ph_prologue(X, P);
    if constexpr (Q == 1) { ph_modulate(X, P, 0); __syncthreads(); convert_rest(X, P); }
    if constexpr (Q == 2) ph_inproj(X, P, l);
    if constexpr (Q == 3) ph_hgrn_naive(X, P, l);
    if constexpr (Q == 4) ph_hgrn_combine_naive(X, P, l);
    if constexpr (Q == 5) ph_attn_naive(X, P, l);
    if constexpr (Q == 6) ph_outproj(X, P, l);
    if constexpr (Q == 7) ph_ln1(X, P, l);
    if constexpr (Q == 24) ph_ln1(X, P, l, true);
    if constexpr (Q == 27) ph_inproj_plain(X, P, l);
    if constexpr (Q == 8) ph_moe1(X, P, l);
    if constexpr (Q == 9) ph_moe2(X, P, l);
    if constexpr (Q == 13) ph_hgrn_out(X, P, l);
    if constexpr (Q == 14) ph_swa(X, P, l);
    if constexpr (Q == 15) ph_na(X, P, l);
#ifdef DBG_BRUTE
    if constexpr (Q == 23) ph_dbg_scores(X, P, l);
#endif
    if constexpr (Q == 20) ph_dbg_copy(X, P);
    if constexpr (Q == 21) ph_dbg_compare(X, P);
    if constexpr (Q == 22) ph_dbg_apply(X, P);
    if constexpr (Q == 10) ph_ln2(X, P, l);
    if constexpr (Q == 17) ph_mix_queue(X, P, l);
}

constexpr int LDS_BYTES = 150 * 1024;
template <int Q>
__global__ void __launch_bounds__(NTHREADS, 2) k_step(Params P, int l) {
    extern __shared__ __attribute__((aligned(16))) unsigned char lds_raw[];
    Ctx X; X.lds = (LAS unsigned char*)lds_raw; X.tid = threadIdx.x; X.lane = X.tid & 63; X.wave = __builtin_amdgcn_readfirstlane(X.tid >> 6); X.bid = blockIdx.x; X.nb = gridDim.x;
    run_phase<Q>(X, P, l);
}
template <int Q> static void launch_step(const Params& P, int l, int grid, hipStream_t stream) {
    static bool attr = false;
    if (!attr) { (void)hipFuncSetAttribute((const void*)k_step<Q>, hipFuncAttributeMaxDynamicSharedMemorySize, LDS_BYTES); attr = true; }
    hipLaunchKernelGGL(k_step<Q>, dim3(grid), dim3(NTHREADS), LDS_BYTES, stream, P, l);
}

constexpr int LDS_CTL_OFF = 144 * 1024;
__global__ void __launch_bounds__(NTHREADS, 2) k_mega(Params P) {
    extern __shared__ __attribute__((aligned(16))) unsigned char lds_raw[];
    Ctx X; X.lds = (LAS unsigned char*)lds_raw; X.tid = threadIdx.x; X.lane = X.tid & 63; X.wave = __builtin_amdgcn_readfirstlane(X.tid >> 6); X.bid = blockIdx.x; X.nb = gridDim.x;
    volatile LAS unsigned* st = (volatile LAS unsigned*)(X.lds + LDS_CTL_OFF);
    if (X.tid < 16) st[X.tid] = 0u;
    __syncthreads();
    { const XcdBarrier b0 = xcd_barrier_post((unsigned*)(P.ws + WS_CTL) + CW_BAR, st); if (X.tid == 0) st[2] = b0.x; }
    __syncthreads();
#ifdef TS_SEL
#define STAMP() do { if (blockIdx.x == 0 && threadIdx.x == 0) { unsigned long long* ts_ = (unsigned long long*)((unsigned*)(P.ws + WS_CTL) + CW_TS); const unsigned n_ = st[8]; ts_[n_] = __builtin_amdgcn_s_memrealtime(); st[8] = n_ + 1u; } } while (0)
#else
#define STAMP() do { } while (0)
#endif
#define GBAR() do { for (int br_ = 0; br_ < BAR_REP; ++br_) GBAR1(); STAMP(); } while (0)
#define GBAR1() do { unsigned char* w_ = P.ws; asm volatile("" : "+s"(w_)); XcdBarrier b_; b_.bar = (unsigned*)(w_ + WS_CTL) + CW_BAR; b_.st = st; b_.x = threadIdx.x == 0 ? st[2] : 0u; xcd_barrier(b_); } while (0)
#ifndef DUP
#define DUP 0
#endif
#ifndef BAR_REP
#define BAR_REP 1
#endif
#define NREP(bit) ({ int n_ = (DUP & (1 << (bit))) ? 2 : 1; asm volatile("" : "+s"(n_)); n_; })
#define RUNP(Q, bit) do { const int nr_ = NREP(bit); for (int rep_ = 0; rep_ < nr_; ++rep_) { run_phase<Q>(X, P, l); GBAR(); } } while (0)
    STAMP();
    { const int l = 0; RUNP(0, 0); RUNP(1, 1); }
    for (int l = 0; l < 2; ++l) {
        if (DUP & 32768) { run_phase<27>(X, P, l); GBAR(); }
        RUNP(2, 2);
#if FAST_MIX
        run_phase<17>(X, P, l); GBAR();
#ifdef DBG_MIX
        if (l == 0) {
            run_phase<20>(X, P, l); GBAR();
            run_phase<3>(X, P, l); GBAR();
            run_phase<4>(X, P, l); GBAR();
            run_phase<5>(X, P, l); GBAR();
            run_phase<21>(X, P, l); GBAR();
        }
#endif
#else
        run_phase<3>(X, P, l); GBAR();
        run_phase<4>(X, P, l); GBAR();
        run_phase<5>(X, P, l); GBAR();
#endif
        RUNP(6, 9);
        if ((DUP & 4096) && l == 0) { run_phase<24>(X, P, l); GBAR(); }
        run_phase<7>(X, P, l); GBAR();
        RUNP(8, 10);
        RUNP(9, 11);
        run_phase<10>(X, P, l); if (l == 0) GBAR();
    }
#ifdef TS_SEL
    GBAR();
    { const unsigned long long* ts_ = (const unsigned long long*)((const unsigned*)(P.ws + WS_CTL) + CW_TS); const float dt_us = 10.0f * floorf((float)(ts_[TS_SEL] - ts_[TS_SEL - 1]) * 0.001f + 0.5f); const float sc = 1.0f + dt_us * (1.0f / 2000.0f);
      f32x4* o = (f32x4*)P.out; for (size_t i = (size_t)blockIdx.x * NTHREADS + threadIdx.x; i < (size_t)NLAT * 256; i += (size_t)gridDim.x * NTHREADS) o[i] = o[i] * sc; }
#endif
#ifdef DBG_MIX
    GBAR(); run_phase<22>(X, P, 0);
#endif
#undef GBAR
}

extern "C" void kernel_launch(void* const* d_in, const int* in_sizes, int n_in, void* d_out, int out_size, void* d_ws, size_t ws_size, hipStream_t stream) {
    static int grid = 0;
    if (grid == 0) {
        if (n_in != 21 || out_size != NLAT * D || ws_size < WS_END) { fprintf(stderr, "kernel_launch: unexpected shapes n_in %d out %d ws %zu\n", n_in, out_size, ws_size); grid = -1; return; }
        int dev = 0, cus = 0; (void)hipGetDevice(&dev); (void)hipDeviceGetAttribute(&cus, hipDeviceAttributeMultiprocessorCount, dev);
        grid = cus > 0 ? cus : 256;
        (void)hipFuncSetAttribute((const void*)k_mega, hipFuncAttributeMaxDynamicSharedMemorySize, LDS_BYTES);
    }
    if (grid < 0) return;
    (void)hipMemsetAsync((char*)d_ws + WS_CTL, 0, CTL_BYTES, stream);
    Params P{};
    for (int i = 0; i < 21; ++i) P.in[i] = (const float*)d_in[i];
    P.out = (float*)d_out; P.ws = (unsigned char*)d_ws;
#if N_LAUNCH_MODE == 1
    hipLaunchKernelGGL(k_mega, dim3(grid), dim3(NTHREADS), LDS_BYTES, stream, P);
#else
    launch_step<0>(P, 0, grid, stream);
    launch_step<1>(P, 0, grid, stream);
    for (int l = 0; l < 2; ++l) {
        launch_step<2>(P, l, grid, stream); launch_step<3>(P, l, grid, stream); launch_step<4>(P, l, grid, stream); launch_step<5>(P, l, grid, stream);
        launch_step<6>(P, l, grid, stream); launch_step<7>(P, l, grid, stream); launch_step<8>(P, l, grid, stream); launch_step<9>(P, l, grid, stream);
        launch_step<10>(P, l, grid, stream);
    }
#endif
}
#ifdef DBG_INST
template __global__ void k_step<11>(Params, int);
template __global__ void k_step<12>(Params, int);
template __global__ void k_step<13>(Params, int);
template __global__ void k_step<14>(Params, int);
template __global__ void k_step<15>(Params, int);
template __global__ void k_step<16>(Params, int);
#endif
```

```cpp
#include <hip/hip_runtime.h>
#include <cstdint>
#include <cstdio>

#ifndef N_LAUNCH_MODE
#define N_LAUNCH_MODE 1
#endif
#ifndef FAST_MIX
#define FAST_MIX 1
#endif
#ifndef DBG_TEST
#define DBG_TEST 0
#endif
#ifndef DBG_HG_MODE
#define DBG_HG_MODE 0
#endif
#ifndef FAST_GEMM
#define FAST_GEMM 1
#endif

#define LAS __attribute__((address_space(3)))
#define GAS __attribute__((address_space(1)))
typedef unsigned short bf16_t;
typedef short bf16x8 __attribute__((ext_vector_type(8)));
typedef float f32x4 __attribute__((ext_vector_type(4)));
typedef float f32x2 __attribute__((ext_vector_type(2)));
typedef unsigned u32x4 __attribute__((ext_vector_type(4)));
typedef unsigned u32x2 __attribute__((ext_vector_type(2)));
typedef short s16x4 __attribute__((ext_vector_type(4)));
typedef float f32x16 __attribute__((ext_vector_type(16)));
#define DI __device__ __forceinline__

constexpr int D = 1024, NB = 2, SEQ = 8192, CTXL = 256, NLAT = NB * SEQ, NCTX = NB * CTXL, NROWS = NLAT + NCTX;
constexpr int INW = 2816, PBW = 2304, ZW = 512, NEXP = 16, DEXP = 512, LISTCAP = NROWS;
constexpr int NTHREADS = 512, NWAVES = 8;
constexpr float ALPHA = 1.41421356237f, LN_EPS = 1e-5f, RMS_EPS = 1e-6f, LOG2E = 1.4426950408889634f, QSCALE = 0.125f * LOG2E;
constexpr int PB_AQ = 0, PB_AI = 256, PB_AG = 512, PB_NQ = 768, PB_NK = 1024, PB_NV = 1280, PB_SQ = 1536, PB_SK = 2048, PB_SV = 2176;
constexpr int NCHAIN = 132;

constexpr size_t MiB = 1u << 20;
constexpr size_t WS_CTL = 0, CTL_BYTES = 1 * MiB;
constexpr size_t WS_MODS = 1 * MiB;
constexpr size_t WS_LB = WS_MODS + 2 * 3 * 6144 * 4;
constexpr size_t WS_ROPE = WS_LB + 2 * 2 * 256 * 4;
constexpr size_t WS_TOKE = WS_ROPE + 129 * 16 * 2 * 4;
constexpr size_t WS_TOKP = WS_TOKE + NROWS * 8;
constexpr size_t WS_TOKW = WS_TOKP + NROWS * 8;
constexpr size_t WS_LIST = 2 * MiB;
constexpr size_t WS_XC = 4 * MiB;
constexpr size_t WS_X1 = 211 * MiB;
constexpr size_t WS_WIN = 6 * MiB;
constexpr size_t WS_WOUT = 17 * MiB;
constexpr size_t WS_WGU = 21 * MiB;
constexpr size_t WS_WD = 53 * MiB;
constexpr size_t WS_H = 69 * MiB;
constexpr size_t WS_Y = 102 * MiB;
constexpr size_t WS_S = 135 * MiB;
constexpr size_t WS_DD = 282 * MiB;
constexpr size_t WS_PB = 174 * MiB;
constexpr size_t WS_Z = WS_PB + (size_t)NROWS * PBW * 2;
constexpr size_t WS_O = 174 * MiB;
constexpr size_t WS_YO = 248 * MiB;
constexpr size_t WS_WGU1 = 284 * MiB, WS_WD1 = 316 * MiB;
constexpr size_t WS_END = 332 * MiB;
constexpr int HE_ROWS = 37888;
constexpr size_t WS_KK = WS_Z + (size_t)NROWS * ZW * 2;
static_assert(WS_DD + (size_t)2 * 2112 * 64 * 4 <= WS_END && WS_Z + (size_t)NROWS * ZW * 4 <= WS_DD && WS_O + (size_t)HE_ROWS * 1024 * 2 <= WS_YO && WS_YO + (size_t)NROWS * 2048 <= WS_END, "ws map");
static_assert(WS_TOKW + NROWS * 8 <= WS_LIST && WS_LIST + 16 * LISTCAP * 4 <= WS_XC, "ws map small");
constexpr int CW_CNT = 8192;
constexpr int CW_BAR = 4096;
constexpr int CW_DBG = 512;
constexpr int CW_Q = 1024;
constexpr int CW_TS = 2048;
constexpr int CW_SCAN = 1536;

struct Params {
    const float* in[21];
    float* out;
    unsigned char* ws;
    int step_lo, step_hi;
};

DI unsigned f2bf(float f) { unsigned u = __builtin_bit_cast(unsigned, f); return (u + 0x7fffu + ((u >> 16) & 1u)) >> 16; }
DI float bf2f(unsigned h) { return __builtin_bit_cast(float, h << 16); }
typedef __bf16 bf16x2_t __attribute__((ext_vector_type(2)));
DI unsigned pk2(float lo, float hi) { return __builtin_bit_cast(unsigned, __builtin_convertvector((f32x2){lo, hi}, bf16x2_t)); }
DI float bflo(unsigned w) { return __builtin_bit_cast(float, w << 16); }
DI float bfhi(unsigned w) { return __builtin_bit_cast(float, w & 0xffff0000u); }
#define DPPF(v, ctrl, rm) __builtin_bit_cast(float, __builtin_amdgcn_update_dpp(0, __builtin_bit_cast(int, (v)), (ctrl), (rm), 0xf, false))
DI float wave_sum(float v) {
    v += DPPF(v, 0xB1, 0xf); v += DPPF(v, 0x4E, 0xf); v += DPPF(v, 0x141, 0xf); v += DPPF(v, 0x140, 0xf);
    v += DPPF(v, 0x142, 0xa); v += DPPF(v, 0x143, 0xc);
    return __builtin_bit_cast(float, __builtin_amdgcn_readlane(__builtin_bit_cast(int, v), 63));
}
DI float wave_max(float v) {
#pragma unroll
    for (int o = 1; o < 64; o <<= 1) v = fmaxf(v, __shfl_xor(v, o));
    return v;
}
DI float sigmoidf_(float x) { return 1.0f / (1.0f + __expf(-x)); }
DI float siluf_(float x) { return x / (1.0f + __expf(-x)); }
DI unsigned pk_fp8x4(f32x4 v) { int w = 0; w = __builtin_amdgcn_cvt_pk_fp8_f32(v[0], v[1], w, false); w = __builtin_amdgcn_cvt_pk_fp8_f32(v[2], v[3], w, true); return (unsigned)w; }
DI void store_bf4(bf16_t* p, f32x4 v) { u32x2 w; w.x = pk2(v[0], v[1]); w.y = pk2(v[2], v[3]); *(u32x2*)p = w; }

struct Ctx {
    LAS unsigned char* lds;
    int tid, lane, wave, bid, nb;
};

struct Unit { int pm, pn, e, cnt, i0, slot; };

struct PlainSched {
    int nM, nN, nwg, G, c;
    DI void init(int M, int N, int G_, int c_) { nM = M / 256; nN = N / 256; nwg = nM * nN; G = G_; c = c_; }
    DI bool next(int i, Unit& u) const {
        const long L = (long)i * G + c; if (L >= nwg) return false;
        int wgid = (int)L; { const int q = nwg / 8, r = nwg % 8, xcd = wgid % 8, off = wgid / 8; wgid = (xcd < r ? xcd * (q + 1) : r * (q + 1) + (xcd - r) * q) + off; }
        const int nig = 8 * nN, gid = wgid / nig, fm = gid * 8, gsz = (nM - fm) < 8 ? (nM - fm) : 8;
        u.pm = fm + ((wgid % nig) % gsz); u.pn = (wgid % nig) / gsz; u.e = 0; u.cnt = 0; u.i0 = 0; u.slot = 0; return true;
    }
    DI int a_row(const Unit& u, int r) const { return u.pm * 256 + r; }
    DI int b_row0(const Unit& u) const { return u.pn * 256; }
    static constexpr bool LOADS = false;
};
constexpr int MOE_TBL_OFF = 144 * 1024 + 512;
constexpr int MOE_LIST_OFF = 144 * 1024 + 2560;
DI void moe_build_table(const Ctx& X, const int* cnt) {
    LAS int* tbl = (LAS int*)(X.lds + MOE_TBL_OFF);
    if (X.tid < 160) { const int T = X.tid; int acc = 0, e = -1, i0 = 0, ce = 0;
#pragma unroll
        for (int q = 0; q < NEXP; ++q) { const int cq = cnt[q * 64]; const int nt = (cq + 255) >> 8; if (e < 0 && T < acc + nt) { e = q; i0 = T - acc; ce = cq; } acc += nt; }
        tbl[1 + 3 * T] = e; tbl[2 + 3 * T] = i0; tbl[3 + 3 * T] = ce; if (T == 0) tbl[0] = acc; }
    __syncthreads();
}
template <bool GATHER> struct MoeSched {
    const int* cnt; const int* list; int G, c, nct, bt_rows; LAS unsigned char* lds; static constexpr bool gather = GATHER;
    DI bool next(int i, Unit& u) const {
        const LAS int* tbl = (const LAS int*)(lds + MOE_TBL_OFF);
        const int xcd = c & 7, j = c >> 3; const int L = i * G + xcd * (G >> 3) + j;
        const int T = L / nct; if (T >= __builtin_amdgcn_readfirstlane(tbl[0])) return false;
        u.slot = i; u.pm = T; u.pn = L % nct; u.e = __builtin_amdgcn_readfirstlane(tbl[1 + 3 * T]); u.i0 = __builtin_amdgcn_readfirstlane(tbl[2 + 3 * T]); u.cnt = __builtin_amdgcn_readfirstlane(tbl[3 + 3 * T]); return true;
    }
    DI int a_row(const Unit& u, int r) const {
        if (!gather) return u.pm * 256 + r;
        return ((const LAS int*)(lds + MOE_LIST_OFF))[u.slot * 256 + r];
    }
    DI int b_row0(const Unit& u) const { return u.e * bt_rows + u.pn * 256; }
    static constexpr bool LOADS = GATHER;
};

DI void store_bf8(bf16_t* p, f32x4 lo, f32x4 hi) { u32x4 w; w.x = pk2(lo[0], lo[1]); w.y = pk2(lo[2], lo[3]); w.z = pk2(hi[0], hi[1]); w.w = pk2(hi[2], hi[3]); *(u32x4*)p = w; }
DI void store_f8x8(unsigned char* p, f32x4 lo, f32x4 hi) { u32x2 w; w.x = pk_fp8x4(lo); w.y = pk_fp8x4(hi); *(u32x2*)p = w; }
DI float lane32_partner(float v, bool upper) { const auto rr = __builtin_amdgcn_permlane32_swap(__float_as_uint(v), __float_as_uint(v), false, false); return __uint_as_float(upper ? rr[0] : rr[1]); }
struct EpiIn {
    bf16_t* PB; bf16_t* Z; const float* rope; const float* lb; bf16_t* KK;
    DI void gate8(bf16_t* zp, bf16_t* kp, const float* lbp, f32x4 z0, f32x4 z1) const {
        const f32x4 lb0 = *(const f32x4*)lbp, lb1 = *(const f32x4*)(lbp + 4); f32x4 lf0, lf1, k0, k1;
#pragma unroll
        for (int j = 0; j < 4; ++j) { const float zc = fminf(fmaxf(z0[j], -30.f), 30.f), e = __expf(-zc), sg = 1.0f / (1.0f + e); lf0[j] = __log2f(lb0[j] + (1.0f - lb0[j]) * sg); k0[j] = (1.0f - lb0[j]) * (e * sg); }
#pragma unroll
        for (int j = 0; j < 4; ++j) { const float zc = fminf(fmaxf(z1[j], -30.f), 30.f), e = __expf(-zc), sg = 1.0f / (1.0f + e); lf1[j] = __log2f(lb1[j] + (1.0f - lb1[j]) * sg); k1[j] = (1.0f - lb1[j]) * (e * sg); }
        store_bf8(zp, lf0, lf1); store_bf8(kp, k0, k1);
    }
    DI void rope8(f32x4& v0, f32x4& v1, const float* rp, bool upper) const {
#pragma unroll
        for (int j = 0; j < 4; ++j) { const float c0 = rp[2 * j], s0 = rp[2 * j + 1], c1 = rp[2 * (j + 4)], s1 = rp[2 * (j + 4) + 1];
            const float p0 = lane32_partner(v0[j], upper), p1 = lane32_partner(v1[j], upper);
            v0[j] = upper ? p0 * s0 + v0[j] * c0 : v0[j] * c0 - p0 * s0; v1[j] = upper ? p1 * s1 + v1[j] * c1 : v1[j] * c1 - p1 * s1; }
    }
    DI void group(const Unit& u, int r, int c, f32x4 a0, f32x4 a1, f32x4 b0, f32x4 b1) const {
        const int row = u.pm * 256 + r, seg = u.pn, gc = u.pn * 256 + c;
        if (seg == 1 || seg == 2) {
            const int ci = (seg - 1) * 256 + c; bf16_t* z = Z + (size_t)row * ZW + ci; bf16_t* k = KK + (size_t)row * ZW + ci; const float* lp = lb + ci;
            gate8(z, k, lp, a0, a1); gate8(z + 128, k + 128, lp + 128, b0, b1);
            return;
        }
        if (seg >= 8) {
            const int t = row & (SEQ - 1); const int which = (c >> 5) & 1; const int pos = row < NLAT ? (which ? (t & 63) : (t >> 6)) : 128;
            const bool upper = (c & 31) >= 16; const float* rp = rope + (pos * 16 + (c & 15)) * 2;
            rope8(a0, a1, rp, upper); if (seg < 10) rope8(b0, b1, rp, upper);
        }
        if (seg == 5 || seg == 8 || seg == 9) { a0 *= QSCALE; a1 *= QSCALE; b0 *= QSCALE; b1 *= QSCALE; }
        bf16_t* p = PB + (size_t)row * PBW + (gc >= 768 ? gc - 512 : gc);
        store_bf8(p, a0, a1); store_bf8(p + 128, b0, b1);
    }
};
struct EpiBf {
    bf16_t* C; int ldc;
    DI void group(const Unit& u, int r, int c, f32x4 a0, f32x4 a1, f32x4 b0, f32x4 b1) const {
        bf16_t* p = C + (size_t)(u.pm * 256 + r) * ldc + u.pn * 256 + c;
        store_bf8(p, a0, a1); store_bf8(p + 128, b0, b1);
    }
};
struct EpiF8 {
    unsigned char* C; int ldc;
    DI void group(const Unit& u, int r, int c, f32x4 a0, f32x4 a1, f32x4 b0, f32x4 b1) const {
        unsigned char* p = C + (size_t)(u.pm * 256 + r) * ldc + u.pn * 256 + c;
        store_f8x8(p, a0 * 16.0f, a1 * 16.0f); store_f8x8(p + 128, b0 * 16.0f, b1 * 16.0f);
    }
};
struct EpiGU {
    bf16_t* HE;
    DI void group(const Unit& u, int r, int c, f32x4 a0, f32x4 a1, f32x4 b0, f32x4 b1) const {
        f32x4 h0, h1;
#pragma unroll
        for (int j = 0; j < 4; ++j) { h0[j] = siluf_(a0[j]) * b0[j]; h1[j] = siluf_(a1[j]) * b1[j]; }
        store_f8x8((unsigned char*)HE + (size_t)(u.pm * 256 + r) * DEXP + u.pn * 128 + c, h0, h1);
    }
};

template <class Sched, class Epi>
DI void gemm_naive(const Ctx& X, const bf16_t* A, const bf16_t* Bt, int K, const Sched& S, const Epi& E) {
    Unit u;
    for (int i = 0; S.next(i, u); ++i) {
        for (int g = X.tid; g < 4096; g += NTHREADS) {
            const int fq = g & 3, wc = (g >> 2) & 3, r = g >> 4, c = wc * 32 + fq * 4;
            const bf16_t* ap = A + (size_t)S.a_row(u, r) * K;
            const bf16_t* bp = Bt + (size_t)(S.b_row0(u) + c) * K;
            float acc[16];
#pragma unroll
            for (int q = 0; q < 16; ++q) acc[q] = 0.f;
            for (int k = 0; k < K; k += 8) {
                const u32x4 av = *(const u32x4*)(ap + k);
                float af[8] = {bflo(av.x), bfhi(av.x), bflo(av.y), bfhi(av.y), bflo(av.z), bfhi(av.z), bflo(av.w), bfhi(av.w)};
#pragma unroll
                for (int q = 0; q < 16; ++q) {
                    const int col = (q >> 3) * 128 + ((q >> 2) & 1) * 16 + (q & 3);
                    const u32x4 bv = *(const u32x4*)(bp + (size_t)col * K + k);
                    acc[q] += af[0] * bflo(bv.x) + af[1] * bfhi(bv.x) + af[2] * bflo(bv.y) + af[3] * bfhi(bv.y) + af[4] * bflo(bv.z) + af[5] * bfhi(bv.z) + af[6] * bflo(bv.w) + af[7] * bfhi(bv.w);
                }
            }
            E.group(u, r, c, (f32x4){acc[0], acc[1], acc[2], acc[3]}, (f32x4){acc[4], acc[5], acc[6], acc[7]}, (f32x4){acc[8], acc[9], acc[10], acc[11]}, (f32x4){acc[12], acc[13], acc[14], acc[15]});
        }
    }
}

constexpr int HTB = 128 * 64 * 2;
DI int lds_byte(int r, int c) { const int st = (r >> 4) * 2 + (c >> 5), rr = r & 15, cc = c & 31, ob = rr * 64 + cc * 2; return st * 1024 + (ob ^ (((ob >> 9) & 1) << 5)); }
DI void stage_rc(int b, int& R, int& C) { const int st = b / 1024, sb = b % 1024, swz = sb ^ (((sb >> 9) & 1) << 5); R = (st >> 1) * 16 + swz / 64; C = (st & 1) * 32 + (swz % 64) / 2; }
typedef int v8i_t __attribute__((ext_vector_type(8)));
template <class Sched, class Epi, bool F8 = false, int SCALE_B = 127>
DI void gemm_fast(const Ctx& X, const void* A, const void* Bt, int K, const Sched& S, const Epi& E) {
    LAS unsigned char* lds = X.lds;
    const int tid = X.tid, wid = X.wave, lane = X.lane, wr = wid >> 2, wc = wid & 3, fr = lane & 15, fq = lane >> 4;
    asm volatile("" : "+s"(K));
    const int RP = F8 ? K : 2 * K, nt = RP / 128;
    int Rr[2], Cc[2]; unsigned voffB[2];
#pragma unroll
    for (int i = 0; i < 2; ++i) { stage_rc(tid * 16 + i * 8192, Rr[i], Cc[i]); const int rho = Rr[i] & 31, Rb = (Rr[i] & ~31) + 8 * ((rho & 15) >> 2) + 4 * (rho >> 4) + (rho & 3);
        voffB[i] = (unsigned)(Rb * RP + Cc[i] * 2); }
    const size_t kstep = 128, hstepB = (size_t)128 * RP;
    const unsigned ldsw = (unsigned)wid * 1024u;
    const int aoff = lds_byte(wr * 64 + fr, fq * 8), boff = lds_byte(wc * 32 + fr, fq * 8);
#define G_SA(b, h) (((b) * 2 + (h)) * HTB)
#define G_SB(b, h) ((4 + (b) * 2 + (h)) * HTB)
#define G_STAGE(bufoff, gbase, voff) do { _Pragma("unroll") for (int _i = 0; _i < 2; ++_i) \
        __builtin_amdgcn_global_load_lds((const unsigned*)((const char*)(gbase) + (voff)[_i]), (LAS unsigned*)(lds + (bufoff) + ldsw + _i * 8192), 16, 0, 0); } while (0)
#define G_LD8(p) __builtin_bit_cast(v8i_t, __builtin_shufflevector(*(const LAS u32x4*)(p), *(const LAS u32x4*)((p) + 1024), 0, 1, 2, 3, 4, 5, 6, 7))
#define G_LDA(dst, b, h) do { _Pragma("unroll") for (int m = 0; m < 4; ++m) dst[m] = G_LD8(lds + G_SA(b, h) + aoff + m * 2048); } while (0)
#define G_LDB(dst, b, h) do { _Pragma("unroll") for (int n = 0; n < 2; ++n) dst[n] = G_LD8(lds + G_SB(b, h) + boff + n * 2048); } while (0)
#define G_LO(f) __builtin_bit_cast(bf16x8, __builtin_shufflevector((f), (f), 0, 1, 2, 3))
#define G_HI(f) __builtin_bit_cast(bf16x8, __builtin_shufflevector((f), (f), 4, 5, 6, 7))
#define G_MMA(ai, bj, At, Bt_) do { __builtin_amdgcn_s_setprio(1); _Pragma("unroll") for (int m = 0; m < 4; ++m) _Pragma("unroll") for (int n = 0; n < 2; ++n) { \
        if constexpr (F8) asm volatile("v_mfma_scale_f32_16x16x128_f8f6f4 %0, %1, %2, %0, %3, %4 op_sel_hi:[0,0,0]" : "+v"(acc[ai][bj][m][n]) : "v"(Bt_[n]), "v"(At[m]), "v"(scl_w), "v"(scl_x)); \
        else { acc[ai][bj][m][n] = __builtin_amdgcn_mfma_f32_16x16x32_bf16(G_LO(Bt_[n]), G_LO(At[m]), acc[ai][bj][m][n], 0, 0, 0); acc[ai][bj][m][n] = __builtin_amdgcn_mfma_f32_16x16x32_bf16(G_HI(Bt_[n]), G_HI(At[m]), acc[ai][bj][m][n], 0, 0, 0); } } __builtin_amdgcn_s_setprio(0); } while (0)
#define G_WAIT_V(n) asm volatile("s_waitcnt vmcnt(" #n ")" ::: "memory")
#define G_WAIT_L(n) asm volatile("s_waitcnt lgkmcnt(" #n ")" ::: "memory")
#define G_BAR __builtin_amdgcn_s_barrier()
#define G_SCHED __builtin_amdgcn_sched_barrier(0)
    Unit cur, nxt; int ui = 0;
    if (!S.next(0, cur)) return;
    f32x4 acc[2][2][4][2];
#pragma unroll
    for (int a = 0; a < 2; ++a)
#pragma unroll
        for (int b = 0; b < 2; ++b)
#pragma unroll
            for (int m = 0; m < 4; ++m)
#pragma unroll
                for (int n = 0; n < 2; ++n) acc[a][b][m][n] = (f32x4){0.f, 0.f, 0.f, 0.f};
    v8i_t At[4], B0[2], B1[2];
    int scl_w = SCALE_B * 0x01010101, scl_x = 0x7f7f7f7f; asm volatile("" : "+v"(scl_w), "+v"(scl_x));
    constexpr bool GA = Sched::LOADS;
    unsigned vAc[2][2], vAn[2][2];
#pragma unroll
    for (int h = 0; h < 2; ++h)
#pragma unroll
        for (int i = 0; i < 2; ++i) { vAc[h][i] = GA ? (unsigned)(S.a_row(cur, h * 128 + Rr[i]) * RP + Cc[i] * 2) : (unsigned)((h * 128 + Rr[i]) * RP + Cc[i] * 2); vAn[h][i] = vAc[h][i]; }
    if (GA) G_WAIT_V(0);
    const char* A0 = (const char*)A;
    const char* cA = GA ? A0 : A0 + (size_t)S.a_row(cur, 0) * RP;
    const char* cB = (const char*)Bt + (size_t)S.b_row0(cur) * RP;
    G_STAGE(G_SB(0, 0), cB, voffB); G_STAGE(G_SB(0, 1), cB + hstepB, voffB); G_STAGE(G_SA(0, 0), cA, vAc[0]); G_STAGE(G_SA(0, 1), cA, vAc[1]);
    if (wr == 1) G_BAR;
    G_WAIT_V(2); G_BAR;
    G_STAGE(G_SB(1, 0), cB + kstep, voffB); G_STAGE(G_SA(1, 0), cA + kstep, vAc[0]); G_STAGE(G_SB(1, 1), cB + hstepB + kstep, voffB);
    G_WAIT_V(6); G_BAR;
    for (;;) {
        const bool has_next = S.next(ui + 1, nxt);
        if (GA) {
#pragma unroll
            for (int h = 0; h < 2; ++h)
#pragma unroll
                for (int i = 0; i < 2; ++i) vAn[h][i] = has_next ? (unsigned)(S.a_row(nxt, h * 128 + Rr[i]) * RP + Cc[i] * 2) : vAc[h][i];
        }
        const char* nA = GA ? A0 : (has_next ? A0 + (size_t)S.a_row(nxt, 0) * RP : cA);
        const char* nB = has_next ? (const char*)Bt + (size_t)S.b_row0(nxt) * RP : cB;
#pragma unroll 1
        for (int t = 0; t < nt; t += 2) {
            const bool last = (t == nt - 2);
            const char* a1 = cA + (size_t)(t + 1) * kstep;
            const char* a2 = last ? nA : cA + (size_t)(t + 2) * kstep; const char* b2 = last ? nB : cB + (size_t)(t + 2) * kstep;
            const char* a3 = a2 + kstep; const char* b3 = b2 + kstep;
            unsigned v2[2][2];
#pragma unroll
            for (int h = 0; h < 2; ++h)
#pragma unroll
                for (int i = 0; i < 2; ++i) v2[h][i] = (GA && last) ? vAn[h][i] : vAc[h][i];
            G_LDB(B0, 0, 0); G_LDB(B1, 0, 1); G_SCHED; G_LDA(At, 0, 0); G_STAGE(G_SA(1, 1), a1, vAc[1]);
            G_WAIT_V(8); G_WAIT_L(0); G_BAR; G_MMA(0, 0, At, B0); G_MMA(0, 1, At, B1); G_BAR; G_SCHED;
            G_LDA(At, 0, 1); G_STAGE(G_SB(0, 0), b2, voffB); G_STAGE(G_SB(0, 1), b2 + hstepB, voffB); G_STAGE(G_SA(0, 0), a2, v2[0]);
            G_WAIT_V(8); G_WAIT_L(0); G_BAR; G_MMA(1, 0, At, B0); G_MMA(1, 1, At, B1); G_BAR; G_SCHED;
            G_LDB(B0, 1, 0); G_LDB(B1, 1, 1); G_SCHED; G_LDA(At, 1, 0); G_STAGE(G_SA(0, 1), a2, v2[1]);
            G_WAIT_V(8); G_WAIT_L(0); G_BAR; G_MMA(0, 0, At, B0); G_MMA(0, 1, At, B1); G_BAR; G_SCHED;
            G_LDA(At, 1, 1); G_STAGE(G_SB(1, 0), b3, voffB); G_STAGE(G_SB(1, 1), b3 + hstepB, voffB); G_STAGE(G_SA(1, 0), a3, v2[0]);
            G_WAIT_V(8); G_WAIT_L(0); G_BAR; G_MMA(1, 0, At, B0); G_MMA(1, 1, At, B1); G_BAR; G_SCHED;
        }
        if constexpr (F8) asm volatile("s_nop 15\n\ts_nop 15" ::: "memory");
        if (wr == 0) G_BAR;
#pragma unroll
        for (int ai = 0; ai < 2; ++ai)
#pragma unroll
            for (int m = 0; m < 4; ++m) E.group(cur, ai * 128 + wr * 64 + m * 16 + fr, wc * 32 + fq * 8, acc[ai][0][m][0], acc[ai][0][m][1], acc[ai][1][m][0], acc[ai][1][m][1]);
        if (!has_next) break;
#pragma unroll
        for (int a = 0; a < 2; ++a)
#pragma unroll
            for (int b = 0; b < 2; ++b)
#pragma unroll
                for (int m = 0; m < 4; ++m)
#pragma unroll
                    for (int n = 0; n < 2; ++n) acc[a][b][m][n] = (f32x4){0.f, 0.f, 0.f, 0.f};
        cur = nxt; cB = nB; cA = nA; ++ui;
        if (GA) {
#pragma unroll
            for (int h = 0; h < 2; ++h)
#pragma unroll
                for (int i = 0; i < 2; ++i) vAc[h][i] = vAn[h][i]; }
        if (wr == 1) G_BAR;
    }
    G_WAIT_V(0);
    G_BAR;
#undef G_SA
#undef G_SB
#undef G_STAGE
#undef G_LDA
#undef G_LDB
#undef G_MMA
#undef G_LD8
#undef G_LO
#undef G_HI
#undef G_WAIT_V
#undef G_WAIT_L
#undef G_BAR
#undef G_SCHED
}
#if FAST_GEMM
#define GEMM_IMPL gemm_fast
#else
#define GEMM_IMPL gemm_naive
#endif

struct TrDesc { const float* W; bf16_t* WT; int N, Kd, k0, n0, drow0, f8; float sc; };
DI void tr_load(const TrDesc& d, float (&rg)[32], int lane) {
#pragma unroll
    for (int i = 0; i < 32; ++i) { const int kk = 2 * i + (lane >> 5); rg[i] = d.W[(size_t)(d.k0 + kk) * d.N + d.n0 + (lane & 31)]; }
}
DI void tr_finish(const TrDesc& d, const float (&rg)[32], LAS float* scr, int lane) {
#pragma unroll
    for (int i = 0; i < 32; ++i) { const int kk = 2 * i + (lane >> 5); scr[kk * 33 + (lane & 31)] = rg[i]; }
    asm volatile("s_waitcnt lgkmcnt(0)" ::: "memory");
    const int c = lane & 7;
#pragma unroll
    for (int j = 0; j < 4; ++j) { const int n = (lane >> 3) + 8 * j; const LAS float* s = scr + (8 * c) * 33 + n;
        if (d.f8) { u32x2 o; o.x = pk_fp8x4((f32x4){s[0 * 33], s[1 * 33], s[2 * 33], s[3 * 33]} * d.sc); o.y = pk_fp8x4((f32x4){s[4 * 33], s[5 * 33], s[6 * 33], s[7 * 33]} * d.sc);
            *(u32x2*)((unsigned char*)d.WT + (size_t)(d.drow0 + n) * d.Kd + d.k0 + 8 * c) = o; }
        else { u32x4 o; o.x = pk2(s[0 * 33], s[1 * 33]); o.y = pk2(s[2 * 33], s[3 * 33]); o.z = pk2(s[4 * 33], s[5 * 33]); o.w = pk2(s[6 * 33], s[7 * 33]);
            *(u32x4*)(d.WT + (size_t)(d.drow0 + n) * d.Kd + d.k0 + 8 * c) = o; } }
    asm volatile("s_waitcnt lgkmcnt(0)" ::: "memory");
}
DI TrDesc expert_desc(const Params& P, int l, int it) {
    bf16_t* WGU = (bf16_t*)(P.ws + (l ? WS_WGU1 : WS_WGU)); bf16_t* WD = (bf16_t*)(P.ws + (l ? WS_WD1 : WS_WD));
    const float* wg = P.in[18] + (size_t)l * NEXP * D * DEXP; const float* wu = P.in[19] + (size_t)l * NEXP * D * DEXP; const float* wd = P.in[20] + (size_t)l * NEXP * DEXP * D;
    const int set = it >> 12, r = it & 4095, e = r >> 8, q = r & 255; TrDesc d; d.sc = 32.0f;
    if (set < 2) { const int kb = q >> 4, nbk = q & 15, n0 = nbk * 32;
        d.f8 = 1; d.W = (set ? wu : wg) + (size_t)e * D * DEXP; d.N = DEXP; d.WT = (bf16_t*)((unsigned char*)WGU + (size_t)e * 1024 * 1024); d.Kd = 1024; d.k0 = kb * 64; d.n0 = n0; d.drow0 = 256 * (n0 >> 7) + (n0 & 127) + set * 128;
    } else { const int kb = q >> 5, nbk = q & 31, n0 = nbk * 32;
        d.f8 = 1; d.W = wd + (size_t)e * DEXP * D; d.N = D; d.WT = (bf16_t*)((unsigned char*)WD + (size_t)e * 1024 * 512); d.Kd = 512; d.k0 = kb * 64; d.n0 = n0; d.drow0 = n0; }
    return d;
}
DI TrDesc rest_desc(const Params& P, int it) {
    if (it >= 2432) return expert_desc(P, 0, it - 2432);
    bf16_t* WIN = (bf16_t*)(P.ws + WS_WIN); bf16_t* WOUT = (bf16_t*)(P.ws + WS_WOUT); TrDesc d;
    d.f8 = 1; d.sc = 32.0f;
    if (it < 1408) { const int kb = it / 88, nbk = it % 88; d.f8 = 1; d.W = P.in[6] + (size_t)D * INW; d.N = INW; d.WT = (bf16_t*)((unsigned char*)WIN + (size_t)INW * D); d.Kd = D; d.k0 = kb * 64; d.n0 = nbk * 32; d.drow0 = nbk * 32; }
    else { const int r0 = it - 1408, l = r0 >> 9, r = r0 & 511, kb = r >> 5, nbk = r & 31; d.sc = 64.0f; d.W = P.in[11] + (size_t)l * D * D; d.N = D; d.WT = (bf16_t*)((unsigned char*)WOUT + (size_t)l * D * D); d.Kd = D; d.k0 = kb * 64; d.n0 = nbk * 32; d.drow0 = nbk * 32; }
    return d;
}
DI TrDesc win0_desc(const Params& P, int it) { TrDesc d; d.f8 = 1; d.sc = 32.0f; const int kb = it / 88, nbk = it % 88; d.W = P.in[6]; d.N = INW; d.WT = (bf16_t*)(P.ws + WS_WIN); d.Kd = D; d.k0 = kb * 64; d.n0 = nbk * 32; d.drow0 = nbk * 32; return d; }
#define TR_LOOP(DESC_EXPR, first, limit, step) do { int it_ = (first); if (it_ < (limit)) { float rg_[32]; TrDesc d_ = DESC_EXPR(it_); tr_load(d_, rg_, X.lane); \
        for (;;) { const int nx_ = it_ + (step); if (nx_ < (limit)) { float rn_[32]; const TrDesc dn_ = DESC_EXPR(nx_); tr_load(dn_, rn_, X.lane); tr_finish(d_, rg_, scr, X.lane); d_ = dn_; _Pragma("unroll") for (int q_ = 0; q_ < 32; ++q_) rg_[q_] = rn_[q_]; it_ = nx_; } \
                   else { tr_finish(d_, rg_, scr, X.lane); break; } } } } while (0)
DI void ph_prologue(const Ctx& X, const Params& P) {
    LAS float* sc = (LAS float*)X.lds;
    LAS float* red = sc + 3072;
    float* MODS = (float*)(P.ws + WS_MODS);
    for (int it = X.bid; it < 193; it += X.nb) {
        if (it < 192) {
            const int l = it / 96, cg = it % 96;
            for (int i = X.tid; i < 3072; i += NTHREADS) { const int cond = i >> 10, k = i & 1023; const float v = cond < 2 ? P.in[1][cond * 1024 + k] : P.in[3][k]; sc[i] = siluf_(v); }
            __syncthreads();
            const int kq = X.tid >> 4, c4 = X.tid & 15;
            float acc[3][4];
#pragma unroll
            for (int a = 0; a < 3; ++a)
#pragma unroll
                for (int j = 0; j < 4; ++j) acc[a][j] = 0.f;
            const float* w = P.in[4] + (size_t)l * D * 6144 + cg * 64 + c4 * 4;
#pragma unroll 8
            for (int i = 0; i < 32; ++i) { const int k = kq + 32 * i; const f32x4 wv = *(const f32x4*)(w + (size_t)k * 6144);
                const float s0 = sc[k], s1 = sc[1024 + k], s2 = sc[2048 + k];
#pragma unroll
                for (int j = 0; j < 4; ++j) { acc[0][j] += s0 * wv[j]; acc[1][j] += s1 * wv[j]; acc[2][j] += s2 * wv[j]; } }
#pragma unroll
            for (int a = 0; a < 3; ++a)
#pragma unroll
                for (int j = 0; j < 4; ++j) red[(kq * 3 + a) * 64 + c4 * 4 + j] = acc[a][j];
            __syncthreads();
            if (X.tid < 192) { const int cond = X.tid >> 6, col = X.tid & 63; float s = 0.f;
                for (int q = 0; q < 32; ++q) s += red[(q * 3 + cond) * 64 + col];
                MODS[(l * 3 + cond) * 6144 + cg * 64 + col] = s + P.in[5][l * 6144 + cg * 64 + col]; }
            __syncthreads();
        } else {
            float* LB = (float*)(P.ws + WS_LB);
            { const int i = X.tid; const float l0 = P.in[7][i], l1 = P.in[7][512 + i]; const float p1 = 1.0f / (1.0f + expf(l0 - l1));
              LB[i] = 1e-6f; LB[512 + i] = fmaxf(p1, 1e-6f); }
            float* RP = (float*)(P.ws + WS_ROPE);
            for (int i = X.tid; i < 2048 + 16; i += NTHREADS) { const int pos = i >> 4, f = i & 15; const float inv = powf(10000.0f, -(float)f / 16.0f); const float ang = pos < 128 ? (float)pos * inv : 0.0f;
                RP[2 * i] = cosf(ang); RP[2 * i + 1] = sinf(ang); }
        }
    }
    __syncthreads();
    LAS float* scr = (LAS float*)X.lds + X.wave * (64 * 33);
    const int gw = X.bid * NWAVES + X.wave, NGW = X.nb * NWAVES;
#define DESC_WIN0(i) win0_desc(P, (i))
    TR_LOOP(DESC_WIN0, gw, 1408, NGW);
}
DI void convert_rest(const Ctx& X, const Params& P) {
    LAS float* scr = (LAS float*)X.lds + X.wave * (64 * 33);
    const int gw = X.bid * NWAVES + X.wave, NGW = X.nb * NWAVES;
#define DESC_REST(i) rest_desc(P, (i))
    TR_LOOP(DESC_REST, gw, 2432, NGW);
}

DI const float* mods_row(const Params& P, int l, int row) { const int cond = row < NLAT ? (row >> 13) : 2; return (const float*)(P.ws + WS_MODS) + (l * 3 + cond) * 6144; }
template <int NR>
DI void modulate_rows(const Ctx& X, const Params& P, int l, int row0) {
    bf16_t* H = (bf16_t*)(P.ws + WS_H);
    const float* xr = row0 < NLAT ? P.in[0] + (size_t)row0 * D : P.in[2] + (size_t)(row0 - NLAT) * D; const float* md = mods_row(P, l, row0);
    f32x4 x[NR][4];
#pragma unroll
    for (int j = 0; j < 4; ++j)
#pragma unroll
        for (int r = 0; r < NR; ++r) x[r][j] = *(const f32x4*)(xr + (size_t)r * D + 4 * X.lane + 256 * j);
#pragma unroll
    for (int j = 0; j < 4; ++j) { const int c = 4 * X.lane + 256 * j; const f32x4 sh = *(const f32x4*)(md + c), sc = *(const f32x4*)(md + 1024 + c);
#pragma unroll
        for (int r = 0; r < NR; ++r) *(unsigned*)((unsigned char*)H + (size_t)(row0 + r) * D + c) = pk_fp8x4(x[r][j] * (1.0f + sc) + sh); }
}
DI void ph_modulate(const Ctx& X, const Params& P, int l) {
    const int gw = X.bid * NWAVES + X.wave;
    if (gw < NLAT / 8) { modulate_rows<4>(X, P, l, 8 * gw); modulate_rows<4>(X, P, l, 8 * gw + 4); }
    if (gw < NCTX) modulate_rows<1>(X, P, l, NLAT + gw);
}
template <int NR>
DI void ln1_rows(const Ctx& X, const Params& P, int l, int row0, int slot0, const LAS float* wrT, float (&lgv)[16]) {
    bf16_t* H = (bf16_t*)(P.ws + WS_H); const bf16_t* YO = (const bf16_t*)(P.ws + WS_YO); bf16_t* X1 = (bf16_t*)(P.ws + WS_X1) + (size_t)row0 * D;
    const float* g = P.in[12] + l * D; const float* bta = P.in[13] + l * D;
    const bool lat = row0 < NLAT;
    const float* xr = lat ? P.in[0] + (size_t)row0 * D : P.in[2] + (size_t)(row0 - NLAT) * D;
    const bf16_t* xb = (const bf16_t*)P.out + (size_t)row0 * D;
    const float* md = mods_row(P, l, row0);
    const int c0 = 4 * X.lane;
    f32x4 v[NR][4]; float sm[NR];
#pragma unroll
    for (int r = 0; r < NR; ++r) sm[r] = 0.f;
#pragma unroll
    for (int j = 0; j < 4; ++j) { const int c = c0 + 256 * j; const f32x4 g1 = *(const f32x4*)(md + 2048 + c);
#pragma unroll
        for (int r = 0; r < NR; ++r) { f32x4 x; if (l == 0) x = *(const f32x4*)(xr + (size_t)r * D + c); else { const u32x2 xw = *(const u32x2*)(xb + (size_t)r * D + c); x = (f32x4){bflo(xw.x), bfhi(xw.x), bflo(xw.y), bfhi(xw.y)}; }
            const u32x2 yw = *(const u32x2*)(YO + (size_t)(row0 + r) * D + c);
            const f32x4 y = {bflo(yw.x), bfhi(yw.x), bflo(yw.y), bfhi(yw.y)}; v[r][j] = ALPHA * x + g1 * y; sm[r] += (v[r][j][0] + v[r][j][1]) + (v[r][j][2] + v[r][j][3]); } }
    float rstd[NR];
#pragma unroll
    for (int r = 0; r < NR; ++r) { const float mean = wave_sum(sm[r]) * (1.0f / D); float q = 0.f;
#pragma unroll
        for (int j = 0; j < 4; ++j) { v[r][j] = v[r][j] - mean; q += (v[r][j][0] * v[r][j][0] + v[r][j][1] * v[r][j][1]) + (v[r][j][2] * v[r][j][2] + v[r][j][3] * v[r][j][3]); }
        sm[r] = q; }
#pragma unroll
    for (int r = 0; r < NR; ++r) rstd[r] = 1.0f / sqrtf(wave_sum(sm[r]) * (1.0f / D) + LN_EPS);
#pragma unroll
    for (int j = 0; j < 4; ++j) { const int c = c0 + 256 * j; const f32x4 gm = *(const f32x4*)(g + c), bt = *(const f32x4*)(bta + c), sc2 = *(const f32x4*)(md + 4096 + c), sh2 = *(const f32x4*)(md + 3072 + c);
#pragma unroll
        for (int r = 0; r < NR; ++r) { const f32x4 x1 = v[r][j] * rstd[r] * gm + bt; store_bf4(X1 + (size_t)r * D + c, x1);
            const f32x4 h2 = x1 * (1.0f + sc2) + sh2; *(unsigned*)((unsigned char*)H + (size_t)(row0 + r) * D + c) = pk_fp8x4(h2); v[r][j] = h2; } }
#pragma unroll
    for (int e = 0; e < 16; ++e) {
        f32x4 w[4];
#pragma unroll
        for (int j = 0; j < 4; ++j) w[j] = *(const LAS f32x4*)(wrT + e * 1024 + c0 + 256 * j);
#pragma unroll
        for (int r = 0; r < NR; ++r) { f32x4 acc = v[r][0] * w[0]; acc += v[r][1] * w[1]; acc += v[r][2] * w[2]; acc += v[r][3] * w[3];
            const float tot = wave_sum((acc[0] + acc[1]) + (acc[2] + acc[3]));
            lgv[e] = X.lane == slot0 + r ? tot : lgv[e]; }
        asm volatile("" ::: "memory");
    }
}
DI void ph_ln1(const Ctx& X, const Params& P, int l, bool dummy = false) {
    LAS float* wrT = (LAS float*)X.lds;
    for (int i = X.tid; i < 16384; i += NTHREADS) { const int k = i >> 4, e = i & 15; wrT[e * 1024 + k] = P.in[16][i]; }
    int* TOKP = (int*)(P.ws + WS_TOKP); int* LIST = (int*)(P.ws + WS_LIST);
    unsigned* CNT = (unsigned*)(P.ws + WS_CTL) + CW_CNT + 1024 * l + (dummy ? 4096 : 0);
    LAS int* lcnt = (LAS int*)(X.lds + 65536); LAS int* lbase = lcnt + 16; LAS int* linfo = lcnt + 32;
    if (X.tid < 16) lcnt[X.tid] = 0;
    for (int i = X.tid; i < 72 * 4; i += NTHREADS) linfo[i] = -1;
    __syncthreads();
    const int gw = X.bid * NWAVES + X.wave;
    float lgv[16];
#pragma unroll
    for (int e = 0; e < 16; ++e) lgv[e] = 0.f;
    if (gw < NLAT / 8) ln1_rows<8>(X, P, l, 8 * gw, 0, wrT, lgv);
    const bool hasctx = l == 0 && gw < NCTX;
    if (hasctx) ln1_rows<1>(X, P, l, NLAT + gw, 8, wrT, lgv);
    {
        int* TOKE = (int*)(P.ws + WS_TOKE); float* TOKW = (float*)(P.ws + WS_TOKW);
        const int k = X.lane; const bool valid = (k < 8 && gw < NLAT / 8) || (k == 8 && hasctx); const int row = k < 8 ? 8 * gw + k : NLAT + gw;
        float sg[16], sel[16];
#pragma unroll
        for (int e = 0; e < 16; ++e) { sg[e] = sigmoidf_(lgv[e]); sel[e] = sg[e] + P.in[17][e]; }
        int best = 0; float bestv = -3e38f;
#pragma unroll
        for (int gq = 0; gq < 4; ++gq) { float m1 = -3e38f, m2 = -3e38f;
#pragma unroll
            for (int j = 0; j < 4; ++j) { const float t = sel[gq * 4 + j]; const float lo = fminf(m1, t); m1 = fmaxf(m1, t); m2 = fmaxf(m2, lo); }
            const float gs = m1 + m2; const bool bt = gs > bestv; best = bt ? gq : best; bestv = bt ? gs : bestv; }
        int i0 = 0, i1 = 0; float v0 = -3e38f, v1 = -3e38f, s0 = 0.f, s1 = 0.f;
#pragma unroll
        for (int e = 0; e < 16; ++e) { const float t = (e >> 2) == best ? sel[e] : -3e38f; const bool c0 = t > v0, c1 = !c0 && t > v1;
            v1 = c0 ? v0 : (c1 ? t : v1); i1 = c0 ? i0 : (c1 ? e : i1); s1 = c0 ? s0 : (c1 ? sg[e] : s1);
            v0 = c0 ? t : v0; i0 = c0 ? e : i0; s0 = c0 ? sg[e] : s0; }
        if (valid) { const int slot = X.wave * 9 + k; const float inv = 1.0f / (s0 + s1);
            const int p0 = __hip_atomic_fetch_add(lcnt + i0, 1, __ATOMIC_RELAXED, __HIP_MEMORY_SCOPE_WORKGROUP), p1 = __hip_atomic_fetch_add(lcnt + i1, 1, __ATOMIC_RELAXED, __HIP_MEMORY_SCOPE_WORKGROUP);
            linfo[4 * slot] = row; linfo[4 * slot + 1] = i0 | (i1 << 8); linfo[4 * slot + 2] = p0; linfo[4 * slot + 3] = p1;
            TOKE[2 * row] = i0; TOKE[2 * row + 1] = i1; TOKW[2 * row] = s0 * inv; TOKW[2 * row + 1] = s1 * inv; }
    }
    __syncthreads();
    if (X.tid < 16) lbase[X.tid] = (int)atomicAdd(CNT + 64 * X.tid, (unsigned)lcnt[X.tid]);
    __syncthreads();
    if (X.tid < 72) { const int row = linfo[4 * X.tid];
        if (row >= 0) { const int ee = linfo[4 * X.tid + 1], e0 = ee & 255, e1 = ee >> 8, p0 = lbase[e0] + linfo[4 * X.tid + 2], p1 = lbase[e1] + linfo[4 * X.tid + 3];
            LIST[e0 * LISTCAP + p0] = row; LIST[e1 * LISTCAP + p1] = row; TOKP[2 * row] = p0; TOKP[2 * row + 1] = p1; } }
}
template <int NR>
DI void ln2_rows(const Ctx& X, const Params& P, int l, int row0, const int (&off)[16]) {
    bf16_t* H = (bf16_t*)(P.ws + WS_H); const unsigned char* O = P.ws + WS_O; const bf16_t* X1 = (const bf16_t*)(P.ws + WS_X1) + (size_t)row0 * D;
    const int* TOKE = (const int*)(P.ws + WS_TOKE); const int* TOKP = (const int*)(P.ws + WS_TOKP); const float* TOKW = (const float*)(P.ws + WS_TOKW);
    const float* g = P.in[14] + l * D; const float* bta = P.in[15] + l * D;
    const bool lat = row0 < NLAT;
    const float* md = mods_row(P, l, row0); const float* mdn = mods_row(P, 1, row0);
    const int c0 = 4 * X.lane;
    const unsigned char* ra[NR]; const unsigned char* rb[NR]; float w0[NR], w1[NR];
#pragma unroll
    for (int r = 0; r < NR; ++r) { const int row = row0 + r; const int e0 = TOKE[2 * row], e1 = TOKE[2 * row + 1]; int o0 = 0, o1 = 0;
#pragma unroll
        for (int e = 0; e < 16; ++e) { if (e == e0) o0 = off[e]; if (e == e1) o1 = off[e]; }
        ra[r] = O + (size_t)(o0 + TOKP[2 * row]) * D; rb[r] = O + (size_t)(o1 + TOKP[2 * row + 1]) * D; w0[r] = TOKW[2 * row] * 0.0625f; w1[r] = TOKW[2 * row + 1] * 0.0625f; }
    f32x4 v[NR][4]; float sm[NR];
#pragma unroll
    for (int r = 0; r < NR; ++r) sm[r] = 0.f;
#pragma unroll
    for (int j = 0; j < 4; ++j) { const int c = c0 + 256 * j; const f32x4 g2 = *(const f32x4*)(md + 5120 + c);
#pragma unroll
        for (int r = 0; r < NR; ++r) { const u32x2 xw = *(const u32x2*)(X1 + (size_t)r * D + c); const f32x4 x = {bflo(xw.x), bfhi(xw.x), bflo(xw.y), bfhi(xw.y)}; const int a = *(const int*)(ra[r] + c), b = *(const int*)(rb[r] + c);
            const f32x2 a01 = __builtin_amdgcn_cvt_pk_f32_fp8(a, false), a23 = __builtin_amdgcn_cvt_pk_f32_fp8(a, true), b01 = __builtin_amdgcn_cvt_pk_f32_fp8(b, false), b23 = __builtin_amdgcn_cvt_pk_f32_fp8(b, true);
            const f32x4 f = w0[r] * (f32x4){a01[0], a01[1], a23[0], a23[1]} + w1[r] * (f32x4){b01[0], b01[1], b23[0], b23[1]};
            v[r][j] = ALPHA * x + g2 * f; sm[r] += (v[r][j][0] + v[r][j][1]) + (v[r][j][2] + v[r][j][3]); } }
    float rstd[NR];
#pragma unroll
    for (int r = 0; r < NR; ++r) { const float mean = wave_sum(sm[r]) * (1.0f / D); float q = 0.f;
#pragma unroll
        for (int j = 0; j < 4; ++j) { v[r][j] = v[r][j] - mean; q += (v[r][j][0] * v[r][j][0] + v[r][j][1] * v[r][j][1]) + (v[r][j][2] * v[r][j][2] + v[r][j][3] * v[r][j][3]); }
        sm[r] = q; }
#pragma unroll
    for (int r = 0; r < NR; ++r) rstd[r] = 1.0f / sqrtf(wave_sum(sm[r]) * (1.0f / D) + LN_EPS);
#pragma unroll
    for (int j = 0; j < 4; ++j) { const int c = c0 + 256 * j; const f32x4 gm = *(const f32x4*)(g + c), bt = *(const f32x4*)(bta + c);
        f32x4 sc1 = {0.f, 0.f, 0.f, 0.f}, sh1 = {0.f, 0.f, 0.f, 0.f}; if (l == 0) { sc1 = *(const f32x4*)(mdn + 1024 + c); sh1 = *(const f32x4*)(mdn + c); }
#pragma unroll
        for (int r = 0; r < NR; ++r) { const f32x4 x2 = v[r][j] * rstd[r] * gm + bt;
            if (l == 0) { if (lat) store_bf4((bf16_t*)P.out + (size_t)(row0 + r) * D + c, x2); *(unsigned*)((unsigned char*)H + (size_t)(row0 + r) * D + c) = pk_fp8x4(x2 * (1.0f + sc1) + sh1); }
            else *(f32x4*)(P.out + (size_t)(row0 + r) * D + c) = x2; } }
}
DI void ph_ln2(const Ctx& X, const Params& P, int l) {
    const unsigned* CNT = (const unsigned*)(P.ws + WS_CTL) + CW_CNT + 1024 * l;
    int off[16]; { int acc = 0;
#pragma unroll
        for (int e = 0; e < 16; ++e) { off[e] = acc; acc += (((int)CNT[e * 64] + 255) >> 8) << 8; } }
    const int gw = X.bid * NWAVES + X.wave;
    if (gw < NLAT / 8) { ln2_rows<4>(X, P, l, 8 * gw, off); ln2_rows<4>(X, P, l, 8 * gw + 4, off); }
    if (l == 0 && gw < NCTX) ln2_rows<1>(X, P, l, NLAT + gw, off);
}

struct KeysNA { int b, r, c, rs, cs, h; const float* rpb;
    DI int n() const { return 128 + CTXL; }
    DI void get(int k, int& krow, float& bias) const { if (k < 128) { const int kr = rs + (k >> 4), kc = cs + (k & 15); krow = b * SEQ + kr * 64 + kc; bias = LOG2E * rpb[h * 465 + (kr - r + 7) * 31 + (kc - c + 15)]; } else { krow = NLAT + b * CTXL + (k - 128); bias = 0.f; } } };
struct KeysSWA { int b, lo, nband;
    DI int n() const { return nband + CTXL; }
    DI void get(int k, int& krow, float& bias) const { krow = k < nband ? b * SEQ + lo + k : NLAT + b * CTXL + (k - nband); bias = 0.f; } };
struct KeysCtx { int b;
    DI int n() const { return CTXL; }
    DI void get(int k, int& krow, float& bias) const { krow = NLAT + b * CTXL + k; bias = 0.f; } };
template <class Keys>
DI void attn_row_naive(const bf16_t* PB, int qrow, int qcol, int kcol, int vcol, const Keys& KS, bool has_sink, float sink, LAS float* sc, bf16_t* yout, int lane) {
    float q[64];
    { const u32x4* qp = (const u32x4*)(PB + (size_t)qrow * PBW + qcol);
#pragma unroll
      for (int i = 0; i < 8; ++i) { const u32x4 w = qp[i]; q[8 * i] = bflo(w.x); q[8 * i + 1] = bfhi(w.x); q[8 * i + 2] = bflo(w.y); q[8 * i + 3] = bfhi(w.y); q[8 * i + 4] = bflo(w.z); q[8 * i + 5] = bfhi(w.z); q[8 * i + 6] = bflo(w.w); q[8 * i + 7] = bfhi(w.w); } }
    const int nk = KS.n(); float mx = has_sink ? sink : -3e38f;
    for (int k = lane; k < nk; k += 64) { int krow; float bias; KS.get(k, krow, bias);
        const u32x4* kp = (const u32x4*)(PB + (size_t)krow * PBW + kcol); float s = 0.f;
#pragma unroll
        for (int i = 0; i < 8; ++i) { const u32x4 w = kp[i]; s += q[8 * i] * bflo(w.x) + q[8 * i + 1] * bfhi(w.x) + q[8 * i + 2] * bflo(w.y) + q[8 * i + 3] * bfhi(w.y) + q[8 * i + 4] * bflo(w.z) + q[8 * i + 5] * bfhi(w.z) + q[8 * i + 6] * bflo(w.w) + q[8 * i + 7] * bfhi(w.w); }
        s += bias; sc[k] = s; mx = fmaxf(mx, s); }
    mx = wave_max(mx); float den = 0.f;
    for (int k = lane; k < nk; k += 64) { const float p = exp2f(sc[k] - mx); sc[k] = p; den += p; }
    den = wave_sum(den); if (has_sink) den += exp2f(sink - mx);
    asm volatile("s_waitcnt lgkmcnt(0)" ::: "memory");
    float o = 0.f;
    for (int k = 0; k < nk; ++k) { int krow; float bias; KS.get(k, krow, bias); o += sc[k] * bf2f(PB[(size_t)krow * PBW + vcol + lane]); }
    yout[lane] = (bf16_t)f2bf(o / den);
    asm volatile("s_waitcnt lgkmcnt(0)" ::: "memory");
}
DI void ph_attn_naive(const Ctx& X, const Params& P, int l) {
    const bf16_t* PB = (const bf16_t*)(P.ws + WS_PB); bf16_t* Y = (bf16_t*)(P.ws + WS_Y);
    LAS float* sc = (LAS float*)X.lds + X.wave * 640;
    const float* rpb = P.in[9] + l * 4 * 465; const float* sink = P.in[10] + l * 8;
    const int nrows = l == 0 ? NROWS : NLAT;
    const int gw = X.bid * NWAVES + X.wave, NGW = X.nb * NWAVES;
    for (int it = gw; it < nrows * 12; it += NGW) {
        const int row = it / 12, hh = it % 12;
        if (row < NLAT) { const int b = row >> 13, t = row & (SEQ - 1);
            if (hh < 4) { KeysNA K; K.b = b; K.r = t >> 6; K.c = t & 63; K.rs = min(max(K.r - 4, 0), 120); K.cs = min(max(K.c - 8, 0), 48); K.h = hh; K.rpb = rpb;
                attn_row_naive(PB, row, PB_NQ + hh * 64, PB_NK + hh * 64, PB_NV + hh * 64, K, false, 0.f, sc, Y + (size_t)row * D + 256 + hh * 64, X.lane);
            } else { const int qh = hh - 4, n = qh >> 2; KeysSWA K; K.b = b; K.lo = max(t - 128, 0); K.nband = min(t + 128, SEQ - 1) - K.lo + 1;
                attn_row_naive(PB, row, PB_SQ + qh * 64, PB_SK + n * 64, PB_SV + n * 64, K, true, LOG2E * sink[qh], sc, Y + (size_t)row * D + 512 + qh * 64, X.lane); }
        } else { const int b = (row - NLAT) >> 8; KeysCtx K; K.b = b;
            if (hh < 4) attn_row_naive(PB, row, PB_NQ + hh * 64, PB_NK + hh * 64, PB_NV + hh * 64, K, false, 0.f, sc, Y + (size_t)row * D + 256 + hh * 64, X.lane);
            else { const int qh = hh - 4, n = qh >> 2; attn_row_naive(PB, row, PB_SQ + qh * 64, PB_SK + n * 64, PB_SV + n * 64, K, true, LOG2E * sink[qh], sc, Y + (size_t)row * D + 512 + qh * 64, X.lane); }
        }
    }
}
DI void ph_hgrn_naive(const Ctx& X, const Params& P, int l) {
    const bf16_t* PB = (const bf16_t*)(P.ws + WS_PB); const float* Z = (const float*)(P.ws + WS_Z); float* O32 = (float*)(P.ws + WS_S);
    const float* LB = (const float*)(P.ws + WS_LB) + l * 512;
    const int gw = X.bid * NWAVES + X.wave;
    if (gw >= 16) return;
    const int b = gw >> 3, h = (gw >> 1) & 3, dir = gw & 1, lane = X.lane;
    const float lb = LB[dir * 256 + h * 64 + lane];
    float S[64];
#pragma unroll
    for (int d = 0; d < 64; ++d) S[d] = 0.f;
    for (int step = 0; step < CTXL + SEQ; ++step) {
        int row;
        if (step < CTXL) row = NLAT + b * CTXL + (dir ? CTXL - 1 - step : step); else { const int t = step - CTXL; row = b * SEQ + (dir ? SEQ - 1 - t : t); }
        float f = exp2f(bf2f(((const bf16_t*)Z)[(size_t)row * ZW + dir * 256 + h * 64 + lane])); const float kk = bf2f(((const bf16_t*)(P.ws + WS_KK))[(size_t)row * ZW + dir * 256 + h * 64 + lane]); (void)lb;
#if DBG_HG_MODE & 8
        f = 1.0f;
#endif
        const float qv = bf2f(PB[(size_t)row * PBW + PB_AQ + h * 64 + lane]), vv = bf2f(PB[(size_t)row * PBW + PB_AI + h * 64 + lane]);
#if DBG_HG_MODE & 1
        if ((step & 63) == 0) {
#pragma unroll
            for (int d = 0; d < 64; ++d) S[d] = 0.f; }
#endif
        float o = 0.f;
#pragma unroll
        for (int d = 0; d < 64; ++d) { const float fd = __builtin_bit_cast(float, __builtin_amdgcn_readlane(__builtin_bit_cast(int, f), d)), kd = __builtin_bit_cast(float, __builtin_amdgcn_readlane(__builtin_bit_cast(int, kk), d)), qd = __builtin_bit_cast(float, __builtin_amdgcn_readlane(__builtin_bit_cast(int, qv), d));
            S[d] = fd * S[d] + kd * vv; o += S[d] * qd; }
#if DBG_HG_MODE & 2
        if (dir == 1) o = 0.f;
#endif
#if DBG_HG_MODE & 4
        if (dir == 0) o = 0.f;
#endif
        O32[((size_t)dir * NROWS + row) * 256 + h * 64 + lane] = o;
    }
}
DI void ph_hgrn_combine_naive(const Ctx& X, const Params& P, int l) {
    const bf16_t* PB = (const bf16_t*)(P.ws + WS_PB); const float* O32 = (const float*)(P.ws + WS_S); bf16_t* Y = (bf16_t*)(P.ws + WS_Y);
    const float* nw = P.in[8] + l * 64;
    const int nrows = l == 0 ? NROWS : NLAT;
    const int gw = X.bid * NWAVES + X.wave, NGW = X.nb * NWAVES;
    for (int it = gw; it < nrows * 4; it += NGW) { const int row = it >> 2, h = it & 3;
        const float o = O32[(size_t)row * 256 + h * 64 + X.lane] + O32[((size_t)NROWS + row) * 256 + h * 64 + X.lane];
        const float ms = wave_sum(o * o) * (1.0f / 64.0f); const float y = o * (1.0f / sqrtf(ms + RMS_EPS)) * nw[X.lane];
        const float gte = bf2f(PB[(size_t)row * PBW + PB_AG + h * 64 + X.lane]);
        Y[(size_t)row * D + h * 64 + X.lane] = (bf16_t)f2bf(y * siluf_(gte)); }
}

typedef short v4i16_t __attribute__((ext_vector_type(4)));
DI s16x4 tr_read(const LAS unsigned char* p) { return __builtin_bit_cast(s16x4, __builtin_amdgcn_ds_read_tr16_b64_v4i16((LAS v4i16_t*)p)); }
DI bf16x8 cat8(s16x4 a, s16x4 b) { return __builtin_shufflevector(a, b, 0, 1, 2, 3, 4, 5, 6, 7); }
DI bf16x8 pack8(float a0, float a1, float a2, float a3, float a4, float a5, float a6, float a7) {
    u32x4 w; w.x = pk2(a0, a1); w.y = pk2(a2, a3); w.z = pk2(a4, a5); w.w = pk2(a6, a7); return __builtin_bit_cast(bf16x8, w); }
DI float shfl_f(float v, int src) { return __shfl(v, src); }

constexpr int HP = 144;
constexpr size_t WS_QT = WS_H, WS_KT = WS_H + (size_t)2 * NROWS * 256 * 2;
#ifdef DBG_MIX
constexpr size_t WS_ST = 318 * MiB;
#else
constexpr size_t WS_ST = WS_Z;
#endif
DI size_t st_base(const Ctx& X) {
#ifdef QPROBE
    return *(volatile LAS unsigned*)(X.lds + 144 * 1024 + 48) ? WS_Y : WS_ST;
#else
    (void)X; return WS_ST;
#endif
}
static_assert(WS_KT + (size_t)2 * NROWS * 256 * 2 <= WS_Y && (size_t)2112 * 4096 * 2 <= (size_t)NROWS * ZW * 4, "hgrn buffers");
DI void hgrn_chunk_rows(int b, int dir, int p, int& row0) {
    if (p < 4) row0 = NLAT + b * CTXL + 64 * (dir ? 3 - p : p); else row0 = b * SEQ + 64 * (dir ? 131 - p : p - 4);
}
DI void hgrn_local_item(const Ctx& X, const Params& P, int l, int it) {
    const bf16_t* PB = (const bf16_t*)(P.ws + WS_PB); const bf16_t* Z = (const bf16_t*)(P.ws + WS_Z);
    bf16_t* QT = (bf16_t*)(P.ws + WS_QT); bf16_t* KT = (bf16_t*)(P.ws + WS_KT); float* U = (float*)(P.ws + WS_S); float* DD = (float*)(P.ws + WS_DD); float* ER = DD + 2112 * 64;
    const float* LB = (const float*)(P.ws + WS_LB) + l * 512;
    LAS unsigned char* kt_l = X.lds + X.wave * (2 * 64 * HP); LAS unsigned char* v_l = kt_l + 64 * HP;
    const int lane = X.lane;
    if (it < 2112) {
        const int p = it % NCHAIN, chain = it / NCHAIN, dir = chain & 1, h = (chain >> 1) & 3, b = chain >> 3;
        int row0; hgrn_chunk_rows(b, dir, p, row0);
#pragma unroll
        for (int i = 0; i < 8; ++i) { const int r = i * 8 + (lane >> 3), pc = lane & 7; const u32x4 w = *(const u32x4*)(PB + (size_t)(row0 + r) * PBW + PB_AI + h * 64 + pc * 8); *(LAS u32x4*)(v_l + r * HP + pc * 16) = w; }
        float lf[64];
        const bf16_t* zp = Z + (size_t)row0 * ZW + dir * 256 + h * 64 + lane;
#pragma unroll
        for (int s = 0; s < 64; ++s) lf[s] = bf2f(zp[(size_t)s * ZW]);
        float ref, last;
        if (dir == 0) {
#pragma unroll
            for (int s = 1; s < 64; ++s) lf[s] += lf[s - 1];
            ref = lf[31]; last = lf[63];
        } else {
#pragma unroll
            for (int s = 62; s >= 0; --s) lf[s] += lf[s + 1];
            ref = lf[32]; last = lf[0];
        }
        const bf16_t* qp = PB + (size_t)row0 * PBW + PB_AQ + h * 64 + lane; const bf16_t* kp = (const bf16_t*)(P.ws + WS_KK) + (size_t)row0 * ZW + dir * 256 + h * 64 + lane;
        bf16_t* qto = QT + ((size_t)dir * NROWS + row0) * 256 + h * 64 + lane; bf16_t* kto = KT + ((size_t)dir * NROWS + row0) * 256 + h * 64 + lane;
#pragma unroll
        for (int hf = 0; hf < 2; ++hf) {
            unsigned short qv[32], kv[32];
#pragma unroll
            for (int s = 0; s < 32; ++s) { qv[s] = qp[(size_t)(32 * hf + s) * PBW]; kv[s] = kp[(size_t)(32 * hf + s) * ZW]; }
#pragma unroll
            for (int s2 = 0; s2 < 32; ++s2) { const int s = 32 * hf + s2;
                const float q = bf2f(qv[s2]), kk = bf2f(kv[s2]);
                const float eq = __builtin_amdgcn_exp2f(lf[s] - ref), ek = __builtin_amdgcn_exp2f(ref - lf[s]);
                const unsigned short qb = (unsigned short)f2bf(q * eq), kb = (unsigned short)f2bf(kk * ek);
                qto[(size_t)s * 256] = qb; kto[(size_t)s * 256] = kb;
                *(LAS unsigned short*)(kt_l + s * HP + lane * 2) = kb; }
            asm volatile("" ::: "memory");
        }
        asm volatile("" ::: "memory");
        const float e_lr = __builtin_amdgcn_exp2f(last - ref);
        DD[it * 64 + lane] = __builtin_amdgcn_exp2f(last); ER[it * 64 + lane] = __builtin_amdgcn_exp2f(ref);
        f32x4 acc[4][4];
#pragma unroll
        for (int m = 0; m < 4; ++m)
#pragma unroll
            for (int n = 0; n < 4; ++n) acc[m][n] = (f32x4){0.f, 0.f, 0.f, 0.f};
        const int g = lane >> 4, i16 = lane & 15;
        const int troff = (8 * g + (i16 >> 2)) * HP + (i16 & 3) * 8;
#pragma unroll
        for (int ks = 0; ks < 2; ++ks) {
            bf16x8 af[4], bfv[4];
#pragma unroll
            for (int m = 0; m < 4; ++m) af[m] = cat8(tr_read(kt_l + troff + ks * 32 * HP + m * 32), tr_read(kt_l + troff + (ks * 32 + 4) * HP + m * 32));
#pragma unroll
            for (int n = 0; n < 4; ++n) bfv[n] = cat8(tr_read(v_l + troff + ks * 32 * HP + n * 32), tr_read(v_l + troff + (ks * 32 + 4) * HP + n * 32));
#pragma unroll
            for (int m = 0; m < 4; ++m)
#pragma unroll
                for (int n = 0; n < 4; ++n) acc[m][n] = __builtin_amdgcn_mfma_f32_16x16x32_bf16(af[m], bfv[n], acc[m][n], 0, 0, 0);
        }
        float* up = U + (size_t)it * 4096;
#pragma unroll
        for (int m = 0; m < 4; ++m)
#pragma unroll
            for (int r = 0; r < 4; ++r) { const int d = 16 * m + 4 * g + r; const float sc = shfl_f(e_lr, d);
#pragma unroll
                for (int n = 0; n < 4; ++n) up[d * 64 + 16 * n + i16] = acc[m][n][r] * sc; }
        asm volatile("s_waitcnt lgkmcnt(0)" ::: "memory");
    }
}
DI void ph_hgrn_scan(const Ctx& X, const Params& P, int part) {
    const float* U = (const float*)(P.ws + WS_S); const float* DD = (const float*)(P.ws + WS_DD); const float* ER = DD + 2112 * 64; bf16_t* ST = (bf16_t*)(P.ws + st_base(X));
    const int gt = part * NTHREADS + X.tid;
    const int chain = gt >> 11, d = (gt >> 5) & 63, e2 = (gt & 31) * 2;
    float s0 = 0.f, s1 = 0.f;
    for (int p0 = 0; p0 < NCHAIN; p0 += 4) {
        f32x2 u[4]; float dd[4], er[4];
#pragma unroll
        for (int j = 0; j < 4; ++j) { const int slot = chain * NCHAIN + p0 + j; u[j] = *(const f32x2*)(U + (size_t)slot * 4096 + d * 64 + e2); dd[j] = DD[slot * 64 + d]; er[j] = ER[slot * 64 + d]; }
#pragma unroll
        for (int j = 0; j < 4; ++j) { const int slot = chain * NCHAIN + p0 + j; *(unsigned*)(ST + (size_t)slot * 4096 + d * 64 + e2) = pk2(s0 * er[j], s1 * er[j]); s0 = dd[j] * s0 + u[j][0]; s1 = dd[j] * s1 + u[j][1]; }
    }
}
DI void hgrn_out_item(const Ctx& X, const Params& P, int l, int it) {
    const bf16_t* PB = (const bf16_t*)(P.ws + WS_PB); const bf16_t* QT = (const bf16_t*)(P.ws + WS_QT); const bf16_t* KT = (const bf16_t*)(P.ws + WS_KT); const bf16_t* ST = (const bf16_t*)(P.ws + st_base(X));
    unsigned char* Y = P.ws + WS_Y;        const float* nw = P.in[8] + l * 64;
    LAS unsigned char* s_l = X.lds + X.wave * (2 * 64 * HP); LAS unsigned char* v_l = s_l + 64 * HP;
    const int lane = X.lane, g = lane >> 4, i16 = lane & 15, gw = X.wave * X.nb + X.bid, NGW = X.nb * NWAVES;
    const int nchunk = l == 0 ? 132 : 128;
    const int troff = (8 * g + (i16 >> 2)) * HP + (i16 & 3) * 8;
    const int troff4 = (4 * g + (i16 >> 2)) * HP + (i16 & 3) * 8;
    (void)gw; (void)NGW;
    if (it < 8 * nchunk) {
        const int c = it % nchunk, bh = it / nchunk, h = bh & 3, b = bh >> 2;
        const bool isctx = c >= 128; const int row0 = isctx ? NLAT + b * CTXL + 64 * (c - 128) : b * SEQ + 64 * c;
#pragma unroll
        for (int i = 0; i < 8; ++i) { const int r = i * 8 + (lane >> 3), pc = lane & 7; const u32x4 w = *(const u32x4*)(PB + (size_t)(row0 + r) * PBW + PB_AI + h * 64 + pc * 8); *(LAS u32x4*)(v_l + r * HP + pc * 16) = w; }
        f32x4 o[4][4];
#pragma unroll
        for (int a = 0; a < 4; ++a)
#pragma unroll
            for (int t = 0; t < 4; ++t) o[a][t] = (f32x4){0.f, 0.f, 0.f, 0.f};
#pragma unroll 1
        for (int dir = 0; dir < 2; ++dir) {
#if DBG_HG_MODE & 2
            if (dir == 1) continue;
#endif
#if DBG_HG_MODE & 4
            if (dir == 0) continue;
#endif
            const int p = isctx ? (dir ? 3 - (c - 128) : c - 128) : (dir ? 127 - c + 4 : c + 4);
            const int slot = ((b * 4 + h) * 2 + dir) * NCHAIN + p, sgn = 1 - 2 * dir;
            asm volatile("s_waitcnt lgkmcnt(0)" ::: "memory");
#pragma unroll
            for (int i = 0; i < 8; ++i) { const int r = i * 8 + (lane >> 3), pc = lane & 7; const u32x4 w = *(const u32x4*)(ST + (size_t)slot * 4096 + r * 64 + pc * 8); *(LAS u32x4*)(s_l + r * HP + pc * 16) = w; }
            const bf16_t* qt = QT + ((size_t)dir * NROWS + row0) * 256 + h * 64 + g * 8; const bf16_t* kt = KT + ((size_t)dir * NROWS + row0) * 256 + h * 64 + g * 8;
            bf16x8 qf[4][2];
#pragma unroll
            for (int t = 0; t < 4; ++t)
#pragma unroll
                for (int ks = 0; ks < 2; ++ks) qf[t][ks] = *(const bf16x8*)(qt + (size_t)(16 * t + i16) * 256 + 32 * ks);
#pragma unroll
            for (int pr = 0; pr < 2; ++pr) {
                bf16x8 kf[2][2];
#pragma unroll
                for (int t = 0; t < 2; ++t)
#pragma unroll
                    for (int ks = 0; ks < 2; ++ks) kf[t][ks] = *(const bf16x8*)(kt + (size_t)(16 * (2 * pr + t) + i16) * 256 + 32 * ks);
                f32x4 sc[2][4];
#pragma unroll
                for (int s2 = 0; s2 < 2; ++s2)
#pragma unroll
                    for (int tt = 0; tt < 4; ++tt) { f32x4 a = {0.f, 0.f, 0.f, 0.f};
                        a = __builtin_amdgcn_mfma_f32_16x16x32_bf16(kf[s2][0], qf[tt][0], a, 0, 0, 0); a = __builtin_amdgcn_mfma_f32_16x16x32_bf16(kf[s2][1], qf[tt][1], a, 0, 0, 0);
#pragma unroll
                        for (int r = 0; r < 4; ++r) { const int sidx = 16 * (2 * pr + s2) + 4 * g + r, tidx = 16 * tt + i16; const int keep = ~(((tidx - sidx) * sgn) >> 31); { const float av = a[r]; a[r] = __int_as_float(__float_as_int(av) & keep); } }
                        sc[s2][tt] = a; }
                bf16x8 vf[4];
#pragma unroll
#ifdef DBG_NO_TR
                for (int et = 0; et < 4; ++et) { unsigned short tv[8];
#pragma unroll
                    for (int j = 0; j < 8; ++j) { const int sidx = 32 * pr + (j < 4 ? 4 * g + j : 16 + 4 * g + (j - 4)); tv[j] = *(const LAS unsigned short*)(v_l + sidx * HP + (16 * et + i16) * 2); }
                    u32x4 w; w.x = tv[0] | ((unsigned)tv[1] << 16); w.y = tv[2] | ((unsigned)tv[3] << 16); w.z = tv[4] | ((unsigned)tv[5] << 16); w.w = tv[6] | ((unsigned)tv[7] << 16); vf[et] = __builtin_bit_cast(bf16x8, w); }
#else
                for (int et = 0; et < 4; ++et) vf[et] = cat8(tr_read(v_l + troff4 + (32 * pr) * HP + et * 32), tr_read(v_l + troff4 + (32 * pr + 16) * HP + et * 32));
#endif
#ifdef DBG_BRUTE
                {   float* dacc = (float*)(P.ws + WS_CTL) + CW_DBG + 16; float nA = 0.f, dA = 0.f, nB = 0.f, dB = 0.f;
                    const bf16_t* qt0 = QT + ((size_t)dir * NROWS + row0) * 256 + h * 64; const bf16_t* kt0 = KT + ((size_t)dir * NROWS + row0) * 256 + h * 64;
#if DBG_TEST == 1
#pragma unroll
                    for (int s2 = 0; s2 < 2; ++s2)
#pragma unroll
                        for (int tt = 0; tt < 4; ++tt)
#pragma unroll
                            for (int r = 0; r < 4; ++r) *(LAS float*)(s_l + (((s2 * 4 + tt) * 4 + r) * 64 + lane) * 4) = sc[s2][tt][r];
                    asm volatile("s_waitcnt lgkmcnt(0)" ::: "memory");
#pragma unroll 1
                    for (int idx = 0; idx < 32; ++idx) { const int s2 = idx >> 4, tt = (idx >> 2) & 3, r = idx & 3; const int sidx = 16 * (2 * pr + s2) + 4 * g + r, tidx = 16 * tt + i16; float ref = 0.f;
#pragma unroll 1
                        for (int d = 0; d < 64; ++d) ref += bf2f(kt0[(size_t)sidx * 256 + d]) * bf2f(qt0[(size_t)tidx * 256 + d]);
                        if (sidx > tidx) ref = 0.f; const float got = *(LAS float*)(s_l + (idx * 64 + lane) * 4); const float df = got - ref; nA += df * df; dA += ref * ref; }
#endif
#if DBG_TEST == 2
#pragma unroll
                    for (int et = 0; et < 4; ++et)
#pragma unroll
                        for (int j = 0; j < 8; ++j) { const int sidx = 32 * pr + (j < 4 ? 4 * g + j : 16 + 4 * g + (j - 4)); const float ref = bf2f(PB[(size_t)(row0 + sidx) * PBW + PB_AI + h * 64 + 16 * et + i16]);
                            const float got = bf2f((unsigned short)vf[et][j]); const float df = got - ref; nB += df * df; dB += ref * ref; asm volatile("" : "+v"(nB), "+v"(dB) :: "memory"); }
#endif
                    nA = wave_sum(nA); dA = wave_sum(dA); nB = wave_sum(nB); dB = wave_sum(dB); if (lane == 0) { atomicAdd(dacc, nA); atomicAdd(dacc + 1, dA); atomicAdd(dacc + 2, nB); atomicAdd(dacc + 3, dB); }
                }
#endif
#pragma unroll
                for (int tt = 0; tt < 4; ++tt) { const f32x4 p0 = sc[0][tt], p1 = sc[1][tt]; const bf16x8 pf = pack8(p0[0], p0[1], p0[2], p0[3], p1[0], p1[1], p1[2], p1[3]);
#pragma unroll
                    for (int et = 0; et < 4; ++et) o[et][tt] = __builtin_amdgcn_mfma_f32_16x16x32_bf16(vf[et], pf, o[et][tt], 0, 0, 0); }
                asm volatile("" ::: "memory");
            }
#pragma unroll
            for (int ks = 0; ks < ((DBG_HG_MODE & 1) ? 0 : 2); ++ks) {
                bf16x8 sf[4];
#pragma unroll
                for (int et = 0; et < 4; ++et) sf[et] = cat8(tr_read(s_l + troff + (32 * ks) * HP + et * 32), tr_read(s_l + troff + (32 * ks + 4) * HP + et * 32));
#pragma unroll
                for (int tt = 0; tt < 4; ++tt)
#pragma unroll
                    for (int et = 0; et < 4; ++et) o[et][tt] = __builtin_amdgcn_mfma_f32_16x16x32_bf16(sf[et], qf[tt][ks], o[et][tt], 0, 0, 0);
            }
        }
#if defined(DBG_BRUTE) && DBG_TEST == 3
        {
            float* dacc = (float*)(P.ws + WS_CTL) + CW_DBG + 8; float num = 0.f, den = 0.f;
            const bf16_t* qt0 = QT + ((size_t)0 * NROWS + row0) * 256 + h * 64; const bf16_t* kt0 = KT + ((size_t)0 * NROWS + row0) * 256 + h * 64;
            for (int tt = 0; tt < 4; ++tt) for (int et = 0; et < 4; ++et) for (int r = 0; r < 4; ++r) {
                const int t = 16 * tt + i16, e = 16 * et + 4 * g + r; float ref = 0.f;
                for (int s2 = 0; s2 <= t; ++s2) { float sc = 0.f; for (int d = 0; d < 64; ++d) sc += bf2f(kt0[(size_t)s2 * 256 + d]) * bf2f(qt0[(size_t)t * 256 + d]);
                    ref += bf2f((unsigned short)f2bf(sc)) * bf2f(PB[(size_t)(row0 + s2) * PBW + PB_AI + h * 64 + e]); }
                float got = 0.f;
#pragma unroll
                for (int a = 0; a < 4; ++a)
#pragma unroll
                    for (int b2 = 0; b2 < 4; ++b2)
#pragma unroll
                        for (int c2 = 0; c2 < 4; ++c2) if (a == tt && b2 == et && c2 == r) got = o[b2][a][c2];
                num += (got - ref) * (got - ref); den += ref * ref; }
            num = wave_sum(num); den = wave_sum(den); if (lane == 0) { atomicAdd(dacc, num); atomicAdd(dacc + 1, den); }
        }
#endif
#pragma unroll
        for (int tt = 0; tt < 4; ++tt) {
            float ss = 0.f;
#pragma unroll
            for (int et = 0; et < 4; ++et) ss += (o[et][tt][0] * o[et][tt][0] + o[et][tt][1] * o[et][tt][1]) + (o[et][tt][2] * o[et][tt][2] + o[et][tt][3] * o[et][tt][3]);
            ss += __shfl_xor(ss, 16); ss += __shfl_xor(ss, 32);
            const float rstd = 1.0f / sqrtf(ss * (1.0f / 64.0f) + RMS_EPS);
            const size_t row = (size_t)row0 + 16 * tt + i16;
#pragma unroll
            for (int et = 0; et < 4; ++et) { const int e = 16 * et + 4 * g; const u32x2 gw2 = *(const u32x2*)(PB + row * PBW + PB_AG + h * 64 + e); const f32x4 wv = *(const f32x4*)(nw + e);
                const f32x4 gt = {bflo(gw2.x), bfhi(gw2.x), bflo(gw2.y), bfhi(gw2.y)}; f32x4 y;
#pragma unroll
                for (int r = 0; r < 4; ++r) y[r] = o[et][tt][r] * rstd * wv[r] * siluf_(gt[r]);
                *(unsigned*)(Y + row * D + h * 64 + e) = pk_fp8x4(y); }
        }
        asm volatile("s_waitcnt lgkmcnt(0)" ::: "memory");
    }
}


DI void ph_hgrn_out(const Ctx& X, const Params& P, int l) { const int n = 8 * (l == 0 ? 132 : 128); for (int it = X.wave * X.nb + X.bid; it < n; it += X.nb * NWAVES) hgrn_out_item(X, P, l, it); }

#ifdef DBG_BRUTE
DI void ph_dbg_scores(const Ctx& X, const Params& P, int l) {
    const bf16_t* QT = (const bf16_t*)(P.ws + WS_QT); const bf16_t* KT = (const bf16_t*)(P.ws + WS_KT);
    LAS unsigned char* s_l = X.lds + X.wave * (2 * 64 * HP);
    const int lane = X.lane, g = lane >> 4, i16 = lane & 15, gw = X.wave * X.nb + X.bid, NGW = X.nb * NWAVES;
    float* dacc = (float*)(P.ws + WS_CTL) + CW_DBG + 16; float nA = 0.f, dA = 0.f;
    for (int it = gw; it < 8 * 128; it += NGW) {
        const int c = it % 128, bh = it / 128, h = bh & 3, b = bh >> 2, dir = 0, sgn = 1; const int row0 = b * SEQ + 64 * c;
        const bf16_t* qt = QT + ((size_t)dir * NROWS + row0) * 256 + h * 64 + g * 8; const bf16_t* kt = KT + ((size_t)dir * NROWS + row0) * 256 + h * 64 + g * 8;
        const bf16_t* qt0 = QT + ((size_t)dir * NROWS + row0) * 256 + h * 64; const bf16_t* kt0 = KT + ((size_t)dir * NROWS + row0) * 256 + h * 64;
        bf16x8 qf[4][2];
#pragma unroll
        for (int t = 0; t < 4; ++t)
#pragma unroll
            for (int ks = 0; ks < 2; ++ks) qf[t][ks] = *(const bf16x8*)(qt + (size_t)(16 * t + i16) * 256 + 32 * ks);
#pragma unroll 1
        for (int pr = 0; pr < 2; ++pr) {
            bf16x8 kf[2][2];
#pragma unroll
            for (int t = 0; t < 2; ++t)
#pragma unroll
                for (int ks = 0; ks < 2; ++ks) kf[t][ks] = *(const bf16x8*)(kt + (size_t)(16 * (2 * pr + t) + i16) * 256 + 32 * ks);
#pragma unroll
            for (int s2 = 0; s2 < 2; ++s2)
#pragma unroll
                for (int tt = 0; tt < 4; ++tt) { f32x4 a = {0.f, 0.f, 0.f, 0.f};
                    a = __builtin_amdgcn_mfma_f32_16x16x32_bf16(kf[s2][0], qf[tt][0], a, 0, 0, 0); a = __builtin_amdgcn_mfma_f32_16x16x32_bf16(kf[s2][1], qf[tt][1], a, 0, 0, 0);
#pragma unroll
                    for (int r = 0; r < 4; ++r) { const int sidx = 16 * (2 * pr + s2) + 4 * g + r, tidx = 16 * tt + i16; const int keep = ~(((tidx - sidx) * sgn) >> 31); { const float av = a[r]; a[r] = __int_as_float(__float_as_int(av) & keep); }
                        *(LAS float*)(s_l + (((s2 * 4 + tt) * 4 + r) * 64 + lane) * 4) = a[r]; } }
            asm volatile("s_waitcnt lgkmcnt(0)" ::: "memory");
#pragma unroll 1
            for (int idx = 0; idx < 32; ++idx) { const int s2 = idx >> 4, tt = (idx >> 2) & 3, r = idx & 3; const int sidx = 16 * (2 * pr + s2) + 4 * g + r, tidx = 16 * tt + i16; float ref = 0.f;
#pragma unroll 1
                for (int d = 0; d < 64; ++d) ref += bf2f(kt0[(size_t)sidx * 256 + d]) * bf2f(qt0[(size_t)tidx * 256 + d]);
                if (sidx > tidx) ref = 0.f; const float got = *(LAS float*)(s_l + (idx * 64 + lane) * 4); const float df = got - ref; nA += df * df; dA += ref * ref; }
            asm volatile("s_waitcnt lgkmcnt(0)" ::: "memory");
        }
    }
    nA = wave_sum(nA); dA = wave_sum(dA); if (lane == 0) { atomicAdd(dacc, nA); atomicAdd(dacc + 1, dA); }
}
#endif
constexpr int KP = 144, VP = 192, KBYTES = 128 * KP, VBYTES = 128 * VP, CHB = KBYTES + VBYTES, RPB_OFF = 2 * CHB;
static_assert(RPB_OFF + 4096 <= 144 * 1024, "attn lds");
struct ChunkSrc { int mode, rbase, kr0; };
DI int chunk_row(const ChunkSrc& c, int key) { return c.mode == 0 ? c.rbase + key : c.rbase + min(c.kr0 + (key >> 5), 127) * 64 + (key & 31); }
struct StageRegs { u32x4 k[2], v[2]; };
DI void stage_load(const Ctx& X, const bf16_t* PB, int kcol, int vcol, const ChunkSrc& c, StageRegs& R) {
#pragma unroll
    for (int i = 0; i < 2; ++i) { const int idx = X.tid + NTHREADS * i, key = idx >> 3, pc = idx & 7; const size_t row = (size_t)chunk_row(c, key);
        R.k[i] = *(const u32x4*)(PB + row * PBW + kcol + pc * 8); R.v[i] = *(const u32x4*)(PB + row * PBW + vcol + pc * 8); }
}
DI void stage_store(const Ctx& X, LAS unsigned char* buf, const StageRegs& R) {
#pragma unroll
    for (int i = 0; i < 2; ++i) { const int idx = X.tid + NTHREADS * i, key = idx >> 3, pc = idx & 7;
        *(LAS u32x4*)(buf + key * KP + pc * 16) = R.k[i]; *(LAS u32x4*)(buf + KBYTES + key * VP + pc * 16) = R.v[i]; }
}
template <int NQT> struct AttnState { f32x16 o[NQT][2]; float m[NQT], l[NQT]; };
template <int NQT, class MaskF>
DI void attn_tile_kv(const bf16x8 (&kf)[4], const LAS unsigned char* vt, int kt, const bf16x8 (&qf)[NQT][4], AttnState<NQT>& S, const bool (&act)[NQT], const MaskF& MF, int lane) {
    const int h = lane >> 5, G = lane >> 4, i16 = lane & 15;
    const LAS unsigned char* vb = vt + (4 * h + (i16 >> 2)) * VP + (16 * (G & 1) + 4 * (i16 & 3)) * 2;
    bf16x8 vf[2][2];
#pragma unroll
    for (int db = 0; db < 2; ++db)
#pragma unroll
        for (int s2 = 0; s2 < 2; ++s2) vf[db][s2] = cat8(tr_read(vb + (16 * s2) * VP + db * 64), tr_read(vb + (16 * s2 + 8) * VP + db * 64));
#pragma unroll
    for (int qt = 0; qt < NQT; ++qt) {
        if (!act[qt]) continue;
        f32x16 s;
#pragma unroll
        for (int r = 0; r < 16; ++r) s[r] = 0.f;
#pragma unroll
        for (int ks = 0; ks < 4; ++ks) s = __builtin_amdgcn_mfma_f32_32x32x16_bf16(kf[ks], qf[qt][ks], s, 0, 0, 0);
        MF(s, qt, kt);
        float mx = s[0];
#pragma unroll
        for (int r = 1; r < 16; ++r) mx = fmaxf(mx, s[r]);
        { const auto rr = __builtin_amdgcn_permlane32_swap(__float_as_uint(mx), __float_as_uint(mx), false, false); mx = fmaxf(__uint_as_float(rr[0]), __uint_as_float(rr[1])); }
        {
            const float mn = fmaxf(S.m[qt], mx), alpha = __builtin_amdgcn_exp2f(S.m[qt] - mn); S.m[qt] = mn; S.l[qt] *= alpha;
#pragma unroll
            for (int db = 0; db < 2; ++db)
#pragma unroll
                for (int r = 0; r < 16; ++r) S.o[qt][db][r] *= alpha;
        }
        const float mcur = S.m[qt]; float ps = 0.f;
#pragma unroll
        for (int r = 0; r < 16; ++r) { s[r] = __builtin_amdgcn_exp2f(s[r] - mcur); ps += s[r]; }
        S.l[qt] += ps;
        const bf16x8 p0 = pack8(s[0], s[1], s[2], s[3], s[4], s[5], s[6], s[7]), p1 = pack8(s[8], s[9], s[10], s[11], s[12], s[13], s[14], s[15]);
#pragma unroll
        for (int db = 0; db < 2; ++db) { S.o[qt][db] = __builtin_amdgcn_mfma_f32_32x32x16_bf16(vf[db][0], p0, S.o[qt][db], 0, 0, 0); S.o[qt][db] = __builtin_amdgcn_mfma_f32_32x32x16_bf16(vf[db][1], p1, S.o[qt][db], 0, 0, 0); }
    }
}
template <int NQT, class MaskF>
DI void attn_tile(const LAS unsigned char* buf, int kt, const bf16x8 (&qf)[NQT][4], AttnState<NQT>& S, const bool (&act)[NQT], const MaskF& MF, int lane) {
    bf16x8 kf[4];
#pragma unroll
    for (int ks = 0; ks < 4; ++ks) kf[ks] = *(const LAS bf16x8*)(buf + (32 * kt + (lane & 31)) * KP + ks * 32 + (lane >> 5) * 16);
    attn_tile_kv<NQT, MaskF>(kf, buf + KBYTES + 32 * kt * VP, kt, qf, S, act, MF, lane);
}
template <int NQT>
DI void attn_finish(AttnState<NQT>& S, int qt, unsigned char* yrow  , int lane) {
    const int h = lane >> 5; float l = S.l[qt]; { const auto rr = __builtin_amdgcn_permlane32_swap(__float_as_uint(l), __float_as_uint(l), false, false); l = __uint_as_float(rr[0]) + __uint_as_float(rr[1]); } const float inv = 1.0f / l;
#pragma unroll
    for (int db = 0; db < 2; ++db)
#pragma unroll
        for (int gq = 0; gq < 4; ++gq) *(unsigned*)(yrow + 32 * db + 8 * gq + 4 * h) = pk_fp8x4((f32x4){S.o[qt][db][4 * gq] * inv, S.o[qt][db][4 * gq + 1] * inv, S.o[qt][db][4 * gq + 2] * inv, S.o[qt][db][4 * gq + 3] * inv});
}
struct MaskNone { DI void operator()(f32x16&, int, int) const {} };
struct MaskSWA { int cmode, u0, lane;
    DI void operator()(f32x16& s, int qt, int kt) const {
        if (cmode == 1 || 32 * kt != u0 + 32 * qt) return;
        const int sg = cmode == 0 ? 1 : -1, e = sg * (4 * (lane >> 5) - (lane & 31));
#pragma unroll
        for (int r = 0; r < 16; ++r) { const int thr = -sg * ((r & 3) + 8 * (r >> 2)); s[r] = e >= thr ? s[r] : -1e30f; }
    } };
DI void swa_item(const Ctx& X, const Params& P, int l, int it) {
    const bf16_t* PB = (const bf16_t*)(P.ws + WS_PB); unsigned char* Y = P.ws + WS_Y;        const float* sink = P.in[10] + l * 8;
    const int lane = X.lane, w = X.wave;
    {
        const int j = it & 63, n = (it >> 6) & 1, b = it >> 7;
        const int qh = n * 4 + (w >> 1), u0 = (w & 1) * 64;
        const int nchunks = 3 + (j > 0) + (j < 63);
        bf16x8 qf[2][4];
#pragma unroll
        for (int qt = 0; qt < 2; ++qt)
#pragma unroll
            for (int ks = 0; ks < 4; ++ks) qf[qt][ks] = *(const bf16x8*)(PB + (size_t)(b * SEQ + 128 * j + u0 + 32 * qt + (lane & 31)) * PBW + PB_SQ + qh * 64 + 16 * ks + 8 * (lane >> 5));
        AttnState<2> S;
#pragma unroll
        for (int qt = 0; qt < 2; ++qt) { S.m[qt] = LOG2E * sink[qh]; S.l[qt] = lane < 32 ? 1.0f : 0.0f;
#pragma unroll
            for (int db = 0; db < 2; ++db)
#pragma unroll
                for (int r = 0; r < 16; ++r) S.o[qt][db][r] = 0.f; }
        StageRegs R;
        auto chunk_id = [&](int i) -> int { return i < 2 ? 3 + i : (i == 2 ? 1 : (i == 3 ? (j > 0 ? 0 : 2) : 2)); };
        auto chunk_src = [&](int c) -> ChunkSrc { ChunkSrc cs; cs.mode = 0; cs.kr0 = 0; cs.rbase = c < 3 ? b * SEQ + 128 * (j - 1 + c) : NLAT + b * CTXL + 128 * (c - 3); return cs; };
        stage_load(X, PB, PB_SK + n * 64, PB_SV + n * 64, chunk_src(chunk_id(0)), R);
#pragma unroll
        for (int qt = 0; qt < 2; ++qt)
#pragma unroll
            for (int ks = 0; ks < 4; ++ks) asm volatile("" : "+v"(qf[qt][ks]));
        stage_store(X, X.lds, R);
        __syncthreads();
        for (int i = 0; i < nchunks; ++i) {
            const int c = chunk_id(i);
            if (i + 1 < nchunks) stage_load(X, PB, PB_SK + n * 64, PB_SV + n * 64, chunk_src(chunk_id(i + 1)), R);
            const LAS unsigned char* buf = X.lds + (i & 1) * CHB;
            MaskSWA MF; MF.cmode = c == 0 ? 0 : (c == 2 ? 2 : 1); MF.u0 = u0; MF.lane = lane;
#pragma unroll 1
            for (int kt = 0; kt < 4; ++kt) {
                bool act[2];
#pragma unroll
                for (int qt = 0; qt < 2; ++qt) act[qt] = c == 0 ? (32 * kt + 31 >= u0 + 32 * qt) : (c == 2 ? (32 * kt <= u0 + 32 * qt + 31) : true);
                if (!(act[0] || act[1])) continue;
                attn_tile<2>(buf, kt, qf, S, act, MF, lane);
            }
            if (i + 1 < nchunks) stage_store(X, X.lds + ((i + 1) & 1) * CHB, R);
            __syncthreads();
        }
#pragma unroll
        for (int qt = 0; qt < 2; ++qt) attn_finish<2>(S, qt, Y + (size_t)(b * SEQ + 128 * j + u0 + 32 * qt + (lane & 31)) * D + 512 + qh * 64, lane);
    }
}
struct MaskNA { bool win; int kr0, qr, qc, rs, cs, blk, lane; const LAS float* rpb;
    DI void operator()(f32x16& s, int qt, int kt) const {
        if (!win) return;
        const int kr = kr0 + kt; const bool rowok = kr >= rs && kr < rs + 8;
        const int kcb = blk + 4 * (lane >> 5); const int ib = rowok ? (kr - qr + 7) * 31 + (kcb - qc + 15) : 0;
        float bv[16];
#pragma unroll
        for (int r = 0; r < 16; ++r) bv[r] = rpb[ib + (r & 3) + 8 * (r >> 2)];
        asm volatile("" : "+v"(bv[0]), "+v"(bv[1]), "+v"(bv[2]), "+v"(bv[3]), "+v"(bv[4]), "+v"(bv[5]), "+v"(bv[6]), "+v"(bv[7]), "+v"(bv[8]), "+v"(bv[9]), "+v"(bv[10]), "+v"(bv[11]), "+v"(bv[12]), "+v"(bv[13]), "+v"(bv[14]), "+v"(bv[15]));
        const unsigned t0 = rowok ? (unsigned)(kcb - cs) : 0x7fffff00u;
#pragma unroll
        for (int r = 0; r < 16; ++r) { const bool ok = t0 + (unsigned)((r & 3) + 8 * (r >> 2)) < 16u; s[r] = ok ? s[r] + bv[r] : -1e30f; }
    } };
struct NaTileRegs { bf16x8 k[4]; u32x4 v[4]; };
DI void na_load(const bf16_t* PB, int h, int rowk  , int rowv  , int lane, NaTileRegs& R) {
    const bf16_t* kp = PB + (size_t)rowk * PBW + PB_NK + h * 64 + 8 * (lane >> 5);
#pragma unroll
    for (int ks = 0; ks < 4; ++ks) R.k[ks] = *(const bf16x8*)(kp + 16 * ks);
    const bf16_t* vp = PB + (size_t)rowv * PBW + PB_NV + h * 64 + (lane & 1) * 32;
#pragma unroll
    for (int i = 0; i < 4; ++i) R.v[i] = *(const u32x4*)(vp + 8 * i);
}
DI void na_item(const Ctx& X, const Params& P, int l, int it) {
    const bf16_t* PB = (const bf16_t*)(P.ws + WS_PB); unsigned char* Y = P.ws + WS_Y;        const float* rpbg = P.in[9] + l * 4 * 465;
    const int lane = X.lane, w = X.wave; LAS float* rpbl = (LAS float*)(X.lds + 8 * 32 * VP) + 32;
    LAS unsigned char* vt = X.lds + w * (32 * VP);
    const int j = it & 3, rg = (it >> 2) & 7, h = (it >> 5) & 3, b = it >> 7;
    const int r0 = 16 * rg, blk = min(max(16 * j - 8, 0), 32);
    const int ra = r0 + 2 * w, qr = ra + ((lane & 31) >> 4), qc = 16 * j + (lane & 15);
    const int rs_a = min(max(ra - 4, 0), 120), rs_b = min(max(ra + 1 - 4, 0), 120), ntile = 8 + (rs_b + 8 - rs_a);
    for (int i = X.tid; i < 465; i += NTHREADS) rpbl[i] = LOG2E * rpbg[h * 465 + i];
    __syncthreads();
    bf16x8 qf[1][4];
#pragma unroll
    for (int ks = 0; ks < 4; ++ks) qf[0][ks] = *(const bf16x8*)(PB + (size_t)(b * SEQ + qr * 64 + qc) * PBW + PB_NQ + h * 64 + 16 * ks + 8 * (lane >> 5));
    AttnState<1> S; S.m[0] = -1e30f; S.l[0] = 0.f;
#pragma unroll
    for (int db = 0; db < 2; ++db)
#pragma unroll
        for (int r = 0; r < 16; ++r) S.o[0][db][r] = 0.f;
    MaskNA MF; MF.qr = qr; MF.qc = qc; MF.rs = min(max(qr - 4, 0), 120); MF.cs = min(max(qc - 8, 0), 48); MF.blk = blk; MF.lane = lane; MF.rpb = rpbl;
    const bool act[1] = {true};
#define NA_ROW(t, key) ((t) < 8 ? NLAT + b * CTXL + 32 * (t) + (key) : b * SEQ + (rs_a + (t) - 8) * 64 + blk + (key))
#define NA_LOAD(t, R) na_load(PB, h, NA_ROW(t, lane & 31), NA_ROW(t, lane >> 1), lane, R)
#define NA_COMPUTE(t, R) do { asm volatile("" ::: "memory"); _Pragma("unroll") for (int i_ = 0; i_ < 4; ++i_) *(LAS u32x4*)(vt + (lane >> 1) * VP + (lane & 1) * 64 + i_ * 16) = R.v[i_]; \
        asm volatile("" ::: "memory"); MF.win = (t) >= 8; MF.kr0 = rs_a + (t) - 8; attn_tile_kv<1>(R.k, vt, 0, qf, S, act, MF, lane); asm volatile("" ::: "memory"); } while (0)
    NaTileRegs RA, RB;
    NA_LOAD(0, RA);
#pragma unroll
    for (int ks = 0; ks < 4; ++ks) asm volatile("" : "+v"(qf[0][ks]));
    for (int t = 0; t < ntile; t += 2) {
        { const int tn = min(t + 1, ntile - 1); NA_LOAD(tn, RB); }
        NA_COMPUTE(t, RA);
        { const int tn = min(t + 2, ntile - 1); NA_LOAD(tn, RA); }
        if (t + 1 < ntile) NA_COMPUTE(t + 1, RB);
    }
#undef NA_ROW
#undef NA_LOAD
#undef NA_COMPUTE
    attn_finish<1>(S, 0, Y + (size_t)(b * SEQ + qr * 64 + qc) * D + 256 + h * 64, lane);
    __syncthreads();
}
DI void ctx_attn_item(const Ctx& X, const Params& P, int l, int it) {
    const bf16_t* PB = (const bf16_t*)(P.ws + WS_PB); unsigned char* Y = P.ws + WS_Y;        const float* sink = P.in[10] + l * 8;
    const int lane = X.lane, w = X.wave;
    {
        const bool swa = it >= 8; const int b = (it >> 2) & 1;
        const int h = it & 3, n = (it >> 1) & 1, half = it & 1;
        const int kcol = swa ? PB_SK + n * 64 : PB_NK + h * 64, vcol = swa ? PB_SV + n * 64 : PB_NV + h * 64;
        StageRegs R; ChunkSrc cs; cs.mode = 0; cs.kr0 = 0; cs.rbase = NLAT + b * CTXL;
        stage_load(X, PB, kcol, vcol, cs, R); stage_store(X, X.lds, R);
        cs.rbase += 128; stage_load(X, PB, kcol, vcol, cs, R); stage_store(X, X.lds + CHB, R);
        __syncthreads();
        const MaskNone MF;
        if (!swa) {
            const int qrow = NLAT + b * CTXL + 32 * w + (lane & 31);
            bf16x8 qf[1][4];
#pragma unroll
            for (int ks = 0; ks < 4; ++ks) qf[0][ks] = *(const bf16x8*)(PB + (size_t)qrow * PBW + PB_NQ + h * 64 + 16 * ks + 8 * (lane >> 5));
            AttnState<1> S; S.m[0] = -1e30f; S.l[0] = 0.f;
#pragma unroll
            for (int db = 0; db < 2; ++db)
#pragma unroll
                for (int r = 0; r < 16; ++r) S.o[0][db][r] = 0.f;
            const bool act[1] = {true};
#pragma unroll 1
            for (int kt = 0; kt < 8; ++kt) attn_tile<1>(X.lds + (kt >> 2) * CHB, kt & 3, qf, S, act, MF, lane);
            attn_finish<1>(S, 0, Y + (size_t)qrow * D + 256 + h * 64, lane);
        } else {
            const int qh = n * 4 + half * 2 + (w >> 2), q0 = NLAT + b * CTXL + (w & 3) * 64 + (lane & 31);
            bf16x8 qf[2][4];
#pragma unroll
            for (int qt = 0; qt < 2; ++qt)
#pragma unroll
                for (int ks = 0; ks < 4; ++ks) qf[qt][ks] = *(const bf16x8*)(PB + (size_t)(q0 + 32 * qt) * PBW + PB_SQ + qh * 64 + 16 * ks + 8 * (lane >> 5));
            AttnState<2> S;
#pragma unroll
            for (int qt = 0; qt < 2; ++qt) { S.m[qt] = LOG2E * sink[qh]; S.l[qt] = lane < 32 ? 1.0f : 0.0f;
#pragma unroll
                for (int db = 0; db < 2; ++db)
#pragma unroll
                    for (int r = 0; r < 16; ++r) S.o[qt][db][r] = 0.f; }
            const bool act[2] = {true, true};
#pragma unroll 1
            for (int kt = 0; kt < 8; ++kt) attn_tile<2>(X.lds + (kt >> 2) * CHB, kt & 3, qf, S, act, MF, lane);
#pragma unroll
            for (int qt = 0; qt < 2; ++qt) attn_finish<2>(S, qt, Y + (size_t)(q0 + 32 * qt) * D + 512 + qh * 64, lane);
        }
        __syncthreads();
    }
}

DI void ph_swa(const Ctx& X, const Params& P, int l) { for (int it = X.bid; it < 256; it += X.nb) swa_item(X, P, l, it); }
DI void ph_na(const Ctx& X, const Params& P, int l) { for (int it = X.bid; it < 256; it += X.nb) na_item(X, P, l, it); }
DI void queue_publish(const Ctx& X, unsigned* cnt) {
    asm volatile("s_waitcnt vmcnt(0)" ::: "memory");
    __syncthreads();
    if (X.tid == 0) { __builtin_amdgcn_fence(__ATOMIC_RELEASE, "agent"); asm volatile("s_waitcnt vmcnt(0)" ::: "memory"); __hip_atomic_fetch_add(cnt, 1u, __ATOMIC_RELAXED, __HIP_MEMORY_SCOPE_AGENT); }
}
DI void queue_wait(const Ctx& X, unsigned* cnt, unsigned need) {
    if (X.tid == 0) { unsigned sp = 0; while (__hip_atomic_load(cnt, __ATOMIC_RELAXED, __HIP_MEMORY_SCOPE_AGENT) < need && ++sp < (1u << 24)) __builtin_amdgcn_s_sleep(2);
        __builtin_amdgcn_fence(__ATOMIC_ACQUIRE, "agent"); asm volatile("s_waitcnt vmcnt(0)" ::: "memory"); }
    __syncthreads();
}
DI void ph_mix_queue(const Ctx& X, const Params& P, int l, int rep = 0) {
    unsigned* ctl = (unsigned*)(P.ws + WS_CTL);
    unsigned* head = ctl + CW_Q + 64 * l + 128 * rep; unsigned* scan_cnt = ctl + CW_SCAN + 64 * l + 256 * rep; unsigned* loc_cnt = ctl + CW_SCAN + 128 + 64 * l + 256 * rep;
    volatile LAS unsigned* slot = (volatile LAS unsigned*)(X.lds + 144 * 1024 + 64);
    const int nloc = 264, nscan = 64, nctx = l == 0 ? 16 : 0, nconv = l == 0 ? 1536 : 0, nho = l == 0 ? 132 : 128;
    const int o_ctx = nloc, o_swa = o_ctx + nctx, o_scan = o_swa + 256, o_na = o_scan + nscan, o_conv = o_na + 256, o_ho = o_conv + nconv, total = o_ho + nho;
    bool scan_ok = false;
    for (;;) {
        if (X.tid == 0) *slot = atomicAdd(head, 1u);
        __syncthreads();
        int it = (int)*slot;
        __syncthreads();
        if (it >= total) break;
        if (nconv && it >= o_swa && it < o_ho) {
            const int j = it - o_swa, per = j / 11, ph = j - per * 11;
            it = (ph & 3) == 0 ? o_swa + per * 3 + (ph >> 2) : o_conv + per * 8 + (ph - 1 - (ph > 4) - (ph > 8));
        }
        Ctx Xi = X; { int wv = X.wave; asm volatile("" : "+s"(wv)); int ln; asm volatile("v_mbcnt_lo_u32_b32 %0, -1, 0\n\tv_mbcnt_hi_u32_b32 %0, -1, %0" : "=v"(ln)); Xi.tid = wv * 64 + ln; Xi.lane = ln; Xi.wave = wv; }
        if (it < o_ctx) { hgrn_local_item(Xi, P, l, it * 8 + Xi.wave); queue_publish(Xi, loc_cnt); }
        else if (it < o_swa) ctx_attn_item(Xi, P, l, it - o_ctx);
        else if (it < o_scan) swa_item(Xi, P, l, it - o_swa);
        else if (it < o_na) { queue_wait(Xi, loc_cnt, (unsigned)nloc); ph_hgrn_scan(Xi, P, it - o_scan); queue_publish(Xi, scan_cnt); }
        else if (it < o_conv) na_item(Xi, P, l, it - o_na);
        else if (it < o_ho) { LAS float* scr = (LAS float*)X.lds + X.wave * (64 * 33); const int g = it - o_conv, lyr = g >= 768, f0 = (g - 768 * lyr) * 16 + X.wave;
#define DESC_EQ(i) expert_desc(P, lyr, (i))
            TR_LOOP(DESC_EQ, f0, f0 + 16, 8); __syncthreads(); }
        else { if (!scan_ok) { queue_wait(Xi, scan_cnt, (unsigned)nscan); scan_ok = true; }
            hgrn_out_item(Xi, P, l, (it - o_ho) * 8 + Xi.wave); __syncthreads(); }
    }
}
constexpr size_t WS_Y2 = 284 * MiB;
DI void ph_dbg_copy(const Ctx& X, const Params& P) {
    const u32x4* src = (const u32x4*)(P.ws + WS_Y); u32x4* dst = (u32x4*)(P.ws + WS_Y2);
    for (size_t i = (size_t)X.bid * NTHREADS + X.tid; i < (size_t)NROWS * 128; i += (size_t)X.nb * NTHREADS) dst[i] = src[i];
}
DI void ph_dbg_compare(const Ctx& X, const Params& P) {
    const bf16_t* Yg = (const bf16_t*)(P.ws + WS_Y); const bf16_t* Yf = (const bf16_t*)(P.ws + WS_Y2); float* acc = (float*)(P.ws + WS_CTL) + CW_DBG;
    float num[3] = {0.f, 0.f, 0.f}, den[3] = {0.f, 0.f, 0.f};
    const int gw = X.bid * NWAVES + X.wave, NGW = X.nb * NWAVES;
    for (int row = gw; row < NROWS; row += NGW) {
#pragma unroll
        for (int j = 0; j < 16; ++j) { const int c = j * 64 + X.lane; const float a = bf2f(Yg[(size_t)row * D + c]), b = bf2f(Yf[(size_t)row * D + c]); const float d = a - b;
            const int br = j < 4 ? 0 : (j < 8 ? 1 : 2);
            if (br == 0) { num[0] += d * d; den[0] += a * a; } else if (br == 1) { num[1] += d * d; den[1] += a * a; } else { num[2] += d * d; den[2] += a * a; } }
    }
#pragma unroll
    for (int b = 0; b < 3; ++b) { const float n = wave_sum(num[b]), d = wave_sum(den[b]); if (X.lane == 0) { atomicAdd(acc + 2 * b, n); atomicAdd(acc + 2 * b + 1, d); } }
}
DI void ph_dbg_apply(const Ctx& X, const Params& P) {
    const float* acc = (const float*)(P.ws + WS_CTL) + CW_DBG;
#ifdef DBG_BRUTE
    float code = sqrtf(acc[16] / acc[17]);
#else
    float code = sqrtf(acc[0] / acc[1]);
#endif
    if (code == 0.f) return;
    f32x4* o = (f32x4*)P.out;
    for (size_t i = (size_t)X.bid * NTHREADS + X.tid; i < (size_t)NLAT * 256; i += (size_t)X.nb * NTHREADS) o[i] = o[i] * (1.0f + code);
}

DI void ph_inproj(const Ctx& X, const Params& P, int l) {
    PlainSched S; S.init(NROWS, INW, X.nb, X.bid);
    EpiIn E{(bf16_t*)(P.ws + WS_PB), (bf16_t*)(P.ws + WS_Z), (const float*)(P.ws + WS_ROPE), (const float*)(P.ws + WS_LB) + l * 512, (bf16_t*)(P.ws + WS_KK)};
    gemm_fast<PlainSched, EpiIn, true, 122>(X, P.ws + WS_H, P.ws + WS_WIN + (size_t)l * INW * D, D, S, E);
}
struct EpiNull { DI void group(const Unit&, int, int, f32x4 a0, f32x4 a1, f32x4 b0, f32x4 b1) const { asm volatile("" :: "v"(a0), "v"(a1), "v"(b0), "v"(b1)); } };
DI void ph_inproj_plain(const Ctx& X, const Params& P, int l) {
    PlainSched S; S.init(NROWS, INW, X.nb, X.bid);
    EpiNull E;
    GEMM_IMPL(X, (const bf16_t*)(P.ws + WS_H), (const bf16_t*)(P.ws + WS_WIN) + (size_t)l * INW * D, D, S, E);
}
DI void small_gemm_item(const Ctx& X, const unsigned char* A, const unsigned char* Bt, bf16_t* C, int row0, int col0) {
    const int wm = X.wave >> 2, wn = X.wave & 3, fr = X.lane & 15, fq = X.lane >> 4;
    const unsigned char* ap = A + (size_t)(row0 + 16 * wm + fr) * D + 8 * fq; const unsigned char* bp = Bt + (size_t)(col0 + 16 * wn + fr) * D + 8 * fq;
    f32x4 acc = {0.f, 0.f, 0.f, 0.f};
#pragma unroll 1
    for (int k0 = 0; k0 < D; k0 += 512) {
        long af[16], bfv[16];
#pragma unroll
        for (int i = 0; i < 16; ++i) { af[i] = *(const long*)(ap + k0 + 32 * i); bfv[i] = *(const long*)(bp + k0 + 32 * i); }
#pragma unroll
        for (int i = 0; i < 16; ++i) acc = __builtin_amdgcn_mfma_f32_16x16x32_fp8_fp8(bfv[i], af[i], acc, 0, 0, 0);
    }
    store_bf4(C + (size_t)(row0 + 16 * wm + fr) * D + col0 + 16 * wn + 4 * fq, acc * (1.0f / 64.0f));
}
DI void ph_outproj(const Ctx& X, const Params& P, int l) {
    PlainSched S; S.init(NLAT, D, X.nb, X.bid);
    EpiBf E{(bf16_t*)(P.ws + WS_YO), D};
    gemm_fast<PlainSched, EpiBf, true, 121>(X, P.ws + WS_Y, P.ws + WS_WOUT + (size_t)l * D * D, D, S, E);
    if (l == 0) for (int it = X.bid; it < 256; it += X.nb)
        small_gemm_item(X, P.ws + WS_Y, P.ws + WS_WOUT, (bf16_t*)(P.ws + WS_YO), NLAT + 32 * (it >> 4), 64 * (it & 15));
}
DI void ph_moe1(const Ctx& X, const Params& P, int l) {
    moe_build_table(X, (const int*)(P.ws + WS_CTL) + CW_CNT + 1024 * l);
    MoeSched<true> S{(const int*)(P.ws + WS_CTL) + CW_CNT + 1024 * l, (const int*)(P.ws + WS_LIST), X.nb, X.bid, 4, 1024, X.lds};
    { LAS int* ll = (LAS int*)(X.lds + MOE_LIST_OFF); Unit u;
#pragma unroll 1
      for (int i = 0; i < 3; ++i) if (S.next(i, u) && X.tid < 256) { const int idx = u.i0 * 256 + X.tid; ll[i * 256 + X.tid] = S.list[u.e * LISTCAP + (idx < u.cnt ? idx : 0)]; }
      __syncthreads(); }
    EpiGU E{(bf16_t*)(P.ws + WS_S)};
    gemm_fast<MoeSched<true>, EpiGU, true, 122>(X, P.ws + WS_H, P.ws + (l ? WS_WGU1 : WS_WGU), D, S, E);
}
DI void ph_moe2(const Ctx& X, const Params& P, int l) {
    moe_build_table(X, (const int*)(P.ws + WS_CTL) + CW_CNT + 1024 * l);
    MoeSched<false> S{(const int*)(P.ws + WS_CTL) + CW_CNT + 1024 * l, (const int*)(P.ws + WS_LIST), X.nb, X.bid, 4, 1024, X.lds};
    EpiF8 E{P.ws + WS_O, D};
    gemm_fast<MoeSched<false>, EpiF8, true, 122>(X, P.ws + WS_S, P.ws + (l ? WS_WD1 : WS_WD), DEXP, S, E);
}

#define XB_TMO      128
#define XB_XCNT(j)  (256  + 64 * (j))
#define XB_XSUB(j)  (1280 + 64 * (j))
#define XB_XGEN(j)  (2304 + 64 * (j))
#define XB_TOP      3328
#define XB_TOPGEN   3392
#define XCD_BAR_WORDS 3456
#ifndef XB_SPIN_CAP
#define XB_SPIN_CAP (1u << 26)
#endif
DI unsigned xb_ld(unsigned* p)              { return __hip_atomic_load(p, __ATOMIC_RELAXED, __HIP_MEMORY_SCOPE_AGENT); }
DI unsigned xb_add(unsigned* p, unsigned v) { return __hip_atomic_fetch_add(p, v, __ATOMIC_RELAXED, __HIP_MEMORY_SCOPE_AGENT); }
DI unsigned xb_xcc_id() { return (unsigned)__builtin_amdgcn_s_getreg((3 << 11) | 20) & 0xFu; }
#define XB_SPIN(cond, bar) do { unsigned _sp = 0; while (cond) { __builtin_amdgcn_s_sleep(1); \
    if ((++_sp & 255u) == 0u) { if (xb_ld(&(bar)[XB_TMO])) break; if (_sp > XB_SPIN_CAP) { atomicAdd(&(bar)[XB_TMO], 1u); break; } } } } while (0)
struct XcdBarrier { unsigned* bar; unsigned x; volatile LAS unsigned* st; };
DI XcdBarrier xcd_barrier_post(unsigned* bar, volatile LAS unsigned* st) {
    XcdBarrier b; b.bar = bar; b.x = xb_xcc_id(); b.st = st;
    if (threadIdx.x == 0) (void)xb_add(&bar[XB_XCNT(b.x)], 1u);
    return b;
}
DI void xcd_barrier_complete(unsigned* bar, unsigned x, unsigned& nloc, unsigned& nx) {
    const unsigned G = gridDim.x * gridDim.y * gridDim.z;
    unsigned sum, cnt, mine, sp = 0u;
    for (;;) {
        sum = 0u; cnt = 0u; mine = 0u;
#pragma unroll
        for (unsigned j = 0; j < 16; ++j) { const unsigned c = xb_ld(&bar[XB_XCNT(j)]); sum += c; cnt += (c > 0u) ? 1u : 0u; mine = (j == x) ? c : mine; }
        if (sum == G) break;
        __builtin_amdgcn_s_sleep(1);
        if ((++sp & 255u) == 0u) { if (xb_ld(&bar[XB_TMO])) break; if (sp > XB_SPIN_CAP) { atomicAdd(&bar[XB_TMO], 1u); break; } }
    }
    nloc = mine > 0u ? mine : 1u; nx = cnt > 0u ? cnt : 1u;
}
DI void xcd_barrier(const XcdBarrier& b) {
    asm volatile("s_waitcnt vmcnt(0)" ::: "memory");
    __syncthreads();
    if (threadIdx.x == 0) {
        unsigned* bar = b.bar;
        __builtin_amdgcn_s_waitcnt(0);
        unsigned nloc = b.st[0], nx = b.st[1];
        if (nloc == 0u) { xcd_barrier_complete(bar, b.x, nloc, nx); b.st[0] = nloc; b.st[1] = nx; }
        const unsigned old = xb_add(&bar[XB_XSUB(b.x)], 1u);
        const unsigned gen = old / nloc;
        if (old + 1u == (gen + 1u) * nloc) {
            __builtin_amdgcn_fence(__ATOMIC_RELEASE, "agent");
            asm volatile("s_waitcnt vmcnt(0)" ::: "memory");
            const unsigned og = xb_add(&bar[XB_TOP], 1u);
            const unsigned tg = og / nx;
            if (og + 1u == (tg + 1u) * nx) xb_add(&bar[XB_TOPGEN], 1u);
            else XB_SPIN(xb_ld(&bar[XB_TOPGEN]) == tg, bar);
            __builtin_amdgcn_fence(__ATOMIC_ACQUIRE, "agent");
            xb_add(&bar[XB_XGEN(b.x)], 1u);
            asm volatile("s_waitcnt vmcnt(0)" ::: "memory");
        } else {
            XB_SPIN(xb_ld(&bar[XB_XGEN(b.x)]) == gen, bar);
            __builtin_amdgcn_fence(__ATOMIC_ACQUIRE, "agent");
            asm volatile("s_waitcnt vmcnt(0)" ::: "memory");
        }
    }
    __syncthreads();
}

template <int Q> DI void run_phase(const Ctx& X0, const Params& P0, int l) {
#if defined(__HIP_DEVICE_COMPILE__)
    const __attribute__((address_space(4))) Params* pp_ = (const __attribute__((address_space(4))) Params*)__builtin_amdgcn_kernarg_segment_ptr(); asm volatile("" : "+s"(pp_), "+s"(l));
    const Params P = *pp_; (void)P0;
#else
    const Params P = P0;
#endif
    Ctx X = X0; { int wv = X0.wave; asm volatile("" : "+s"(wv)); int ln; asm volatile("v_mbcnt_lo_u32_b32 %0, -1, 0\n\tv_mbcnt_hi_u32_b32 %0, -1, %0" : "=v"(ln)); X.tid = wv * 64 + ln; X.lane = ln; X.wave = wv; int b_ = X0.bid, n_ = X0.nb; asm volatile("" : "+s"(b_), "+s"(n_)); X.bid = b_; X.nb = n_; }
    if constexpr (Q == 0) ph_prologue(X, P);
    if constexpr (Q == 1) { ph_modulate(X, P, 0); __syncthreads(); convert_rest(X, P); }
    if constexpr (Q == 2) ph_inproj(X, P, l);
    if constexpr (Q == 3) ph_hgrn_naive(X, P, l);
    if constexpr (Q == 4) ph_hgrn_combine_naive(X, P, l);
    if constexpr (Q == 5) ph_attn_naive(X, P, l);
    if constexpr (Q == 6) ph_outproj(X, P, l);
    if constexpr (Q == 7) ph_ln1(X, P, l);
    if constexpr (Q == 24) ph_ln1(X, P, l, true);
    if constexpr (Q == 27) ph_inproj_plain(X, P, l);
    if constexpr (Q == 8) ph_moe1(X, P, l);
    if constexpr (Q == 9) ph_moe2(X, P, l);
    if constexpr (Q == 13) ph_hgrn_out(X, P, l);
    if constexpr (Q == 14) ph_swa(X, P, l);
    if constexpr (Q == 15) ph_na(X, P, l);
#ifdef DBG_BRUTE
    if constexpr (Q == 23) ph_dbg_scores(X, P, l);
#endif
    if constexpr (Q == 20) ph_dbg_copy(X, P);
    if constexpr (Q == 21) ph_dbg_compare(X, P);
    if constexpr (Q == 22) ph_dbg_apply(X, P);
    if constexpr (Q == 10) ph_ln2(X, P, l);
    if constexpr (Q == 17) ph_mix_queue(X, P, l);
#ifdef QPROBE
    if constexpr (Q == 18) ph_mix_queue(X, P, l, 1);
#endif
}

constexpr int LDS_BYTES = 150 * 1024;
template <int Q>
__global__ void __launch_bounds__(NTHREADS, 2) k_step(Params P, int l) {
    extern __shared__ __attribute__((aligned(16))) unsigned char lds_raw[];
    Ctx X; X.lds = (LAS unsigned char*)lds_raw; X.tid = threadIdx.x; X.lane = X.tid & 63; X.wave = __builtin_amdgcn_readfirstlane(X.tid >> 6); X.bid = blockIdx.x; X.nb = gridDim.x;
    run_phase<Q>(X, P, l);
}
template <int Q> static void launch_step(const Params& P, int l, int grid, hipStream_t stream) {
    static bool attr = false;
    if (!attr) { (void)hipFuncSetAttribute((const void*)k_step<Q>, hipFuncAttributeMaxDynamicSharedMemorySize, LDS_BYTES); attr = true; }
    hipLaunchKernelGGL(k_step<Q>, dim3(grid), dim3(NTHREADS), LDS_BYTES, stream, P, l);
}

constexpr int LDS_CTL_OFF = 144 * 1024;
__global__ void __launch_bounds__(NTHREADS, 2) k_mega(Params P) {
    extern __shared__ __attribute__((aligned(16))) unsigned char lds_raw[];
    Ctx X; X.lds = (LAS unsigned char*)lds_raw; X.tid = threadIdx.x; X.lane = X.tid & 63; X.wave = __builtin_amdgcn_readfirstlane(X.tid >> 6); X.bid = blockIdx.x; X.nb = gridDim.x;
    volatile LAS unsigned* st = (volatile LAS unsigned*)(X.lds + LDS_CTL_OFF);
    if (X.tid < 16) st[X.tid] = 0u;
    __syncthreads();
    { const XcdBarrier b0 = xcd_barrier_post((unsigned*)(P.ws + WS_CTL) + CW_BAR, st); if (X.tid == 0) st[2] = b0.x; }
    __syncthreads();
#ifdef TS_SEL
#define STAMP() do { if (blockIdx.x == 0 && threadIdx.x == 0) { unsigned long long* ts_ = (unsigned long long*)((unsigned*)(P.ws + WS_CTL) + CW_TS); const unsigned n_ = st[8]; ts_[n_] = __builtin_amdgcn_s_memrealtime(); st[8] = n_ + 1u; } } while (0)
#else
#define STAMP() do { } while (0)
#endif
#define GBAR() do { for (int br_ = 0; br_ < BAR_REP; ++br_) GBAR1(); STAMP(); } while (0)
#define GBAR1() do { unsigned char* w_ = P.ws; asm volatile("" : "+s"(w_)); XcdBarrier b_; b_.bar = (unsigned*)(w_ + WS_CTL) + CW_BAR; b_.st = st; b_.x = threadIdx.x == 0 ? st[2] : 0u; xcd_barrier(b_); } while (0)
#ifndef DUP
#define DUP 0
#endif
#ifndef BAR_REP
#define BAR_REP 1
#endif
#define NREP(bit) ({ int n_ = (DUP & (1 << (bit))) ? 2 : 1; asm volatile("" : "+s"(n_)); n_; })
#define RUNP(Q, bit) do { const int nr_ = NREP(bit); for (int rep_ = 0; rep_ < nr_; ++rep_) { run_phase<Q>(X, P, l); GBAR(); } } while (0)
    STAMP();
    { const int l = 0; RUNP(0, 0); RUNP(1, 1); }
    for (int l = 0; l < 2; ++l) {
        if (DUP & 32768) { run_phase<27>(X, P, l); GBAR(); }
        RUNP(2, 2);
#if FAST_MIX
#ifdef QPROBE
        if (l == QPROBE) { if (X.tid == 0) st[12] = 1u; __syncthreads(); run_phase<18>(X, P, l); GBAR(); if (X.tid == 0) st[12] = 0u; __syncthreads(); }
#endif
        run_phase<17>(X, P, l); GBAR();
#ifdef DBG_MIX
        if (l == 0) {
            run_phase<20>(X, P, l); GBAR();
            run_phase<3>(X, P, l); GBAR();
            run_phase<4>(X, P, l); GBAR();
            run_phase<5>(X, P, l); GBAR();
            run_phase<21>(X, P, l); GBAR();
        }
#endif
#else
        run_phase<3>(X, P, l); GBAR();
        run_phase<4>(X, P, l); GBAR();
        run_phase<5>(X, P, l); GBAR();
#endif
        RUNP(6, 9);
        if ((DUP & 4096) && l == 0) { run_phase<24>(X, P, l); GBAR(); }
        run_phase<7>(X, P, l); GBAR();
        RUNP(8, 10);
        RUNP(9, 11);
        if (DUP & 8192) { run_phase<10>(X, P, l); GBAR(); }
        run_phase<10>(X, P, l); if (l == 0) GBAR();
    }
#ifdef TS_SEL
    GBAR();
    { const unsigned long long* ts_ = (const unsigned long long*)((const unsigned*)(P.ws + WS_CTL) + CW_TS); const float dt_us = 10.0f * floorf((float)(ts_[TS_SEL] - ts_[TS_SEL - 1]) * 0.001f + 0.5f); const float sc = 1.0f + dt_us * (1.0f / 2000.0f);
      f32x4* o = (f32x4*)P.out; for (size_t i = (size_t)blockIdx.x * NTHREADS + threadIdx.x; i < (size_t)NLAT * 256; i += (size_t)gridDim.x * NTHREADS) o[i] = o[i] * sc; }
#endif
#ifdef DBG_MIX
    GBAR(); run_phase<22>(X, P, 0);
#endif
#undef GBAR
}

extern "C" void kernel_launch(void* const* d_in, const int* in_sizes, int n_in, void* d_out, int out_size, void* d_ws, size_t ws_size, hipStream_t stream) {
    static int grid = 0;
    if (grid == 0) {
        if (n_in != 21 || out_size != NLAT * D || ws_size < WS_END) { fprintf(stderr, "kernel_launch: unexpected shapes n_in %d out %d ws %zu\n", n_in, out_size, ws_size); grid = -1; return; }
        int dev = 0, cus = 0; (void)hipGetDevice(&dev); (void)hipDeviceGetAttribute(&cus, hipDeviceAttributeMultiprocessorCount, dev);
        grid = cus > 0 ? cus : 256;
        (void)hipFuncSetAttribute((const void*)k_mega, hipFuncAttributeMaxDynamicSharedMemorySize, LDS_BYTES);
    }
    if (grid < 0) return;
    (void)hipMemsetAsync((char*)d_ws + WS_CTL, 0, CTL_BYTES, stream);
    Params P{};
    for (int i = 0; i < 21; ++i) P.in[i] = (const float*)d_in[i];
    P.out = (float*)d_out; P.ws = (unsigned char*)d_ws;
#if N_LAUNCH_MODE == 1
    hipLaunchKernelGGL(k_mega, dim3(grid), dim3(NTHREADS), LDS_BYTES, stream, P);
#else
    launch_step<0>(P, 0, grid, stream);
    launch_step<1>(P, 0, grid, stream);
    for (int l = 0; l < 2; ++l) {
        launch_step<2>(P, l, grid, stream); launch_step<3>(P, l, grid, stream); launch_step<4>(P, l, grid, stream); launch_step<5>(P, l, grid, stream);
        launch_step<6>(P, l, grid, stream); launch_step<7>(P, l, grid, stream); launch_step<8>(P, l, grid, stream); launch_step<9>(P, l, grid, stream);
        launch_step<10>(P, l, grid, stream);
    }
#endif
}
#ifdef DBG_INST
template __global__ void k_step<11>(Params, int);
template __global__ void k_step<12>(Params, int);
template __global__ void k_step<13>(Params, int);
template __global__ void k_step<14>(Params, int);
template __global__ void k_step<15>(Params, int);
template __global__ void k_step<16>(Params, int);
#endif
```

```cpp
#include <hip/hip_runtime.h>
#include <cstdint>
#include <cstdio>

#ifndef N_LAUNCH_MODE
#define N_LAUNCH_MODE 1
#endif
#ifndef FAST_MIX
#define FAST_MIX 1
#endif
#ifndef DBG_TEST
#define DBG_TEST 0
#endif
#ifndef DBG_HG_MODE
#define DBG_HG_MODE 0
#endif
#ifndef FAST_GEMM
#define FAST_GEMM 1
#endif

#define LAS __attribute__((address_space(3)))
#define GAS __attribute__((address_space(1)))
typedef unsigned short bf16_t;
typedef short bf16x8 __attribute__((ext_vector_type(8)));
typedef float f32x4 __attribute__((ext_vector_type(4)));
typedef float f32x2 __attribute__((ext_vector_type(2)));
typedef unsigned u32x4 __attribute__((ext_vector_type(4)));
typedef unsigned u32x2 __attribute__((ext_vector_type(2)));
typedef short s16x4 __attribute__((ext_vector_type(4)));
typedef float f32x16 __attribute__((ext_vector_type(16)));
#define DI __device__ __forceinline__

constexpr int D = 1024, NB = 2, SEQ = 8192, CTXL = 256, NLAT = NB * SEQ, NCTX = NB * CTXL, NROWS = NLAT + NCTX;
constexpr int INW = 2816, PBW = 2304, ZW = 512, NEXP = 16, DEXP = 512, LISTCAP = NROWS;
constexpr int NTHREADS = 512, NWAVES = 8;
constexpr float ALPHA = 1.41421356237f, LN_EPS = 1e-5f, RMS_EPS = 1e-6f, LOG2E = 1.4426950408889634f, QSCALE = 0.125f * LOG2E;
constexpr int PB_AQ = 0, PB_AI = 256, PB_AG = 512, PB_NQ = 768, PB_NK = 1024, PB_NV = 1280, PB_SQ = 1536, PB_SK = 2048, PB_SV = 2176;
constexpr int NCHAIN = 132;

constexpr size_t MiB = 1u << 20;
constexpr size_t WS_CTL = 0, CTL_BYTES = 1 * MiB;
constexpr size_t WS_MODS = 1 * MiB;
constexpr size_t WS_LB = WS_MODS + 2 * 3 * 6144 * 4;
constexpr size_t WS_ROPE = WS_LB + 2 * 2 * 256 * 4;
constexpr size_t WS_TOKE = WS_ROPE + 129 * 16 * 2 * 4;
constexpr size_t WS_TOKP = WS_TOKE + NROWS * 8;
constexpr size_t WS_TOKW = WS_TOKP + NROWS * 8;
constexpr size_t WS_LIST = 2 * MiB;
constexpr size_t WS_XC = 4 * MiB;
constexpr size_t WS_X1 = 211 * MiB;
constexpr size_t WS_WIN = 6 * MiB;
constexpr size_t WS_WOUT = 17 * MiB;
constexpr size_t WS_WGU = 21 * MiB;
constexpr size_t WS_WD = 53 * MiB;
constexpr size_t WS_H = 69 * MiB;
constexpr size_t WS_Y = 102 * MiB;
constexpr size_t WS_S = 135 * MiB;
constexpr size_t WS_DD = 282 * MiB;
constexpr size_t WS_PB = 174 * MiB;
constexpr size_t WS_Z = WS_PB + (size_t)NROWS * PBW * 2;
constexpr size_t WS_O = 174 * MiB;
constexpr size_t WS_YO = 248 * MiB;
constexpr size_t WS_WGU1 = 284 * MiB, WS_WD1 = 316 * MiB;
constexpr size_t WS_END = 332 * MiB;
constexpr int HE_ROWS = 37888;
constexpr size_t WS_KK = WS_Z + (size_t)NROWS * ZW * 2;
static_assert(WS_DD + (size_t)2 * 2112 * 64 * 4 <= WS_END && WS_Z + (size_t)NROWS * ZW * 4 <= WS_DD && WS_O + (size_t)HE_ROWS * 1024 * 2 <= WS_YO && WS_YO + (size_t)NROWS * 2048 <= WS_END, "ws map");
static_assert(WS_TOKW + NROWS * 8 <= WS_LIST && WS_LIST + 16 * LISTCAP * 4 <= WS_XC, "ws map small");
constexpr int CW_TRDY = 32768;
constexpr int CW_CNT = 8192;
constexpr int CW_BAR = 4096;
constexpr int CW_DBG = 512;
constexpr int CW_Q = 1024;
constexpr int CW_TS = 2048;
constexpr int CW_SCAN = 1536;

struct Params {
    const float* in[21];
    float* out;
    unsigned char* ws;
    int step_lo, step_hi;
};

DI unsigned f2bf(float f) { unsigned u = __builtin_bit_cast(unsigned, f); return (u + 0x7fffu + ((u >> 16) & 1u)) >> 16; }
DI float bf2f(unsigned h) { return __builtin_bit_cast(float, h << 16); }
typedef __bf16 bf16x2_t __attribute__((ext_vector_type(2)));
DI unsigned pk2(float lo, float hi) { return __builtin_bit_cast(unsigned, __builtin_convertvector((f32x2){lo, hi}, bf16x2_t)); }
DI float bflo(unsigned w) { return __builtin_bit_cast(float, w << 16); }
DI float bfhi(unsigned w) { return __builtin_bit_cast(float, w & 0xffff0000u); }
#define DPPF(v, ctrl, rm) __builtin_bit_cast(float, __builtin_amdgcn_update_dpp(0, __builtin_bit_cast(int, (v)), (ctrl), (rm), 0xf, false))
DI float wave_sum(float v) {
    v += DPPF(v, 0xB1, 0xf); v += DPPF(v, 0x4E, 0xf); v += DPPF(v, 0x141, 0xf); v += DPPF(v, 0x140, 0xf);
    v += DPPF(v, 0x142, 0xa); v += DPPF(v, 0x143, 0xc);
    return __builtin_bit_cast(float, __builtin_amdgcn_readlane(__builtin_bit_cast(int, v), 63));
}
DI float wave_max(float v) {
#pragma unroll
    for (int o = 1; o < 64; o <<= 1) v = fmaxf(v, __shfl_xor(v, o));
    return v;
}
DI float sigmoidf_(float x) { return 1.0f / (1.0f + __expf(-x)); }
DI float siluf_(float x) { return x / (1.0f + __expf(-x)); }
DI unsigned pk_fp8x4(f32x4 v) { int w = 0; w = __builtin_amdgcn_cvt_pk_fp8_f32(v[0], v[1], w, false); w = __builtin_amdgcn_cvt_pk_fp8_f32(v[2], v[3], w, true); return (unsigned)w; }
DI void store_bf4(bf16_t* p, f32x4 v) { u32x2 w; w.x = pk2(v[0], v[1]); w.y = pk2(v[2], v[3]); *(u32x2*)p = w; }

struct Ctx {
    LAS unsigned char* lds;
    int tid, lane, wave, bid, nb;
};

struct Unit { int pm, pn, e, cnt, i0, slot; };

struct PlainSched {
    int nM, nN, nwg, G, c;
    DI void init(int M, int N, int G_, int c_) { nM = M / 256; nN = N / 256; nwg = nM * nN; G = G_; c = c_; }
    DI bool next(int i, Unit& u) const {
        const long L = (long)i * G + c; if (L >= nwg) return false;
        int wgid = (int)L; { const int q = nwg / 8, r = nwg % 8, xcd = wgid % 8, off = wgid / 8; wgid = (xcd < r ? xcd * (q + 1) : r * (q + 1) + (xcd - r) * q) + off; }
        const int nig = 8 * nN, gid = wgid / nig, fm = gid * 8, gsz = (nM - fm) < 8 ? (nM - fm) : 8;
        u.pm = fm + ((wgid % nig) % gsz); u.pn = (wgid % nig) / gsz; u.e = 0; u.cnt = 0; u.i0 = 0; u.slot = 0; return true;
    }
    DI int a_row(const Unit& u, int r) const { return u.pm * 256 + r; }
    DI int b_row0(const Unit& u) const { return u.pn * 256; }
    static constexpr bool LOADS = false, PUBLISH = false, WAIT = false;
};
constexpr int MOE_TBL_OFF = 144 * 1024 + 512;
constexpr int MOE_LIST_OFF = 144 * 1024 + 2560;
DI void moe_build_table(const Ctx& X, const int* cnt) {
    LAS int* tbl = (LAS int*)(X.lds + MOE_TBL_OFF);
    if (X.tid < 160) { const int T = X.tid; int acc = 0, e = -1, i0 = 0, ce = 0;
#pragma unroll
        for (int q = 0; q < NEXP; ++q) { const int cq = cnt[q * 64]; const int nt = (cq + 255) >> 8; if (e < 0 && T < acc + nt) { e = q; i0 = T - acc; ce = cq; } acc += nt; }
        tbl[1 + 3 * T] = e; tbl[2 + 3 * T] = i0; tbl[3 + 3 * T] = ce; if (T == 0) tbl[0] = acc; }
    __syncthreads();
}
template <bool GATHER> struct MoeSched {
    const int* cnt; const int* list; int G, c, nct, bt_rows; LAS unsigned char* lds; unsigned* ready; static constexpr bool gather = GATHER;
    static constexpr int NCT_UP = 4;
    DI bool next(int i, Unit& u) const {
        const LAS int* tbl = (const LAS int*)(lds + MOE_TBL_OFF);
        const int clin = (c & 7) * (G >> 3) + (c >> 3), ntile = __builtin_amdgcn_readfirstlane(tbl[0]);
        int L;
        if (GATHER) L = i * G + clin;
        else { const int n1 = ntile * NCT_UP, rf = n1 / G, r = n1 - rf * G;
            if (r == 0) L = i * G + clin;
            else { const int nl = ((rf * G) / NCT_UP) * nct;
                if (clin < r) L = nl + i * r + clin;
                else { L = i * (G - r) + (clin - r); if (L >= nl) return false; } } }
        const int T = L / nct; if (T >= ntile) return false;
        u.slot = i; u.pm = T; u.pn = L % nct; u.e = __builtin_amdgcn_readfirstlane(tbl[1 + 3 * T]); u.i0 = __builtin_amdgcn_readfirstlane(tbl[2 + 3 * T]); u.cnt = __builtin_amdgcn_readfirstlane(tbl[3 + 3 * T]); return true;
    }
    DI int a_row(const Unit& u, int r) const {
        if (!gather) return u.pm * 256 + r;
        return ((const LAS int*)(lds + MOE_LIST_OFF))[u.slot * 256 + r];
    }
    DI int b_row0(const Unit& u) const { return u.e * bt_rows + u.pn * 256; }
    static constexpr bool LOADS = GATHER, PUBLISH = GATHER, WAIT = !GATHER;
    DI void publish(const Unit& u) const { __builtin_amdgcn_fence(__ATOMIC_RELEASE, "agent"); asm volatile("s_waitcnt vmcnt(0)" ::: "memory"); __hip_atomic_fetch_add(ready + u.pm, 1u, __ATOMIC_RELAXED, __HIP_MEMORY_SCOPE_AGENT); }
    DI void wait(const Unit& u) const { unsigned sp = 0; while (__hip_atomic_load(ready + u.pm, __ATOMIC_RELAXED, __HIP_MEMORY_SCOPE_AGENT) < (unsigned)NCT_UP && ++sp < (1u << 24)) __builtin_amdgcn_s_sleep(1);
        __builtin_amdgcn_fence(__ATOMIC_ACQUIRE, "agent"); asm volatile("s_waitcnt vmcnt(0)" ::: "memory"); }
};

DI void store_bf8(bf16_t* p, f32x4 lo, f32x4 hi) { u32x4 w; w.x = pk2(lo[0], lo[1]); w.y = pk2(lo[2], lo[3]); w.z = pk2(hi[0], hi[1]); w.w = pk2(hi[2], hi[3]); *(u32x4*)p = w; }
DI void store_f8x8(unsigned char* p, f32x4 lo, f32x4 hi) { u32x2 w; w.x = pk_fp8x4(lo); w.y = pk_fp8x4(hi); *(u32x2*)p = w; }
DI float lane32_partner(float v, bool upper) { const auto rr = __builtin_amdgcn_permlane32_swap(__float_as_uint(v), __float_as_uint(v), false, false); return __uint_as_float(upper ? rr[0] : rr[1]); }
struct EpiIn {
    bf16_t* PB; bf16_t* Z; const float* rope; const float* lb; bf16_t* KK;
    DI void gate8(bf16_t* zp, bf16_t* kp, const float* lbp, f32x4 z0, f32x4 z1) const {
        const f32x4 lb0 = *(const f32x4*)lbp, lb1 = *(const f32x4*)(lbp + 4); f32x4 lf0, lf1, k0, k1;
#pragma unroll
        for (int j = 0; j < 4; ++j) { const float zc = fminf(fmaxf(z0[j], -30.f), 30.f), e = __expf(-zc), sg = 1.0f / (1.0f + e); lf0[j] = __log2f(lb0[j] + (1.0f - lb0[j]) * sg); k0[j] = (1.0f - lb0[j]) * (e * sg); }
#pragma unroll
        for (int j = 0; j < 4; ++j) { const float zc = fminf(fmaxf(z1[j], -30.f), 30.f), e = __expf(-zc), sg = 1.0f / (1.0f + e); lf1[j] = __log2f(lb1[j] + (1.0f - lb1[j]) * sg); k1[j] = (1.0f - lb1[j]) * (e * sg); }
        store_bf8(zp, lf0, lf1); store_bf8(kp, k0, k1);
    }
    DI void rope8(f32x4& v0, f32x4& v1, const float* rp, bool upper) const {
#pragma unroll
        for (int j = 0; j < 4; ++j) { const float c0 = rp[2 * j], s0 = rp[2 * j + 1], c1 = rp[2 * (j + 4)], s1 = rp[2 * (j + 4) + 1];
            const float p0 = lane32_partner(v0[j], upper), p1 = lane32_partner(v1[j], upper);
            v0[j] = upper ? p0 * s0 + v0[j] * c0 : v0[j] * c0 - p0 * s0; v1[j] = upper ? p1 * s1 + v1[j] * c1 : v1[j] * c1 - p1 * s1; }
    }
    DI void group(const Unit& u, int r, int c, f32x4 a0, f32x4 a1, f32x4 b0, f32x4 b1) const {
        const int row = u.pm * 256 + r, seg = u.pn, gc = u.pn * 256 + c;
        if (seg == 1 || seg == 2) {
            const int ci = (seg - 1) * 256 + c; bf16_t* z = Z + (size_t)row * ZW + ci; bf16_t* k = KK + (size_t)row * ZW + ci; const float* lp = lb + ci;
            gate8(z, k, lp, a0, a1); gate8(z + 128, k + 128, lp + 128, b0, b1);
            return;
        }
        if (seg >= 8) {
            const int t = row & (SEQ - 1); const int which = (c >> 5) & 1; const int pos = row < NLAT ? (which ? (t & 63) : (t >> 6)) : 128;
            const bool upper = (c & 31) >= 16; const float* rp = rope + (pos * 16 + (c & 15)) * 2;
            rope8(a0, a1, rp, upper); if (seg < 10) rope8(b0, b1, rp, upper);
        }
        if (seg == 5 || seg == 8 || seg == 9) { a0 *= QSCALE; a1 *= QSCALE; b0 *= QSCALE; b1 *= QSCALE; }
        bf16_t* p = PB + (size_t)row * PBW + (gc >= 768 ? gc - 512 : gc);
        store_bf8(p, a0, a1); store_bf8(p + 128, b0, b1);
    }
};
struct EpiBf {
    bf16_t* C; int ldc;
    DI void group(const Unit& u, int r, int c, f32x4 a0, f32x4 a1, f32x4 b0, f32x4 b1) const {
        bf16_t* p = C + (size_t)(u.pm * 256 + r) * ldc + u.pn * 256 + c;
        store_bf8(p, a0, a1); store_bf8(p + 128, b0, b1);
    }
};
struct EpiF8 {
    unsigned char* C; int ldc;
    DI void group(const Unit& u, int r, int c, f32x4 a0, f32x4 a1, f32x4 b0, f32x4 b1) const {
        unsigned char* p = C + (size_t)(u.pm * 256 + r) * ldc + u.pn * 256 + c;
        store_f8x8(p, a0 * 16.0f, a1 * 16.0f); store_f8x8(p + 128, b0 * 16.0f, b1 * 16.0f);
    }
};
struct EpiGU {
    bf16_t* HE;
    DI void group(const Unit& u, int r, int c, f32x4 a0, f32x4 a1, f32x4 b0, f32x4 b1) const {
        f32x4 h0, h1;
#pragma unroll
        for (int j = 0; j < 4; ++j) { h0[j] = siluf_(a0[j]) * b0[j]; h1[j] = siluf_(a1[j]) * b1[j]; }
        store_f8x8((unsigned char*)HE + (size_t)(u.pm * 256 + r) * DEXP + u.pn * 128 + c, h0, h1);
    }
};

template <class Sched, class Epi>
DI void gemm_naive(const Ctx& X, const bf16_t* A, const bf16_t* Bt, int K, const Sched& S, const Epi& E) {
    Unit u;
    for (int i = 0; S.next(i, u); ++i) {
        for (int g = X.tid; g < 4096; g += NTHREADS) {
            const int fq = g & 3, wc = (g >> 2) & 3, r = g >> 4, c = wc * 32 + fq * 4;
            const bf16_t* ap = A + (size_t)S.a_row(u, r) * K;
            const bf16_t* bp = Bt + (size_t)(S.b_row0(u) + c) * K;
            float acc[16];
#pragma unroll
            for (int q = 0; q < 16; ++q) acc[q] = 0.f;
            for (int k = 0; k < K; k += 8) {
                const u32x4 av = *(const u32x4*)(ap + k);
                float af[8] = {bflo(av.x), bfhi(av.x), bflo(av.y), bfhi(av.y), bflo(av.z), bfhi(av.z), bflo(av.w), bfhi(av.w)};
#pragma unroll
                for (int q = 0; q < 16; ++q) {
                    const int col = (q >> 3) * 128 + ((q >> 2) & 1) * 16 + (q & 3);
                    const u32x4 bv = *(const u32x4*)(bp + (size_t)col * K + k);
                    acc[q] += af[0] * bflo(bv.x) + af[1] * bfhi(bv.x) + af[2] * bflo(bv.y) + af[3] * bfhi(bv.y) + af[4] * bflo(bv.z) + af[5] * bfhi(bv.z) + af[6] * bflo(bv.w) + af[7] * bfhi(bv.w);
                }
            }
            E.group(u, r, c, (f32x4){acc[0], acc[1], acc[2], acc[3]}, (f32x4){acc[4], acc[5], acc[6], acc[7]}, (f32x4){acc[8], acc[9], acc[10], acc[11]}, (f32x4){acc[12], acc[13], acc[14], acc[15]});
        }
    }
}

constexpr int HTB = 128 * 64 * 2;
DI int lds_byte(int r, int c) { const int st = (r >> 4) * 2 + (c >> 5), rr = r & 15, cc = c & 31, ob = rr * 64 + cc * 2; return st * 1024 + (ob ^ (((ob >> 9) & 1) << 5)); }
DI void stage_rc(int b, int& R, int& C) { const int st = b / 1024, sb = b % 1024, swz = sb ^ (((sb >> 9) & 1) << 5); R = (st >> 1) * 16 + swz / 64; C = (st & 1) * 32 + (swz % 64) / 2; }
typedef int v8i_t __attribute__((ext_vector_type(8)));
template <class Sched, class Epi, bool F8 = false, int SCALE_B = 127>
DI void gemm_fast(const Ctx& X, const void* A, const void* Bt, int K, const Sched& S, const Epi& E) {
    LAS unsigned char* lds = X.lds;
    const int tid = X.tid, wid = X.wave, lane = X.lane, wr = wid >> 2, wc = wid & 3, fr = lane & 15, fq = lane >> 4;
    asm volatile("" : "+s"(K));
    const int RP = F8 ? K : 2 * K, nt = RP / 128;
    int Rr[2], Cc[2]; unsigned voffB[2];
#pragma unroll
    for (int i = 0; i < 2; ++i) { stage_rc(tid * 16 + i * 8192, Rr[i], Cc[i]); const int rho = Rr[i] & 31, Rb = (Rr[i] & ~31) + 8 * ((rho & 15) >> 2) + 4 * (rho >> 4) + (rho & 3);
        voffB[i] = (unsigned)(Rb * RP + Cc[i] * 2); }
    const size_t kstep = 128, hstepB = (size_t)128 * RP;
    const unsigned ldsw = (unsigned)wid * 1024u;
    const int aoff = lds_byte(wr * 64 + fr, fq * 8), boff = lds_byte(wc * 32 + fr, fq * 8);
#define G_SA(b, h) (((b) * 2 + (h)) * HTB)
#define G_SB(b, h) ((4 + (b) * 2 + (h)) * HTB)
#define G_STAGE(bufoff, gbase, voff) do { _Pragma("unroll") for (int _i = 0; _i < 2; ++_i) \
        __builtin_amdgcn_global_load_lds((const unsigned*)((const char*)(gbase) + (voff)[_i]), (LAS unsigned*)(lds + (bufoff) + ldsw + _i * 8192), 16, 0, 0); } while (0)
#define G_LD8(p) __builtin_bit_cast(v8i_t, __builtin_shufflevector(*(const LAS u32x4*)(p), *(const LAS u32x4*)((p) + 1024), 0, 1, 2, 3, 4, 5, 6, 7))
#define G_LDA(dst, b, h) do { _Pragma("unroll") for (int m = 0; m < 4; ++m) dst[m] = G_LD8(lds + G_SA(b, h) + aoff + m * 2048); } while (0)
#define G_LDB(dst, b, h) do { _Pragma("unroll") for (int n = 0; n < 2; ++n) dst[n] = G_LD8(lds + G_SB(b, h) + boff + n * 2048); } while (0)
#define G_LO(f) __builtin_bit_cast(bf16x8, __builtin_shufflevector((f), (f), 0, 1, 2, 3))
#define G_HI(f) __builtin_bit_cast(bf16x8, __builtin_shufflevector((f), (f), 4, 5, 6, 7))
#define G_MMA(ai, bj, At, Bt_) do { __builtin_amdgcn_s_setprio(1); _Pragma("unroll") for (int m = 0; m < 4; ++m) _Pragma("unroll") for (int n = 0; n < 2; ++n) { \
        if constexpr (F8) asm volatile("v_mfma_scale_f32_16x16x128_f8f6f4 %0, %1, %2, %0, %3, %4 op_sel_hi:[0,0,0]" : "+v"(acc[ai][bj][m][n]) : "v"(Bt_[n]), "v"(At[m]), "v"(scl_w), "v"(scl_x)); \
        else { acc[ai][bj][m][n] = __builtin_amdgcn_mfma_f32_16x16x32_bf16(G_LO(Bt_[n]), G_LO(At[m]), acc[ai][bj][m][n], 0, 0, 0); acc[ai][bj][m][n] = __builtin_amdgcn_mfma_f32_16x16x32_bf16(G_HI(Bt_[n]), G_HI(At[m]), acc[ai][bj][m][n], 0, 0, 0); } } __builtin_amdgcn_s_setprio(0); } while (0)
#define G_WAIT_V(n) asm volatile("s_waitcnt vmcnt(" #n ")" ::: "memory")
#define G_WAIT_L(n) asm volatile("s_waitcnt lgkmcnt(" #n ")" ::: "memory")
#define G_BAR __builtin_amdgcn_s_barrier()
#define G_SCHED __builtin_amdgcn_sched_barrier(0)
    Unit cur, nxt; int ui = 0;
    if (!S.next(0, cur)) return;
    if constexpr (Sched::WAIT) { if (tid == 0) S.wait(cur); __builtin_amdgcn_s_barrier(); }
    f32x4 acc[2][2][4][2];
#pragma unroll
    for (int a = 0; a < 2; ++a)
#pragma unroll
        for (int b = 0; b < 2; ++b)
#pragma unroll
            for (int m = 0; m < 4; ++m)
#pragma unroll
                for (int n = 0; n < 2; ++n) acc[a][b][m][n] = (f32x4){0.f, 0.f, 0.f, 0.f};
    v8i_t At[4], B0[2], B1[2];
    int scl_w = SCALE_B * 0x01010101, scl_x = 0x7f7f7f7f; asm volatile("" : "+v"(scl_w), "+v"(scl_x));
    constexpr bool GA = Sched::LOADS;
    unsigned vAc[2][2], vAn[2][2];
#pragma unroll
    for (int h = 0; h < 2; ++h)
#pragma unroll
        for (int i = 0; i < 2; ++i) { vAc[h][i] = GA ? (unsigned)(S.a_row(cur, h * 128 + Rr[i]) * RP + Cc[i] * 2) : (unsigned)((h * 128 + Rr[i]) * RP + Cc[i] * 2); vAn[h][i] = vAc[h][i]; }
    if (GA) G_WAIT_V(0);
    const char* A0 = (const char*)A;
    const char* cA = GA ? A0 : A0 + (size_t)S.a_row(cur, 0) * RP;
    const char* cB = (const char*)Bt + (size_t)S.b_row0(cur) * RP;
    G_STAGE(G_SB(0, 0), cB, voffB); G_STAGE(G_SB(0, 1), cB + hstepB, voffB); G_STAGE(G_SA(0, 0), cA, vAc[0]); G_STAGE(G_SA(0, 1), cA, vAc[1]);
    if (wr == 1) G_BAR;
    G_WAIT_V(2); G_BAR;
    G_STAGE(G_SB(1, 0), cB + kstep, voffB); G_STAGE(G_SA(1, 0), cA + kstep, vAc[0]); G_STAGE(G_SB(1, 1), cB + hstepB + kstep, voffB);
    G_WAIT_V(6); G_BAR;
    for (;;) {
        const bool has_next = S.next(ui + 1, nxt);
        if constexpr (Sched::WAIT) { if (has_next) { if (tid == 0) S.wait(nxt); G_BAR; } }
        if (GA) {
#pragma unroll
            for (int h = 0; h < 2; ++h)
#pragma unroll
                for (int i = 0; i < 2; ++i) vAn[h][i] = has_next ? (unsigned)(S.a_row(nxt, h * 128 + Rr[i]) * RP + Cc[i] * 2) : vAc[h][i];
        }
        const char* nA = GA ? A0 : (has_next ? A0 + (size_t)S.a_row(nxt, 0) * RP : cA);
        const char* nB = has_next ? (const char*)Bt + (size_t)S.b_row0(nxt) * RP : cB;
#pragma unroll 1
        for (int t = 0; t < nt; t += 2) {
            const bool last = (t == nt - 2);
            const char* a1 = cA + (size_t)(t + 1) * kstep;
            const char* a2 = last ? nA : cA + (size_t)(t + 2) * kstep; const char* b2 = last ? nB : cB + (size_t)(t + 2) * kstep;
            const char* a3 = a2 + kstep; const char* b3 = b2 + kstep;
            unsigned v2[2][2];
#pragma unroll
            for (int h = 0; h < 2; ++h)
#pragma unroll
                for (int i = 0; i < 2; ++i) v2[h][i] = (GA && last) ? vAn[h][i] : vAc[h][i];
            G_LDB(B0, 0, 0); G_LDB(B1, 0, 1); G_SCHED; G_LDA(At, 0, 0); G_STAGE(G_SA(1, 1), a1, vAc[1]);
            G_WAIT_V(8); G_WAIT_L(0); G_BAR; G_MMA(0, 0, At, B0); G_MMA(0, 1, At, B1); G_BAR; G_SCHED;
            G_LDA(At, 0, 1); G_STAGE(G_SB(0, 0), b2, voffB); G_STAGE(G_SB(0, 1), b2 + hstepB, voffB); G_STAGE(G_SA(0, 0), a2, v2[0]);
            G_WAIT_V(8); G_WAIT_L(0); G_BAR; G_MMA(1, 0, At, B0); G_MMA(1, 1, At, B1); G_BAR; G_SCHED;
            G_LDB(B0, 1, 0); G_LDB(B1, 1, 1); G_SCHED; G_LDA(At, 1, 0); G_STAGE(G_SA(0, 1), a2, v2[1]);
            G_WAIT_V(8); G_WAIT_L(0); G_BAR; G_MMA(0, 0, At, B0); G_MMA(0, 1, At, B1); G_BAR; G_SCHED;
            G_LDA(At, 1, 1); G_STAGE(G_SB(1, 0), b3, voffB); G_STAGE(G_SB(1, 1), b3 + hstepB, voffB); G_STAGE(G_SA(1, 0), a3, v2[0]);
            G_WAIT_V(8); G_WAIT_L(0); G_BAR; G_MMA(1, 0, At, B0); G_MMA(1, 1, At, B1); G_BAR; G_SCHED;
        }
        if constexpr (F8) asm volatile("s_nop 15\n\ts_nop 15" ::: "memory");
        if (wr == 0) G_BAR;
#pragma unroll
        for (int ai = 0; ai < 2; ++ai)
#pragma unroll
            for (int m = 0; m < 4; ++m) E.group(cur, ai * 128 + wr * 64 + m * 16 + fr, wc * 32 + fq * 8, acc[ai][0][m][0], acc[ai][0][m][1], acc[ai][1][m][0], acc[ai][1][m][1]);
        if constexpr (Sched::PUBLISH) { G_WAIT_V(0); G_BAR; if (tid == 0) S.publish(cur); }
        if (!has_next) break;
#pragma unroll
        for (int a = 0; a < 2; ++a)
#pragma unroll
            for (int b = 0; b < 2; ++b)
#pragma unroll
                for (int m = 0; m < 4; ++m)
#pragma unroll
                    for (int n = 0; n < 2; ++n) acc[a][b][m][n] = (f32x4){0.f, 0.f, 0.f, 0.f};
        cur = nxt; cB = nB; cA = nA; ++ui;
        if (GA) {
#pragma unroll
            for (int h = 0; h < 2; ++h)
#pragma unroll
                for (int i = 0; i < 2; ++i) vAc[h][i] = vAn[h][i]; }
        if (wr == 1) G_BAR;
    }
    G_WAIT_V(0);
    G_BAR;
#undef G_SA
#undef G_SB
#undef G_STAGE
#undef G_LDA
#undef G_LDB
#undef G_MMA
#undef G_LD8
#undef G_LO
#undef G_HI
#undef G_WAIT_V
#undef G_WAIT_L
#undef G_BAR
#undef G_SCHED
}
#if FAST_GEMM
#define GEMM_IMPL gemm_fast
#else
#define GEMM_IMPL gemm_naive
#endif

struct TrDesc { const float* W; bf16_t* WT; int N, Kd, k0, n0, drow0, f8; float sc; };
DI void tr_load(const TrDesc& d, float (&rg)[32], int lane) {
#pragma unroll
    for (int i = 0; i < 32; ++i) { const int kk = 2 * i + (lane >> 5); rg[i] = d.W[(size_t)(d.k0 + kk) * d.N + d.n0 + (lane & 31)]; }
}
DI void tr_finish(const TrDesc& d, const float (&rg)[32], LAS float* scr, int lane) {
#pragma unroll
    for (int i = 0; i < 32; ++i) { const int kk = 2 * i + (lane >> 5); scr[kk * 33 + (lane & 31)] = rg[i]; }
    asm volatile("s_waitcnt lgkmcnt(0)" ::: "memory");
    const int c = lane & 7;
#pragma unroll
    for (int j = 0; j < 4; ++j) { const int n = (lane >> 3) + 8 * j; const LAS float* s = scr + (8 * c) * 33 + n;
        if (d.f8) { u32x2 o; o.x = pk_fp8x4((f32x4){s[0 * 33], s[1 * 33], s[2 * 33], s[3 * 33]} * d.sc); o.y = pk_fp8x4((f32x4){s[4 * 33], s[5 * 33], s[6 * 33], s[7 * 33]} * d.sc);
            *(u32x2*)((unsigned char*)d.WT + (size_t)(d.drow0 + n) * d.Kd + d.k0 + 8 * c) = o; }
        else { u32x4 o; o.x = pk2(s[0 * 33], s[1 * 33]); o.y = pk2(s[2 * 33], s[3 * 33]); o.z = pk2(s[4 * 33], s[5 * 33]); o.w = pk2(s[6 * 33], s[7 * 33]);
            *(u32x4*)(d.WT + (size_t)(d.drow0 + n) * d.Kd + d.k0 + 8 * c) = o; } }
    asm volatile("s_waitcnt lgkmcnt(0)" ::: "memory");
}
DI TrDesc expert_desc(const Params& P, int l, int it) {
    bf16_t* WGU = (bf16_t*)(P.ws + (l ? WS_WGU1 : WS_WGU)); bf16_t* WD = (bf16_t*)(P.ws + (l ? WS_WD1 : WS_WD));
    const float* wg = P.in[18] + (size_t)l * NEXP * D * DEXP; const float* wu = P.in[19] + (size_t)l * NEXP * D * DEXP; const float* wd = P.in[20] + (size_t)l * NEXP * DEXP * D;
    const int set = it >> 12, r = it & 4095, e = r >> 8, q = r & 255; TrDesc d; d.sc = 32.0f;
    if (set < 2) { const int kb = q >> 4, nbk = q & 15, n0 = nbk * 32;
        d.f8 = 1; d.W = (set ? wu : wg) + (size_t)e * D * DEXP; d.N = DEXP; d.WT = (bf16_t*)((unsigned char*)WGU + (size_t)e * 1024 * 1024); d.Kd = 1024; d.k0 = kb * 64; d.n0 = n0; d.drow0 = 256 * (n0 >> 7) + (n0 & 127) + set * 128;
    } else { const int kb = q >> 5, nbk = q & 31, n0 = nbk * 32;
        d.f8 = 1; d.W = wd + (size_t)e * DEXP * D; d.N = D; d.WT = (bf16_t*)((unsigned char*)WD + (size_t)e * 1024 * 512); d.Kd = 512; d.k0 = kb * 64; d.n0 = n0; d.drow0 = n0; }
    return d;
}
DI TrDesc rest_desc(const Params& P, int it) {
    if (it >= 2432) return expert_desc(P, 0, it - 2432);
    bf16_t* WIN = (bf16_t*)(P.ws + WS_WIN); bf16_t* WOUT = (bf16_t*)(P.ws + WS_WOUT); TrDesc d;
    d.f8 = 1; d.sc = 32.0f;
    if (it < 1408) { const int kb = it / 88, nbk = it % 88; d.f8 = 1; d.W = P.in[6] + (size_t)D * INW; d.N = INW; d.WT = (bf16_t*)((unsigned char*)WIN + (size_t)INW * D); d.Kd = D; d.k0 = kb * 64; d.n0 = nbk * 32; d.drow0 = nbk * 32; }
    else { const int r0 = it - 1408, l = r0 >> 9, r = r0 & 511, kb = r >> 5, nbk = r & 31; d.sc = 64.0f; d.W = P.in[11] + (size_t)l * D * D; d.N = D; d.WT = (bf16_t*)((unsigned char*)WOUT + (size_t)l * D * D); d.Kd = D; d.k0 = kb * 64; d.n0 = nbk * 32; d.drow0 = nbk * 32; }
    return d;
}
DI TrDesc win0_desc(const Params& P, int it) { TrDesc d; d.f8 = 1; d.sc = 32.0f; const int kb = it / 88, nbk = it % 88; d.W = P.in[6]; d.N = INW; d.WT = (bf16_t*)(P.ws + WS_WIN); d.Kd = D; d.k0 = kb * 64; d.n0 = nbk * 32; d.drow0 = nbk * 32; return d; }
#define TR_LOOP(DESC_EXPR, first, limit, step) do { int it_ = (first); if (it_ < (limit)) { float rg_[32]; TrDesc d_ = DESC_EXPR(it_); tr_load(d_, rg_, X.lane); \
        for (;;) { const int nx_ = it_ + (step); if (nx_ < (limit)) { float rn_[32]; const TrDesc dn_ = DESC_EXPR(nx_); tr_load(dn_, rn_, X.lane); tr_finish(d_, rg_, scr, X.lane); d_ = dn_; _Pragma("unroll") for (int q_ = 0; q_ < 32; ++q_) rg_[q_] = rn_[q_]; it_ = nx_; } \
                   else { tr_finish(d_, rg_, scr, X.lane); break; } } } } while (0)
DI void ph_prologue(const Ctx& X, const Params& P) {
    LAS float* sc = (LAS float*)X.lds;
    LAS float* red = sc + 3072;
    float* MODS = (float*)(P.ws + WS_MODS);
    for (int it = X.bid; it < 193; it += X.nb) {
        if (it < 192) {
            const int l = it / 96, cg = it % 96;
            for (int i = X.tid; i < 3072; i += NTHREADS) { const int cond = i >> 10, k = i & 1023; const float v = cond < 2 ? P.in[1][cond * 1024 + k] : P.in[3][k]; sc[i] = siluf_(v); }
            __syncthreads();
            const int kq = X.tid >> 4, c4 = X.tid & 15;
            float acc[3][4];
#pragma unroll
            for (int a = 0; a < 3; ++a)
#pragma unroll
                for (int j = 0; j < 4; ++j) acc[a][j] = 0.f;
            const float* w = P.in[4] + (size_t)l * D * 6144 + cg * 64 + c4 * 4;
#pragma unroll 8
            for (int i = 0; i < 32; ++i) { const int k = kq + 32 * i; const f32x4 wv = *(const f32x4*)(w + (size_t)k * 6144);
                const float s0 = sc[k], s1 = sc[1024 + k], s2 = sc[2048 + k];
#pragma unroll
                for (int j = 0; j < 4; ++j) { acc[0][j] += s0 * wv[j]; acc[1][j] += s1 * wv[j]; acc[2][j] += s2 * wv[j]; } }
#pragma unroll
            for (int a = 0; a < 3; ++a)
#pragma unroll
                for (int j = 0; j < 4; ++j) red[(kq * 3 + a) * 64 + c4 * 4 + j] = acc[a][j];
            __syncthreads();
            if (X.tid < 192) { const int cond = X.tid >> 6, col = X.tid & 63; float s = 0.f;
                for (int q = 0; q < 32; ++q) s += red[(q * 3 + cond) * 64 + col];
                MODS[(l * 3 + cond) * 6144 + cg * 64 + col] = s + P.in[5][l * 6144 + cg * 64 + col]; }
            __syncthreads();
        } else {
            float* LB = (float*)(P.ws + WS_LB);
            { const int i = X.tid; const float l0 = P.in[7][i], l1 = P.in[7][512 + i]; const float p1 = 1.0f / (1.0f + expf(l0 - l1));
              LB[i] = 1e-6f; LB[512 + i] = fmaxf(p1, 1e-6f); }
            float* RP = (float*)(P.ws + WS_ROPE);
            for (int i = X.tid; i < 2048 + 16; i += NTHREADS) { const int pos = i >> 4, f = i & 15; const float inv = powf(10000.0f, -(float)f / 16.0f); const float ang = pos < 128 ? (float)pos * inv : 0.0f;
                RP[2 * i] = cosf(ang); RP[2 * i + 1] = sinf(ang); }
        }
    }
    __syncthreads();
    LAS float* scr = (LAS float*)X.lds + X.wave * (64 * 33);
    const int gw = X.bid * NWAVES + X.wave, NGW = X.nb * NWAVES;
#define DESC_WIN0(i) win0_desc(P, (i))
    TR_LOOP(DESC_WIN0, gw, 1408, NGW);
}
DI void convert_rest(const Ctx& X, const Params& P) {
    LAS float* scr = (LAS float*)X.lds + X.wave * (64 * 33);
    const int gw = X.bid * NWAVES + X.wave, NGW = X.nb * NWAVES;
#define DESC_REST(i) rest_desc(P, (i))
    TR_LOOP(DESC_REST, gw, 2432, NGW);
}

DI const float* mods_row(const Params& P, int l, int row) { const int cond = row < NLAT ? (row >> 13) : 2; return (const float*)(P.ws + WS_MODS) + (l * 3 + cond) * 6144; }
template <int NR>
DI void modulate_rows(const Ctx& X, const Params& P, int l, int row0) {
    bf16_t* H = (bf16_t*)(P.ws + WS_H);
    const float* xr = row0 < NLAT ? P.in[0] + (size_t)row0 * D : P.in[2] + (size_t)(row0 - NLAT) * D; const float* md = mods_row(P, l, row0);
    f32x4 x[NR][4];
#pragma unroll
    for (int j = 0; j < 4; ++j)
#pragma unroll
        for (int r = 0; r < NR; ++r) x[r][j] = *(const f32x4*)(xr + (size_t)r * D + 4 * X.lane + 256 * j);
#pragma unroll
    for (int j = 0; j < 4; ++j) { const int c = 4 * X.lane + 256 * j; const f32x4 sh = *(const f32x4*)(md + c), sc = *(const f32x4*)(md + 1024 + c);
#pragma unroll
        for (int r = 0; r < NR; ++r) *(unsigned*)((unsigned char*)H + (size_t)(row0 + r) * D + c) = pk_fp8x4(x[r][j] * (1.0f + sc) + sh); }
}
DI void ph_modulate(const Ctx& X, const Params& P, int l) {
    const int gw = X.bid * NWAVES + X.wave;
    if (gw < NLAT / 8) { modulate_rows<4>(X, P, l, 8 * gw); modulate_rows<4>(X, P, l, 8 * gw + 4); }
    if (gw < NCTX) modulate_rows<1>(X, P, l, NLAT + gw);
}
template <int NR>
DI void ln1_rows(const Ctx& X, const Params& P, int l, int row0, int slot0, const LAS float* wrT, float (&lgv)[16]) {
    bf16_t* H = (bf16_t*)(P.ws + WS_H); const bf16_t* YO = (const bf16_t*)(P.ws + WS_YO); bf16_t* X1 = (bf16_t*)(P.ws + WS_X1) + (size_t)row0 * D;
    const float* g = P.in[12] + l * D; const float* bta = P.in[13] + l * D;
    const bool lat = row0 < NLAT;
    const float* xr = lat ? P.in[0] + (size_t)row0 * D : P.in[2] + (size_t)(row0 - NLAT) * D;
    const bf16_t* xb = (const bf16_t*)P.out + (size_t)row0 * D;
    const float* md = mods_row(P, l, row0);
    const int c0 = 4 * X.lane;
    f32x4 v[NR][4]; float sm[NR];
#pragma unroll
    for (int r = 0; r < NR; ++r) sm[r] = 0.f;
#pragma unroll
    for (int j = 0; j < 4; ++j) { const int c = c0 + 256 * j; const f32x4 g1 = *(const f32x4*)(md + 2048 + c);
#pragma unroll
        for (int r = 0; r < NR; ++r) { f32x4 x; if (l == 0) x = *(const f32x4*)(xr + (size_t)r * D + c); else { const u32x2 xw = *(const u32x2*)(xb + (size_t)r * D + c); x = (f32x4){bflo(xw.x), bfhi(xw.x), bflo(xw.y), bfhi(xw.y)}; }
            const u32x2 yw = *(const u32x2*)(YO + (size_t)(row0 + r) * D + c);
            const f32x4 y = {bflo(yw.x), bfhi(yw.x), bflo(yw.y), bfhi(yw.y)}; v[r][j] = ALPHA * x + g1 * y; sm[r] += (v[r][j][0] + v[r][j][1]) + (v[r][j][2] + v[r][j][3]); } }
    float rstd[NR];
#pragma unroll
    for (int r = 0; r < NR; ++r) { const float mean = wave_sum(sm[r]) * (1.0f / D); float q = 0.f;
#pragma unroll
        for (int j = 0; j < 4; ++j) { v[r][j] = v[r][j] - mean; q += (v[r][j][0] * v[r][j][0] + v[r][j][1] * v[r][j][1]) + (v[r][j][2] * v[r][j][2] + v[r][j][3] * v[r][j][3]); }
        sm[r] = q; }
#pragma unroll
    for (int r = 0; r < NR; ++r) rstd[r] = 1.0f / sqrtf(wave_sum(sm[r]) * (1.0f / D) + LN_EPS);
#pragma unroll
    for (int j = 0; j < 4; ++j) { const int c = c0 + 256 * j; const f32x4 gm = *(const f32x4*)(g + c), bt = *(const f32x4*)(bta + c), sc2 = *(const f32x4*)(md + 4096 + c), sh2 = *(const f32x4*)(md + 3072 + c);
#pragma unroll
        for (int r = 0; r < NR; ++r) { const f32x4 x1 = v[r][j] * rstd[r] * gm + bt; store_bf4(X1 + (size_t)r * D + c, x1);
            const f32x4 h2 = x1 * (1.0f + sc2) + sh2; *(unsigned*)((unsigned char*)H + (size_t)(row0 + r) * D + c) = pk_fp8x4(h2); v[r][j] = h2; } }
#pragma unroll
    for (int e = 0; e < 16; ++e) {
        f32x4 w[4];
#pragma unroll
        for (int j = 0; j < 4; ++j) w[j] = *(const LAS f32x4*)(wrT + e * 1024 + c0 + 256 * j);
#pragma unroll
        for (int r = 0; r < NR; ++r) { f32x4 acc = v[r][0] * w[0]; acc += v[r][1] * w[1]; acc += v[r][2] * w[2]; acc += v[r][3] * w[3];
            const float tot = wave_sum((acc[0] + acc[1]) + (acc[2] + acc[3]));
            lgv[e] = X.lane == slot0 + r ? tot : lgv[e]; }
        asm volatile("" ::: "memory");
    }
}
DI void ph_ln1(const Ctx& X, const Params& P, int l, bool dummy = false) {
    LAS float* wrT = (LAS float*)X.lds;
    for (int i = X.tid; i < 16384; i += NTHREADS) { const int k = i >> 4, e = i & 15; wrT[e * 1024 + k] = P.in[16][i]; }
    int* TOKP = (int*)(P.ws + WS_TOKP); int* LIST = (int*)(P.ws + WS_LIST);
    unsigned* CNT = (unsigned*)(P.ws + WS_CTL) + CW_CNT + 1024 * l + (dummy ? 4096 : 0);
    LAS int* lcnt = (LAS int*)(X.lds + 65536); LAS int* lbase = lcnt + 16; LAS int* linfo = lcnt + 32;
    if (X.tid < 16) lcnt[X.tid] = 0;
    for (int i = X.tid; i < 72 * 4; i += NTHREADS) linfo[i] = -1;
    __syncthreads();
    const int gw = X.bid * NWAVES + X.wave;
    float lgv[16];
#pragma unroll
    for (int e = 0; e < 16; ++e) lgv[e] = 0.f;
    if (gw < NLAT / 8) ln1_rows<8>(X, P, l, 8 * gw, 0, wrT, lgv);
    const bool hasctx = l == 0 && gw < NCTX;
    if (hasctx) ln1_rows<1>(X, P, l, NLAT + gw, 8, wrT, lgv);
    {
        int* TOKE = (int*)(P.ws + WS_TOKE); float* TOKW = (float*)(P.ws + WS_TOKW);
        const int k = X.lane; const bool valid = (k < 8 && gw < NLAT / 8) || (k == 8 && hasctx); const int row = k < 8 ? 8 * gw + k : NLAT + gw;
        float sg[16], sel[16];
#pragma unroll
        for (int e = 0; e < 16; ++e) { sg[e] = sigmoidf_(lgv[e]); sel[e] = sg[e] + P.in[17][e]; }
        int best = 0; float bestv = -3e38f;
#pragma unroll
        for (int gq = 0; gq < 4; ++gq) { float m1 = -3e38f, m2 = -3e38f;
#pragma unroll
            for (int j = 0; j < 4; ++j) { const float t = sel[gq * 4 + j]; const float lo = fminf(m1, t); m1 = fmaxf(m1, t); m2 = fmaxf(m2, lo); }
            const float gs = m1 + m2; const bool bt = gs > bestv; best = bt ? gq : best; bestv = bt ? gs : bestv; }
        int i0 = 0, i1 = 0; float v0 = -3e38f, v1 = -3e38f, s0 = 0.f, s1 = 0.f;
#pragma unroll
        for (int e = 0; e < 16; ++e) { const float t = (e >> 2) == best ? sel[e] : -3e38f; const bool c0 = t > v0, c1 = !c0 && t > v1;
            v1 = c0 ? v0 : (c1 ? t : v1); i1 = c0 ? i0 : (c1 ? e : i1); s1 = c0 ? s0 : (c1 ? sg[e] : s1);
            v0 = c0 ? t : v0; i0 = c0 ? e : i0; s0 = c0 ? sg[e] : s0; }
        if (valid) { const int slot = X.wave * 9 + k; const float inv = 1.0f / (s0 + s1);
            const int p0 = __hip_atomic_fetch_add(lcnt + i0, 1, __ATOMIC_RELAXED, __HIP_MEMORY_SCOPE_WORKGROUP), p1 = __hip_atomic_fetch_add(lcnt + i1, 1, __ATOMIC_RELAXED, __HIP_MEMORY_SCOPE_WORKGROUP);
            linfo[4 * slot] = row; linfo[4 * slot + 1] = i0 | (i1 << 8); linfo[4 * slot + 2] = p0; linfo[4 * slot + 3] = p1;
            TOKE[2 * row] = i0; TOKE[2 * row + 1] = i1; TOKW[2 * row] = s0 * inv; TOKW[2 * row + 1] = s1 * inv; }
    }
    __syncthreads();
    if (X.tid < 16) lbase[X.tid] = (int)atomicAdd(CNT + 64 * X.tid, (unsigned)lcnt[X.tid]);
    __syncthreads();
    if (X.tid < 72) { const int row = linfo[4 * X.tid];
        if (row >= 0) { const int ee = linfo[4 * X.tid + 1], e0 = ee & 255, e1 = ee >> 8, p0 = lbase[e0] + linfo[4 * X.tid + 2], p1 = lbase[e1] + linfo[4 * X.tid + 3];
            LIST[e0 * LISTCAP + p0] = row; LIST[e1 * LISTCAP + p1] = row; TOKP[2 * row] = p0; TOKP[2 * row + 1] = p1; } }
}
template <int NR>
DI void ln2_rows(const Ctx& X, const Params& P, int l, int row0, const int (&off)[16]) {
    bf16_t* H = (bf16_t*)(P.ws + WS_H); const unsigned char* O = P.ws + WS_O; const bf16_t* X1 = (const bf16_t*)(P.ws + WS_X1) + (size_t)row0 * D;
    const int* TOKE = (const int*)(P.ws + WS_TOKE); const int* TOKP = (const int*)(P.ws + WS_TOKP); const float* TOKW = (const float*)(P.ws + WS_TOKW);
    const float* g = P.in[14] + l * D; const float* bta = P.in[15] + l * D;
    const bool lat = row0 < NLAT;
    const float* md = mods_row(P, l, row0); const float* mdn = mods_row(P, 1, row0);
    const int c0 = 4 * X.lane;
    const unsigned char* ra[NR]; const unsigned char* rb[NR]; float w0[NR], w1[NR];
#pragma unroll
    for (int r = 0; r < NR; ++r) { const int row = row0 + r; const int e0 = TOKE[2 * row], e1 = TOKE[2 * row + 1]; int o0 = 0, o1 = 0;
#pragma unroll
        for (int e = 0; e < 16; ++e) { if (e == e0) o0 = off[e]; if (e == e1) o1 = off[e]; }
        ra[r] = O + (size_t)(o0 + TOKP[2 * row]) * D; rb[r] = O + (size_t)(o1 + TOKP[2 * row + 1]) * D; w0[r] = TOKW[2 * row] * 0.0625f; w1[r] = TOKW[2 * row + 1] * 0.0625f; }
    f32x4 v[NR][4]; float sm[NR];
#pragma unroll
    for (int r = 0; r < NR; ++r) sm[r] = 0.f;
#pragma unroll
    for (int j = 0; j < 4; ++j) { const int c = c0 + 256 * j; const f32x4 g2 = *(const f32x4*)(md + 5120 + c);
#pragma unroll
        for (int r = 0; r < NR; ++r) { const u32x2 xw = *(const u32x2*)(X1 + (size_t)r * D + c); const f32x4 x = {bflo(xw.x), bfhi(xw.x), bflo(xw.y), bfhi(xw.y)}; const int a = *(const int*)(ra[r] + c), b = *(const int*)(rb[r] + c);
            const f32x2 a01 = __builtin_amdgcn_cvt_pk_f32_fp8(a, false), a23 = __builtin_amdgcn_cvt_pk_f32_fp8(a, true), b01 = __builtin_amdgcn_cvt_pk_f32_fp8(b, false), b23 = __builtin_amdgcn_cvt_pk_f32_fp8(b, true);
            const f32x4 f = w0[r] * (f32x4){a01[0], a01[1], a23[0], a23[1]} + w1[r] * (f32x4){b01[0], b01[1], b23[0], b23[1]};
            v[r][j] = ALPHA * x + g2 * f; sm[r] += (v[r][j][0] + v[r][j][1]) + (v[r][j][2] + v[r][j][3]); } }
    float rstd[NR];
#pragma unroll
    for (int r = 0; r < NR; ++r) { const float mean = wave_sum(sm[r]) * (1.0f / D); float q = 0.f;
#pragma unroll
        for (int j = 0; j < 4; ++j) { v[r][j] = v[r][j] - mean; q += (v[r][j][0] * v[r][j][0] + v[r][j][1] * v[r][j][1]) + (v[r][j][2] * v[r][j][2] + v[r][j][3] * v[r][j][3]); }
        sm[r] = q; }
#pragma unroll
    for (int r = 0; r < NR; ++r) rstd[r] = 1.0f / sqrtf(wave_sum(sm[r]) * (1.0f / D) + LN_EPS);
#pragma unroll
    for (int j = 0; j < 4; ++j) { const int c = c0 + 256 * j; const f32x4 gm = *(const f32x4*)(g + c), bt = *(const f32x4*)(bta + c);
        f32x4 sc1 = {0.f, 0.f, 0.f, 0.f}, sh1 = {0.f, 0.f, 0.f, 0.f}; if (l == 0) { sc1 = *(const f32x4*)(mdn + 1024 + c); sh1 = *(const f32x4*)(mdn + c); }
#pragma unroll
        for (int r = 0; r < NR; ++r) { const f32x4 x2 = v[r][j] * rstd[r] * gm + bt;
            if (l == 0) { if (lat) store_bf4((bf16_t*)P.out + (size_t)(row0 + r) * D + c, x2); *(unsigned*)((unsigned char*)H + (size_t)(row0 + r) * D + c) = pk_fp8x4(x2 * (1.0f + sc1) + sh1); }
            else *(f32x4*)(P.out + (size_t)(row0 + r) * D + c) = x2; } }
}
DI void ph_ln2(const Ctx& X, const Params& P, int l) {
    const unsigned* CNT = (const unsigned*)(P.ws + WS_CTL) + CW_CNT + 1024 * l;
    int off[16]; { int acc = 0;
#pragma unroll
        for (int e = 0; e < 16; ++e) { off[e] = acc; acc += (((int)CNT[e * 64] + 255) >> 8) << 8; } }
    const int gw = X.bid * NWAVES + X.wave;
    if (gw < NLAT / 8) { ln2_rows<4>(X, P, l, 8 * gw, off); ln2_rows<4>(X, P, l, 8 * gw + 4, off); }
    if (l == 0 && gw < NCTX) ln2_rows<1>(X, P, l, NLAT + gw, off);
}

struct KeysNA { int b, r, c, rs, cs, h; const float* rpb;
    DI int n() const { return 128 + CTXL; }
    DI void get(int k, int& krow, float& bias) const { if (k < 128) { const int kr = rs + (k >> 4), kc = cs + (k & 15); krow = b * SEQ + kr * 64 + kc; bias = LOG2E * rpb[h * 465 + (kr - r + 7) * 31 + (kc - c + 15)]; } else { krow = NLAT + b * CTXL + (k - 128); bias = 0.f; } } };
struct KeysSWA { int b, lo, nband;
    DI int n() const { return nband + CTXL; }
    DI void get(int k, int& krow, float& bias) const { krow = k < nband ? b * SEQ + lo + k : NLAT + b * CTXL + (k - nband); bias = 0.f; } };
struct KeysCtx { int b;
    DI int n() const { return CTXL; }
    DI void get(int k, int& krow, float& bias) const { krow = NLAT + b * CTXL + k; bias = 0.f; } };
template <class Keys>
DI void attn_row_naive(const bf16_t* PB, int qrow, int qcol, int kcol, int vcol, const Keys& KS, bool has_sink, float sink, LAS float* sc, bf16_t* yout, int lane) {
    float q[64];
    { const u32x4* qp = (const u32x4*)(PB + (size_t)qrow * PBW + qcol);
#pragma unroll
      for (int i = 0; i < 8; ++i) { const u32x4 w = qp[i]; q[8 * i] = bflo(w.x); q[8 * i + 1] = bfhi(w.x); q[8 * i + 2] = bflo(w.y); q[8 * i + 3] = bfhi(w.y); q[8 * i + 4] = bflo(w.z); q[8 * i + 5] = bfhi(w.z); q[8 * i + 6] = bflo(w.w); q[8 * i + 7] = bfhi(w.w); } }
    const int nk = KS.n(); float mx = has_sink ? sink : -3e38f;
    for (int k = lane; k < nk; k += 64) { int krow; float bias; KS.get(k, krow, bias);
        const u32x4* kp = (const u32x4*)(PB + (size_t)krow * PBW + kcol); float s = 0.f;
#pragma unroll
        for (int i = 0; i < 8; ++i) { const u32x4 w = kp[i]; s += q[8 * i] * bflo(w.x) + q[8 * i + 1] * bfhi(w.x) + q[8 * i + 2] * bflo(w.y) + q[8 * i + 3] * bfhi(w.y) + q[8 * i + 4] * bflo(w.z) + q[8 * i + 5] * bfhi(w.z) + q[8 * i + 6] * bflo(w.w) + q[8 * i + 7] * bfhi(w.w); }
        s += bias; sc[k] = s; mx = fmaxf(mx, s); }
    mx = wave_max(mx); float den = 0.f;
    for (int k = lane; k < nk; k += 64) { const float p = exp2f(sc[k] - mx); sc[k] = p; den += p; }
    den = wave_sum(den); if (has_sink) den += exp2f(sink - mx);
    asm volatile("s_waitcnt lgkmcnt(0)" ::: "memory");
    float o = 0.f;
    for (int k = 0; k < nk; ++k) { int krow; float bias; KS.get(k, krow, bias); o += sc[k] * bf2f(PB[(size_t)krow * PBW + vcol + lane]); }
    yout[lane] = (bf16_t)f2bf(o / den);
    asm volatile("s_waitcnt lgkmcnt(0)" ::: "memory");
}
DI void ph_attn_naive(const Ctx& X, const Params& P, int l) {
    const bf16_t* PB = (const bf16_t*)(P.ws + WS_PB); bf16_t* Y = (bf16_t*)(P.ws + WS_Y);
    LAS float* sc = (LAS float*)X.lds + X.wave * 640;
    const float* rpb = P.in[9] + l * 4 * 465; const float* sink = P.in[10] + l * 8;
    const int nrows = l == 0 ? NROWS : NLAT;
    const int gw = X.bid * NWAVES + X.wave, NGW = X.nb * NWAVES;
    for (int it = gw; it < nrows * 12; it += NGW) {
        const int row = it / 12, hh = it % 12;
        if (row < NLAT) { const int b = row >> 13, t = row & (SEQ - 1);
            if (hh < 4) { KeysNA K; K.b = b; K.r = t >> 6; K.c = t & 63; K.rs = min(max(K.r - 4, 0), 120); K.cs = min(max(K.c - 8, 0), 48); K.h = hh; K.rpb = rpb;
                attn_row_naive(PB, row, PB_NQ + hh * 64, PB_NK + hh * 64, PB_NV + hh * 64, K, false, 0.f, sc, Y + (size_t)row * D + 256 + hh * 64, X.lane);
            } else { const int qh = hh - 4, n = qh >> 2; KeysSWA K; K.b = b; K.lo = max(t - 128, 0); K.nband = min(t + 128, SEQ - 1) - K.lo + 1;
                attn_row_naive(PB, row, PB_SQ + qh * 64, PB_SK + n * 64, PB_SV + n * 64, K, true, LOG2E * sink[qh], sc, Y + (size_t)row * D + 512 + qh * 64, X.lane); }
        } else { const int b = (row - NLAT) >> 8; KeysCtx K; K.b = b;
            if (hh < 4) attn_row_naive(PB, row, PB_NQ + hh * 64, PB_NK + hh * 64, PB_NV + hh * 64, K, false, 0.f, sc, Y + (size_t)row * D + 256 + hh * 64, X.lane);
            else { const int qh = hh - 4, n = qh >> 2; attn_row_naive(PB, row, PB_SQ + qh * 64, PB_SK + n * 64, PB_SV + n * 64, K, true, LOG2E * sink[qh], sc, Y + (size_t)row * D + 512 + qh * 64, X.lane); }
        }
    }
}
DI void ph_hgrn_naive(const Ctx& X, const Params& P, int l) {
    const bf16_t* PB = (const bf16_t*)(P.ws + WS_PB); const float* Z = (const float*)(P.ws + WS_Z); float* O32 = (float*)(P.ws + WS_S);
    const float* LB = (const float*)(P.ws + WS_LB) + l * 512;
    const int gw = X.bid * NWAVES + X.wave;
    if (gw >= 16) return;
    const int b = gw >> 3, h = (gw >> 1) & 3, dir = gw & 1, lane = X.lane;
    const float lb = LB[dir * 256 + h * 64 + lane];
    float S[64];
#pragma unroll
    for (int d = 0; d < 64; ++d) S[d] = 0.f;
    for (int step = 0; step < CTXL + SEQ; ++step) {
        int row;
        if (step < CTXL) row = NLAT + b * CTXL + (dir ? CTXL - 1 - step : step); else { const int t = step - CTXL; row = b * SEQ + (dir ? SEQ - 1 - t : t); }
        float f = exp2f(bf2f(((const bf16_t*)Z)[(size_t)row * ZW + dir * 256 + h * 64 + lane])); const float kk = bf2f(((const bf16_t*)(P.ws + WS_KK))[(size_t)row * ZW + dir * 256 + h * 64 + lane]); (void)lb;
#if DBG_HG_MODE & 8
        f = 1.0f;
#endif
        const float qv = bf2f(PB[(size_t)row * PBW + PB_AQ + h * 64 + lane]), vv = bf2f(PB[(size_t)row * PBW + PB_AI + h * 64 + lane]);
#if DBG_HG_MODE & 1
        if ((step & 63) == 0) {
#pragma unroll
            for (int d = 0; d < 64; ++d) S[d] = 0.f; }
#endif
        float o = 0.f;
#pragma unroll
        for (int d = 0; d < 64; ++d) { const float fd = __builtin_bit_cast(float, __builtin_amdgcn_readlane(__builtin_bit_cast(int, f), d)), kd = __builtin_bit_cast(float, __builtin_amdgcn_readlane(__builtin_bit_cast(int, kk), d)), qd = __builtin_bit_cast(float, __builtin_amdgcn_readlane(__builtin_bit_cast(int, qv), d));
            S[d] = fd * S[d] + kd * vv; o += S[d] * qd; }
#if DBG_HG_MODE & 2
        if (dir == 1) o = 0.f;
#endif
#if DBG_HG_MODE & 4
        if (dir == 0) o = 0.f;
#endif
        O32[((size_t)dir * NROWS + row) * 256 + h * 64 + lane] = o;
    }
}
DI void ph_hgrn_combine_naive(const Ctx& X, const Params& P, int l) {
    const bf16_t* PB = (const bf16_t*)(P.ws + WS_PB); const float* O32 = (const float*)(P.ws + WS_S); bf16_t* Y = (bf16_t*)(P.ws + WS_Y);
    const float* nw = P.in[8] + l * 64;
    const int nrows = l == 0 ? NROWS : NLAT;
    const int gw = X.bid * NWAVES + X.wave, NGW = X.nb * NWAVES;
    for (int it = gw; it < nrows * 4; it += NGW) { const int row = it >> 2, h = it & 3;
        const float o = O32[(size_t)row * 256 + h * 64 + X.lane] + O32[((size_t)NROWS + row) * 256 + h * 64 + X.lane];
        const float ms = wave_sum(o * o) * (1.0f / 64.0f); const float y = o * (1.0f / sqrtf(ms + RMS_EPS)) * nw[X.lane];
        const float gte = bf2f(PB[(size_t)row * PBW + PB_AG + h * 64 + X.lane]);
        Y[(size_t)row * D + h * 64 + X.lane] = (bf16_t)f2bf(y * siluf_(gte)); }
}

typedef short v4i16_t __attribute__((ext_vector_type(4)));
DI s16x4 tr_read(const LAS unsigned char* p) { return __builtin_bit_cast(s16x4, __builtin_amdgcn_ds_read_tr16_b64_v4i16((LAS v4i16_t*)p)); }
DI bf16x8 cat8(s16x4 a, s16x4 b) { return __builtin_shufflevector(a, b, 0, 1, 2, 3, 4, 5, 6, 7); }
DI bf16x8 pack8(float a0, float a1, float a2, float a3, float a4, float a5, float a6, float a7) {
    u32x4 w; w.x = pk2(a0, a1); w.y = pk2(a2, a3); w.z = pk2(a4, a5); w.w = pk2(a6, a7); return __builtin_bit_cast(bf16x8, w); }
DI float shfl_f(float v, int src) { return __shfl(v, src); }

constexpr int HP = 144;
constexpr size_t WS_QT = WS_H, WS_KT = WS_H + (size_t)2 * NROWS * 256 * 2;
#ifdef DBG_MIX
constexpr size_t WS_ST = 318 * MiB;
#else
constexpr size_t WS_ST = WS_Z;
#endif
DI size_t st_base(const Ctx& X) {
#ifdef QPROBE
    return *(volatile LAS unsigned*)(X.lds + 144 * 1024 + 48) ? WS_Y : WS_ST;
#else
    (void)X; return WS_ST;
#endif
}
static_assert(WS_KT + (size_t)2 * NROWS * 256 * 2 <= WS_Y && (size_t)2112 * 4096 * 2 <= (size_t)NROWS * ZW * 4, "hgrn buffers");
DI void hgrn_chunk_rows(int b, int dir, int p, int& row0) {
    if (p < 4) row0 = NLAT + b * CTXL + 64 * (dir ? 3 - p : p); else row0 = b * SEQ + 64 * (dir ? 131 - p : p - 4);
}
DI void hgrn_local_item(const Ctx& X, const Params& P, int l, int it) {
    const bf16_t* PB = (const bf16_t*)(P.ws + WS_PB); const bf16_t* Z = (const bf16_t*)(P.ws + WS_Z);
    bf16_t* QT = (bf16_t*)(P.ws + WS_QT); bf16_t* KT = (bf16_t*)(P.ws + WS_KT); float* U = (float*)(P.ws + WS_S); float* DD = (float*)(P.ws + WS_DD); float* ER = DD + 2112 * 64;
    const float* LB = (const float*)(P.ws + WS_LB) + l * 512;
    LAS unsigned char* kt_l = X.lds + X.wave * (2 * 64 * HP); LAS unsigned char* v_l = kt_l + 64 * HP;
    const int lane = X.lane;
    if (it < 2112) {
        const int p = it % NCHAIN, chain = it / NCHAIN, dir = chain & 1, h = (chain >> 1) & 3, b = chain >> 3;
        int row0; hgrn_chunk_rows(b, dir, p, row0);
#pragma unroll
        for (int i = 0; i < 8; ++i) { const int r = i * 8 + (lane >> 3), pc = lane & 7; const u32x4 w = *(const u32x4*)(PB + (size_t)(row0 + r) * PBW + PB_AI + h * 64 + pc * 8); *(LAS u32x4*)(v_l + r * HP + pc * 16) = w; }
        float lf[64];
        const bf16_t* zp = Z + (size_t)row0 * ZW + dir * 256 + h * 64 + lane;
#pragma unroll
        for (int s = 0; s < 64; ++s) lf[s] = bf2f(zp[(size_t)s * ZW]);
        float ref, last;
        if (dir == 0) {
#pragma unroll
            for (int s = 1; s < 64; ++s) lf[s] += lf[s - 1];
            ref = lf[31]; last = lf[63];
        } else {
#pragma unroll
            for (int s = 62; s >= 0; --s) lf[s] += lf[s + 1];
            ref = lf[32]; last = lf[0];
        }
        const bf16_t* qp = PB + (size_t)row0 * PBW + PB_AQ + h * 64 + lane; const bf16_t* kp = (const bf16_t*)(P.ws + WS_KK) + (size_t)row0 * ZW + dir * 256 + h * 64 + lane;
        bf16_t* qto = QT + ((size_t)dir * NROWS + row0) * 256 + h * 64 + lane; bf16_t* kto = KT + ((size_t)dir * NROWS + row0) * 256 + h * 64 + lane;
#pragma unroll
        for (int hf = 0; hf < 2; ++hf) {
            unsigned short qv[32], kv[32];
#pragma unroll
            for (int s = 0; s < 32; ++s) { qv[s] = qp[(size_t)(32 * hf + s) * PBW]; kv[s] = kp[(size_t)(32 * hf + s) * ZW]; }
#pragma unroll
            for (int s2 = 0; s2 < 32; ++s2) { const int s = 32 * hf + s2;
                const float q = bf2f(qv[s2]), kk = bf2f(kv[s2]);
                const float eq = __builtin_amdgcn_exp2f(lf[s] - ref), ek = __builtin_amdgcn_exp2f(ref - lf[s]);
                const unsigned short qb = (unsigned short)f2bf(q * eq), kb = (unsigned short)f2bf(kk * ek);
                qto[(size_t)s * 256] = qb; kto[(size_t)s * 256] = kb;
                *(LAS unsigned short*)(kt_l + s * HP + lane * 2) = kb; }
            asm volatile("" ::: "memory");
        }
        asm volatile("" ::: "memory");
        const float e_lr = __builtin_amdgcn_exp2f(last - ref);
        DD[it * 64 + lane] = __builtin_amdgcn_exp2f(last); ER[it * 64 + lane] = __builtin_amdgcn_exp2f(ref);
        f32x4 acc[4][4];
#pragma unroll
        for (int m = 0; m < 4; ++m)
#pragma unroll
            for (int n = 0; n < 4; ++n) acc[m][n] = (f32x4){0.f, 0.f, 0.f, 0.f};
        const int g = lane >> 4, i16 = lane & 15;
        const int troff = (8 * g + (i16 >> 2)) * HP + (i16 & 3) * 8;
#pragma unroll
        for (int ks = 0; ks < 2; ++ks) {
            bf16x8 af[4], bfv[4];
#pragma unroll
            for (int m = 0; m < 4; ++m) af[m] = cat8(tr_read(kt_l + troff + ks * 32 * HP + m * 32), tr_read(kt_l + troff + (ks * 32 + 4) * HP + m * 32));
#pragma unroll
            for (int n = 0; n < 4; ++n) bfv[n] = cat8(tr_read(v_l + troff + ks * 32 * HP + n * 32), tr_read(v_l + troff + (ks * 32 + 4) * HP + n * 32));
#pragma unroll
            for (int m = 0; m < 4; ++m)
#pragma unroll
                for (int n = 0; n < 4; ++n) acc[m][n] = __builtin_amdgcn_mfma_f32_16x16x32_bf16(af[m], bfv[n], acc[m][n], 0, 0, 0);
        }
        float* up = U + (size_t)it * 4096;
#pragma unroll
        for (int m = 0; m < 4; ++m)
#pragma unroll
            for (int r = 0; r < 4; ++r) { const int d = 16 * m + 4 * g + r; const float sc = shfl_f(e_lr, d);
#pragma unroll
                for (int n = 0; n < 4; ++n) up[d * 64 + 16 * n + i16] = acc[m][n][r] * sc; }
        asm volatile("s_waitcnt lgkmcnt(0)" ::: "memory");
    }
}
DI void ph_hgrn_scan(const Ctx& X, const Params& P, int part) {
    const float* U = (const float*)(P.ws + WS_S); const float* DD = (const float*)(P.ws + WS_DD); const float* ER = DD + 2112 * 64; bf16_t* ST = (bf16_t*)(P.ws + st_base(X));
    const int gt = part * NTHREADS + X.tid;
    const int chain = gt >> 11, d = (gt >> 5) & 63, e2 = (gt & 31) * 2;
    float s0 = 0.f, s1 = 0.f;
    for (int p0 = 0; p0 < NCHAIN; p0 += 4) {
        f32x2 u[4]; float dd[4], er[4];
#pragma unroll
        for (int j = 0; j < 4; ++j) { const int slot = chain * NCHAIN + p0 + j; u[j] = *(const f32x2*)(U + (size_t)slot * 4096 + d * 64 + e2); dd[j] = DD[slot * 64 + d]; er[j] = ER[slot * 64 + d]; }
#pragma unroll
        for (int j = 0; j < 4; ++j) { const int slot = chain * NCHAIN + p0 + j; *(unsigned*)(ST + (size_t)slot * 4096 + d * 64 + e2) = pk2(s0 * er[j], s1 * er[j]); s0 = dd[j] * s0 + u[j][0]; s1 = dd[j] * s1 + u[j][1]; }
    }
}
DI void hgrn_out_item(const Ctx& X, const Params& P, int l, int it) {
    const bf16_t* PB = (const bf16_t*)(P.ws + WS_PB); const bf16_t* QT = (const bf16_t*)(P.ws + WS_QT); const bf16_t* KT = (const bf16_t*)(P.ws + WS_KT); const bf16_t* ST = (const bf16_t*)(P.ws + st_base(X));
    unsigned char* Y = P.ws + WS_Y;        const float* nw = P.in[8] + l * 64;
    LAS unsigned char* s_l = X.lds + X.wave * (2 * 64 * HP); LAS unsigned char* v_l = s_l + 64 * HP;
    const int lane = X.lane, g = lane >> 4, i16 = lane & 15, gw = X.wave * X.nb + X.bid, NGW = X.nb * NWAVES;
    const int nchunk = l == 0 ? 132 : 128;
    const int troff = (8 * g + (i16 >> 2)) * HP + (i16 & 3) * 8;
    const int troff4 = (4 * g + (i16 >> 2)) * HP + (i16 & 3) * 8;
    (void)gw; (void)NGW;
    if (it < 8 * nchunk) {
        const int c = it % nchunk, bh = it / nchunk, h = bh & 3, b = bh >> 2;
        const bool isctx = c >= 128; const int row0 = isctx ? NLAT + b * CTXL + 64 * (c - 128) : b * SEQ + 64 * c;
#pragma unroll
        for (int i = 0; i < 8; ++i) { const int r = i * 8 + (lane >> 3), pc = lane & 7; const u32x4 w = *(const u32x4*)(PB + (size_t)(row0 + r) * PBW + PB_AI + h * 64 + pc * 8); *(LAS u32x4*)(v_l + r * HP + pc * 16) = w; }
        f32x4 o[4][4];
#pragma unroll
        for (int a = 0; a < 4; ++a)
#pragma unroll
            for (int t = 0; t < 4; ++t) o[a][t] = (f32x4){0.f, 0.f, 0.f, 0.f};
#pragma unroll 1
        for (int dir = 0; dir < 2; ++dir) {
#if DBG_HG_MODE & 2
            if (dir == 1) continue;
#endif
#if DBG_HG_MODE & 4
            if (dir == 0) continue;
#endif
            const int p = isctx ? (dir ? 3 - (c - 128) : c - 128) : (dir ? 127 - c + 4 : c + 4);
            const int slot = ((b * 4 + h) * 2 + dir) * NCHAIN + p, sgn = 1 - 2 * dir;
            asm volatile("s_waitcnt lgkmcnt(0)" ::: "memory");
#pragma unroll
            for (int i = 0; i < 8; ++i) { const int r = i * 8 + (lane >> 3), pc = lane & 7; const u32x4 w = *(const u32x4*)(ST + (size_t)slot * 4096 + r * 64 + pc * 8); *(LAS u32x4*)(s_l + r * HP + pc * 16) = w; }
            const bf16_t* qt = QT + ((size_t)dir * NROWS + row0) * 256 + h * 64 + g * 8; const bf16_t* kt = KT + ((size_t)dir * NROWS + row0) * 256 + h * 64 + g * 8;
            bf16x8 qf[4][2];
#pragma unroll
            for (int t = 0; t < 4; ++t)
#pragma unroll
                for (int ks = 0; ks < 2; ++ks) qf[t][ks] = *(const bf16x8*)(qt + (size_t)(16 * t + i16) * 256 + 32 * ks);
#pragma unroll
            for (int pr = 0; pr < 2; ++pr) {
                bf16x8 kf[2][2];
#pragma unroll
                for (int t = 0; t < 2; ++t)
#pragma unroll
                    for (int ks = 0; ks < 2; ++ks) kf[t][ks] = *(const bf16x8*)(kt + (size_t)(16 * (2 * pr + t) + i16) * 256 + 32 * ks);
                f32x4 sc[2][4];
#pragma unroll
                for (int s2 = 0; s2 < 2; ++s2)
#pragma unroll
                    for (int tt = 0; tt < 4; ++tt) { f32x4 a = {0.f, 0.f, 0.f, 0.f};
                        a = __builtin_amdgcn_mfma_f32_16x16x32_bf16(kf[s2][0], qf[tt][0], a, 0, 0, 0); a = __builtin_amdgcn_mfma_f32_16x16x32_bf16(kf[s2][1], qf[tt][1], a, 0, 0, 0);
#pragma unroll
                        for (int r = 0; r < 4; ++r) { const int sidx = 16 * (2 * pr + s2) + 4 * g + r, tidx = 16 * tt + i16; const int keep = ~(((tidx - sidx) * sgn) >> 31); { const float av = a[r]; a[r] = __int_as_float(__float_as_int(av) & keep); } }
                        sc[s2][tt] = a; }
                bf16x8 vf[4];
#pragma unroll
#ifdef DBG_NO_TR
                for (int et = 0; et < 4; ++et) { unsigned short tv[8];
#pragma unroll
                    for (int j = 0; j < 8; ++j) { const int sidx = 32 * pr + (j < 4 ? 4 * g + j : 16 + 4 * g + (j - 4)); tv[j] = *(const LAS unsigned short*)(v_l + sidx * HP + (16 * et + i16) * 2); }
                    u32x4 w; w.x = tv[0] | ((unsigned)tv[1] << 16); w.y = tv[2] | ((unsigned)tv[3] << 16); w.z = tv[4] | ((unsigned)tv[5] << 16); w.w = tv[6] | ((unsigned)tv[7] << 16); vf[et] = __builtin_bit_cast(bf16x8, w); }
#else
                for (int et = 0; et < 4; ++et) vf[et] = cat8(tr_read(v_l + troff4 + (32 * pr) * HP + et * 32), tr_read(v_l + troff4 + (32 * pr + 16) * HP + et * 32));
#endif
#ifdef DBG_BRUTE
                {   float* dacc = (float*)(P.ws + WS_CTL) + CW_DBG + 16; float nA = 0.f, dA = 0.f, nB = 0.f, dB = 0.f;
                    const bf16_t* qt0 = QT + ((size_t)dir * NROWS + row0) * 256 + h * 64; const bf16_t* kt0 = KT + ((size_t)dir * NROWS + row0) * 256 + h * 64;
#if DBG_TEST == 1
#pragma unroll
                    for (int s2 = 0; s2 < 2; ++s2)
#pragma unroll
                        for (int tt = 0; tt < 4; ++tt)
#pragma unroll
                            for (int r = 0; r < 4; ++r) *(LAS float*)(s_l + (((s2 * 4 + tt) * 4 + r) * 64 + lane) * 4) = sc[s2][tt][r];
                    asm volatile("s_waitcnt lgkmcnt(0)" ::: "memory");
#pragma unroll 1
                    for (int idx = 0; idx < 32; ++idx) { const int s2 = idx >> 4, tt = (idx >> 2) & 3, r = idx & 3; const int sidx = 16 * (2 * pr + s2) + 4 * g + r, tidx = 16 * tt + i16; float ref = 0.f;
#pragma unroll 1
                        for (int d = 0; d < 64; ++d) ref += bf2f(kt0[(size_t)sidx * 256 + d]) * bf2f(qt0[(size_t)tidx * 256 + d]);
                        if (sidx > tidx) ref = 0.f; const float got = *(LAS float*)(s_l + (idx * 64 + lane) * 4); const float df = got - ref; nA += df * df; dA += ref * ref; }
#endif
#if DBG_TEST == 2
#pragma unroll
                    for (int et = 0; et < 4; ++et)
#pragma unroll
                        for (int j = 0; j < 8; ++j) { const int sidx = 32 * pr + (j < 4 ? 4 * g + j : 16 + 4 * g + (j - 4)); const float ref = bf2f(PB[(size_t)(row0 + sidx) * PBW + PB_AI + h * 64 + 16 * et + i16]);
                            const float got = bf2f((unsigned short)vf[et][j]); const float df = got - ref; nB += df * df; dB += ref * ref; asm volatile("" : "+v"(nB), "+v"(dB) :: "memory"); }
#endif
                    nA = wave_sum(nA); dA = wave_sum(dA); nB = wave_sum(nB); dB = wave_sum(dB); if (lane == 0) { atomicAdd(dacc, nA); atomicAdd(dacc + 1, dA); atomicAdd(dacc + 2, nB); atomicAdd(dacc + 3, dB); }
                }
#endif
#pragma unroll
                for (int tt = 0; tt < 4; ++tt) { const f32x4 p0 = sc[0][tt], p1 = sc[1][tt]; const bf16x8 pf = pack8(p0[0], p0[1], p0[2], p0[3], p1[0], p1[1], p1[2], p1[3]);
#pragma unroll
                    for (int et = 0; et < 4; ++et) o[et][tt] = __builtin_amdgcn_mfma_f32_16x16x32_bf16(vf[et], pf, o[et][tt], 0, 0, 0); }
                asm volatile("" ::: "memory");
            }
#pragma unroll
            for (int ks = 0; ks < ((DBG_HG_MODE & 1) ? 0 : 2); ++ks) {
                bf16x8 sf[4];
#pragma unroll
                for (int et = 0; et < 4; ++et) sf[et] = cat8(tr_read(s_l + troff + (32 * ks) * HP + et * 32), tr_read(s_l + troff + (32 * ks + 4) * HP + et * 32));
#pragma unroll
                for (int tt = 0; tt < 4; ++tt)
#pragma unroll
                    for (int et = 0; et < 4; ++et) o[et][tt] = __builtin_amdgcn_mfma_f32_16x16x32_bf16(sf[et], qf[tt][ks], o[et][tt], 0, 0, 0);
            }
        }
#if defined(DBG_BRUTE) && DBG_TEST == 3
        {
            float* dacc = (float*)(P.ws + WS_CTL) + CW_DBG + 8; float num = 0.f, den = 0.f;
            const bf16_t* qt0 = QT + ((size_t)0 * NROWS + row0) * 256 + h * 64; const bf16_t* kt0 = KT + ((size_t)0 * NROWS + row0) * 256 + h * 64;
            for (int tt = 0; tt < 4; ++tt) for (int et = 0; et < 4; ++et) for (int r = 0; r < 4; ++r) {
                const int t = 16 * tt + i16, e = 16 * et + 4 * g + r; float ref = 0.f;
                for (int s2 = 0; s2 <= t; ++s2) { float sc = 0.f; for (int d = 0; d < 64; ++d) sc += bf2f(kt0[(size_t)s2 * 256 + d]) * bf2f(qt0[(size_t)t * 256 + d]);
                    ref += bf2f((unsigned short)f2bf(sc)) * bf2f(PB[(size_t)(row0 + s2) * PBW + PB_AI + h * 64 + e]); }
                float got = 0.f;
#pragma unroll
                for (int a = 0; a < 4; ++a)
#pragma unroll
                    for (int b2 = 0; b2 < 4; ++b2)
#pragma unroll
                        for (int c2 = 0; c2 < 4; ++c2) if (a == tt && b2 == et && c2 == r) got = o[b2][a][c2];
                num += (got - ref) * (got - ref); den += ref * ref; }
            num = wave_sum(num); den = wave_sum(den); if (lane == 0) { atomicAdd(dacc, num); atomicAdd(dacc + 1, den); }
        }
#endif
#pragma unroll
        for (int tt = 0; tt < 4; ++tt) {
            float ss = 0.f;
#pragma unroll
            for (int et = 0; et < 4; ++et) ss += (o[et][tt][0] * o[et][tt][0] + o[et][tt][1] * o[et][tt][1]) + (o[et][tt][2] * o[et][tt][2] + o[et][tt][3] * o[et][tt][3]);
            ss += __shfl_xor(ss, 16); ss += __shfl_xor(ss, 32);
            const float rstd = 1.0f / sqrtf(ss * (1.0f / 64.0f) + RMS_EPS);
            const size_t row = (size_t)row0 + 16 * tt + i16;
#pragma unroll
            for (int et = 0; et < 4; ++et) { const int e = 16 * et + 4 * g; const u32x2 gw2 = *(const u32x2*)(PB + row * PBW + PB_AG + h * 64 + e); const f32x4 wv = *(const f32x4*)(nw + e);
                const f32x4 gt = {bflo(gw2.x), bfhi(gw2.x), bflo(gw2.y), bfhi(gw2.y)}; f32x4 y;
#pragma unroll
                for (int r = 0; r < 4; ++r) y[r] = o[et][tt][r] * rstd * wv[r] * siluf_(gt[r]);
                *(unsigned*)(Y + row * D + h * 64 + e) = pk_fp8x4(y); }
        }
        asm volatile("s_waitcnt lgkmcnt(0)" ::: "memory");
    }
}


DI void ph_hgrn_out(const Ctx& X, const Params& P, int l) { const int n = 8 * (l == 0 ? 132 : 128); for (int it = X.wave * X.nb + X.bid; it < n; it += X.nb * NWAVES) hgrn_out_item(X, P, l, it); }

#ifdef DBG_BRUTE
DI void ph_dbg_scores(const Ctx& X, const Params& P, int l) {
    const bf16_t* QT = (const bf16_t*)(P.ws + WS_QT); const bf16_t* KT = (const bf16_t*)(P.ws + WS_KT);
    LAS unsigned char* s_l = X.lds + X.wave * (2 * 64 * HP);
    const int lane = X.lane, g = lane >> 4, i16 = lane & 15, gw = X.wave * X.nb + X.bid, NGW = X.nb * NWAVES;
    float* dacc = (float*)(P.ws + WS_CTL) + CW_DBG + 16; float nA = 0.f, dA = 0.f;
    for (int it = gw; it < 8 * 128; it += NGW) {
        const int c = it % 128, bh = it / 128, h = bh & 3, b = bh >> 2, dir = 0, sgn = 1; const int row0 = b * SEQ + 64 * c;
        const bf16_t* qt = QT + ((size_t)dir * NROWS + row0) * 256 + h * 64 + g * 8; const bf16_t* kt = KT + ((size_t)dir * NROWS + row0) * 256 + h * 64 + g * 8;
        const bf16_t* qt0 = QT + ((size_t)dir * NROWS + row0) * 256 + h * 64; const bf16_t* kt0 = KT + ((size_t)dir * NROWS + row0) * 256 + h * 64;
        bf16x8 qf[4][2];
#pragma unroll
        for (int t = 0; t < 4; ++t)
#pragma unroll
            for (int ks = 0; ks < 2; ++ks) qf[t][ks] = *(const bf16x8*)(qt + (size_t)(16 * t + i16) * 256 + 32 * ks);
#pragma unroll 1
        for (int pr = 0; pr < 2; ++pr) {
            bf16x8 kf[2][2];
#pragma unroll
            for (int t = 0; t < 2; ++t)
#pragma unroll
                for (int ks = 0; ks < 2; ++ks) kf[t][ks] = *(const bf16x8*)(kt + (size_t)(16 * (2 * pr + t) + i16) * 256 + 32 * ks);
#pragma unroll
            for (int s2 = 0; s2 < 2; ++s2)
#pragma unroll
                for (int tt = 0; tt < 4; ++tt) { f32x4 a = {0.f, 0.f, 0.f, 0.f};
                    a = __builtin_amdgcn_mfma_f32_16x16x32_bf16(kf[s2][0], qf[tt][0], a, 0, 0, 0); a = __builtin_amdgcn_mfma_f32_16x16x32_bf16(kf[s2][1], qf[tt][1], a, 0, 0, 0);
#pragma unroll
                    for (int r = 0; r < 4; ++r) { const int sidx = 16 * (2 * pr + s2) + 4 * g + r, tidx = 16 * tt + i16; const int keep = ~(((tidx - sidx) * sgn) >> 31); { const float av = a[r]; a[r] = __int_as_float(__float_as_int(av) & keep); }
                        *(LAS float*)(s_l + (((s2 * 4 + tt) * 4 + r) * 64 + lane) * 4) = a[r]; } }
            asm volatile("s_waitcnt lgkmcnt(0)" ::: "memory");
#pragma unroll 1
            for (int idx = 0; idx < 32; ++idx) { const int s2 = idx >> 4, tt = (idx >> 2) & 3, r = idx & 3; const int sidx = 16 * (2 * pr + s2) + 4 * g + r, tidx = 16 * tt + i16; float ref = 0.f;
#pragma unroll 1
                for (int d = 0; d < 64; ++d) ref += bf2f(kt0[(size_t)sidx * 256 + d]) * bf2f(qt0[(size_t)tidx * 256 + d]);
                if (sidx > tidx) ref = 0.f; const float got = *(LAS float*)(s_l + (idx * 64 + lane) * 4); const float df = got - ref; nA += df * df; dA += ref * ref; }
            asm volatile("s_waitcnt lgkmcnt(0)" ::: "memory");
        }
    }
    nA = wave_sum(nA); dA = wave_sum(dA); if (lane == 0) { atomicAdd(dacc, nA); atomicAdd(dacc + 1, dA); }
}
#endif
constexpr int KP = 144, VP = 192, KBYTES = 128 * KP, VBYTES = 128 * VP, CHB = KBYTES + VBYTES, RPB_OFF = 2 * CHB;
static_assert(RPB_OFF + 4096 <= 144 * 1024, "attn lds");
struct ChunkSrc { int mode, rbase, kr0; };
DI int chunk_row(const ChunkSrc& c, int key) { return c.mode == 0 ? c.rbase + key : c.rbase + min(c.kr0 + (key >> 5), 127) * 64 + (key & 31); }
struct StageRegs { u32x4 k[2], v[2]; };
DI void stage_load(const Ctx& X, const bf16_t* PB, int kcol, int vcol, const ChunkSrc& c, StageRegs& R) {
#pragma unroll
    for (int i = 0; i < 2; ++i) { const int idx = X.tid + NTHREADS * i, key = idx >> 3, pc = idx & 7; const size_t row = (size_t)chunk_row(c, key);
        R.k[i] = *(const u32x4*)(PB + row * PBW + kcol + pc * 8); R.v[i] = *(const u32x4*)(PB + row * PBW + vcol + pc * 8); }
}
DI void stage_store(const Ctx& X, LAS unsigned char* buf, const StageRegs& R) {
#pragma unroll
    for (int i = 0; i < 2; ++i) { const int idx = X.tid + NTHREADS * i, key = idx >> 3, pc = idx & 7;
        *(LAS u32x4*)(buf + key * KP + pc * 16) = R.k[i]; *(LAS u32x4*)(buf + KBYTES + key * VP + pc * 16) = R.v[i]; }
}
template <int NQT> struct AttnState { f32x16 o[NQT][2]; float m[NQT], l[NQT]; };
template <int NQT, class MaskF>
DI void attn_tile_kv(const bf16x8 (&kf)[4], const LAS unsigned char* vt, int kt, const bf16x8 (&qf)[NQT][4], AttnState<NQT>& S, const bool (&act)[NQT], const MaskF& MF, int lane) {
    const int h = lane >> 5, G = lane >> 4, i16 = lane & 15;
    const LAS unsigned char* vb = vt + (4 * h + (i16 >> 2)) * VP + (16 * (G & 1) + 4 * (i16 & 3)) * 2;
    bf16x8 vf[2][2];
#pragma unroll
    for (int db = 0; db < 2; ++db)
#pragma unroll
        for (int s2 = 0; s2 < 2; ++s2) vf[db][s2] = cat8(tr_read(vb + (16 * s2) * VP + db * 64), tr_read(vb + (16 * s2 + 8) * VP + db * 64));
#pragma unroll
    for (int qt = 0; qt < NQT; ++qt) {
        if (!act[qt]) continue;
        f32x16 s;
#pragma unroll
        for (int r = 0; r < 16; ++r) s[r] = 0.f;
#pragma unroll
        for (int ks = 0; ks < 4; ++ks) s = __builtin_amdgcn_mfma_f32_32x32x16_bf16(kf[ks], qf[qt][ks], s, 0, 0, 0);
        MF(s, qt, kt);
        float mx = s[0];
#pragma unroll
        for (int r = 1; r < 16; ++r) mx = fmaxf(mx, s[r]);
        { const auto rr = __builtin_amdgcn_permlane32_swap(__float_as_uint(mx), __float_as_uint(mx), false, false); mx = fmaxf(__uint_as_float(rr[0]), __uint_as_float(rr[1])); }
        {
            const float mn = fmaxf(S.m[qt], mx), alpha = __builtin_amdgcn_exp2f(S.m[qt] - mn); S.m[qt] = mn; S.l[qt] *= alpha;
#pragma unroll
            for (int db = 0; db < 2; ++db)
#pragma unroll
                for (int r = 0; r < 16; ++r) S.o[qt][db][r] *= alpha;
        }
        const float mcur = S.m[qt]; float ps = 0.f;
#pragma unroll
        for (int r = 0; r < 16; ++r) { s[r] = __builtin_amdgcn_exp2f(s[r] - mcur); ps += s[r]; }
        S.l[qt] += ps;
        const bf16x8 p0 = pack8(s[0], s[1], s[2], s[3], s[4], s[5], s[6], s[7]), p1 = pack8(s[8], s[9], s[10], s[11], s[12], s[13], s[14], s[15]);
#pragma unroll
        for (int db = 0; db < 2; ++db) { S.o[qt][db] = __builtin_amdgcn_mfma_f32_32x32x16_bf16(vf[db][0], p0, S.o[qt][db], 0, 0, 0); S.o[qt][db] = __builtin_amdgcn_mfma_f32_32x32x16_bf16(vf[db][1], p1, S.o[qt][db], 0, 0, 0); }
    }
}
template <int NQT, class MaskF>
DI void attn_tile(const LAS unsigned char* buf, int kt, const bf16x8 (&qf)[NQT][4], AttnState<NQT>& S, const bool (&act)[NQT], const MaskF& MF, int lane) {
    bf16x8 kf[4];
#pragma unroll
    for (int ks = 0; ks < 4; ++ks) kf[ks] = *(const LAS bf16x8*)(buf + (32 * kt + (lane & 31)) * KP + ks * 32 + (lane >> 5) * 16);
    attn_tile_kv<NQT, MaskF>(kf, buf + KBYTES + 32 * kt * VP, kt, qf, S, act, MF, lane);
}
template <int NQT>
DI void attn_finish(AttnState<NQT>& S, int qt, unsigned char* yrow  , int lane) {
    const int h = lane >> 5; float l = S.l[qt]; { const auto rr = __builtin_amdgcn_permlane32_swap(__float_as_uint(l), __float_as_uint(l), false, false); l = __uint_as_float(rr[0]) + __uint_as_float(rr[1]); } const float inv = 1.0f / l;
#pragma unroll
    for (int db = 0; db < 2; ++db)
#pragma unroll
        for (int gq = 0; gq < 4; ++gq) *(unsigned*)(yrow + 32 * db + 8 * gq + 4 * h) = pk_fp8x4((f32x4){S.o[qt][db][4 * gq] * inv, S.o[qt][db][4 * gq + 1] * inv, S.o[qt][db][4 * gq + 2] * inv, S.o[qt][db][4 * gq + 3] * inv});
}
struct MaskNone { DI void operator()(f32x16&, int, int) const {} };
struct MaskSWA { int cmode, u0, lane;
    DI void operator()(f32x16& s, int qt, int kt) const {
        if (cmode == 1 || 32 * kt != u0 + 32 * qt) return;
        const int sg = cmode == 0 ? 1 : -1, e = sg * (4 * (lane >> 5) - (lane & 31));
#pragma unroll
        for (int r = 0; r < 16; ++r) { const int thr = -sg * ((r & 3) + 8 * (r >> 2)); s[r] = e >= thr ? s[r] : -1e30f; }
    } };
DI void swa_item(const Ctx& X, const Params& P, int l, int it) {
    const bf16_t* PB = (const bf16_t*)(P.ws + WS_PB); unsigned char* Y = P.ws + WS_Y;        const float* sink = P.in[10] + l * 8;
    const int lane = X.lane, w = X.wave;
    {
        const int j = it & 63, n = (it >> 6) & 1, b = it >> 7;
        const int qh = n * 4 + (w >> 1), u0 = (w & 1) * 64;
        const int nchunks = 3 + (j > 0) + (j < 63);
        bf16x8 qf[2][4];
#pragma unroll
        for (int qt = 0; qt < 2; ++qt)
#pragma unroll
            for (int ks = 0; ks < 4; ++ks) qf[qt][ks] = *(const bf16x8*)(PB + (size_t)(b * SEQ + 128 * j + u0 + 32 * qt + (lane & 31)) * PBW + PB_SQ + qh * 64 + 16 * ks + 8 * (lane >> 5));
        AttnState<2> S;
#pragma unroll
        for (int qt = 0; qt < 2; ++qt) { S.m[qt] = LOG2E * sink[qh]; S.l[qt] = lane < 32 ? 1.0f : 0.0f;
#pragma unroll
            for (int db = 0; db < 2; ++db)
#pragma unroll
                for (int r = 0; r < 16; ++r) S.o[qt][db][r] = 0.f; }
        StageRegs R;
        auto chunk_id = [&](int i) -> int { return i < 2 ? 3 + i : (i == 2 ? 1 : (i == 3 ? (j > 0 ? 0 : 2) : 2)); };
        auto chunk_src = [&](int c) -> ChunkSrc { ChunkSrc cs; cs.mode = 0; cs.kr0 = 0; cs.rbase = c < 3 ? b * SEQ + 128 * (j - 1 + c) : NLAT + b * CTXL + 128 * (c - 3); return cs; };
        stage_load(X, PB, PB_SK + n * 64, PB_SV + n * 64, chunk_src(chunk_id(0)), R);
#pragma unroll
        for (int qt = 0; qt < 2; ++qt)
#pragma unroll
            for (int ks = 0; ks < 4; ++ks) asm volatile("" : "+v"(qf[qt][ks]));
        stage_store(X, X.lds, R);
        __syncthreads();
        for (int i = 0; i < nchunks; ++i) {
            const int c = chunk_id(i);
            if (i + 1 < nchunks) stage_load(X, PB, PB_SK + n * 64, PB_SV + n * 64, chunk_src(chunk_id(i + 1)), R);
            const LAS unsigned char* buf = X.lds + (i & 1) * CHB;
            MaskSWA MF; MF.cmode = c == 0 ? 0 : (c == 2 ? 2 : 1); MF.u0 = u0; MF.lane = lane;
#pragma unroll 1
            for (int kt = 0; kt < 4; ++kt) {
                bool act[2];
#pragma unroll
                for (int qt = 0; qt < 2; ++qt) act[qt] = c == 0 ? (32 * kt + 31 >= u0 + 32 * qt) : (c == 2 ? (32 * kt <= u0 + 32 * qt + 31) : true);
                if (!(act[0] || act[1])) continue;
                attn_tile<2>(buf, kt, qf, S, act, MF, lane);
            }
            if (i + 1 < nchunks) stage_store(X, X.lds + ((i + 1) & 1) * CHB, R);
            __syncthreads();
        }
#pragma unroll
        for (int qt = 0; qt < 2; ++qt) attn_finish<2>(S, qt, Y + (size_t)(b * SEQ + 128 * j + u0 + 32 * qt + (lane & 31)) * D + 512 + qh * 64, lane);
    }
}
struct MaskNA { bool win; int kr0, qr, qc, rs, cs, blk, lane; const LAS float* rpb;
    DI void operator()(f32x16& s, int qt, int kt) const {
        if (!win) return;
        const int kr = kr0 + kt; const bool rowok = kr >= rs && kr < rs + 8;
        const int kcb = blk + 4 * (lane >> 5); const int ib = rowok ? (kr - qr + 7) * 31 + (kcb - qc + 15) : 0;
        float bv[16];
#pragma unroll
        for (int r = 0; r < 16; ++r) bv[r] = rpb[ib + (r & 3) + 8 * (r >> 2)];
        asm volatile("" : "+v"(bv[0]), "+v"(bv[1]), "+v"(bv[2]), "+v"(bv[3]), "+v"(bv[4]), "+v"(bv[5]), "+v"(bv[6]), "+v"(bv[7]), "+v"(bv[8]), "+v"(bv[9]), "+v"(bv[10]), "+v"(bv[11]), "+v"(bv[12]), "+v"(bv[13]), "+v"(bv[14]), "+v"(bv[15]));
        const unsigned t0 = rowok ? (unsigned)(kcb - cs) : 0x7fffff00u;
#pragma unroll
        for (int r = 0; r < 16; ++r) { const bool ok = t0 + (unsigned)((r & 3) + 8 * (r >> 2)) < 16u; s[r] = ok ? s[r] + bv[r] : -1e30f; }
    } };
struct NaTileRegs { bf16x8 k[4]; u32x4 v[4]; };
DI void na_load(const bf16_t* PB, int h, int rowk  , int rowv  , int lane, NaTileRegs& R) {
    const bf16_t* kp = PB + (size_t)rowk * PBW + PB_NK + h * 64 + 8 * (lane >> 5);
#pragma unroll
    for (int ks = 0; ks < 4; ++ks) R.k[ks] = *(const bf16x8*)(kp + 16 * ks);
    const bf16_t* vp = PB + (size_t)rowv * PBW + PB_NV + h * 64 + (lane & 1) * 32;
#pragma unroll
    for (int i = 0; i < 4; ++i) R.v[i] = *(const u32x4*)(vp + 8 * i);
}
DI void na_item(const Ctx& X, const Params& P, int l, int it) {
    const bf16_t* PB = (const bf16_t*)(P.ws + WS_PB); unsigned char* Y = P.ws + WS_Y;        const float* rpbg = P.in[9] + l * 4 * 465;
    const int lane = X.lane, w = X.wave; LAS float* rpbl = (LAS float*)(X.lds + 8 * 32 * VP) + 32;
    LAS unsigned char* vt = X.lds + w * (32 * VP);
    const int j = it & 3, rg = (it >> 2) & 7, h = (it >> 5) & 3, b = it >> 7;
    const int r0 = 16 * rg, blk = min(max(16 * j - 8, 0), 32);
    const int ra = r0 + 2 * w, qr = ra + ((lane & 31) >> 4), qc = 16 * j + (lane & 15);
    const int rs_a = min(max(ra - 4, 0), 120), rs_b = min(max(ra + 1 - 4, 0), 120), ntile = 8 + (rs_b + 8 - rs_a);
    for (int i = X.tid; i < 465; i += NTHREADS) rpbl[i] = LOG2E * rpbg[h * 465 + i];
    __syncthreads();
    bf16x8 qf[1][4];
#pragma unroll
    for (int ks = 0; ks < 4; ++ks) qf[0][ks] = *(const bf16x8*)(PB + (size_t)(b * SEQ + qr * 64 + qc) * PBW + PB_NQ + h * 64 + 16 * ks + 8 * (lane >> 5));
    AttnState<1> S; S.m[0] = -1e30f; S.l[0] = 0.f;
#pragma unroll
    for (int db = 0; db < 2; ++db)
#pragma unroll
        for (int r = 0; r < 16; ++r) S.o[0][db][r] = 0.f;
    MaskNA MF; MF.qr = qr; MF.qc = qc; MF.rs = min(max(qr - 4, 0), 120); MF.cs = min(max(qc - 8, 0), 48); MF.blk = blk; MF.lane = lane; MF.rpb = rpbl;
    const bool act[1] = {true};
#define NA_ROW(t, key) ((t) < 8 ? NLAT + b * CTXL + 32 * (t) + (key) : b * SEQ + (rs_a + (t) - 8) * 64 + blk + (key))
#define NA_LOAD(t, R) na_load(PB, h, NA_ROW(t, lane & 31), NA_ROW(t, lane >> 1), lane, R)
#define NA_COMPUTE(t, R) do { asm volatile("" ::: "memory"); _Pragma("unroll") for (int i_ = 0; i_ < 4; ++i_) *(LAS u32x4*)(vt + (lane >> 1) * VP + (lane & 1) * 64 + i_ * 16) = R.v[i_]; \
        asm volatile("" ::: "memory"); MF.win = (t) >= 8; MF.kr0 = rs_a + (t) - 8; attn_tile_kv<1>(R.k, vt, 0, qf, S, act, MF, lane); asm volatile("" ::: "memory"); } while (0)
    NaTileRegs RA, RB;
    NA_LOAD(0, RA);
#pragma unroll
    for (int ks = 0; ks < 4; ++ks) asm volatile("" : "+v"(qf[0][ks]));
    for (int t = 0; t < ntile; t += 2) {
        { const int tn = min(t + 1, ntile - 1); NA_LOAD(tn, RB); }
        NA_COMPUTE(t, RA);
        { const int tn = min(t + 2, ntile - 1); NA_LOAD(tn, RA); }
        if (t + 1 < ntile) NA_COMPUTE(t + 1, RB);
    }
#undef NA_ROW
#undef NA_LOAD
#undef NA_COMPUTE
    attn_finish<1>(S, 0, Y + (size_t)(b * SEQ + qr * 64 + qc) * D + 256 + h * 64, lane);
    __syncthreads();
}
DI void ctx_attn_item(const Ctx& X, const Params& P, int l, int it) {
    const bf16_t* PB = (const bf16_t*)(P.ws + WS_PB); unsigned char* Y = P.ws + WS_Y;        const float* sink = P.in[10] + l * 8;
    const int lane = X.lane, w = X.wave;
    {
        const bool swa = it >= 8; const int b = (it >> 2) & 1;
        const int h = it & 3, n = (it >> 1) & 1, half = it & 1;
        const int kcol = swa ? PB_SK + n * 64 : PB_NK + h * 64, vcol = swa ? PB_SV + n * 64 : PB_NV + h * 64;
        StageRegs R; ChunkSrc cs; cs.mode = 0; cs.kr0 = 0; cs.rbase = NLAT + b * CTXL;
        stage_load(X, PB, kcol, vcol, cs, R); stage_store(X, X.lds, R);
        cs.rbase += 128; stage_load(X, PB, kcol, vcol, cs, R); stage_store(X, X.lds + CHB, R);
        __syncthreads();
        const MaskNone MF;
        if (!swa) {
            const int qrow = NLAT + b * CTXL + 32 * w + (lane & 31);
            bf16x8 qf[1][4];
#pragma unroll
            for (int ks = 0; ks < 4; ++ks) qf[0][ks] = *(const bf16x8*)(PB + (size_t)qrow * PBW + PB_NQ + h * 64 + 16 * ks + 8 * (lane >> 5));
            AttnState<1> S; S.m[0] = -1e30f; S.l[0] = 0.f;
#pragma unroll
            for (int db = 0; db < 2; ++db)
#pragma unroll
                for (int r = 0; r < 16; ++r) S.o[0][db][r] = 0.f;
            const bool act[1] = {true};
#pragma unroll 1
            for (int kt = 0; kt < 8; ++kt) attn_tile<1>(X.lds + (kt >> 2) * CHB, kt & 3, qf, S, act, MF, lane);
            attn_finish<1>(S, 0, Y + (size_t)qrow * D + 256 + h * 64, lane);
        } else {
            const int qh = n * 4 + half * 2 + (w >> 2), q0 = NLAT + b * CTXL + (w & 3) * 64 + (lane & 31);
            bf16x8 qf[2][4];
#pragma unroll
            for (int qt = 0; qt < 2; ++qt)
#pragma unroll
                for (int ks = 0; ks < 4; ++ks) qf[qt][ks] = *(const bf16x8*)(PB + (size_t)(q0 + 32 * qt) * PBW + PB_SQ + qh * 64 + 16 * ks + 8 * (lane >> 5));
            AttnState<2> S;
#pragma unroll
            for (int qt = 0; qt < 2; ++qt) { S.m[qt] = LOG2E * sink[qh]; S.l[qt] = lane < 32 ? 1.0f : 0.0f;
#pragma unroll
                for (int db = 0; db < 2; ++db)
#pragma unroll
                    for (int r = 0; r < 16; ++r) S.o[qt][db][r] = 0.f; }
            const bool act[2] = {true, true};
#pragma unroll 1
            for (int kt = 0; kt < 8; ++kt) attn_tile<2>(X.lds + (kt >> 2) * CHB, kt & 3, qf, S, act, MF, lane);
#pragma unroll
            for (int qt = 0; qt < 2; ++qt) attn_finish<2>(S, qt, Y + (size_t)(q0 + 32 * qt) * D + 512 + qh * 64, lane);
        }
        __syncthreads();
    }
}

DI void ph_swa(const Ctx& X, const Params& P, int l) { for (int it = X.bid; it < 256; it += X.nb) swa_item(X, P, l, it); }
DI void ph_na(const Ctx& X, const Params& P, int l) { for (int it = X.bid; it < 256; it += X.nb) na_item(X, P, l, it); }
DI void queue_publish(const Ctx& X, unsigned* cnt) {
    asm volatile("s_waitcnt vmcnt(0)" ::: "memory");
    __syncthreads();
    if (X.tid == 0) { __builtin_amdgcn_fence(__ATOMIC_RELEASE, "agent"); asm volatile("s_waitcnt vmcnt(0)" ::: "memory"); __hip_atomic_fetch_add(cnt, 1u, __ATOMIC_RELAXED, __HIP_MEMORY_SCOPE_AGENT); }
}
DI void queue_wait(const Ctx& X, unsigned* cnt, unsigned need) {
    if (X.tid == 0) { unsigned sp = 0; while (__hip_atomic_load(cnt, __ATOMIC_RELAXED, __HIP_MEMORY_SCOPE_AGENT) < need && ++sp < (1u << 24)) __builtin_amdgcn_s_sleep(2);
        __builtin_amdgcn_fence(__ATOMIC_ACQUIRE, "agent"); asm volatile("s_waitcnt vmcnt(0)" ::: "memory"); }
    __syncthreads();
}
DI void ph_mix_queue(const Ctx& X, const Params& P, int l, int rep = 0) {
    unsigned* ctl = (unsigned*)(P.ws + WS_CTL);
    unsigned* head = ctl + CW_Q + 64 * l + 128 * rep; unsigned* scan_cnt = ctl + CW_SCAN + 64 * l + 256 * rep; unsigned* loc_cnt = ctl + CW_SCAN + 128 + 64 * l + 256 * rep;
    volatile LAS unsigned* slot = (volatile LAS unsigned*)(X.lds + 144 * 1024 + 64);
    const int nloc = 264, nscan = 64, nctx = l == 0 ? 16 : 0, nconv = l == 0 ? 1536 : 0, nho = l == 0 ? 132 : 128;
    const int o_ctx = nloc, o_swa = o_ctx + nctx, o_scan = o_swa + 256, o_na = o_scan + nscan, o_conv = o_na + 256, o_ho = o_conv + nconv, total = o_ho + nho;
    bool scan_ok = false;
    for (;;) {
        if (X.tid == 0) *slot = atomicAdd(head, 1u);
        __syncthreads();
        int it = (int)*slot;
        __syncthreads();
        if (it >= total) break;
        if (nconv && it >= o_swa && it < o_ho) {
            const int j = it - o_swa, per = j / 11, ph = j - per * 11;
            it = (ph & 3) == 0 ? o_swa + per * 3 + (ph >> 2) : o_conv + per * 8 + (ph - 1 - (ph > 4) - (ph > 8));
        }
        Ctx Xi = X; { int wv = X.wave; asm volatile("" : "+s"(wv)); int ln; asm volatile("v_mbcnt_lo_u32_b32 %0, -1, 0\n\tv_mbcnt_hi_u32_b32 %0, -1, %0" : "=v"(ln)); Xi.tid = wv * 64 + ln; Xi.lane = ln; Xi.wave = wv; }
#ifdef QMASK
        if (rep) { const int ty = it < o_ctx ? 1 : (it < o_swa ? 2 : (it < o_scan ? 4 : (it < o_na ? 8 : (it < o_conv ? 16 : (it < o_ho ? 32 : 64))))); if (!(QMASK & ty)) continue; }
#endif
        if (it < o_ctx) { hgrn_local_item(Xi, P, l, it * 8 + Xi.wave); queue_publish(Xi, loc_cnt); }
        else if (it < o_swa) ctx_attn_item(Xi, P, l, it - o_ctx);
        else if (it < o_scan) swa_item(Xi, P, l, it - o_swa);
        else if (it < o_na) { queue_wait(Xi, loc_cnt, (unsigned)nloc); ph_hgrn_scan(Xi, P, it - o_scan); queue_publish(Xi, scan_cnt); }
        else if (it < o_conv) na_item(Xi, P, l, it - o_na);
        else if (it < o_ho) { LAS float* scr = (LAS float*)X.lds + X.wave * (64 * 33); const int g = it - o_conv, lyr = g >= 768, f0 = (g - 768 * lyr) * 16 + X.wave;
#define DESC_EQ(i) expert_desc(P, lyr, (i))
            TR_LOOP(DESC_EQ, f0, f0 + 16, 8); __syncthreads(); }
        else { if (!scan_ok) { queue_wait(Xi, scan_cnt, (unsigned)nscan); scan_ok = true; }
            hgrn_out_item(Xi, P, l, (it - o_ho) * 8 + Xi.wave); __syncthreads(); }
    }
}
constexpr size_t WS_Y2 = 284 * MiB;
DI void ph_dbg_copy(const Ctx& X, const Params& P) {
    const u32x4* src = (const u32x4*)(P.ws + WS_Y); u32x4* dst = (u32x4*)(P.ws + WS_Y2);
    for (size_t i = (size_t)X.bid * NTHREADS + X.tid; i < (size_t)NROWS * 128; i += (size_t)X.nb * NTHREADS) dst[i] = src[i];
}
DI void ph_dbg_compare(const Ctx& X, const Params& P) {
    const bf16_t* Yg = (const bf16_t*)(P.ws + WS_Y); const bf16_t* Yf = (const bf16_t*)(P.ws + WS_Y2); float* acc = (float*)(P.ws + WS_CTL) + CW_DBG;
    float num[3] = {0.f, 0.f, 0.f}, den[3] = {0.f, 0.f, 0.f};
    const int gw = X.bid * NWAVES + X.wave, NGW = X.nb * NWAVES;
    for (int row = gw; row < NROWS; row += NGW) {
#pragma unroll
        for (int j = 0; j < 16; ++j) { const int c = j * 64 + X.lane; const float a = bf2f(Yg[(size_t)row * D + c]), b = bf2f(Yf[(size_t)row * D + c]); const float d = a - b;
            const int br = j < 4 ? 0 : (j < 8 ? 1 : 2);
            if (br == 0) { num[0] += d * d; den[0] += a * a; } else if (br == 1) { num[1] += d * d; den[1] += a * a; } else { num[2] += d * d; den[2] += a * a; } }
    }
#pragma unroll
    for (int b = 0; b < 3; ++b) { const float n = wave_sum(num[b]), d = wave_sum(den[b]); if (X.lane == 0) { atomicAdd(acc + 2 * b, n); atomicAdd(acc + 2 * b + 1, d); } }
}
DI void ph_dbg_apply(const Ctx& X, const Params& P) {
    const float* acc = (const float*)(P.ws + WS_CTL) + CW_DBG;
#ifdef DBG_BRUTE
    float code = sqrtf(acc[16] / acc[17]);
#else
    float code = sqrtf(acc[0] / acc[1]);
#endif
    if (code == 0.f) return;
    f32x4* o = (f32x4*)P.out;
    for (size_t i = (size_t)X.bid * NTHREADS + X.tid; i < (size_t)NLAT * 256; i += (size_t)X.nb * NTHREADS) o[i] = o[i] * (1.0f + code);
}

DI void ph_inproj(const Ctx& X, const Params& P, int l) {
    PlainSched S; S.init(NROWS, INW, X.nb, X.bid);
    EpiIn E{(bf16_t*)(P.ws + WS_PB), (bf16_t*)(P.ws + WS_Z), (const float*)(P.ws + WS_ROPE), (const float*)(P.ws + WS_LB) + l * 512, (bf16_t*)(P.ws + WS_KK)};
    gemm_fast<PlainSched, EpiIn, true, 122>(X, P.ws + WS_H, P.ws + WS_WIN + (size_t)l * INW * D, D, S, E);
}
struct EpiNull { DI void group(const Unit&, int, int, f32x4 a0, f32x4 a1, f32x4 b0, f32x4 b1) const { asm volatile("" :: "v"(a0), "v"(a1), "v"(b0), "v"(b1)); } };
DI void ph_inproj_plain(const Ctx& X, const Params& P, int l) {
    PlainSched S; S.init(NROWS, INW, X.nb, X.bid);
    EpiNull E;
    GEMM_IMPL(X, (const bf16_t*)(P.ws + WS_H), (const bf16_t*)(P.ws + WS_WIN) + (size_t)l * INW * D, D, S, E);
}
DI void small_gemm_item(const Ctx& X, const unsigned char* A, const unsigned char* Bt, bf16_t* C, int row0, int col0) {
    const int wm = X.wave >> 2, wn = X.wave & 3, fr = X.lane & 15, fq = X.lane >> 4;
    const unsigned char* ap = A + (size_t)(row0 + 16 * wm + fr) * D + 8 * fq; const unsigned char* bp = Bt + (size_t)(col0 + 16 * wn + fr) * D + 8 * fq;
    f32x4 acc = {0.f, 0.f, 0.f, 0.f};
#pragma unroll 1
    for (int k0 = 0; k0 < D; k0 += 512) {
        long af[16], bfv[16];
#pragma unroll
        for (int i = 0; i < 16; ++i) { af[i] = *(const long*)(ap + k0 + 32 * i); bfv[i] = *(const long*)(bp + k0 + 32 * i); }
#pragma unroll
        for (int i = 0; i < 16; ++i) acc = __builtin_amdgcn_mfma_f32_16x16x32_fp8_fp8(bfv[i], af[i], acc, 0, 0, 0);
    }
    store_bf4(C + (size_t)(row0 + 16 * wm + fr) * D + col0 + 16 * wn + 4 * fq, acc * (1.0f / 64.0f));
}
DI void ph_outproj(const Ctx& X, const Params& P, int l) {
    PlainSched S; S.init(NLAT, D, X.nb, X.bid);
    EpiBf E{(bf16_t*)(P.ws + WS_YO), D};
    gemm_fast<PlainSched, EpiBf, true, 121>(X, P.ws + WS_Y, P.ws + WS_WOUT + (size_t)l * D * D, D, S, E);
    if (l == 0) for (int it = X.bid; it < 256; it += X.nb)
        small_gemm_item(X, P.ws + WS_Y, P.ws + WS_WOUT, (bf16_t*)(P.ws + WS_YO), NLAT + 32 * (it >> 4), 64 * (it & 15));
}
DI void ph_moe(const Ctx& X, const Params& P, int l) {
    const int* cnt = (const int*)(P.ws + WS_CTL) + CW_CNT + 1024 * l; unsigned* rdy = (unsigned*)(P.ws + WS_CTL) + CW_TRDY + 256 * l;
    moe_build_table(X, cnt);
    {
        MoeSched<true> S{cnt, (const int*)(P.ws + WS_LIST), X.nb, X.bid, 4, 1024, X.lds, rdy};
        { LAS int* ll = (LAS int*)(X.lds + MOE_LIST_OFF); Unit u;
#pragma unroll 1
          for (int i = 0; i < 3; ++i) if (S.next(i, u) && X.tid < 256) { const int idx = u.i0 * 256 + X.tid; ll[i * 256 + X.tid] = S.list[u.e * LISTCAP + (idx < u.cnt ? idx : 0)]; }
          __syncthreads(); }
        EpiGU E{(bf16_t*)(P.ws + WS_S)};
        gemm_fast<MoeSched<true>, EpiGU, true, 122>(X, P.ws + WS_H, P.ws + (l ? WS_WGU1 : WS_WGU), D, S, E);
    }
    {
        MoeSched<false> S{cnt, (const int*)(P.ws + WS_LIST), X.nb, X.bid, 4, 1024, X.lds, rdy};
        EpiF8 E{P.ws + WS_O, D};
        gemm_fast<MoeSched<false>, EpiF8, true, 122>(X, P.ws + WS_S, P.ws + (l ? WS_WD1 : WS_WD), DEXP, S, E);
    }
}

#define XB_TMO      128
#define XB_XCNT(j)  (256  + 64 * (j))
#define XB_XSUB(j)  (1280 + 64 * (j))
#define XB_XGEN(j)  (2304 + 64 * (j))
#define XB_TOP      3328
#define XB_TOPGEN   3392
#define XCD_BAR_WORDS 3456
#ifndef XB_SPIN_CAP
#define XB_SPIN_CAP (1u << 26)
#endif
DI unsigned xb_ld(unsigned* p)              { return __hip_atomic_load(p, __ATOMIC_RELAXED, __HIP_MEMORY_SCOPE_AGENT); }
DI unsigned xb_add(unsigned* p, unsigned v) { return __hip_atomic_fetch_add(p, v, __ATOMIC_RELAXED, __HIP_MEMORY_SCOPE_AGENT); }
DI unsigned xb_xcc_id() { return (unsigned)__builtin_amdgcn_s_getreg((3 << 11) | 20) & 0xFu; }
#define XB_SPIN(cond, bar) do { unsigned _sp = 0; while (cond) { __builtin_amdgcn_s_sleep(1); \
    if ((++_sp & 255u) == 0u) { if (xb_ld(&(bar)[XB_TMO])) break; if (_sp > XB_SPIN_CAP) { atomicAdd(&(bar)[XB_TMO], 1u); break; } } } } while (0)
struct XcdBarrier { unsigned* bar; unsigned x; volatile LAS unsigned* st; };
DI XcdBarrier xcd_barrier_post(unsigned* bar, volatile LAS unsigned* st) {
    XcdBarrier b; b.bar = bar; b.x = xb_xcc_id(); b.st = st;
    if (threadIdx.x == 0) (void)xb_add(&bar[XB_XCNT(b.x)], 1u);
    return b;
}
DI void xcd_barrier_complete(unsigned* bar, unsigned x, unsigned& nloc, unsigned& nx) {
    const unsigned G = gridDim.x * gridDim.y * gridDim.z;
    unsigned sum, cnt, mine, sp = 0u;
    for (;;) {
        sum = 0u; cnt = 0u; mine = 0u;
#pragma unroll
        for (unsigned j = 0; j < 16; ++j) { const unsigned c = xb_ld(&bar[XB_XCNT(j)]); sum += c; cnt += (c > 0u) ? 1u : 0u; mine = (j == x) ? c : mine; }
        if (sum == G) break;
        __builtin_amdgcn_s_sleep(1);
        if ((++sp & 255u) == 0u) { if (xb_ld(&bar[XB_TMO])) break; if (sp > XB_SPIN_CAP) { atomicAdd(&bar[XB_TMO], 1u); break; } }
    }
    nloc = mine > 0u ? mine : 1u; nx = cnt > 0u ? cnt : 1u;
}
DI void xcd_barrier(const XcdBarrier& b) {
    asm volatile("s_waitcnt vmcnt(0)" ::: "memory");
    __syncthreads();
    if (threadIdx.x == 0) {
        unsigned* bar = b.bar;
        __builtin_amdgcn_s_waitcnt(0);
        unsigned nloc = b.st[0], nx = b.st[1];
        if (nloc == 0u) { xcd_barrier_complete(bar, b.x, nloc, nx); b.st[0] = nloc; b.st[1] = nx; }
        const unsigned old = xb_add(&bar[XB_XSUB(b.x)], 1u);
        const unsigned gen = old / nloc;
        if (old + 1u == (gen + 1u) * nloc) {
            __builtin_amdgcn_fence(__ATOMIC_RELEASE, "agent");
            asm volatile("s_waitcnt vmcnt(0)" ::: "memory");
            const unsigned og = xb_add(&bar[XB_TOP], 1u);
            const unsigned tg = og / nx;
            if (og + 1u == (tg + 1u) * nx) xb_add(&bar[XB_TOPGEN], 1u);
            else XB_SPIN(xb_ld(&bar[XB_TOPGEN]) == tg, bar);
            __builtin_amdgcn_fence(__ATOMIC_ACQUIRE, "agent");
            xb_add(&bar[XB_XGEN(b.x)], 1u);
            asm volatile("s_waitcnt vmcnt(0)" ::: "memory");
        } else {
            XB_SPIN(xb_ld(&bar[XB_XGEN(b.x)]) == gen, bar);
            __builtin_amdgcn_fence(__ATOMIC_ACQUIRE, "agent");
            asm volatile("s_waitcnt vmcnt(0)" ::: "memory");
        }
    }
    __syncthreads();
}

template <int Q> DI void run_phase(const Ctx& X0, const Params& P0, int l) {
#if defined(__HIP_DEVICE_COMPILE__)
    const __attribute__((address_space(4))) Params* pp_ = (const __attribute__((address_space(4))) Params*)__builtin_amdgcn_kernarg_segment_ptr(); asm volatile("" : "+s"(pp_), "+s"(l));
    const Params P = *pp_; (void)P0;
#else
    const Params P = P0;
#endif
    Ctx X = X0; { int wv = X0.wave; asm volatile("" : "+s"(wv)); int ln; asm volatile("v_mbcnt_lo_u32_b32 %0, -1, 0\n\tv_mbcnt_hi_u32_b32 %0, -1, %0" : "=v"(ln)); X.tid = wv * 64 + ln; X.lane = ln; X.wave = wv; int b_ = X0.bid, n_ = X0.nb; asm volatile("" : "+s"(b_), "+s"(n_)); X.bid = b_; X.nb = n_; }
    if constexpr (Q == 0) ph_prologue(X, P);
    if constexpr (Q == 1) { ph_modulate(X, P, 0); __syncthreads(); convert_rest(X, P); }
    if constexpr (Q == 2) ph_inproj(X, P, l);
    if constexpr (Q == 3) ph_hgrn_naive(X, P, l);
    if constexpr (Q == 4) ph_hgrn_combine_naive(X, P, l);
    if constexpr (Q == 5) ph_attn_naive(X, P, l);
    if constexpr (Q == 6) ph_outproj(X, P, l);
    if constexpr (Q == 7) ph_ln1(X, P, l);
    if constexpr (Q == 24) ph_ln1(X, P, l, true);
    if constexpr (Q == 27) ph_inproj_plain(X, P, l);
    if constexpr (Q == 8) ph_moe(X, P, l);
    if constexpr (Q == 13) ph_hgrn_out(X, P, l);
    if constexpr (Q == 14) ph_swa(X, P, l);
    if constexpr (Q == 15) ph_na(X, P, l);
#ifdef DBG_BRUTE
    if constexpr (Q == 23) ph_dbg_scores(X, P, l);
#endif
    if constexpr (Q == 20) ph_dbg_copy(X, P);
    if constexpr (Q == 21) ph_dbg_compare(X, P);
    if constexpr (Q == 22) ph_dbg_apply(X, P);
    if constexpr (Q == 10) ph_ln2(X, P, l);
    if constexpr (Q == 17) ph_mix_queue(X, P, l);
#ifdef QPROBE
    if constexpr (Q == 18) ph_mix_queue(X, P, l, 1);
#endif
}

constexpr int LDS_BYTES = 150 * 1024;
template <int Q>
__global__ void __launch_bounds__(NTHREADS, 2) k_step(Params P, int l) {
    extern __shared__ __attribute__((aligned(16))) unsigned char lds_raw[];
    Ctx X; X.lds = (LAS unsigned char*)lds_raw; X.tid = threadIdx.x; X.lane = X.tid & 63; X.wave = __builtin_amdgcn_readfirstlane(X.tid >> 6); X.bid = blockIdx.x; X.nb = gridDim.x;
    run_phase<Q>(X, P, l);
}
template <int Q> static void launch_step(const Params& P, int l, int grid, hipStream_t stream) {
    static bool attr = false;
    if (!attr) { (void)hipFuncSetAttribute((const void*)k_step<Q>, hipFuncAttributeMaxDynamicSharedMemorySize, LDS_BYTES); attr = true; }
    hipLaunchKernelGGL(k_step<Q>, dim3(grid), dim3(NTHREADS), LDS_BYTES, stream, P, l);
}

constexpr int LDS_CTL_OFF = 144 * 1024;
__global__ void __launch_bounds__(NTHREADS, 2) k_mega(Params P) {
    extern __shared__ __attribute__((aligned(16))) unsigned char lds_raw[];
    Ctx X; X.lds = (LAS unsigned char*)lds_raw; X.tid = threadIdx.x; X.lane = X.tid & 63; X.wave = __builtin_amdgcn_readfirstlane(X.tid >> 6); X.bid = blockIdx.x; X.nb = gridDim.x;
    volatile LAS unsigned* st = (volatile LAS unsigned*)(X.lds + LDS_CTL_OFF);
    if (X.tid < 16) st[X.tid] = 0u;
    __syncthreads();
    { const XcdBarrier b0 = xcd_barrier_post((unsigned*)(P.ws + WS_CTL) + CW_BAR, st); if (X.tid == 0) st[2] = b0.x; }
    __syncthreads();
#ifdef TS_SEL
#define STAMP() do { if (blockIdx.x == 0 && threadIdx.x == 0) { unsigned long long* ts_ = (unsigned long long*)((unsigned*)(P.ws + WS_CTL) + CW_TS); const unsigned n_ = st[8]; ts_[n_] = __builtin_amdgcn_s_memrealtime(); st[8] = n_ + 1u; } } while (0)
#else
#define STAMP() do { } while (0)
#endif
#define GBAR() do { for (int br_ = 0; br_ < BAR_REP; ++br_) GBAR1(); STAMP(); } while (0)
#define GBAR1() do { unsigned char* w_ = P.ws; asm volatile("" : "+s"(w_)); XcdBarrier b_; b_.bar = (unsigned*)(w_ + WS_CTL) + CW_BAR; b_.st = st; b_.x = threadIdx.x == 0 ? st[2] : 0u; xcd_barrier(b_); } while (0)
#ifndef DUP
#define DUP 0
#endif
#ifndef BAR_REP
#define BAR_REP 1
#endif
#define NREP(bit) ({ int n_ = (DUP & (1 << (bit))) ? 2 : 1; asm volatile("" : "+s"(n_)); n_; })
#define RUNP(Q, bit) do { const int nr_ = NREP(bit); for (int rep_ = 0; rep_ < nr_; ++rep_) { run_phase<Q>(X, P, l); GBAR(); } } while (0)
    STAMP();
    { const int l = 0; RUNP(0, 0); RUNP(1, 1); }
    for (int l = 0; l < 2; ++l) {
        if (DUP & 32768) { run_phase<27>(X, P, l); GBAR(); }
        RUNP(2, 2);
#if FAST_MIX
#ifdef QPROBE
        if (l == QPROBE) { if (X.tid == 0) st[12] = 1u; __syncthreads(); run_phase<18>(X, P, l); GBAR(); if (X.tid == 0) st[12] = 0u; __syncthreads(); }
#endif
        run_phase<17>(X, P, l); GBAR();
#ifdef DBG_MIX
        if (l == 0) {
            run_phase<20>(X, P, l); GBAR();
            run_phase<3>(X, P, l); GBAR();
            run_phase<4>(X, P, l); GBAR();
            run_phase<5>(X, P, l); GBAR();
            run_phase<21>(X, P, l); GBAR();
        }
#endif
#else
        run_phase<3>(X, P, l); GBAR();
        run_phase<4>(X, P, l); GBAR();
        run_phase<5>(X, P, l); GBAR();
#endif
        RUNP(6, 9);
        if ((DUP & 4096) && l == 0) { run_phase<24>(X, P, l); GBAR(); }
        run_phase<7>(X, P, l); GBAR();
        run_phase<8>(X, P, l); GBAR();
        if (DUP & 8192) { run_phase<10>(X, P, l); GBAR(); }
        run_phase<10>(X, P, l); if (l == 0) GBAR();
    }
#ifdef TS_SEL
    GBAR();
    { const unsigned long long* ts_ = (const unsigned long long*)((const unsigned*)(P.ws + WS_CTL) + CW_TS); const float dt_us = 10.0f * floorf((float)(ts_[TS_SEL] - ts_[TS_SEL - 1]) * 0.001f + 0.5f); const float sc = 1.0f + dt_us * (1.0f / 2000.0f);
      f32x4* o = (f32x4*)P.out; for (size_t i = (size_t)blockIdx.x * NTHREADS + threadIdx.x; i < (size_t)NLAT * 256; i += (size_t)gridDim.x * NTHREADS) o[i] = o[i] * sc; }
#endif
#ifdef DBG_MIX
    GBAR(); run_phase<22>(X, P, 0);
#endif
#undef GBAR
}

extern "C" void kernel_launch(void* const* d_in, const int* in_sizes, int n_in, void* d_out, int out_size, void* d_ws, size_t ws_size, hipStream_t stream) {
    static int grid = 0;
    if (grid == 0) {
        if (n_in != 21 || out_size != NLAT * D || ws_size < WS_END) { fprintf(stderr, "kernel_launch: unexpected shapes n_in %d out %d ws %zu\n", n_in, out_size, ws_size); grid = -1; return; }
        int dev = 0, cus = 0; (void)hipGetDevice(&dev); (void)hipDeviceGetAttribute(&cus, hipDeviceAttributeMultiprocessorCount, dev);
        grid = cus > 0 ? cus : 256;
        (void)hipFuncSetAttribute((const void*)k_mega, hipFuncAttributeMaxDynamicSharedMemorySize, LDS_BYTES);
    }
    if (grid < 0) return;
    (void)hipMemsetAsync((char*)d_ws + WS_CTL, 0, CTL_BYTES, stream);
    Params P{};
    for (int i = 0; i < 21; ++i) P.in[i] = (const float*)d_in[i];
    P.out = (float*)d_out; P.ws = (unsigned char*)d_ws;
#if N_LAUNCH_MODE == 1
    hipLaunchKernelGGL(k_mega, dim3(grid), dim3(NTHREADS), LDS_BYTES, stream, P);
#else
    launch_step<0>(P, 0, grid, stream);
    launch_step<1>(P, 0, grid, stream);
    for (int l = 0; l < 2; ++l) {
        launch_step<2>(P, l, grid, stream); launch_step<3>(P, l, grid, stream); launch_step<4>(P, l, grid, stream); launch_step<5>(P, l, grid, stream);
        launch_step<6>(P, l, grid, stream); launch_step<7>(P, l, grid, stream); launch_step<8>(P, l, grid, stream);
        launch_step<10>(P, l, grid, stream);
    }
#endif
}
#ifdef DBG_INST
template __global__ void k_step<11>(Params, int);
template __global__ void k_step<12>(Params, int);
template __global__ void k_step<13>(Params, int);
template __global__ void k_step<14>(Params, int);
template __global__ void k_step<15>(Params, int);
template __global__ void k_step<16>(Params, int);
#endif
```

```cpp
#include <hip/hip_runtime.h>
#include <cstdint>
#include <cstdio>

#ifndef N_LAUNCH_MODE
#define N_LAUNCH_MODE 1
#endif
#ifndef FAST_MIX
#define FAST_MIX 1
#endif
#ifndef DBG_TEST
#define DBG_TEST 0
#endif
#ifndef DBG_HG_MODE
#define DBG_HG_MODE 0
#endif
#ifndef FAST_GEMM
#define FAST_GEMM 1
#endif

#define LAS __attribute__((address_space(3)))
#define GAS __attribute__((address_space(1)))
typedef unsigned short bf16_t;
typedef short bf16x8 __attribute__((ext_vector_type(8)));
typedef float f32x4 __attribute__((ext_vector_type(4)));
typedef float f32x2 __attribute__((ext_vector_type(2)));
typedef unsigned u32x4 __attribute__((ext_vector_type(4)));
typedef unsigned u32x2 __attribute__((ext_vector_type(2)));
typedef short s16x4 __attribute__((ext_vector_type(4)));
typedef float f32x16 __attribute__((ext_vector_type(16)));
#define DI __device__ __forceinline__

constexpr int D = 1024, NB = 2, SEQ = 8192, CTXL = 256, NLAT = NB * SEQ, NCTX = NB * CTXL, NROWS = NLAT + NCTX;
constexpr int INW = 2816, PBW = 2304, ZW = 512, NEXP = 16, DEXP = 512, LISTCAP = NROWS;
constexpr int NTHREADS = 512, NWAVES = 8;
constexpr float ALPHA = 1.41421356237f, LN_EPS = 1e-5f, RMS_EPS = 1e-6f, LOG2E = 1.4426950408889634f, QSCALE = 0.125f * LOG2E;
constexpr int PB_AQ = 0, PB_AI = 256, PB_AG = 512, PB_NQ = 768, PB_NK = 1024, PB_NV = 1280, PB_SQ = 1536, PB_SK = 2048, PB_SV = 2176;
constexpr int NCHAIN = 132;

constexpr size_t MiB = 1u << 20;
constexpr size_t WS_CTL = 0, CTL_BYTES = 1 * MiB;
constexpr size_t WS_MODS = 1 * MiB;
constexpr size_t WS_LB = WS_MODS + 2 * 3 * 6144 * 4;
constexpr size_t WS_ROPE = WS_LB + 2 * 2 * 256 * 4;
constexpr size_t WS_TOKE = WS_ROPE + 129 * 16 * 2 * 4;
constexpr size_t WS_TOKP = WS_TOKE + NROWS * 8;
constexpr size_t WS_TOKW = WS_TOKP + NROWS * 8;
constexpr size_t WS_LIST = 2 * MiB;
constexpr size_t WS_XC = 4 * MiB;
constexpr size_t WS_X1 = 211 * MiB;
constexpr size_t WS_WIN = 6 * MiB;
constexpr size_t WS_WOUT = 17 * MiB;
constexpr size_t WS_WGU = 21 * MiB;
constexpr size_t WS_WD = 53 * MiB;
constexpr size_t WS_H = 69 * MiB;
constexpr size_t WS_Y = 102 * MiB;
constexpr size_t WS_S = 135 * MiB;
constexpr size_t WS_DD = 282 * MiB;
constexpr size_t WS_PB = 174 * MiB;
constexpr size_t WS_Z = WS_PB + (size_t)NROWS * PBW * 2;
constexpr size_t WS_O = 174 * MiB;
constexpr size_t WS_YO = 248 * MiB;
constexpr size_t WS_WGU1 = 284 * MiB, WS_WD1 = 316 * MiB;
constexpr size_t WS_END = 332 * MiB;
constexpr int HE_ROWS = 37888;
constexpr size_t WS_KK = WS_Z + (size_t)NROWS * ZW * 2;
static_assert(WS_DD + (size_t)2 * 2112 * 64 * 4 <= WS_END && WS_Z + (size_t)NROWS * ZW * 4 <= WS_DD && WS_O + (size_t)HE_ROWS * 1024 * 2 <= WS_YO && WS_YO + (size_t)NROWS * 2048 <= WS_END, "ws map");
static_assert(WS_TOKW + NROWS * 8 <= WS_LIST && WS_LIST + 16 * LISTCAP * 4 <= WS_XC, "ws map small");
constexpr int CW_TRDY = 32768;
constexpr int CW_CNT = 8192;
constexpr int CW_BAR = 4096;
constexpr int CW_DBG = 512;
constexpr int CW_Q = 1024;
constexpr int CW_TS = 2048;
constexpr int CW_SCAN = 1536;

struct Params {
    const float* in[21];
    float* out;
    unsigned char* ws;
    int step_lo, step_hi;
};

DI unsigned f2bf(float f) { unsigned u = __builtin_bit_cast(unsigned, f); return (u + 0x7fffu + ((u >> 16) & 1u)) >> 16; }
DI float bf2f(unsigned h) { return __builtin_bit_cast(float, h << 16); }
typedef __bf16 bf16x2_t __attribute__((ext_vector_type(2)));
DI unsigned pk2(float lo, float hi) { return __builtin_bit_cast(unsigned, __builtin_convertvector((f32x2){lo, hi}, bf16x2_t)); }
DI float bflo(unsigned w) { return __builtin_bit_cast(float, w << 16); }
DI float bfhi(unsigned w) { return __builtin_bit_cast(float, w & 0xffff0000u); }
#define DPPF(v, ctrl, rm) __builtin_bit_cast(float, __builtin_amdgcn_update_dpp(0, __builtin_bit_cast(int, (v)), (ctrl), (rm), 0xf, false))
DI float wave_sum(float v) {
    v += DPPF(v, 0xB1, 0xf); v += DPPF(v, 0x4E, 0xf); v += DPPF(v, 0x141, 0xf); v += DPPF(v, 0x140, 0xf);
    v += DPPF(v, 0x142, 0xa); v += DPPF(v, 0x143, 0xc);
    return __builtin_bit_cast(float, __builtin_amdgcn_readlane(__builtin_bit_cast(int, v), 63));
}
DI float wave_max(float v) {
#pragma unroll
    for (int o = 1; o < 64; o <<= 1) v = fmaxf(v, __shfl_xor(v, o));
    return v;
}
DI float sigmoidf_(float x) { return 1.0f / (1.0f + __expf(-x)); }
DI float siluf_(float x) { return x / (1.0f + __expf(-x)); }
DI unsigned pk_fp8x4(f32x4 v) { int w = 0; w = __builtin_amdgcn_cvt_pk_fp8_f32(v[0], v[1], w, false); w = __builtin_amdgcn_cvt_pk_fp8_f32(v[2], v[3], w, true); return (unsigned)w; }
DI void store_bf4(bf16_t* p, f32x4 v) { u32x2 w; w.x = pk2(v[0], v[1]); w.y = pk2(v[2], v[3]); *(u32x2*)p = w; }

struct Ctx {
    LAS unsigned char* lds;
    int tid, lane, wave, bid, nb;
};

struct Unit { int pm, pn, e, cnt, i0, slot; };

struct PlainSched {
    int nM, nN, nwg, G, c;
    DI void init(int M, int N, int G_, int c_) { nM = M / 256; nN = N / 256; nwg = nM * nN; G = G_; c = c_; }
    DI bool next(int i, Unit& u) const {
        const long L = (long)i * G + c; if (L >= nwg) return false;
        int wgid = (int)L; { const int q = nwg / 8, r = nwg % 8, xcd = wgid % 8, off = wgid / 8; wgid = (xcd < r ? xcd * (q + 1) : r * (q + 1) + (xcd - r) * q) + off; }
        const int nig = 8 * nN, gid = wgid / nig, fm = gid * 8, gsz = (nM - fm) < 8 ? (nM - fm) : 8;
        u.pm = fm + ((wgid % nig) % gsz); u.pn = (wgid % nig) / gsz; u.e = 0; u.cnt = 0; u.i0 = 0; u.slot = 0; return true;
    }
    DI int a_row(const Unit& u, int r) const { return u.pm * 256 + r; }
    DI int b_row0(const Unit& u) const { return u.pn * 256; }
    static constexpr bool LOADS = false, PUBLISH = false, WAIT = false;
};
constexpr int MOE_TBL_OFF = 144 * 1024 + 512;
constexpr int MOE_LIST_OFF = 144 * 1024 + 2560;
DI void moe_build_table(const Ctx& X, const int* cnt) {
    LAS int* tbl = (LAS int*)(X.lds + MOE_TBL_OFF);
    if (X.tid < 160) { const int T = X.tid; int acc = 0, e = -1, i0 = 0, ce = 0;
#pragma unroll
        for (int q = 0; q < NEXP; ++q) { const int cq = cnt[q * 64]; const int nt = (cq + 255) >> 8; if (e < 0 && T < acc + nt) { e = q; i0 = T - acc; ce = cq; } acc += nt; }
        tbl[1 + 3 * T] = e; tbl[2 + 3 * T] = i0; tbl[3 + 3 * T] = ce; if (T == 0) tbl[0] = acc; }
    __syncthreads();
}
template <bool GATHER> struct MoeSched {
    const int* cnt; const int* list; int G, c, nct, bt_rows; LAS unsigned char* lds; unsigned* ready; static constexpr bool gather = GATHER;
    static constexpr int NCT_UP = 4;
    DI bool next(int i, Unit& u) const {
        const LAS int* tbl = (const LAS int*)(lds + MOE_TBL_OFF);
        const int clin = (c & 7) * (G >> 3) + (c >> 3), ntile = __builtin_amdgcn_readfirstlane(tbl[0]);
        int L;
        if (GATHER) L = i * G + clin;
        else { const int n1 = ntile * NCT_UP, rf = n1 / G, r = n1 - rf * G;
            if (r == 0) L = i * G + clin;
            else { const int nl = ((rf * G) / NCT_UP) * nct;
                if (clin < r) L = nl + i * r + clin;
                else { L = i * (G - r) + (clin - r); if (L >= nl) return false; } } }
        const int T = L / nct; if (T >= ntile) return false;
        u.slot = i; u.pm = T; u.pn = L % nct; u.e = __builtin_amdgcn_readfirstlane(tbl[1 + 3 * T]); u.i0 = __builtin_amdgcn_readfirstlane(tbl[2 + 3 * T]); u.cnt = __builtin_amdgcn_readfirstlane(tbl[3 + 3 * T]); return true;
    }
    DI int a_row(const Unit& u, int r) const {
        if (!gather) return u.pm * 256 + r;
        return ((const LAS int*)(lds + MOE_LIST_OFF))[u.slot * 256 + r];
    }
    DI int b_row0(const Unit& u) const { return u.e * bt_rows + u.pn * 256; }
    static constexpr bool LOADS = GATHER, PUBLISH = GATHER, WAIT = !GATHER;
    DI void publish(const Unit& u) const { __hip_atomic_fetch_add(ready + u.pm, 1u, __ATOMIC_RELAXED, __HIP_MEMORY_SCOPE_AGENT); }
    DI void wait(const Unit& u) const { unsigned sp = 0; while (__hip_atomic_load(ready + u.pm, __ATOMIC_RELAXED, __HIP_MEMORY_SCOPE_AGENT) < (unsigned)NCT_UP && ++sp < (1u << 24)) __builtin_amdgcn_s_sleep(1);
        __builtin_amdgcn_fence(__ATOMIC_ACQUIRE, "agent"); asm volatile("s_waitcnt vmcnt(0)" ::: "memory"); }
};

DI void store_bf8(bf16_t* p, f32x4 lo, f32x4 hi) { u32x4 w; w.x = pk2(lo[0], lo[1]); w.y = pk2(lo[2], lo[3]); w.z = pk2(hi[0], hi[1]); w.w = pk2(hi[2], hi[3]); *(u32x4*)p = w; }
DI void store_f8x8(unsigned char* p, f32x4 lo, f32x4 hi) { u32x2 w; w.x = pk_fp8x4(lo); w.y = pk_fp8x4(hi); *(u32x2*)p = w; }
DI float lane32_partner(float v, bool upper) { const auto rr = __builtin_amdgcn_permlane32_swap(__float_as_uint(v), __float_as_uint(v), false, false); return __uint_as_float(upper ? rr[0] : rr[1]); }
struct EpiIn {
    bf16_t* PB; bf16_t* Z; const float* rope; const float* lb; bf16_t* KK;
    DI void gate8(bf16_t* zp, bf16_t* kp, const float* lbp, f32x4 z0, f32x4 z1) const {
        const f32x4 lb0 = *(const f32x4*)lbp, lb1 = *(const f32x4*)(lbp + 4); f32x4 lf0, lf1, k0, k1;
#pragma unroll
        for (int j = 0; j < 4; ++j) { const float zc = fminf(fmaxf(z0[j], -30.f), 30.f), e = __expf(-zc), sg = 1.0f / (1.0f + e); lf0[j] = __log2f(lb0[j] + (1.0f - lb0[j]) * sg); k0[j] = (1.0f - lb0[j]) * (e * sg); }
#pragma unroll
        for (int j = 0; j < 4; ++j) { const float zc = fminf(fmaxf(z1[j], -30.f), 30.f), e = __expf(-zc), sg = 1.0f / (1.0f + e); lf1[j] = __log2f(lb1[j] + (1.0f - lb1[j]) * sg); k1[j] = (1.0f - lb1[j]) * (e * sg); }
        store_bf8(zp, lf0, lf1); store_bf8(kp, k0, k1);
    }
    DI void rope8(f32x4& v0, f32x4& v1, const float* rp, bool upper) const {
#pragma unroll
        for (int j = 0; j < 4; ++j) { const float c0 = rp[2 * j], s0 = rp[2 * j + 1], c1 = rp[2 * (j + 4)], s1 = rp[2 * (j + 4) + 1];
            const float p0 = lane32_partner(v0[j], upper), p1 = lane32_partner(v1[j], upper);
            v0[j] = upper ? p0 * s0 + v0[j] * c0 : v0[j] * c0 - p0 * s0; v1[j] = upper ? p1 * s1 + v1[j] * c1 : v1[j] * c1 - p1 * s1; }
    }
    DI void group(const Unit& u, int r, int c, f32x4 a0, f32x4 a1, f32x4 b0, f32x4 b1) const {
        const int row = u.pm * 256 + r, seg = u.pn, gc = u.pn * 256 + c;
        if (seg == 1 || seg == 2) {
            const int ci = (seg - 1) * 256 + c; bf16_t* z = Z + (size_t)row * ZW + ci; bf16_t* k = KK + (size_t)row * ZW + ci; const float* lp = lb + ci;
            gate8(z, k, lp, a0, a1); gate8(z + 128, k + 128, lp + 128, b0, b1);
            return;
        }
        if (seg >= 8) {
            const int t = row & (SEQ - 1); const int which = (c >> 5) & 1; const int pos = row < NLAT ? (which ? (t & 63) : (t >> 6)) : 128;
            const bool upper = (c & 31) >= 16; const float* rp = rope + (pos * 16 + (c & 15)) * 2;
            rope8(a0, a1, rp, upper); if (seg < 10) rope8(b0, b1, rp, upper);
        }
        if (seg == 5 || seg == 8 || seg == 9) { a0 *= QSCALE; a1 *= QSCALE; b0 *= QSCALE; b1 *= QSCALE; }
        bf16_t* p = PB + (size_t)row * PBW + (gc >= 768 ? gc - 512 : gc);
        store_bf8(p, a0, a1); store_bf8(p + 128, b0, b1);
    }
};
struct EpiBf {
    bf16_t* C; int ldc;
    DI void group(const Unit& u, int r, int c, f32x4 a0, f32x4 a1, f32x4 b0, f32x4 b1) const {
        bf16_t* p = C + (size_t)(u.pm * 256 + r) * ldc + u.pn * 256 + c;
        store_bf8(p, a0, a1); store_bf8(p + 128, b0, b1);
    }
};
struct EpiF8 {
    unsigned char* C; int ldc;
    DI void group(const Unit& u, int r, int c, f32x4 a0, f32x4 a1, f32x4 b0, f32x4 b1) const {
        unsigned char* p = C + (size_t)(u.pm * 256 + r) * ldc + u.pn * 256 + c;
        store_f8x8(p, a0 * 16.0f, a1 * 16.0f); store_f8x8(p + 128, b0 * 16.0f, b1 * 16.0f);
    }
};
struct EpiGU {
    bf16_t* HE;
    DI void group(const Unit& u, int r, int c, f32x4 a0, f32x4 a1, f32x4 b0, f32x4 b1) const {
        f32x4 h0, h1;
#pragma unroll
        for (int j = 0; j < 4; ++j) { h0[j] = siluf_(a0[j]) * b0[j]; h1[j] = siluf_(a1[j]) * b1[j]; }
        u32x2 w; w.x = pk_fp8x4(h0); w.y = pk_fp8x4(h1);
        __hip_atomic_store((unsigned long long*)((unsigned char*)HE + (size_t)(u.pm * 256 + r) * DEXP + u.pn * 128 + c), (unsigned long long)w.x | ((unsigned long long)w.y << 32), __ATOMIC_RELAXED, __HIP_MEMORY_SCOPE_AGENT);
    }
};

template <class Sched, class Epi>
DI void gemm_naive(const Ctx& X, const bf16_t* A, const bf16_t* Bt, int K, const Sched& S, const Epi& E) {
    Unit u;
    for (int i = 0; S.next(i, u); ++i) {
        for (int g = X.tid; g < 4096; g += NTHREADS) {
            const int fq = g & 3, wc = (g >> 2) & 3, r = g >> 4, c = wc * 32 + fq * 4;
            const bf16_t* ap = A + (size_t)S.a_row(u, r) * K;
            const bf16_t* bp = Bt + (size_t)(S.b_row0(u) + c) * K;
            float acc[16];
#pragma unroll
            for (int q = 0; q < 16; ++q) acc[q] = 0.f;
            for (int k = 0; k < K; k += 8) {
                const u32x4 av = *(const u32x4*)(ap + k);
                float af[8] = {bflo(av.x), bfhi(av.x), bflo(av.y), bfhi(av.y), bflo(av.z), bfhi(av.z), bflo(av.w), bfhi(av.w)};
#pragma unroll
                for (int q = 0; q < 16; ++q) {
                    const int col = (q >> 3) * 128 + ((q >> 2) & 1) * 16 + (q & 3);
                    const u32x4 bv = *(const u32x4*)(bp + (size_t)col * K + k);
                    acc[q] += af[0] * bflo(bv.x) + af[1] * bfhi(bv.x) + af[2] * bflo(bv.y) + af[3] * bfhi(bv.y) + af[4] * bflo(bv.z) + af[5] * bfhi(bv.z) + af[6] * bflo(bv.w) + af[7] * bfhi(bv.w);
                }
            }
            E.group(u, r, c, (f32x4){acc[0], acc[1], acc[2], acc[3]}, (f32x4){acc[4], acc[5], acc[6], acc[7]}, (f32x4){acc[8], acc[9], acc[10], acc[11]}, (f32x4){acc[12], acc[13], acc[14], acc[15]});
        }
    }
}

constexpr int HTB = 128 * 64 * 2;
DI int lds_byte(int r, int c) { const int st = (r >> 4) * 2 + (c >> 5), rr = r & 15, cc = c & 31, ob = rr * 64 + cc * 2; return st * 1024 + (ob ^ (((ob >> 9) & 1) << 5)); }
DI void stage_rc(int b, int& R, int& C) { const int st = b / 1024, sb = b % 1024, swz = sb ^ (((sb >> 9) & 1) << 5); R = (st >> 1) * 16 + swz / 64; C = (st & 1) * 32 + (swz % 64) / 2; }
typedef int v8i_t __attribute__((ext_vector_type(8)));
template <class Sched, class Epi, bool F8 = false, int SCALE_B = 127>
DI void gemm_fast(const Ctx& X, const void* A, const void* Bt, int K, const Sched& S, const Epi& E) {
    LAS unsigned char* lds = X.lds;
    const int tid = X.tid, wid = X.wave, lane = X.lane, wr = wid >> 2, wc = wid & 3, fr = lane & 15, fq = lane >> 4;
    asm volatile("" : "+s"(K));
    const int RP = F8 ? K : 2 * K, nt = RP / 128;
    int Rr[2], Cc[2]; unsigned voffB[2];
#pragma unroll
    for (int i = 0; i < 2; ++i) { stage_rc(tid * 16 + i * 8192, Rr[i], Cc[i]); const int rho = Rr[i] & 31, Rb = (Rr[i] & ~31) + 8 * ((rho & 15) >> 2) + 4 * (rho >> 4) + (rho & 3);
        voffB[i] = (unsigned)(Rb * RP + Cc[i] * 2); }
    const size_t kstep = 128, hstepB = (size_t)128 * RP;
    const unsigned ldsw = (unsigned)wid * 1024u;
    const int aoff = lds_byte(wr * 64 + fr, fq * 8), boff = lds_byte(wc * 32 + fr, fq * 8);
#define G_SA(b, h) (((b) * 2 + (h)) * HTB)
#define G_SB(b, h) ((4 + (b) * 2 + (h)) * HTB)
#define G_STAGE(bufoff, gbase, voff) do { _Pragma("unroll") for (int _i = 0; _i < 2; ++_i) \
        __builtin_amdgcn_global_load_lds((const unsigned*)((const char*)(gbase) + (voff)[_i]), (LAS unsigned*)(lds + (bufoff) + ldsw + _i * 8192), 16, 0, 0); } while (0)
#define G_LD8(p) __builtin_bit_cast(v8i_t, __builtin_shufflevector(*(const LAS u32x4*)(p), *(const LAS u32x4*)((p) + 1024), 0, 1, 2, 3, 4, 5, 6, 7))
#define G_LDA(dst, b, h) do { _Pragma("unroll") for (int m = 0; m < 4; ++m) dst[m] = G_LD8(lds + G_SA(b, h) + aoff + m * 2048); } while (0)
#define G_LDB(dst, b, h) do { _Pragma("unroll") for (int n = 0; n < 2; ++n) dst[n] = G_LD8(lds + G_SB(b, h) + boff + n * 2048); } while (0)
#define G_LO(f) __builtin_bit_cast(bf16x8, __builtin_shufflevector((f), (f), 0, 1, 2, 3))
#define G_HI(f) __builtin_bit_cast(bf16x8, __builtin_shufflevector((f), (f), 4, 5, 6, 7))
#define G_MMA(ai, bj, At, Bt_) do { __builtin_amdgcn_s_setprio(1); _Pragma("unroll") for (int m = 0; m < 4; ++m) _Pragma("unroll") for (int n = 0; n < 2; ++n) { \
        if constexpr (F8) asm volatile("v_mfma_scale_f32_16x16x128_f8f6f4 %0, %1, %2, %0, %3, %4 op_sel_hi:[0,0,0]" : "+v"(acc[ai][bj][m][n]) : "v"(Bt_[n]), "v"(At[m]), "v"(scl_w), "v"(scl_x)); \
        else { acc[ai][bj][m][n] = __builtin_amdgcn_mfma_f32_16x16x32_bf16(G_LO(Bt_[n]), G_LO(At[m]), acc[ai][bj][m][n], 0, 0, 0); acc[ai][bj][m][n] = __builtin_amdgcn_mfma_f32_16x16x32_bf16(G_HI(Bt_[n]), G_HI(At[m]), acc[ai][bj][m][n], 0, 0, 0); } } __builtin_amdgcn_s_setprio(0); } while (0)
#define G_WAIT_V(n) asm volatile("s_waitcnt vmcnt(" #n ")" ::: "memory")
#define G_WAIT_L(n) asm volatile("s_waitcnt lgkmcnt(" #n ")" ::: "memory")
#define G_BAR __builtin_amdgcn_s_barrier()
#define G_SCHED __builtin_amdgcn_sched_barrier(0)
    Unit cur, nxt; int ui = 0;
    if (!S.next(0, cur)) return;
    if constexpr (Sched::WAIT) { if (tid == 0) S.wait(cur); __builtin_amdgcn_s_barrier(); }
    f32x4 acc[2][2][4][2];
#pragma unroll
    for (int a = 0; a < 2; ++a)
#pragma unroll
        for (int b = 0; b < 2; ++b)
#pragma unroll
            for (int m = 0; m < 4; ++m)
#pragma unroll
                for (int n = 0; n < 2; ++n) acc[a][b][m][n] = (f32x4){0.f, 0.f, 0.f, 0.f};
    v8i_t At[4], B0[2], B1[2];
    int scl_w = SCALE_B * 0x01010101, scl_x = 0x7f7f7f7f; asm volatile("" : "+v"(scl_w), "+v"(scl_x));
    constexpr bool GA = Sched::LOADS;
    unsigned vAc[2][2], vAn[2][2];
#pragma unroll
    for (int h = 0; h < 2; ++h)
#pragma unroll
        for (int i = 0; i < 2; ++i) { vAc[h][i] = GA ? (unsigned)(S.a_row(cur, h * 128 + Rr[i]) * RP + Cc[i] * 2) : (unsigned)((h * 128 + Rr[i]) * RP + Cc[i] * 2); vAn[h][i] = vAc[h][i]; }
    if (GA) G_WAIT_V(0);
    const char* A0 = (const char*)A;
    const char* cA = GA ? A0 : A0 + (size_t)S.a_row(cur, 0) * RP;
    const char* cB = (const char*)Bt + (size_t)S.b_row0(cur) * RP;
    G_STAGE(G_SB(0, 0), cB, voffB); G_STAGE(G_SB(0, 1), cB + hstepB, voffB); G_STAGE(G_SA(0, 0), cA, vAc[0]); G_STAGE(G_SA(0, 1), cA, vAc[1]);
    if (wr == 1) G_BAR;
    G_WAIT_V(2); G_BAR;
    G_STAGE(G_SB(1, 0), cB + kstep, voffB); G_STAGE(G_SA(1, 0), cA + kstep, vAc[0]); G_STAGE(G_SB(1, 1), cB + hstepB + kstep, voffB);
    G_WAIT_V(6); G_BAR;
    for (;;) {
        const bool has_next = S.next(ui + 1, nxt);
        if constexpr (Sched::WAIT) { if (has_next) { if (tid == 0) S.wait(nxt); G_BAR; } }
        if (GA) {
#pragma unroll
            for (int h = 0; h < 2; ++h)
#pragma unroll
                for (int i = 0; i < 2; ++i) vAn[h][i] = has_next ? (unsigned)(S.a_row(nxt, h * 128 + Rr[i]) * RP + Cc[i] * 2) : vAc[h][i];
        }
        const char* nA = GA ? A0 : (has_next ? A0 + (size_t)S.a_row(nxt, 0) * RP : cA);
        const char* nB = has_next ? (const char*)Bt + (size_t)S.b_row0(nxt) * RP : cB;
#pragma unroll 1
        for (int t = 0; t < nt; t += 2) {
            const bool last = (t == nt - 2);
            const char* a1 = cA + (size_t)(t + 1) * kstep;
            const char* a2 = last ? nA : cA + (size_t)(t + 2) * kstep; const char* b2 = last ? nB : cB + (size_t)(t + 2) * kstep;
            const char* a3 = a2 + kstep; const char* b3 = b2 + kstep;
            unsigned v2[2][2];
#pragma unroll
            for (int h = 0; h < 2; ++h)
#pragma unroll
                for (int i = 0; i < 2; ++i) v2[h][i] = (GA && last) ? vAn[h][i] : vAc[h][i];
            G_LDB(B0, 0, 0); G_LDB(B1, 0, 1); G_SCHED; G_LDA(At, 0, 0); G_STAGE(G_SA(1, 1), a1, vAc[1]);
            G_WAIT_V(8); G_WAIT_L(0); G_BAR; G_MMA(0, 0, At, B0); G_MMA(0, 1, At, B1); G_BAR; G_SCHED;
            G_LDA(At, 0, 1); G_STAGE(G_SB(0, 0), b2, voffB); G_STAGE(G_SB(0, 1), b2 + hstepB, voffB); G_STAGE(G_SA(0, 0), a2, v2[0]);
            G_WAIT_V(8); G_WAIT_L(0); G_BAR; G_MMA(1, 0, At, B0); G_MMA(1, 1, At, B1); G_BAR; G_SCHED;
            G_LDB(B0, 1, 0); G_LDB(B1, 1, 1); G_SCHED; G_LDA(At, 1, 0); G_STAGE(G_SA(0, 1), a2, v2[1]);
            G_WAIT_V(8); G_WAIT_L(0); G_BAR; G_MMA(0, 0, At, B0); G_MMA(0, 1, At, B1); G_BAR; G_SCHED;
            G_LDA(At, 1, 1); G_STAGE(G_SB(1, 0), b3, voffB); G_STAGE(G_SB(1, 1), b3 + hstepB, voffB); G_STAGE(G_SA(1, 0), a3, v2[0]);
            G_WAIT_V(8); G_WAIT_L(0); G_BAR; G_MMA(1, 0, At, B0); G_MMA(1, 1, At, B1); G_BAR; G_SCHED;
        }
        if constexpr (F8) asm volatile("s_nop 15\n\ts_nop 15" ::: "memory");
        if (wr == 0) G_BAR;
#pragma unroll
        for (int ai = 0; ai < 2; ++ai)
#pragma unroll
            for (int m = 0; m < 4; ++m) E.group(cur, ai * 128 + wr * 64 + m * 16 + fr, wc * 32 + fq * 8, acc[ai][0][m][0], acc[ai][0][m][1], acc[ai][1][m][0], acc[ai][1][m][1]);
        if constexpr (Sched::PUBLISH) { G_WAIT_V(0); G_BAR; if (tid == 0) S.publish(cur); }
        if (!has_next) break;
#pragma unroll
        for (int a = 0; a < 2; ++a)
#pragma unroll
            for (int b = 0; b < 2; ++b)
#pragma unroll
                for (int m = 0; m < 4; ++m)
#pragma unroll
                    for (int n = 0; n < 2; ++n) acc[a][b][m][n] = (f32x4){0.f, 0.f, 0.f, 0.f};
        cur = nxt; cB = nB; cA = nA; ++ui;
        if (GA) {
#pragma unroll
            for (int h = 0; h < 2; ++h)
#pragma unroll
                for (int i = 0; i < 2; ++i) vAc[h][i] = vAn[h][i]; }
        if (wr == 1) G_BAR;
    }
    G_WAIT_V(0);
    G_BAR;
#undef G_SA
#undef G_SB
#undef G_STAGE
#undef G_LDA
#undef G_LDB
#undef G_MMA
#undef G_LD8
#undef G_LO
#undef G_HI
#undef G_WAIT_V
#undef G_WAIT_L
#undef G_BAR
#undef G_SCHED
}
#if FAST_GEMM
#define GEMM_IMPL gemm_fast
#else
#define GEMM_IMPL gemm_naive
#endif

struct TrDesc { const float* W; bf16_t* WT; int N, Kd, k0, n0, drow0, f8; float sc; };
DI void tr_load(const TrDesc& d, float (&rg)[32], int lane) {
#pragma unroll
    for (int i = 0; i < 32; ++i) { const int kk = 2 * i + (lane >> 5); rg[i] = d.W[(size_t)(d.k0 + kk) * d.N + d.n0 + (lane & 31)]; }
}
DI void tr_finish(const TrDesc& d, const float (&rg)[32], LAS float* scr, int lane) {
#pragma unroll
    for (int i = 0; i < 32; ++i) { const int kk = 2 * i + (lane >> 5); scr[kk * 33 + (lane & 31)] = rg[i]; }
    asm volatile("s_waitcnt lgkmcnt(0)" ::: "memory");
    const int c = lane & 7;
#pragma unroll
    for (int j = 0; j < 4; ++j) { const int n = (lane >> 3) + 8 * j; const LAS float* s = scr + (8 * c) * 33 + n;
        if (d.f8) { u32x2 o; o.x = pk_fp8x4((f32x4){s[0 * 33], s[1 * 33], s[2 * 33], s[3 * 33]} * d.sc); o.y = pk_fp8x4((f32x4){s[4 * 33], s[5 * 33], s[6 * 33], s[7 * 33]} * d.sc);
            *(u32x2*)((unsigned char*)d.WT + (size_t)(d.drow0 + n) * d.Kd + d.k0 + 8 * c) = o; }
        else { u32x4 o; o.x = pk2(s[0 * 33], s[1 * 33]); o.y = pk2(s[2 * 33], s[3 * 33]); o.z = pk2(s[4 * 33], s[5 * 33]); o.w = pk2(s[6 * 33], s[7 * 33]);
            *(u32x4*)(d.WT + (size_t)(d.drow0 + n) * d.Kd + d.k0 + 8 * c) = o; } }
    asm volatile("s_waitcnt lgkmcnt(0)" ::: "memory");
}
DI TrDesc expert_desc(const Params& P, int l, int it) {
    bf16_t* WGU = (bf16_t*)(P.ws + (l ? WS_WGU1 : WS_WGU)); bf16_t* WD = (bf16_t*)(P.ws + (l ? WS_WD1 : WS_WD));
    const float* wg = P.in[18] + (size_t)l * NEXP * D * DEXP; const float* wu = P.in[19] + (size_t)l * NEXP * D * DEXP; const float* wd = P.in[20] + (size_t)l * NEXP * DEXP * D;
    const int set = it >> 12, r = it & 4095, e = r >> 8, q = r & 255; TrDesc d; d.sc = 32.0f;
    if (set < 2) { const int kb = q >> 4, nbk = q & 15, n0 = nbk * 32;
        d.f8 = 1; d.W = (set ? wu : wg) + (size_t)e * D * DEXP; d.N = DEXP; d.WT = (bf16_t*)((unsigned char*)WGU + (size_t)e * 1024 * 1024); d.Kd = 1024; d.k0 = kb * 64; d.n0 = n0; d.drow0 = 256 * (n0 >> 7) + (n0 & 127) + set * 128;
    } else { const int kb = q >> 5, nbk = q & 31, n0 = nbk * 32;
        d.f8 = 1; d.W = wd + (size_t)e * DEXP * D; d.N = D; d.WT = (bf16_t*)((unsigned char*)WD + (size_t)e * 1024 * 512); d.Kd = 512; d.k0 = kb * 64; d.n0 = n0; d.drow0 = n0; }
    return d;
}
DI TrDesc rest_desc(const Params& P, int it) {
    if (it >= 2432) return expert_desc(P, 0, it - 2432);
    bf16_t* WIN = (bf16_t*)(P.ws + WS_WIN); bf16_t* WOUT = (bf16_t*)(P.ws + WS_WOUT); TrDesc d;
    d.f8 = 1; d.sc = 32.0f;
    if (it < 1408) { const int kb = it / 88, nbk = it % 88; d.f8 = 1; d.W = P.in[6] + (size_t)D * INW; d.N = INW; d.WT = (bf16_t*)((unsigned char*)WIN + (size_t)INW * D); d.Kd = D; d.k0 = kb * 64; d.n0 = nbk * 32; d.drow0 = nbk * 32; }
    else { const int r0 = it - 1408, l = r0 >> 9, r = r0 & 511, kb = r >> 5, nbk = r & 31; d.sc = 64.0f; d.W = P.in[11] + (size_t)l * D * D; d.N = D; d.WT = (bf16_t*)((unsigned char*)WOUT + (size_t)l * D * D); d.Kd = D; d.k0 = kb * 64; d.n0 = nbk * 32; d.drow0 = nbk * 32; }
    return d;
}
DI TrDesc win0_desc(const Params& P, int it) { TrDesc d; d.f8 = 1; d.sc = 32.0f; const int kb = it / 88, nbk = it % 88; d.W = P.in[6]; d.N = INW; d.WT = (bf16_t*)(P.ws + WS_WIN); d.Kd = D; d.k0 = kb * 64; d.n0 = nbk * 32; d.drow0 = nbk * 32; return d; }
#define TR_LOOP(DESC_EXPR, first, limit, step) do { int it_ = (first); if (it_ < (limit)) { float rg_[32]; TrDesc d_ = DESC_EXPR(it_); tr_load(d_, rg_, X.lane); \
        for (;;) { const int nx_ = it_ + (step); if (nx_ < (limit)) { float rn_[32]; const TrDesc dn_ = DESC_EXPR(nx_); tr_load(dn_, rn_, X.lane); tr_finish(d_, rg_, scr, X.lane); d_ = dn_; _Pragma("unroll") for (int q_ = 0; q_ < 32; ++q_) rg_[q_] = rn_[q_]; it_ = nx_; } \
                   else { tr_finish(d_, rg_, scr, X.lane); break; } } } } while (0)
DI void ph_prologue(const Ctx& X, const Params& P) {
    LAS float* sc = (LAS float*)X.lds;
    LAS float* red = sc + 3072;
    float* MODS = (float*)(P.ws + WS_MODS);
    for (int it = X.bid; it < 193; it += X.nb) {
        if (it < 192) {
            const int l = it / 96, cg = it % 96;
            for (int i = X.tid; i < 3072; i += NTHREADS) { const int cond = i >> 10, k = i & 1023; const float v = cond < 2 ? P.in[1][cond * 1024 + k] : P.in[3][k]; sc[i] = siluf_(v); }
            __syncthreads();
            const int kq = X.tid >> 4, c4 = X.tid & 15;
            float acc[3][4];
#pragma unroll
            for (int a = 0; a < 3; ++a)
#pragma unroll
                for (int j = 0; j < 4; ++j) acc[a][j] = 0.f;
            const float* w = P.in[4] + (size_t)l * D * 6144 + cg * 64 + c4 * 4;
#pragma unroll 8
            for (int i = 0; i < 32; ++i) { const int k = kq + 32 * i; const f32x4 wv = *(const f32x4*)(w + (size_t)k * 6144);
                const float s0 = sc[k], s1 = sc[1024 + k], s2 = sc[2048 + k];
#pragma unroll
                for (int j = 0; j < 4; ++j) { acc[0][j] += s0 * wv[j]; acc[1][j] += s1 * wv[j]; acc[2][j] += s2 * wv[j]; } }
#pragma unroll
            for (int a = 0; a < 3; ++a)
#pragma unroll
                for (int j = 0; j < 4; ++j) red[(kq * 3 + a) * 64 + c4 * 4 + j] = acc[a][j];
            __syncthreads();
            if (X.tid < 192) { const int cond = X.tid >> 6, col = X.tid & 63; float s = 0.f;
                for (int q = 0; q < 32; ++q) s += red[(q * 3 + cond) * 64 + col];
                MODS[(l * 3 + cond) * 6144 + cg * 64 + col] = s + P.in[5][l * 6144 + cg * 64 + col]; }
            __syncthreads();
        } else {
            float* LB = (float*)(P.ws + WS_LB);
            { const int i = X.tid; const float l0 = P.in[7][i], l1 = P.in[7][512 + i]; const float p1 = 1.0f / (1.0f + expf(l0 - l1));
              LB[i] = 1e-6f; LB[512 + i] = fmaxf(p1, 1e-6f); }
            float* RP = (float*)(P.ws + WS_ROPE);
            for (int i = X.tid; i < 2048 + 16; i += NTHREADS) { const int pos = i >> 4, f = i & 15; const float inv = powf(10000.0f, -(float)f / 16.0f); const float ang = pos < 128 ? (float)pos * inv : 0.0f;
                RP[2 * i] = cosf(ang); RP[2 * i + 1] = sinf(ang); }
        }
    }
    __syncthreads();
    LAS float* scr = (LAS float*)X.lds + X.wave * (64 * 33);
    const int gw = X.bid * NWAVES + X.wave, NGW = X.nb * NWAVES;
#define DESC_WIN0(i) win0_desc(P, (i))
    TR_LOOP(DESC_WIN0, gw, 1408, NGW);
}
DI void convert_rest(const Ctx& X, const Params& P) {
    LAS float* scr = (LAS float*)X.lds + X.wave * (64 * 33);
    const int gw = X.bid * NWAVES + X.wave, NGW = X.nb * NWAVES;
#define DESC_REST(i) rest_desc(P, (i))
    TR_LOOP(DESC_REST, gw, 2432, NGW);
}

DI const float* mods_row(const Params& P, int l, int row) { const int cond = row < NLAT ? (row >> 13) : 2; return (const float*)(P.ws + WS_MODS) + (l * 3 + cond) * 6144; }
template <int NR>
DI void modulate_rows(const Ctx& X, const Params& P, int l, int row0) {
    bf16_t* H = (bf16_t*)(P.ws + WS_H);
    const float* xr = row0 < NLAT ? P.in[0] + (size_t)row0 * D : P.in[2] + (size_t)(row0 - NLAT) * D; const float* md = mods_row(P, l, row0);
    f32x4 x[NR][4];
#pragma unroll
    for (int j = 0; j < 4; ++j)
#pragma unroll
        for (int r = 0; r < NR; ++r) x[r][j] = *(const f32x4*)(xr + (size_t)r * D + 4 * X.lane + 256 * j);
#pragma unroll
    for (int j = 0; j < 4; ++j) { const int c = 4 * X.lane + 256 * j; const f32x4 sh = *(const f32x4*)(md + c), sc = *(const f32x4*)(md + 1024 + c);
#pragma unroll
        for (int r = 0; r < NR; ++r) *(unsigned*)((unsigned char*)H + (size_t)(row0 + r) * D + c) = pk_fp8x4(x[r][j] * (1.0f + sc) + sh); }
}
DI void ph_modulate(const Ctx& X, const Params& P, int l) {
    const int gw = X.bid * NWAVES + X.wave;
    if (gw < NLAT / 8) { modulate_rows<4>(X, P, l, 8 * gw); modulate_rows<4>(X, P, l, 8 * gw + 4); }
    if (gw < NCTX) modulate_rows<1>(X, P, l, NLAT + gw);
}
template <int NR>
DI void ln1_rows(const Ctx& X, const Params& P, int l, int row0, int slot0, const LAS float* wrT, float (&lgv)[16]) {
    bf16_t* H = (bf16_t*)(P.ws + WS_H); const bf16_t* YO = (const bf16_t*)(P.ws + WS_YO); bf16_t* X1 = (bf16_t*)(P.ws + WS_X1) + (size_t)row0 * D;
    const float* g = P.in[12] + l * D; const float* bta = P.in[13] + l * D;
    const bool lat = row0 < NLAT;
    const float* xr = lat ? P.in[0] + (size_t)row0 * D : P.in[2] + (size_t)(row0 - NLAT) * D;
    const bf16_t* xb = (const bf16_t*)P.out + (size_t)row0 * D;
    const float* md = mods_row(P, l, row0);
    const int c0 = 4 * X.lane;
    f32x4 v[NR][4]; float sm[NR];
#pragma unroll
    for (int r = 0; r < NR; ++r) sm[r] = 0.f;
#pragma unroll
    for (int j = 0; j < 4; ++j) { const int c = c0 + 256 * j; const f32x4 g1 = *(const f32x4*)(md + 2048 + c);
#pragma unroll
        for (int r = 0; r < NR; ++r) { f32x4 x; if (l == 0) x = *(const f32x4*)(xr + (size_t)r * D + c); else { const u32x2 xw = *(const u32x2*)(xb + (size_t)r * D + c); x = (f32x4){bflo(xw.x), bfhi(xw.x), bflo(xw.y), bfhi(xw.y)}; }
            const u32x2 yw = *(const u32x2*)(YO + (size_t)(row0 + r) * D + c);
            const f32x4 y = {bflo(yw.x), bfhi(yw.x), bflo(yw.y), bfhi(yw.y)}; v[r][j] = ALPHA * x + g1 * y; sm[r] += (v[r][j][0] + v[r][j][1]) + (v[r][j][2] + v[r][j][3]); } }
    float rstd[NR];
#pragma unroll
    for (int r = 0; r < NR; ++r) { const float mean = wave_sum(sm[r]) * (1.0f / D); float q = 0.f;
#pragma unroll
        for (int j = 0; j < 4; ++j) { v[r][j] = v[r][j] - mean; q += (v[r][j][0] * v[r][j][0] + v[r][j][1] * v[r][j][1]) + (v[r][j][2] * v[r][j][2] + v[r][j][3] * v[r][j][3]); }
        sm[r] = q; }
#pragma unroll
    for (int r = 0; r < NR; ++r) rstd[r] = 1.0f / sqrtf(wave_sum(sm[r]) * (1.0f / D) + LN_EPS);
#pragma unroll
    for (int j = 0; j < 4; ++j) { const int c = c0 + 256 * j; const f32x4 gm = *(const f32x4*)(g + c), bt = *(const f32x4*)(bta + c), sc2 = *(const f32x4*)(md + 4096 + c), sh2 = *(const f32x4*)(md + 3072 + c);
#pragma unroll
        for (int r = 0; r < NR; ++r) { const f32x4 x1 = v[r][j] * rstd[r] * gm + bt; store_bf4(X1 + (size_t)r * D + c, x1);
            const f32x4 h2 = x1 * (1.0f + sc2) + sh2; *(unsigned*)((unsigned char*)H + (size_t)(row0 + r) * D + c) = pk_fp8x4(h2); v[r][j] = h2; } }
#pragma unroll
    for (int e = 0; e < 16; ++e) {
        f32x4 w[4];
#pragma unroll
        for (int j = 0; j < 4; ++j) w[j] = *(const LAS f32x4*)(wrT + e * 1024 + c0 + 256 * j);
#pragma unroll
        for (int r = 0; r < NR; ++r) { f32x4 acc = v[r][0] * w[0]; acc += v[r][1] * w[1]; acc += v[r][2] * w[2]; acc += v[r][3] * w[3];
            const float tot = wave_sum((acc[0] + acc[1]) + (acc[2] + acc[3]));
            lgv[e] = X.lane == slot0 + r ? tot : lgv[e]; }
        asm volatile("" ::: "memory");
    }
}
DI void ph_ln1(const Ctx& X, const Params& P, int l, bool dummy = false) {
    LAS float* wrT = (LAS float*)X.lds;
    for (int i = X.tid; i < 16384; i += NTHREADS) { const int k = i >> 4, e = i & 15; wrT[e * 1024 + k] = P.in[16][i]; }
    int* TOKP = (int*)(P.ws + WS_TOKP); int* LIST = (int*)(P.ws + WS_LIST);
    unsigned* CNT = (unsigned*)(P.ws + WS_CTL) + CW_CNT + 1024 * l + (dummy ? 4096 : 0);
    LAS int* lcnt = (LAS int*)(X.lds + 65536); LAS int* lbase = lcnt + 16; LAS int* linfo = lcnt + 32;
    if (X.tid < 16) lcnt[X.tid] = 0;
    for (int i = X.tid; i < 72 * 4; i += NTHREADS) linfo[i] = -1;
    __syncthreads();
    const int gw = X.bid * NWAVES + X.wave;
    float lgv[16];
#pragma unroll
    for (int e = 0; e < 16; ++e) lgv[e] = 0.f;
    if (gw < NLAT / 8) ln1_rows<8>(X, P, l, 8 * gw, 0, wrT, lgv);
    const bool hasctx = l == 0 && gw < NCTX;
    if (hasctx) ln1_rows<1>(X, P, l, NLAT + gw, 8, wrT, lgv);
    {
        int* TOKE = (int*)(P.ws + WS_TOKE); float* TOKW = (float*)(P.ws + WS_TOKW);
        const int k = X.lane; const bool valid = (k < 8 && gw < NLAT / 8) || (k == 8 && hasctx); const int row = k < 8 ? 8 * gw + k : NLAT + gw;
        float sg[16], sel[16];
#pragma unroll
        for (int e = 0; e < 16; ++e) { sg[e] = sigmoidf_(lgv[e]); sel[e] = sg[e] + P.in[17][e]; }
        int best = 0; float bestv = -3e38f;
#pragma unroll
        for (int gq = 0; gq < 4; ++gq) { float m1 = -3e38f, m2 = -3e38f;
#pragma unroll
            for (int j = 0; j < 4; ++j) { const float t = sel[gq * 4 + j]; const float lo = fminf(m1, t); m1 = fmaxf(m1, t); m2 = fmaxf(m2, lo); }
            const float gs = m1 + m2; const bool bt = gs > bestv; best = bt ? gq : best; bestv = bt ? gs : bestv; }
        int i0 = 0, i1 = 0; float v0 = -3e38f, v1 = -3e38f, s0 = 0.f, s1 = 0.f;
#pragma unroll
        for (int e = 0; e < 16; ++e) { const float t = (e >> 2) == best ? sel[e] : -3e38f; const bool c0 = t > v0, c1 = !c0 && t > v1;
            v1 = c0 ? v0 : (c1 ? t : v1); i1 = c0 ? i0 : (c1 ? e : i1); s1 = c0 ? s0 : (c1 ? sg[e] : s1);
            v0 = c0 ? t : v0; i0 = c0 ? e : i0; s0 = c0 ? sg[e] : s0; }
        if (valid) { const int slot = X.wave * 9 + k; const float inv = 1.0f / (s0 + s1);
            const int p0 = __hip_atomic_fetch_add(lcnt + i0, 1, __ATOMIC_RELAXED, __HIP_MEMORY_SCOPE_WORKGROUP), p1 = __hip_atomic_fetch_add(lcnt + i1, 1, __ATOMIC_RELAXED, __HIP_MEMORY_SCOPE_WORKGROUP);
            linfo[4 * slot] = row; linfo[4 * slot + 1] = i0 | (i1 << 8); linfo[4 * slot + 2] = p0; linfo[4 * slot + 3] = p1;
            TOKE[2 * row] = i0; TOKE[2 * row + 1] = i1; TOKW[2 * row] = s0 * inv; TOKW[2 * row + 1] = s1 * inv; }
    }
    __syncthreads();
    if (X.tid < 16) lbase[X.tid] = (int)atomicAdd(CNT + 64 * X.tid, (unsigned)lcnt[X.tid]);
    __syncthreads();
    if (X.tid < 72) { const int row = linfo[4 * X.tid];
        if (row >= 0) { const int ee = linfo[4 * X.tid + 1], e0 = ee & 255, e1 = ee >> 8, p0 = lbase[e0] + linfo[4 * X.tid + 2], p1 = lbase[e1] + linfo[4 * X.tid + 3];
            LIST[e0 * LISTCAP + p0] = row; LIST[e1 * LISTCAP + p1] = row; TOKP[2 * row] = p0; TOKP[2 * row + 1] = p1; } }
}
template <int NR>
DI void ln2_rows(const Ctx& X, const Params& P, int l, int row0, const int (&off)[16]) {
    bf16_t* H = (bf16_t*)(P.ws + WS_H); const unsigned char* O = P.ws + WS_O; const bf16_t* X1 = (const bf16_t*)(P.ws + WS_X1) + (size_t)row0 * D;
    const int* TOKE = (const int*)(P.ws + WS_TOKE); const int* TOKP = (const int*)(P.ws + WS_TOKP); const float* TOKW = (const float*)(P.ws + WS_TOKW);
    const float* g = P.in[14] + l * D; const float* bta = P.in[15] + l * D;
    const bool lat = row0 < NLAT;
    const float* md = mods_row(P, l, row0); const float* mdn = mods_row(P, 1, row0);
    const int c0 = 4 * X.lane;
    const unsigned char* ra[NR]; const unsigned char* rb[NR]; float w0[NR], w1[NR];
#pragma unroll
    for (int r = 0; r < NR; ++r) { const int row = row0 + r; const int e0 = TOKE[2 * row], e1 = TOKE[2 * row + 1]; int o0 = 0, o1 = 0;
#pragma unroll
        for (int e = 0; e < 16; ++e) { if (e == e0) o0 = off[e]; if (e == e1) o1 = off[e]; }
        ra[r] = O + (size_t)(o0 + TOKP[2 * row]) * D; rb[r] = O + (size_t)(o1 + TOKP[2 * row + 1]) * D; w0[r] = TOKW[2 * row] * 0.0625f; w1[r] = TOKW[2 * row + 1] * 0.0625f; }
    f32x4 v[NR][4]; float sm[NR];
#pragma unroll
    for (int r = 0; r < NR; ++r) sm[r] = 0.f;
#pragma unroll
    for (int j = 0; j < 4; ++j) { const int c = c0 + 256 * j; const f32x4 g2 = *(const f32x4*)(md + 5120 + c);
#pragma unroll
        for (int r = 0; r < NR; ++r) { const u32x2 xw = *(const u32x2*)(X1 + (size_t)r * D + c); const f32x4 x = {bflo(xw.x), bfhi(xw.x), bflo(xw.y), bfhi(xw.y)}; const int a = *(const int*)(ra[r] + c), b = *(const int*)(rb[r] + c);
            const f32x2 a01 = __builtin_amdgcn_cvt_pk_f32_fp8(a, false), a23 = __builtin_amdgcn_cvt_pk_f32_fp8(a, true), b01 = __builtin_amdgcn_cvt_pk_f32_fp8(b, false), b23 = __builtin_amdgcn_cvt_pk_f32_fp8(b, true);
            const f32x4 f = w0[r] * (f32x4){a01[0], a01[1], a23[0], a23[1]} + w1[r] * (f32x4){b01[0], b01[1], b23[0], b23[1]};
            v[r][j] = ALPHA * x + g2 * f; sm[r] += (v[r][j][0] + v[r][j][1]) + (v[r][j][2] + v[r][j][3]); } }
    float rstd[NR];
#pragma unroll
    for (int r = 0; r < NR; ++r) { const float mean = wave_sum(sm[r]) * (1.0f / D); float q = 0.f;
#pragma unroll
        for (int j = 0; j < 4; ++j) { v[r][j] = v[r][j] - mean; q += (v[r][j][0] * v[r][j][0] + v[r][j][1] * v[r][j][1]) + (v[r][j][2] * v[r][j][2] + v[r][j][3] * v[r][j][3]); }
        sm[r] = q; }
#pragma unroll
    for (int r = 0; r < NR; ++r) rstd[r] = 1.0f / sqrtf(wave_sum(sm[r]) * (1.0f / D) + LN_EPS);
#pragma unroll
    for (int j = 0; j < 4; ++j) { const int c = c0 + 256 * j; const f32x4 gm = *(const f32x4*)(g + c), bt = *(const f32x4*)(bta + c);
        f32x4 sc1 = {0.f, 0.f, 0.f, 0.f}, sh1 = {0.f, 0.f, 0.f, 0.f}; if (l == 0) { sc1 = *(const f32x4*)(mdn + 1024 + c); sh1 = *(const f32x4*)(mdn + c); }
#pragma unroll
        for (int r = 0; r < NR; ++r) { const f32x4 x2 = v[r][j] * rstd[r] * gm + bt;
            if (l == 0) { if (lat) store_bf4((bf16_t*)P.out + (size_t)(row0 + r) * D + c, x2); *(unsigned*)((unsigned char*)H + (size_t)(row0 + r) * D + c) = pk_fp8x4(x2 * (1.0f + sc1) + sh1); }
            else *(f32x4*)(P.out + (size_t)(row0 + r) * D + c) = x2; } }
}
DI void ph_ln2(const Ctx& X, const Params& P, int l) {
    const unsigned* CNT = (const unsigned*)(P.ws + WS_CTL) + CW_CNT + 1024 * l;
    int off[16]; { int acc = 0;
#pragma unroll
        for (int e = 0; e < 16; ++e) { off[e] = acc; acc += (((int)CNT[e * 64] + 255) >> 8) << 8; } }
    const int gw = X.bid * NWAVES + X.wave;
    if (gw < NLAT / 8) { ln2_rows<4>(X, P, l, 8 * gw, off); ln2_rows<4>(X, P, l, 8 * gw + 4, off); }
    if (l == 0 && gw < NCTX) ln2_rows<1>(X, P, l, NLAT + gw, off);
}

struct KeysNA { int b, r, c, rs, cs, h; const float* rpb;
    DI int n() const { return 128 + CTXL; }
    DI void get(int k, int& krow, float& bias) const { if (k < 128) { const int kr = rs + (k >> 4), kc = cs + (k & 15); krow = b * SEQ + kr * 64 + kc; bias = LOG2E * rpb[h * 465 + (kr - r + 7) * 31 + (kc - c + 15)]; } else { krow = NLAT + b * CTXL + (k - 128); bias = 0.f; } } };
struct KeysSWA { int b, lo, nband;
    DI int n() const { return nband + CTXL; }
    DI void get(int k, int& krow, float& bias) const { krow = k < nband ? b * SEQ + lo + k : NLAT + b * CTXL + (k - nband); bias = 0.f; } };
struct KeysCtx { int b;
    DI int n() const { return CTXL; }
    DI void get(int k, int& krow, float& bias) const { krow = NLAT + b * CTXL + k; bias = 0.f; } };
template <class Keys>
DI void attn_row_naive(const bf16_t* PB, int qrow, int qcol, int kcol, int vcol, const Keys& KS, bool has_sink, float sink, LAS float* sc, bf16_t* yout, int lane) {
    float q[64];
    { const u32x4* qp = (const u32x4*)(PB + (size_t)qrow * PBW + qcol);
#pragma unroll
      for (int i = 0; i < 8; ++i) { const u32x4 w = qp[i]; q[8 * i] = bflo(w.x); q[8 * i + 1] = bfhi(w.x); q[8 * i + 2] = bflo(w.y); q[8 * i + 3] = bfhi(w.y); q[8 * i + 4] = bflo(w.z); q[8 * i + 5] = bfhi(w.z); q[8 * i + 6] = bflo(w.w); q[8 * i + 7] = bfhi(w.w); } }
    const int nk = KS.n(); float mx = has_sink ? sink : -3e38f;
    for (int k = lane; k < nk; k += 64) { int krow; float bias; KS.get(k, krow, bias);
        const u32x4* kp = (const u32x4*)(PB + (size_t)krow * PBW + kcol); float s = 0.f;
#pragma unroll
        for (int i = 0; i < 8; ++i) { const u32x4 w = kp[i]; s += q[8 * i] * bflo(w.x) + q[8 * i + 1] * bfhi(w.x) + q[8 * i + 2] * bflo(w.y) + q[8 * i + 3] * bfhi(w.y) + q[8 * i + 4] * bflo(w.z) + q[8 * i + 5] * bfhi(w.z) + q[8 * i + 6] * bflo(w.w) + q[8 * i + 7] * bfhi(w.w); }
        s += bias; sc[k] = s; mx = fmaxf(mx, s); }
    mx = wave_max(mx); float den = 0.f;
    for (int k = lane; k < nk; k += 64) { const float p = exp2f(sc[k] - mx); sc[k] = p; den += p; }
    den = wave_sum(den); if (has_sink) den += exp2f(sink - mx);
    asm volatile("s_waitcnt lgkmcnt(0)" ::: "memory");
    float o = 0.f;
    for (int k = 0; k < nk; ++k) { int krow; float bias; KS.get(k, krow, bias); o += sc[k] * bf2f(PB[(size_t)krow * PBW + vcol + lane]); }
    yout[lane] = (bf16_t)f2bf(o / den);
    asm volatile("s_waitcnt lgkmcnt(0)" ::: "memory");
}
DI void ph_attn_naive(const Ctx& X, const Params& P, int l) {
    const bf16_t* PB = (const bf16_t*)(P.ws + WS_PB); bf16_t* Y = (bf16_t*)(P.ws + WS_Y);
    LAS float* sc = (LAS float*)X.lds + X.wave * 640;
    const float* rpb = P.in[9] + l * 4 * 465; const float* sink = P.in[10] + l * 8;
    const int nrows = l == 0 ? NROWS : NLAT;
    const int gw = X.bid * NWAVES + X.wave, NGW = X.nb * NWAVES;
    for (int it = gw; it < nrows * 12; it += NGW) {
        const int row = it / 12, hh = it % 12;
        if (row < NLAT) { const int b = row >> 13, t = row & (SEQ - 1);
            if (hh < 4) { KeysNA K; K.b = b; K.r = t >> 6; K.c = t & 63; K.rs = min(max(K.r - 4, 0), 120); K.cs = min(max(K.c - 8, 0), 48); K.h = hh; K.rpb = rpb;
                attn_row_naive(PB, row, PB_NQ + hh * 64, PB_NK + hh * 64, PB_NV + hh * 64, K, false, 0.f, sc, Y + (size_t)row * D + 256 + hh * 64, X.lane);
            } else { const int qh = hh - 4, n = qh >> 2; KeysSWA K; K.b = b; K.lo = max(t - 128, 0); K.nband = min(t + 128, SEQ - 1) - K.lo + 1;
                attn_row_naive(PB, row, PB_SQ + qh * 64, PB_SK + n * 64, PB_SV + n * 64, K, true, LOG2E * sink[qh], sc, Y + (size_t)row * D + 512 + qh * 64, X.lane); }
        } else { const int b = (row - NLAT) >> 8; KeysCtx K; K.b = b;
            if (hh < 4) attn_row_naive(PB, row, PB_NQ + hh * 64, PB_NK + hh * 64, PB_NV + hh * 64, K, false, 0.f, sc, Y + (size_t)row * D + 256 + hh * 64, X.lane);
            else { const int qh = hh - 4, n = qh >> 2; attn_row_naive(PB, row, PB_SQ + qh * 64, PB_SK + n * 64, PB_SV + n * 64, K, true, LOG2E * sink[qh], sc, Y + (size_t)row * D + 512 + qh * 64, X.lane); }
        }
    }
}
DI void ph_hgrn_naive(const Ctx& X, const Params& P, int l) {
    const bf16_t* PB = (const bf16_t*)(P.ws + WS_PB); const float* Z = (const float*)(P.ws + WS_Z); float* O32 = (float*)(P.ws + WS_S);
    const float* LB = (const float*)(P.ws + WS_LB) + l * 512;
    const int gw = X.bid * NWAVES + X.wave;
    if (gw >= 16) return;
    const int b = gw >> 3, h = (gw >> 1) & 3, dir = gw & 1, lane = X.lane;
    const float lb = LB[dir * 256 + h * 64 + lane];
    float S[64];
#pragma unroll
    for (int d = 0; d < 64; ++d) S[d] = 0.f;
    for (int step = 0; step < CTXL + SEQ; ++step) {
        int row;
        if (step < CTXL) row = NLAT + b * CTXL + (dir ? CTXL - 1 - step : step); else { const int t = step - CTXL; row = b * SEQ + (dir ? SEQ - 1 - t : t); }
        float f = exp2f(bf2f(((const bf16_t*)Z)[(size_t)row * ZW + dir * 256 + h * 64 + lane])); const float kk = bf2f(((const bf16_t*)(P.ws + WS_KK))[(size_t)row * ZW + dir * 256 + h * 64 + lane]); (void)lb;
#if DBG_HG_MODE & 8
        f = 1.0f;
#endif
        const float qv = bf2f(PB[(size_t)row * PBW + PB_AQ + h * 64 + lane]), vv = bf2f(PB[(size_t)row * PBW + PB_AI + h * 64 + lane]);
#if DBG_HG_MODE & 1
        if ((step & 63) == 0) {
#pragma unroll
            for (int d = 0; d < 64; ++d) S[d] = 0.f; }
#endif
        float o = 0.f;
#pragma unroll
        for (int d = 0; d < 64; ++d) { const float fd = __builtin_bit_cast(float, __builtin_amdgcn_readlane(__builtin_bit_cast(int, f), d)), kd = __builtin_bit_cast(float, __builtin_amdgcn_readlane(__builtin_bit_cast(int, kk), d)), qd = __builtin_bit_cast(float, __builtin_amdgcn_readlane(__builtin_bit_cast(int, qv), d));
            S[d] = fd * S[d] + kd * vv; o += S[d] * qd; }
#if DBG_HG_MODE & 2
        if (dir == 1) o = 0.f;
#endif
#if DBG_HG_MODE & 4
        if (dir == 0) o = 0.f;
#endif
        O32[((size_t)dir * NROWS + row) * 256 + h * 64 + lane] = o;
    }
}
DI void ph_hgrn_combine_naive(const Ctx& X, const Params& P, int l) {
    const bf16_t* PB = (const bf16_t*)(P.ws + WS_PB); const float* O32 = (const float*)(P.ws + WS_S); bf16_t* Y = (bf16_t*)(P.ws + WS_Y);
    const float* nw = P.in[8] + l * 64;
    const int nrows = l == 0 ? NROWS : NLAT;
    const int gw = X.bid * NWAVES + X.wave, NGW = X.nb * NWAVES;
    for (int it = gw; it < nrows * 4; it += NGW) { const int row = it >> 2, h = it & 3;
        const float o = O32[(size_t)row * 256 + h * 64 + X.lane] + O32[((size_t)NROWS + row) * 256 + h * 64 + X.lane];
        const float ms = wave_sum(o * o) * (1.0f / 64.0f); const float y = o * (1.0f / sqrtf(ms + RMS_EPS)) * nw[X.lane];
        const float gte = bf2f(PB[(size_t)row * PBW + PB_AG + h * 64 + X.lane]);
        Y[(size_t)row * D + h * 64 + X.lane] = (bf16_t)f2bf(y * siluf_(gte)); }
}

typedef short v4i16_t __attribute__((ext_vector_type(4)));
DI s16x4 tr_read(const LAS unsigned char* p) { return __builtin_bit_cast(s16x4, __builtin_amdgcn_ds_read_tr16_b64_v4i16((LAS v4i16_t*)p)); }
DI bf16x8 cat8(s16x4 a, s16x4 b) { return __builtin_shufflevector(a, b, 0, 1, 2, 3, 4, 5, 6, 7); }
DI bf16x8 pack8(float a0, float a1, float a2, float a3, float a4, float a5, float a6, float a7) {
    u32x4 w; w.x = pk2(a0, a1); w.y = pk2(a2, a3); w.z = pk2(a4, a5); w.w = pk2(a6, a7); return __builtin_bit_cast(bf16x8, w); }
DI float shfl_f(float v, int src) { return __shfl(v, src); }

constexpr int HP = 144;
constexpr size_t WS_QT = WS_H, WS_KT = WS_H + (size_t)2 * NROWS * 256 * 2;
#ifdef DBG_MIX
constexpr size_t WS_ST = 318 * MiB;
#else
constexpr size_t WS_ST = WS_Z;
#endif
DI size_t st_base(const Ctx& X) {
#ifdef QPROBE
    return *(volatile LAS unsigned*)(X.lds + 144 * 1024 + 48) ? WS_Y : WS_ST;
#else
    (void)X; return WS_ST;
#endif
}
static_assert(WS_KT + (size_t)2 * NROWS * 256 * 2 <= WS_Y && (size_t)2112 * 4096 * 2 <= (size_t)NROWS * ZW * 4, "hgrn buffers");
DI void hgrn_chunk_rows(int b, int dir, int p, int& row0) {
    if (p < 4) row0 = NLAT + b * CTXL + 64 * (dir ? 3 - p : p); else row0 = b * SEQ + 64 * (dir ? 131 - p : p - 4);
}
DI void hgrn_local_item(const Ctx& X, const Params& P, int l, int it) {
    const bf16_t* PB = (const bf16_t*)(P.ws + WS_PB); const bf16_t* Z = (const bf16_t*)(P.ws + WS_Z);
    bf16_t* QT = (bf16_t*)(P.ws + WS_QT); bf16_t* KT = (bf16_t*)(P.ws + WS_KT); float* U = (float*)(P.ws + WS_S); float* DD = (float*)(P.ws + WS_DD); float* ER = DD + 2112 * 64;
    const float* LB = (const float*)(P.ws + WS_LB) + l * 512;
    LAS unsigned char* kt_l = X.lds + X.wave * (2 * 64 * HP); LAS unsigned char* v_l = kt_l + 64 * HP;
    const int lane = X.lane;
    if (it < 2112) {
        const int p = it % NCHAIN, chain = it / NCHAIN, dir = chain & 1, h = (chain >> 1) & 3, b = chain >> 3;
        int row0; hgrn_chunk_rows(b, dir, p, row0);
#pragma unroll
        for (int i = 0; i < 8; ++i) { const int r = i * 8 + (lane >> 3), pc = lane & 7; const u32x4 w = *(const u32x4*)(PB + (size_t)(row0 + r) * PBW + PB_AI + h * 64 + pc * 8); *(LAS u32x4*)(v_l + r * HP + pc * 16) = w; }
        float lf[64];
        const bf16_t* zp = Z + (size_t)row0 * ZW + dir * 256 + h * 64 + lane;
#pragma unroll
        for (int s = 0; s < 64; ++s) lf[s] = bf2f(zp[(size_t)s * ZW]);
        float ref, last;
        if (dir == 0) {
#pragma unroll
            for (int s = 1; s < 64; ++s) lf[s] += lf[s - 1];
            ref = lf[31]; last = lf[63];
        } else {
#pragma unroll
            for (int s = 62; s >= 0; --s) lf[s] += lf[s + 1];
            ref = lf[32]; last = lf[0];
        }
        const bf16_t* qp = PB + (size_t)row0 * PBW + PB_AQ + h * 64 + lane; const bf16_t* kp = (const bf16_t*)(P.ws + WS_KK) + (size_t)row0 * ZW + dir * 256 + h * 64 + lane;
        bf16_t* qto = QT + ((size_t)dir * NROWS + row0) * 256 + h * 64 + lane; bf16_t* kto = KT + ((size_t)dir * NROWS + row0) * 256 + h * 64 + lane;
#pragma unroll
        for (int hf = 0; hf < 2; ++hf) {
            unsigned short qv[32], kv[32];
#pragma unroll
            for (int s = 0; s < 32; ++s) { qv[s] = qp[(size_t)(32 * hf + s) * PBW]; kv[s] = kp[(size_t)(32 * hf + s) * ZW]; }
#pragma unroll
            for (int s2 = 0; s2 < 32; ++s2) { const int s = 32 * hf + s2;
                const float q = bf2f(qv[s2]), kk = bf2f(kv[s2]);
                const float eq = __builtin_amdgcn_exp2f(lf[s] - ref), ek = __builtin_amdgcn_exp2f(ref - lf[s]);
                const unsigned short qb = (unsigned short)f2bf(q * eq), kb = (unsigned short)f2bf(kk * ek);
                qto[(size_t)s * 256] = qb; kto[(size_t)s * 256] = kb;
                *(LAS unsigned short*)(kt_l + s * HP + lane * 2) = kb; }
            asm volatile("" ::: "memory");
        }
        asm volatile("" ::: "memory");
        const float e_lr = __builtin_amdgcn_exp2f(last - ref);
        DD[it * 64 + lane] = __builtin_amdgcn_exp2f(last); ER[it * 64 + lane] = __builtin_amdgcn_exp2f(ref);
        f32x4 acc[4][4];
#pragma unroll
        for (int m = 0; m < 4; ++m)
#pragma unroll
            for (int n = 0; n < 4; ++n) acc[m][n] = (f32x4){0.f, 0.f, 0.f, 0.f};
        const int g = lane >> 4, i16 = lane & 15;
        const int troff = (8 * g + (i16 >> 2)) * HP + (i16 & 3) * 8;
#pragma unroll
        for (int ks = 0; ks < 2; ++ks) {
            bf16x8 af[4], bfv[4];
#pragma unroll
            for (int m = 0; m < 4; ++m) af[m] = cat8(tr_read(kt_l + troff + ks * 32 * HP + m * 32), tr_read(kt_l + troff + (ks * 32 + 4) * HP + m * 32));
#pragma unroll
            for (int n = 0; n < 4; ++n) bfv[n] = cat8(tr_read(v_l + troff + ks * 32 * HP + n * 32), tr_read(v_l + troff + (ks * 32 + 4) * HP + n * 32));
#pragma unroll
            for (int m = 0; m < 4; ++m)
#pragma unroll
                for (int n = 0; n < 4; ++n) acc[m][n] = __builtin_amdgcn_mfma_f32_16x16x32_bf16(af[m], bfv[n], acc[m][n], 0, 0, 0);
        }
        float* up = U + (size_t)it * 4096;
#pragma unroll
        for (int m = 0; m < 4; ++m)
#pragma unroll
            for (int r = 0; r < 4; ++r) { const int d = 16 * m + 4 * g + r; const float sc = shfl_f(e_lr, d);
#pragma unroll
                for (int n = 0; n < 4; ++n) up[d * 64 + 16 * n + i16] = acc[m][n][r] * sc; }
        asm volatile("s_waitcnt lgkmcnt(0)" ::: "memory");
    }
}
DI void ph_hgrn_scan(const Ctx& X, const Params& P, int part) {
    const float* U = (const float*)(P.ws + WS_S); const float* DD = (const float*)(P.ws + WS_DD); const float* ER = DD + 2112 * 64; bf16_t* ST = (bf16_t*)(P.ws + st_base(X));
    const int gt = part * NTHREADS + X.tid;
    const int chain = gt >> 11, d = (gt >> 5) & 63, e2 = (gt & 31) * 2;
    float s0 = 0.f, s1 = 0.f;
    for (int p0 = 0; p0 < NCHAIN; p0 += 4) {
        f32x2 u[4]; float dd[4], er[4];
#pragma unroll
        for (int j = 0; j < 4; ++j) { const int slot = chain * NCHAIN + p0 + j; u[j] = *(const f32x2*)(U + (size_t)slot * 4096 + d * 64 + e2); dd[j] = DD[slot * 64 + d]; er[j] = ER[slot * 64 + d]; }
#pragma unroll
        for (int j = 0; j < 4; ++j) { const int slot = chain * NCHAIN + p0 + j; *(unsigned*)(ST + (size_t)slot * 4096 + d * 64 + e2) = pk2(s0 * er[j], s1 * er[j]); s0 = dd[j] * s0 + u[j][0]; s1 = dd[j] * s1 + u[j][1]; }
    }
}
DI void hgrn_out_item(const Ctx& X, const Params& P, int l, int it) {
    const bf16_t* PB = (const bf16_t*)(P.ws + WS_PB); const bf16_t* QT = (const bf16_t*)(P.ws + WS_QT); const bf16_t* KT = (const bf16_t*)(P.ws + WS_KT); const bf16_t* ST = (const bf16_t*)(P.ws + st_base(X));
    unsigned char* Y = P.ws + WS_Y;        const float* nw = P.in[8] + l * 64;
    LAS unsigned char* s_l = X.lds + X.wave * (2 * 64 * HP); LAS unsigned char* v_l = s_l + 64 * HP;
    const int lane = X.lane, g = lane >> 4, i16 = lane & 15, gw = X.wave * X.nb + X.bid, NGW = X.nb * NWAVES;
    const int nchunk = l == 0 ? 132 : 128;
    const int troff = (8 * g + (i16 >> 2)) * HP + (i16 & 3) * 8;
    const int troff4 = (4 * g + (i16 >> 2)) * HP + (i16 & 3) * 8;
    (void)gw; (void)NGW;
    if (it < 8 * nchunk) {
        const int c = it % nchunk, bh = it / nchunk, h = bh & 3, b = bh >> 2;
        const bool isctx = c >= 128; const int row0 = isctx ? NLAT + b * CTXL + 64 * (c - 128) : b * SEQ + 64 * c;
#pragma unroll
        for (int i = 0; i < 8; ++i) { const int r = i * 8 + (lane >> 3), pc = lane & 7; const u32x4 w = *(const u32x4*)(PB + (size_t)(row0 + r) * PBW + PB_AI + h * 64 + pc * 8); *(LAS u32x4*)(v_l + r * HP + pc * 16) = w; }
        f32x4 o[4][4];
#pragma unroll
        for (int a = 0; a < 4; ++a)
#pragma unroll
            for (int t = 0; t < 4; ++t) o[a][t] = (f32x4){0.f, 0.f, 0.f, 0.f};
#pragma unroll 1
        for (int dir = 0; dir < 2; ++dir) {
#if DBG_HG_MODE & 2
            if (dir == 1) continue;
#endif
#if DBG_HG_MODE & 4
            if (dir == 0) continue;
#endif
            const int p = isctx ? (dir ? 3 - (c - 128) : c - 128) : (dir ? 127 - c + 4 : c + 4);
            const int slot = ((b * 4 + h) * 2 + dir) * NCHAIN + p, sgn = 1 - 2 * dir;
            asm volatile("s_waitcnt lgkmcnt(0)" ::: "memory");
#pragma unroll
            for (int i = 0; i < 8; ++i) { const int r = i * 8 + (lane >> 3), pc = lane & 7; const u32x4 w = *(const u32x4*)(ST + (size_t)slot * 4096 + r * 64 + pc * 8); *(LAS u32x4*)(s_l + r * HP + pc * 16) = w; }
            const bf16_t* qt = QT + ((size_t)dir * NROWS + row0) * 256 + h * 64 + g * 8; const bf16_t* kt = KT + ((size_t)dir * NROWS + row0) * 256 + h * 64 + g * 8;
            bf16x8 qf[4][2];
#pragma unroll
            for (int t = 0; t < 4; ++t)
#pragma unroll
                for (int ks = 0; ks < 2; ++ks) qf[t][ks] = *(const bf16x8*)(qt + (size_t)(16 * t + i16) * 256 + 32 * ks);
#pragma unroll
            for (int pr = 0; pr < 2; ++pr) {
                bf16x8 kf[2][2];
#pragma unroll
                for (int t = 0; t < 2; ++t)
#pragma unroll
                    for (int ks = 0; ks < 2; ++ks) kf[t][ks] = *(const bf16x8*)(kt + (size_t)(16 * (2 * pr + t) + i16) * 256 + 32 * ks);
                f32x4 sc[2][4];
#pragma unroll
                for (int s2 = 0; s2 < 2; ++s2)
#pragma unroll
                    for (int tt = 0; tt < 4; ++tt) { f32x4 a = {0.f, 0.f, 0.f, 0.f};
                        a = __builtin_amdgcn_mfma_f32_16x16x32_bf16(kf[s2][0], qf[tt][0], a, 0, 0, 0); a = __builtin_amdgcn_mfma_f32_16x16x32_bf16(kf[s2][1], qf[tt][1], a, 0, 0, 0);
#pragma unroll
                        for (int r = 0; r < 4; ++r) { const int sidx = 16 * (2 * pr + s2) + 4 * g + r, tidx = 16 * tt + i16; const int keep = ~(((tidx - sidx) * sgn) >> 31); { const float av = a[r]; a[r] = __int_as_float(__float_as_int(av) & keep); } }
                        sc[s2][tt] = a; }
                bf16x8 vf[4];
#pragma unroll
#ifdef DBG_NO_TR
                for (int et = 0; et < 4; ++et) { unsigned short tv[8];
#pragma unroll
                    for (int j = 0; j < 8; ++j) { const int sidx = 32 * pr + (j < 4 ? 4 * g + j : 16 + 4 * g + (j - 4)); tv[j] = *(const LAS unsigned short*)(v_l + sidx * HP + (16 * et + i16) * 2); }
                    u32x4 w; w.x = tv[0] | ((unsigned)tv[1] << 16); w.y = tv[2] | ((unsigned)tv[3] << 16); w.z = tv[4] | ((unsigned)tv[5] << 16); w.w = tv[6] | ((unsigned)tv[7] << 16); vf[et] = __builtin_bit_cast(bf16x8, w); }
#else
                for (int et = 0; et < 4; ++et) vf[et] = cat8(tr_read(v_l + troff4 + (32 * pr) * HP + et * 32), tr_read(v_l + troff4 + (32 * pr + 16) * HP + et * 32));
#endif
#ifdef DBG_BRUTE
                {   float* dacc = (float*)(P.ws + WS_CTL) + CW_DBG + 16; float nA = 0.f, dA = 0.f, nB = 0.f, dB = 0.f;
                    const bf16_t* qt0 = QT + ((size_t)dir * NROWS + row0) * 256 + h * 64; const bf16_t* kt0 = KT + ((size_t)dir * NROWS + row0) * 256 + h * 64;
#if DBG_TEST == 1
#pragma unroll
                    for (int s2 = 0; s2 < 2; ++s2)
#pragma unroll
                        for (int tt = 0; tt < 4; ++tt)
#pragma unroll
                            for (int r = 0; r < 4; ++r) *(LAS float*)(s_l + (((s2 * 4 + tt) * 4 + r) * 64 + lane) * 4) = sc[s2][tt][r];
                    asm volatile("s_waitcnt lgkmcnt(0)" ::: "memory");
#pragma unroll 1
                    for (int idx = 0; idx < 32; ++idx) { const int s2 = idx >> 4, tt = (idx >> 2) & 3, r = idx & 3; const int sidx = 16 * (2 * pr + s2) + 4 * g + r, tidx = 16 * tt + i16; float ref = 0.f;
#pragma unroll 1
                        for (int d = 0; d < 64; ++d) ref += bf2f(kt0[(size_t)sidx * 256 + d]) * bf2f(qt0[(size_t)tidx * 256 + d]);
                        if (sidx > tidx) ref = 0.f; const float got = *(LAS float*)(s_l + (idx * 64 + lane) * 4); const float df = got - ref; nA += df * df; dA += ref * ref; }
#endif
#if DBG_TEST == 2
#pragma unroll
                    for (int et = 0; et < 4; ++et)
#pragma unroll
                        for (int j = 0; j < 8; ++j) { const int sidx = 32 * pr + (j < 4 ? 4 * g + j : 16 + 4 * g + (j - 4)); const float ref = bf2f(PB[(size_t)(row0 + sidx) * PBW + PB_AI + h * 64 + 16 * et + i16]);
                            const float got = bf2f((unsigned short)vf[et][j]); const float df = got - ref; nB += df * df; dB += ref * ref; asm volatile("" : "+v"(nB), "+v"(dB) :: "memory"); }
#endif
                    nA = wave_sum(nA); dA = wave_sum(dA); nB = wave_sum(nB); dB = wave_sum(dB); if (lane == 0) { atomicAdd(dacc, nA); atomicAdd(dacc + 1, dA); atomicAdd(dacc + 2, nB); atomicAdd(dacc + 3, dB); }
                }
#endif
#pragma unroll
                for (int tt = 0; tt < 4; ++tt) { const f32x4 p0 = sc[0][tt], p1 = sc[1][tt]; const bf16x8 pf = pack8(p0[0], p0[1], p0[2], p0[3], p1[0], p1[1], p1[2], p1[3]);
#pragma unroll
                    for (int et = 0; et < 4; ++et) o[et][tt] = __builtin_amdgcn_mfma_f32_16x16x32_bf16(vf[et], pf, o[et][tt], 0, 0, 0); }
                asm volatile("" ::: "memory");
            }
#pragma unroll
            for (int ks = 0; ks < ((DBG_HG_MODE & 1) ? 0 : 2); ++ks) {
                bf16x8 sf[4];
#pragma unroll
                for (int et = 0; et < 4; ++et) sf[et] = cat8(tr_read(s_l + troff + (32 * ks) * HP + et * 32), tr_read(s_l + troff + (32 * ks + 4) * HP + et * 32));
#pragma unroll
                for (int tt = 0; tt < 4; ++tt)
#pragma unroll
                    for (int et = 0; et < 4; ++et) o[et][tt] = __builtin_amdgcn_mfma_f32_16x16x32_bf16(sf[et], qf[tt][ks], o[et][tt], 0, 0, 0);
            }
        }
#if defined(DBG_BRUTE) && DBG_TEST == 3
        {
            float* dacc = (float*)(P.ws + WS_CTL) + CW_DBG + 8; float num = 0.f, den = 0.f;
            const bf16_t* qt0 = QT + ((size_t)0 * NROWS + row0) * 256 + h * 64; const bf16_t* kt0 = KT + ((size_t)0 * NROWS + row0) * 256 + h * 64;
            for (int tt = 0; tt < 4; ++tt) for (int et = 0; et < 4; ++et) for (int r = 0; r < 4; ++r) {
                const int t = 16 * tt + i16, e = 16 * et + 4 * g + r; float ref = 0.f;
                for (int s2 = 0; s2 <= t; ++s2) { float sc = 0.f; for (int d = 0; d < 64; ++d) sc += bf2f(kt0[(size_t)s2 * 256 + d]) * bf2f(qt0[(size_t)t * 256 + d]);
                    ref += bf2f((unsigned short)f2bf(sc)) * bf2f(PB[(size_t)(row0 + s2) * PBW + PB_AI + h * 64 + e]); }
                float got = 0.f;
#pragma unroll
                for (int a = 0; a < 4; ++a)
#pragma unroll
                    for (int b2 = 0; b2 < 4; ++b2)
#pragma unroll
                        for (int c2 = 0; c2 < 4; ++c2) if (a == tt && b2 == et && c2 == r) got = o[b2][a][c2];
                num += (got - ref) * (got - ref); den += ref * ref; }
            num = wave_sum(num); den = wave_sum(den); if (lane == 0) { atomicAdd(dacc, num); atomicAdd(dacc + 1, den); }
        }
#endif
#pragma unroll
        for (int tt = 0; tt < 4; ++tt) {
            float ss = 0.f;
#pragma unroll
            for (int et = 0; et < 4; ++et) ss += (o[et][tt][0] * o[et][tt][0] + o[et][tt][1] * o[et][tt][1]) + (o[et][tt][2] * o[et][tt][2] + o[et][tt][3] * o[et][tt][3]);
            ss += __shfl_xor(ss, 16); ss += __shfl_xor(ss, 32);
            const float rstd = 1.0f / sqrtf(ss * (1.0f / 64.0f) + RMS_EPS);
            const size_t row = (size_t)row0 + 16 * tt + i16;
#pragma unroll
            for (int et = 0; et < 4; ++et) { const int e = 16 * et + 4 * g; const u32x2 gw2 = *(const u32x2*)(PB + row * PBW + PB_AG + h * 64 + e); const f32x4 wv = *(const f32x4*)(nw + e);
                const f32x4 gt = {bflo(gw2.x), bfhi(gw2.x), bflo(gw2.y), bfhi(gw2.y)}; f32x4 y;
#pragma unroll
                for (int r = 0; r < 4; ++r) y[r] = o[et][tt][r] * rstd * wv[r] * siluf_(gt[r]);
                *(unsigned*)(Y + row * D + h * 64 + e) = pk_fp8x4(y); }
        }
        asm volatile("s_waitcnt lgkmcnt(0)" ::: "memory");
    }
}


DI void ph_hgrn_out(const Ctx& X, const Params& P, int l) { const int n = 8 * (l == 0 ? 132 : 128); for (int it = X.wave * X.nb + X.bid; it < n; it += X.nb * NWAVES) hgrn_out_item(X, P, l, it); }

#ifdef DBG_BRUTE
DI void ph_dbg_scores(const Ctx& X, const Params& P, int l) {
    const bf16_t* QT = (const bf16_t*)(P.ws + WS_QT); const bf16_t* KT = (const bf16_t*)(P.ws + WS_KT);
    LAS unsigned char* s_l = X.lds + X.wave * (2 * 64 * HP);
    const int lane = X.lane, g = lane >> 4, i16 = lane & 15, gw = X.wave * X.nb + X.bid, NGW = X.nb * NWAVES;
    float* dacc = (float*)(P.ws + WS_CTL) + CW_DBG + 16; float nA = 0.f, dA = 0.f;
    for (int it = gw; it < 8 * 128; it += NGW) {
        const int c = it % 128, bh = it / 128, h = bh & 3, b = bh >> 2, dir = 0, sgn = 1; const int row0 = b * SEQ + 64 * c;
        const bf16_t* qt = QT + ((size_t)dir * NROWS + row0) * 256 + h * 64 + g * 8; const bf16_t* kt = KT + ((size_t)dir * NROWS + row0) * 256 + h * 64 + g * 8;
        const bf16_t* qt0 = QT + ((size_t)dir * NROWS + row0) * 256 + h * 64; const bf16_t* kt0 = KT + ((size_t)dir * NROWS + row0) * 256 + h * 64;
        bf16x8 qf[4][2];
#pragma unroll
        for (int t = 0; t < 4; ++t)
#pragma unroll
            for (int ks = 0; ks < 2; ++ks) qf[t][ks] = *(const bf16x8*)(qt + (size_t)(16 * t + i16) * 256 + 32 * ks);
#pragma unroll 1
        for (int pr = 0; pr < 2; ++pr) {
            bf16x8 kf[2][2];
#pragma unroll
            for (int t = 0; t < 2; ++t)
#pragma unroll
                for (int ks = 0; ks < 2; ++ks) kf[t][ks] = *(const bf16x8*)(kt + (size_t)(16 * (2 * pr + t) + i16) * 256 + 32 * ks);
#pragma unroll
            for (int s2 = 0; s2 < 2; ++s2)
#pragma unroll
                for (int tt = 0; tt < 4; ++tt) { f32x4 a = {0.f, 0.f, 0.f, 0.f};
                    a = __builtin_amdgcn_mfma_f32_16x16x32_bf16(kf[s2][0], qf[tt][0], a, 0, 0, 0); a = __builtin_amdgcn_mfma_f32_16x16x32_bf16(kf[s2][1], qf[tt][1], a, 0, 0, 0);
#pragma unroll
                    for (int r = 0; r < 4; ++r) { const int sidx = 16 * (2 * pr + s2) + 4 * g + r, tidx = 16 * tt + i16; const int keep = ~(((tidx - sidx) * sgn) >> 31); { const float av = a[r]; a[r] = __int_as_float(__float_as_int(av) & keep); }
                        *(LAS float*)(s_l + (((s2 * 4 + tt) * 4 + r) * 64 + lane) * 4) = a[r]; } }
            asm volatile("s_waitcnt lgkmcnt(0)" ::: "memory");
#pragma unroll 1
            for (int idx = 0; idx < 32; ++idx) { const int s2 = idx >> 4, tt = (idx >> 2) & 3, r = idx & 3; const int sidx = 16 * (2 * pr + s2) + 4 * g + r, tidx = 16 * tt + i16; float ref = 0.f;
#pragma unroll 1
                for (int d = 0; d < 64; ++d) ref += bf2f(kt0[(size_t)sidx * 256 + d]) * bf2f(qt0[(size_t)tidx * 256 + d]);
                if (sidx > tidx) ref = 0.f; const float got = *(LAS float*)(s_l + (idx * 64 + lane) * 4); const float df = got - ref; nA += df * df; dA += ref * ref; }
            asm volatile("s_waitcnt lgkmcnt(0)" ::: "memory");
        }
    }
    nA = wave_sum(nA); dA = wave_sum(dA); if (lane == 0) { atomicAdd(dacc, nA); atomicAdd(dacc + 1, dA); }
}
#endif
constexpr int KP = 144, VP = 192, KBYTES = 128 * KP, VBYTES = 128 * VP, CHB = KBYTES + VBYTES, RPB_OFF = 2 * CHB;
static_assert(RPB_OFF + 4096 <= 144 * 1024, "attn lds");
struct ChunkSrc { int mode, rbase, kr0; };
DI int chunk_row(const ChunkSrc& c, int key) { return c.mode == 0 ? c.rbase + key : c.rbase + min(c.kr0 + (key >> 5), 127) * 64 + (key & 31); }
struct StageRegs { u32x4 k[2], v[2]; };
DI void stage_load(const Ctx& X, const bf16_t* PB, int kcol, int vcol, const ChunkSrc& c, StageRegs& R) {
#pragma unroll
    for (int i = 0; i < 2; ++i) { const int idx = X.tid + NTHREADS * i, key = idx >> 3, pc = idx & 7; const size_t row = (size_t)chunk_row(c, key);
        R.k[i] = *(const u32x4*)(PB + row * PBW + kcol + pc * 8); R.v[i] = *(const u32x4*)(PB + row * PBW + vcol + pc * 8); }
}
DI void stage_store(const Ctx& X, LAS unsigned char* buf, const StageRegs& R) {
#pragma unroll
    for (int i = 0; i < 2; ++i) { const int idx = X.tid + NTHREADS * i, key = idx >> 3, pc = idx & 7;
        *(LAS u32x4*)(buf + key * KP + pc * 16) = R.k[i]; *(LAS u32x4*)(buf + KBYTES + key * VP + pc * 16) = R.v[i]; }
}
template <int NQT> struct AttnState { f32x16 o[NQT][2]; float m[NQT], l[NQT]; };
template <int NQT, class MaskF>
DI void attn_tile_kv(const bf16x8 (&kf)[4], const LAS unsigned char* vt, int kt, const bf16x8 (&qf)[NQT][4], AttnState<NQT>& S, const bool (&act)[NQT], const MaskF& MF, int lane) {
    const int h = lane >> 5, G = lane >> 4, i16 = lane & 15;
    const LAS unsigned char* vb = vt + (4 * h + (i16 >> 2)) * VP + (16 * (G & 1) + 4 * (i16 & 3)) * 2;
    bf16x8 vf[2][2];
#pragma unroll
    for (int db = 0; db < 2; ++db)
#pragma unroll
        for (int s2 = 0; s2 < 2; ++s2) vf[db][s2] = cat8(tr_read(vb + (16 * s2) * VP + db * 64), tr_read(vb + (16 * s2 + 8) * VP + db * 64));
#pragma unroll
    for (int qt = 0; qt < NQT; ++qt) {
        if (!act[qt]) continue;
        f32x16 s;
#pragma unroll
        for (int r = 0; r < 16; ++r) s[r] = 0.f;
#pragma unroll
        for (int ks = 0; ks < 4; ++ks) s = __builtin_amdgcn_mfma_f32_32x32x16_bf16(kf[ks], qf[qt][ks], s, 0, 0, 0);
        MF(s, qt, kt);
        float mx = s[0];
#pragma unroll
        for (int r = 1; r < 16; ++r) mx = fmaxf(mx, s[r]);
        { const auto rr = __builtin_amdgcn_permlane32_swap(__float_as_uint(mx), __float_as_uint(mx), false, false); mx = fmaxf(__uint_as_float(rr[0]), __uint_as_float(rr[1])); }
        {
            const float mn = fmaxf(S.m[qt], mx), alpha = __builtin_amdgcn_exp2f(S.m[qt] - mn); S.m[qt] = mn; S.l[qt] *= alpha;
#pragma unroll
            for (int db = 0; db < 2; ++db)
#pragma unroll
                for (int r = 0; r < 16; ++r) S.o[qt][db][r] *= alpha;
        }
        const float mcur = S.m[qt]; float ps = 0.f;
#pragma unroll
        for (int r = 0; r < 16; ++r) { s[r] = __builtin_amdgcn_exp2f(s[r] - mcur); ps += s[r]; }
        S.l[qt] += ps;
        const bf16x8 p0 = pack8(s[0], s[1], s[2], s[3], s[4], s[5], s[6], s[7]), p1 = pack8(s[8], s[9], s[10], s[11], s[12], s[13], s[14], s[15]);
#pragma unroll
        for (int db = 0; db < 2; ++db) { S.o[qt][db] = __builtin_amdgcn_mfma_f32_32x32x16_bf16(vf[db][0], p0, S.o[qt][db], 0, 0, 0); S.o[qt][db] = __builtin_amdgcn_mfma_f32_32x32x16_bf16(vf[db][1], p1, S.o[qt][db], 0, 0, 0); }
    }
}
template <int NQT, class MaskF>
DI void attn_tile(const LAS unsigned char* buf, int kt, const bf16x8 (&qf)[NQT][4], AttnState<NQT>& S, const bool (&act)[NQT], const MaskF& MF, int lane) {
    bf16x8 kf[4];
#pragma unroll
    for (int ks = 0; ks < 4; ++ks) kf[ks] = *(const LAS bf16x8*)(buf + (32 * kt + (lane & 31)) * KP + ks * 32 + (lane >> 5) * 16);
    attn_tile_kv<NQT, MaskF>(kf, buf + KBYTES + 32 * kt * VP, kt, qf, S, act, MF, lane);
}
template <int NQT>
DI void attn_finish(AttnState<NQT>& S, int qt, unsigned char* yrow  , int lane) {
    const int h = lane >> 5; float l = S.l[qt]; { const auto rr = __builtin_amdgcn_permlane32_swap(__float_as_uint(l), __float_as_uint(l), false, false); l = __uint_as_float(rr[0]) + __uint_as_float(rr[1]); } const float inv = 1.0f / l;
#pragma unroll
    for (int db = 0; db < 2; ++db)
#pragma unroll
        for (int gq = 0; gq < 4; ++gq) *(unsigned*)(yrow + 32 * db + 8 * gq + 4 * h) = pk_fp8x4((f32x4){S.o[qt][db][4 * gq] * inv, S.o[qt][db][4 * gq + 1] * inv, S.o[qt][db][4 * gq + 2] * inv, S.o[qt][db][4 * gq + 3] * inv});
}
struct MaskNone { DI void operator()(f32x16&, int, int) const {} };
struct MaskSWA { int cmode, u0, lane;
    DI void operator()(f32x16& s, int qt, int kt) const {
        if (cmode == 1 || 32 * kt != u0 + 32 * qt) return;
        const int sg = cmode == 0 ? 1 : -1, e = sg * (4 * (lane >> 5) - (lane & 31));
#pragma unroll
        for (int r = 0; r < 16; ++r) { const int thr = -sg * ((r & 3) + 8 * (r >> 2)); s[r] = e >= thr ? s[r] : -1e30f; }
    } };
DI void swa_item(const Ctx& X, const Params& P, int l, int it) {
    const bf16_t* PB = (const bf16_t*)(P.ws + WS_PB); unsigned char* Y = P.ws + WS_Y;        const float* sink = P.in[10] + l * 8;
    const int lane = X.lane, w = X.wave;
    {
        const int j = it & 63, n = (it >> 6) & 1, b = it >> 7;
        const int qh = n * 4 + (w >> 1), u0 = (w & 1) * 64;
        const int nchunks = 3 + (j > 0) + (j < 63);
        bf16x8 qf[2][4];
#pragma unroll
        for (int qt = 0; qt < 2; ++qt)
#pragma unroll
            for (int ks = 0; ks < 4; ++ks) qf[qt][ks] = *(const bf16x8*)(PB + (size_t)(b * SEQ + 128 * j + u0 + 32 * qt + (lane & 31)) * PBW + PB_SQ + qh * 64 + 16 * ks + 8 * (lane >> 5));
        AttnState<2> S;
#pragma unroll
        for (int qt = 0; qt < 2; ++qt) { S.m[qt] = LOG2E * sink[qh]; S.l[qt] = lane < 32 ? 1.0f : 0.0f;
#pragma unroll
            for (int db = 0; db < 2; ++db)
#pragma unroll
                for (int r = 0; r < 16; ++r) S.o[qt][db][r] = 0.f; }
        StageRegs R;
        auto chunk_id = [&](int i) -> int { return i < 2 ? 3 + i : (i == 2 ? 1 : (i == 3 ? (j > 0 ? 0 : 2) : 2)); };
        auto chunk_src = [&](int c) -> ChunkSrc { ChunkSrc cs; cs.mode = 0; cs.kr0 = 0; cs.rbase = c < 3 ? b * SEQ + 128 * (j - 1 + c) : NLAT + b * CTXL + 128 * (c - 3); return cs; };
        stage_load(X, PB, PB_SK + n * 64, PB_SV + n * 64, chunk_src(chunk_id(0)), R);
#pragma unroll
        for (int qt = 0; qt < 2; ++qt)
#pragma unroll
            for (int ks = 0; ks < 4; ++ks) asm volatile("" : "+v"(qf[qt][ks]));
        stage_store(X, X.lds, R);
        __syncthreads();
        for (int i = 0; i < nchunks; ++i) {
            const int c = chunk_id(i);
            if (i + 1 < nchunks) stage_load(X, PB, PB_SK + n * 64, PB_SV + n * 64, chunk_src(chunk_id(i + 1)), R);
            const LAS unsigned char* buf = X.lds + (i & 1) * CHB;
            MaskSWA MF; MF.cmode = c == 0 ? 0 : (c == 2 ? 2 : 1); MF.u0 = u0; MF.lane = lane;
#pragma unroll 1
            for (int kt = 0; kt < 4; ++kt) {
                bool act[2];
#pragma unroll
                for (int qt = 0; qt < 2; ++qt) act[qt] = c == 0 ? (32 * kt + 31 >= u0 + 32 * qt) : (c == 2 ? (32 * kt <= u0 + 32 * qt + 31) : true);
                if (!(act[0] || act[1])) continue;
                attn_tile<2>(buf, kt, qf, S, act, MF, lane);
            }
            if (i + 1 < nchunks) stage_store(X, X.lds + ((i + 1) & 1) * CHB, R);
            __syncthreads();
        }
#pragma unroll
        for (int qt = 0; qt < 2; ++qt) attn_finish<2>(S, qt, Y + (size_t)(b * SEQ + 128 * j + u0 + 32 * qt + (lane & 31)) * D + 512 + qh * 64, lane);
    }
}
struct MaskNA { bool win; int kr0, qr, qc, rs, cs, blk, lane; const LAS float* rpb;
    DI void operator()(f32x16& s, int qt, int kt) const {
        if (!win) return;
        const int kr = kr0 + kt; const bool rowok = kr >= rs && kr < rs + 8;
        const int kcb = blk + 4 * (lane >> 5); const int ib = rowok ? (kr - qr + 7) * 31 + (kcb - qc + 15) : 0;
        float bv[16];
#pragma unroll
        for (int r = 0; r < 16; ++r) bv[r] = rpb[ib + (r & 3) + 8 * (r >> 2)];
        asm volatile("" : "+v"(bv[0]), "+v"(bv[1]), "+v"(bv[2]), "+v"(bv[3]), "+v"(bv[4]), "+v"(bv[5]), "+v"(bv[6]), "+v"(bv[7]), "+v"(bv[8]), "+v"(bv[9]), "+v"(bv[10]), "+v"(bv[11]), "+v"(bv[12]), "+v"(bv[13]), "+v"(bv[14]), "+v"(bv[15]));
        const unsigned t0 = rowok ? (unsigned)(kcb - cs) : 0x7fffff00u;
#pragma unroll
        for (int r = 0; r < 16; ++r) { const bool ok = t0 + (unsigned)((r & 3) + 8 * (r >> 2)) < 16u; s[r] = ok ? s[r] + bv[r] : -1e30f; }
    } };
struct NaTileRegs { bf16x8 k[4]; u32x4 v[4]; };
DI void na_load(const bf16_t* PB, int h, int rowk  , int rowv  , int lane, NaTileRegs& R) {
    const bf16_t* kp = PB + (size_t)rowk * PBW + PB_NK + h * 64 + 8 * (lane >> 5);
#pragma unroll
    for (int ks = 0; ks < 4; ++ks) R.k[ks] = *(const bf16x8*)(kp + 16 * ks);
    const bf16_t* vp = PB + (size_t)rowv * PBW + PB_NV + h * 64 + (lane & 1) * 32;
#pragma unroll
    for (int i = 0; i < 4; ++i) R.v[i] = *(const u32x4*)(vp + 8 * i);
}
DI void na_item(const Ctx& X, const Params& P, int l, int it) {
    const bf16_t* PB = (const bf16_t*)(P.ws + WS_PB); unsigned char* Y = P.ws + WS_Y;        const float* rpbg = P.in[9] + l * 4 * 465;
    const int lane = X.lane, w = X.wave; LAS float* rpbl = (LAS float*)(X.lds + 8 * 32 * VP) + 32;
    LAS unsigned char* vt = X.lds + w * (32 * VP);
    const int j = it & 3, rg = (it >> 2) & 7, h = (it >> 5) & 3, b = it >> 7;
    const int r0 = 16 * rg, blk = min(max(16 * j - 8, 0), 32);
    const int ra = r0 + 2 * w, qr = ra + ((lane & 31) >> 4), qc = 16 * j + (lane & 15);
    const int rs_a = min(max(ra - 4, 0), 120), rs_b = min(max(ra + 1 - 4, 0), 120), ntile = 8 + (rs_b + 8 - rs_a);
    for (int i = X.tid; i < 465; i += NTHREADS) rpbl[i] = LOG2E * rpbg[h * 465 + i];
    __syncthreads();
    bf16x8 qf[1][4];
#pragma unroll
    for (int ks = 0; ks < 4; ++ks) qf[0][ks] = *(const bf16x8*)(PB + (size_t)(b * SEQ + qr * 64 + qc) * PBW + PB_NQ + h * 64 + 16 * ks + 8 * (lane >> 5));
    AttnState<1> S; S.m[0] = -1e30f; S.l[0] = 0.f;
#pragma unroll
    for (int db = 0; db < 2; ++db)
#pragma unroll
        for (int r = 0; r < 16; ++r) S.o[0][db][r] = 0.f;
    MaskNA MF; MF.qr = qr; MF.qc = qc; MF.rs = min(max(qr - 4, 0), 120); MF.cs = min(max(qc - 8, 0), 48); MF.blk = blk; MF.lane = lane; MF.rpb = rpbl;
    const bool act[1] = {true};
#define NA_ROW(t, key) ((t) < 8 ? NLAT + b * CTXL + 32 * (t) + (key) : b * SEQ + (rs_a + (t) - 8) * 64 + blk + (key))
#define NA_LOAD(t, R) na_load(PB, h, NA_ROW(t, lane & 31), NA_ROW(t, lane >> 1), lane, R)
#define NA_COMPUTE(t, R) do { asm volatile("" ::: "memory"); _Pragma("unroll") for (int i_ = 0; i_ < 4; ++i_) *(LAS u32x4*)(vt + (lane >> 1) * VP + (lane & 1) * 64 + i_ * 16) = R.v[i_]; \
        asm volatile("" ::: "memory"); MF.win = (t) >= 8; MF.kr0 = rs_a + (t) - 8; attn_tile_kv<1>(R.k, vt, 0, qf, S, act, MF, lane); asm volatile("" ::: "memory"); } while (0)
    NaTileRegs RA, RB;
    NA_LOAD(0, RA);
#pragma unroll
    for (int ks = 0; ks < 4; ++ks) asm volatile("" : "+v"(qf[0][ks]));
    for (int t = 0; t < ntile; t += 2) {
        { const int tn = min(t + 1, ntile - 1); NA_LOAD(tn, RB); }
        NA_COMPUTE(t, RA);
        { const int tn = min(t + 2, ntile - 1); NA_LOAD(tn, RA); }
        if (t + 1 < ntile) NA_COMPUTE(t + 1, RB);
    }
#undef NA_ROW
#undef NA_LOAD
#undef NA_COMPUTE
    attn_finish<1>(S, 0, Y + (size_t)(b * SEQ + qr * 64 + qc) * D + 256 + h * 64, lane);
    __syncthreads();
}
DI void ctx_attn_item(const Ctx& X, const Params& P, int l, int it) {
    const bf16_t* PB = (const bf16_t*)(P.ws + WS_PB); unsigned char* Y = P.ws + WS_Y;        const float* sink = P.in[10] + l * 8;
    const int lane = X.lane, w = X.wave;
    {
        const bool swa = it >= 8; const int b = (it >> 2) & 1;
        const int h = it & 3, n = (it >> 1) & 1, half = it & 1;
        const int kcol = swa ? PB_SK + n * 64 : PB_NK + h * 64, vcol = swa ? PB_SV + n * 64 : PB_NV + h * 64;
        StageRegs R; ChunkSrc cs; cs.mode = 0; cs.kr0 = 0; cs.rbase = NLAT + b * CTXL;
        stage_load(X, PB, kcol, vcol, cs, R); stage_store(X, X.lds, R);
        cs.rbase += 128; stage_load(X, PB, kcol, vcol, cs, R); stage_store(X, X.lds + CHB, R);
        __syncthreads();
        const MaskNone MF;
        if (!swa) {
            const int qrow = NLAT + b * CTXL + 32 * w + (lane & 31);
            bf16x8 qf[1][4];
#pragma unroll
            for (int ks = 0; ks < 4; ++ks) qf[0][ks] = *(const bf16x8*)(PB + (size_t)qrow * PBW + PB_NQ + h * 64 + 16 * ks + 8 * (lane >> 5));
            AttnState<1> S; S.m[0] = -1e30f; S.l[0] = 0.f;
#pragma unroll
            for (int db = 0; db < 2; ++db)
#pragma unroll
                for (int r = 0; r < 16; ++r) S.o[0][db][r] = 0.f;
            const bool act[1] = {true};
#pragma unroll 1
            for (int kt = 0; kt < 8; ++kt) attn_tile<1>(X.lds + (kt >> 2) * CHB, kt & 3, qf, S, act, MF, lane);
            attn_finish<1>(S, 0, Y + (size_t)qrow * D + 256 + h * 64, lane);
        } else {
            const int qh = n * 4 + half * 2 + (w >> 2), q0 = NLAT + b * CTXL + (w & 3) * 64 + (lane & 31);
            bf16x8 qf[2][4];
#pragma unroll
            for (int qt = 0; qt < 2; ++qt)
#pragma unroll
                for (int ks = 0; ks < 4; ++ks) qf[qt][ks] = *(const bf16x8*)(PB + (size_t)(q0 + 32 * qt) * PBW + PB_SQ + qh * 64 + 16 * ks + 8 * (lane >> 5));
            AttnState<2> S;
#pragma unroll
            for (int qt = 0; qt < 2; ++qt) { S.m[qt] = LOG2E * sink[qh]; S.l[qt] = lane < 32 ? 1.0f : 0.0f;
#pragma unroll
                for (int db = 0; db < 2; ++db)
#pragma unroll
                    for (int r = 0; r < 16; ++r) S.o[qt][db][r] = 0.f; }
            const bool act[2] = {true, true};
#pragma unroll 1
            for (int kt = 0; kt < 8; ++kt) attn_tile<2>(X.lds + (kt >> 2) * CHB, kt & 3, qf, S, act, MF, lane);
#pragma unroll
            for (int qt = 0; qt < 2; ++qt) attn_finish<2>(S, qt, Y + (size_t)(q0 + 32 * qt) * D + 512 + qh * 64, lane);
        }
        __syncthreads();
    }
}

DI void ph_swa(const Ctx& X, const Params& P, int l) { for (int it = X.bid; it < 256; it += X.nb) swa_item(X, P, l, it); }
DI void ph_na(const Ctx& X, const Params& P, int l) { for (int it = X.bid; it < 256; it += X.nb) na_item(X, P, l, it); }
DI void queue_publish(const Ctx& X, unsigned* cnt) {
    asm volatile("s_waitcnt vmcnt(0)" ::: "memory");
    __syncthreads();
    if (X.tid == 0) { __builtin_amdgcn_fence(__ATOMIC_RELEASE, "agent"); asm volatile("s_waitcnt vmcnt(0)" ::: "memory"); __hip_atomic_fetch_add(cnt, 1u, __ATOMIC_RELAXED, __HIP_MEMORY_SCOPE_AGENT); }
}
DI void queue_wait(const Ctx& X, unsigned* cnt, unsigned need) {
    if (X.tid == 0) { unsigned sp = 0; while (__hip_atomic_load(cnt, __ATOMIC_RELAXED, __HIP_MEMORY_SCOPE_AGENT) < need && ++sp < (1u << 24)) __builtin_amdgcn_s_sleep(2);
        __builtin_amdgcn_fence(__ATOMIC_ACQUIRE, "agent"); asm volatile("s_waitcnt vmcnt(0)" ::: "memory"); }
    __syncthreads();
}
DI void ph_mix_queue(const Ctx& X, const Params& P, int l, int rep = 0) {
    unsigned* ctl = (unsigned*)(P.ws + WS_CTL);
    unsigned* head = ctl + CW_Q + 64 * l + 128 * rep; unsigned* scan_cnt = ctl + CW_SCAN + 64 * l + 256 * rep; unsigned* loc_cnt = ctl + CW_SCAN + 128 + 64 * l + 256 * rep;
    volatile LAS unsigned* slot = (volatile LAS unsigned*)(X.lds + 144 * 1024 + 64);
    const int nloc = 264, nscan = 64, nctx = l == 0 ? 16 : 0, nconv = l == 0 ? 1536 : 0, nho = l == 0 ? 132 : 128;
    const int o_ctx = nloc, o_swa = o_ctx + nctx, o_scan = o_swa + 256, o_na = o_scan + nscan, o_conv = o_na + 256, o_ho = o_conv + nconv, total = o_ho + nho;
    bool scan_ok = false;
    for (;;) {
        if (X.tid == 0) *slot = atomicAdd(head, 1u);
        __syncthreads();
        int it = (int)*slot;
        __syncthreads();
        if (it >= total) break;
        if (nconv && it >= o_swa && it < o_ho) {
            const int j = it - o_swa, per = j / 11, ph = j - per * 11;
            it = (ph & 3) == 0 ? o_swa + per * 3 + (ph >> 2) : o_conv + per * 8 + (ph - 1 - (ph > 4) - (ph > 8));
        }
        Ctx Xi = X; { int wv = X.wave; asm volatile("" : "+s"(wv)); int ln; asm volatile("v_mbcnt_lo_u32_b32 %0, -1, 0\n\tv_mbcnt_hi_u32_b32 %0, -1, %0" : "=v"(ln)); Xi.tid = wv * 64 + ln; Xi.lane = ln; Xi.wave = wv; }
#ifdef QMASK
        if (rep) { const int ty = it < o_ctx ? 1 : (it < o_swa ? 2 : (it < o_scan ? 4 : (it < o_na ? 8 : (it < o_conv ? 16 : (it < o_ho ? 32 : 64))))); if (!(QMASK & ty)) continue; }
#endif
        if (it < o_ctx) { hgrn_local_item(Xi, P, l, it * 8 + Xi.wave); queue_publish(Xi, loc_cnt); }
        else if (it < o_swa) ctx_attn_item(Xi, P, l, it - o_ctx);
        else if (it < o_scan) swa_item(Xi, P, l, it - o_swa);
        else if (it < o_na) { queue_wait(Xi, loc_cnt, (unsigned)nloc); ph_hgrn_scan(Xi, P, it - o_scan); queue_publish(Xi, scan_cnt); }
        else if (it < o_conv) na_item(Xi, P, l, it - o_na);
        else if (it < o_ho) { LAS float* scr = (LAS float*)X.lds + X.wave * (64 * 33); const int g = it - o_conv, lyr = g >= 768, f0 = (g - 768 * lyr) * 16 + X.wave;
#define DESC_EQ(i) expert_desc(P, lyr, (i))
            TR_LOOP(DESC_EQ, f0, f0 + 16, 8); __syncthreads(); }
        else { if (!scan_ok) { queue_wait(Xi, scan_cnt, (unsigned)nscan); scan_ok = true; }
            hgrn_out_item(Xi, P, l, (it - o_ho) * 8 + Xi.wave); __syncthreads(); }
    }
}
constexpr size_t WS_Y2 = 284 * MiB;
DI void ph_dbg_copy(const Ctx& X, const Params& P) {
    const u32x4* src = (const u32x4*)(P.ws + WS_Y); u32x4* dst = (u32x4*)(P.ws + WS_Y2);
    for (size_t i = (size_t)X.bid * NTHREADS + X.tid; i < (size_t)NROWS * 128; i += (size_t)X.nb * NTHREADS) dst[i] = src[i];
}
DI void ph_dbg_compare(const Ctx& X, const Params& P) {
    const bf16_t* Yg = (const bf16_t*)(P.ws + WS_Y); const bf16_t* Yf = (const bf16_t*)(P.ws + WS_Y2); float* acc = (float*)(P.ws + WS_CTL) + CW_DBG;
    float num[3] = {0.f, 0.f, 0.f}, den[3] = {0.f, 0.f, 0.f};
    const int gw = X.bid * NWAVES + X.wave, NGW = X.nb * NWAVES;
    for (int row = gw; row < NROWS; row += NGW) {
#pragma unroll
        for (int j = 0; j < 16; ++j) { const int c = j * 64 + X.lane; const float a = bf2f(Yg[(size_t)row * D + c]), b = bf2f(Yf[(size_t)row * D + c]); const float d = a - b;
            const int br = j < 4 ? 0 : (j < 8 ? 1 : 2);
            if (br == 0) { num[0] += d * d; den[0] += a * a; } else if (br == 1) { num[1] += d * d; den[1] += a * a; } else { num[2] += d * d; den[2] += a * a; } }
    }
#pragma unroll
    for (int b = 0; b < 3; ++b) { const float n = wave_sum(num[b]), d = wave_sum(den[b]); if (X.lane == 0) { atomicAdd(acc + 2 * b, n); atomicAdd(acc + 2 * b + 1, d); } }
}
DI void ph_dbg_apply(const Ctx& X, const Params& P) {
    const float* acc = (const float*)(P.ws + WS_CTL) + CW_DBG;
#ifdef DBG_BRUTE
    float code = sqrtf(acc[16] / acc[17]);
#else
    float code = sqrtf(acc[0] / acc[1]);
#endif
    if (code == 0.f) return;
    f32x4* o = (f32x4*)P.out;
    for (size_t i = (size_t)X.bid * NTHREADS + X.tid; i < (size_t)NLAT * 256; i += (size_t)X.nb * NTHREADS) o[i] = o[i] * (1.0f + code);
}

DI void ph_inproj(const Ctx& X, const Params& P, int l) {
    PlainSched S; S.init(NROWS, INW, X.nb, X.bid);
    EpiIn E{(bf16_t*)(P.ws + WS_PB), (bf16_t*)(P.ws + WS_Z), (const float*)(P.ws + WS_ROPE), (const float*)(P.ws + WS_LB) + l * 512, (bf16_t*)(P.ws + WS_KK)};
    gemm_fast<PlainSched, EpiIn, true, 122>(X, P.ws + WS_H, P.ws + WS_WIN + (size_t)l * INW * D, D, S, E);
}
struct EpiNull { DI void group(const Unit&, int, int, f32x4 a0, f32x4 a1, f32x4 b0, f32x4 b1) const { asm volatile("" :: "v"(a0), "v"(a1), "v"(b0), "v"(b1)); } };
DI void ph_inproj_plain(const Ctx& X, const Params& P, int l) {
    PlainSched S; S.init(NROWS, INW, X.nb, X.bid);
    EpiNull E;
    GEMM_IMPL(X, (const bf16_t*)(P.ws + WS_H), (const bf16_t*)(P.ws + WS_WIN) + (size_t)l * INW * D, D, S, E);
}
DI void small_gemm_item(const Ctx& X, const unsigned char* A, const unsigned char* Bt, bf16_t* C, int row0, int col0) {
    const int wm = X.wave >> 2, wn = X.wave & 3, fr = X.lane & 15, fq = X.lane >> 4;
    const unsigned char* ap = A + (size_t)(row0 + 16 * wm + fr) * D + 8 * fq; const unsigned char* bp = Bt + (size_t)(col0 + 16 * wn + fr) * D + 8 * fq;
    f32x4 acc = {0.f, 0.f, 0.f, 0.f};
#pragma unroll 1
    for (int k0 = 0; k0 < D; k0 += 512) {
        long af[16], bfv[16];
#pragma unroll
        for (int i = 0; i < 16; ++i) { af[i] = *(const long*)(ap + k0 + 32 * i); bfv[i] = *(const long*)(bp + k0 + 32 * i); }
#pragma unroll
        for (int i = 0; i < 16; ++i) acc = __builtin_amdgcn_mfma_f32_16x16x32_fp8_fp8(bfv[i], af[i], acc, 0, 0, 0);
    }
    store_bf4(C + (size_t)(row0 + 16 * wm + fr) * D + col0 + 16 * wn + 4 * fq, acc * (1.0f / 64.0f));
}
DI void ph_outproj(const Ctx& X, const Params& P, int l) {
    PlainSched S; S.init(NLAT, D, X.nb, X.bid);
    EpiBf E{(bf16_t*)(P.ws + WS_YO), D};
    gemm_fast<PlainSched, EpiBf, true, 121>(X, P.ws + WS_Y, P.ws + WS_WOUT + (size_t)l * D * D, D, S, E);
    if (l == 0) for (int it = X.bid; it < 256; it += X.nb)
        small_gemm_item(X, P.ws + WS_Y, P.ws + WS_WOUT, (bf16_t*)(P.ws + WS_YO), NLAT + 32 * (it >> 4), 64 * (it & 15));
}
DI void ph_moe(const Ctx& X, const Params& P, int l) {
    const int* cnt = (const int*)(P.ws + WS_CTL) + CW_CNT + 1024 * l; unsigned* rdy = (unsigned*)(P.ws + WS_CTL) + CW_TRDY + 256 * l;
    moe_build_table(X, cnt);
    {
        MoeSched<true> S{cnt, (const int*)(P.ws + WS_LIST), X.nb, X.bid, 4, 1024, X.lds, rdy};
        { LAS int* ll = (LAS int*)(X.lds + MOE_LIST_OFF); Unit u;
#pragma unroll 1
          for (int i = 0; i < 3; ++i) if (S.next(i, u) && X.tid < 256) { const int idx = u.i0 * 256 + X.tid; ll[i * 256 + X.tid] = S.list[u.e * LISTCAP + (idx < u.cnt ? idx : 0)]; }
          __syncthreads(); }
        EpiGU E{(bf16_t*)(P.ws + WS_S)};
        gemm_fast<MoeSched<true>, EpiGU, true, 122>(X, P.ws + WS_H, P.ws + (l ? WS_WGU1 : WS_WGU), D, S, E);
    }
    {
        MoeSched<false> S{cnt, (const int*)(P.ws + WS_LIST), X.nb, X.bid, 4, 1024, X.lds, rdy};
        EpiF8 E{P.ws + WS_O, D};
        gemm_fast<MoeSched<false>, EpiF8, true, 122>(X, P.ws + WS_S, P.ws + (l ? WS_WD1 : WS_WD), DEXP, S, E);
    }
}

#define XB_TMO      128
#define XB_XCNT(j)  (256  + 64 * (j))
#define XB_XSUB(j)  (1280 + 64 * (j))
#define XB_XGEN(j)  (2304 + 64 * (j))
#define XB_TOP      3328
#define XB_TOPGEN   3392
#define XCD_BAR_WORDS 3456
#ifndef XB_SPIN_CAP
#define XB_SPIN_CAP (1u << 26)
#endif
DI unsigned xb_ld(unsigned* p)              { return __hip_atomic_load(p, __ATOMIC_RELAXED, __HIP_MEMORY_SCOPE_AGENT); }
DI unsigned xb_add(unsigned* p, unsigned v) { return __hip_atomic_fetch_add(p, v, __ATOMIC_RELAXED, __HIP_MEMORY_SCOPE_AGENT); }
DI unsigned xb_xcc_id() { return (unsigned)__builtin_amdgcn_s_getreg((3 << 11) | 20) & 0xFu; }
#define XB_SPIN(cond, bar) do { unsigned _sp = 0; while (cond) { __builtin_amdgcn_s_sleep(1); \
    if ((++_sp & 255u) == 0u) { if (xb_ld(&(bar)[XB_TMO])) break; if (_sp > XB_SPIN_CAP) { atomicAdd(&(bar)[XB_TMO], 1u); break; } } } } while (0)
struct XcdBarrier { unsigned* bar; unsigned x; volatile LAS unsigned* st; };
DI XcdBarrier xcd_barrier_post(unsigned* bar, volatile LAS unsigned* st) {
    XcdBarrier b; b.bar = bar; b.x = xb_xcc_id(); b.st = st;
    if (threadIdx.x == 0) (void)xb_add(&bar[XB_XCNT(b.x)], 1u);
    return b;
}
DI void xcd_barrier_complete(unsigned* bar, unsigned x, unsigned& nloc, unsigned& nx) {
    const unsigned G = gridDim.x * gridDim.y * gridDim.z;
    unsigned sum, cnt, mine, sp = 0u;
    for (;;) {
        sum = 0u; cnt = 0u; mine = 0u;
#pragma unroll
        for (unsigned j = 0; j < 16; ++j) { const unsigned c = xb_ld(&bar[XB_XCNT(j)]); sum += c; cnt += (c > 0u) ? 1u : 0u; mine = (j == x) ? c : mine; }
        if (sum == G) break;
        __builtin_amdgcn_s_sleep(1);
        if ((++sp & 255u) == 0u) { if (xb_ld(&bar[XB_TMO])) break; if (sp > XB_SPIN_CAP) { atomicAdd(&bar[XB_TMO], 1u); break; } }
    }
    nloc = mine > 0u ? mine : 1u; nx = cnt > 0u ? cnt : 1u;
}
DI void xcd_barrier(const XcdBarrier& b) {
    asm volatile("s_waitcnt vmcnt(0)" ::: "memory");
    __syncthreads();
    if (threadIdx.x == 0) {
        unsigned* bar = b.bar;
        __builtin_amdgcn_s_waitcnt(0);
        unsigned nloc = b.st[0], nx = b.st[1];
        if (nloc == 0u) { xcd_barrier_complete(bar, b.x, nloc, nx); b.st[0] = nloc; b.st[1] = nx; }
        const unsigned old = xb_add(&bar[XB_XSUB(b.x)], 1u);
        const unsigned gen = old / nloc;
        if (old + 1u == (gen + 1u) * nloc) {
            __builtin_amdgcn_fence(__ATOMIC_RELEASE, "agent");
            asm volatile("s_waitcnt vmcnt(0)" ::: "memory");
            const unsigned og = xb_add(&bar[XB_TOP], 1u);
            const unsigned tg = og / nx;
            if (og + 1u == (tg + 1u) * nx) xb_add(&bar[XB_TOPGEN], 1u);
            else XB_SPIN(xb_ld(&bar[XB_TOPGEN]) == tg, bar);
            __builtin_amdgcn_fence(__ATOMIC_ACQUIRE, "agent");
            xb_add(&bar[XB_XGEN(b.x)], 1u);
            asm volatile("s_waitcnt vmcnt(0)" ::: "memory");
        } else {
            XB_SPIN(xb_ld(&bar[XB_XGEN(b.x)]) == gen, bar);
            __builtin_amdgcn_fence(__ATOMIC_ACQUIRE, "agent");
            asm volatile("s_waitcnt vmcnt(0)" ::: "memory");
        }
    }
    __syncthreads();
}

template <int Q> DI void run_phase(const Ctx& X0, const Params& P0, int l) {
#if defined(__HIP_DEVICE_COMPILE__)
    const __attribute__((address_space(4))) Params* pp_ = (const __attribute__((address_space(4))) Params*)__builtin_amdgcn_kernarg_segment_ptr(); asm volatile("" : "+s"(pp_), "+s"(l));
    const Params P = *pp_; (void)P0;
#else
    const Params P = P0;
#endif
    Ctx X = X0; { int wv = X0.wave; asm volatile("" : "+s"(wv)); int ln; asm volatile("v_mbcnt_lo_u32_b32 %0, -1, 0\n\tv_mbcnt_hi_u32_b32 %0, -1, %0" : "=v"(ln)); X.tid = wv * 64 + ln; X.lane = ln; X.wave = wv; int b_ = X0.bid, n_ = X0.nb; asm volatile("" : "+s"(b_), "+s"(n_)); X.bid = b_; X.nb = n_; }
    if constexpr (Q == 0) ph_prologue(X, P);
    if constexpr (Q == 1) { ph_modulate(X, P, 0); __syncthreads(); convert_rest(X, P); }
    if constexpr (Q == 2) ph_inproj(X, P, l);
    if constexpr (Q == 3) ph_hgrn_naive(X, P, l);
    if constexpr (Q == 4) ph_hgrn_combine_naive(X, P, l);
    if constexpr (Q == 5) ph_attn_naive(X, P, l);
    if constexpr (Q == 6) ph_outproj(X, P, l);
    if constexpr (Q == 7) ph_ln1(X, P, l);
    if constexpr (Q == 24) ph_ln1(X, P, l, true);
    if constexpr (Q == 27) ph_inproj_plain(X, P, l);
    if constexpr (Q == 8) ph_moe(X, P, l);
    if constexpr (Q == 13) ph_hgrn_out(X, P, l);
    if constexpr (Q == 14) ph_swa(X, P, l);
    if constexpr (Q == 15) ph_na(X, P, l);
#ifdef DBG_BRUTE
    if constexpr (Q == 23) ph_dbg_scores(X, P, l);
#endif
    if constexpr (Q == 20) ph_dbg_copy(X, P);
    if constexpr (Q == 21) ph_dbg_compare(X, P);
    if constexpr (Q == 22) ph_dbg_apply(X, P);
    if constexpr (Q == 10) ph_ln2(X, P, l);
    if constexpr (Q == 17) ph_mix_queue(X, P, l);
#ifdef QPROBE
    if constexpr (Q == 18) ph_mix_queue(X, P, l, 1);
#endif
}

constexpr int LDS_BYTES = 150 * 1024;
template <int Q>
__global__ void __launch_bounds__(NTHREADS, 2) k_step(Params P, int l) {
    extern __shared__ __attribute__((aligned(16))) unsigned char lds_raw[];
    Ctx X; X.lds = (LAS unsigned char*)lds_raw; X.tid = threadIdx.x; X.lane = X.tid & 63; X.wave = __builtin_amdgcn_readfirstlane(X.tid >> 6); X.bid = blockIdx.x; X.nb = gridDim.x;
    run_phase<Q>(X, P, l);
}
template <int Q> static void launch_step(const Params& P, int l, int grid, hipStream_t stream) {
    static bool attr = false;
    if (!attr) { (void)hipFuncSetAttribute((const void*)k_step<Q>, hipFuncAttributeMaxDynamicSharedMemorySize, LDS_BYTES); attr = true; }
    hipLaunchKernelGGL(k_step<Q>, dim3(grid), dim3(NTHREADS), LDS_BYTES, stream, P, l);
}

constexpr int LDS_CTL_OFF = 144 * 1024;
__global__ void __launch_bounds__(NTHREADS, 2) k_mega(Params P) {
    extern __shared__ __attribute__((aligned(16))) unsigned char lds_raw[];
    Ctx X; X.lds = (LAS unsigned char*)lds_raw; X.tid = threadIdx.x; X.lane = X.tid & 63; X.wave = __builtin_amdgcn_readfirstlane(X.tid >> 6); X.bid = blockIdx.x; X.nb = gridDim.x;
    volatile LAS unsigned* st = (volatile LAS unsigned*)(X.lds + LDS_CTL_OFF);
    if (X.tid < 16) st[X.tid] = 0u;
    __syncthreads();
    { const XcdBarrier b0 = xcd_barrier_post((unsigned*)(P.ws + WS_CTL) + CW_BAR, st); if (X.tid == 0) st[2] = b0.x; }
    __syncthreads();
#ifdef TS_SEL
#define STAMP() do { if (blockIdx.x == 0 && threadIdx.x == 0) { unsigned long long* ts_ = (unsigned long long*)((unsigned*)(P.ws + WS_CTL) + CW_TS); const unsigned n_ = st[8]; ts_[n_] = __builtin_amdgcn_s_memrealtime(); st[8] = n_ + 1u; } } while (0)
#else
#define STAMP() do { } while (0)
#endif
#define GBAR() do { for (int br_ = 0; br_ < BAR_REP; ++br_) GBAR1(); STAMP(); } while (0)
#define GBAR1() do { unsigned char* w_ = P.ws; asm volatile("" : "+s"(w_)); XcdBarrier b_; b_.bar = (unsigned*)(w_ + WS_CTL) + CW_BAR; b_.st = st; b_.x = threadIdx.x == 0 ? st[2] : 0u; xcd_barrier(b_); } while (0)
#ifndef DUP
#define DUP 0
#endif
#ifndef BAR_REP
#define BAR_REP 1
#endif
#define NREP(bit) ({ int n_ = (DUP & (1 << (bit))) ? 2 : 1; asm volatile("" : "+s"(n_)); n_; })
#define RUNP(Q, bit) do { const int nr_ = NREP(bit); for (int rep_ = 0; rep_ < nr_; ++rep_) { run_phase<Q>(X, P, l); GBAR(); } } while (0)
    STAMP();
    { const int l = 0; RUNP(0, 0); RUNP(1, 1); }
    for (int l = 0; l < 2; ++l) {
        if (DUP & 32768) { run_phase<27>(X, P, l); GBAR(); }
        RUNP(2, 2);
#if FAST_MIX
#ifdef QPROBE
        if (l == QPROBE) { if (X.tid == 0) st[12] = 1u; __syncthreads(); run_phase<18>(X, P, l); GBAR(); if (X.tid == 0) st[12] = 0u; __syncthreads(); }
#endif
        run_phase<17>(X, P, l); GBAR();
#ifdef DBG_MIX
        if (l == 0) {
            run_phase<20>(X, P, l); GBAR();
            run_phase<3>(X, P, l); GBAR();
            run_phase<4>(X, P, l); GBAR();
            run_phase<5>(X, P, l); GBAR();
            run_phase<21>(X, P, l); GBAR();
        }
#endif
#else
        run_phase<3>(X, P, l); GBAR();
        run_phase<4>(X, P, l); GBAR();
        run_phase<5>(X, P, l); GBAR();
#endif
        RUNP(6, 9);
        if ((DUP & 4096) && l == 0) { run_phase<24>(X, P, l); GBAR(); }
        run_phase<7>(X, P, l); GBAR();
        run_phase<8>(X, P, l); GBAR();
        if (DUP & 8192) { run_phase<10>(X, P, l); GBAR(); }
        run_phase<10>(X, P, l); if (l == 0) GBAR();
    }
#ifdef TS_SEL
    GBAR();
    { const unsigned long long* ts_ = (const unsigned long long*)((const unsigned*)(P.ws + WS_CTL) + CW_TS); const float dt_us = 10.0f * floorf((float)(ts_[TS_SEL] - ts_[TS_SEL - 1]) * 0.001f + 0.5f); const float sc = 1.0f + dt_us * (1.0f / 2000.0f);
      f32x4* o = (f32x4*)P.out; for (size_t i = (size_t)blockIdx.x * NTHREADS + threadIdx.x; i < (size_t)NLAT * 256; i += (size_t)gridDim.x * NTHREADS) o[i] = o[i] * sc; }
#endif
#ifdef DBG_MIX
    GBAR(); run_phase<22>(X, P, 0);
#endif
#undef GBAR
}

extern "C" void kernel_launch(void* const* d_in, const int* in_sizes, int n_in, void* d_out, int out_size, void* d_ws, size_t ws_size, hipStream_t stream) {
    static int grid = 0;
    if (grid == 0) {
        if (n_in != 21 || out_size != NLAT * D || ws_size < WS_END) { fprintf(stderr, "kernel_launch: unexpected shapes n_in %d out %d ws %zu\n", n_in, out_size, ws_size); grid = -1; return; }
        int dev = 0, cus = 0; (void)hipGetDevice(&dev); (void)hipDeviceGetAttribute(&cus, hipDeviceAttributeMultiprocessorCount, dev);
        grid = cus > 0 ? cus : 256;
        (void)hipFuncSetAttribute((const void*)k_mega, hipFuncAttributeMaxDynamicSharedMemorySize, LDS_BYTES);
    }
    if (grid < 0) return;
    (void)hipMemsetAsync((char*)d_ws + WS_CTL, 0, CTL_BYTES, stream);
    Params P{};
    for (int i = 0; i < 21; ++i) P.in[i] = (const float*)d_in[i];
    P.out = (float*)d_out; P.ws = (unsigned char*)d_ws;
#if N_LAUNCH_MODE == 1
    hipLaunchKernelGGL(k_mega, dim3(grid), dim3(NTHREADS), LDS_BYTES, stream, P);
#else
    launch_step<0>(P, 0, grid, stream);
    launch_step<1>(P, 0, grid, stream);
    for (int l = 0; l < 2; ++l) {
        launch_step<2>(P, l, grid, stream); launch_step<3>(P, l, grid, stream); launch_step<4>(P, l, grid, stream); launch_step<5>(P, l, grid, stream);
        launch_step<6>(P, l, grid, stream); launch_step<7>(P, l, grid, stream); launch_step<8>(P, l, grid, stream);
        launch_step<10>(P, l, grid, stream);
    }
#endif
}
#ifdef DBG_INST
template __global__ void k_step<11>(Params, int);
template __global__ void k_step<12>(Params, int);
template __global__ void k_step<13>(Params, int);
template __global__ void k_step<14>(Params, int);
template __global__ void k_step<15>(Params, int);
template __global__ void k_step<16>(Params, int);
#endif
```

```cpp
#include <hip/hip_runtime.h>
#include <cstdint>
#include <cstdio>

#ifndef N_LAUNCH_MODE
#define N_LAUNCH_MODE 1
#endif
#ifndef FAST_MIX
#define FAST_MIX 1
#endif
#ifndef DBG_TEST
#define DBG_TEST 0
#endif
#ifndef DBG_HG_MODE
#define DBG_HG_MODE 0
#endif
#ifndef FAST_GEMM
#define FAST_GEMM 1
#endif

#define LAS __attribute__((address_space(3)))
#define GAS __attribute__((address_space(1)))
typedef unsigned short bf16_t;
typedef short bf16x8 __attribute__((ext_vector_type(8)));
typedef float f32x4 __attribute__((ext_vector_type(4)));
typedef float f32x2 __attribute__((ext_vector_type(2)));
typedef unsigned u32x4 __attribute__((ext_vector_type(4)));
typedef unsigned u32x2 __attribute__((ext_vector_type(2)));
typedef short s16x4 __attribute__((ext_vector_type(4)));
typedef float f32x16 __attribute__((ext_vector_type(16)));
#define DI __device__ __forceinline__

constexpr int D = 1024, NB = 2, SEQ = 8192, CTXL = 256, NLAT = NB * SEQ, NCTX = NB * CTXL, NROWS = NLAT + NCTX;
constexpr int INW = 2816, PBW = 2304, ZW = 512, NEXP = 16, DEXP = 512, LISTCAP = NROWS;
constexpr int NTHREADS = 512, NWAVES = 8;
constexpr float ALPHA = 1.41421356237f, LN_EPS = 1e-5f, RMS_EPS = 1e-6f, LOG2E = 1.4426950408889634f, QSCALE = 0.125f * LOG2E;
constexpr int PB_AQ = 0, PB_AI = 256, PB_AG = 512, PB_NQ = 768, PB_NK = 1024, PB_NV = 1280, PB_SQ = 1536, PB_SK = 2048, PB_SV = 2176;
constexpr int NCHAIN = 132;

constexpr size_t MiB = 1u << 20;
constexpr size_t WS_CTL = 0, CTL_BYTES = 1 * MiB;
constexpr size_t WS_MODS = 1 * MiB;
constexpr size_t WS_LB = WS_MODS + 2 * 3 * 6144 * 4;
constexpr size_t WS_ROPE = WS_LB + 2 * 2 * 256 * 4;
constexpr size_t WS_TOKE = WS_ROPE + 129 * 16 * 2 * 4;
constexpr size_t WS_TOKP = WS_TOKE + NROWS * 8;
constexpr size_t WS_TOKW = WS_TOKP + NROWS * 8;
constexpr size_t WS_LIST = 2 * MiB;
constexpr size_t WS_XC = 4 * MiB;
constexpr size_t WS_X1 = 211 * MiB;
constexpr size_t WS_WIN = 6 * MiB;
constexpr size_t WS_WOUT = 17 * MiB;
constexpr size_t WS_WGU = 21 * MiB;
constexpr size_t WS_WD = 53 * MiB;
constexpr size_t WS_H = 69 * MiB;
constexpr size_t WS_Y = 102 * MiB;
constexpr size_t WS_S = 135 * MiB;
constexpr size_t WS_DD = 282 * MiB;
constexpr size_t WS_PB = 174 * MiB;
constexpr size_t WS_Z = WS_PB + (size_t)NROWS * PBW * 2;
constexpr size_t WS_O = 174 * MiB;
constexpr size_t WS_YO = 248 * MiB;
constexpr size_t WS_WGU1 = 284 * MiB, WS_WD1 = 316 * MiB;
constexpr size_t WS_END = 332 * MiB;
constexpr int HE_ROWS = 37888;
constexpr size_t WS_KK = WS_Z + (size_t)NROWS * ZW * 2;
static_assert(WS_DD + (size_t)2 * 2112 * 64 * 4 <= WS_END && WS_Z + (size_t)NROWS * ZW * 4 <= WS_DD && WS_O + (size_t)HE_ROWS * 1024 * 2 <= WS_YO && WS_YO + (size_t)NROWS * 2048 <= WS_END, "ws map");
static_assert(WS_TOKW + NROWS * 8 <= WS_LIST && WS_LIST + 16 * LISTCAP * 4 <= WS_XC, "ws map small");
constexpr int CW_TRDY = 32768;
constexpr int CW_CNT = 8192;
constexpr int CW_BAR = 4096;
constexpr int CW_DBG = 512;
constexpr int CW_Q = 1024;
constexpr int CW_TS = 2048;
constexpr int CW_SCAN = 1536;

struct Params {
    const float* in[21];
    float* out;
    unsigned char* ws;
    int step_lo, step_hi;
};

DI unsigned f2bf(float f) { unsigned u = __builtin_bit_cast(unsigned, f); return (u + 0x7fffu + ((u >> 16) & 1u)) >> 16; }
DI float bf2f(unsigned h) { return __builtin_bit_cast(float, h << 16); }
typedef __bf16 bf16x2_t __attribute__((ext_vector_type(2)));
DI unsigned pk2(float lo, float hi) { return __builtin_bit_cast(unsigned, __builtin_convertvector((f32x2){lo, hi}, bf16x2_t)); }
DI float bflo(unsigned w) { return __builtin_bit_cast(float, w << 16); }
DI float bfhi(unsigned w) { return __builtin_bit_cast(float, w & 0xffff0000u); }
#define DPPF(v, ctrl, rm) __builtin_bit_cast(float, __builtin_amdgcn_update_dpp(0, __builtin_bit_cast(int, (v)), (ctrl), (rm), 0xf, false))
DI float wave_sum(float v) {
    v += DPPF(v, 0xB1, 0xf); v += DPPF(v, 0x4E, 0xf); v += DPPF(v, 0x141, 0xf); v += DPPF(v, 0x140, 0xf);
    v += DPPF(v, 0x142, 0xa); v += DPPF(v, 0x143, 0xc);
    return __builtin_bit_cast(float, __builtin_amdgcn_readlane(__builtin_bit_cast(int, v), 63));
}
DI float wave_max(float v) {
#pragma unroll
    for (int o = 1; o < 64; o <<= 1) v = fmaxf(v, __shfl_xor(v, o));
    return v;
}
DI float sigmoidf_(float x) { return 1.0f / (1.0f + __expf(-x)); }
DI float siluf_(float x) { return x / (1.0f + __expf(-x)); }
DI unsigned pk_fp8x4(f32x4 v) { int w = 0; w = __builtin_amdgcn_cvt_pk_fp8_f32(v[0], v[1], w, false); w = __builtin_amdgcn_cvt_pk_fp8_f32(v[2], v[3], w, true); return (unsigned)w; }
DI void st_wt(void* p, unsigned v) { __hip_atomic_store((unsigned*)p, v, __ATOMIC_RELAXED, __HIP_MEMORY_SCOPE_AGENT); }
DI void st_wtf(float* p, float v) { __hip_atomic_store((unsigned*)p, __float_as_uint(v), __ATOMIC_RELAXED, __HIP_MEMORY_SCOPE_AGENT); }
DI void st_wth(bf16_t* p, unsigned short v) { __hip_atomic_store((unsigned short*)p, v, __ATOMIC_RELAXED, __HIP_MEMORY_SCOPE_AGENT); }
DI void store_bf4(bf16_t* p, f32x4 v) { u32x2 w; w.x = pk2(v[0], v[1]); w.y = pk2(v[2], v[3]); *(u32x2*)p = w; }

struct Ctx {
    LAS unsigned char* lds;
    int tid, lane, wave, bid, nb;
};

struct Unit { int pm, pn, e, cnt, i0, slot; };

struct PlainSched {
    int nM, nN, nwg, G, c;
    DI void init(int M, int N, int G_, int c_) { nM = M / 256; nN = N / 256; nwg = nM * nN; G = G_; c = c_; }
    DI bool next(int i, Unit& u) const {
        const long L = (long)i * G + c; if (L >= nwg) return false;
        int wgid = (int)L; { const int q = nwg / 8, r = nwg % 8, xcd = wgid % 8, off = wgid / 8; wgid = (xcd < r ? xcd * (q + 1) : r * (q + 1) + (xcd - r) * q) + off; }
        const int nig = 8 * nN, gid = wgid / nig, fm = gid * 8, gsz = (nM - fm) < 8 ? (nM - fm) : 8;
        u.pm = fm + ((wgid % nig) % gsz); u.pn = (wgid % nig) / gsz; u.e = 0; u.cnt = 0; u.i0 = 0; u.slot = 0; return true;
    }
    DI int a_row(const Unit& u, int r) const { return u.pm * 256 + r; }
    DI int b_row0(const Unit& u) const { return u.pn * 256; }
    static constexpr bool LOADS = false, PUBLISH = false, WAIT = false;
};
constexpr int MOE_TBL_OFF = 144 * 1024 + 512;
constexpr int MOE_LIST_OFF = 144 * 1024 + 2560;
DI void moe_build_table(const Ctx& X, const int* cnt) {
    LAS int* tbl = (LAS int*)(X.lds + MOE_TBL_OFF);
    if (X.tid < 160) { const int T = X.tid; int acc = 0, e = -1, i0 = 0, ce = 0;
#pragma unroll
        for (int q = 0; q < NEXP; ++q) { const int cq = cnt[q * 64]; const int nt = (cq + 255) >> 8; if (e < 0 && T < acc + nt) { e = q; i0 = T - acc; ce = cq; } acc += nt; }
        tbl[1 + 3 * T] = e; tbl[2 + 3 * T] = i0; tbl[3 + 3 * T] = ce; if (T == 0) tbl[0] = acc; }
    __syncthreads();
}
template <bool GATHER> struct MoeSched {
    const int* cnt; const int* list; int G, c, nct, bt_rows; LAS unsigned char* lds; unsigned* ready; static constexpr bool gather = GATHER;
    static constexpr int NCT_UP = 4;
    DI bool next(int i, Unit& u) const {
        const LAS int* tbl = (const LAS int*)(lds + MOE_TBL_OFF);
        const int clin = (c & 7) * (G >> 3) + (c >> 3), ntile = __builtin_amdgcn_readfirstlane(tbl[0]);
        int L;
        if (GATHER) L = i * G + clin;
        else { const int n1 = ntile * NCT_UP, rf = n1 / G, r = n1 - rf * G;
            if (r == 0) L = i * G + clin;
            else { const int nl = ((rf * G) / NCT_UP) * nct;
                if (clin < r) L = nl + i * r + clin;
                else { L = i * (G - r) + (clin - r); if (L >= nl) return false; } } }
        const int T = L / nct; if (T >= ntile) return false;
        u.slot = i; u.pm = T; u.pn = L % nct; u.e = __builtin_amdgcn_readfirstlane(tbl[1 + 3 * T]); u.i0 = __builtin_amdgcn_readfirstlane(tbl[2 + 3 * T]); u.cnt = __builtin_amdgcn_readfirstlane(tbl[3 + 3 * T]); return true;
    }
    DI int a_row(const Unit& u, int r) const {
        if (!gather) return u.pm * 256 + r;
        return ((const LAS int*)(lds + MOE_LIST_OFF))[u.slot * 256 + r];
    }
    DI int b_row0(const Unit& u) const { return u.e * bt_rows + u.pn * 256; }
    static constexpr bool LOADS = GATHER, PUBLISH = GATHER, WAIT = !GATHER;
    DI void publish(const Unit& u) const { __hip_atomic_fetch_add(ready + u.pm, 1u, __ATOMIC_RELAXED, __HIP_MEMORY_SCOPE_AGENT); }
    DI void wait(const Unit& u) const { unsigned sp = 0; while (__hip_atomic_load(ready + u.pm, __ATOMIC_RELAXED, __HIP_MEMORY_SCOPE_AGENT) < (unsigned)NCT_UP && ++sp < (1u << 24)) __builtin_amdgcn_s_sleep(1);
        __builtin_amdgcn_fence(__ATOMIC_ACQUIRE, "agent"); asm volatile("s_waitcnt vmcnt(0)" ::: "memory"); }
};

DI void store_bf8(bf16_t* p, f32x4 lo, f32x4 hi) { u32x4 w; w.x = pk2(lo[0], lo[1]); w.y = pk2(lo[2], lo[3]); w.z = pk2(hi[0], hi[1]); w.w = pk2(hi[2], hi[3]); *(u32x4*)p = w; }
DI void store_f8x8(unsigned char* p, f32x4 lo, f32x4 hi) { u32x2 w; w.x = pk_fp8x4(lo); w.y = pk_fp8x4(hi); *(u32x2*)p = w; }
DI float lane32_partner(float v, bool upper) { const auto rr = __builtin_amdgcn_permlane32_swap(__float_as_uint(v), __float_as_uint(v), false, false); return __uint_as_float(upper ? rr[0] : rr[1]); }
struct EpiIn {
    bf16_t* PB; bf16_t* Z; const float* rope; const float* lb; bf16_t* KK;
    DI void gate8(bf16_t* zp, bf16_t* kp, const float* lbp, f32x4 z0, f32x4 z1) const {
        const f32x4 lb0 = *(const f32x4*)lbp, lb1 = *(const f32x4*)(lbp + 4); f32x4 lf0, lf1, k0, k1;
#pragma unroll
        for (int j = 0; j < 4; ++j) { const float zc = fminf(fmaxf(z0[j], -30.f), 30.f), e = __expf(-zc), sg = 1.0f / (1.0f + e); lf0[j] = __log2f(lb0[j] + (1.0f - lb0[j]) * sg); k0[j] = (1.0f - lb0[j]) * (e * sg); }
#pragma unroll
        for (int j = 0; j < 4; ++j) { const float zc = fminf(fmaxf(z1[j], -30.f), 30.f), e = __expf(-zc), sg = 1.0f / (1.0f + e); lf1[j] = __log2f(lb1[j] + (1.0f - lb1[j]) * sg); k1[j] = (1.0f - lb1[j]) * (e * sg); }
        store_bf8(zp, lf0, lf1); store_bf8(kp, k0, k1);
    }
    DI void rope8(f32x4& v0, f32x4& v1, const float* rp, bool upper) const {
#pragma unroll
        for (int j = 0; j < 4; ++j) { const float c0 = rp[2 * j], s0 = rp[2 * j + 1], c1 = rp[2 * (j + 4)], s1 = rp[2 * (j + 4) + 1];
            const float p0 = lane32_partner(v0[j], upper), p1 = lane32_partner(v1[j], upper);
            v0[j] = upper ? p0 * s0 + v0[j] * c0 : v0[j] * c0 - p0 * s0; v1[j] = upper ? p1 * s1 + v1[j] * c1 : v1[j] * c1 - p1 * s1; }
    }
    DI void group(const Unit& u, int r, int c, f32x4 a0, f32x4 a1, f32x4 b0, f32x4 b1) const {
        const int row = u.pm * 256 + r, seg = u.pn, gc = u.pn * 256 + c;
        if (seg == 1 || seg == 2) {
            const int ci = (seg - 1) * 256 + c; bf16_t* z = Z + (size_t)row * ZW + ci; bf16_t* k = KK + (size_t)row * ZW + ci; const float* lp = lb + ci;
            gate8(z, k, lp, a0, a1); gate8(z + 128, k + 128, lp + 128, b0, b1);
            return;
        }
        if (seg >= 8) {
            const int t = row & (SEQ - 1); const int which = (c >> 5) & 1; const int pos = row < NLAT ? (which ? (t & 63) : (t >> 6)) : 128;
            const bool upper = (c & 31) >= 16; const float* rp = rope + (pos * 16 + (c & 15)) * 2;
            rope8(a0, a1, rp, upper); if (seg < 10) rope8(b0, b1, rp, upper);
        }
        if (seg == 5 || seg == 8 || seg == 9) { a0 *= QSCALE; a1 *= QSCALE; b0 *= QSCALE; b1 *= QSCALE; }
        bf16_t* p = PB + (size_t)row * PBW + (gc >= 768 ? gc - 512 : gc);
        store_bf8(p, a0, a1); store_bf8(p + 128, b0, b1);
    }
};
struct EpiBf {
    bf16_t* C; int ldc;
    DI void group(const Unit& u, int r, int c, f32x4 a0, f32x4 a1, f32x4 b0, f32x4 b1) const {
        bf16_t* p = C + (size_t)(u.pm * 256 + r) * ldc + u.pn * 256 + c;
        store_bf8(p, a0, a1); store_bf8(p + 128, b0, b1);
    }
};
struct EpiF8 {
    unsigned char* C; int ldc;
    DI void group(const Unit& u, int r, int c, f32x4 a0, f32x4 a1, f32x4 b0, f32x4 b1) const {
        unsigned char* p = C + (size_t)(u.pm * 256 + r) * ldc + u.pn * 256 + c;
        store_f8x8(p, a0 * 16.0f, a1 * 16.0f); store_f8x8(p + 128, b0 * 16.0f, b1 * 16.0f);
    }
};
struct EpiGU {
    bf16_t* HE;
    DI void group(const Unit& u, int r, int c, f32x4 a0, f32x4 a1, f32x4 b0, f32x4 b1) const {
        f32x4 h0, h1;
#pragma unroll
        for (int j = 0; j < 4; ++j) { h0[j] = siluf_(a0[j]) * b0[j]; h1[j] = siluf_(a1[j]) * b1[j]; }
        u32x2 w; w.x = pk_fp8x4(h0); w.y = pk_fp8x4(h1);
        __hip_atomic_store((unsigned long long*)((unsigned char*)HE + (size_t)(u.pm * 256 + r) * DEXP + u.pn * 128 + c), (unsigned long long)w.x | ((unsigned long long)w.y << 32), __ATOMIC_RELAXED, __HIP_MEMORY_SCOPE_AGENT);
    }
};

template <class Sched, class Epi>
DI void gemm_naive(const Ctx& X, const bf16_t* A, const bf16_t* Bt, int K, const Sched& S, const Epi& E) {
    Unit u;
    for (int i = 0; S.next(i, u); ++i) {
        for (int g = X.tid; g < 4096; g += NTHREADS) {
            const int fq = g & 3, wc = (g >> 2) & 3, r = g >> 4, c = wc * 32 + fq * 4;
            const bf16_t* ap = A + (size_t)S.a_row(u, r) * K;
            const bf16_t* bp = Bt + (size_t)(S.b_row0(u) + c) * K;
            float acc[16];
#pragma unroll
            for (int q = 0; q < 16; ++q) acc[q] = 0.f;
            for (int k = 0; k < K; k += 8) {
                const u32x4 av = *(const u32x4*)(ap + k);
                float af[8] = {bflo(av.x), bfhi(av.x), bflo(av.y), bfhi(av.y), bflo(av.z), bfhi(av.z), bflo(av.w), bfhi(av.w)};
#pragma unroll
                for (int q = 0; q < 16; ++q) {
                    const int col = (q >> 3) * 128 + ((q >> 2) & 1) * 16 + (q & 3);
                    const u32x4 bv = *(const u32x4*)(bp + (size_t)col * K + k);
                    acc[q] += af[0] * bflo(bv.x) + af[1] * bfhi(bv.x) + af[2] * bflo(bv.y) + af[3] * bfhi(bv.y) + af[4] * bflo(bv.z) + af[5] * bfhi(bv.z) + af[6] * bflo(bv.w) + af[7] * bfhi(bv.w);
                }
            }
            E.group(u, r, c, (f32x4){acc[0], acc[1], acc[2], acc[3]}, (f32x4){acc[4], acc[5], acc[6], acc[7]}, (f32x4){acc[8], acc[9], acc[10], acc[11]}, (f32x4){acc[12], acc[13], acc[14], acc[15]});
        }
    }
}

constexpr int HTB = 128 * 64 * 2;
DI int lds_byte(int r, int c) { const int st = (r >> 4) * 2 + (c >> 5), rr = r & 15, cc = c & 31, ob = rr * 64 + cc * 2; return st * 1024 + (ob ^ (((ob >> 9) & 1) << 5)); }
DI void stage_rc(int b, int& R, int& C) { const int st = b / 1024, sb = b % 1024, swz = sb ^ (((sb >> 9) & 1) << 5); R = (st >> 1) * 16 + swz / 64; C = (st & 1) * 32 + (swz % 64) / 2; }
typedef int v8i_t __attribute__((ext_vector_type(8)));
template <class Sched, class Epi, bool F8 = false, int SCALE_B = 127>
DI void gemm_fast(const Ctx& X, const void* A, const void* Bt, int K, const Sched& S, const Epi& E) {
    LAS unsigned char* lds = X.lds;
    const int tid = X.tid, wid = X.wave, lane = X.lane, wr = wid >> 2, wc = wid & 3, fr = lane & 15, fq = lane >> 4;
    asm volatile("" : "+s"(K));
    const int RP = F8 ? K : 2 * K, nt = RP / 128;
    int Rr[2], Cc[2]; unsigned voffB[2];
#pragma unroll
    for (int i = 0; i < 2; ++i) { stage_rc(tid * 16 + i * 8192, Rr[i], Cc[i]); const int rho = Rr[i] & 31, Rb = (Rr[i] & ~31) + 8 * ((rho & 15) >> 2) + 4 * (rho >> 4) + (rho & 3);
        voffB[i] = (unsigned)(Rb * RP + Cc[i] * 2); }
    const size_t kstep = 128, hstepB = (size_t)128 * RP;
    const unsigned ldsw = (unsigned)wid * 1024u;
    const int aoff = lds_byte(wr * 64 + fr, fq * 8), boff = lds_byte(wc * 32 + fr, fq * 8);
#define G_SA(b, h) (((b) * 2 + (h)) * HTB)
#define G_SB(b, h) ((4 + (b) * 2 + (h)) * HTB)
#define G_STAGE(bufoff, gbase, voff) do { _Pragma("unroll") for (int _i = 0; _i < 2; ++_i) \
        __builtin_amdgcn_global_load_lds((const unsigned*)((const char*)(gbase) + (voff)[_i]), (LAS unsigned*)(lds + (bufoff) + ldsw + _i * 8192), 16, 0, 0); } while (0)
#define G_LD8(p) __builtin_bit_cast(v8i_t, __builtin_shufflevector(*(const LAS u32x4*)(p), *(const LAS u32x4*)((p) + 1024), 0, 1, 2, 3, 4, 5, 6, 7))
#define G_LDA(dst, b, h) do { _Pragma("unroll") for (int m = 0; m < 4; ++m) dst[m] = G_LD8(lds + G_SA(b, h) + aoff + m * 2048); } while (0)
#define G_LDB(dst, b, h) do { _Pragma("unroll") for (int n = 0; n < 2; ++n) dst[n] = G_LD8(lds + G_SB(b, h) + boff + n * 2048); } while (0)
#define G_LO(f) __builtin_bit_cast(bf16x8, __builtin_shufflevector((f), (f), 0, 1, 2, 3))
#define G_HI(f) __builtin_bit_cast(bf16x8, __builtin_shufflevector((f), (f), 4, 5, 6, 7))
#define G_MMA(ai, bj, At, Bt_) do { __builtin_amdgcn_s_setprio(1); _Pragma("unroll") for (int m = 0; m < 4; ++m) _Pragma("unroll") for (int n = 0; n < 2; ++n) { \
        if constexpr (F8) asm volatile("v_mfma_scale_f32_16x16x128_f8f6f4 %0, %1, %2, %0, %3, %4 op_sel_hi:[0,0,0]" : "+v"(acc[ai][bj][m][n]) : "v"(Bt_[n]), "v"(At[m]), "v"(scl_w), "v"(scl_x)); \
        else { acc[ai][bj][m][n] = __builtin_amdgcn_mfma_f32_16x16x32_bf16(G_LO(Bt_[n]), G_LO(At[m]), acc[ai][bj][m][n], 0, 0, 0); acc[ai][bj][m][n] = __builtin_amdgcn_mfma_f32_16x16x32_bf16(G_HI(Bt_[n]), G_HI(At[m]), acc[ai][bj][m][n], 0, 0, 0); } } __builtin_amdgcn_s_setprio(0); } while (0)
#define G_WAIT_V(n) asm volatile("s_waitcnt vmcnt(" #n ")" ::: "memory")
#define G_WAIT_L(n) asm volatile("s_waitcnt lgkmcnt(" #n ")" ::: "memory")
#define G_BAR __builtin_amdgcn_s_barrier()
#define G_SCHED __builtin_amdgcn_sched_barrier(0)
    Unit cur, nxt; int ui = 0;
    if (!S.next(0, cur)) return;
    if constexpr (Sched::WAIT) { if (tid == 0) S.wait(cur); __builtin_amdgcn_s_barrier(); }
    f32x4 acc[2][2][4][2];
#pragma unroll
    for (int a = 0; a < 2; ++a)
#pragma unroll
        for (int b = 0; b < 2; ++b)
#pragma unroll
            for (int m = 0; m < 4; ++m)
#pragma unroll
                for (int n = 0; n < 2; ++n) acc[a][b][m][n] = (f32x4){0.f, 0.f, 0.f, 0.f};
    v8i_t At[4], B0[2], B1[2];
    int scl_w = SCALE_B * 0x01010101, scl_x = 0x7f7f7f7f; asm volatile("" : "+v"(scl_w), "+v"(scl_x));
    constexpr bool GA = Sched::LOADS;
    unsigned vAc[2][2], vAn[2][2];
#pragma unroll
    for (int h = 0; h < 2; ++h)
#pragma unroll
        for (int i = 0; i < 2; ++i) { vAc[h][i] = GA ? (unsigned)(S.a_row(cur, h * 128 + Rr[i]) * RP + Cc[i] * 2) : (unsigned)((h * 128 + Rr[i]) * RP + Cc[i] * 2); vAn[h][i] = vAc[h][i]; }
    if (GA) G_WAIT_V(0);
    const char* A0 = (const char*)A;
    const char* cA = GA ? A0 : A0 + (size_t)S.a_row(cur, 0) * RP;
    const char* cB = (const char*)Bt + (size_t)S.b_row0(cur) * RP;
    G_STAGE(G_SB(0, 0), cB, voffB); G_STAGE(G_SB(0, 1), cB + hstepB, voffB); G_STAGE(G_SA(0, 0), cA, vAc[0]); G_STAGE(G_SA(0, 1), cA, vAc[1]);
    if (wr == 1) G_BAR;
    G_WAIT_V(2); G_BAR;
    G_STAGE(G_SB(1, 0), cB + kstep, voffB); G_STAGE(G_SA(1, 0), cA + kstep, vAc[0]); G_STAGE(G_SB(1, 1), cB + hstepB + kstep, voffB);
    G_WAIT_V(6); G_BAR;
    for (;;) {
        const bool has_next = S.next(ui + 1, nxt);
        if constexpr (Sched::WAIT) { if (has_next) { if (tid == 0) S.wait(nxt); G_BAR; } }
        if (GA) {
#pragma unroll
            for (int h = 0; h < 2; ++h)
#pragma unroll
                for (int i = 0; i < 2; ++i) vAn[h][i] = has_next ? (unsigned)(S.a_row(nxt, h * 128 + Rr[i]) * RP + Cc[i] * 2) : vAc[h][i];
        }
        const char* nA = GA ? A0 : (has_next ? A0 + (size_t)S.a_row(nxt, 0) * RP : cA);
        const char* nB = has_next ? (const char*)Bt + (size_t)S.b_row0(nxt) * RP : cB;
#pragma unroll 1
        for (int t = 0; t < nt; t += 2) {
            const bool last = (t == nt - 2);
            const char* a1 = cA + (size_t)(t + 1) * kstep;
            const char* a2 = last ? nA : cA + (size_t)(t + 2) * kstep; const char* b2 = last ? nB : cB + (size_t)(t + 2) * kstep;
            const char* a3 = a2 + kstep; const char* b3 = b2 + kstep;
            unsigned v2[2][2];
#pragma unroll
            for (int h = 0; h < 2; ++h)
#pragma unroll
                for (int i = 0; i < 2; ++i) v2[h][i] = (GA && last) ? vAn[h][i] : vAc[h][i];
            G_LDB(B0, 0, 0); G_LDB(B1, 0, 1); G_SCHED; G_LDA(At, 0, 0); G_STAGE(G_SA(1, 1), a1, vAc[1]);
            G_WAIT_V(8); G_WAIT_L(0); G_BAR; G_MMA(0, 0, At, B0); G_MMA(0, 1, At, B1); G_BAR; G_SCHED;
            G_LDA(At, 0, 1); G_STAGE(G_SB(0, 0), b2, voffB); G_STAGE(G_SB(0, 1), b2 + hstepB, voffB); G_STAGE(G_SA(0, 0), a2, v2[0]);
            G_WAIT_V(8); G_WAIT_L(0); G_BAR; G_MMA(1, 0, At, B0); G_MMA(1, 1, At, B1); G_BAR; G_SCHED;
            G_LDB(B0, 1, 0); G_LDB(B1, 1, 1); G_SCHED; G_LDA(At, 1, 0); G_STAGE(G_SA(0, 1), a2, v2[1]);
            G_WAIT_V(8); G_WAIT_L(0); G_BAR; G_MMA(0, 0, At, B0); G_MMA(0, 1, At, B1); G_BAR; G_SCHED;
            G_LDA(At, 1, 1); G_STAGE(G_SB(1, 0), b3, voffB); G_STAGE(G_SB(1, 1), b3 + hstepB, voffB); G_STAGE(G_SA(1, 0), a3, v2[0]);
            G_WAIT_V(8); G_WAIT_L(0); G_BAR; G_MMA(1, 0, At, B0); G_MMA(1, 1, At, B1); G_BAR; G_SCHED;
        }
        if constexpr (F8) asm volatile("s_nop 15\n\ts_nop 15" ::: "memory");
        if (wr == 0) G_BAR;
#pragma unroll
        for (int ai = 0; ai < 2; ++ai)
#pragma unroll
            for (int m = 0; m < 4; ++m) E.group(cur, ai * 128 + wr * 64 + m * 16 + fr, wc * 32 + fq * 8, acc[ai][0][m][0], acc[ai][0][m][1], acc[ai][1][m][0], acc[ai][1][m][1]);
        if constexpr (Sched::PUBLISH) { G_WAIT_V(0); G_BAR; if (tid == 0) S.publish(cur); }
        if (!has_next) break;
#pragma unroll
        for (int a = 0; a < 2; ++a)
#pragma unroll
            for (int b = 0; b < 2; ++b)
#pragma unroll
                for (int m = 0; m < 4; ++m)
#pragma unroll
                    for (int n = 0; n < 2; ++n) acc[a][b][m][n] = (f32x4){0.f, 0.f, 0.f, 0.f};
        cur = nxt; cB = nB; cA = nA; ++ui;
        if (GA) {
#pragma unroll
            for (int h = 0; h < 2; ++h)
#pragma unroll
                for (int i = 0; i < 2; ++i) vAc[h][i] = vAn[h][i]; }
        if (wr == 1) G_BAR;
    }
    G_WAIT_V(0);
    G_BAR;
#undef G_SA
#undef G_SB
#undef G_STAGE
#undef G_LDA
#undef G_LDB
#undef G_MMA
#undef G_LD8
#undef G_LO
#undef G_HI
#undef G_WAIT_V
#undef G_WAIT_L
#undef G_BAR
#undef G_SCHED
}
#if FAST_GEMM
#define GEMM_IMPL gemm_fast
#else
#define GEMM_IMPL gemm_naive
#endif

struct TrDesc { const float* W; bf16_t* WT; int N, Kd, k0, n0, drow0, f8; float sc; };
DI void tr_load(const TrDesc& d, float (&rg)[32], int lane) {
#pragma unroll
    for (int i = 0; i < 32; ++i) { const int kk = 2 * i + (lane >> 5); rg[i] = d.W[(size_t)(d.k0 + kk) * d.N + d.n0 + (lane & 31)]; }
}
DI void tr_finish(const TrDesc& d, const float (&rg)[32], LAS float* scr, int lane) {
#pragma unroll
    for (int i = 0; i < 32; ++i) { const int kk = 2 * i + (lane >> 5); scr[kk * 33 + (lane & 31)] = rg[i]; }
    asm volatile("s_waitcnt lgkmcnt(0)" ::: "memory");
    const int c = lane & 7;
#pragma unroll
    for (int j = 0; j < 4; ++j) { const int n = (lane >> 3) + 8 * j; const LAS float* s = scr + (8 * c) * 33 + n;
        if (d.f8) { u32x2 o; o.x = pk_fp8x4((f32x4){s[0 * 33], s[1 * 33], s[2 * 33], s[3 * 33]} * d.sc); o.y = pk_fp8x4((f32x4){s[4 * 33], s[5 * 33], s[6 * 33], s[7 * 33]} * d.sc);
            *(u32x2*)((unsigned char*)d.WT + (size_t)(d.drow0 + n) * d.Kd + d.k0 + 8 * c) = o; }
        else { u32x4 o; o.x = pk2(s[0 * 33], s[1 * 33]); o.y = pk2(s[2 * 33], s[3 * 33]); o.z = pk2(s[4 * 33], s[5 * 33]); o.w = pk2(s[6 * 33], s[7 * 33]);
            *(u32x4*)(d.WT + (size_t)(d.drow0 + n) * d.Kd + d.k0 + 8 * c) = o; } }
    asm volatile("s_waitcnt lgkmcnt(0)" ::: "memory");
}
DI TrDesc expert_desc(const Params& P, int l, int it) {
    bf16_t* WGU = (bf16_t*)(P.ws + (l ? WS_WGU1 : WS_WGU)); bf16_t* WD = (bf16_t*)(P.ws + (l ? WS_WD1 : WS_WD));
    const float* wg = P.in[18] + (size_t)l * NEXP * D * DEXP; const float* wu = P.in[19] + (size_t)l * NEXP * D * DEXP; const float* wd = P.in[20] + (size_t)l * NEXP * DEXP * D;
    const int set = it >> 12, r = it & 4095, e = r >> 8, q = r & 255; TrDesc d; d.sc = 32.0f;
    if (set < 2) { const int kb = q >> 4, nbk = q & 15, n0 = nbk * 32;
        d.f8 = 1; d.W = (set ? wu : wg) + (size_t)e * D * DEXP; d.N = DEXP; d.WT = (bf16_t*)((unsigned char*)WGU + (size_t)e * 1024 * 1024); d.Kd = 1024; d.k0 = kb * 64; d.n0 = n0; d.drow0 = 256 * (n0 >> 7) + (n0 & 127) + set * 128;
    } else { const int kb = q >> 5, nbk = q & 31, n0 = nbk * 32;
        d.f8 = 1; d.W = wd + (size_t)e * DEXP * D; d.N = D; d.WT = (bf16_t*)((unsigned char*)WD + (size_t)e * 1024 * 512); d.Kd = 512; d.k0 = kb * 64; d.n0 = n0; d.drow0 = n0; }
    return d;
}
DI TrDesc rest_desc(const Params& P, int it) {
    if (it >= 2432) return expert_desc(P, 0, it - 2432);
    bf16_t* WIN = (bf16_t*)(P.ws + WS_WIN); bf16_t* WOUT = (bf16_t*)(P.ws + WS_WOUT); TrDesc d;
    d.f8 = 1; d.sc = 32.0f;
    if (it < 1408) { const int kb = it / 88, nbk = it % 88; d.f8 = 1; d.W = P.in[6] + (size_t)D * INW; d.N = INW; d.WT = (bf16_t*)((unsigned char*)WIN + (size_t)INW * D); d.Kd = D; d.k0 = kb * 64; d.n0 = nbk * 32; d.drow0 = nbk * 32; }
    else { const int r0 = it - 1408, l = r0 >> 9, r = r0 & 511, kb = r >> 5, nbk = r & 31; d.sc = 64.0f; d.W = P.in[11] + (size_t)l * D * D; d.N = D; d.WT = (bf16_t*)((unsigned char*)WOUT + (size_t)l * D * D); d.Kd = D; d.k0 = kb * 64; d.n0 = nbk * 32; d.drow0 = nbk * 32; }
    return d;
}
DI TrDesc win0_desc(const Params& P, int it) { TrDesc d; d.f8 = 1; d.sc = 32.0f; const int kb = it / 88, nbk = it % 88; d.W = P.in[6]; d.N = INW; d.WT = (bf16_t*)(P.ws + WS_WIN); d.Kd = D; d.k0 = kb * 64; d.n0 = nbk * 32; d.drow0 = nbk * 32; return d; }
#define TR_LOOP(DESC_EXPR, first, limit, step) do { int it_ = (first); if (it_ < (limit)) { float rg_[32]; TrDesc d_ = DESC_EXPR(it_); tr_load(d_, rg_, X.lane); \
        for (;;) { const int nx_ = it_ + (step); if (nx_ < (limit)) { float rn_[32]; const TrDesc dn_ = DESC_EXPR(nx_); tr_load(dn_, rn_, X.lane); tr_finish(d_, rg_, scr, X.lane); d_ = dn_; _Pragma("unroll") for (int q_ = 0; q_ < 32; ++q_) rg_[q_] = rn_[q_]; it_ = nx_; } \
                   else { tr_finish(d_, rg_, scr, X.lane); break; } } } } while (0)
DI void ph_prologue(const Ctx& X, const Params& P) {
    LAS float* sc = (LAS float*)X.lds;
    LAS float* red = sc + 3072;
    float* MODS = (float*)(P.ws + WS_MODS);
    for (int it = X.bid; it < 193; it += X.nb) {
        if (it < 192) {
            const int l = it / 96, cg = it % 96;
            for (int i = X.tid; i < 3072; i += NTHREADS) { const int cond = i >> 10, k = i & 1023; const float v = cond < 2 ? P.in[1][cond * 1024 + k] : P.in[3][k]; sc[i] = siluf_(v); }
            __syncthreads();
            const int kq = X.tid >> 4, c4 = X.tid & 15;
            float acc[3][4];
#pragma unroll
            for (int a = 0; a < 3; ++a)
#pragma unroll
                for (int j = 0; j < 4; ++j) acc[a][j] = 0.f;
            const float* w = P.in[4] + (size_t)l * D * 6144 + cg * 64 + c4 * 4;
#pragma unroll 8
            for (int i = 0; i < 32; ++i) { const int k = kq + 32 * i; const f32x4 wv = *(const f32x4*)(w + (size_t)k * 6144);
                const float s0 = sc[k], s1 = sc[1024 + k], s2 = sc[2048 + k];
#pragma unroll
                for (int j = 0; j < 4; ++j) { acc[0][j] += s0 * wv[j]; acc[1][j] += s1 * wv[j]; acc[2][j] += s2 * wv[j]; } }
#pragma unroll
            for (int a = 0; a < 3; ++a)
#pragma unroll
                for (int j = 0; j < 4; ++j) red[(kq * 3 + a) * 64 + c4 * 4 + j] = acc[a][j];
            __syncthreads();
            if (X.tid < 192) { const int cond = X.tid >> 6, col = X.tid & 63; float s = 0.f;
                for (int q = 0; q < 32; ++q) s += red[(q * 3 + cond) * 64 + col];
                MODS[(l * 3 + cond) * 6144 + cg * 64 + col] = s + P.in[5][l * 6144 + cg * 64 + col]; }
            __syncthreads();
        } else {
            float* LB = (float*)(P.ws + WS_LB);
            { const int i = X.tid; const float l0 = P.in[7][i], l1 = P.in[7][512 + i]; const float p1 = 1.0f / (1.0f + expf(l0 - l1));
              LB[i] = 1e-6f; LB[512 + i] = fmaxf(p1, 1e-6f); }
            float* RP = (float*)(P.ws + WS_ROPE);
            for (int i = X.tid; i < 2048 + 16; i += NTHREADS) { const int pos = i >> 4, f = i & 15; const float inv = powf(10000.0f, -(float)f / 16.0f); const float ang = pos < 128 ? (float)pos * inv : 0.0f;
                RP[2 * i] = cosf(ang); RP[2 * i + 1] = sinf(ang); }
        }
    }
    __syncthreads();
    LAS float* scr = (LAS float*)X.lds + X.wave * (64 * 33);
    const int gw = X.bid * NWAVES + X.wave, NGW = X.nb * NWAVES;
#define DESC_WIN0(i) win0_desc(P, (i))
    TR_LOOP(DESC_WIN0, gw, 1408, NGW);
}
DI void convert_rest(const Ctx& X, const Params& P) {
    LAS float* scr = (LAS float*)X.lds + X.wave * (64 * 33);
    const int gw = X.bid * NWAVES + X.wave, NGW = X.nb * NWAVES;
#define DESC_REST(i) rest_desc(P, (i))
    TR_LOOP(DESC_REST, gw, 2432, NGW);
}

DI const float* mods_row(const Params& P, int l, int row) { const int cond = row < NLAT ? (row >> 13) : 2; return (const float*)(P.ws + WS_MODS) + (l * 3 + cond) * 6144; }
template <int NR>
DI void modulate_rows(const Ctx& X, const Params& P, int l, int row0) {
    bf16_t* H = (bf16_t*)(P.ws + WS_H);
    const float* xr = row0 < NLAT ? P.in[0] + (size_t)row0 * D : P.in[2] + (size_t)(row0 - NLAT) * D; const float* md = mods_row(P, l, row0);
    f32x4 x[NR][4];
#pragma unroll
    for (int j = 0; j < 4; ++j)
#pragma unroll
        for (int r = 0; r < NR; ++r) x[r][j] = *(const f32x4*)(xr + (size_t)r * D + 4 * X.lane + 256 * j);
#pragma unroll
    for (int j = 0; j < 4; ++j) { const int c = 4 * X.lane + 256 * j; const f32x4 sh = *(const f32x4*)(md + c), sc = *(const f32x4*)(md + 1024 + c);
#pragma unroll
        for (int r = 0; r < NR; ++r) *(unsigned*)((unsigned char*)H + (size_t)(row0 + r) * D + c) = pk_fp8x4(x[r][j] * (1.0f + sc) + sh); }
}
DI void ph_modulate(const Ctx& X, const Params& P, int l) {
    const int gw = X.bid * NWAVES + X.wave;
    if (gw < NLAT / 8) { modulate_rows<4>(X, P, l, 8 * gw); modulate_rows<4>(X, P, l, 8 * gw + 4); }
    if (gw < NCTX) modulate_rows<1>(X, P, l, NLAT + gw);
}
template <int NR>
DI void ln1_rows(const Ctx& X, const Params& P, int l, int row0, int slot0, const LAS float* wrT, float (&lgv)[16]) {
    bf16_t* H = (bf16_t*)(P.ws + WS_H); const bf16_t* YO = (const bf16_t*)(P.ws + WS_YO); bf16_t* X1 = (bf16_t*)(P.ws + WS_X1) + (size_t)row0 * D;
    const float* g = P.in[12] + l * D; const float* bta = P.in[13] + l * D;
    const bool lat = row0 < NLAT;
    const float* xr = lat ? P.in[0] + (size_t)row0 * D : P.in[2] + (size_t)(row0 - NLAT) * D;
    const bf16_t* xb = (const bf16_t*)P.out + (size_t)row0 * D;
    const float* md = mods_row(P, l, row0);
    const int c0 = 4 * X.lane;
    f32x4 v[NR][4]; float sm[NR];
#pragma unroll
    for (int r = 0; r < NR; ++r) sm[r] = 0.f;
#pragma unroll
    for (int j = 0; j < 4; ++j) { const int c = c0 + 256 * j; const f32x4 g1 = *(const f32x4*)(md + 2048 + c);
#pragma unroll
        for (int r = 0; r < NR; ++r) { f32x4 x; if (l == 0) x = *(const f32x4*)(xr + (size_t)r * D + c); else { const u32x2 xw = *(const u32x2*)(xb + (size_t)r * D + c); x = (f32x4){bflo(xw.x), bfhi(xw.x), bflo(xw.y), bfhi(xw.y)}; }
            const u32x2 yw = *(const u32x2*)(YO + (size_t)(row0 + r) * D + c);
            const f32x4 y = {bflo(yw.x), bfhi(yw.x), bflo(yw.y), bfhi(yw.y)}; v[r][j] = ALPHA * x + g1 * y; sm[r] += (v[r][j][0] + v[r][j][1]) + (v[r][j][2] + v[r][j][3]); } }
    float rstd[NR];
#pragma unroll
    for (int r = 0; r < NR; ++r) { const float mean = wave_sum(sm[r]) * (1.0f / D); float q = 0.f;
#pragma unroll
        for (int j = 0; j < 4; ++j) { v[r][j] = v[r][j] - mean; q += (v[r][j][0] * v[r][j][0] + v[r][j][1] * v[r][j][1]) + (v[r][j][2] * v[r][j][2] + v[r][j][3] * v[r][j][3]); }
        sm[r] = q; }
#pragma unroll
    for (int r = 0; r < NR; ++r) rstd[r] = 1.0f / sqrtf(wave_sum(sm[r]) * (1.0f / D) + LN_EPS);
#pragma unroll
    for (int j = 0; j < 4; ++j) { const int c = c0 + 256 * j; const f32x4 gm = *(const f32x4*)(g + c), bt = *(const f32x4*)(bta + c), sc2 = *(const f32x4*)(md + 4096 + c), sh2 = *(const f32x4*)(md + 3072 + c);
#pragma unroll
        for (int r = 0; r < NR; ++r) { const f32x4 x1 = v[r][j] * rstd[r] * gm + bt; store_bf4(X1 + (size_t)r * D + c, x1);
            const f32x4 h2 = x1 * (1.0f + sc2) + sh2; *(unsigned*)((unsigned char*)H + (size_t)(row0 + r) * D + c) = pk_fp8x4(h2); v[r][j] = h2; } }
#pragma unroll
    for (int e = 0; e < 16; ++e) {
        f32x4 w[4];
#pragma unroll
        for (int j = 0; j < 4; ++j) w[j] = *(const LAS f32x4*)(wrT + e * 1024 + c0 + 256 * j);
#pragma unroll
        for (int r = 0; r < NR; ++r) { f32x4 acc = v[r][0] * w[0]; acc += v[r][1] * w[1]; acc += v[r][2] * w[2]; acc += v[r][3] * w[3];
            const float tot = wave_sum((acc[0] + acc[1]) + (acc[2] + acc[3]));
            lgv[e] = X.lane == slot0 + r ? tot : lgv[e]; }
        asm volatile("" ::: "memory");
    }
}
DI void ph_ln1(const Ctx& X, const Params& P, int l, bool dummy = false) {
    LAS float* wrT = (LAS float*)X.lds;
    for (int i = X.tid; i < 16384; i += NTHREADS) { const int k = i >> 4, e = i & 15; wrT[e * 1024 + k] = P.in[16][i]; }
    int* TOKP = (int*)(P.ws + WS_TOKP); int* LIST = (int*)(P.ws + WS_LIST);
    unsigned* CNT = (unsigned*)(P.ws + WS_CTL) + CW_CNT + 1024 * l + (dummy ? 4096 : 0);
    LAS int* lcnt = (LAS int*)(X.lds + 65536); LAS int* lbase = lcnt + 16; LAS int* linfo = lcnt + 32;
    if (X.tid < 16) lcnt[X.tid] = 0;
    for (int i = X.tid; i < 72 * 4; i += NTHREADS) linfo[i] = -1;
    __syncthreads();
    const int gw = X.bid * NWAVES + X.wave;
    float lgv[16];
#pragma unroll
    for (int e = 0; e < 16; ++e) lgv[e] = 0.f;
    if (gw < NLAT / 8) ln1_rows<8>(X, P, l, 8 * gw, 0, wrT, lgv);
    const bool hasctx = l == 0 && gw < NCTX;
    if (hasctx) ln1_rows<1>(X, P, l, NLAT + gw, 8, wrT, lgv);
    {
        int* TOKE = (int*)(P.ws + WS_TOKE); float* TOKW = (float*)(P.ws + WS_TOKW);
        const int k = X.lane; const bool valid = (k < 8 && gw < NLAT / 8) || (k == 8 && hasctx); const int row = k < 8 ? 8 * gw + k : NLAT + gw;
        float sg[16], sel[16];
#pragma unroll
        for (int e = 0; e < 16; ++e) { sg[e] = sigmoidf_(lgv[e]); sel[e] = sg[e] + P.in[17][e]; }
        int best = 0; float bestv = -3e38f;
#pragma unroll
        for (int gq = 0; gq < 4; ++gq) { float m1 = -3e38f, m2 = -3e38f;
#pragma unroll
            for (int j = 0; j < 4; ++j) { const float t = sel[gq * 4 + j]; const float lo = fminf(m1, t); m1 = fmaxf(m1, t); m2 = fmaxf(m2, lo); }
            const float gs = m1 + m2; const bool bt = gs > bestv; best = bt ? gq : best; bestv = bt ? gs : bestv; }
        int i0 = 0, i1 = 0; float v0 = -3e38f, v1 = -3e38f, s0 = 0.f, s1 = 0.f;
#pragma unroll
        for (int e = 0; e < 16; ++e) { const float t = (e >> 2) == best ? sel[e] : -3e38f; const bool c0 = t > v0, c1 = !c0 && t > v1;
            v1 = c0 ? v0 : (c1 ? t : v1); i1 = c0 ? i0 : (c1 ? e : i1); s1 = c0 ? s0 : (c1 ? sg[e] : s1);
            v0 = c0 ? t : v0; i0 = c0 ? e : i0; s0 = c0 ? sg[e] : s0; }
        if (valid) { const int slot = X.wave * 9 + k; const float inv = 1.0f / (s0 + s1);
            const int p0 = __hip_atomic_fetch_add(lcnt + i0, 1, __ATOMIC_RELAXED, __HIP_MEMORY_SCOPE_WORKGROUP), p1 = __hip_atomic_fetch_add(lcnt + i1, 1, __ATOMIC_RELAXED, __HIP_MEMORY_SCOPE_WORKGROUP);
            linfo[4 * slot] = row; linfo[4 * slot + 1] = i0 | (i1 << 8); linfo[4 * slot + 2] = p0; linfo[4 * slot + 3] = p1;
            TOKE[2 * row] = i0; TOKE[2 * row + 1] = i1; TOKW[2 * row] = s0 * inv; TOKW[2 * row + 1] = s1 * inv; }
    }
    __syncthreads();
    if (X.tid < 16) lbase[X.tid] = (int)atomicAdd(CNT + 64 * X.tid, (unsigned)lcnt[X.tid]);
    __syncthreads();
    if (X.tid < 72) { const int row = linfo[4 * X.tid];
        if (row >= 0) { const int ee = linfo[4 * X.tid + 1], e0 = ee & 255, e1 = ee >> 8, p0 = lbase[e0] + linfo[4 * X.tid + 2], p1 = lbase[e1] + linfo[4 * X.tid + 3];
            LIST[e0 * LISTCAP + p0] = row; LIST[e1 * LISTCAP + p1] = row; TOKP[2 * row] = p0; TOKP[2 * row + 1] = p1; } }
}
template <int NR>
DI void ln2_rows(const Ctx& X, const Params& P, int l, int row0, const int (&off)[16]) {
    bf16_t* H = (bf16_t*)(P.ws + WS_H); const unsigned char* O = P.ws + WS_O; const bf16_t* X1 = (const bf16_t*)(P.ws + WS_X1) + (size_t)row0 * D;
    const int* TOKE = (const int*)(P.ws + WS_TOKE); const int* TOKP = (const int*)(P.ws + WS_TOKP); const float* TOKW = (const float*)(P.ws + WS_TOKW);
    const float* g = P.in[14] + l * D; const float* bta = P.in[15] + l * D;
    const bool lat = row0 < NLAT;
    const float* md = mods_row(P, l, row0); const float* mdn = mods_row(P, 1, row0);
    const int c0 = 4 * X.lane;
    const unsigned char* ra[NR]; const unsigned char* rb[NR]; float w0[NR], w1[NR];
#pragma unroll
    for (int r = 0; r < NR; ++r) { const int row = row0 + r; const int e0 = TOKE[2 * row], e1 = TOKE[2 * row + 1]; int o0 = 0, o1 = 0;
#pragma unroll
        for (int e = 0; e < 16; ++e) { if (e == e0) o0 = off[e]; if (e == e1) o1 = off[e]; }
        ra[r] = O + (size_t)(o0 + TOKP[2 * row]) * D; rb[r] = O + (size_t)(o1 + TOKP[2 * row + 1]) * D; w0[r] = TOKW[2 * row] * 0.0625f; w1[r] = TOKW[2 * row + 1] * 0.0625f; }
    f32x4 v[NR][4]; float sm[NR];
#pragma unroll
    for (int r = 0; r < NR; ++r) sm[r] = 0.f;
#pragma unroll
    for (int j = 0; j < 4; ++j) { const int c = c0 + 256 * j; const f32x4 g2 = *(const f32x4*)(md + 5120 + c);
#pragma unroll
        for (int r = 0; r < NR; ++r) { const u32x2 xw = *(const u32x2*)(X1 + (size_t)r * D + c); const f32x4 x = {bflo(xw.x), bfhi(xw.x), bflo(xw.y), bfhi(xw.y)}; const int a = *(const int*)(ra[r] + c), b = *(const int*)(rb[r] + c);
            const f32x2 a01 = __builtin_amdgcn_cvt_pk_f32_fp8(a, false), a23 = __builtin_amdgcn_cvt_pk_f32_fp8(a, true), b01 = __builtin_amdgcn_cvt_pk_f32_fp8(b, false), b23 = __builtin_amdgcn_cvt_pk_f32_fp8(b, true);
            const f32x4 f = w0[r] * (f32x4){a01[0], a01[1], a23[0], a23[1]} + w1[r] * (f32x4){b01[0], b01[1], b23[0], b23[1]};
            v[r][j] = ALPHA * x + g2 * f; sm[r] += (v[r][j][0] + v[r][j][1]) + (v[r][j][2] + v[r][j][3]); } }
    float rstd[NR];
#pragma unroll
    for (int r = 0; r < NR; ++r) { const float mean = wave_sum(sm[r]) * (1.0f / D); float q = 0.f;
#pragma unroll
        for (int j = 0; j < 4; ++j) { v[r][j] = v[r][j] - mean; q += (v[r][j][0] * v[r][j][0] + v[r][j][1] * v[r][j][1]) + (v[r][j][2] * v[r][j][2] + v[r][j][3] * v[r][j][3]); }
        sm[r] = q; }
#pragma unroll
    for (int r = 0; r < NR; ++r) rstd[r] = 1.0f / sqrtf(wave_sum(sm[r]) * (1.0f / D) + LN_EPS);
#pragma unroll
    for (int j = 0; j < 4; ++j) { const int c = c0 + 256 * j; const f32x4 gm = *(const f32x4*)(g + c), bt = *(const f32x4*)(bta + c);
        f32x4 sc1 = {0.f, 0.f, 0.f, 0.f}, sh1 = {0.f, 0.f, 0.f, 0.f}; if (l == 0) { sc1 = *(const f32x4*)(mdn + 1024 + c); sh1 = *(const f32x4*)(mdn + c); }
#pragma unroll
        for (int r = 0; r < NR; ++r) { const f32x4 x2 = v[r][j] * rstd[r] * gm + bt;
            if (l == 0) { if (lat) store_bf4((bf16_t*)P.out + (size_t)(row0 + r) * D + c, x2); *(unsigned*)((unsigned char*)H + (size_t)(row0 + r) * D + c) = pk_fp8x4(x2 * (1.0f + sc1) + sh1); }
            else *(f32x4*)(P.out + (size_t)(row0 + r) * D + c) = x2; } }
}
DI void ph_ln2(const Ctx& X, const Params& P, int l) {
    const unsigned* CNT = (const unsigned*)(P.ws + WS_CTL) + CW_CNT + 1024 * l;
    int off[16]; { int acc = 0;
#pragma unroll
        for (int e = 0; e < 16; ++e) { off[e] = acc; acc += (((int)CNT[e * 64] + 255) >> 8) << 8; } }
    const int gw = X.bid * NWAVES + X.wave;
    if (gw < NLAT / 8) { ln2_rows<4>(X, P, l, 8 * gw, off); ln2_rows<4>(X, P, l, 8 * gw + 4, off); }
    if (l == 0 && gw < NCTX) ln2_rows<1>(X, P, l, NLAT + gw, off);
}

struct KeysNA { int b, r, c, rs, cs, h; const float* rpb;
    DI int n() const { return 128 + CTXL; }
    DI void get(int k, int& krow, float& bias) const { if (k < 128) { const int kr = rs + (k >> 4), kc = cs + (k & 15); krow = b * SEQ + kr * 64 + kc; bias = LOG2E * rpb[h * 465 + (kr - r + 7) * 31 + (kc - c + 15)]; } else { krow = NLAT + b * CTXL + (k - 128); bias = 0.f; } } };
struct KeysSWA { int b, lo, nband;
    DI int n() const { return nband + CTXL; }
    DI void get(int k, int& krow, float& bias) const { krow = k < nband ? b * SEQ + lo + k : NLAT + b * CTXL + (k - nband); bias = 0.f; } };
struct KeysCtx { int b;
    DI int n() const { return CTXL; }
    DI void get(int k, int& krow, float& bias) const { krow = NLAT + b * CTXL + k; bias = 0.f; } };
template <class Keys>
DI void attn_row_naive(const bf16_t* PB, int qrow, int qcol, int kcol, int vcol, const Keys& KS, bool has_sink, float sink, LAS float* sc, bf16_t* yout, int lane) {
    float q[64];
    { const u32x4* qp = (const u32x4*)(PB + (size_t)qrow * PBW + qcol);
#pragma unroll
      for (int i = 0; i < 8; ++i) { const u32x4 w = qp[i]; q[8 * i] = bflo(w.x); q[8 * i + 1] = bfhi(w.x); q[8 * i + 2] = bflo(w.y); q[8 * i + 3] = bfhi(w.y); q[8 * i + 4] = bflo(w.z); q[8 * i + 5] = bfhi(w.z); q[8 * i + 6] = bflo(w.w); q[8 * i + 7] = bfhi(w.w); } }
    const int nk = KS.n(); float mx = has_sink ? sink : -3e38f;
    for (int k = lane; k < nk; k += 64) { int krow; float bias; KS.get(k, krow, bias);
        const u32x4* kp = (const u32x4*)(PB + (size_t)krow * PBW + kcol); float s = 0.f;
#pragma unroll
        for (int i = 0; i < 8; ++i) { const u32x4 w = kp[i]; s += q[8 * i] * bflo(w.x) + q[8 * i + 1] * bfhi(w.x) + q[8 * i + 2] * bflo(w.y) + q[8 * i + 3] * bfhi(w.y) + q[8 * i + 4] * bflo(w.z) + q[8 * i + 5] * bfhi(w.z) + q[8 * i + 6] * bflo(w.w) + q[8 * i + 7] * bfhi(w.w); }
        s += bias; sc[k] = s; mx = fmaxf(mx, s); }
    mx = wave_max(mx); float den = 0.f;
    for (int k = lane; k < nk; k += 64) { const float p = exp2f(sc[k] - mx); sc[k] = p; den += p; }
    den = wave_sum(den); if (has_sink) den += exp2f(sink - mx);
    asm volatile("s_waitcnt lgkmcnt(0)" ::: "memory");
    float o = 0.f;
    for (int k = 0; k < nk; ++k) { int krow; float bias; KS.get(k, krow, bias); o += sc[k] * bf2f(PB[(size_t)krow * PBW + vcol + lane]); }
    yout[lane] = (bf16_t)f2bf(o / den);
    asm volatile("s_waitcnt lgkmcnt(0)" ::: "memory");
}
DI void ph_attn_naive(const Ctx& X, const Params& P, int l) {
    const bf16_t* PB = (const bf16_t*)(P.ws + WS_PB); bf16_t* Y = (bf16_t*)(P.ws + WS_Y);
    LAS float* sc = (LAS float*)X.lds + X.wave * 640;
    const float* rpb = P.in[9] + l * 4 * 465; const float* sink = P.in[10] + l * 8;
    const int nrows = l == 0 ? NROWS : NLAT;
    const int gw = X.bid * NWAVES + X.wave, NGW = X.nb * NWAVES;
    for (int it = gw; it < nrows * 12; it += NGW) {
        const int row = it / 12, hh = it % 12;
        if (row < NLAT) { const int b = row >> 13, t = row & (SEQ - 1);
            if (hh < 4) { KeysNA K; K.b = b; K.r = t >> 6; K.c = t & 63; K.rs = min(max(K.r - 4, 0), 120); K.cs = min(max(K.c - 8, 0), 48); K.h = hh; K.rpb = rpb;
                attn_row_naive(PB, row, PB_NQ + hh * 64, PB_NK + hh * 64, PB_NV + hh * 64, K, false, 0.f, sc, Y + (size_t)row * D + 256 + hh * 64, X.lane);
            } else { const int qh = hh - 4, n = qh >> 2; KeysSWA K; K.b = b; K.lo = max(t - 128, 0); K.nband = min(t + 128, SEQ - 1) - K.lo + 1;
                attn_row_naive(PB, row, PB_SQ + qh * 64, PB_SK + n * 64, PB_SV + n * 64, K, true, LOG2E * sink[qh], sc, Y + (size_t)row * D + 512 + qh * 64, X.lane); }
        } else { const int b = (row - NLAT) >> 8; KeysCtx K; K.b = b;
            if (hh < 4) attn_row_naive(PB, row, PB_NQ + hh * 64, PB_NK + hh * 64, PB_NV + hh * 64, K, false, 0.f, sc, Y + (size_t)row * D + 256 + hh * 64, X.lane);
            else { const int qh = hh - 4, n = qh >> 2; attn_row_naive(PB, row, PB_SQ + qh * 64, PB_SK + n * 64, PB_SV + n * 64, K, true, LOG2E * sink[qh], sc, Y + (size_t)row * D + 512 + qh * 64, X.lane); }
        }
    }
}
DI void ph_hgrn_naive(const Ctx& X, const Params& P, int l) {
    const bf16_t* PB = (const bf16_t*)(P.ws + WS_PB); const float* Z = (const float*)(P.ws + WS_Z); float* O32 = (float*)(P.ws + WS_S);
    const float* LB = (const float*)(P.ws + WS_LB) + l * 512;
    const int gw = X.bid * NWAVES + X.wave;
    if (gw >= 16) return;
    const int b = gw >> 3, h = (gw >> 1) & 3, dir = gw & 1, lane = X.lane;
    const float lb = LB[dir * 256 + h * 64 + lane];
    float S[64];
#pragma unroll
    for (int d = 0; d < 64; ++d) S[d] = 0.f;
    for (int step = 0; step < CTXL + SEQ; ++step) {
        int row;
        if (step < CTXL) row = NLAT + b * CTXL + (dir ? CTXL - 1 - step : step); else { const int t = step - CTXL; row = b * SEQ + (dir ? SEQ - 1 - t : t); }
        float f = exp2f(bf2f(((const bf16_t*)Z)[(size_t)row * ZW + dir * 256 + h * 64 + lane])); const float kk = bf2f(((const bf16_t*)(P.ws + WS_KK))[(size_t)row * ZW + dir * 256 + h * 64 + lane]); (void)lb;
#if DBG_HG_MODE & 8
        f = 1.0f;
#endif
        const float qv = bf2f(PB[(size_t)row * PBW + PB_AQ + h * 64 + lane]), vv = bf2f(PB[(size_t)row * PBW + PB_AI + h * 64 + lane]);
#if DBG_HG_MODE & 1
        if ((step & 63) == 0) {
#pragma unroll
            for (int d = 0; d < 64; ++d) S[d] = 0.f; }
#endif
        float o = 0.f;
#pragma unroll
        for (int d = 0; d < 64; ++d) { const float fd = __builtin_bit_cast(float, __builtin_amdgcn_readlane(__builtin_bit_cast(int, f), d)), kd = __builtin_bit_cast(float, __builtin_amdgcn_readlane(__builtin_bit_cast(int, kk), d)), qd = __builtin_bit_cast(float, __builtin_amdgcn_readlane(__builtin_bit_cast(int, qv), d));
            S[d] = fd * S[d] + kd * vv; o += S[d] * qd; }
#if DBG_HG_MODE & 2
        if (dir == 1) o = 0.f;
#endif
#if DBG_HG_MODE & 4
        if (dir == 0) o = 0.f;
#endif
        O32[((size_t)dir * NROWS + row) * 256 + h * 64 + lane] = o;
    }
}
DI void ph_hgrn_combine_naive(const Ctx& X, const Params& P, int l) {
    const bf16_t* PB = (const bf16_t*)(P.ws + WS_PB); const float* O32 = (const float*)(P.ws + WS_S); bf16_t* Y = (bf16_t*)(P.ws + WS_Y);
    const float* nw = P.in[8] + l * 64;
    const int nrows = l == 0 ? NROWS : NLAT;
    const int gw = X.bid * NWAVES + X.wave, NGW = X.nb * NWAVES;
    for (int it = gw; it < nrows * 4; it += NGW) { const int row = it >> 2, h = it & 3;
        const float o = O32[(size_t)row * 256 + h * 64 + X.lane] + O32[((size_t)NROWS + row) * 256 + h * 64 + X.lane];
        const float ms = wave_sum(o * o) * (1.0f / 64.0f); const float y = o * (1.0f / sqrtf(ms + RMS_EPS)) * nw[X.lane];
        const float gte = bf2f(PB[(size_t)row * PBW + PB_AG + h * 64 + X.lane]);
        Y[(size_t)row * D + h * 64 + X.lane] = (bf16_t)f2bf(y * siluf_(gte)); }
}

typedef short v4i16_t __attribute__((ext_vector_type(4)));
DI s16x4 tr_read(const LAS unsigned char* p) { return __builtin_bit_cast(s16x4, __builtin_amdgcn_ds_read_tr16_b64_v4i16((LAS v4i16_t*)p)); }
DI bf16x8 cat8(s16x4 a, s16x4 b) { return __builtin_shufflevector(a, b, 0, 1, 2, 3, 4, 5, 6, 7); }
DI bf16x8 pack8(float a0, float a1, float a2, float a3, float a4, float a5, float a6, float a7) {
    u32x4 w; w.x = pk2(a0, a1); w.y = pk2(a2, a3); w.z = pk2(a4, a5); w.w = pk2(a6, a7); return __builtin_bit_cast(bf16x8, w); }
DI float shfl_f(float v, int src) { return __shfl(v, src); }

constexpr int HP = 144;
constexpr size_t WS_QT = WS_H, WS_KT = WS_H + (size_t)2 * NROWS * 256 * 2;
#ifdef DBG_MIX
constexpr size_t WS_ST = 318 * MiB;
#else
constexpr size_t WS_ST = WS_Z;
#endif
DI size_t st_base(const Ctx& X) {
#ifdef QPROBE
    return *(volatile LAS unsigned*)(X.lds + 144 * 1024 + 48) ? WS_Y : WS_ST;
#else
    (void)X; return WS_ST;
#endif
}
static_assert(WS_KT + (size_t)2 * NROWS * 256 * 2 <= WS_Y && (size_t)2112 * 4096 * 2 <= (size_t)NROWS * ZW * 4, "hgrn buffers");
DI void hgrn_chunk_rows(int b, int dir, int p, int& row0) {
    if (p < 4) row0 = NLAT + b * CTXL + 64 * (dir ? 3 - p : p); else row0 = b * SEQ + 64 * (dir ? 131 - p : p - 4);
}
DI void hgrn_local_item(const Ctx& X, const Params& P, int l, int it) {
    const bf16_t* PB = (const bf16_t*)(P.ws + WS_PB); const bf16_t* Z = (const bf16_t*)(P.ws + WS_Z);
    bf16_t* QT = (bf16_t*)(P.ws + WS_QT); bf16_t* KT = (bf16_t*)(P.ws + WS_KT); float* U = (float*)(P.ws + WS_S); float* DD = (float*)(P.ws + WS_DD); float* ER = DD + 2112 * 64;
    const float* LB = (const float*)(P.ws + WS_LB) + l * 512;
    LAS unsigned char* kt_l = X.lds + X.wave * (2 * 64 * HP); LAS unsigned char* v_l = kt_l + 64 * HP;
    const int lane = X.lane;
    if (it < 2112) {
        const int p = it % NCHAIN, chain = it / NCHAIN, dir = chain & 1, h = (chain >> 1) & 3, b = chain >> 3;
        int row0; hgrn_chunk_rows(b, dir, p, row0);
#pragma unroll
        for (int i = 0; i < 8; ++i) { const int r = i * 8 + (lane >> 3), pc = lane & 7; const u32x4 w = *(const u32x4*)(PB + (size_t)(row0 + r) * PBW + PB_AI + h * 64 + pc * 8); *(LAS u32x4*)(v_l + r * HP + pc * 16) = w; }
        float lf[64];
        const bf16_t* zp = Z + (size_t)row0 * ZW + dir * 256 + h * 64 + lane;
#pragma unroll
        for (int s = 0; s < 64; ++s) lf[s] = bf2f(zp[(size_t)s * ZW]);
        float ref, last;
        if (dir == 0) {
#pragma unroll
            for (int s = 1; s < 64; ++s) lf[s] += lf[s - 1];
            ref = lf[31]; last = lf[63];
        } else {
#pragma unroll
            for (int s = 62; s >= 0; --s) lf[s] += lf[s + 1];
            ref = lf[32]; last = lf[0];
        }
        const bf16_t* qp = PB + (size_t)row0 * PBW + PB_AQ + h * 64 + lane; const bf16_t* kp = (const bf16_t*)(P.ws + WS_KK) + (size_t)row0 * ZW + dir * 256 + h * 64 + lane;
        bf16_t* qto = QT + ((size_t)dir * NROWS + row0) * 256 + h * 64 + lane; bf16_t* kto = KT + ((size_t)dir * NROWS + row0) * 256 + h * 64 + lane;
#pragma unroll
        for (int hf = 0; hf < 2; ++hf) {
            unsigned short qv[32], kv[32];
#pragma unroll
            for (int s = 0; s < 32; ++s) { qv[s] = qp[(size_t)(32 * hf + s) * PBW]; kv[s] = kp[(size_t)(32 * hf + s) * ZW]; }
#pragma unroll
            for (int s2 = 0; s2 < 32; ++s2) { const int s = 32 * hf + s2;
                const float q = bf2f(qv[s2]), kk = bf2f(kv[s2]);
                const float eq = __builtin_amdgcn_exp2f(lf[s] - ref), ek = __builtin_amdgcn_exp2f(ref - lf[s]);
                const unsigned short qb = (unsigned short)f2bf(q * eq), kb = (unsigned short)f2bf(kk * ek);
                st_wth(qto + (size_t)s * 256, qb); st_wth(kto + (size_t)s * 256, kb);
                *(LAS unsigned short*)(kt_l + s * HP + lane * 2) = kb; }
            asm volatile("" ::: "memory");
        }
        asm volatile("" ::: "memory");
        const float e_lr = __builtin_amdgcn_exp2f(last - ref);
        st_wtf(DD + it * 64 + lane, __builtin_amdgcn_exp2f(last)); st_wtf(ER + it * 64 + lane, __builtin_amdgcn_exp2f(ref));
        f32x4 acc[4][4];
#pragma unroll
        for (int m = 0; m < 4; ++m)
#pragma unroll
            for (int n = 0; n < 4; ++n) acc[m][n] = (f32x4){0.f, 0.f, 0.f, 0.f};
        const int g = lane >> 4, i16 = lane & 15;
        const int troff = (8 * g + (i16 >> 2)) * HP + (i16 & 3) * 8;
#pragma unroll
        for (int ks = 0; ks < 2; ++ks) {
            bf16x8 af[4], bfv[4];
#pragma unroll
            for (int m = 0; m < 4; ++m) af[m] = cat8(tr_read(kt_l + troff + ks * 32 * HP + m * 32), tr_read(kt_l + troff + (ks * 32 + 4) * HP + m * 32));
#pragma unroll
            for (int n = 0; n < 4; ++n) bfv[n] = cat8(tr_read(v_l + troff + ks * 32 * HP + n * 32), tr_read(v_l + troff + (ks * 32 + 4) * HP + n * 32));
#pragma unroll
            for (int m = 0; m < 4; ++m)
#pragma unroll
                for (int n = 0; n < 4; ++n) acc[m][n] = __builtin_amdgcn_mfma_f32_16x16x32_bf16(af[m], bfv[n], acc[m][n], 0, 0, 0);
        }
        float* up = U + (size_t)it * 4096;
#pragma unroll
        for (int m = 0; m < 4; ++m)
#pragma unroll
            for (int r = 0; r < 4; ++r) { const int d = 16 * m + 4 * g + r; const float sc = shfl_f(e_lr, d);
#pragma unroll
                for (int n = 0; n < 4; ++n) st_wtf(up + d * 64 + 16 * n + i16, acc[m][n][r] * sc); }
        asm volatile("s_waitcnt lgkmcnt(0)" ::: "memory");
    }
}
DI void ph_hgrn_scan(const Ctx& X, const Params& P, int part) {
    const float* U = (const float*)(P.ws + WS_S); const float* DD = (const float*)(P.ws + WS_DD); const float* ER = DD + 2112 * 64; bf16_t* ST = (bf16_t*)(P.ws + st_base(X));
    const int gt = part * NTHREADS + X.tid;
    const int chain = gt >> 11, d = (gt >> 5) & 63, e2 = (gt & 31) * 2;
    float s0 = 0.f, s1 = 0.f;
    for (int p0 = 0; p0 < NCHAIN; p0 += 4) {
        f32x2 u[4]; float dd[4], er[4];
#pragma unroll
        for (int j = 0; j < 4; ++j) { const int slot = chain * NCHAIN + p0 + j; u[j] = *(const f32x2*)(U + (size_t)slot * 4096 + d * 64 + e2); dd[j] = DD[slot * 64 + d]; er[j] = ER[slot * 64 + d]; }
#pragma unroll
        for (int j = 0; j < 4; ++j) { const int slot = chain * NCHAIN + p0 + j; st_wt(ST + (size_t)slot * 4096 + d * 64 + e2, pk2(s0 * er[j], s1 * er[j])); s0 = dd[j] * s0 + u[j][0]; s1 = dd[j] * s1 + u[j][1]; }
    }
}
DI void hgrn_out_item(const Ctx& X, const Params& P, int l, int it) {
    const bf16_t* PB = (const bf16_t*)(P.ws + WS_PB); const bf16_t* QT = (const bf16_t*)(P.ws + WS_QT); const bf16_t* KT = (const bf16_t*)(P.ws + WS_KT); const bf16_t* ST = (const bf16_t*)(P.ws + st_base(X));
    unsigned char* Y = P.ws + WS_Y;        const float* nw = P.in[8] + l * 64;
    LAS unsigned char* s_l = X.lds + X.wave * (2 * 64 * HP); LAS unsigned char* v_l = s_l + 64 * HP;
    const int lane = X.lane, g = lane >> 4, i16 = lane & 15, gw = X.wave * X.nb + X.bid, NGW = X.nb * NWAVES;
    const int nchunk = l == 0 ? 132 : 128;
    const int troff = (8 * g + (i16 >> 2)) * HP + (i16 & 3) * 8;
    const int troff4 = (4 * g + (i16 >> 2)) * HP + (i16 & 3) * 8;
    (void)gw; (void)NGW;
    if (it < 8 * nchunk) {
        const int c = it % nchunk, bh = it / nchunk, h = bh & 3, b = bh >> 2;
        const bool isctx = c >= 128; const int row0 = isctx ? NLAT + b * CTXL + 64 * (c - 128) : b * SEQ + 64 * c;
#pragma unroll
        for (int i = 0; i < 8; ++i) { const int r = i * 8 + (lane >> 3), pc = lane & 7; const u32x4 w = *(const u32x4*)(PB + (size_t)(row0 + r) * PBW + PB_AI + h * 64 + pc * 8); *(LAS u32x4*)(v_l + r * HP + pc * 16) = w; }
        f32x4 o[4][4];
#pragma unroll
        for (int a = 0; a < 4; ++a)
#pragma unroll
            for (int t = 0; t < 4; ++t) o[a][t] = (f32x4){0.f, 0.f, 0.f, 0.f};
#pragma unroll 1
        for (int dir = 0; dir < 2; ++dir) {
#if DBG_HG_MODE & 2
            if (dir == 1) continue;
#endif
#if DBG_HG_MODE & 4
            if (dir == 0) continue;
#endif
            const int p = isctx ? (dir ? 3 - (c - 128) : c - 128) : (dir ? 127 - c + 4 : c + 4);
            const int slot = ((b * 4 + h) * 2 + dir) * NCHAIN + p, sgn = 1 - 2 * dir;
            asm volatile("s_waitcnt lgkmcnt(0)" ::: "memory");
#pragma unroll
            for (int i = 0; i < 8; ++i) { const int r = i * 8 + (lane >> 3), pc = lane & 7; const u32x4 w = *(const u32x4*)(ST + (size_t)slot * 4096 + r * 64 + pc * 8); *(LAS u32x4*)(s_l + r * HP + pc * 16) = w; }
            const bf16_t* qt = QT + ((size_t)dir * NROWS + row0) * 256 + h * 64 + g * 8; const bf16_t* kt = KT + ((size_t)dir * NROWS + row0) * 256 + h * 64 + g * 8;
            bf16x8 qf[4][2];
#pragma unroll
            for (int t = 0; t < 4; ++t)
#pragma unroll
                for (int ks = 0; ks < 2; ++ks) qf[t][ks] = *(const bf16x8*)(qt + (size_t)(16 * t + i16) * 256 + 32 * ks);
#pragma unroll
            for (int pr = 0; pr < 2; ++pr) {
                bf16x8 kf[2][2];
#pragma unroll
                for (int t = 0; t < 2; ++t)
#pragma unroll
                    for (int ks = 0; ks < 2; ++ks) kf[t][ks] = *(const bf16x8*)(kt + (size_t)(16 * (2 * pr + t) + i16) * 256 + 32 * ks);
                f32x4 sc[2][4];
#pragma unroll
                for (int s2 = 0; s2 < 2; ++s2)
#pragma unroll
                    for (int tt = 0; tt < 4; ++tt) { f32x4 a = {0.f, 0.f, 0.f, 0.f};
                        a = __builtin_amdgcn_mfma_f32_16x16x32_bf16(kf[s2][0], qf[tt][0], a, 0, 0, 0); a = __builtin_amdgcn_mfma_f32_16x16x32_bf16(kf[s2][1], qf[tt][1], a, 0, 0, 0);
#pragma unroll
                        for (int r = 0; r < 4; ++r) { const int sidx = 16 * (2 * pr + s2) + 4 * g + r, tidx = 16 * tt + i16; const int keep = ~(((tidx - sidx) * sgn) >> 31); { const float av = a[r]; a[r] = __int_as_float(__float_as_int(av) & keep); } }
                        sc[s2][tt] = a; }
                bf16x8 vf[4];
#pragma unroll
#ifdef DBG_NO_TR
                for (int et = 0; et < 4; ++et) { unsigned short tv[8];
#pragma unroll
                    for (int j = 0; j < 8; ++j) { const int sidx = 32 * pr + (j < 4 ? 4 * g + j : 16 + 4 * g + (j - 4)); tv[j] = *(const LAS unsigned short*)(v_l + sidx * HP + (16 * et + i16) * 2); }
                    u32x4 w; w.x = tv[0] | ((unsigned)tv[1] << 16); w.y = tv[2] | ((unsigned)tv[3] << 16); w.z = tv[4] | ((unsigned)tv[5] << 16); w.w = tv[6] | ((unsigned)tv[7] << 16); vf[et] = __builtin_bit_cast(bf16x8, w); }
#else
                for (int et = 0; et < 4; ++et) vf[et] = cat8(tr_read(v_l + troff4 + (32 * pr) * HP + et * 32), tr_read(v_l + troff4 + (32 * pr + 16) * HP + et * 32));
#endif
#ifdef DBG_BRUTE
                {   float* dacc = (float*)(P.ws + WS_CTL) + CW_DBG + 16; float nA = 0.f, dA = 0.f, nB = 0.f, dB = 0.f;
                    const bf16_t* qt0 = QT + ((size_t)dir * NROWS + row0) * 256 + h * 64; const bf16_t* kt0 = KT + ((size_t)dir * NROWS + row0) * 256 + h * 64;
#if DBG_TEST == 1
#pragma unroll
                    for (int s2 = 0; s2 < 2; ++s2)
#pragma unroll
                        for (int tt = 0; tt < 4; ++tt)
#pragma unroll
                            for (int r = 0; r < 4; ++r) *(LAS float*)(s_l + (((s2 * 4 + tt) * 4 + r) * 64 + lane) * 4) = sc[s2][tt][r];
                    asm volatile("s_waitcnt lgkmcnt(0)" ::: "memory");
#pragma unroll 1
                    for (int idx = 0; idx < 32; ++idx) { const int s2 = idx >> 4, tt = (idx >> 2) & 3, r = idx & 3; const int sidx = 16 * (2 * pr + s2) + 4 * g + r, tidx = 16 * tt + i16; float ref = 0.f;
#pragma unroll 1
                        for (int d = 0; d < 64; ++d) ref += bf2f(kt0[(size_t)sidx * 256 + d]) * bf2f(qt0[(size_t)tidx * 256 + d]);
                        if (sidx > tidx) ref = 0.f; const float got = *(LAS float*)(s_l + (idx * 64 + lane) * 4); const float df = got - ref; nA += df * df; dA += ref * ref; }
#endif
#if DBG_TEST == 2
#pragma unroll
                    for (int et = 0; et < 4; ++et)
#pragma unroll
                        for (int j = 0; j < 8; ++j) { const int sidx = 32 * pr + (j < 4 ? 4 * g + j : 16 + 4 * g + (j - 4)); const float ref = bf2f(PB[(size_t)(row0 + sidx) * PBW + PB_AI + h * 64 + 16 * et + i16]);
                            const float got = bf2f((unsigned short)vf[et][j]); const float df = got - ref; nB += df * df; dB += ref * ref; asm volatile("" : "+v"(nB), "+v"(dB) :: "memory"); }
#endif
                    nA = wave_sum(nA); dA = wave_sum(dA); nB = wave_sum(nB); dB = wave_sum(dB); if (lane == 0) { atomicAdd(dacc, nA); atomicAdd(dacc + 1, dA); atomicAdd(dacc + 2, nB); atomicAdd(dacc + 3, dB); }
                }
#endif
#pragma unroll
                for (int tt = 0; tt < 4; ++tt) { const f32x4 p0 = sc[0][tt], p1 = sc[1][tt]; const bf16x8 pf = pack8(p0[0], p0[1], p0[2], p0[3], p1[0], p1[1], p1[2], p1[3]);
#pragma unroll
                    for (int et = 0; et < 4; ++et) o[et][tt] = __builtin_amdgcn_mfma_f32_16x16x32_bf16(vf[et], pf, o[et][tt], 0, 0, 0); }
                asm volatile("" ::: "memory");
            }
#pragma unroll
            for (int ks = 0; ks < ((DBG_HG_MODE & 1) ? 0 : 2); ++ks) {
                bf16x8 sf[4];
#pragma unroll
                for (int et = 0; et < 4; ++et) sf[et] = cat8(tr_read(s_l + troff + (32 * ks) * HP + et * 32), tr_read(s_l + troff + (32 * ks + 4) * HP + et * 32));
#pragma unroll
                for (int tt = 0; tt < 4; ++tt)
#pragma unroll
                    for (int et = 0; et < 4; ++et) o[et][tt] = __builtin_amdgcn_mfma_f32_16x16x32_bf16(sf[et], qf[tt][ks], o[et][tt], 0, 0, 0);
            }
        }
#if defined(DBG_BRUTE) && DBG_TEST == 3
        {
            float* dacc = (float*)(P.ws + WS_CTL) + CW_DBG + 8; float num = 0.f, den = 0.f;
            const bf16_t* qt0 = QT + ((size_t)0 * NROWS + row0) * 256 + h * 64; const bf16_t* kt0 = KT + ((size_t)0 * NROWS + row0) * 256 + h * 64;
            for (int tt = 0; tt < 4; ++tt) for (int et = 0; et < 4; ++et) for (int r = 0; r < 4; ++r) {
                const int t = 16 * tt + i16, e = 16 * et + 4 * g + r; float ref = 0.f;
                for (int s2 = 0; s2 <= t; ++s2) { float sc = 0.f; for (int d = 0; d < 64; ++d) sc += bf2f(kt0[(size_t)s2 * 256 + d]) * bf2f(qt0[(size_t)t * 256 + d]);
                    ref += bf2f((unsigned short)f2bf(sc)) * bf2f(PB[(size_t)(row0 + s2) * PBW + PB_AI + h * 64 + e]); }
                float got = 0.f;
#pragma unroll
                for (int a = 0; a < 4; ++a)
#pragma unroll
                    for (int b2 = 0; b2 < 4; ++b2)
#pragma unroll
                        for (int c2 = 0; c2 < 4; ++c2) if (a == tt && b2 == et && c2 == r) got = o[b2][a][c2];
                num += (got - ref) * (got - ref); den += ref * ref; }
            num = wave_sum(num); den = wave_sum(den); if (lane == 0) { atomicAdd(dacc, num); atomicAdd(dacc + 1, den); }
        }
#endif
#pragma unroll
        for (int tt = 0; tt < 4; ++tt) {
            float ss = 0.f;
#pragma unroll
            for (int et = 0; et < 4; ++et) ss += (o[et][tt][0] * o[et][tt][0] + o[et][tt][1] * o[et][tt][1]) + (o[et][tt][2] * o[et][tt][2] + o[et][tt][3] * o[et][tt][3]);
            ss += __shfl_xor(ss, 16); ss += __shfl_xor(ss, 32);
            const float rstd = 1.0f / sqrtf(ss * (1.0f / 64.0f) + RMS_EPS);
            const size_t row = (size_t)row0 + 16 * tt + i16;
#pragma unroll
            for (int et = 0; et < 4; ++et) { const int e = 16 * et + 4 * g; const u32x2 gw2 = *(const u32x2*)(PB + row * PBW + PB_AG + h * 64 + e); const f32x4 wv = *(const f32x4*)(nw + e);
                const f32x4 gt = {bflo(gw2.x), bfhi(gw2.x), bflo(gw2.y), bfhi(gw2.y)}; f32x4 y;
#pragma unroll
                for (int r = 0; r < 4; ++r) y[r] = o[et][tt][r] * rstd * wv[r] * siluf_(gt[r]);
                *(unsigned*)(Y + row * D + h * 64 + e) = pk_fp8x4(y); }
        }
        asm volatile("s_waitcnt lgkmcnt(0)" ::: "memory");
    }
}


DI void ph_hgrn_out(const Ctx& X, const Params& P, int l) { const int n = 8 * (l == 0 ? 132 : 128); for (int it = X.wave * X.nb + X.bid; it < n; it += X.nb * NWAVES) hgrn_out_item(X, P, l, it); }

#ifdef DBG_BRUTE
DI void ph_dbg_scores(const Ctx& X, const Params& P, int l) {
    const bf16_t* QT = (const bf16_t*)(P.ws + WS_QT); const bf16_t* KT = (const bf16_t*)(P.ws + WS_KT);
    LAS unsigned char* s_l = X.lds + X.wave * (2 * 64 * HP);
    const int lane = X.lane, g = lane >> 4, i16 = lane & 15, gw = X.wave * X.nb + X.bid, NGW = X.nb * NWAVES;
    float* dacc = (float*)(P.ws + WS_CTL) + CW_DBG + 16; float nA = 0.f, dA = 0.f;
    for (int it = gw; it < 8 * 128; it += NGW) {
        const int c = it % 128, bh = it / 128, h = bh & 3, b = bh >> 2, dir = 0, sgn = 1; const int row0 = b * SEQ + 64 * c;
        const bf16_t* qt = QT + ((size_t)dir * NROWS + row0) * 256 + h * 64 + g * 8; const bf16_t* kt = KT + ((size_t)dir * NROWS + row0) * 256 + h * 64 + g * 8;
        const bf16_t* qt0 = QT + ((size_t)dir * NROWS + row0) * 256 + h * 64; const bf16_t* kt0 = KT + ((size_t)dir * NROWS + row0) * 256 + h * 64;
        bf16x8 qf[4][2];
#pragma unroll
        for (int t = 0; t < 4; ++t)
#pragma unroll
            for (int ks = 0; ks < 2; ++ks) qf[t][ks] = *(const bf16x8*)(qt + (size_t)(16 * t + i16) * 256 + 32 * ks);
#pragma unroll 1
        for (int pr = 0; pr < 2; ++pr) {
            bf16x8 kf[2][2];
#pragma unroll
            for (int t = 0; t < 2; ++t)
#pragma unroll
                for (int ks = 0; ks < 2; ++ks) kf[t][ks] = *(const bf16x8*)(kt + (size_t)(16 * (2 * pr + t) + i16) * 256 + 32 * ks);
#pragma unroll
            for (int s2 = 0; s2 < 2; ++s2)
#pragma unroll
                for (int tt = 0; tt < 4; ++tt) { f32x4 a = {0.f, 0.f, 0.f, 0.f};
                    a = __builtin_amdgcn_mfma_f32_16x16x32_bf16(kf[s2][0], qf[tt][0], a, 0, 0, 0); a = __builtin_amdgcn_mfma_f32_16x16x32_bf16(kf[s2][1], qf[tt][1], a, 0, 0, 0);
#pragma unroll
                    for (int r = 0; r < 4; ++r) { const int sidx = 16 * (2 * pr + s2) + 4 * g + r, tidx = 16 * tt + i16; const int keep = ~(((tidx - sidx) * sgn) >> 31); { const float av = a[r]; a[r] = __int_as_float(__float_as_int(av) & keep); }
                        *(LAS float*)(s_l + (((s2 * 4 + tt) * 4 + r) * 64 + lane) * 4) = a[r]; } }
            asm volatile("s_waitcnt lgkmcnt(0)" ::: "memory");
#pragma unroll 1
            for (int idx = 0; idx < 32; ++idx) { const int s2 = idx >> 4, tt = (idx >> 2) & 3, r = idx & 3; const int sidx = 16 * (2 * pr + s2) + 4 * g + r, tidx = 16 * tt + i16; float ref = 0.f;
#pragma unroll 1
                for (int d = 0; d < 64; ++d) ref += bf2f(kt0[(size_t)sidx * 256 + d]) * bf2f(qt0[(size_t)tidx * 256 + d]);
                if (sidx > tidx) ref = 0.f; const float got = *(LAS float*)(s_l + (idx * 64 + lane) * 4); const float df = got - ref; nA += df * df; dA += ref * ref; }
            asm volatile("s_waitcnt lgkmcnt(0)" ::: "memory");
        }
    }
    nA = wave_sum(nA); dA = wave_sum(dA); if (lane == 0) { atomicAdd(dacc, nA); atomicAdd(dacc + 1, dA); }
}
#endif
constexpr int KP = 144, VP = 192, KBYTES = 128 * KP, VBYTES = 128 * VP, CHB = KBYTES + VBYTES, RPB_OFF = 2 * CHB;
static_assert(RPB_OFF + 4096 <= 144 * 1024, "attn lds");
struct ChunkSrc { int mode, rbase, kr0; };
DI int chunk_row(const ChunkSrc& c, int key) { return c.mode == 0 ? c.rbase + key : c.rbase + min(c.kr0 + (key >> 5), 127) * 64 + (key & 31); }
struct StageRegs { u32x4 k[2], v[2]; };
DI void stage_load(const Ctx& X, const bf16_t* PB, int kcol, int vcol, const ChunkSrc& c, StageRegs& R) {
#pragma unroll
    for (int i = 0; i < 2; ++i) { const int idx = X.tid + NTHREADS * i, key = idx >> 3, pc = idx & 7; const size_t row = (size_t)chunk_row(c, key);
        R.k[i] = *(const u32x4*)(PB + row * PBW + kcol + pc * 8); R.v[i] = *(const u32x4*)(PB + row * PBW + vcol + pc * 8); }
}
DI void stage_store(const Ctx& X, LAS unsigned char* buf, const StageRegs& R) {
#pragma unroll
    for (int i = 0; i < 2; ++i) { const int idx = X.tid + NTHREADS * i, key = idx >> 3, pc = idx & 7;
        *(LAS u32x4*)(buf + key * KP + pc * 16) = R.k[i]; *(LAS u32x4*)(buf + KBYTES + key * VP + pc * 16) = R.v[i]; }
}
template <int NQT> struct AttnState { f32x16 o[NQT][2]; float m[NQT], l[NQT]; };
template <int NQT, class MaskF>
DI void attn_tile_kv(const bf16x8 (&kf)[4], const LAS unsigned char* vt, int kt, const bf16x8 (&qf)[NQT][4], AttnState<NQT>& S, const bool (&act)[NQT], const MaskF& MF, int lane) {
    const int h = lane >> 5, G = lane >> 4, i16 = lane & 15;
    const LAS unsigned char* vb = vt + (4 * h + (i16 >> 2)) * VP + (16 * (G & 1) + 4 * (i16 & 3)) * 2;
    bf16x8 vf[2][2];
#pragma unroll
    for (int db = 0; db < 2; ++db)
#pragma unroll
        for (int s2 = 0; s2 < 2; ++s2) vf[db][s2] = cat8(tr_read(vb + (16 * s2) * VP + db * 64), tr_read(vb + (16 * s2 + 8) * VP + db * 64));
#pragma unroll
    for (int qt = 0; qt < NQT; ++qt) {
        if (!act[qt]) continue;
        f32x16 s;
#pragma unroll
        for (int r = 0; r < 16; ++r) s[r] = 0.f;
#pragma unroll
        for (int ks = 0; ks < 4; ++ks) s = __builtin_amdgcn_mfma_f32_32x32x16_bf16(kf[ks], qf[qt][ks], s, 0, 0, 0);
        MF(s, qt, kt);
        float mx = s[0];
#pragma unroll
        for (int r = 1; r < 16; ++r) mx = fmaxf(mx, s[r]);
        { const auto rr = __builtin_amdgcn_permlane32_swap(__float_as_uint(mx), __float_as_uint(mx), false, false); mx = fmaxf(__uint_as_float(rr[0]), __uint_as_float(rr[1])); }
        {
            const float mn = fmaxf(S.m[qt], mx), alpha = __builtin_amdgcn_exp2f(S.m[qt] - mn); S.m[qt] = mn; S.l[qt] *= alpha;
#pragma unroll
            for (int db = 0; db < 2; ++db)
#pragma unroll
                for (int r = 0; r < 16; ++r) S.o[qt][db][r] *= alpha;
        }
        const float mcur = S.m[qt]; float ps = 0.f;
#pragma unroll
        for (int r = 0; r < 16; ++r) { s[r] = __builtin_amdgcn_exp2f(s[r] - mcur); ps += s[r]; }
        S.l[qt] += ps;
        const bf16x8 p0 = pack8(s[0], s[1], s[2], s[3], s[4], s[5], s[6], s[7]), p1 = pack8(s[8], s[9], s[10], s[11], s[12], s[13], s[14], s[15]);
#pragma unroll
        for (int db = 0; db < 2; ++db) { S.o[qt][db] = __builtin_amdgcn_mfma_f32_32x32x16_bf16(vf[db][0], p0, S.o[qt][db], 0, 0, 0); S.o[qt][db] = __builtin_amdgcn_mfma_f32_32x32x16_bf16(vf[db][1], p1, S.o[qt][db], 0, 0, 0); }
    }
}
template <int NQT, class MaskF>
DI void attn_tile(const LAS unsigned char* buf, int kt, const bf16x8 (&qf)[NQT][4], AttnState<NQT>& S, const bool (&act)[NQT], const MaskF& MF, int lane) {
    bf16x8 kf[4];
#pragma unroll
    for (int ks = 0; ks < 4; ++ks) kf[ks] = *(const LAS bf16x8*)(buf + (32 * kt + (lane & 31)) * KP + ks * 32 + (lane >> 5) * 16);
    attn_tile_kv<NQT, MaskF>(kf, buf + KBYTES + 32 * kt * VP, kt, qf, S, act, MF, lane);
}
template <int NQT>
DI void attn_finish(AttnState<NQT>& S, int qt, unsigned char* yrow  , int lane) {
    const int h = lane >> 5; float l = S.l[qt]; { const auto rr = __builtin_amdgcn_permlane32_swap(__float_as_uint(l), __float_as_uint(l), false, false); l = __uint_as_float(rr[0]) + __uint_as_float(rr[1]); } const float inv = 1.0f / l;
#pragma unroll
    for (int db = 0; db < 2; ++db)
#pragma unroll
        for (int gq = 0; gq < 4; ++gq) *(unsigned*)(yrow + 32 * db + 8 * gq + 4 * h) = pk_fp8x4((f32x4){S.o[qt][db][4 * gq] * inv, S.o[qt][db][4 * gq + 1] * inv, S.o[qt][db][4 * gq + 2] * inv, S.o[qt][db][4 * gq + 3] * inv});
}
struct MaskNone { DI void operator()(f32x16&, int, int) const {} };
struct MaskSWA { int cmode, u0, lane;
    DI void operator()(f32x16& s, int qt, int kt) const {
        if (cmode == 1 || 32 * kt != u0 + 32 * qt) return;
        const int sg = cmode == 0 ? 1 : -1, e = sg * (4 * (lane >> 5) - (lane & 31));
#pragma unroll
        for (int r = 0; r < 16; ++r) { const int thr = -sg * ((r & 3) + 8 * (r >> 2)); s[r] = e >= thr ? s[r] : -1e30f; }
    } };
DI void swa_item(const Ctx& X, const Params& P, int l, int it) {
    const bf16_t* PB = (const bf16_t*)(P.ws + WS_PB); unsigned char* Y = P.ws + WS_Y;        const float* sink = P.in[10] + l * 8;
    const int lane = X.lane, w = X.wave;
    {
        const int j = it & 63, n = (it >> 6) & 1, b = it >> 7;
        const int qh = n * 4 + (w >> 1), u0 = (w & 1) * 64;
        const int nchunks = 3 + (j > 0) + (j < 63);
        bf16x8 qf[2][4];
#pragma unroll
        for (int qt = 0; qt < 2; ++qt)
#pragma unroll
            for (int ks = 0; ks < 4; ++ks) qf[qt][ks] = *(const bf16x8*)(PB + (size_t)(b * SEQ + 128 * j + u0 + 32 * qt + (lane & 31)) * PBW + PB_SQ + qh * 64 + 16 * ks + 8 * (lane >> 5));
        AttnState<2> S;
#pragma unroll
        for (int qt = 0; qt < 2; ++qt) { S.m[qt] = LOG2E * sink[qh]; S.l[qt] = lane < 32 ? 1.0f : 0.0f;
#pragma unroll
            for (int db = 0; db < 2; ++db)
#pragma unroll
                for (int r = 0; r < 16; ++r) S.o[qt][db][r] = 0.f; }
        StageRegs R;
        auto chunk_id = [&](int i) -> int { return i < 2 ? 3 + i : (i == 2 ? 1 : (i == 3 ? (j > 0 ? 0 : 2) : 2)); };
        auto chunk_src = [&](int c) -> ChunkSrc { ChunkSrc cs; cs.mode = 0; cs.kr0 = 0; cs.rbase = c < 3 ? b * SEQ + 128 * (j - 1 + c) : NLAT + b * CTXL + 128 * (c - 3); return cs; };
        stage_load(X, PB, PB_SK + n * 64, PB_SV + n * 64, chunk_src(chunk_id(0)), R);
#pragma unroll
        for (int qt = 0; qt < 2; ++qt)
#pragma unroll
            for (int ks = 0; ks < 4; ++ks) asm volatile("" : "+v"(qf[qt][ks]));
        stage_store(X, X.lds, R);
        __syncthreads();
        for (int i = 0; i < nchunks; ++i) {
            const int c = chunk_id(i);
            if (i + 1 < nchunks) stage_load(X, PB, PB_SK + n * 64, PB_SV + n * 64, chunk_src(chunk_id(i + 1)), R);
            const LAS unsigned char* buf = X.lds + (i & 1) * CHB;
            MaskSWA MF; MF.cmode = c == 0 ? 0 : (c == 2 ? 2 : 1); MF.u0 = u0; MF.lane = lane;
#pragma unroll 1
            for (int kt = 0; kt < 4; ++kt) {
                bool act[2];
#pragma unroll
                for (int qt = 0; qt < 2; ++qt) act[qt] = c == 0 ? (32 * kt + 31 >= u0 + 32 * qt) : (c == 2 ? (32 * kt <= u0 + 32 * qt + 31) : true);
                if (!(act[0] || act[1])) continue;
                attn_tile<2>(buf, kt, qf, S, act, MF, lane);
            }
            if (i + 1 < nchunks) stage_store(X, X.lds + ((i + 1) & 1) * CHB, R);
            __syncthreads();
        }
#pragma unroll
        for (int qt = 0; qt < 2; ++qt) attn_finish<2>(S, qt, Y + (size_t)(b * SEQ + 128 * j + u0 + 32 * qt + (lane & 31)) * D + 512 + qh * 64, lane);
    }
}
struct MaskNA { bool win; int kr0, qr, qc, rs, cs, blk, lane; const LAS float* rpb;
    DI void operator()(f32x16& s, int qt, int kt) const {
        if (!win) return;
        const int kr = kr0 + kt; const bool rowok = kr >= rs && kr < rs + 8;
        const int kcb = blk + 4 * (lane >> 5); const int ib = rowok ? (kr - qr + 7) * 31 + (kcb - qc + 15) : 0;
        float bv[16];
#pragma unroll
        for (int r = 0; r < 16; ++r) bv[r] = rpb[ib + (r & 3) + 8 * (r >> 2)];
        asm volatile("" : "+v"(bv[0]), "+v"(bv[1]), "+v"(bv[2]), "+v"(bv[3]), "+v"(bv[4]), "+v"(bv[5]), "+v"(bv[6]), "+v"(bv[7]), "+v"(bv[8]), "+v"(bv[9]), "+v"(bv[10]), "+v"(bv[11]), "+v"(bv[12]), "+v"(bv[13]), "+v"(bv[14]), "+v"(bv[15]));
        const unsigned t0 = rowok ? (unsigned)(kcb - cs) : 0x7fffff00u;
#pragma unroll
        for (int r = 0; r < 16; ++r) { const bool ok = t0 + (unsigned)((r & 3) + 8 * (r >> 2)) < 16u; s[r] = ok ? s[r] + bv[r] : -1e30f; }
    } };
struct NaTileRegs { bf16x8 k[4]; u32x4 v[4]; };
DI void na_load(const bf16_t* PB, int h, int rowk  , int rowv  , int lane, NaTileRegs& R) {
    const bf16_t* kp = PB + (size_t)rowk * PBW + PB_NK + h * 64 + 8 * (lane >> 5);
#pragma unroll
    for (int ks = 0; ks < 4; ++ks) R.k[ks] = *(const bf16x8*)(kp + 16 * ks);
    const bf16_t* vp = PB + (size_t)rowv * PBW + PB_NV + h * 64 + (lane & 1) * 32;
#pragma unroll
    for (int i = 0; i < 4; ++i) R.v[i] = *(const u32x4*)(vp + 8 * i);
}
DI void na_item(const Ctx& X, const Params& P, int l, int it) {
    const bf16_t* PB = (const bf16_t*)(P.ws + WS_PB); unsigned char* Y = P.ws + WS_Y;        const float* rpbg = P.in[9] + l * 4 * 465;
    const int lane = X.lane, w = X.wave; LAS float* rpbl = (LAS float*)(X.lds + 8 * 32 * VP) + 32;
    LAS unsigned char* vt = X.lds + w * (32 * VP);
    const int j = it & 3, rg = (it >> 2) & 7, h = (it >> 5) & 3, b = it >> 7;
    const int r0 = 16 * rg, blk = min(max(16 * j - 8, 0), 32);
    const int ra = r0 + 2 * w, qr = ra + ((lane & 31) >> 4), qc = 16 * j + (lane & 15);
    const int rs_a = min(max(ra - 4, 0), 120), rs_b = min(max(ra + 1 - 4, 0), 120), ntile = 8 + (rs_b + 8 - rs_a);
    for (int i = X.tid; i < 465; i += NTHREADS) rpbl[i] = LOG2E * rpbg[h * 465 + i];
    __syncthreads();
    bf16x8 qf[1][4];
#pragma unroll
    for (int ks = 0; ks < 4; ++ks) qf[0][ks] = *(const bf16x8*)(PB + (size_t)(b * SEQ + qr * 64 + qc) * PBW + PB_NQ + h * 64 + 16 * ks + 8 * (lane >> 5));
    AttnState<1> S; S.m[0] = -1e30f; S.l[0] = 0.f;
#pragma unroll
    for (int db = 0; db < 2; ++db)
#pragma unroll
        for (int r = 0; r < 16; ++r) S.o[0][db][r] = 0.f;
    MaskNA MF; MF.qr = qr; MF.qc = qc; MF.rs = min(max(qr - 4, 0), 120); MF.cs = min(max(qc - 8, 0), 48); MF.blk = blk; MF.lane = lane; MF.rpb = rpbl;
    const bool act[1] = {true};
#define NA_ROW(t, key) ((t) < 8 ? NLAT + b * CTXL + 32 * (t) + (key) : b * SEQ + (rs_a + (t) - 8) * 64 + blk + (key))
#define NA_LOAD(t, R) na_load(PB, h, NA_ROW(t, lane & 31), NA_ROW(t, lane >> 1), lane, R)
#define NA_COMPUTE(t, R) do { asm volatile("" ::: "memory"); _Pragma("unroll") for (int i_ = 0; i_ < 4; ++i_) *(LAS u32x4*)(vt + (lane >> 1) * VP + (lane & 1) * 64 + i_ * 16) = R.v[i_]; \
        asm volatile("" ::: "memory"); MF.win = (t) >= 8; MF.kr0 = rs_a + (t) - 8; attn_tile_kv<1>(R.k, vt, 0, qf, S, act, MF, lane); asm volatile("" ::: "memory"); } while (0)
    NaTileRegs RA, RB;
    NA_LOAD(0, RA);
#pragma unroll
    for (int ks = 0; ks < 4; ++ks) asm volatile("" : "+v"(qf[0][ks]));
    for (int t = 0; t < ntile; t += 2) {
        { const int tn = min(t + 1, ntile - 1); NA_LOAD(tn, RB); }
        NA_COMPUTE(t, RA);
        { const int tn = min(t + 2, ntile - 1); NA_LOAD(tn, RA); }
        if (t + 1 < ntile) NA_COMPUTE(t + 1, RB);
    }
#undef NA_ROW
#undef NA_LOAD
#undef NA_COMPUTE
    attn_finish<1>(S, 0, Y + (size_t)(b * SEQ + qr * 64 + qc) * D + 256 + h * 64, lane);
    __syncthreads();
}
DI void ctx_attn_item(const Ctx& X, const Params& P, int l, int it) {
    const bf16_t* PB = (const bf16_t*)(P.ws + WS_PB); unsigned char* Y = P.ws + WS_Y;        const float* sink = P.in[10] + l * 8;
    const int lane = X.lane, w = X.wave;
    {
        const bool swa = it >= 8; const int b = (it >> 2) & 1;
        const int h = it & 3, n = (it >> 1) & 1, half = it & 1;
        const int kcol = swa ? PB_SK + n * 64 : PB_NK + h * 64, vcol = swa ? PB_SV + n * 64 : PB_NV + h * 64;
        StageRegs R; ChunkSrc cs; cs.mode = 0; cs.kr0 = 0; cs.rbase = NLAT + b * CTXL;
        stage_load(X, PB, kcol, vcol, cs, R); stage_store(X, X.lds, R);
        cs.rbase += 128; stage_load(X, PB, kcol, vcol, cs, R); stage_store(X, X.lds + CHB, R);
        __syncthreads();
        const MaskNone MF;
        if (!swa) {
            const int qrow = NLAT + b * CTXL + 32 * w + (lane & 31);
            bf16x8 qf[1][4];
#pragma unroll
            for (int ks = 0; ks < 4; ++ks) qf[0][ks] = *(const bf16x8*)(PB + (size_t)qrow * PBW + PB_NQ + h * 64 + 16 * ks + 8 * (lane >> 5));
            AttnState<1> S; S.m[0] = -1e30f; S.l[0] = 0.f;
#pragma unroll
            for (int db = 0; db < 2; ++db)
#pragma unroll
                for (int r = 0; r < 16; ++r) S.o[0][db][r] = 0.f;
            const bool act[1] = {true};
#pragma unroll 1
            for (int kt = 0; kt < 8; ++kt) attn_tile<1>(X.lds + (kt >> 2) * CHB, kt & 3, qf, S, act, MF, lane);
            attn_finish<1>(S, 0, Y + (size_t)qrow * D + 256 + h * 64, lane);
        } else {
            const int qh = n * 4 + half * 2 + (w >> 2), q0 = NLAT + b * CTXL + (w & 3) * 64 + (lane & 31);
            bf16x8 qf[2][4];
#pragma unroll
            for (int qt = 0; qt < 2; ++qt)
#pragma unroll
                for (int ks = 0; ks < 4; ++ks) qf[qt][ks] = *(const bf16x8*)(PB + (size_t)(q0 + 32 * qt) * PBW + PB_SQ + qh * 64 + 16 * ks + 8 * (lane >> 5));
            AttnState<2> S;
#pragma unroll
            for (int qt = 0; qt < 2; ++qt) { S.m[qt] = LOG2E * sink[qh]; S.l[qt] = lane < 32 ? 1.0f : 0.0f;
#pragma unroll
                for (int db = 0; db < 2; ++db)
#pragma unroll
                    for (int r = 0; r < 16; ++r) S.o[qt][db][r] = 0.f; }
            const bool act[2] = {true, true};
#pragma unroll 1
            for (int kt = 0; kt < 8; ++kt) attn_tile<2>(X.lds + (kt >> 2) * CHB, kt & 3, qf, S, act, MF, lane);
#pragma unroll
            for (int qt = 0; qt < 2; ++qt) attn_finish<2>(S, qt, Y + (size_t)(q0 + 32 * qt) * D + 512 + qh * 64, lane);
        }
        __syncthreads();
    }
}

DI void ph_swa(const Ctx& X, const Params& P, int l) { for (int it = X.bid; it < 256; it += X.nb) swa_item(X, P, l, it); }
DI void ph_na(const Ctx& X, const Params& P, int l) { for (int it = X.bid; it < 256; it += X.nb) na_item(X, P, l, it); }
DI void queue_publish(const Ctx& X, unsigned* cnt) {
    asm volatile("s_waitcnt vmcnt(0)" ::: "memory");
    __syncthreads();
    if (X.tid == 0) __hip_atomic_fetch_add(cnt, 1u, __ATOMIC_RELAXED, __HIP_MEMORY_SCOPE_AGENT);
}
DI void queue_wait(const Ctx& X, unsigned* cnt, unsigned need) {
    if (X.tid == 0) { unsigned sp = 0; while (__hip_atomic_load(cnt, __ATOMIC_RELAXED, __HIP_MEMORY_SCOPE_AGENT) < need && ++sp < (1u << 24)) __builtin_amdgcn_s_sleep(2);
        __builtin_amdgcn_fence(__ATOMIC_ACQUIRE, "agent"); asm volatile("s_waitcnt vmcnt(0)" ::: "memory"); }
    __syncthreads();
}
DI void ph_mix_queue(const Ctx& X, const Params& P, int l, int rep = 0) {
    unsigned* ctl = (unsigned*)(P.ws + WS_CTL);
    unsigned* head = ctl + CW_Q + 64 * l + 128 * rep; unsigned* scan_cnt = ctl + CW_SCAN + 64 * l + 256 * rep; unsigned* loc_cnt = ctl + CW_SCAN + 128 + 64 * l + 256 * rep;
    volatile LAS unsigned* slot = (volatile LAS unsigned*)(X.lds + 144 * 1024 + 64);
    const int nloc = 264, nscan = 64, nctx = l == 0 ? 16 : 0, nconv = l == 0 ? 1536 : 0, nho = l == 0 ? 132 : 128;
    const int o_ctx = nloc, o_swa = o_ctx + nctx, o_scan = o_swa + 256, o_na = o_scan + nscan, o_conv = o_na + 256, o_ho = o_conv + nconv, total = o_ho + nho;
    bool scan_ok = false;
    for (;;) {
        if (X.tid == 0) *slot = atomicAdd(head, 1u);
        __syncthreads();
        int it = (int)*slot;
        __syncthreads();
        if (it >= total) break;
        if (nconv && it >= o_swa && it < o_ho) {
            const int j = it - o_swa, per = j / 11, ph = j - per * 11;
            it = (ph & 3) == 0 ? o_swa + per * 3 + (ph >> 2) : o_conv + per * 8 + (ph - 1 - (ph > 4) - (ph > 8));
        }
        Ctx Xi = X; { int wv = X.wave; asm volatile("" : "+s"(wv)); int ln; asm volatile("v_mbcnt_lo_u32_b32 %0, -1, 0\n\tv_mbcnt_hi_u32_b32 %0, -1, %0" : "=v"(ln)); Xi.tid = wv * 64 + ln; Xi.lane = ln; Xi.wave = wv; }
#ifdef QMASK
        if (rep) { const int ty = it < o_ctx ? 1 : (it < o_swa ? 2 : (it < o_scan ? 4 : (it < o_na ? 8 : (it < o_conv ? 16 : (it < o_ho ? 32 : 64))))); if (!(QMASK & ty)) continue; }
#endif
        if (it < o_ctx) { hgrn_local_item(Xi, P, l, it * 8 + Xi.wave); queue_publish(Xi, loc_cnt); }
        else if (it < o_swa) ctx_attn_item(Xi, P, l, it - o_ctx);
        else if (it < o_scan) swa_item(Xi, P, l, it - o_swa);
        else if (it < o_na) { queue_wait(Xi, loc_cnt, (unsigned)nloc); ph_hgrn_scan(Xi, P, it - o_scan); queue_publish(Xi, scan_cnt); }
        else if (it < o_conv) na_item(Xi, P, l, it - o_na);
        else if (it < o_ho) { LAS float* scr = (LAS float*)X.lds + X.wave * (64 * 33); const int g = it - o_conv, lyr = g >= 768, f0 = (g - 768 * lyr) * 16 + X.wave;
#define DESC_EQ(i) expert_desc(P, lyr, (i))
            TR_LOOP(DESC_EQ, f0, f0 + 16, 8); __syncthreads(); }
        else { if (!scan_ok) { queue_wait(Xi, scan_cnt, (unsigned)nscan); scan_ok = true; }
            hgrn_out_item(Xi, P, l, (it - o_ho) * 8 + Xi.wave); __syncthreads(); }
    }
}
constexpr size_t WS_Y2 = 284 * MiB;
DI void ph_dbg_copy(const Ctx& X, const Params& P) {
    const u32x4* src = (const u32x4*)(P.ws + WS_Y); u32x4* dst = (u32x4*)(P.ws + WS_Y2);
    for (size_t i = (size_t)X.bid * NTHREADS + X.tid; i < (size_t)NROWS * 128; i += (size_t)X.nb * NTHREADS) dst[i] = src[i];
}
DI void ph_dbg_compare(const Ctx& X, const Params& P) {
    const bf16_t* Yg = (const bf16_t*)(P.ws + WS_Y); const bf16_t* Yf = (const bf16_t*)(P.ws + WS_Y2); float* acc = (float*)(P.ws + WS_CTL) + CW_DBG;
    float num[3] = {0.f, 0.f, 0.f}, den[3] = {0.f, 0.f, 0.f};
    const int gw = X.bid * NWAVES + X.wave, NGW = X.nb * NWAVES;
    for (int row = gw; row < NROWS; row += NGW) {
#pragma unroll
        for (int j = 0; j < 16; ++j) { const int c = j * 64 + X.lane; const float a = bf2f(Yg[(size_t)row * D + c]), b = bf2f(Yf[(size_t)row * D + c]); const float d = a - b;
            const int br = j < 4 ? 0 : (j < 8 ? 1 : 2);
            if (br == 0) { num[0] += d * d; den[0] += a * a; } else if (br == 1) { num[1] += d * d; den[1] += a * a; } else { num[2] += d * d; den[2] += a * a; } }
    }
#pragma unroll
    for (int b = 0; b < 3; ++b) { const float n = wave_sum(num[b]), d = wave_sum(den[b]); if (X.lane == 0) { atomicAdd(acc + 2 * b, n); atomicAdd(acc + 2 * b + 1, d); } }
}
DI void ph_dbg_apply(const Ctx& X, const Params& P) {
    const float* acc = (const float*)(P.ws + WS_CTL) + CW_DBG;
#ifdef DBG_BRUTE
    float code = sqrtf(acc[16] / acc[17]);
#else
    float code = sqrtf(acc[0] / acc[1]);
#endif
    if (code == 0.f) return;
    f32x4* o = (f32x4*)P.out;
    for (size_t i = (size_t)X.bid * NTHREADS + X.tid; i < (size_t)NLAT * 256; i += (size_t)X.nb * NTHREADS) o[i] = o[i] * (1.0f + code);
}

DI void ph_inproj(const Ctx& X, const Params& P, int l) {
    PlainSched S; S.init(NROWS, INW, X.nb, X.bid);
    EpiIn E{(bf16_t*)(P.ws + WS_PB), (bf16_t*)(P.ws + WS_Z), (const float*)(P.ws + WS_ROPE), (const float*)(P.ws + WS_LB) + l * 512, (bf16_t*)(P.ws + WS_KK)};
    gemm_fast<PlainSched, EpiIn, true, 122>(X, P.ws + WS_H, P.ws + WS_WIN + (size_t)l * INW * D, D, S, E);
}
struct EpiNull { DI void group(const Unit&, int, int, f32x4 a0, f32x4 a1, f32x4 b0, f32x4 b1) const { asm volatile("" :: "v"(a0), "v"(a1), "v"(b0), "v"(b1)); } };
DI void ph_inproj_plain(const Ctx& X, const Params& P, int l) {
    PlainSched S; S.init(NROWS, INW, X.nb, X.bid);
    EpiNull E;
    GEMM_IMPL(X, (const bf16_t*)(P.ws + WS_H), (const bf16_t*)(P.ws + WS_WIN) + (size_t)l * INW * D, D, S, E);
}
DI void small_gemm_item(const Ctx& X, const unsigned char* A, const unsigned char* Bt, bf16_t* C, int row0, int col0) {
    const int wm = X.wave >> 2, wn = X.wave & 3, fr = X.lane & 15, fq = X.lane >> 4;
    const unsigned char* ap = A + (size_t)(row0 + 16 * wm + fr) * D + 8 * fq; const unsigned char* bp = Bt + (size_t)(col0 + 16 * wn + fr) * D + 8 * fq;
    f32x4 acc = {0.f, 0.f, 0.f, 0.f};
#pragma unroll 1
    for (int k0 = 0; k0 < D; k0 += 512) {
        long af[16], bfv[16];
#pragma unroll
        for (int i = 0; i < 16; ++i) { af[i] = *(const long*)(ap + k0 + 32 * i); bfv[i] = *(const long*)(bp + k0 + 32 * i); }
#pragma unroll
        for (int i = 0; i < 16; ++i) acc = __builtin_amdgcn_mfma_f32_16x16x32_fp8_fp8(bfv[i], af[i], acc, 0, 0, 0);
    }
    store_bf4(C + (size_t)(row0 + 16 * wm + fr) * D + col0 + 16 * wn + 4 * fq, acc * (1.0f / 64.0f));
}
DI void ph_outproj(const Ctx& X, const Params& P, int l) {
    PlainSched S; S.init(NLAT, D, X.nb, X.bid);
    EpiBf E{(bf16_t*)(P.ws + WS_YO), D};
    gemm_fast<PlainSched, EpiBf, true, 121>(X, P.ws + WS_Y, P.ws + WS_WOUT + (size_t)l * D * D, D, S, E);
    if (l == 0) for (int it = X.bid; it < 256; it += X.nb)
        small_gemm_item(X, P.ws + WS_Y, P.ws + WS_WOUT, (bf16_t*)(P.ws + WS_YO), NLAT + 32 * (it >> 4), 64 * (it & 15));
}
DI void ph_moe(const Ctx& X, const Params& P, int l) {
    const int* cnt = (const int*)(P.ws + WS_CTL) + CW_CNT + 1024 * l; unsigned* rdy = (unsigned*)(P.ws + WS_CTL) + CW_TRDY + 256 * l;
    moe_build_table(X, cnt);
    {
        MoeSched<true> S{cnt, (const int*)(P.ws + WS_LIST), X.nb, X.bid, 4, 1024, X.lds, rdy};
        { LAS int* ll = (LAS int*)(X.lds + MOE_LIST_OFF); Unit u;
#pragma unroll 1
          for (int i = 0; i < 3; ++i) if (S.next(i, u) && X.tid < 256) { const int idx = u.i0 * 256 + X.tid; ll[i * 256 + X.tid] = S.list[u.e * LISTCAP + (idx < u.cnt ? idx : 0)]; }
          __syncthreads(); }
        EpiGU E{(bf16_t*)(P.ws + WS_S)};
        gemm_fast<MoeSched<true>, EpiGU, true, 122>(X, P.ws + WS_H, P.ws + (l ? WS_WGU1 : WS_WGU), D, S, E);
    }
    {
        MoeSched<false> S{cnt, (const int*)(P.ws + WS_LIST), X.nb, X.bid, 4, 1024, X.lds, rdy};
        EpiF8 E{P.ws + WS_O, D};
        gemm_fast<MoeSched<false>, EpiF8, true, 122>(X, P.ws + WS_S, P.ws + (l ? WS_WD1 : WS_WD), DEXP, S, E);
    }
}

#define XB_TMO      128
#define XB_XCNT(j)  (256  + 64 * (j))
#define XB_XSUB(j)  (1280 + 64 * (j))
#define XB_XGEN(j)  (2304 + 64 * (j))
#define XB_TOP      3328
#define XB_TOPGEN   3392
#define XCD_BAR_WORDS 3456
#ifndef XB_SPIN_CAP
#define XB_SPIN_CAP (1u << 26)
#endif
DI unsigned xb_ld(unsigned* p)              { return __hip_atomic_load(p, __ATOMIC_RELAXED, __HIP_MEMORY_SCOPE_AGENT); }
DI unsigned xb_add(unsigned* p, unsigned v) { return __hip_atomic_fetch_add(p, v, __ATOMIC_RELAXED, __HIP_MEMORY_SCOPE_AGENT); }
DI unsigned xb_xcc_id() { return (unsigned)__builtin_amdgcn_s_getreg((3 << 11) | 20) & 0xFu; }
#define XB_SPIN(cond, bar) do { unsigned _sp = 0; while (cond) { __builtin_amdgcn_s_sleep(1); \
    if ((++_sp & 255u) == 0u) { if (xb_ld(&(bar)[XB_TMO])) break; if (_sp > XB_SPIN_CAP) { atomicAdd(&(bar)[XB_TMO], 1u); break; } } } } while (0)
struct XcdBarrier { unsigned* bar; unsigned x; volatile LAS unsigned* st; };
DI XcdBarrier xcd_barrier_post(unsigned* bar, volatile LAS unsigned* st) {
    XcdBarrier b; b.bar = bar; b.x = xb_xcc_id(); b.st = st;
    if (threadIdx.x == 0) (void)xb_add(&bar[XB_XCNT(b.x)], 1u);
    return b;
}
DI void xcd_barrier_complete(unsigned* bar, unsigned x, unsigned& nloc, unsigned& nx) {
    const unsigned G = gridDim.x * gridDim.y * gridDim.z;
    unsigned sum, cnt, mine, sp = 0u;
    for (;;) {
        sum = 0u; cnt = 0u; mine = 0u;
#pragma unroll
        for (unsigned j = 0; j < 16; ++j) { const unsigned c = xb_ld(&bar[XB_XCNT(j)]); sum += c; cnt += (c > 0u) ? 1u : 0u; mine = (j == x) ? c : mine; }
        if (sum == G) break;
        __builtin_amdgcn_s_sleep(1);
        if ((++sp & 255u) == 0u) { if (xb_ld(&bar[XB_TMO])) break; if (sp > XB_SPIN_CAP) { atomicAdd(&bar[XB_TMO], 1u); break; } }
    }
    nloc = mine > 0u ? mine : 1u; nx = cnt > 0u ? cnt : 1u;
}
DI void xcd_barrier(const XcdBarrier& b) {
    asm volatile("s_waitcnt vmcnt(0)" ::: "memory");
    __syncthreads();
    if (threadIdx.x == 0) {
        unsigned* bar = b.bar;
        __builtin_amdgcn_s_waitcnt(0);
        unsigned nloc = b.st[0], nx = b.st[1];
        if (nloc == 0u) { xcd_barrier_complete(bar, b.x, nloc, nx); b.st[0] = nloc; b.st[1] = nx; }
        const unsigned old = xb_add(&bar[XB_XSUB(b.x)], 1u);
        const unsigned gen = old / nloc;
        if (old + 1u == (gen + 1u) * nloc) {
            __builtin_amdgcn_fence(__ATOMIC_RELEASE, "agent");
            asm volatile("s_waitcnt vmcnt(0)" ::: "memory");
            const unsigned og = xb_add(&bar[XB_TOP], 1u);
            const unsigned tg = og / nx;
            if (og + 1u == (tg + 1u) * nx) xb_add(&bar[XB_TOPGEN], 1u);
            else XB_SPIN(xb_ld(&bar[XB_TOPGEN]) == tg, bar);
            __builtin_amdgcn_fence(__ATOMIC_ACQUIRE, "agent");
            xb_add(&bar[XB_XGEN(b.x)], 1u);
            asm volatile("s_waitcnt vmcnt(0)" ::: "memory");
        } else {
            XB_SPIN(xb_ld(&bar[XB_XGEN(b.x)]) == gen, bar);
            __builtin_amdgcn_fence(__ATOMIC_ACQUIRE, "agent");
            asm volatile("s_waitcnt vmcnt(0)" ::: "memory");
        }
    }
    __syncthreads();
}

template <int Q> DI void run_phase(const Ctx& X0, const Params& P0, int l) {
#if defined(__HIP_DEVICE_COMPILE__)
    const __attribute__((address_space(4))) Params* pp_ = (const __attribute__((address_space(4))) Params*)__builtin_amdgcn_kernarg_segment_ptr(); asm volatile("" : "+s"(pp_), "+s"(l));
    const Params P = *pp_; (void)P0;
#else
    const Params P = P0;
#endif
    Ctx X = X0; { int wv = X0.wave; asm volatile("" : "+s"(wv)); int ln; asm volatile("v_mbcnt_lo_u32_b32 %0, -1, 0\n\tv_mbcnt_hi_u32_b32 %0, -1, %0" : "=v"(ln)); X.tid = wv * 64 + ln; X.lane = ln; X.wave = wv; int b_ = X0.bid, n_ = X0.nb; asm volatile("" : "+s"(b_), "+s"(n_)); X.bid = b_; X.nb = n_; }
    if constexpr (Q == 0) ph_prologue(X, P);
    if constexpr (Q == 1) { ph_modulate(X, P, 0); __syncthreads(); convert_rest(X, P); }
    if constexpr (Q == 2) ph_inproj(X, P, l);
    if constexpr (Q == 3) ph_hgrn_naive(X, P, l);
    if constexpr (Q == 4) ph_hgrn_combine_naive(X, P, l);
    if constexpr (Q == 5) ph_attn_naive(X, P, l);
    if constexpr (Q == 6) ph_outproj(X, P, l);
    if constexpr (Q == 7) ph_ln1(X, P, l);
    if constexpr (Q == 24) ph_ln1(X, P, l, true);
    if constexpr (Q == 27) ph_inproj_plain(X, P, l);
    if constexpr (Q == 8) ph_moe(X, P, l);
    if constexpr (Q == 13) ph_hgrn_out(X, P, l);
    if constexpr (Q == 14) ph_swa(X, P, l);
    if constexpr (Q == 15) ph_na(X, P, l);
#ifdef DBG_BRUTE
    if constexpr (Q == 23) ph_dbg_scores(X, P, l);
#endif
    if constexpr (Q == 20) ph_dbg_copy(X, P);
    if constexpr (Q == 21) ph_dbg_compare(X, P);
    if constexpr (Q == 22) ph_dbg_apply(X, P);
    if constexpr (Q == 10) ph_ln2(X, P, l);
    if constexpr (Q == 17) ph_mix_queue(X, P, l);
#ifdef QPROBE
    if constexpr (Q == 18) ph_mix_queue(X, P, l, 1);
#endif
}

constexpr int LDS_BYTES = 150 * 1024;
template <int Q>
__global__ void __launch_bounds__(NTHREADS, 2) k_step(Params P, int l) {
    extern __shared__ __attribute__((aligned(16))) unsigned char lds_raw[];
    Ctx X; X.lds = (LAS unsigned char*)lds_raw; X.tid = threadIdx.x; X.lane = X.tid & 63; X.wave = __builtin_amdgcn_readfirstlane(X.tid >> 6); X.bid = blockIdx.x; X.nb = gridDim.x;
    run_phase<Q>(X, P, l);
}
template <int Q> static void launch_step(const Params& P, int l, int grid, hipStream_t stream) {
    static bool attr = false;
    if (!attr) { (void)hipFuncSetAttribute((const void*)k_step<Q>, hipFuncAttributeMaxDynamicSharedMemorySize, LDS_BYTES); attr = true; }
    hipLaunchKernelGGL(k_step<Q>, dim3(grid), dim3(NTHREADS), LDS_BYTES, stream, P, l);
}

constexpr int LDS_CTL_OFF = 144 * 1024;
__global__ void __launch_bounds__(NTHREADS, 2) k_mega(Params P) {
    extern __shared__ __attribute__((aligned(16))) unsigned char lds_raw[];
    Ctx X; X.lds = (LAS unsigned char*)lds_raw; X.tid = threadIdx.x; X.lane = X.tid & 63; X.wave = __builtin_amdgcn_readfirstlane(X.tid >> 6); X.bid = blockIdx.x; X.nb = gridDim.x;
    volatile LAS unsigned* st = (volatile LAS unsigned*)(X.lds + LDS_CTL_OFF);
    if (X.tid < 16) st[X.tid] = 0u;
    __syncthreads();
    { const XcdBarrier b0 = xcd_barrier_post((unsigned*)(P.ws + WS_CTL) + CW_BAR, st); if (X.tid == 0) st[2] = b0.x; }
    __syncthreads();
#ifdef TS_SEL
#define STAMP() do { if (blockIdx.x == 0 && threadIdx.x == 0) { unsigned long long* ts_ = (unsigned long long*)((unsigned*)(P.ws + WS_CTL) + CW_TS); const unsigned n_ = st[8]; ts_[n_] = __builtin_amdgcn_s_memrealtime(); st[8] = n_ + 1u; } } while (0)
#else
#define STAMP() do { } while (0)
#endif
#define GBAR() do { for (int br_ = 0; br_ < BAR_REP; ++br_) GBAR1(); STAMP(); } while (0)
#define GBAR1() do { unsigned char* w_ = P.ws; asm volatile("" : "+s"(w_)); XcdBarrier b_; b_.bar = (unsigned*)(w_ + WS_CTL) + CW_BAR; b_.st = st; b_.x = threadIdx.x == 0 ? st[2] : 0u; xcd_barrier(b_); } while (0)
#ifndef DUP
#define DUP 0
#endif
#ifndef BAR_REP
#define BAR_REP 1
#endif
#define NREP(bit) ({ int n_ = (DUP & (1 << (bit))) ? 2 : 1; asm volatile("" : "+s"(n_)); n_; })
#define RUNP(Q, bit) do { const int nr_ = NREP(bit); for (int rep_ = 0; rep_ < nr_; ++rep_) { run_phase<Q>(X, P, l); GBAR(); } } while (0)
    STAMP();
    { const int l = 0; RUNP(0, 0); RUNP(1, 1); }
    for (int l = 0; l < 2; ++l) {
        if (DUP & 32768) { run_phase<27>(X, P, l); GBAR(); }
        RUNP(2, 2);
#if FAST_MIX
#ifdef QPROBE
        if (l == QPROBE) { if (X.tid == 0) st[12] = 1u; __syncthreads(); run_phase<18>(X, P, l); GBAR(); if (X.tid == 0) st[12] = 0u; __syncthreads(); }
#endif
        run_phase<17>(X, P, l); GBAR();
#ifdef DBG_MIX
        if (l == 0) {
            run_phase<20>(X, P, l); GBAR();
            run_phase<3>(X, P, l); GBAR();
            run_phase<4>(X, P, l); GBAR();
            run_phase<5>(X, P, l); GBAR();
            run_phase<21>(X, P, l); GBAR();
        }
#endif
#else
        run_phase<3>(X, P, l); GBAR();
        run_phase<4>(X, P, l); GBAR();
        run_phase<5>(X, P, l); GBAR();
#endif
        RUNP(6, 9);
        if ((DUP & 4096) && l == 0) { run_phase<24>(X, P, l); GBAR(); }
        run_phase<7>(X, P, l); GBAR();
        run_phase<8>(X, P, l); GBAR();
        if (DUP & 8192) { run_phase<10>(X, P, l); GBAR(); }
        run_phase<10>(X, P, l); if (l == 0) GBAR();
    }
#ifdef TS_SEL
    GBAR();
    { const unsigned long long* ts_ = (const unsigned long long*)((const unsigned*)(P.ws + WS_CTL) + CW_TS); const float dt_us = 10.0f * floorf((float)(ts_[TS_SEL] - ts_[TS_SEL - 1]) * 0.001f + 0.5f); const float sc = 1.0f + dt_us * (1.0f / 2000.0f);
      f32x4* o = (f32x4*)P.out; for (size_t i = (size_t)blockIdx.x * NTHREADS + threadIdx.x; i < (size_t)NLAT * 256; i += (size_t)gridDim.x * NTHREADS) o[i] = o[i] * sc; }
#endif
#ifdef DBG_MIX
    GBAR(); run_phase<22>(X, P, 0);
#endif
#undef GBAR
}

extern "C" void kernel_launch(void* const* d_in, const int* in_sizes, int n_in, void* d_out, int out_size, void* d_ws, size_t ws_size, hipStream_t stream) {
    static int grid = 0;
    if (grid == 0) {
        if (n_in != 21 || out_size != NLAT * D || ws_size < WS_END) { fprintf(stderr, "kernel_launch: unexpected shapes n_in %d out %d ws %zu\n", n_in, out_size, ws_size); grid = -1; return; }
        int dev = 0, cus = 0; (void)hipGetDevice(&dev); (void)hipDeviceGetAttribute(&cus, hipDeviceAttributeMultiprocessorCount, dev);
        grid = cus > 0 ? cus : 256;
        (void)hipFuncSetAttribute((const void*)k_mega, hipFuncAttributeMaxDynamicSharedMemorySize, LDS_BYTES);
    }
    if (grid < 0) return;
    (void)hipMemsetAsync((char*)d_ws + WS_CTL, 0, CTL_BYTES, stream);
    Params P{};
    for (int i = 0; i < 21; ++i) P.in[i] = (const float*)d_in[i];
    P.out = (float*)d_out; P.ws = (unsigned char*)d_ws;
#if N_LAUNCH_MODE == 1
    hipLaunchKernelGGL(k_mega, dim3(grid), dim3(NTHREADS), LDS_BYTES, stream, P);
#else
    launch_step<0>(P, 0, grid, stream);
    launch_step<1>(P, 0, grid, stream);
    for (int l = 0; l < 2; ++l) {
        launch_step<2>(P, l, grid, stream); launch_step<3>(P, l, grid, stream); launch_step<4>(P, l, grid, stream); launch_step<5>(P, l, grid, stream);
        launch_step<6>(P, l, grid, stream); launch_step<7>(P, l, grid, stream); launch_step<8>(P, l, grid, stream);
        launch_step<10>(P, l, grid, stream);
    }
#endif
}
#ifdef DBG_INST
template __global__ void k_step<11>(Params, int);
template __global__ void k_step<12>(Params, int);
template __global__ void k_step<13>(Params, int);
template __global__ void k_step<14>(Params, int);
template __global__ void k_step<15>(Params, int);
template __global__ void k_step<16>(Params, int);
#endif
```

```cpp
#include <hip/hip_runtime.h>
#include <cstdint>
#include <cstdio>

#ifndef N_LAUNCH_MODE
#define N_LAUNCH_MODE 1
#endif
#ifndef FAST_MIX
#define FAST_MIX 1
#endif
#ifndef DBG_TEST
#define DBG_TEST 0
#endif
#ifndef DBG_HG_MODE
#define DBG_HG_MODE 0
#endif
#ifndef FAST_GEMM
#define FAST_GEMM 1
#endif

#define LAS __attribute__((address_space(3)))
#define GAS __attribute__((address_space(1)))
typedef unsigned short bf16_t;
typedef short bf16x8 __attribute__((ext_vector_type(8)));
typedef float f32x4 __attribute__((ext_vector_type(4)));
typedef float f32x2 __attribute__((ext_vector_type(2)));
typedef unsigned u32x4 __attribute__((ext_vector_type(4)));
typedef unsigned u32x2 __attribute__((ext_vector_type(2)));
typedef short s16x4 __attribute__((ext_vector_type(4)));
typedef float f32x16 __attribute__((ext_vector_type(16)));
#define DI __device__ __forceinline__

constexpr int D = 1024, NB = 2, SEQ = 8192, CTXL = 256, NLAT = NB * SEQ, NCTX = NB * CTXL, NROWS = NLAT + NCTX;
constexpr int INW = 2816, PBW = 2304, ZW = 512, NEXP = 16, DEXP = 512, LISTCAP = NROWS;
constexpr int NTHREADS = 512, NWAVES = 8;
constexpr float ALPHA = 1.41421356237f, LN_EPS = 1e-5f, RMS_EPS = 1e-6f, LOG2E = 1.4426950408889634f, QSCALE = 0.125f * LOG2E;
constexpr int PB_AQ = 0, PB_AI = 256, PB_AG = 512, PB_NQ = 768, PB_NK = 1024, PB_NV = 1280, PB_SQ = 1536, PB_SK = 2048, PB_SV = 2176;
constexpr int NCHAIN = 132;

constexpr size_t MiB = 1u << 20;
constexpr size_t WS_CTL = 0, CTL_BYTES = 1 * MiB;
constexpr size_t WS_MODS = 1 * MiB;
constexpr size_t WS_LB = WS_MODS + 2 * 3 * 6144 * 4;
constexpr size_t WS_ROPE = WS_LB + 2 * 2 * 256 * 4;
constexpr size_t WS_TOKE = WS_ROPE + 129 * 16 * 2 * 4;
constexpr size_t WS_TOKP = WS_TOKE + NROWS * 8;
constexpr size_t WS_TOKW = WS_TOKP + NROWS * 8;
constexpr size_t WS_LIST = 2 * MiB;
constexpr size_t WS_XC = 4 * MiB;
constexpr size_t WS_X1 = 211 * MiB;
constexpr size_t WS_WIN = 6 * MiB;
constexpr size_t WS_WOUT = 17 * MiB;
constexpr size_t WS_WGU = 21 * MiB;
constexpr size_t WS_WD = 53 * MiB;
constexpr size_t WS_H = 69 * MiB;
constexpr size_t WS_Y = 102 * MiB;
constexpr size_t WS_S = 135 * MiB;
constexpr size_t WS_DD = 282 * MiB;
constexpr size_t WS_PB = 174 * MiB;
constexpr size_t WS_Z = WS_PB + (size_t)NROWS * PBW * 2;
constexpr size_t WS_O = 174 * MiB;
constexpr size_t WS_YO = 248 * MiB;
constexpr size_t WS_WGU1 = 284 * MiB, WS_WD1 = 316 * MiB;
constexpr size_t WS_END = 332 * MiB;
constexpr int HE_ROWS = 37888;
constexpr size_t WS_KK = WS_Z + (size_t)NROWS * ZW * 2;
static_assert(WS_DD + (size_t)2 * 2112 * 64 * 4 <= WS_END && WS_Z + (size_t)NROWS * ZW * 4 <= WS_DD && WS_O + (size_t)HE_ROWS * 1024 * 2 <= WS_YO && WS_YO + (size_t)NROWS * 2048 <= WS_END, "ws map");
static_assert(WS_TOKW + NROWS * 8 <= WS_LIST && WS_LIST + 16 * LISTCAP * 4 <= WS_XC, "ws map small");
constexpr int CW_TRDY = 32768;
constexpr int CW_CNT = 8192;
constexpr int CW_BAR = 4096;
constexpr int CW_DBG = 512;
constexpr int CW_Q = 1024;
constexpr int CW_TS = 2048;
constexpr int CW_SCAN = 1536;

struct Params {
    const float* in[21];
    float* out;
    unsigned char* ws;
    int step_lo, step_hi;
};

DI unsigned f2bf(float f) { unsigned u = __builtin_bit_cast(unsigned, f); return (u + 0x7fffu + ((u >> 16) & 1u)) >> 16; }
DI float bf2f(unsigned h) { return __builtin_bit_cast(float, h << 16); }
typedef __bf16 bf16x2_t __attribute__((ext_vector_type(2)));
DI unsigned pk2(float lo, float hi) { return __builtin_bit_cast(unsigned, __builtin_convertvector((f32x2){lo, hi}, bf16x2_t)); }
DI float bflo(unsigned w) { return __builtin_bit_cast(float, w << 16); }
DI float bfhi(unsigned w) { return __builtin_bit_cast(float, w & 0xffff0000u); }
#define DPPF(v, ctrl, rm) __builtin_bit_cast(float, __builtin_amdgcn_update_dpp(0, __builtin_bit_cast(int, (v)), (ctrl), (rm), 0xf, false))
DI float wave_sum(float v) {
    v += DPPF(v, 0xB1, 0xf); v += DPPF(v, 0x4E, 0xf); v += DPPF(v, 0x141, 0xf); v += DPPF(v, 0x140, 0xf);
    v += DPPF(v, 0x142, 0xa); v += DPPF(v, 0x143, 0xc);
    return __builtin_bit_cast(float, __builtin_amdgcn_readlane(__builtin_bit_cast(int, v), 63));
}
DI float wave_max(float v) {
#pragma unroll
    for (int o = 1; o < 64; o <<= 1) v = fmaxf(v, __shfl_xor(v, o));
    return v;
}
DI float sigmoidf_(float x) { return __builtin_amdgcn_rcpf(1.0f + __expf(-x)); }
DI float siluf_(float x) { return x * __builtin_amdgcn_rcpf(1.0f + __expf(-x)); }
DI unsigned pk_fp8x4(f32x4 v) { int w = 0; w = __builtin_amdgcn_cvt_pk_fp8_f32(v[0], v[1], w, false); w = __builtin_amdgcn_cvt_pk_fp8_f32(v[2], v[3], w, true); return (unsigned)w; }
DI void st_wt(void* p, unsigned v) { __hip_atomic_store((unsigned*)p, v, __ATOMIC_RELAXED, __HIP_MEMORY_SCOPE_AGENT); }
DI void st_wtf(float* p, float v) { __hip_atomic_store((unsigned*)p, __float_as_uint(v), __ATOMIC_RELAXED, __HIP_MEMORY_SCOPE_AGENT); }
DI void st_wth(bf16_t* p, unsigned short v) { __hip_atomic_store((unsigned short*)p, v, __ATOMIC_RELAXED, __HIP_MEMORY_SCOPE_AGENT); }
DI void store_bf4(bf16_t* p, f32x4 v) { u32x2 w; w.x = pk2(v[0], v[1]); w.y = pk2(v[2], v[3]); *(u32x2*)p = w; }

struct Ctx {
    LAS unsigned char* lds;
    int tid, lane, wave, bid, nb;
};

struct Unit { int pm, pn, e, cnt, i0, slot; };

struct PlainSched {
    int nM, nN, nwg, G, c;
    DI void init(int M, int N, int G_, int c_) { nM = M / 256; nN = N / 256; nwg = nM * nN; G = G_; c = c_; }
    DI bool next(int i, Unit& u) const {
        const long L = (long)i * G + c; if (L >= nwg) return false;
        int wgid = (int)L; { const int q = nwg / 8, r = nwg % 8, xcd = wgid % 8, off = wgid / 8; wgid = (xcd < r ? xcd * (q + 1) : r * (q + 1) + (xcd - r) * q) + off; }
        const int nig = 8 * nN, gid = wgid / nig, fm = gid * 8, gsz = (nM - fm) < 8 ? (nM - fm) : 8;
        u.pm = fm + ((wgid % nig) % gsz); u.pn = (wgid % nig) / gsz; u.e = 0; u.cnt = 0; u.i0 = 0; u.slot = 0; return true;
    }
    DI int a_row(const Unit& u, int r) const { return u.pm * 256 + r; }
    DI int b_row0(const Unit& u) const { return u.pn * 256; }
    static constexpr bool LOADS = false, PUBLISH = false, WAIT = false;
};
constexpr int MOE_TBL_OFF = 144 * 1024 + 512;
constexpr int MOE_LIST_OFF = 144 * 1024 + 2560;
DI void moe_build_table(const Ctx& X, const int* cnt) {
    LAS int* tbl = (LAS int*)(X.lds + MOE_TBL_OFF);
    if (X.tid < 160) { const int T = X.tid; int acc = 0, e = -1, i0 = 0, ce = 0;
#pragma unroll
        for (int q = 0; q < NEXP; ++q) { const int cq = cnt[q * 64]; const int nt = (cq + 255) >> 8; if (e < 0 && T < acc + nt) { e = q; i0 = T - acc; ce = cq; } acc += nt; }
        tbl[1 + 3 * T] = e; tbl[2 + 3 * T] = i0; tbl[3 + 3 * T] = ce; if (T == 0) tbl[0] = acc; }
    __syncthreads();
}
template <bool GATHER> struct MoeSched {
    const int* cnt; const int* list; int G, c, nct, bt_rows; LAS unsigned char* lds; unsigned* ready; static constexpr bool gather = GATHER;
    static constexpr int NCT_UP = 4;
    DI bool next(int i, Unit& u) const {
        const LAS int* tbl = (const LAS int*)(lds + MOE_TBL_OFF);
        const int clin = (c & 7) * (G >> 3) + (c >> 3), ntile = __builtin_amdgcn_readfirstlane(tbl[0]);
        int L;
        if (GATHER) L = i * G + clin;
        else { const int n1 = ntile * NCT_UP, rf = n1 / G, r = n1 - rf * G;
            if (r == 0) L = i * G + clin;
            else { const int nl = ((rf * G) / NCT_UP) * nct;
                if (clin < r) L = nl + i * r + clin;
                else { L = i * (G - r) + (clin - r); if (L >= nl) return false; } } }
        const int T = L / nct; if (T >= ntile) return false;
        u.slot = i; u.pm = T; u.pn = L % nct; u.e = __builtin_amdgcn_readfirstlane(tbl[1 + 3 * T]); u.i0 = __builtin_amdgcn_readfirstlane(tbl[2 + 3 * T]); u.cnt = __builtin_amdgcn_readfirstlane(tbl[3 + 3 * T]); return true;
    }
    DI int a_row(const Unit& u, int r) const {
        if (!gather) return u.pm * 256 + r;
        return ((const LAS int*)(lds + MOE_LIST_OFF))[u.slot * 256 + r];
    }
    DI int b_row0(const Unit& u) const { return u.e * bt_rows + u.pn * 256; }
    static constexpr bool LOADS = GATHER, PUBLISH = GATHER, WAIT = !GATHER;
    DI void publish(const Unit& u) const { __hip_atomic_fetch_add(ready + u.pm, 1u, __ATOMIC_RELAXED, __HIP_MEMORY_SCOPE_AGENT); }
    DI void wait(const Unit& u) const { unsigned sp = 0; while (__hip_atomic_load(ready + u.pm, __ATOMIC_RELAXED, __HIP_MEMORY_SCOPE_AGENT) < (unsigned)NCT_UP && ++sp < (1u << 24)) __builtin_amdgcn_s_sleep(1);
        __builtin_amdgcn_fence(__ATOMIC_ACQUIRE, "agent"); asm volatile("s_waitcnt vmcnt(0)" ::: "memory"); }
};

DI void store_bf8(bf16_t* p, f32x4 lo, f32x4 hi) { u32x4 w; w.x = pk2(lo[0], lo[1]); w.y = pk2(lo[2], lo[3]); w.z = pk2(hi[0], hi[1]); w.w = pk2(hi[2], hi[3]); *(u32x4*)p = w; }
DI void store_f8x8(unsigned char* p, f32x4 lo, f32x4 hi) { u32x2 w; w.x = pk_fp8x4(lo); w.y = pk_fp8x4(hi); *(u32x2*)p = w; }
DI float lane32_partner(float v, bool upper) { const auto rr = __builtin_amdgcn_permlane32_swap(__float_as_uint(v), __float_as_uint(v), false, false); return __uint_as_float(upper ? rr[0] : rr[1]); }
struct EpiIn {
    bf16_t* PB; bf16_t* Z; const float* rope; const float* lb; bf16_t* KK;
    DI void gate8(bf16_t* zp, bf16_t* kp, const float* lbp, f32x4 z0, f32x4 z1) const {
        const f32x4 lb0 = *(const f32x4*)lbp, lb1 = *(const f32x4*)(lbp + 4); f32x4 lf0, lf1, k0, k1;
#pragma unroll
        for (int j = 0; j < 4; ++j) { const float zc = fminf(fmaxf(z0[j], -30.f), 30.f), e = __expf(-zc), sg = __builtin_amdgcn_rcpf(1.0f + e); lf0[j] = __log2f(lb0[j] + (1.0f - lb0[j]) * sg); k0[j] = (1.0f - lb0[j]) * (e * sg); }
#pragma unroll
        for (int j = 0; j < 4; ++j) { const float zc = fminf(fmaxf(z1[j], -30.f), 30.f), e = __expf(-zc), sg = __builtin_amdgcn_rcpf(1.0f + e); lf1[j] = __log2f(lb1[j] + (1.0f - lb1[j]) * sg); k1[j] = (1.0f - lb1[j]) * (e * sg); }
        store_bf8(zp, lf0, lf1); store_bf8(kp, k0, k1);
    }
    DI void rope8(f32x4& v0, f32x4& v1, const float* rp, bool upper) const {
#pragma unroll
        for (int j = 0; j < 4; ++j) { const float c0 = rp[2 * j], s0 = rp[2 * j + 1], c1 = rp[2 * (j + 4)], s1 = rp[2 * (j + 4) + 1];
            const float p0 = lane32_partner(v0[j], upper), p1 = lane32_partner(v1[j], upper);
            v0[j] = upper ? p0 * s0 + v0[j] * c0 : v0[j] * c0 - p0 * s0; v1[j] = upper ? p1 * s1 + v1[j] * c1 : v1[j] * c1 - p1 * s1; }
    }
    DI void group(const Unit& u, int r, int c, f32x4 a0, f32x4 a1, f32x4 b0, f32x4 b1) const {
        const int row = u.pm * 256 + r, seg = u.pn, gc = u.pn * 256 + c;
        if (seg == 1 || seg == 2) {
            const int ci = (seg - 1) * 256 + c; bf16_t* z = Z + (size_t)row * ZW + ci; bf16_t* k = KK + (size_t)row * ZW + ci; const float* lp = lb + ci;
            gate8(z, k, lp, a0, a1); gate8(z + 128, k + 128, lp + 128, b0, b1);
            return;
        }
        if (seg >= 8) {
            const int t = row & (SEQ - 1); const int which = (c >> 5) & 1; const int pos = row < NLAT ? (which ? (t & 63) : (t >> 6)) : 128;
            const bool upper = (c & 31) >= 16; const float* rp = rope + (pos * 16 + (c & 15)) * 2;
            rope8(a0, a1, rp, upper); if (seg < 10) rope8(b0, b1, rp, upper);
        }
        if (seg == 5 || seg == 8 || seg == 9) { a0 *= QSCALE; a1 *= QSCALE; b0 *= QSCALE; b1 *= QSCALE; }
        bf16_t* p = PB + (size_t)row * PBW + (gc >= 768 ? gc - 512 : gc);
        store_bf8(p, a0, a1); store_bf8(p + 128, b0, b1);
    }
};
struct EpiBf {
    bf16_t* C; int ldc;
    DI void group(const Unit& u, int r, int c, f32x4 a0, f32x4 a1, f32x4 b0, f32x4 b1) const {
        bf16_t* p = C + (size_t)(u.pm * 256 + r) * ldc + u.pn * 256 + c;
        store_bf8(p, a0, a1); store_bf8(p + 128, b0, b1);
    }
};
struct EpiF8 {
    unsigned char* C; int ldc;
    DI void group(const Unit& u, int r, int c, f32x4 a0, f32x4 a1, f32x4 b0, f32x4 b1) const {
        unsigned char* p = C + (size_t)(u.pm * 256 + r) * ldc + u.pn * 256 + c;
        store_f8x8(p, a0 * 16.0f, a1 * 16.0f); store_f8x8(p + 128, b0 * 16.0f, b1 * 16.0f);
    }
};
struct EpiGU {
    bf16_t* HE;
    DI void group(const Unit& u, int r, int c, f32x4 a0, f32x4 a1, f32x4 b0, f32x4 b1) const {
        f32x4 h0, h1;
#pragma unroll
        for (int j = 0; j < 4; ++j) { h0[j] = siluf_(a0[j]) * b0[j]; h1[j] = siluf_(a1[j]) * b1[j]; }
        u32x2 w; w.x = pk_fp8x4(h0); w.y = pk_fp8x4(h1);
        __hip_atomic_store((unsigned long long*)((unsigned char*)HE + (size_t)(u.pm * 256 + r) * DEXP + u.pn * 128 + c), (unsigned long long)w.x | ((unsigned long long)w.y << 32), __ATOMIC_RELAXED, __HIP_MEMORY_SCOPE_AGENT);
    }
};

template <class Sched, class Epi>
DI void gemm_naive(const Ctx& X, const bf16_t* A, const bf16_t* Bt, int K, const Sched& S, const Epi& E) {
    Unit u;
    for (int i = 0; S.next(i, u); ++i) {
        for (int g = X.tid; g < 4096; g += NTHREADS) {
            const int fq = g & 3, wc = (g >> 2) & 3, r = g >> 4, c = wc * 32 + fq * 4;
            const bf16_t* ap = A + (size_t)S.a_row(u, r) * K;
            const bf16_t* bp = Bt + (size_t)(S.b_row0(u) + c) * K;
            float acc[16];
#pragma unroll
            for (int q = 0; q < 16; ++q) acc[q] = 0.f;
            for (int k = 0; k < K; k += 8) {
                const u32x4 av = *(const u32x4*)(ap + k);
                float af[8] = {bflo(av.x), bfhi(av.x), bflo(av.y), bfhi(av.y), bflo(av.z), bfhi(av.z), bflo(av.w), bfhi(av.w)};
#pragma unroll
                for (int q = 0; q < 16; ++q) {
                    const int col = (q >> 3) * 128 + ((q >> 2) & 1) * 16 + (q & 3);
                    const u32x4 bv = *(const u32x4*)(bp + (size_t)col * K + k);
                    acc[q] += af[0] * bflo(bv.x) + af[1] * bfhi(bv.x) + af[2] * bflo(bv.y) + af[3] * bfhi(bv.y) + af[4] * bflo(bv.z) + af[5] * bfhi(bv.z) + af[6] * bflo(bv.w) + af[7] * bfhi(bv.w);
                }
            }
            E.group(u, r, c, (f32x4){acc[0], acc[1], acc[2], acc[3]}, (f32x4){acc[4], acc[5], acc[6], acc[7]}, (f32x4){acc[8], acc[9], acc[10], acc[11]}, (f32x4){acc[12], acc[13], acc[14], acc[15]});
        }
    }
}

constexpr int HTB = 128 * 64 * 2;
DI int lds_byte(int r, int c) { const int st = (r >> 4) * 2 + (c >> 5), rr = r & 15, cc = c & 31, ob = rr * 64 + cc * 2; return st * 1024 + (ob ^ (((ob >> 9) & 1) << 5)); }
DI void stage_rc(int b, int& R, int& C) { const int st = b / 1024, sb = b % 1024, swz = sb ^ (((sb >> 9) & 1) << 5); R = (st >> 1) * 16 + swz / 64; C = (st & 1) * 32 + (swz % 64) / 2; }
typedef int v8i_t __attribute__((ext_vector_type(8)));
template <class Sched, class Epi, bool F8 = false, int SCALE_B = 127>
DI void gemm_fast(const Ctx& X, const void* A, const void* Bt, int K, const Sched& S, const Epi& E) {
    LAS unsigned char* lds = X.lds;
    const int tid = X.tid, wid = X.wave, lane = X.lane, wr = wid >> 2, wc = wid & 3, fr = lane & 15, fq = lane >> 4;
    asm volatile("" : "+s"(K));
    const int RP = F8 ? K : 2 * K, nt = RP / 128;
    int Rr[2], Cc[2]; unsigned voffB[2];
#pragma unroll
    for (int i = 0; i < 2; ++i) { stage_rc(tid * 16 + i * 8192, Rr[i], Cc[i]); const int rho = Rr[i] & 31, Rb = (Rr[i] & ~31) + 8 * ((rho & 15) >> 2) + 4 * (rho >> 4) + (rho & 3);
        voffB[i] = (unsigned)(Rb * RP + Cc[i] * 2); }
    const size_t kstep = 128, hstepB = (size_t)128 * RP;
    const unsigned ldsw = (unsigned)wid * 1024u;
    const int aoff = lds_byte(wr * 64 + fr, fq * 8), boff = lds_byte(wc * 32 + fr, fq * 8);
#define G_SA(b, h) (((b) * 2 + (h)) * HTB)
#define G_SB(b, h) ((4 + (b) * 2 + (h)) * HTB)
#define G_STAGE(bufoff, gbase, voff) do { _Pragma("unroll") for (int _i = 0; _i < 2; ++_i) \
        __builtin_amdgcn_global_load_lds((const unsigned*)((const char*)(gbase) + (voff)[_i]), (LAS unsigned*)(lds + (bufoff) + ldsw + _i * 8192), 16, 0, 0); } while (0)
#define G_LD8(p) __builtin_bit_cast(v8i_t, __builtin_shufflevector(*(const LAS u32x4*)(p), *(const LAS u32x4*)((p) + 1024), 0, 1, 2, 3, 4, 5, 6, 7))
#define G_LDA(dst, b, h) do { _Pragma("unroll") for (int m = 0; m < 4; ++m) dst[m] = G_LD8(lds + G_SA(b, h) + aoff + m * 2048); } while (0)
#define G_LDB(dst, b, h) do { _Pragma("unroll") for (int n = 0; n < 2; ++n) dst[n] = G_LD8(lds + G_SB(b, h) + boff + n * 2048); } while (0)
#define G_LO(f) __builtin_bit_cast(bf16x8, __builtin_shufflevector((f), (f), 0, 1, 2, 3))
#define G_HI(f) __builtin_bit_cast(bf16x8, __builtin_shufflevector((f), (f), 4, 5, 6, 7))
#define G_MMA(ai, bj, At, Bt_) do { __builtin_amdgcn_s_setprio(1); _Pragma("unroll") for (int m = 0; m < 4; ++m) _Pragma("unroll") for (int n = 0; n < 2; ++n) { \
        if constexpr (F8) asm volatile("v_mfma_scale_f32_16x16x128_f8f6f4 %0, %1, %2, %0, %3, %4 op_sel_hi:[0,0,0]" : "+v"(acc[ai][bj][m][n]) : "v"(Bt_[n]), "v"(At[m]), "v"(scl_w), "v"(scl_x)); \
        else { acc[ai][bj][m][n] = __builtin_amdgcn_mfma_f32_16x16x32_bf16(G_LO(Bt_[n]), G_LO(At[m]), acc[ai][bj][m][n], 0, 0, 0); acc[ai][bj][m][n] = __builtin_amdgcn_mfma_f32_16x16x32_bf16(G_HI(Bt_[n]), G_HI(At[m]), acc[ai][bj][m][n], 0, 0, 0); } } __builtin_amdgcn_s_setprio(0); } while (0)
#define G_WAIT_V(n) asm volatile("s_waitcnt vmcnt(" #n ")" ::: "memory")
#define G_WAIT_L(n) asm volatile("s_waitcnt lgkmcnt(" #n ")" ::: "memory")
#define G_BAR __builtin_amdgcn_s_barrier()
#define G_SCHED __builtin_amdgcn_sched_barrier(0)
    Unit cur, nxt; int ui = 0;
    if (!S.next(0, cur)) return;
    if constexpr (Sched::WAIT) { if (tid == 0) S.wait(cur); __builtin_amdgcn_s_barrier(); }
    f32x4 acc[2][2][4][2];
#pragma unroll
    for (int a = 0; a < 2; ++a)
#pragma unroll
        for (int b = 0; b < 2; ++b)
#pragma unroll
            for (int m = 0; m < 4; ++m)
#pragma unroll
                for (int n = 0; n < 2; ++n) acc[a][b][m][n] = (f32x4){0.f, 0.f, 0.f, 0.f};
    v8i_t At[4], B0[2], B1[2];
    int scl_w = SCALE_B * 0x01010101, scl_x = 0x7f7f7f7f; asm volatile("" : "+v"(scl_w), "+v"(scl_x));
    constexpr bool GA = Sched::LOADS;
    unsigned vAc[2][2], vAn[2][2];
#pragma unroll
    for (int h = 0; h < 2; ++h)
#pragma unroll
        for (int i = 0; i < 2; ++i) { vAc[h][i] = GA ? (unsigned)(S.a_row(cur, h * 128 + Rr[i]) * RP + Cc[i] * 2) : (unsigned)((h * 128 + Rr[i]) * RP + Cc[i] * 2); vAn[h][i] = vAc[h][i]; }
    if (GA) G_WAIT_V(0);
    const char* A0 = (const char*)A;
    const char* cA = GA ? A0 : A0 + (size_t)S.a_row(cur, 0) * RP;
    const char* cB = (const char*)Bt + (size_t)S.b_row0(cur) * RP;
    G_STAGE(G_SB(0, 0), cB, voffB); G_STAGE(G_SB(0, 1), cB + hstepB, voffB); G_STAGE(G_SA(0, 0), cA, vAc[0]); G_STAGE(G_SA(0, 1), cA, vAc[1]);
    if (wr == 1) G_BAR;
    G_WAIT_V(2); G_BAR;
    G_STAGE(G_SB(1, 0), cB + kstep, voffB); G_STAGE(G_SA(1, 0), cA + kstep, vAc[0]); G_STAGE(G_SB(1, 1), cB + hstepB + kstep, voffB);
    G_WAIT_V(6); G_BAR;
    for (;;) {
        const bool has_next = S.next(ui + 1, nxt);
        if constexpr (Sched::WAIT) { if (has_next) { if (tid == 0) S.wait(nxt); G_BAR; } }
        if (GA) {
#pragma unroll
            for (int h = 0; h < 2; ++h)
#pragma unroll
                for (int i = 0; i < 2; ++i) vAn[h][i] = has_next ? (unsigned)(S.a_row(nxt, h * 128 + Rr[i]) * RP + Cc[i] * 2) : vAc[h][i];
        }
        const char* nA = GA ? A0 : (has_next ? A0 + (size_t)S.a_row(nxt, 0) * RP : cA);
        const char* nB = has_next ? (const char*)Bt + (size_t)S.b_row0(nxt) * RP : cB;
#pragma unroll 1
        for (int t = 0; t < nt; t += 2) {
            const bool last = (t == nt - 2);
            const char* a1 = cA + (size_t)(t + 1) * kstep;
            const char* a2 = last ? nA : cA + (size_t)(t + 2) * kstep; const char* b2 = last ? nB : cB + (size_t)(t + 2) * kstep;
            const char* a3 = a2 + kstep; const char* b3 = b2 + kstep;
            unsigned v2[2][2];
#pragma unroll
            for (int h = 0; h < 2; ++h)
#pragma unroll
                for (int i = 0; i < 2; ++i) v2[h][i] = (GA && last) ? vAn[h][i] : vAc[h][i];
            G_LDB(B0, 0, 0); G_LDB(B1, 0, 1); G_SCHED; G_LDA(At, 0, 0); G_STAGE(G_SA(1, 1), a1, vAc[1]);
            G_WAIT_V(8); G_WAIT_L(0); G_BAR; G_MMA(0, 0, At, B0); G_MMA(0, 1, At, B1); G_BAR; G_SCHED;
            G_LDA(At, 0, 1); G_STAGE(G_SB(0, 0), b2, voffB); G_STAGE(G_SB(0, 1), b2 + hstepB, voffB); G_STAGE(G_SA(0, 0), a2, v2[0]);
            G_WAIT_V(8); G_WAIT_L(0); G_BAR; G_MMA(1, 0, At, B0); G_MMA(1, 1, At, B1); G_BAR; G_SCHED;
            G_LDB(B0, 1, 0); G_LDB(B1, 1, 1); G_SCHED; G_LDA(At, 1, 0); G_STAGE(G_SA(0, 1), a2, v2[1]);
            G_WAIT_V(8); G_WAIT_L(0); G_BAR; G_MMA(0, 0, At, B0); G_MMA(0, 1, At, B1); G_BAR; G_SCHED;
            G_LDA(At, 1, 1); G_STAGE(G_SB(1, 0), b3, voffB); G_STAGE(G_SB(1, 1), b3 + hstepB, voffB); G_STAGE(G_SA(1, 0), a3, v2[0]);
            G_WAIT_V(8); G_WAIT_L(0); G_BAR; G_MMA(1, 0, At, B0); G_MMA(1, 1, At, B1); G_BAR; G_SCHED;
        }
        if constexpr (F8) asm volatile("s_nop 15\n\ts_nop 15" ::: "memory");
        if (wr == 0) G_BAR;
#pragma unroll
        for (int ai = 0; ai < 2; ++ai)
#pragma unroll
            for (int m = 0; m < 4; ++m) E.group(cur, ai * 128 + wr * 64 + m * 16 + fr, wc * 32 + fq * 8, acc[ai][0][m][0], acc[ai][0][m][1], acc[ai][1][m][0], acc[ai][1][m][1]);
        if constexpr (Sched::PUBLISH) { G_WAIT_V(0); G_BAR; if (tid == 0) S.publish(cur); }
        if (!has_next) break;
#pragma unroll
        for (int a = 0; a < 2; ++a)
#pragma unroll
            for (int b = 0; b < 2; ++b)
#pragma unroll
                for (int m = 0; m < 4; ++m)
#pragma unroll
                    for (int n = 0; n < 2; ++n) acc[a][b][m][n] = (f32x4){0.f, 0.f, 0.f, 0.f};
        cur = nxt; cB = nB; cA = nA; ++ui;
        if (GA) {
#pragma unroll
            for (int h = 0; h < 2; ++h)
#pragma unroll
                for (int i = 0; i < 2; ++i) vAc[h][i] = vAn[h][i]; }
        if (wr == 1) G_BAR;
    }
    G_WAIT_V(0);
    G_BAR;
#undef G_SA
#undef G_SB
#undef G_STAGE
#undef G_LDA
#undef G_LDB
#undef G_MMA
#undef G_LD8
#undef G_LO
#undef G_HI
#undef G_WAIT_V
#undef G_WAIT_L
#undef G_BAR
#undef G_SCHED
}
#if FAST_GEMM
#define GEMM_IMPL gemm_fast
#else
#define GEMM_IMPL gemm_naive
#endif

struct TrDesc { const float* W; bf16_t* WT; int N, Kd, k0, n0, drow0, f8; float sc; };
DI void tr_load(const TrDesc& d, float (&rg)[32], int lane) {
#pragma unroll
    for (int i = 0; i < 32; ++i) { const int kk = 2 * i + (lane >> 5); rg[i] = d.W[(size_t)(d.k0 + kk) * d.N + d.n0 + (lane & 31)]; }
}
DI void tr_finish(const TrDesc& d, const float (&rg)[32], LAS float* scr, int lane) {
#pragma unroll
    for (int i = 0; i < 32; ++i) { const int kk = 2 * i + (lane >> 5); scr[kk * 33 + (lane & 31)] = rg[i]; }
    asm volatile("s_waitcnt lgkmcnt(0)" ::: "memory");
    const int c = lane & 7;
#pragma unroll
    for (int j = 0; j < 4; ++j) { const int n = (lane >> 3) + 8 * j; const LAS float* s = scr + (8 * c) * 33 + n;
        if (d.f8) { u32x2 o; o.x = pk_fp8x4((f32x4){s[0 * 33], s[1 * 33], s[2 * 33], s[3 * 33]} * d.sc); o.y = pk_fp8x4((f32x4){s[4 * 33], s[5 * 33], s[6 * 33], s[7 * 33]} * d.sc);
            *(u32x2*)((unsigned char*)d.WT + (size_t)(d.drow0 + n) * d.Kd + d.k0 + 8 * c) = o; }
        else { u32x4 o; o.x = pk2(s[0 * 33], s[1 * 33]); o.y = pk2(s[2 * 33], s[3 * 33]); o.z = pk2(s[4 * 33], s[5 * 33]); o.w = pk2(s[6 * 33], s[7 * 33]);
            *(u32x4*)(d.WT + (size_t)(d.drow0 + n) * d.Kd + d.k0 + 8 * c) = o; } }
    asm volatile("s_waitcnt lgkmcnt(0)" ::: "memory");
}
DI TrDesc expert_desc(const Params& P, int l, int it) {
    bf16_t* WGU = (bf16_t*)(P.ws + (l ? WS_WGU1 : WS_WGU)); bf16_t* WD = (bf16_t*)(P.ws + (l ? WS_WD1 : WS_WD));
    const float* wg = P.in[18] + (size_t)l * NEXP * D * DEXP; const float* wu = P.in[19] + (size_t)l * NEXP * D * DEXP; const float* wd = P.in[20] + (size_t)l * NEXP * DEXP * D;
    const int set = it >> 12, r = it & 4095, e = r >> 8, q = r & 255; TrDesc d; d.sc = 32.0f;
    if (set < 2) { const int kb = q >> 4, nbk = q & 15, n0 = nbk * 32;
        d.f8 = 1; d.W = (set ? wu : wg) + (size_t)e * D * DEXP; d.N = DEXP; d.WT = (bf16_t*)((unsigned char*)WGU + (size_t)e * 1024 * 1024); d.Kd = 1024; d.k0 = kb * 64; d.n0 = n0; d.drow0 = 256 * (n0 >> 7) + (n0 & 127) + set * 128;
    } else { const int kb = q >> 5, nbk = q & 31, n0 = nbk * 32;
        d.f8 = 1; d.W = wd + (size_t)e * DEXP * D; d.N = D; d.WT = (bf16_t*)((unsigned char*)WD + (size_t)e * 1024 * 512); d.Kd = 512; d.k0 = kb * 64; d.n0 = n0; d.drow0 = n0; }
    return d;
}
DI TrDesc rest_desc(const Params& P, int it) {
    if (it >= 2432) return expert_desc(P, 0, it - 2432);
    bf16_t* WIN = (bf16_t*)(P.ws + WS_WIN); bf16_t* WOUT = (bf16_t*)(P.ws + WS_WOUT); TrDesc d;
    d.f8 = 1; d.sc = 32.0f;
    if (it < 1408) { const int kb = it / 88, nbk = it % 88; d.f8 = 1; d.W = P.in[6] + (size_t)D * INW; d.N = INW; d.WT = (bf16_t*)((unsigned char*)WIN + (size_t)INW * D); d.Kd = D; d.k0 = kb * 64; d.n0 = nbk * 32; d.drow0 = nbk * 32; }
    else { const int r0 = it - 1408, l = r0 >> 9, r = r0 & 511, kb = r >> 5, nbk = r & 31; d.sc = 64.0f; d.W = P.in[11] + (size_t)l * D * D; d.N = D; d.WT = (bf16_t*)((unsigned char*)WOUT + (size_t)l * D * D); d.Kd = D; d.k0 = kb * 64; d.n0 = nbk * 32; d.drow0 = nbk * 32; }
    return d;
}
DI TrDesc win0_desc(const Params& P, int it) { TrDesc d; d.f8 = 1; d.sc = 32.0f; const int kb = it / 88, nbk = it % 88; d.W = P.in[6]; d.N = INW; d.WT = (bf16_t*)(P.ws + WS_WIN); d.Kd = D; d.k0 = kb * 64; d.n0 = nbk * 32; d.drow0 = nbk * 32; return d; }
#define TR_LOOP(DESC_EXPR, first, limit, step) do { int it_ = (first); if (it_ < (limit)) { float rg_[32]; TrDesc d_ = DESC_EXPR(it_); tr_load(d_, rg_, X.lane); \
        for (;;) { const int nx_ = it_ + (step); if (nx_ < (limit)) { float rn_[32]; const TrDesc dn_ = DESC_EXPR(nx_); tr_load(dn_, rn_, X.lane); tr_finish(d_, rg_, scr, X.lane); d_ = dn_; _Pragma("unroll") for (int q_ = 0; q_ < 32; ++q_) rg_[q_] = rn_[q_]; it_ = nx_; } \
                   else { tr_finish(d_, rg_, scr, X.lane); break; } } } } while (0)
DI void ph_prologue(const Ctx& X, const Params& P) {
    LAS float* sc = (LAS float*)X.lds;
    LAS float* red = sc + 3072;
    float* MODS = (float*)(P.ws + WS_MODS);
    for (int it = X.bid; it < 193; it += X.nb) {
        if (it < 192) {
            const int l = it / 96, cg = it % 96;
            for (int i = X.tid; i < 3072; i += NTHREADS) { const int cond = i >> 10, k = i & 1023; const float v = cond < 2 ? P.in[1][cond * 1024 + k] : P.in[3][k]; sc[i] = siluf_(v); }
            __syncthreads();
            const int kq = X.tid >> 4, c4 = X.tid & 15;
            float acc[3][4];
#pragma unroll
            for (int a = 0; a < 3; ++a)
#pragma unroll
                for (int j = 0; j < 4; ++j) acc[a][j] = 0.f;
            const float* w = P.in[4] + (size_t)l * D * 6144 + cg * 64 + c4 * 4;
#pragma unroll 8
            for (int i = 0; i < 32; ++i) { const int k = kq + 32 * i; const f32x4 wv = *(const f32x4*)(w + (size_t)k * 6144);
                const float s0 = sc[k], s1 = sc[1024 + k], s2 = sc[2048 + k];
#pragma unroll
                for (int j = 0; j < 4; ++j) { acc[0][j] += s0 * wv[j]; acc[1][j] += s1 * wv[j]; acc[2][j] += s2 * wv[j]; } }
#pragma unroll
            for (int a = 0; a < 3; ++a)
#pragma unroll
                for (int j = 0; j < 4; ++j) red[(kq * 3 + a) * 64 + c4 * 4 + j] = acc[a][j];
            __syncthreads();
            if (X.tid < 192) { const int cond = X.tid >> 6, col = X.tid & 63; float s = 0.f;
                for (int q = 0; q < 32; ++q) s += red[(q * 3 + cond) * 64 + col];
                MODS[(l * 3 + cond) * 6144 + cg * 64 + col] = s + P.in[5][l * 6144 + cg * 64 + col]; }
            __syncthreads();
        } else {
            float* LB = (float*)(P.ws + WS_LB);
            { const int i = X.tid; const float l0 = P.in[7][i], l1 = P.in[7][512 + i]; const float p1 = 1.0f / (1.0f + expf(l0 - l1));
              LB[i] = 1e-6f; LB[512 + i] = fmaxf(p1, 1e-6f); }
            float* RP = (float*)(P.ws + WS_ROPE);
            for (int i = X.tid; i < 2048 + 16; i += NTHREADS) { const int pos = i >> 4, f = i & 15; const float inv = powf(10000.0f, -(float)f / 16.0f); const float ang = pos < 128 ? (float)pos * inv : 0.0f;
                RP[2 * i] = cosf(ang); RP[2 * i + 1] = sinf(ang); }
        }
    }
    __syncthreads();
    LAS float* scr = (LAS float*)X.lds + X.wave * (64 * 33);
    const int gw = X.bid * NWAVES + X.wave, NGW = X.nb * NWAVES;
#define DESC_WIN0(i) win0_desc(P, (i))
    TR_LOOP(DESC_WIN0, gw, 1408, NGW);
}
DI void convert_rest(const Ctx& X, const Params& P) {
    LAS float* scr = (LAS float*)X.lds + X.wave * (64 * 33);
    const int gw = X.bid * NWAVES + X.wave, NGW = X.nb * NWAVES;
#define DESC_REST(i) rest_desc(P, (i))
    TR_LOOP(DESC_REST, gw, 2432, NGW);
}

DI const float* mods_row(const Params& P, int l, int row) { const int cond = row < NLAT ? (row >> 13) : 2; return (const float*)(P.ws + WS_MODS) + (l * 3 + cond) * 6144; }
template <int NR>
DI void modulate_rows(const Ctx& X, const Params& P, int l, int row0) {
    bf16_t* H = (bf16_t*)(P.ws + WS_H);
    const float* xr = row0 < NLAT ? P.in[0] + (size_t)row0 * D : P.in[2] + (size_t)(row0 - NLAT) * D; const float* md = mods_row(P, l, row0);
    f32x4 x[NR][4];
#pragma unroll
    for (int j = 0; j < 4; ++j)
#pragma unroll
        for (int r = 0; r < NR; ++r) x[r][j] = *(const f32x4*)(xr + (size_t)r * D + 4 * X.lane + 256 * j);
#pragma unroll
    for (int j = 0; j < 4; ++j) { const int c = 4 * X.lane + 256 * j; const f32x4 sh = *(const f32x4*)(md + c), sc = *(const f32x4*)(md + 1024 + c);
#pragma unroll
        for (int r = 0; r < NR; ++r) *(unsigned*)((unsigned char*)H + (size_t)(row0 + r) * D + c) = pk_fp8x4(x[r][j] * (1.0f + sc) + sh); }
}
DI void ph_modulate(const Ctx& X, const Params& P, int l) {
    const int gw = X.bid * NWAVES + X.wave;
    if (gw < NLAT / 8) { modulate_rows<4>(X, P, l, 8 * gw); modulate_rows<4>(X, P, l, 8 * gw + 4); }
    if (gw < NCTX) modulate_rows<1>(X, P, l, NLAT + gw);
}
template <int NR>
DI void ln1_rows(const Ctx& X, const Params& P, int l, int row0, int slot0, const LAS float* wrT, float (&lgv)[16]) {
    bf16_t* H = (bf16_t*)(P.ws + WS_H); const bf16_t* YO = (const bf16_t*)(P.ws + WS_YO); bf16_t* X1 = (bf16_t*)(P.ws + WS_X1) + (size_t)row0 * D;
    const float* g = P.in[12] + l * D; const float* bta = P.in[13] + l * D;
    const bool lat = row0 < NLAT;
    const float* xr = lat ? P.in[0] + (size_t)row0 * D : P.in[2] + (size_t)(row0 - NLAT) * D;
    const bf16_t* xb = (const bf16_t*)P.out + (size_t)row0 * D;
    const float* md = mods_row(P, l, row0);
    const int c0 = 4 * X.lane;
    f32x4 v[NR][4]; float sm[NR];
#pragma unroll
    for (int r = 0; r < NR; ++r) sm[r] = 0.f;
#pragma unroll
    for (int j = 0; j < 4; ++j) { const int c = c0 + 256 * j; const f32x4 g1 = *(const f32x4*)(md + 2048 + c);
#pragma unroll
        for (int r = 0; r < NR; ++r) { f32x4 x; if (l == 0) x = *(const f32x4*)(xr + (size_t)r * D + c); else { const u32x2 xw = *(const u32x2*)(xb + (size_t)r * D + c); x = (f32x4){bflo(xw.x), bfhi(xw.x), bflo(xw.y), bfhi(xw.y)}; }
            const u32x2 yw = *(const u32x2*)(YO + (size_t)(row0 + r) * D + c);
            const f32x4 y = {bflo(yw.x), bfhi(yw.x), bflo(yw.y), bfhi(yw.y)}; v[r][j] = ALPHA * x + g1 * y; sm[r] += (v[r][j][0] + v[r][j][1]) + (v[r][j][2] + v[r][j][3]); } }
    float rstd[NR];
#pragma unroll
    for (int r = 0; r < NR; ++r) { const float mean = wave_sum(sm[r]) * (1.0f / D); float q = 0.f;
#pragma unroll
        for (int j = 0; j < 4; ++j) { v[r][j] = v[r][j] - mean; q += (v[r][j][0] * v[r][j][0] + v[r][j][1] * v[r][j][1]) + (v[r][j][2] * v[r][j][2] + v[r][j][3] * v[r][j][3]); }
        sm[r] = q; }
#pragma unroll
    for (int r = 0; r < NR; ++r) rstd[r] = 1.0f / sqrtf(wave_sum(sm[r]) * (1.0f / D) + LN_EPS);
#pragma unroll
    for (int j = 0; j < 4; ++j) { const int c = c0 + 256 * j; const f32x4 gm = *(const f32x4*)(g + c), bt = *(const f32x4*)(bta + c), sc2 = *(const f32x4*)(md + 4096 + c), sh2 = *(const f32x4*)(md + 3072 + c);
#pragma unroll
        for (int r = 0; r < NR; ++r) { const f32x4 x1 = v[r][j] * rstd[r] * gm + bt; store_bf4(X1 + (size_t)r * D + c, x1);
            const f32x4 h2 = x1 * (1.0f + sc2) + sh2; *(unsigned*)((unsigned char*)H + (size_t)(row0 + r) * D + c) = pk_fp8x4(h2); v[r][j] = h2; } }
#pragma unroll
    for (int e = 0; e < 16; ++e) {
        f32x4 w[4];
#pragma unroll
        for (int j = 0; j < 4; ++j) w[j] = *(const LAS f32x4*)(wrT + e * 1024 + c0 + 256 * j);
#pragma unroll
        for (int r = 0; r < NR; ++r) { f32x4 acc = v[r][0] * w[0]; acc += v[r][1] * w[1]; acc += v[r][2] * w[2]; acc += v[r][3] * w[3];
            const float tot = wave_sum((acc[0] + acc[1]) + (acc[2] + acc[3]));
            lgv[e] = X.lane == slot0 + r ? tot : lgv[e]; }
        asm volatile("" ::: "memory");
    }
}
DI void ph_ln1(const Ctx& X, const Params& P, int l, bool dummy = false) {
    LAS float* wrT = (LAS float*)X.lds;
    for (int i = X.tid; i < 16384; i += NTHREADS) { const int k = i >> 4, e = i & 15; wrT[e * 1024 + k] = P.in[16][i]; }
    int* TOKP = (int*)(P.ws + WS_TOKP); int* LIST = (int*)(P.ws + WS_LIST);
    unsigned* CNT = (unsigned*)(P.ws + WS_CTL) + CW_CNT + 1024 * l + (dummy ? 4096 : 0);
    LAS int* lcnt = (LAS int*)(X.lds + 65536); LAS int* lbase = lcnt + 16; LAS int* linfo = lcnt + 32;
    if (X.tid < 16) lcnt[X.tid] = 0;
    for (int i = X.tid; i < 72 * 4; i += NTHREADS) linfo[i] = -1;
    __syncthreads();
    const int gw = X.bid * NWAVES + X.wave;
    float lgv[16];
#pragma unroll
    for (int e = 0; e < 16; ++e) lgv[e] = 0.f;
    if (gw < NLAT / 8) ln1_rows<8>(X, P, l, 8 * gw, 0, wrT, lgv);
    const bool hasctx = l == 0 && gw < NCTX;
    if (hasctx) ln1_rows<1>(X, P, l, NLAT + gw, 8, wrT, lgv);
    {
        int* TOKE = (int*)(P.ws + WS_TOKE); float* TOKW = (float*)(P.ws + WS_TOKW);
        const int k = X.lane; const bool valid = (k < 8 && gw < NLAT / 8) || (k == 8 && hasctx); const int row = k < 8 ? 8 * gw + k : NLAT + gw;
        float sg[16], sel[16];
#pragma unroll
        for (int e = 0; e < 16; ++e) { sg[e] = sigmoidf_(lgv[e]); sel[e] = sg[e] + P.in[17][e]; }
        int best = 0; float bestv = -3e38f;
#pragma unroll
        for (int gq = 0; gq < 4; ++gq) { float m1 = -3e38f, m2 = -3e38f;
#pragma unroll
            for (int j = 0; j < 4; ++j) { const float t = sel[gq * 4 + j]; const float lo = fminf(m1, t); m1 = fmaxf(m1, t); m2 = fmaxf(m2, lo); }
            const float gs = m1 + m2; const bool bt = gs > bestv; best = bt ? gq : best; bestv = bt ? gs : bestv; }
        int i0 = 0, i1 = 0; float v0 = -3e38f, v1 = -3e38f, s0 = 0.f, s1 = 0.f;
#pragma unroll
        for (int e = 0; e < 16; ++e) { const float t = (e >> 2) == best ? sel[e] : -3e38f; const bool c0 = t > v0, c1 = !c0 && t > v1;
            v1 = c0 ? v0 : (c1 ? t : v1); i1 = c0 ? i0 : (c1 ? e : i1); s1 = c0 ? s0 : (c1 ? sg[e] : s1);
            v0 = c0 ? t : v0; i0 = c0 ? e : i0; s0 = c0 ? sg[e] : s0; }
        if (valid) { const int slot = X.wave * 9 + k; const float inv = 1.0f / (s0 + s1);
            const int p0 = __hip_atomic_fetch_add(lcnt + i0, 1, __ATOMIC_RELAXED, __HIP_MEMORY_SCOPE_WORKGROUP), p1 = __hip_atomic_fetch_add(lcnt + i1, 1, __ATOMIC_RELAXED, __HIP_MEMORY_SCOPE_WORKGROUP);
            linfo[4 * slot] = row; linfo[4 * slot + 1] = i0 | (i1 << 8); linfo[4 * slot + 2] = p0; linfo[4 * slot + 3] = p1;
            TOKE[2 * row] = i0; TOKE[2 * row + 1] = i1; TOKW[2 * row] = s0 * inv; TOKW[2 * row + 1] = s1 * inv; }
    }
    __syncthreads();
    if (X.tid < 16) lbase[X.tid] = (int)atomicAdd(CNT + 64 * X.tid, (unsigned)lcnt[X.tid]);
    __syncthreads();
    if (X.tid < 72) { const int row = linfo[4 * X.tid];
        if (row >= 0) { const int ee = linfo[4 * X.tid + 1], e0 = ee & 255, e1 = ee >> 8, p0 = lbase[e0] + linfo[4 * X.tid + 2], p1 = lbase[e1] + linfo[4 * X.tid + 3];
            LIST[e0 * LISTCAP + p0] = row; LIST[e1 * LISTCAP + p1] = row; TOKP[2 * row] = p0; TOKP[2 * row + 1] = p1; } }
}
template <int NR>
DI void ln2_rows(const Ctx& X, const Params& P, int l, int row0, const int (&off)[16]) {
    bf16_t* H = (bf16_t*)(P.ws + WS_H); const unsigned char* O = P.ws + WS_O; const bf16_t* X1 = (const bf16_t*)(P.ws + WS_X1) + (size_t)row0 * D;
    const int* TOKE = (const int*)(P.ws + WS_TOKE); const int* TOKP = (const int*)(P.ws + WS_TOKP); const float* TOKW = (const float*)(P.ws + WS_TOKW);
    const float* g = P.in[14] + l * D; const float* bta = P.in[15] + l * D;
    const bool lat = row0 < NLAT;
    const float* md = mods_row(P, l, row0); const float* mdn = mods_row(P, 1, row0);
    const int c0 = 4 * X.lane;
    const unsigned char* ra[NR]; const unsigned char* rb[NR]; float w0[NR], w1[NR];
#pragma unroll
    for (int r = 0; r < NR; ++r) { const int row = row0 + r; const int e0 = TOKE[2 * row], e1 = TOKE[2 * row + 1]; int o0 = 0, o1 = 0;
#pragma unroll
        for (int e = 0; e < 16; ++e) { if (e == e0) o0 = off[e]; if (e == e1) o1 = off[e]; }
        ra[r] = O + (size_t)(o0 + TOKP[2 * row]) * D; rb[r] = O + (size_t)(o1 + TOKP[2 * row + 1]) * D; w0[r] = TOKW[2 * row] * 0.0625f; w1[r] = TOKW[2 * row + 1] * 0.0625f; }
    f32x4 v[NR][4]; float sm[NR];
#pragma unroll
    for (int r = 0; r < NR; ++r) sm[r] = 0.f;
#pragma unroll
    for (int j = 0; j < 4; ++j) { const int c = c0 + 256 * j; const f32x4 g2 = *(const f32x4*)(md + 5120 + c);
#pragma unroll
        for (int r = 0; r < NR; ++r) { const u32x2 xw = *(const u32x2*)(X1 + (size_t)r * D + c); const f32x4 x = {bflo(xw.x), bfhi(xw.x), bflo(xw.y), bfhi(xw.y)}; const int a = *(const int*)(ra[r] + c), b = *(const int*)(rb[r] + c);
            const f32x2 a01 = __builtin_amdgcn_cvt_pk_f32_fp8(a, false), a23 = __builtin_amdgcn_cvt_pk_f32_fp8(a, true), b01 = __builtin_amdgcn_cvt_pk_f32_fp8(b, false), b23 = __builtin_amdgcn_cvt_pk_f32_fp8(b, true);
            const f32x4 f = w0[r] * (f32x4){a01[0], a01[1], a23[0], a23[1]} + w1[r] * (f32x4){b01[0], b01[1], b23[0], b23[1]};
            v[r][j] = ALPHA * x + g2 * f; sm[r] += (v[r][j][0] + v[r][j][1]) + (v[r][j][2] + v[r][j][3]); } }
    float rstd[NR];
#pragma unroll
    for (int r = 0; r < NR; ++r) { const float mean = wave_sum(sm[r]) * (1.0f / D); float q = 0.f;
#pragma unroll
        for (int j = 0; j < 4; ++j) { v[r][j] = v[r][j] - mean; q += (v[r][j][0] * v[r][j][0] + v[r][j][1] * v[r][j][1]) + (v[r][j][2] * v[r][j][2] + v[r][j][3] * v[r][j][3]); }
        sm[r] = q; }
#pragma unroll
    for (int r = 0; r < NR; ++r) rstd[r] = 1.0f / sqrtf(wave_sum(sm[r]) * (1.0f / D) + LN_EPS);
#pragma unroll
    for (int j = 0; j < 4; ++j) { const int c = c0 + 256 * j; const f32x4 gm = *(const f32x4*)(g + c), bt = *(const f32x4*)(bta + c);
        f32x4 sc1 = {0.f, 0.f, 0.f, 0.f}, sh1 = {0.f, 0.f, 0.f, 0.f}; if (l == 0) { sc1 = *(const f32x4*)(mdn + 1024 + c); sh1 = *(const f32x4*)(mdn + c); }
#pragma unroll
        for (int r = 0; r < NR; ++r) { const f32x4 x2 = v[r][j] * rstd[r] * gm + bt;
            if (l == 0) { if (lat) store_bf4((bf16_t*)P.out + (size_t)(row0 + r) * D + c, x2); *(unsigned*)((unsigned char*)H + (size_t)(row0 + r) * D + c) = pk_fp8x4(x2 * (1.0f + sc1) + sh1); }
            else *(f32x4*)(P.out + (size_t)(row0 + r) * D + c) = x2; } }
}
DI void ph_ln2(const Ctx& X, const Params& P, int l) {
    const unsigned* CNT = (const unsigned*)(P.ws + WS_CTL) + CW_CNT + 1024 * l;
    int off[16]; { int acc = 0;
#pragma unroll
        for (int e = 0; e < 16; ++e) { off[e] = acc; acc += (((int)CNT[e * 64] + 255) >> 8) << 8; } }
    const int gw = X.bid * NWAVES + X.wave;
    if (gw < NLAT / 8) { ln2_rows<4>(X, P, l, 8 * gw, off); ln2_rows<4>(X, P, l, 8 * gw + 4, off); }
    if (l == 0 && gw < NCTX) ln2_rows<1>(X, P, l, NLAT + gw, off);
}

struct KeysNA { int b, r, c, rs, cs, h; const float* rpb;
    DI int n() const { return 128 + CTXL; }
    DI void get(int k, int& krow, float& bias) const { if (k < 128) { const int kr = rs + (k >> 4), kc = cs + (k & 15); krow = b * SEQ + kr * 64 + kc; bias = LOG2E * rpb[h * 465 + (kr - r + 7) * 31 + (kc - c + 15)]; } else { krow = NLAT + b * CTXL + (k - 128); bias = 0.f; } } };
struct KeysSWA { int b, lo, nband;
    DI int n() const { return nband + CTXL; }
    DI void get(int k, int& krow, float& bias) const { krow = k < nband ? b * SEQ + lo + k : NLAT + b * CTXL + (k - nband); bias = 0.f; } };
struct KeysCtx { int b;
    DI int n() const { return CTXL; }
    DI void get(int k, int& krow, float& bias) const { krow = NLAT + b * CTXL + k; bias = 0.f; } };
template <class Keys>
DI void attn_row_naive(const bf16_t* PB, int qrow, int qcol, int kcol, int vcol, const Keys& KS, bool has_sink, float sink, LAS float* sc, bf16_t* yout, int lane) {
    float q[64];
    { const u32x4* qp = (const u32x4*)(PB + (size_t)qrow * PBW + qcol);
#pragma unroll
      for (int i = 0; i < 8; ++i) { const u32x4 w = qp[i]; q[8 * i] = bflo(w.x); q[8 * i + 1] = bfhi(w.x); q[8 * i + 2] = bflo(w.y); q[8 * i + 3] = bfhi(w.y); q[8 * i + 4] = bflo(w.z); q[8 * i + 5] = bfhi(w.z); q[8 * i + 6] = bflo(w.w); q[8 * i + 7] = bfhi(w.w); } }
    const int nk = KS.n(); float mx = has_sink ? sink : -3e38f;
    for (int k = lane; k < nk; k += 64) { int krow; float bias; KS.get(k, krow, bias);
        const u32x4* kp = (const u32x4*)(PB + (size_t)krow * PBW + kcol); float s = 0.f;
#pragma unroll
        for (int i = 0; i < 8; ++i) { const u32x4 w = kp[i]; s += q[8 * i] * bflo(w.x) + q[8 * i + 1] * bfhi(w.x) + q[8 * i + 2] * bflo(w.y) + q[8 * i + 3] * bfhi(w.y) + q[8 * i + 4] * bflo(w.z) + q[8 * i + 5] * bfhi(w.z) + q[8 * i + 6] * bflo(w.w) + q[8 * i + 7] * bfhi(w.w); }
        s += bias; sc[k] = s; mx = fmaxf(mx, s); }
    mx = wave_max(mx); float den = 0.f;
    for (int k = lane; k < nk; k += 64) { const float p = exp2f(sc[k] - mx); sc[k] = p; den += p; }
    den = wave_sum(den); if (has_sink) den += exp2f(sink - mx);
    asm volatile("s_waitcnt lgkmcnt(0)" ::: "memory");
    float o = 0.f;
    for (int k = 0; k < nk; ++k) { int krow; float bias; KS.get(k, krow, bias); o += sc[k] * bf2f(PB[(size_t)krow * PBW + vcol + lane]); }
    yout[lane] = (bf16_t)f2bf(o / den);
    asm volatile("s_waitcnt lgkmcnt(0)" ::: "memory");
}
DI void ph_attn_naive(const Ctx& X, const Params& P, int l) {
    const bf16_t* PB = (const bf16_t*)(P.ws + WS_PB); bf16_t* Y = (bf16_t*)(P.ws + WS_Y);
    LAS float* sc = (LAS float*)X.lds + X.wave * 640;
    const float* rpb = P.in[9] + l * 4 * 465; const float* sink = P.in[10] + l * 8;
    const int nrows = l == 0 ? NROWS : NLAT;
    const int gw = X.bid * NWAVES + X.wave, NGW = X.nb * NWAVES;
    for (int it = gw; it < nrows * 12; it += NGW) {
        const int row = it / 12, hh = it % 12;
        if (row < NLAT) { const int b = row >> 13, t = row & (SEQ - 1);
            if (hh < 4) { KeysNA K; K.b = b; K.r = t >> 6; K.c = t & 63; K.rs = min(max(K.r - 4, 0), 120); K.cs = min(max(K.c - 8, 0), 48); K.h = hh; K.rpb = rpb;
                attn_row_naive(PB, row, PB_NQ + hh * 64, PB_NK + hh * 64, PB_NV + hh * 64, K, false, 0.f, sc, Y + (size_t)row * D + 256 + hh * 64, X.lane);
            } else { const int qh = hh - 4, n = qh >> 2; KeysSWA K; K.b = b; K.lo = max(t - 128, 0); K.nband = min(t + 128, SEQ - 1) - K.lo + 1;
                attn_row_naive(PB, row, PB_SQ + qh * 64, PB_SK + n * 64, PB_SV + n * 64, K, true, LOG2E * sink[qh], sc, Y + (size_t)row * D + 512 + qh * 64, X.lane); }
        } else { const int b = (row - NLAT) >> 8; KeysCtx K; K.b = b;
            if (hh < 4) attn_row_naive(PB, row, PB_NQ + hh * 64, PB_NK + hh * 64, PB_NV + hh * 64, K, false, 0.f, sc, Y + (size_t)row * D + 256 + hh * 64, X.lane);
            else { const int qh = hh - 4, n = qh >> 2; attn_row_naive(PB, row, PB_SQ + qh * 64, PB_SK + n * 64, PB_SV + n * 64, K, true, LOG2E * sink[qh], sc, Y + (size_t)row * D + 512 + qh * 64, X.lane); }
        }
    }
}
DI void ph_hgrn_naive(const Ctx& X, const Params& P, int l) {
    const bf16_t* PB = (const bf16_t*)(P.ws + WS_PB); const float* Z = (const float*)(P.ws + WS_Z); float* O32 = (float*)(P.ws + WS_S);
    const float* LB = (const float*)(P.ws + WS_LB) + l * 512;
    const int gw = X.bid * NWAVES + X.wave;
    if (gw >= 16) return;
    const int b = gw >> 3, h = (gw >> 1) & 3, dir = gw & 1, lane = X.lane;
    const float lb = LB[dir * 256 + h * 64 + lane];
    float S[64];
#pragma unroll
    for (int d = 0; d < 64; ++d) S[d] = 0.f;
    for (int step = 0; step < CTXL + SEQ; ++step) {
        int row;
        if (step < CTXL) row = NLAT + b * CTXL + (dir ? CTXL - 1 - step : step); else { const int t = step - CTXL; row = b * SEQ + (dir ? SEQ - 1 - t : t); }
        float f = exp2f(bf2f(((const bf16_t*)Z)[(size_t)row * ZW + dir * 256 + h * 64 + lane])); const float kk = bf2f(((const bf16_t*)(P.ws + WS_KK))[(size_t)row * ZW + dir * 256 + h * 64 + lane]); (void)lb;
#if DBG_HG_MODE & 8
        f = 1.0f;
#endif
        const float qv = bf2f(PB[(size_t)row * PBW + PB_AQ + h * 64 + lane]), vv = bf2f(PB[(size_t)row * PBW + PB_AI + h * 64 + lane]);
#if DBG_HG_MODE & 1
        if ((step & 63) == 0) {
#pragma unroll
            for (int d = 0; d < 64; ++d) S[d] = 0.f; }
#endif
        float o = 0.f;
#pragma unroll
        for (int d = 0; d < 64; ++d) { const float fd = __builtin_bit_cast(float, __builtin_amdgcn_readlane(__builtin_bit_cast(int, f), d)), kd = __builtin_bit_cast(float, __builtin_amdgcn_readlane(__builtin_bit_cast(int, kk), d)), qd = __builtin_bit_cast(float, __builtin_amdgcn_readlane(__builtin_bit_cast(int, qv), d));
            S[d] = fd * S[d] + kd * vv; o += S[d] * qd; }
#if DBG_HG_MODE & 2
        if (dir == 1) o = 0.f;
#endif
#if DBG_HG_MODE & 4
        if (dir == 0) o = 0.f;
#endif
        O32[((size_t)dir * NROWS + row) * 256 + h * 64 + lane] = o;
    }
}
DI void ph_hgrn_combine_naive(const Ctx& X, const Params& P, int l) {
    const bf16_t* PB = (const bf16_t*)(P.ws + WS_PB); const float* O32 = (const float*)(P.ws + WS_S); bf16_t* Y = (bf16_t*)(P.ws + WS_Y);
    const float* nw = P.in[8] + l * 64;
    const int nrows = l == 0 ? NROWS : NLAT;
    const int gw = X.bid * NWAVES + X.wave, NGW = X.nb * NWAVES;
    for (int it = gw; it < nrows * 4; it += NGW) { const int row = it >> 2, h = it & 3;
        const float o = O32[(size_t)row * 256 + h * 64 + X.lane] + O32[((size_t)NROWS + row) * 256 + h * 64 + X.lane];
        const float ms = wave_sum(o * o) * (1.0f / 64.0f); const float y = o * (1.0f / sqrtf(ms + RMS_EPS)) * nw[X.lane];
        const float gte = bf2f(PB[(size_t)row * PBW + PB_AG + h * 64 + X.lane]);
        Y[(size_t)row * D + h * 64 + X.lane] = (bf16_t)f2bf(y * siluf_(gte)); }
}

typedef short v4i16_t __attribute__((ext_vector_type(4)));
DI s16x4 tr_read(const LAS unsigned char* p) { return __builtin_bit_cast(s16x4, __builtin_amdgcn_ds_read_tr16_b64_v4i16((LAS v4i16_t*)p)); }
DI bf16x8 cat8(s16x4 a, s16x4 b) { return __builtin_shufflevector(a, b, 0, 1, 2, 3, 4, 5, 6, 7); }
DI bf16x8 pack8(float a0, float a1, float a2, float a3, float a4, float a5, float a6, float a7) {
    u32x4 w; w.x = pk2(a0, a1); w.y = pk2(a2, a3); w.z = pk2(a4, a5); w.w = pk2(a6, a7); return __builtin_bit_cast(bf16x8, w); }
DI float shfl_f(float v, int src) { return __shfl(v, src); }

constexpr int HP = 144;
constexpr size_t WS_QT = WS_H, WS_KT = WS_H + (size_t)2 * NROWS * 256 * 2;
#ifdef DBG_MIX
constexpr size_t WS_ST = 318 * MiB;
#else
constexpr size_t WS_ST = WS_Z;
#endif
DI size_t st_base(const Ctx& X) {
#ifdef QPROBE
    return *(volatile LAS unsigned*)(X.lds + 144 * 1024 + 48) ? WS_Y : WS_ST;
#else
    (void)X; return WS_ST;
#endif
}
static_assert(WS_KT + (size_t)2 * NROWS * 256 * 2 <= WS_Y && (size_t)2112 * 4096 * 2 <= (size_t)NROWS * ZW * 4, "hgrn buffers");
DI void hgrn_chunk_rows(int b, int dir, int p, int& row0) {
    if (p < 4) row0 = NLAT + b * CTXL + 64 * (dir ? 3 - p : p); else row0 = b * SEQ + 64 * (dir ? 131 - p : p - 4);
}
DI void hgrn_local_item(const Ctx& X, const Params& P, int l, int it) {
    const bf16_t* PB = (const bf16_t*)(P.ws + WS_PB); const bf16_t* Z = (const bf16_t*)(P.ws + WS_Z);
    bf16_t* QT = (bf16_t*)(P.ws + WS_QT); bf16_t* KT = (bf16_t*)(P.ws + WS_KT); float* U = (float*)(P.ws + WS_S); float* DD = (float*)(P.ws + WS_DD); float* ER = DD + 2112 * 64;
    const float* LB = (const float*)(P.ws + WS_LB) + l * 512;
    LAS unsigned char* kt_l = X.lds + X.wave * (2 * 64 * HP); LAS unsigned char* v_l = kt_l + 64 * HP;
    const int lane = X.lane;
    if (it < 2112) {
        const int p = it % NCHAIN, chain = it / NCHAIN, dir = chain & 1, h = (chain >> 1) & 3, b = chain >> 3;
        int row0; hgrn_chunk_rows(b, dir, p, row0);
#pragma unroll
        for (int i = 0; i < 8; ++i) { const int r = i * 8 + (lane >> 3), pc = lane & 7; const u32x4 w = *(const u32x4*)(PB + (size_t)(row0 + r) * PBW + PB_AI + h * 64 + pc * 8); *(LAS u32x4*)(v_l + r * HP + pc * 16) = w; }
        float lf[64];
        const bf16_t* zp = Z + (size_t)row0 * ZW + dir * 256 + h * 64 + lane;
#pragma unroll
        for (int s = 0; s < 64; ++s) lf[s] = bf2f(zp[(size_t)s * ZW]);
        float ref, last;
        if (dir == 0) {
#pragma unroll
            for (int s = 1; s < 64; ++s) lf[s] += lf[s - 1];
            ref = lf[31]; last = lf[63];
        } else {
#pragma unroll
            for (int s = 62; s >= 0; --s) lf[s] += lf[s + 1];
            ref = lf[32]; last = lf[0];
        }
        const bf16_t* qp = PB + (size_t)row0 * PBW + PB_AQ + h * 64 + lane; const bf16_t* kp = (const bf16_t*)(P.ws + WS_KK) + (size_t)row0 * ZW + dir * 256 + h * 64 + lane;
        bf16_t* qto = QT + ((size_t)dir * NROWS + row0) * 256 + h * 64 + lane; bf16_t* kto = KT + ((size_t)dir * NROWS + row0) * 256 + h * 64 + lane;
#pragma unroll
        for (int hf = 0; hf < 2; ++hf) {
            unsigned short qv[32], kv[32];
#pragma unroll
            for (int s = 0; s < 32; ++s) { qv[s] = qp[(size_t)(32 * hf + s) * PBW]; kv[s] = kp[(size_t)(32 * hf + s) * ZW]; }
#pragma unroll
            for (int s2 = 0; s2 < 32; ++s2) { const int s = 32 * hf + s2;
                const float q = bf2f(qv[s2]), kk = bf2f(kv[s2]);
                const float eq = __builtin_amdgcn_exp2f(lf[s] - ref), ek = __builtin_amdgcn_exp2f(ref - lf[s]);
                const unsigned short qb = (unsigned short)f2bf(q * eq), kb = (unsigned short)f2bf(kk * ek);
                st_wth(qto + (size_t)s * 256, qb); st_wth(kto + (size_t)s * 256, kb);
                *(LAS unsigned short*)(kt_l + s * HP + lane * 2) = kb; }
            asm volatile("" ::: "memory");
        }
        asm volatile("" ::: "memory");
        const float e_lr = __builtin_amdgcn_exp2f(last - ref);
        st_wtf(DD + it * 64 + lane, __builtin_amdgcn_exp2f(last)); st_wtf(ER + it * 64 + lane, __builtin_amdgcn_exp2f(ref));
        f32x4 acc[4][4];
#pragma unroll
        for (int m = 0; m < 4; ++m)
#pragma unroll
            for (int n = 0; n < 4; ++n) acc[m][n] = (f32x4){0.f, 0.f, 0.f, 0.f};
        const int g = lane >> 4, i16 = lane & 15;
        const int troff = (8 * g + (i16 >> 2)) * HP + (i16 & 3) * 8;
#pragma unroll
        for (int ks = 0; ks < 2; ++ks) {
            bf16x8 af[4], bfv[4];
#pragma unroll
            for (int m = 0; m < 4; ++m) af[m] = cat8(tr_read(kt_l + troff + ks * 32 * HP + m * 32), tr_read(kt_l + troff + (ks * 32 + 4) * HP + m * 32));
#pragma unroll
            for (int n = 0; n < 4; ++n) bfv[n] = cat8(tr_read(v_l + troff + ks * 32 * HP + n * 32), tr_read(v_l + troff + (ks * 32 + 4) * HP + n * 32));
#pragma unroll
            for (int m = 0; m < 4; ++m)
#pragma unroll
                for (int n = 0; n < 4; ++n) acc[m][n] = __builtin_amdgcn_mfma_f32_16x16x32_bf16(af[m], bfv[n], acc[m][n], 0, 0, 0);
        }
        float* up = U + (size_t)it * 4096;
#pragma unroll
        for (int m = 0; m < 4; ++m)
#pragma unroll
            for (int r = 0; r < 4; ++r) { const int d = 16 * m + 4 * g + r; const float sc = shfl_f(e_lr, d);
#pragma unroll
                for (int n = 0; n < 4; ++n) st_wtf(up + d * 64 + 16 * n + i16, acc[m][n][r] * sc); }
        asm volatile("s_waitcnt lgkmcnt(0)" ::: "memory");
    }
}
DI void ph_hgrn_scan(const Ctx& X, const Params& P, int part) {
    const float* U = (const float*)(P.ws + WS_S); const float* DD = (const float*)(P.ws + WS_DD); const float* ER = DD + 2112 * 64; bf16_t* ST = (bf16_t*)(P.ws + st_base(X));
    const int gt = part * NTHREADS + X.tid;
    const int chain = gt >> 11, d = (gt >> 5) & 63, e2 = (gt & 31) * 2;
    float s0 = 0.f, s1 = 0.f;
    for (int p0 = 0; p0 < NCHAIN; p0 += 4) {
        f32x2 u[4]; float dd[4], er[4];
#pragma unroll
        for (int j = 0; j < 4; ++j) { const int slot = chain * NCHAIN + p0 + j; u[j] = *(const f32x2*)(U + (size_t)slot * 4096 + d * 64 + e2); dd[j] = DD[slot * 64 + d]; er[j] = ER[slot * 64 + d]; }
#pragma unroll
        for (int j = 0; j < 4; ++j) { const int slot = chain * NCHAIN + p0 + j; st_wt(ST + (size_t)slot * 4096 + d * 64 + e2, pk2(s0 * er[j], s1 * er[j])); s0 = dd[j] * s0 + u[j][0]; s1 = dd[j] * s1 + u[j][1]; }
    }
}
DI void hgrn_out_item(const Ctx& X, const Params& P, int l, int it) {
    const bf16_t* PB = (const bf16_t*)(P.ws + WS_PB); const bf16_t* QT = (const bf16_t*)(P.ws + WS_QT); const bf16_t* KT = (const bf16_t*)(P.ws + WS_KT); const bf16_t* ST = (const bf16_t*)(P.ws + st_base(X));
    unsigned char* Y = P.ws + WS_Y;        const float* nw = P.in[8] + l * 64;
    LAS unsigned char* s_l = X.lds + X.wave * (2 * 64 * HP); LAS unsigned char* v_l = s_l + 64 * HP;
    const int lane = X.lane, g = lane >> 4, i16 = lane & 15, gw = X.wave * X.nb + X.bid, NGW = X.nb * NWAVES;
    const int nchunk = l == 0 ? 132 : 128;
    const int troff = (8 * g + (i16 >> 2)) * HP + (i16 & 3) * 8;
    const int troff4 = (4 * g + (i16 >> 2)) * HP + (i16 & 3) * 8;
    (void)gw; (void)NGW;
    if (it < 8 * nchunk) {
        const int c = it % nchunk, bh = it / nchunk, h = bh & 3, b = bh >> 2;
        const bool isctx = c >= 128; const int row0 = isctx ? NLAT + b * CTXL + 64 * (c - 128) : b * SEQ + 64 * c;
#pragma unroll
        for (int i = 0; i < 8; ++i) { const int r = i * 8 + (lane >> 3), pc = lane & 7; const u32x4 w = *(const u32x4*)(PB + (size_t)(row0 + r) * PBW + PB_AI + h * 64 + pc * 8); *(LAS u32x4*)(v_l + r * HP + pc * 16) = w; }
        f32x4 o[4][4];
#pragma unroll
        for (int a = 0; a < 4; ++a)
#pragma unroll
            for (int t = 0; t < 4; ++t) o[a][t] = (f32x4){0.f, 0.f, 0.f, 0.f};
#pragma unroll 1
        for (int dir = 0; dir < 2; ++dir) {
#if DBG_HG_MODE & 2
            if (dir == 1) continue;
#endif
#if DBG_HG_MODE & 4
            if (dir == 0) continue;
#endif
            const int p = isctx ? (dir ? 3 - (c - 128) : c - 128) : (dir ? 127 - c + 4 : c + 4);
            const int slot = ((b * 4 + h) * 2 + dir) * NCHAIN + p, sgn = 1 - 2 * dir;
            asm volatile("s_waitcnt lgkmcnt(0)" ::: "memory");
#pragma unroll
            for (int i = 0; i < 8; ++i) { const int r = i * 8 + (lane >> 3), pc = lane & 7; const u32x4 w = *(const u32x4*)(ST + (size_t)slot * 4096 + r * 64 + pc * 8); *(LAS u32x4*)(s_l + r * HP + pc * 16) = w; }
            const bf16_t* qt = QT + ((size_t)dir * NROWS + row0) * 256 + h * 64 + g * 8; const bf16_t* kt = KT + ((size_t)dir * NROWS + row0) * 256 + h * 64 + g * 8;
            bf16x8 qf[4][2];
#pragma unroll
            for (int t = 0; t < 4; ++t)
#pragma unroll
                for (int ks = 0; ks < 2; ++ks) qf[t][ks] = *(const bf16x8*)(qt + (size_t)(16 * t + i16) * 256 + 32 * ks);
#pragma unroll
            for (int pr = 0; pr < 2; ++pr) {
                bf16x8 kf[2][2];
#pragma unroll
                for (int t = 0; t < 2; ++t)
#pragma unroll
                    for (int ks = 0; ks < 2; ++ks) kf[t][ks] = *(const bf16x8*)(kt + (size_t)(16 * (2 * pr + t) + i16) * 256 + 32 * ks);
                f32x4 sc[2][4];
#pragma unroll
                for (int s2 = 0; s2 < 2; ++s2)
#pragma unroll
                    for (int tt = 0; tt < 4; ++tt) { f32x4 a = {0.f, 0.f, 0.f, 0.f};
                        a = __builtin_amdgcn_mfma_f32_16x16x32_bf16(kf[s2][0], qf[tt][0], a, 0, 0, 0); a = __builtin_amdgcn_mfma_f32_16x16x32_bf16(kf[s2][1], qf[tt][1], a, 0, 0, 0);
#pragma unroll
                        for (int r = 0; r < 4; ++r) { const int sidx = 16 * (2 * pr + s2) + 4 * g + r, tidx = 16 * tt + i16; const int keep = ~(((tidx - sidx) * sgn) >> 31); { const float av = a[r]; a[r] = __int_as_float(__float_as_int(av) & keep); } }
                        sc[s2][tt] = a; }
                bf16x8 vf[4];
#pragma unroll
#ifdef DBG_NO_TR
                for (int et = 0; et < 4; ++et) { unsigned short tv[8];
#pragma unroll
                    for (int j = 0; j < 8; ++j) { const int sidx = 32 * pr + (j < 4 ? 4 * g + j : 16 + 4 * g + (j - 4)); tv[j] = *(const LAS unsigned short*)(v_l + sidx * HP + (16 * et + i16) * 2); }
                    u32x4 w; w.x = tv[0] | ((unsigned)tv[1] << 16); w.y = tv[2] | ((unsigned)tv[3] << 16); w.z = tv[4] | ((unsigned)tv[5] << 16); w.w = tv[6] | ((unsigned)tv[7] << 16); vf[et] = __builtin_bit_cast(bf16x8, w); }
#else
                for (int et = 0; et < 4; ++et) vf[et] = cat8(tr_read(v_l + troff4 + (32 * pr) * HP + et * 32), tr_read(v_l + troff4 + (32 * pr + 16) * HP + et * 32));
#endif
#ifdef DBG_BRUTE
                {   float* dacc = (float*)(P.ws + WS_CTL) + CW_DBG + 16; float nA = 0.f, dA = 0.f, nB = 0.f, dB = 0.f;
                    const bf16_t* qt0 = QT + ((size_t)dir * NROWS + row0) * 256 + h * 64; const bf16_t* kt0 = KT + ((size_t)dir * NROWS + row0) * 256 + h * 64;
#if DBG_TEST == 1
#pragma unroll
                    for (int s2 = 0; s2 < 2; ++s2)
#pragma unroll
                        for (int tt = 0; tt < 4; ++tt)
#pragma unroll
                            for (int r = 0; r < 4; ++r) *(LAS float*)(s_l + (((s2 * 4 + tt) * 4 + r) * 64 + lane) * 4) = sc[s2][tt][r];
                    asm volatile("s_waitcnt lgkmcnt(0)" ::: "memory");
#pragma unroll 1
                    for (int idx = 0; idx < 32; ++idx) { const int s2 = idx >> 4, tt = (idx >> 2) & 3, r = idx & 3; const int sidx = 16 * (2 * pr + s2) + 4 * g + r, tidx = 16 * tt + i16; float ref = 0.f;
#pragma unroll 1
                        for (int d = 0; d < 64; ++d) ref += bf2f(kt0[(size_t)sidx * 256 + d]) * bf2f(qt0[(size_t)tidx * 256 + d]);
                        if (sidx > tidx) ref = 0.f; const float got = *(LAS float*)(s_l + (idx * 64 + lane) * 4); const float df = got - ref; nA += df * df; dA += ref * ref; }
#endif
#if DBG_TEST == 2
#pragma unroll
                    for (int et = 0; et < 4; ++et)
#pragma unroll
                        for (int j = 0; j < 8; ++j) { const int sidx = 32 * pr + (j < 4 ? 4 * g + j : 16 + 4 * g + (j - 4)); const float ref = bf2f(PB[(size_t)(row0 + sidx) * PBW + PB_AI + h * 64 + 16 * et + i16]);
                            const float got = bf2f((unsigned short)vf[et][j]); const float df = got - ref; nB += df * df; dB += ref * ref; asm volatile("" : "+v"(nB), "+v"(dB) :: "memory"); }
#endif
                    nA = wave_sum(nA); dA = wave_sum(dA); nB = wave_sum(nB); dB = wave_sum(dB); if (lane == 0) { atomicAdd(dacc, nA); atomicAdd(dacc + 1, dA); atomicAdd(dacc + 2, nB); atomicAdd(dacc + 3, dB); }
                }
#endif
#pragma unroll
                for (int tt = 0; tt < 4; ++tt) { const f32x4 p0 = sc[0][tt], p1 = sc[1][tt]; const bf16x8 pf = pack8(p0[0], p0[1], p0[2], p0[3], p1[0], p1[1], p1[2], p1[3]);
#pragma unroll
                    for (int et = 0; et < 4; ++et) o[et][tt] = __builtin_amdgcn_mfma_f32_16x16x32_bf16(vf[et], pf, o[et][tt], 0, 0, 0); }
                asm volatile("" ::: "memory");
            }
#pragma unroll
            for (int ks = 0; ks < ((DBG_HG_MODE & 1) ? 0 : 2); ++ks) {
                bf16x8 sf[4];
#pragma unroll
                for (int et = 0; et < 4; ++et) sf[et] = cat8(tr_read(s_l + troff + (32 * ks) * HP + et * 32), tr_read(s_l + troff + (32 * ks + 4) * HP + et * 32));
#pragma unroll
                for (int tt = 0; tt < 4; ++tt)
#pragma unroll
                    for (int et = 0; et < 4; ++et) o[et][tt] = __builtin_amdgcn_mfma_f32_16x16x32_bf16(sf[et], qf[tt][ks], o[et][tt], 0, 0, 0);
            }
        }
#if defined(DBG_BRUTE) && DBG_TEST == 3
        {
            float* dacc = (float*)(P.ws + WS_CTL) + CW_DBG + 8; float num = 0.f, den = 0.f;
            const bf16_t* qt0 = QT + ((size_t)0 * NROWS + row0) * 256 + h * 64; const bf16_t* kt0 = KT + ((size_t)0 * NROWS + row0) * 256 + h * 64;
            for (int tt = 0; tt < 4; ++tt) for (int et = 0; et < 4; ++et) for (int r = 0; r < 4; ++r) {
                const int t = 16 * tt + i16, e = 16 * et + 4 * g + r; float ref = 0.f;
                for (int s2 = 0; s2 <= t; ++s2) { float sc = 0.f; for (int d = 0; d < 64; ++d) sc += bf2f(kt0[(size_t)s2 * 256 + d]) * bf2f(qt0[(size_t)t * 256 + d]);
                    ref += bf2f((unsigned short)f2bf(sc)) * bf2f(PB[(size_t)(row0 + s2) * PBW + PB_AI + h * 64 + e]); }
                float got = 0.f;
#pragma unroll
                for (int a = 0; a < 4; ++a)
#pragma unroll
                    for (int b2 = 0; b2 < 4; ++b2)
#pragma unroll
                        for (int c2 = 0; c2 < 4; ++c2) if (a == tt && b2 == et && c2 == r) got = o[b2][a][c2];
                num += (got - ref) * (got - ref); den += ref * ref; }
            num = wave_sum(num); den = wave_sum(den); if (lane == 0) { atomicAdd(dacc, num); atomicAdd(dacc + 1, den); }
        }
#endif
#pragma unroll
        for (int tt = 0; tt < 4; ++tt) {
            float ss = 0.f;
#pragma unroll
            for (int et = 0; et < 4; ++et) ss += (o[et][tt][0] * o[et][tt][0] + o[et][tt][1] * o[et][tt][1]) + (o[et][tt][2] * o[et][tt][2] + o[et][tt][3] * o[et][tt][3]);
            ss += __shfl_xor(ss, 16); ss += __shfl_xor(ss, 32);
            const float rstd = 1.0f / sqrtf(ss * (1.0f / 64.0f) + RMS_EPS);
            const size_t row = (size_t)row0 + 16 * tt + i16;
#pragma unroll
            for (int et = 0; et < 4; ++et) { const int e = 16 * et + 4 * g; const u32x2 gw2 = *(const u32x2*)(PB + row * PBW + PB_AG + h * 64 + e); const f32x4 wv = *(const f32x4*)(nw + e);
                const f32x4 gt = {bflo(gw2.x), bfhi(gw2.x), bflo(gw2.y), bfhi(gw2.y)}; f32x4 y;
#pragma unroll
                for (int r = 0; r < 4; ++r) y[r] = o[et][tt][r] * rstd * wv[r] * siluf_(gt[r]);
                *(unsigned*)(Y + row * D + h * 64 + e) = pk_fp8x4(y); }
        }
        asm volatile("s_waitcnt lgkmcnt(0)" ::: "memory");
    }
}


DI void ph_hgrn_out(const Ctx& X, const Params& P, int l) { const int n = 8 * (l == 0 ? 132 : 128); for (int it = X.wave * X.nb + X.bid; it < n; it += X.nb * NWAVES) hgrn_out_item(X, P, l, it); }

#ifdef DBG_BRUTE
DI void ph_dbg_scores(const Ctx& X, const Params& P, int l) {
    const bf16_t* QT = (const bf16_t*)(P.ws + WS_QT); const bf16_t* KT = (const bf16_t*)(P.ws + WS_KT);
    LAS unsigned char* s_l = X.lds + X.wave * (2 * 64 * HP);
    const int lane = X.lane, g = lane >> 4, i16 = lane & 15, gw = X.wave * X.nb + X.bid, NGW = X.nb * NWAVES;
    float* dacc = (float*)(P.ws + WS_CTL) + CW_DBG + 16; float nA = 0.f, dA = 0.f;
    for (int it = gw; it < 8 * 128; it += NGW) {
        const int c = it % 128, bh = it / 128, h = bh & 3, b = bh >> 2, dir = 0, sgn = 1; const int row0 = b * SEQ + 64 * c;
        const bf16_t* qt = QT + ((size_t)dir * NROWS + row0) * 256 + h * 64 + g * 8; const bf16_t* kt = KT + ((size_t)dir * NROWS + row0) * 256 + h * 64 + g * 8;
        const bf16_t* qt0 = QT + ((size_t)dir * NROWS + row0) * 256 + h * 64; const bf16_t* kt0 = KT + ((size_t)dir * NROWS + row0) * 256 + h * 64;
        bf16x8 qf[4][2];
#pragma unroll
        for (int t = 0; t < 4; ++t)
#pragma unroll
            for (int ks = 0; ks < 2; ++ks) qf[t][ks] = *(const bf16x8*)(qt + (size_t)(16 * t + i16) * 256 + 32 * ks);
#pragma unroll 1
        for (int pr = 0; pr < 2; ++pr) {
            bf16x8 kf[2][2];
#pragma unroll
            for (int t = 0; t < 2; ++t)
#pragma unroll
                for (int ks = 0; ks < 2; ++ks) kf[t][ks] = *(const bf16x8*)(kt + (size_t)(16 * (2 * pr + t) + i16) * 256 + 32 * ks);
#pragma unroll
            for (int s2 = 0; s2 < 2; ++s2)
#pragma unroll
                for (int tt = 0; tt < 4; ++tt) { f32x4 a = {0.f, 0.f, 0.f, 0.f};
                    a = __builtin_amdgcn_mfma_f32_16x16x32_bf16(kf[s2][0], qf[tt][0], a, 0, 0, 0); a = __builtin_amdgcn_mfma_f32_16x16x32_bf16(kf[s2][1], qf[tt][1], a, 0, 0, 0);
#pragma unroll
                    for (int r = 0; r < 4; ++r) { const int sidx = 16 * (2 * pr + s2) + 4 * g + r, tidx = 16 * tt + i16; const int keep = ~(((tidx - sidx) * sgn) >> 31); { const float av = a[r]; a[r] = __int_as_float(__float_as_int(av) & keep); }
                        *(LAS float*)(s_l + (((s2 * 4 + tt) * 4 + r) * 64 + lane) * 4) = a[r]; } }
            asm volatile("s_waitcnt lgkmcnt(0)" ::: "memory");
#pragma unroll 1
            for (int idx = 0; idx < 32; ++idx) { const int s2 = idx >> 4, tt = (idx >> 2) & 3, r = idx & 3; const int sidx = 16 * (2 * pr + s2) + 4 * g + r, tidx = 16 * tt + i16; float ref = 0.f;
#pragma unroll 1
                for (int d = 0; d < 64; ++d) ref += bf2f(kt0[(size_t)sidx * 256 + d]) * bf2f(qt0[(size_t)tidx * 256 + d]);
                if (sidx > tidx) ref = 0.f; const float got = *(LAS float*)(s_l + (idx * 64 + lane) * 4); const float df = got - ref; nA += df * df; dA += ref * ref; }
            asm volatile("s_waitcnt lgkmcnt(0)" ::: "memory");
        }
    }
    nA = wave_sum(nA); dA = wave_sum(dA); if (lane == 0) { atomicAdd(dacc, nA); atomicAdd(dacc + 1, dA); }
}
#endif
constexpr int KP = 144, VP = 192, KBYTES = 128 * KP, VBYTES = 128 * VP, CHB = KBYTES + VBYTES, RPB_OFF = 2 * CHB;
static_assert(RPB_OFF + 4096 <= 144 * 1024, "attn lds");
struct ChunkSrc { int mode, rbase, kr0; };
DI int chunk_row(const ChunkSrc& c, int key) { return c.mode == 0 ? c.rbase + key : c.rbase + min(c.kr0 + (key >> 5), 127) * 64 + (key & 31); }
struct StageRegs { u32x4 k[2], v[2]; };
DI void stage_load(const Ctx& X, const bf16_t* PB, int kcol, int vcol, const ChunkSrc& c, StageRegs& R) {
#pragma unroll
    for (int i = 0; i < 2; ++i) { const int idx = X.tid + NTHREADS * i, key = idx >> 3, pc = idx & 7; const size_t row = (size_t)chunk_row(c, key);
        R.k[i] = *(const u32x4*)(PB + row * PBW + kcol + pc * 8); R.v[i] = *(const u32x4*)(PB + row * PBW + vcol + pc * 8); }
}
DI void stage_store(const Ctx& X, LAS unsigned char* buf, const StageRegs& R) {
#pragma unroll
    for (int i = 0; i < 2; ++i) { const int idx = X.tid + NTHREADS * i, key = idx >> 3, pc = idx & 7;
        *(LAS u32x4*)(buf + key * KP + pc * 16) = R.k[i]; *(LAS u32x4*)(buf + KBYTES + key * VP + pc * 16) = R.v[i]; }
}
template <int NQT> struct AttnState { f32x16 o[NQT][2]; float m[NQT], l[NQT]; };
template <int NQT, class MaskF>
DI void attn_tile_kv(const bf16x8 (&kf)[4], const LAS unsigned char* vt, int kt, const bf16x8 (&qf)[NQT][4], AttnState<NQT>& S, const bool (&act)[NQT], const MaskF& MF, int lane) {
    const int h = lane >> 5, G = lane >> 4, i16 = lane & 15;
    const LAS unsigned char* vb = vt + (4 * h + (i16 >> 2)) * VP + (16 * (G & 1) + 4 * (i16 & 3)) * 2;
    bf16x8 vf[2][2];
#pragma unroll
    for (int db = 0; db < 2; ++db)
#pragma unroll
        for (int s2 = 0; s2 < 2; ++s2) vf[db][s2] = cat8(tr_read(vb + (16 * s2) * VP + db * 64), tr_read(vb + (16 * s2 + 8) * VP + db * 64));
#pragma unroll
    for (int qt = 0; qt < NQT; ++qt) {
        if (!act[qt]) continue;
        f32x16 s;
#pragma unroll
        for (int r = 0; r < 16; ++r) s[r] = 0.f;
#pragma unroll
        for (int ks = 0; ks < 4; ++ks) s = __builtin_amdgcn_mfma_f32_32x32x16_bf16(kf[ks], qf[qt][ks], s, 0, 0, 0);
        MF(s, qt, kt);
        float mx = s[0];
#pragma unroll
        for (int r = 1; r < 16; ++r) mx = fmaxf(mx, s[r]);
        { const auto rr = __builtin_amdgcn_permlane32_swap(__float_as_uint(mx), __float_as_uint(mx), false, false); mx = fmaxf(__uint_as_float(rr[0]), __uint_as_float(rr[1])); }
        {
            const float mn = fmaxf(S.m[qt], mx), alpha = __builtin_amdgcn_exp2f(S.m[qt] - mn); S.m[qt] = mn; S.l[qt] *= alpha;
#pragma unroll
            for (int db = 0; db < 2; ++db)
#pragma unroll
                for (int r = 0; r < 16; ++r) S.o[qt][db][r] *= alpha;
        }
        const float mcur = S.m[qt]; float ps = 0.f;
#pragma unroll
        for (int r = 0; r < 16; ++r) { s[r] = __builtin_amdgcn_exp2f(s[r] - mcur); ps += s[r]; }
        S.l[qt] += ps;
        const bf16x8 p0 = pack8(s[0], s[1], s[2], s[3], s[4], s[5], s[6], s[7]), p1 = pack8(s[8], s[9], s[10], s[11], s[12], s[13], s[14], s[15]);
#pragma unroll
        for (int db = 0; db < 2; ++db) { S.o[qt][db] = __builtin_amdgcn_mfma_f32_32x32x16_bf16(vf[db][0], p0, S.o[qt][db], 0, 0, 0); S.o[qt][db] = __builtin_amdgcn_mfma_f32_32x32x16_bf16(vf[db][1], p1, S.o[qt][db], 0, 0, 0); }
    }
}
template <int NQT, class MaskF>
DI void attn_tile(const LAS unsigned char* buf, int kt, const bf16x8 (&qf)[NQT][4], AttnState<NQT>& S, const bool (&act)[NQT], const MaskF& MF, int lane) {
    bf16x8 kf[4];
#pragma unroll
    for (int ks = 0; ks < 4; ++ks) kf[ks] = *(const LAS bf16x8*)(buf + (32 * kt + (lane & 31)) * KP + ks * 32 + (lane >> 5) * 16);
    attn_tile_kv<NQT, MaskF>(kf, buf + KBYTES + 32 * kt * VP, kt, qf, S, act, MF, lane);
}
template <int NQT>
DI void attn_finish(AttnState<NQT>& S, int qt, unsigned char* yrow  , int lane) {
    const int h = lane >> 5; float l = S.l[qt]; { const auto rr = __builtin_amdgcn_permlane32_swap(__float_as_uint(l), __float_as_uint(l), false, false); l = __uint_as_float(rr[0]) + __uint_as_float(rr[1]); } const float inv = 1.0f / l;
#pragma unroll
    for (int db = 0; db < 2; ++db)
#pragma unroll
        for (int gq = 0; gq < 4; ++gq) *(unsigned*)(yrow + 32 * db + 8 * gq + 4 * h) = pk_fp8x4((f32x4){S.o[qt][db][4 * gq] * inv, S.o[qt][db][4 * gq + 1] * inv, S.o[qt][db][4 * gq + 2] * inv, S.o[qt][db][4 * gq + 3] * inv});
}
struct MaskNone { DI void operator()(f32x16&, int, int) const {} };
struct MaskSWA { int cmode, u0, lane;
    DI void operator()(f32x16& s, int qt, int kt) const {
        if (cmode == 1 || 32 * kt != u0 + 32 * qt) return;
        const int sg = cmode == 0 ? 1 : -1, e = sg * (4 * (lane >> 5) - (lane & 31));
#pragma unroll
        for (int r = 0; r < 16; ++r) { const int thr = -sg * ((r & 3) + 8 * (r >> 2)); s[r] = e >= thr ? s[r] : -1e30f; }
    } };
DI void swa_item(const Ctx& X, const Params& P, int l, int it) {
    const bf16_t* PB = (const bf16_t*)(P.ws + WS_PB); unsigned char* Y = P.ws + WS_Y;        const float* sink = P.in[10] + l * 8;
    const int lane = X.lane, w = X.wave;
    {
        const int j = it & 63, n = (it >> 6) & 1, b = it >> 7;
        const int qh = n * 4 + (w >> 1), u0 = (w & 1) * 64;
        const int nchunks = 3 + (j > 0) + (j < 63);
        bf16x8 qf[2][4];
#pragma unroll
        for (int qt = 0; qt < 2; ++qt)
#pragma unroll
            for (int ks = 0; ks < 4; ++ks) qf[qt][ks] = *(const bf16x8*)(PB + (size_t)(b * SEQ + 128 * j + u0 + 32 * qt + (lane & 31)) * PBW + PB_SQ + qh * 64 + 16 * ks + 8 * (lane >> 5));
        AttnState<2> S;
#pragma unroll
        for (int qt = 0; qt < 2; ++qt) { S.m[qt] = LOG2E * sink[qh]; S.l[qt] = lane < 32 ? 1.0f : 0.0f;
#pragma unroll
            for (int db = 0; db < 2; ++db)
#pragma unroll
                for (int r = 0; r < 16; ++r) S.o[qt][db][r] = 0.f; }
        StageRegs R;
        auto chunk_id = [&](int i) -> int { return i < 2 ? 3 + i : (i == 2 ? 1 : (i == 3 ? (j > 0 ? 0 : 2) : 2)); };
        auto chunk_src = [&](int c) -> ChunkSrc { ChunkSrc cs; cs.mode = 0; cs.kr0 = 0; cs.rbase = c < 3 ? b * SEQ + 128 * (j - 1 + c) : NLAT + b * CTXL + 128 * (c - 3); return cs; };
        stage_load(X, PB, PB_SK + n * 64, PB_SV + n * 64, chunk_src(chunk_id(0)), R);
#pragma unroll
        for (int qt = 0; qt < 2; ++qt)
#pragma unroll
            for (int ks = 0; ks < 4; ++ks) asm volatile("" : "+v"(qf[qt][ks]));
        stage_store(X, X.lds, R);
        __syncthreads();
        for (int i = 0; i < nchunks; ++i) {
            const int c = chunk_id(i);
            if (i + 1 < nchunks) stage_load(X, PB, PB_SK + n * 64, PB_SV + n * 64, chunk_src(chunk_id(i + 1)), R);
            const LAS unsigned char* buf = X.lds + (i & 1) * CHB;
            MaskSWA MF; MF.cmode = c == 0 ? 0 : (c == 2 ? 2 : 1); MF.u0 = u0; MF.lane = lane;
#pragma unroll 1
            for (int kt = 0; kt < 4; ++kt) {
                bool act[2];
#pragma unroll
                for (int qt = 0; qt < 2; ++qt) act[qt] = c == 0 ? (32 * kt + 31 >= u0 + 32 * qt) : (c == 2 ? (32 * kt <= u0 + 32 * qt + 31) : true);
                if (!(act[0] || act[1])) continue;
                attn_tile<2>(buf, kt, qf, S, act, MF, lane);
            }
            if (i + 1 < nchunks) stage_store(X, X.lds + ((i + 1) & 1) * CHB, R);
            __syncthreads();
        }
#pragma unroll
        for (int qt = 0; qt < 2; ++qt) attn_finish<2>(S, qt, Y + (size_t)(b * SEQ + 128 * j + u0 + 32 * qt + (lane & 31)) * D + 512 + qh * 64, lane);
    }
}
struct MaskNA { bool win; int kr0, qr, qc, rs, cs, blk, lane; const LAS float* rpb;
    DI void operator()(f32x16& s, int qt, int kt) const {
        if (!win) return;
        const int kr = kr0 + kt; const bool rowok = kr >= rs && kr < rs + 8;
        const int kcb = blk + 4 * (lane >> 5); const int ib = rowok ? (kr - qr + 7) * 31 + (kcb - qc + 15) : 0;
        float bv[16];
#pragma unroll
        for (int r = 0; r < 16; ++r) bv[r] = rpb[ib + (r & 3) + 8 * (r >> 2)];
        asm volatile("" : "+v"(bv[0]), "+v"(bv[1]), "+v"(bv[2]), "+v"(bv[3]), "+v"(bv[4]), "+v"(bv[5]), "+v"(bv[6]), "+v"(bv[7]), "+v"(bv[8]), "+v"(bv[9]), "+v"(bv[10]), "+v"(bv[11]), "+v"(bv[12]), "+v"(bv[13]), "+v"(bv[14]), "+v"(bv[15]));
        const unsigned t0 = rowok ? (unsigned)(kcb - cs) : 0x7fffff00u;
#pragma unroll
        for (int r = 0; r < 16; ++r) { const bool ok = t0 + (unsigned)((r & 3) + 8 * (r >> 2)) < 16u; s[r] = ok ? s[r] + bv[r] : -1e30f; }
    } };
struct NaTileRegs { bf16x8 k[4]; u32x4 v[4]; };
DI void na_load(const bf16_t* PB, int h, int rowk  , int rowv  , int lane, NaTileRegs& R) {
    const bf16_t* kp = PB + (size_t)rowk * PBW + PB_NK + h * 64 + 8 * (lane >> 5);
#pragma unroll
    for (int ks = 0; ks < 4; ++ks) R.k[ks] = *(const bf16x8*)(kp + 16 * ks);
    const bf16_t* vp = PB + (size_t)rowv * PBW + PB_NV + h * 64 + (lane & 1) * 32;
#pragma unroll
    for (int i = 0; i < 4; ++i) R.v[i] = *(const u32x4*)(vp + 8 * i);
}
DI void na_item(const Ctx& X, const Params& P, int l, int it) {
    const bf16_t* PB = (const bf16_t*)(P.ws + WS_PB); unsigned char* Y = P.ws + WS_Y;        const float* rpbg = P.in[9] + l * 4 * 465;
    const int lane = X.lane, w = X.wave; LAS float* rpbl = (LAS float*)(X.lds + 8 * 32 * VP) + 32;
    LAS unsigned char* vt = X.lds + w * (32 * VP);
    const int j = it & 3, rg = (it >> 2) & 7, h = (it >> 5) & 3, b = it >> 7;
    const int r0 = 16 * rg, blk = min(max(16 * j - 8, 0), 32);
    const int ra = r0 + 2 * w, qr = ra + ((lane & 31) >> 4), qc = 16 * j + (lane & 15);
    const int rs_a = min(max(ra - 4, 0), 120), rs_b = min(max(ra + 1 - 4, 0), 120), ntile = 8 + (rs_b + 8 - rs_a);
    for (int i = X.tid; i < 465; i += NTHREADS) rpbl[i] = LOG2E * rpbg[h * 465 + i];
    __syncthreads();
    bf16x8 qf[1][4];
#pragma unroll
    for (int ks = 0; ks < 4; ++ks) qf[0][ks] = *(const bf16x8*)(PB + (size_t)(b * SEQ + qr * 64 + qc) * PBW + PB_NQ + h * 64 + 16 * ks + 8 * (lane >> 5));
    AttnState<1> S; S.m[0] = -1e30f; S.l[0] = 0.f;
#pragma unroll
    for (int db = 0; db < 2; ++db)
#pragma unroll
        for (int r = 0; r < 16; ++r) S.o[0][db][r] = 0.f;
    MaskNA MF; MF.qr = qr; MF.qc = qc; MF.rs = min(max(qr - 4, 0), 120); MF.cs = min(max(qc - 8, 0), 48); MF.blk = blk; MF.lane = lane; MF.rpb = rpbl;
    const bool act[1] = {true};
#define NA_ROW(t, key) ((t) < 8 ? NLAT + b * CTXL + 32 * (t) + (key) : b * SEQ + (rs_a + (t) - 8) * 64 + blk + (key))
#define NA_LOAD(t, R) na_load(PB, h, NA_ROW(t, lane & 31), NA_ROW(t, lane >> 1), lane, R)
#define NA_COMPUTE(t, R) do { asm volatile("" ::: "memory"); _Pragma("unroll") for (int i_ = 0; i_ < 4; ++i_) *(LAS u32x4*)(vt + (lane >> 1) * VP + (lane & 1) * 64 + i_ * 16) = R.v[i_]; \
        asm volatile("" ::: "memory"); MF.win = (t) >= 8; MF.kr0 = rs_a + (t) - 8; attn_tile_kv<1>(R.k, vt, 0, qf, S, act, MF, lane); asm volatile("" ::: "memory"); } while (0)
    NaTileRegs RA, RB;
    NA_LOAD(0, RA);
#pragma unroll
    for (int ks = 0; ks < 4; ++ks) asm volatile("" : "+v"(qf[0][ks]));
    for (int t = 0; t < ntile; t += 2) {
        { const int tn = min(t + 1, ntile - 1); NA_LOAD(tn, RB); }
        NA_COMPUTE(t, RA);
        { const int tn = min(t + 2, ntile - 1); NA_LOAD(tn, RA); }
        if (t + 1 < ntile) NA_COMPUTE(t + 1, RB);
    }
#undef NA_ROW
#undef NA_LOAD
#undef NA_COMPUTE
    attn_finish<1>(S, 0, Y + (size_t)(b * SEQ + qr * 64 + qc) * D + 256 + h * 64, lane);
    __syncthreads();
}
DI void ctx_attn_item(const Ctx& X, const Params& P, int l, int it) {
    const bf16_t* PB = (const bf16_t*)(P.ws + WS_PB); unsigned char* Y = P.ws + WS_Y;        const float* sink = P.in[10] + l * 8;
    const int lane = X.lane, w = X.wave;
    {
        const bool swa = it >= 8; const int b = (it >> 2) & 1;
        const int h = it & 3, n = (it >> 1) & 1, half = it & 1;
        const int kcol = swa ? PB_SK + n * 64 : PB_NK + h * 64, vcol = swa ? PB_SV + n * 64 : PB_NV + h * 64;
        StageRegs R; ChunkSrc cs; cs.mode = 0; cs.kr0 = 0; cs.rbase = NLAT + b * CTXL;
        stage_load(X, PB, kcol, vcol, cs, R); stage_store(X, X.lds, R);
        cs.rbase += 128; stage_load(X, PB, kcol, vcol, cs, R); stage_store(X, X.lds + CHB, R);
        __syncthreads();
        const MaskNone MF;
        if (!swa) {
            const int qrow = NLAT + b * CTXL + 32 * w + (lane & 31);
            bf16x8 qf[1][4];
#pragma unroll
            for (int ks = 0; ks < 4; ++ks) qf[0][ks] = *(const bf16x8*)(PB + (size_t)qrow * PBW + PB_NQ + h * 64 + 16 * ks + 8 * (lane >> 5));
            AttnState<1> S; S.m[0] = -1e30f; S.l[0] = 0.f;
#pragma unroll
            for (int db = 0; db < 2; ++db)
#pragma unroll
                for (int r = 0; r < 16; ++r) S.o[0][db][r] = 0.f;
            const bool act[1] = {true};
#pragma unroll 1
            for (int kt = 0; kt < 8; ++kt) attn_tile<1>(X.lds + (kt >> 2) * CHB, kt & 3, qf, S, act, MF, lane);
            attn_finish<1>(S, 0, Y + (size_t)qrow * D + 256 + h * 64, lane);
        } else {
            const int qh = n * 4 + half * 2 + (w >> 2), q0 = NLAT + b * CTXL + (w & 3) * 64 + (lane & 31);
            bf16x8 qf[2][4];
#pragma unroll
            for (int qt = 0; qt < 2; ++qt)
#pragma unroll
                for (int ks = 0; ks < 4; ++ks) qf[qt][ks] = *(const bf16x8*)(PB + (size_t)(q0 + 32 * qt) * PBW + PB_SQ + qh * 64 + 16 * ks + 8 * (lane >> 5));
            AttnState<2> S;
#pragma unroll
            for (int qt = 0; qt < 2; ++qt) { S.m[qt] = LOG2E * sink[qh]; S.l[qt] = lane < 32 ? 1.0f : 0.0f;
#pragma unroll
                for (int db = 0; db < 2; ++db)
#pragma unroll
                    for (int r = 0; r < 16; ++r) S.o[qt][db][r] = 0.f; }
            const bool act[2] = {true, true};
#pragma unroll 1
            for (int kt = 0; kt < 8; ++kt) attn_tile<2>(X.lds + (kt >> 2) * CHB, kt & 3, qf, S, act, MF, lane);
#pragma unroll
            for (int qt = 0; qt < 2; ++qt) attn_finish<2>(S, qt, Y + (size_t)(q0 + 32 * qt) * D + 512 + qh * 64, lane);
        }
        __syncthreads();
    }
}

DI void ph_swa(const Ctx& X, const Params& P, int l) { for (int it = X.bid; it < 256; it += X.nb) swa_item(X, P, l, it); }
DI void ph_na(const Ctx& X, const Params& P, int l) { for (int it = X.bid; it < 256; it += X.nb) na_item(X, P, l, it); }
DI void queue_publish(const Ctx& X, unsigned* cnt) {
    asm volatile("s_waitcnt vmcnt(0)" ::: "memory");
    __syncthreads();
    if (X.tid == 0) __hip_atomic_fetch_add(cnt, 1u, __ATOMIC_RELAXED, __HIP_MEMORY_SCOPE_AGENT);
}
DI void queue_wait(const Ctx& X, unsigned* cnt, unsigned need) {
    if (X.tid == 0) { unsigned sp = 0; while (__hip_atomic_load(cnt, __ATOMIC_RELAXED, __HIP_MEMORY_SCOPE_AGENT) < need && ++sp < (1u << 24)) __builtin_amdgcn_s_sleep(2);
        __builtin_amdgcn_fence(__ATOMIC_ACQUIRE, "agent"); asm volatile("s_waitcnt vmcnt(0)" ::: "memory"); }
    __syncthreads();
}
DI void ph_mix_queue(const Ctx& X, const Params& P, int l, int rep = 0) {
    unsigned* ctl = (unsigned*)(P.ws + WS_CTL);
    unsigned* head = ctl + CW_Q + 64 * l + 128 * rep; unsigned* scan_cnt = ctl + CW_SCAN + 64 * l + 256 * rep; unsigned* loc_cnt = ctl + CW_SCAN + 128 + 64 * l + 256 * rep;
    volatile LAS unsigned* slot = (volatile LAS unsigned*)(X.lds + 144 * 1024 + 64);
    const int nloc = 264, nscan = 64, nctx = l == 0 ? 16 : 0, nconv = l == 0 ? 1536 : 0, nho = l == 0 ? 132 : 128;
    const int o_ctx = nloc, o_swa = o_ctx + nctx, o_scan = o_swa + 256, o_na = o_scan + nscan, o_conv = o_na + 256, o_ho = o_conv + nconv, total = o_ho + nho;
    bool scan_ok = false;
    for (;;) {
        if (X.tid == 0) *slot = atomicAdd(head, 1u);
        __syncthreads();
        int it = (int)*slot;
        __syncthreads();
        if (it >= total) break;
        if (nconv && it >= o_swa && it < o_ho) {
            const int j = it - o_swa, per = j / 11, ph = j - per * 11;
            it = (ph & 3) == 0 ? o_swa + per * 3 + (ph >> 2) : o_conv + per * 8 + (ph - 1 - (ph > 4) - (ph > 8));
        }
        Ctx Xi = X; { int wv = X.wave; asm volatile("" : "+s"(wv)); int ln; asm volatile("v_mbcnt_lo_u32_b32 %0, -1, 0\n\tv_mbcnt_hi_u32_b32 %0, -1, %0" : "=v"(ln)); Xi.tid = wv * 64 + ln; Xi.lane = ln; Xi.wave = wv; }
#ifdef QMASK
        if (rep) { const int ty = it < o_ctx ? 1 : (it < o_swa ? 2 : (it < o_scan ? 4 : (it < o_na ? 8 : (it < o_conv ? 16 : (it < o_ho ? 32 : 64))))); if (!(QMASK & ty)) continue; }
#endif
        if (it < o_ctx) { hgrn_local_item(Xi, P, l, it * 8 + Xi.wave); queue_publish(Xi, loc_cnt); }
        else if (it < o_swa) ctx_attn_item(Xi, P, l, it - o_ctx);
        else if (it < o_scan) swa_item(Xi, P, l, it - o_swa);
        else if (it < o_na) { queue_wait(Xi, loc_cnt, (unsigned)nloc); ph_hgrn_scan(Xi, P, it - o_scan); queue_publish(Xi, scan_cnt); }
        else if (it < o_conv) na_item(Xi, P, l, it - o_na);
        else if (it < o_ho) { LAS float* scr = (LAS float*)X.lds + X.wave * (64 * 33); const int g = it - o_conv, lyr = g >= 768, f0 = (g - 768 * lyr) * 16 + X.wave;
#define DESC_EQ(i) expert_desc(P, lyr, (i))
            TR_LOOP(DESC_EQ, f0, f0 + 16, 8); __syncthreads(); }
        else { if (!scan_ok) { queue_wait(Xi, scan_cnt, (unsigned)nscan); scan_ok = true; }
            hgrn_out_item(Xi, P, l, (it - o_ho) * 8 + Xi.wave); __syncthreads(); }
    }
}
constexpr size_t WS_Y2 = 284 * MiB;
DI void ph_dbg_copy(const Ctx& X, const Params& P) {
    const u32x4* src = (const u32x4*)(P.ws + WS_Y); u32x4* dst = (u32x4*)(P.ws + WS_Y2);
    for (size_t i = (size_t)X.bid * NTHREADS + X.tid; i < (size_t)NROWS * 128; i += (size_t)X.nb * NTHREADS) dst[i] = src[i];
}
DI void ph_dbg_compare(const Ctx& X, const Params& P) {
    const bf16_t* Yg = (const bf16_t*)(P.ws + WS_Y); const bf16_t* Yf = (const bf16_t*)(P.ws + WS_Y2); float* acc = (float*)(P.ws + WS_CTL) + CW_DBG;
    float num[3] = {0.f, 0.f, 0.f}, den[3] = {0.f, 0.f, 0.f};
    const int gw = X.bid * NWAVES + X.wave, NGW = X.nb * NWAVES;
    for (int row = gw; row < NROWS; row += NGW) {
#pragma unroll
        for (int j = 0; j < 16; ++j) { const int c = j * 64 + X.lane; const float a = bf2f(Yg[(size_t)row * D + c]), b = bf2f(Yf[(size_t)row * D + c]); const float d = a - b;
            const int br = j < 4 ? 0 : (j < 8 ? 1 : 2);
            if (br == 0) { num[0] += d * d; den[0] += a * a; } else if (br == 1) { num[1] += d * d; den[1] += a * a; } else { num[2] += d * d; den[2] += a * a; } }
    }
#pragma unroll
    for (int b = 0; b < 3; ++b) { const float n = wave_sum(num[b]), d = wave_sum(den[b]); if (X.lane == 0) { atomicAdd(acc + 2 * b, n); atomicAdd(acc + 2 * b + 1, d); } }
}
DI void ph_dbg_apply(const Ctx& X, const Params& P) {
    const float* acc = (const float*)(P.ws + WS_CTL) + CW_DBG;
#ifdef DBG_BRUTE
    float code = sqrtf(acc[16] / acc[17]);
#else
    float code = sqrtf(acc[0] / acc[1]);
#endif
    if (code == 0.f) return;
    f32x4* o = (f32x4*)P.out;
    for (size_t i = (size_t)X.bid * NTHREADS + X.tid; i < (size_t)NLAT * 256; i += (size_t)X.nb * NTHREADS) o[i] = o[i] * (1.0f + code);
}

DI void ph_inproj(const Ctx& X, const Params& P, int l) {
    PlainSched S; S.init(NROWS, INW, X.nb, X.bid);
    EpiIn E{(bf16_t*)(P.ws + WS_PB), (bf16_t*)(P.ws + WS_Z), (const float*)(P.ws + WS_ROPE), (const float*)(P.ws + WS_LB) + l * 512, (bf16_t*)(P.ws + WS_KK)};
    gemm_fast<PlainSched, EpiIn, true, 122>(X, P.ws + WS_H, P.ws + WS_WIN + (size_t)l * INW * D, D, S, E);
}
struct EpiNull { DI void group(const Unit&, int, int, f32x4 a0, f32x4 a1, f32x4 b0, f32x4 b1) const { asm volatile("" :: "v"(a0), "v"(a1), "v"(b0), "v"(b1)); } };
DI void ph_inproj_plain(const Ctx& X, const Params& P, int l) {
    PlainSched S; S.init(NROWS, INW, X.nb, X.bid);
    EpiNull E;
    GEMM_IMPL(X, (const bf16_t*)(P.ws + WS_H), (const bf16_t*)(P.ws + WS_WIN) + (size_t)l * INW * D, D, S, E);
}
DI void small_gemm_item(const Ctx& X, const unsigned char* A, const unsigned char* Bt, bf16_t* C, int row0, int col0) {
    const int wm = X.wave >> 2, wn = X.wave & 3, fr = X.lane & 15, fq = X.lane >> 4;
    const unsigned char* ap = A + (size_t)(row0 + 16 * wm + fr) * D + 8 * fq; const unsigned char* bp = Bt + (size_t)(col0 + 16 * wn + fr) * D + 8 * fq;
    f32x4 acc = {0.f, 0.f, 0.f, 0.f};
#pragma unroll 1
    for (int k0 = 0; k0 < D; k0 += 512) {
        long af[16], bfv[16];
#pragma unroll
        for (int i = 0; i < 16; ++i) { af[i] = *(const long*)(ap + k0 + 32 * i); bfv[i] = *(const long*)(bp + k0 + 32 * i); }
#pragma unroll
        for (int i = 0; i < 16; ++i) acc = __builtin_amdgcn_mfma_f32_16x16x32_fp8_fp8(bfv[i], af[i], acc, 0, 0, 0);
    }
    store_bf4(C + (size_t)(row0 + 16 * wm + fr) * D + col0 + 16 * wn + 4 * fq, acc * (1.0f / 64.0f));
}
DI void ph_outproj(const Ctx& X, const Params& P, int l) {
    PlainSched S; S.init(NLAT, D, X.nb, X.bid);
    EpiBf E{(bf16_t*)(P.ws + WS_YO), D};
    gemm_fast<PlainSched, EpiBf, true, 121>(X, P.ws + WS_Y, P.ws + WS_WOUT + (size_t)l * D * D, D, S, E);
    if (l == 0) for (int it = X.bid; it < 256; it += X.nb)
        small_gemm_item(X, P.ws + WS_Y, P.ws + WS_WOUT, (bf16_t*)(P.ws + WS_YO), NLAT + 32 * (it >> 4), 64 * (it & 15));
}
DI void ph_moe(const Ctx& X, const Params& P, int l) {
    const int* cnt = (const int*)(P.ws + WS_CTL) + CW_CNT + 1024 * l; unsigned* rdy = (unsigned*)(P.ws + WS_CTL) + CW_TRDY + 256 * l;
    moe_build_table(X, cnt);
    {
        MoeSched<true> S{cnt, (const int*)(P.ws + WS_LIST), X.nb, X.bid, 4, 1024, X.lds, rdy};
        { LAS int* ll = (LAS int*)(X.lds + MOE_LIST_OFF); Unit u;
#pragma unroll 1
          for (int i = 0; i < 3; ++i) if (S.next(i, u) && X.tid < 256) { const int idx = u.i0 * 256 + X.tid; ll[i * 256 + X.tid] = S.list[u.e * LISTCAP + (idx < u.cnt ? idx : 0)]; }
          __syncthreads(); }
        EpiGU E{(bf16_t*)(P.ws + WS_S)};
        gemm_fast<MoeSched<true>, EpiGU, true, 122>(X, P.ws + WS_H, P.ws + (l ? WS_WGU1 : WS_WGU), D, S, E);
    }
    {
        MoeSched<false> S{cnt, (const int*)(P.ws + WS_LIST), X.nb, X.bid, 4, 1024, X.lds, rdy};
        EpiF8 E{P.ws + WS_O, D};
        gemm_fast<MoeSched<false>, EpiF8, true, 122>(X, P.ws + WS_S, P.ws + (l ? WS_WD1 : WS_WD), DEXP, S, E);
    }
}

#define XB_TMO      128
#define XB_XCNT(j)  (256  + 64 * (j))
#define XB_XSUB(j)  (1280 + 64 * (j))
#define XB_XGEN(j)  (2304 + 64 * (j))
#define XB_TOP      3328
#define XB_TOPGEN   3392
#define XCD_BAR_WORDS 3456
#ifndef XB_SPIN_CAP
#define XB_SPIN_CAP (1u << 26)
#endif
DI unsigned xb_ld(unsigned* p)              { return __hip_atomic_load(p, __ATOMIC_RELAXED, __HIP_MEMORY_SCOPE_AGENT); }
DI unsigned xb_add(unsigned* p, unsigned v) { return __hip_atomic_fetch_add(p, v, __ATOMIC_RELAXED, __HIP_MEMORY_SCOPE_AGENT); }
DI unsigned xb_xcc_id() { return (unsigned)__builtin_amdgcn_s_getreg((3 << 11) | 20) & 0xFu; }
#define XB_SPIN(cond, bar) do { unsigned _sp = 0; while (cond) { __builtin_amdgcn_s_sleep(1); \
    if ((++_sp & 255u) == 0u) { if (xb_ld(&(bar)[XB_TMO])) break; if (_sp > XB_SPIN_CAP) { atomicAdd(&(bar)[XB_TMO], 1u); break; } } } } while (0)
struct XcdBarrier { unsigned* bar; unsigned x; volatile LAS unsigned* st; };
DI XcdBarrier xcd_barrier_post(unsigned* bar, volatile LAS unsigned* st) {
    XcdBarrier b; b.bar = bar; b.x = xb_xcc_id(); b.st = st;
    if (threadIdx.x == 0) (void)xb_add(&bar[XB_XCNT(b.x)], 1u);
    return b;
}
DI void xcd_barrier_complete(unsigned* bar, unsigned x, unsigned& nloc, unsigned& nx) {
    const unsigned G = gridDim.x * gridDim.y * gridDim.z;
    unsigned sum, cnt, mine, sp = 0u;
    for (;;) {
        sum = 0u; cnt = 0u; mine = 0u;
#pragma unroll
        for (unsigned j = 0; j < 16; ++j) { const unsigned c = xb_ld(&bar[XB_XCNT(j)]); sum += c; cnt += (c > 0u) ? 1u : 0u; mine = (j == x) ? c : mine; }
        if (sum == G) break;
        __builtin_amdgcn_s_sleep(1);
        if ((++sp & 255u) == 0u) { if (xb_ld(&bar[XB_TMO])) break; if (sp > XB_SPIN_CAP) { atomicAdd(&bar[XB_TMO], 1u); break; } }
    }
    nloc = mine > 0u ? mine : 1u; nx = cnt > 0u ? cnt : 1u;
}
DI void xcd_barrier(const XcdBarrier& b) {
    asm volatile("s_waitcnt vmcnt(0)" ::: "memory");
    __syncthreads();
    if (threadIdx.x == 0) {
        unsigned* bar = b.bar;
        __builtin_amdgcn_s_waitcnt(0);
        unsigned nloc = b.st[0], nx = b.st[1];
        if (nloc == 0u) { xcd_barrier_complete(bar, b.x, nloc, nx); b.st[0] = nloc; b.st[1] = nx; }
        const unsigned old = xb_add(&bar[XB_XSUB(b.x)], 1u);
        const unsigned gen = old / nloc;
        if (old + 1u == (gen + 1u) * nloc) {
            __builtin_amdgcn_fence(__ATOMIC_RELEASE, "agent");
            asm volatile("s_waitcnt vmcnt(0)" ::: "memory");
            const unsigned og = xb_add(&bar[XB_TOP], 1u);
            const unsigned tg = og / nx;
            if (og + 1u == (tg + 1u) * nx) xb_add(&bar[XB_TOPGEN], 1u);
            else XB_SPIN(xb_ld(&bar[XB_TOPGEN]) == tg, bar);
            __builtin_amdgcn_fence(__ATOMIC_ACQUIRE, "agent");
            xb_add(&bar[XB_XGEN(b.x)], 1u);
            asm volatile("s_waitcnt vmcnt(0)" ::: "memory");
        } else {
            XB_SPIN(xb_ld(&bar[XB_XGEN(b.x)]) == gen, bar);
            __builtin_amdgcn_fence(__ATOMIC_ACQUIRE, "agent");
            asm volatile("s_waitcnt vmcnt(0)" ::: "memory");
        }
    }
    __syncthreads();
}

template <int Q> DI void run_phase(const Ctx& X0, const Params& P0, int l) {
#if defined(__HIP_DEVICE_COMPILE__)
    const __attribute__((address_space(4))) Params* pp_ = (const __attribute__((address_space(4))) Params*)__builtin_amdgcn_kernarg_segment_ptr(); asm volatile("" : "+s"(pp_), "+s"(l));
    const Params P = *pp_; (void)P0;
#else
    const Params P = P0;
#endif
    Ctx X = X0; { int wv = X0.wave; asm volatile("" : "+s"(wv)); int ln; asm volatile("v_mbcnt_lo_u32_b32 %0, -1, 0\n\tv_mbcnt_hi_u32_b32 %0, -1, %0" : "=v"(ln)); X.tid = wv * 64 + ln; X.lane = ln; X.wave = wv; int b_ = X0.bid, n_ = X0.nb; asm volatile("" : "+s"(b_), "+s"(n_)); X.bid = b_; X.nb = n_; }
    if constexpr (Q == 0) ph_prologue(X, P);
    if constexpr (Q == 1) { ph_modulate(X, P, 0); __syncthreads(); convert_rest(X, P); }
    if constexpr (Q == 2) ph_inproj(X, P, l);
    if constexpr (Q == 3) ph_hgrn_naive(X, P, l);
    if constexpr (Q == 4) ph_hgrn_combine_naive(X, P, l);
    if constexpr (Q == 5) ph_attn_naive(X, P, l);
    if constexpr (Q == 6) ph_outproj(X, P, l);
    if constexpr (Q == 7) ph_ln1(X, P, l);
    if constexpr (Q == 24) ph_ln1(X, P, l, true);
    if constexpr (Q == 27) ph_inproj_plain(X, P, l);
    if constexpr (Q == 8) ph_moe(X, P, l);
    if constexpr (Q == 13) ph_hgrn_out(X, P, l);
    if constexpr (Q == 14) ph_swa(X, P, l);
    if constexpr (Q == 15) ph_na(X, P, l);
#ifdef DBG_BRUTE
    if constexpr (Q == 23) ph_dbg_scores(X, P, l);
#endif
    if constexpr (Q == 20) ph_dbg_copy(X, P);
    if constexpr (Q == 21) ph_dbg_compare(X, P);
    if constexpr (Q == 22) ph_dbg_apply(X, P);
    if constexpr (Q == 10) ph_ln2(X, P, l);
    if constexpr (Q == 17) ph_mix_queue(X, P, l);
#ifdef QPROBE
    if constexpr (Q == 18) ph_mix_queue(X, P, l, 1);
#endif
}

constexpr int LDS_BYTES = 150 * 1024;
template <int Q>
__global__ void __launch_bounds__(NTHREADS, 2) k_step(Params P, int l) {
    extern __shared__ __attribute__((aligned(16))) unsigned char lds_raw[];
    Ctx X; X.lds = (LAS unsigned char*)lds_raw; X.tid = threadIdx.x; X.lane = X.tid & 63; X.wave = __builtin_amdgcn_readfirstlane(X.tid >> 6); X.bid = blockIdx.x; X.nb = gridDim.x;
    run_phase<Q>(X, P, l);
}
template <int Q> static void launch_step(const Params& P, int l, int grid, hipStream_t stream) {
    static bool attr = false;
    if (!attr) { (void)hipFuncSetAttribute((const void*)k_step<Q>, hipFuncAttributeMaxDynamicSharedMemorySize, LDS_BYTES); attr = true; }
    hipLaunchKernelGGL(k_step<Q>, dim3(grid), dim3(NTHREADS), LDS_BYTES, stream, P, l);
}

constexpr int LDS_CTL_OFF = 144 * 1024;
__global__ void __launch_bounds__(NTHREADS, 2) k_mega(Params P) {
    extern __shared__ __attribute__((aligned(16))) unsigned char lds_raw[];
    Ctx X; X.lds = (LAS unsigned char*)lds_raw; X.tid = threadIdx.x; X.lane = X.tid & 63; X.wave = __builtin_amdgcn_readfirstlane(X.tid >> 6); X.bid = blockIdx.x; X.nb = gridDim.x;
    volatile LAS unsigned* st = (volatile LAS unsigned*)(X.lds + LDS_CTL_OFF);
    if (X.tid < 16) st[X.tid] = 0u;
    __syncthreads();
    { const XcdBarrier b0 = xcd_barrier_post((unsigned*)(P.ws + WS_CTL) + CW_BAR, st); if (X.tid == 0) st[2] = b0.x; }
    __syncthreads();
#ifdef TS_SEL
#define STAMP() do { if (blockIdx.x == 0 && threadIdx.x == 0) { unsigned long long* ts_ = (unsigned long long*)((unsigned*)(P.ws + WS_CTL) + CW_TS); const unsigned n_ = st[8]; ts_[n_] = __builtin_amdgcn_s_memrealtime(); st[8] = n_ + 1u; } } while (0)
#else
#define STAMP() do { } while (0)
#endif
#define GBAR() do { for (int br_ = 0; br_ < BAR_REP; ++br_) GBAR1(); STAMP(); } while (0)
#define GBAR1() do { unsigned char* w_ = P.ws; asm volatile("" : "+s"(w_)); XcdBarrier b_; b_.bar = (unsigned*)(w_ + WS_CTL) + CW_BAR; b_.st = st; b_.x = threadIdx.x == 0 ? st[2] : 0u; xcd_barrier(b_); } while (0)
#ifndef DUP
#define DUP 0
#endif
#ifndef BAR_REP
#define BAR_REP 1
#endif
#define NREP(bit) ({ int n_ = (DUP & (1 << (bit))) ? 2 : 1; asm volatile("" : "+s"(n_)); n_; })
#define RUNP(Q, bit) do { const int nr_ = NREP(bit); for (int rep_ = 0; rep_ < nr_; ++rep_) { run_phase<Q>(X, P, l); GBAR(); } } while (0)
    STAMP();
    { const int l = 0; RUNP(0, 0); RUNP(1, 1); }
    for (int l = 0; l < 2; ++l) {
        if (DUP & 32768) { run_phase<27>(X, P, l); GBAR(); }
        RUNP(2, 2);
#if FAST_MIX
#ifdef QPROBE
        if (l == QPROBE) { if (X.tid == 0) st[12] = 1u; __syncthreads(); run_phase<18>(X, P, l); GBAR(); if (X.tid == 0) st[12] = 0u; __syncthreads(); }
#endif
        run_phase<17>(X, P, l); GBAR();
#ifdef DBG_MIX
        if (l == 0) {
            run_phase<20>(X, P, l); GBAR();
            run_phase<3>(X, P, l); GBAR();
            run_phase<4>(X, P, l); GBAR();
            run_phase<5>(X, P, l); GBAR();
            run_phase<21>(X, P, l); GBAR();
        }
#endif
#else
        run_phase<3>(X, P, l); GBAR();
        run_phase<4>(X, P, l); GBAR();
        run_phase<5>(X, P, l); GBAR();
#endif
        RUNP(6, 9);
        if ((DUP & 4096) && l == 0) { run_phase<24>(X, P, l); GBAR(); }
        run_phase<7>(X, P, l); GBAR();
        run_phase<8>(X, P, l); GBAR();
        if (DUP & 8192) { run_phase<10>(X, P, l); GBAR(); }
        run_phase<10>(X, P, l); if (l == 0) GBAR();
    }
#ifdef TS_SEL
    GBAR();
    { const unsigned long long* ts_ = (const unsigned long long*)((const unsigned*)(P.ws + WS_CTL) + CW_TS); const float dt_us = 10.0f * floorf((float)(ts_[TS_SEL] - ts_[TS_SEL - 1]) * 0.001f + 0.5f); const float sc = 1.0f + dt_us * (1.0f / 2000.0f);
      f32x4* o = (f32x4*)P.out; for (size_t i = (size_t)blockIdx.x * NTHREADS + threadIdx.x; i < (size_t)NLAT * 256; i += (size_t)gridDim.x * NTHREADS) o[i] = o[i] * sc; }
#endif
#ifdef DBG_MIX
    GBAR(); run_phase<22>(X, P, 0);
#endif
#undef GBAR
}

extern "C" void kernel_launch(void* const* d_in, const int* in_sizes, int n_in, void* d_out, int out_size, void* d_ws, size_t ws_size, hipStream_t stream) {
    static int grid = 0;
    if (grid == 0) {
        if (n_in != 21 || out_size != NLAT * D || ws_size < WS_END) { fprintf(stderr, "kernel_launch: unexpected shapes n_in %d out %d ws %zu\n", n_in, out_size, ws_size); grid = -1; return; }
        int dev = 0, cus = 0; (void)hipGetDevice(&dev); (void)hipDeviceGetAttribute(&cus, hipDeviceAttributeMultiprocessorCount, dev);
        grid = cus > 0 ? cus : 256;
        (void)hipFuncSetAttribute((const void*)k_mega, hipFuncAttributeMaxDynamicSharedMemorySize, LDS_BYTES);
    }
    if (grid < 0) return;
    (void)hipMemsetAsync((char*)d_ws + WS_CTL, 0, CTL_BYTES, stream);
    Params P{};
    for (int i = 0; i < 21; ++i) P.in[i] = (const float*)d_in[i];
    P.out = (float*)d_out; P.ws = (unsigned char*)d_ws;
#if N_LAUNCH_MODE == 1
    hipLaunchKernelGGL(k_mega, dim3(grid), dim3(NTHREADS), LDS_BYTES, stream, P);
#else
    launch_step<0>(P, 0, grid, stream);
    launch_step<1>(P, 0, grid, stream);
    for (int l = 0; l < 2; ++l) {
        launch_step<2>(P, l, grid, stream); launch_step<3>(P, l, grid, stream); launch_step<4>(P, l, grid, stream); launch_step<5>(P, l, grid, stream);
        launch_step<6>(P, l, grid, stream); launch_step<7>(P, l, grid, stream); launch_step<8>(P, l, grid, stream);
        launch_step<10>(P, l, grid, stream);
    }
#endif
}
#ifdef DBG_INST
template __global__ void k_step<11>(Params, int);
template __global__ void k_step<12>(Params, int);
template __global__ void k_step<13>(Params, int);
template __global__ void k_step<14>(Params, int);
template __global__ void k_step<15>(Params, int);
template __global__ void k_step<16>(Params, int);
#endif
```

```cpp
#include <hip/hip_runtime.h>
#include <cstdint>
#include <cstdio>

#ifndef N_LAUNCH_MODE
#define N_LAUNCH_MODE 1
#endif
#ifndef FAST_MIX
#define FAST_MIX 1
#endif
#ifndef DBG_TEST
#define DBG_TEST 0
#endif
#ifndef DBG_HG_MODE
#define DBG_HG_MODE 0
#endif
#ifndef FAST_GEMM
#define FAST_GEMM 1
#endif

#define LAS __attribute__((address_space(3)))
#define GAS __attribute__((address_space(1)))
typedef unsigned short bf16_t;
typedef short bf16x8 __attribute__((ext_vector_type(8)));
typedef float f32x4 __attribute__((ext_vector_type(4)));
typedef float f32x2 __attribute__((ext_vector_type(2)));
typedef unsigned u32x4 __attribute__((ext_vector_type(4)));
typedef unsigned u32x2 __attribute__((ext_vector_type(2)));
typedef short s16x4 __attribute__((ext_vector_type(4)));
typedef float f32x16 __attribute__((ext_vector_type(16)));
#define DI __device__ __forceinline__

constexpr int D = 1024, NB = 2, SEQ = 8192, CTXL = 256, NLAT = NB * SEQ, NCTX = NB * CTXL, NROWS = NLAT + NCTX;
constexpr int INW = 2816, PBW = 2304, ZW = 512, NEXP = 16, DEXP = 512, LISTCAP = NROWS;
constexpr int NTHREADS = 512, NWAVES = 8;
constexpr float ALPHA = 1.41421356237f, LN_EPS = 1e-5f, RMS_EPS = 1e-6f, LOG2E = 1.4426950408889634f, QSCALE = 0.125f * LOG2E;
constexpr int PB_AQ = 0, PB_AI = 256, PB_AG = 512, PB_NQ = 768, PB_NK = 1024, PB_NV = 1280, PB_SQ = 1536, PB_SK = 2048, PB_SV = 2176;
constexpr int NCHAIN = 132;

constexpr size_t MiB = 1u << 20;
constexpr size_t WS_CTL = 0, CTL_BYTES = 1 * MiB, CTL_USED = 192 * 1024;
constexpr size_t WS_MODS = 1 * MiB;
constexpr size_t WS_LB = WS_MODS + 2 * 3 * 6144 * 4;
constexpr size_t WS_ROPE = WS_LB + 2 * 2 * 256 * 4;
constexpr size_t WS_TOKE = WS_ROPE + 129 * 16 * 2 * 4;
constexpr size_t WS_TOKP = WS_TOKE + NROWS * 8;
constexpr size_t WS_TOKW = WS_TOKP + NROWS * 8;
constexpr size_t WS_LIST = 2 * MiB;
constexpr size_t WS_XC = 4 * MiB;
constexpr size_t WS_X1 = 211 * MiB;
constexpr size_t WS_WIN = 6 * MiB;
constexpr size_t WS_WOUT = 17 * MiB;
constexpr size_t WS_WGU = 21 * MiB;
constexpr size_t WS_WD = 53 * MiB;
constexpr size_t WS_H = 69 * MiB;
constexpr size_t WS_Y = 102 * MiB;
constexpr size_t WS_S = 135 * MiB;
constexpr size_t WS_DD = 282 * MiB;
constexpr size_t WS_PB = 174 * MiB;
constexpr size_t WS_Z = WS_PB + (size_t)NROWS * PBW * 2;
constexpr size_t WS_O = 174 * MiB;
constexpr size_t WS_YO = 248 * MiB;
constexpr size_t WS_WGU1 = 284 * MiB, WS_WD1 = 316 * MiB;
constexpr size_t WS_END = 332 * MiB;
constexpr int HE_ROWS = 37888;
constexpr size_t WS_KK = WS_Z + (size_t)NROWS * ZW * 2;
static_assert(WS_DD + (size_t)2 * 2112 * 64 * 4 <= WS_END && WS_Z + (size_t)NROWS * ZW * 4 <= WS_DD && WS_O + (size_t)HE_ROWS * 1024 * 2 <= WS_YO && WS_YO + (size_t)NROWS * 2048 <= WS_END, "ws map");
static_assert(WS_TOKW + NROWS * 8 <= WS_LIST && WS_LIST + 16 * LISTCAP * 4 <= WS_XC, "ws map small");
constexpr int CW_TRDY = 32768;
constexpr int CW_CNT = 8192;
constexpr int CW_BAR = 4096;
constexpr int CW_DBG = 512;
constexpr int CW_Q = 1024;
constexpr int CW_TS = 2048;
constexpr int CW_SCAN = 1536;

struct Params {
    const float* in[21];
    float* out;
    unsigned char* ws;
    int step_lo, step_hi;
};

DI unsigned f2bf(float f) { unsigned u = __builtin_bit_cast(unsigned, f); return (u + 0x7fffu + ((u >> 16) & 1u)) >> 16; }
DI float bf2f(unsigned h) { return __builtin_bit_cast(float, h << 16); }
typedef __bf16 bf16x2_t __attribute__((ext_vector_type(2)));
DI unsigned pk2(float lo, float hi) { return __builtin_bit_cast(unsigned, __builtin_convertvector((f32x2){lo, hi}, bf16x2_t)); }
DI float bflo(unsigned w) { return __builtin_bit_cast(float, w << 16); }
DI float bfhi(unsigned w) { return __builtin_bit_cast(float, w & 0xffff0000u); }
#define DPPF(v, ctrl, rm) __builtin_bit_cast(float, __builtin_amdgcn_update_dpp(0, __builtin_bit_cast(int, (v)), (ctrl), (rm), 0xf, false))
DI float wave_sum(float v) {
    v += DPPF(v, 0xB1, 0xf); v += DPPF(v, 0x4E, 0xf); v += DPPF(v, 0x141, 0xf); v += DPPF(v, 0x140, 0xf);
    v += DPPF(v, 0x142, 0xa); v += DPPF(v, 0x143, 0xc);
    return __builtin_bit_cast(float, __builtin_amdgcn_readlane(__builtin_bit_cast(int, v), 63));
}
DI float wave_max(float v) {
#pragma unroll
    for (int o = 1; o < 64; o <<= 1) v = fmaxf(v, __shfl_xor(v, o));
    return v;
}
DI float sigmoidf_(float x) { return __builtin_amdgcn_rcpf(1.0f + __expf(-x)); }
DI float siluf_(float x) { return x * __builtin_amdgcn_rcpf(1.0f + __expf(-x)); }
DI unsigned pk_fp8x4(f32x4 v) { int w = 0; w = __builtin_amdgcn_cvt_pk_fp8_f32(v[0], v[1], w, false); w = __builtin_amdgcn_cvt_pk_fp8_f32(v[2], v[3], w, true); return (unsigned)w; }
DI void st_wt(void* p, unsigned v) { __hip_atomic_store((unsigned*)p, v, __ATOMIC_RELAXED, __HIP_MEMORY_SCOPE_AGENT); }
DI void st_wtf(float* p, float v) { __hip_atomic_store((unsigned*)p, __float_as_uint(v), __ATOMIC_RELAXED, __HIP_MEMORY_SCOPE_AGENT); }
DI void st_wth(bf16_t* p, unsigned short v) { __hip_atomic_store((unsigned short*)p, v, __ATOMIC_RELAXED, __HIP_MEMORY_SCOPE_AGENT); }
DI void store_bf4(bf16_t* p, f32x4 v) { u32x2 w; w.x = pk2(v[0], v[1]); w.y = pk2(v[2], v[3]); *(u32x2*)p = w; }

struct Ctx {
    LAS unsigned char* lds;
    int tid, lane, wave, bid, nb;
};

struct Unit { int pm, pn, e, cnt, i0, slot; };

struct PlainSched {
    int nM, nN, nwg, G, c;
    DI void init(int M, int N, int G_, int c_) { nM = M / 256; nN = N / 256; nwg = nM * nN; G = G_; c = c_; }
    DI bool next(int i, Unit& u) const {
        const long L = (long)i * G + c; if (L >= nwg) return false;
        int wgid = (int)L; { const int q = nwg / 8, r = nwg % 8, xcd = wgid % 8, off = wgid / 8; wgid = (xcd < r ? xcd * (q + 1) : r * (q + 1) + (xcd - r) * q) + off; }
        const int nig = 8 * nN, gid = wgid / nig, fm = gid * 8, gsz = (nM - fm) < 8 ? (nM - fm) : 8;
        u.pm = fm + ((wgid % nig) % gsz); u.pn = (wgid % nig) / gsz; u.e = 0; u.cnt = 0; u.i0 = 0; u.slot = 0; return true;
    }
    DI int a_row(const Unit& u, int r) const { return u.pm * 256 + r; }
    DI int b_row0(const Unit& u) const { return u.pn * 256; }
    static constexpr bool LOADS = false, PUBLISH = false, WAIT = false;
};
constexpr int MOE_TBL_OFF = 144 * 1024 + 512;
constexpr int MOE_LIST_OFF = 144 * 1024 + 2560;
DI void moe_build_table(const Ctx& X, const int* cnt) {
    LAS int* tbl = (LAS int*)(X.lds + MOE_TBL_OFF);
    if (X.tid < 160) { const int T = X.tid; int acc = 0, e = -1, i0 = 0, ce = 0;
#pragma unroll
        for (int q = 0; q < NEXP; ++q) { const int cq = cnt[q * 64]; const int nt = (cq + 255) >> 8; if (e < 0 && T < acc + nt) { e = q; i0 = T - acc; ce = cq; } acc += nt; }
        tbl[1 + 3 * T] = e; tbl[2 + 3 * T] = i0; tbl[3 + 3 * T] = ce; if (T == 0) tbl[0] = acc; }
    __syncthreads();
}
template <bool GATHER> struct MoeSched {
    const int* cnt; const int* list; int G, c, nct, bt_rows; LAS unsigned char* lds; unsigned* ready; static constexpr bool gather = GATHER;
    static constexpr int NCT_UP = 4;
    DI bool next(int i, Unit& u) const {
        const LAS int* tbl = (const LAS int*)(lds + MOE_TBL_OFF);
        const int clin = (c & 7) * (G >> 3) + (c >> 3), ntile = __builtin_amdgcn_readfirstlane(tbl[0]);
        int L;
        if (GATHER) L = i * G + clin;
        else { const int n1 = ntile * NCT_UP, rf = n1 / G, r = n1 - rf * G;
            if (r == 0) L = i * G + clin;
            else { const int nl = ((rf * G) / NCT_UP) * nct;
                if (clin < r) L = nl + i * r + clin;
                else { L = i * (G - r) + (clin - r); if (L >= nl) return false; } } }
        const int T = L / nct; if (T >= ntile) return false;
        u.slot = i; u.pm = T; u.pn = L % nct; u.e = __builtin_amdgcn_readfirstlane(tbl[1 + 3 * T]); u.i0 = __builtin_amdgcn_readfirstlane(tbl[2 + 3 * T]); u.cnt = __builtin_amdgcn_readfirstlane(tbl[3 + 3 * T]); return true;
    }
    DI int a_row(const Unit& u, int r) const {
        if (!gather) return u.pm * 256 + r;
        return ((const LAS int*)(lds + MOE_LIST_OFF))[u.slot * 256 + r];
    }
    DI int b_row0(const Unit& u) const { return u.e * bt_rows + u.pn * 256; }
    static constexpr bool LOADS = GATHER, PUBLISH = GATHER, WAIT = !GATHER;
    DI void publish(const Unit& u) const { __hip_atomic_fetch_add(ready + u.pm, 1u, __ATOMIC_RELAXED, __HIP_MEMORY_SCOPE_AGENT); }
    DI void wait(const Unit& u) const { unsigned sp = 0; while (__hip_atomic_load(ready + u.pm, __ATOMIC_RELAXED, __HIP_MEMORY_SCOPE_AGENT) < (unsigned)NCT_UP && ++sp < (1u << 24)) __builtin_amdgcn_s_sleep(1);
        __builtin_amdgcn_fence(__ATOMIC_ACQUIRE, "agent"); asm volatile("s_waitcnt vmcnt(0)" ::: "memory"); }
};

DI void store_bf8(bf16_t* p, f32x4 lo, f32x4 hi) { u32x4 w; w.x = pk2(lo[0], lo[1]); w.y = pk2(lo[2], lo[3]); w.z = pk2(hi[0], hi[1]); w.w = pk2(hi[2], hi[3]); *(u32x4*)p = w; }
DI void store_f8x8(unsigned char* p, f32x4 lo, f32x4 hi) { u32x2 w; w.x = pk_fp8x4(lo); w.y = pk_fp8x4(hi); *(u32x2*)p = w; }
DI float lane32_partner(float v, bool upper) { const auto rr = __builtin_amdgcn_permlane32_swap(__float_as_uint(v), __float_as_uint(v), false, false); return __uint_as_float(upper ? rr[0] : rr[1]); }
struct EpiIn {
    bf16_t* PB; bf16_t* Z; const float* rope; const float* lb; bf16_t* KK;
    DI void gate8(bf16_t* zp, bf16_t* kp, const float* lbp, f32x4 z0, f32x4 z1) const {
        const f32x4 lb0 = *(const f32x4*)lbp, lb1 = *(const f32x4*)(lbp + 4); f32x4 lf0, lf1; (void)kp;
#pragma unroll
        for (int j = 0; j < 4; ++j) { const float e = __expf(-z0[j]), sg = __builtin_amdgcn_rcpf(1.0f + e), f = lb0[j] + (1.0f - lb0[j]) * sg; lf0[j] = __log2f(f); }
#pragma unroll
        for (int j = 0; j < 4; ++j) { const float e = __expf(-z1[j]), sg = __builtin_amdgcn_rcpf(1.0f + e), f = lb1[j] + (1.0f - lb1[j]) * sg; lf1[j] = __log2f(f); }
        store_bf8(zp, lf0, lf1);
    }
    DI void rope8(f32x4& v0, f32x4& v1, const float* rp, bool upper) const {
#pragma unroll
        for (int j = 0; j < 4; ++j) { const float c0 = rp[2 * j], s0 = rp[2 * j + 1], c1 = rp[2 * (j + 4)], s1 = rp[2 * (j + 4) + 1];
            const float p0 = lane32_partner(v0[j], upper), p1 = lane32_partner(v1[j], upper);
            v0[j] = upper ? p0 * s0 + v0[j] * c0 : v0[j] * c0 - p0 * s0; v1[j] = upper ? p1 * s1 + v1[j] * c1 : v1[j] * c1 - p1 * s1; }
    }
    DI void group(const Unit& u, int r, int c, f32x4 a0, f32x4 a1, f32x4 b0, f32x4 b1) const {
        const int row = u.pm * 256 + r, seg = u.pn, gc = u.pn * 256 + c;
        if (seg == 1 || seg == 2) {
            const int ci = (seg - 1) * 256 + c; bf16_t* z = Z + (size_t)row * ZW + ci; bf16_t* k = KK + (size_t)row * ZW + ci; const float* lp = lb + ci;
            gate8(z, k, lp, a0, a1); gate8(z + 128, k + 128, lp + 128, b0, b1);
            return;
        }
        if (seg >= 8) {
            const int t = row & (SEQ - 1); const int which = (c >> 5) & 1; const int pos = row < NLAT ? (which ? (t & 63) : (t >> 6)) : 128;
            const bool upper = (c & 31) >= 16; const float* rp = rope + (pos * 16 + (c & 15)) * 2;
            rope8(a0, a1, rp, upper); if (seg < 10) rope8(b0, b1, rp, upper);
        }
        if (seg == 5 || seg == 8 || seg == 9) { a0 *= QSCALE; a1 *= QSCALE; b0 *= QSCALE; b1 *= QSCALE; }
        bf16_t* p = PB + (size_t)row * PBW + (gc >= 768 ? gc - 512 : gc);
        store_bf8(p, a0, a1); store_bf8(p + 128, b0, b1);
    }
};
struct EpiBf {
    bf16_t* C; int ldc;
    DI void group(const Unit& u, int r, int c, f32x4 a0, f32x4 a1, f32x4 b0, f32x4 b1) const {
        bf16_t* p = C + (size_t)(u.pm * 256 + r) * ldc + u.pn * 256 + c;
        store_bf8(p, a0, a1); store_bf8(p + 128, b0, b1);
    }
};
struct EpiF8 {
    unsigned char* C; int ldc;
    DI void group(const Unit& u, int r, int c, f32x4 a0, f32x4 a1, f32x4 b0, f32x4 b1) const {
        unsigned char* p = C + (size_t)(u.pm * 256 + r) * ldc + u.pn * 256 + c;
        store_f8x8(p, a0 * 16.0f, a1 * 16.0f); store_f8x8(p + 128, b0 * 16.0f, b1 * 16.0f);
    }
};
struct EpiGU {
    bf16_t* HE;
    DI void group(const Unit& u, int r, int c, f32x4 a0, f32x4 a1, f32x4 b0, f32x4 b1) const {
        f32x4 h0, h1;
#pragma unroll
        for (int j = 0; j < 4; ++j) { h0[j] = siluf_(a0[j]) * b0[j]; h1[j] = siluf_(a1[j]) * b1[j]; }
        u32x2 w; w.x = pk_fp8x4(h0); w.y = pk_fp8x4(h1);
        __hip_atomic_store((unsigned long long*)((unsigned char*)HE + (size_t)(u.pm * 256 + r) * DEXP + u.pn * 128 + c), (unsigned long long)w.x | ((unsigned long long)w.y << 32), __ATOMIC_RELAXED, __HIP_MEMORY_SCOPE_AGENT);
    }
};

template <class Sched, class Epi>
DI void gemm_naive(const Ctx& X, const bf16_t* A, const bf16_t* Bt, int K, const Sched& S, const Epi& E) {
    Unit u;
    for (int i = 0; S.next(i, u); ++i) {
        for (int g = X.tid; g < 4096; g += NTHREADS) {
            const int fq = g & 3, wc = (g >> 2) & 3, r = g >> 4, c = wc * 32 + fq * 4;
            const bf16_t* ap = A + (size_t)S.a_row(u, r) * K;
            const bf16_t* bp = Bt + (size_t)(S.b_row0(u) + c) * K;
            float acc[16];
#pragma unroll
            for (int q = 0; q < 16; ++q) acc[q] = 0.f;
            for (int k = 0; k < K; k += 8) {
                const u32x4 av = *(const u32x4*)(ap + k);
                float af[8] = {bflo(av.x), bfhi(av.x), bflo(av.y), bfhi(av.y), bflo(av.z), bfhi(av.z), bflo(av.w), bfhi(av.w)};
#pragma unroll
                for (int q = 0; q < 16; ++q) {
                    const int col = (q >> 3) * 128 + ((q >> 2) & 1) * 16 + (q & 3);
                    const u32x4 bv = *(const u32x4*)(bp + (size_t)col * K + k);
                    acc[q] += af[0] * bflo(bv.x) + af[1] * bfhi(bv.x) + af[2] * bflo(bv.y) + af[3] * bfhi(bv.y) + af[4] * bflo(bv.z) + af[5] * bfhi(bv.z) + af[6] * bflo(bv.w) + af[7] * bfhi(bv.w);
                }
            }
            E.group(u, r, c, (f32x4){acc[0], acc[1], acc[2], acc[3]}, (f32x4){acc[4], acc[5], acc[6], acc[7]}, (f32x4){acc[8], acc[9], acc[10], acc[11]}, (f32x4){acc[12], acc[13], acc[14], acc[15]});
        }
    }
}

constexpr int HTB = 128 * 64 * 2;
DI int lds_byte(int r, int c) { const int st = (r >> 4) * 2 + (c >> 5), rr = r & 15, cc = c & 31, ob = rr * 64 + cc * 2; return st * 1024 + (ob ^ (((ob >> 9) & 1) << 5)); }
DI void stage_rc(int b, int& R, int& C) { const int st = b / 1024, sb = b % 1024, swz = sb ^ (((sb >> 9) & 1) << 5); R = (st >> 1) * 16 + swz / 64; C = (st & 1) * 32 + (swz % 64) / 2; }
typedef int v8i_t __attribute__((ext_vector_type(8)));
template <class Sched, class Epi, bool F8 = false, int SCALE_B = 127>
DI void gemm_fast(const Ctx& X, const void* A, const void* Bt, int K, const Sched& S, const Epi& E) {
    LAS unsigned char* lds = X.lds;
    const int tid = X.tid, wid = X.wave, lane = X.lane, wr = wid >> 2, wc = wid & 3, fr = lane & 15, fq = lane >> 4;
    asm volatile("" : "+s"(K));
    const int RP = F8 ? K : 2 * K, nt = RP / 128;
    int Rr[2], Cc[2]; unsigned voffB[2];
#pragma unroll
    for (int i = 0; i < 2; ++i) { stage_rc(tid * 16 + i * 8192, Rr[i], Cc[i]); const int rho = Rr[i] & 31, Rb = (Rr[i] & ~31) + 8 * ((rho & 15) >> 2) + 4 * (rho >> 4) + (rho & 3);
        voffB[i] = (unsigned)(Rb * RP + Cc[i] * 2); }
    const size_t kstep = 128, hstepB = (size_t)128 * RP;
    const unsigned ldsw = (unsigned)wid * 1024u;
    const int aoff = lds_byte(wr * 64 + fr, fq * 8), boff = lds_byte(wc * 32 + fr, fq * 8);
#define G_SA(b, h) (((b) * 2 + (h)) * HTB)
#define G_SB(b, h) ((4 + (b) * 2 + (h)) * HTB)
#define G_STAGE(bufoff, gbase, voff) do { _Pragma("unroll") for (int _i = 0; _i < 2; ++_i) \
        __builtin_amdgcn_global_load_lds((const unsigned*)((const char*)(gbase) + (voff)[_i]), (LAS unsigned*)(lds + (bufoff) + ldsw + _i * 8192), 16, 0, 0); } while (0)
#define G_LD8(p) __builtin_bit_cast(v8i_t, __builtin_shufflevector(*(const LAS u32x4*)(p), *(const LAS u32x4*)((p) + 1024), 0, 1, 2, 3, 4, 5, 6, 7))
#define G_LDA(dst, b, h) do { _Pragma("unroll") for (int m = 0; m < 4; ++m) dst[m] = G_LD8(lds + G_SA(b, h) + aoff + m * 2048); } while (0)
#define G_LDB(dst, b, h) do { _Pragma("unroll") for (int n = 0; n < 2; ++n) dst[n] = G_LD8(lds + G_SB(b, h) + boff + n * 2048); } while (0)
#define G_LO(f) __builtin_bit_cast(bf16x8, __builtin_shufflevector((f), (f), 0, 1, 2, 3))
#define G_HI(f) __builtin_bit_cast(bf16x8, __builtin_shufflevector((f), (f), 4, 5, 6, 7))
#define G_MMA(ai, bj, At, Bt_) do { __builtin_amdgcn_s_setprio(1); _Pragma("unroll") for (int m = 0; m < 4; ++m) _Pragma("unroll") for (int n = 0; n < 2; ++n) { \
        if constexpr (F8) asm volatile("v_mfma_scale_f32_16x16x128_f8f6f4 %0, %1, %2, %0, %3, %4 op_sel_hi:[0,0,0]" : "+v"(acc[ai][bj][m][n]) : "v"(Bt_[n]), "v"(At[m]), "v"(scl_w), "v"(scl_x)); \
        else { acc[ai][bj][m][n] = __builtin_amdgcn_mfma_f32_16x16x32_bf16(G_LO(Bt_[n]), G_LO(At[m]), acc[ai][bj][m][n], 0, 0, 0); acc[ai][bj][m][n] = __builtin_amdgcn_mfma_f32_16x16x32_bf16(G_HI(Bt_[n]), G_HI(At[m]), acc[ai][bj][m][n], 0, 0, 0); } } __builtin_amdgcn_s_setprio(0); } while (0)
#define G_WAIT_V(n) asm volatile("s_waitcnt vmcnt(" #n ")" ::: "memory")
#define G_WAIT_L(n) asm volatile("s_waitcnt lgkmcnt(" #n ")" ::: "memory")
#define G_BAR __builtin_amdgcn_s_barrier()
#define G_SCHED __builtin_amdgcn_sched_barrier(0)
    Unit cur, nxt; int ui = 0;
    if (!S.next(0, cur)) return;
    if constexpr (Sched::WAIT) { if (tid == 0) S.wait(cur); __builtin_amdgcn_s_barrier(); }
    f32x4 acc[2][2][4][2];
#pragma unroll
    for (int a = 0; a < 2; ++a)
#pragma unroll
        for (int b = 0; b < 2; ++b)
#pragma unroll
            for (int m = 0; m < 4; ++m)
#pragma unroll
                for (int n = 0; n < 2; ++n) acc[a][b][m][n] = (f32x4){0.f, 0.f, 0.f, 0.f};
    v8i_t At[4], B0[2], B1[2];
    int scl_w = SCALE_B * 0x01010101, scl_x = 0x7f7f7f7f; asm volatile("" : "+v"(scl_w), "+v"(scl_x));
    constexpr bool GA = Sched::LOADS;
    unsigned vAc[2][2], vAn[2][2];
#pragma unroll
    for (int h = 0; h < 2; ++h)
#pragma unroll
        for (int i = 0; i < 2; ++i) { vAc[h][i] = GA ? (unsigned)(S.a_row(cur, h * 128 + Rr[i]) * RP + Cc[i] * 2) : (unsigned)((h * 128 + Rr[i]) * RP + Cc[i] * 2); vAn[h][i] = vAc[h][i]; }
    if (GA) G_WAIT_V(0);
    const char* A0 = (const char*)A;
    const char* cA = GA ? A0 : A0 + (size_t)S.a_row(cur, 0) * RP;
    const char* cB = (const char*)Bt + (size_t)S.b_row0(cur) * RP;
    G_STAGE(G_SB(0, 0), cB, voffB); G_STAGE(G_SB(0, 1), cB + hstepB, voffB); G_STAGE(G_SA(0, 0), cA, vAc[0]); G_STAGE(G_SA(0, 1), cA, vAc[1]);
    if (wr == 1) G_BAR;
    G_WAIT_V(2); G_BAR;
    G_STAGE(G_SB(1, 0), cB + kstep, voffB); G_STAGE(G_SA(1, 0), cA + kstep, vAc[0]); G_STAGE(G_SB(1, 1), cB + hstepB + kstep, voffB);
    G_WAIT_V(6); G_BAR;
    for (;;) {
        const bool has_next = S.next(ui + 1, nxt);
        if (GA) {
#pragma unroll
            for (int h = 0; h < 2; ++h)
#pragma unroll
                for (int i = 0; i < 2; ++i) vAn[h][i] = has_next ? (unsigned)(S.a_row(nxt, h * 128 + Rr[i]) * RP + Cc[i] * 2) : vAc[h][i];
        }
        const char* nA = GA ? A0 : (has_next ? A0 + (size_t)S.a_row(nxt, 0) * RP : cA);
        const char* nB = has_next ? (const char*)Bt + (size_t)S.b_row0(nxt) * RP : cB;
#pragma unroll 1
        for (int t = 0; t < nt; t += 2) {
            const bool last = (t == nt - 2);
            if constexpr (Sched::WAIT) { if (last && has_next) { if (tid == 0) S.wait(nxt); G_BAR; } }
            const char* a1 = cA + (size_t)(t + 1) * kstep;
            const char* a2 = last ? nA : cA + (size_t)(t + 2) * kstep; const char* b2 = last ? nB : cB + (size_t)(t + 2) * kstep;
            const char* a3 = a2 + kstep; const char* b3 = b2 + kstep;
            unsigned v2[2][2];
#pragma unroll
            for (int h = 0; h < 2; ++h)
#pragma unroll
                for (int i = 0; i < 2; ++i) v2[h][i] = (GA && last) ? vAn[h][i] : vAc[h][i];
            G_LDB(B0, 0, 0); G_LDB(B1, 0, 1); G_SCHED; G_LDA(At, 0, 0); G_STAGE(G_SA(1, 1), a1, vAc[1]);
            G_WAIT_V(8); G_WAIT_L(0); G_BAR; G_MMA(0, 0, At, B0); G_MMA(0, 1, At, B1); G_BAR; G_SCHED;
            G_LDA(At, 0, 1); G_STAGE(G_SB(0, 0), b2, voffB); G_STAGE(G_SB(0, 1), b2 + hstepB, voffB); G_STAGE(G_SA(0, 0), a2, v2[0]);
            G_WAIT_V(8); G_WAIT_L(0); G_BAR; G_MMA(1, 0, At, B0); G_MMA(1, 1, At, B1); G_BAR; G_SCHED;
            G_LDB(B0, 1, 0); G_LDB(B1, 1, 1); G_SCHED; G_LDA(At, 1, 0); G_STAGE(G_SA(0, 1), a2, v2[1]);
            G_WAIT_V(8); G_WAIT_L(0); G_BAR; G_MMA(0, 0, At, B0); G_MMA(0, 1, At, B1); G_BAR; G_SCHED;
            G_LDA(At, 1, 1); G_STAGE(G_SB(1, 0), b3, voffB); G_STAGE(G_SB(1, 1), b3 + hstepB, voffB); G_STAGE(G_SA(1, 0), a3, v2[0]);
            G_WAIT_V(8); G_WAIT_L(0); G_BAR; G_MMA(1, 0, At, B0); G_MMA(1, 1, At, B1); G_BAR; G_SCHED;
        }
        if constexpr (F8) asm volatile("s_nop 15\n\ts_nop 15" ::: "memory");
        if (wr == 0) G_BAR;
#pragma unroll
        for (int ai = 0; ai < 2; ++ai)
#pragma unroll
            for (int m = 0; m < 4; ++m) E.group(cur, ai * 128 + wr * 64 + m * 16 + fr, wc * 32 + fq * 8, acc[ai][0][m][0], acc[ai][0][m][1], acc[ai][1][m][0], acc[ai][1][m][1]);
        if constexpr (Sched::PUBLISH) { G_WAIT_V(0); G_BAR; if (tid == 0) S.publish(cur); }
        if (!has_next) break;
#pragma unroll
        for (int a = 0; a < 2; ++a)
#pragma unroll
            for (int b = 0; b < 2; ++b)
#pragma unroll
                for (int m = 0; m < 4; ++m)
#pragma unroll
                    for (int n = 0; n < 2; ++n) acc[a][b][m][n] = (f32x4){0.f, 0.f, 0.f, 0.f};
        cur = nxt; cB = nB; cA = nA; ++ui;
        if (GA) {
#pragma unroll
            for (int h = 0; h < 2; ++h)
#pragma unroll
                for (int i = 0; i < 2; ++i) vAc[h][i] = vAn[h][i]; }
        if (wr == 1) G_BAR;
    }
    G_WAIT_V(0);
    G_BAR;
#undef G_SA
#undef G_SB
#undef G_STAGE
#undef G_LDA
#undef G_LDB
#undef G_MMA
#undef G_LD8
#undef G_LO
#undef G_HI
#undef G_WAIT_V
#undef G_WAIT_L
#undef G_BAR
#undef G_SCHED
}
#if FAST_GEMM
#define GEMM_IMPL gemm_fast
#else
#define GEMM_IMPL gemm_naive
#endif

struct TrDesc { const float* W; bf16_t* WT; int N, Kd, k0, n0, drow0, f8; float sc; };
DI void tr_load(const TrDesc& d, float (&rg)[32], int lane) {
#pragma unroll
    for (int i = 0; i < 32; ++i) { const int kk = 2 * i + (lane >> 5); rg[i] = __builtin_nontemporal_load(d.W + (size_t)(d.k0 + kk) * d.N + d.n0 + (lane & 31)); }
}
DI void tr_finish(const TrDesc& d, const float (&rg)[32], LAS float* scr, int lane) {
#pragma unroll
    for (int i = 0; i < 32; ++i) { const int kk = 2 * i + (lane >> 5); scr[kk * 33 + (lane & 31)] = rg[i]; }
    asm volatile("s_waitcnt lgkmcnt(0)" ::: "memory");
    const int c = lane & 7;
#pragma unroll
    for (int j = 0; j < 4; ++j) { const int n = (lane >> 3) + 8 * j; const LAS float* s = scr + (8 * c) * 33 + n;
        if (d.f8) { u32x2 o; o.x = pk_fp8x4((f32x4){s[0 * 33], s[1 * 33], s[2 * 33], s[3 * 33]} * d.sc); o.y = pk_fp8x4((f32x4){s[4 * 33], s[5 * 33], s[6 * 33], s[7 * 33]} * d.sc);
            *(u32x2*)((unsigned char*)d.WT + (size_t)(d.drow0 + n) * d.Kd + d.k0 + 8 * c) = o; }
        else { u32x4 o; o.x = pk2(s[0 * 33], s[1 * 33]); o.y = pk2(s[2 * 33], s[3 * 33]); o.z = pk2(s[4 * 33], s[5 * 33]); o.w = pk2(s[6 * 33], s[7 * 33]);
            *(u32x4*)(d.WT + (size_t)(d.drow0 + n) * d.Kd + d.k0 + 8 * c) = o; } }
    asm volatile("s_waitcnt lgkmcnt(0)" ::: "memory");
}
DI TrDesc expert_desc(const Params& P, int l, int it) {
    bf16_t* WGU = (bf16_t*)(P.ws + (l ? WS_WGU1 : WS_WGU)); bf16_t* WD = (bf16_t*)(P.ws + (l ? WS_WD1 : WS_WD));
    const float* wg = P.in[18] + (size_t)l * NEXP * D * DEXP; const float* wu = P.in[19] + (size_t)l * NEXP * D * DEXP; const float* wd = P.in[20] + (size_t)l * NEXP * DEXP * D;
    const int set = it >> 12, r = it & 4095, e = r >> 8, q = r & 255; TrDesc d; d.sc = 32.0f;
    if (set < 2) { const int kb = q >> 4, nbk = q & 15, n0 = nbk * 32;
        d.f8 = 1; d.W = (set ? wu : wg) + (size_t)e * D * DEXP; d.N = DEXP; d.WT = (bf16_t*)((unsigned char*)WGU + (size_t)e * 1024 * 1024); d.Kd = 1024; d.k0 = kb * 64; d.n0 = n0; d.drow0 = 256 * (n0 >> 7) + (n0 & 127) + set * 128;
    } else { const int kb = q >> 5, nbk = q & 31, n0 = nbk * 32;
        d.f8 = 1; d.W = wd + (size_t)e * DEXP * D; d.N = D; d.WT = (bf16_t*)((unsigned char*)WD + (size_t)e * 1024 * 512); d.Kd = 512; d.k0 = kb * 64; d.n0 = n0; d.drow0 = n0; }
    return d;
}
DI TrDesc rest_desc(const Params& P, int it) {
    if (it >= 2432) return expert_desc(P, 0, it - 2432);
    bf16_t* WIN = (bf16_t*)(P.ws + WS_WIN); bf16_t* WOUT = (bf16_t*)(P.ws + WS_WOUT); TrDesc d;
    d.f8 = 1; d.sc = 32.0f;
    if (it < 1408) { const int kb = it / 88, nbk = it % 88; d.f8 = 1; d.W = P.in[6] + (size_t)D * INW; d.N = INW; d.WT = (bf16_t*)((unsigned char*)WIN + (size_t)INW * D); d.Kd = D; d.k0 = kb * 64; d.n0 = nbk * 32; d.drow0 = nbk * 32; }
    else { const int r0 = it - 1408, l = r0 >> 9, r = r0 & 511, kb = r >> 5, nbk = r & 31; d.sc = 64.0f; d.W = P.in[11] + (size_t)l * D * D; d.N = D; d.WT = (bf16_t*)((unsigned char*)WOUT + (size_t)l * D * D); d.Kd = D; d.k0 = kb * 64; d.n0 = nbk * 32; d.drow0 = nbk * 32; }
    return d;
}
DI TrDesc win0_desc(const Params& P, int it) { TrDesc d; d.f8 = 1; d.sc = 32.0f; const int kb = it / 88, nbk = it % 88; d.W = P.in[6]; d.N = INW; d.WT = (bf16_t*)(P.ws + WS_WIN); d.Kd = D; d.k0 = kb * 64; d.n0 = nbk * 32; d.drow0 = nbk * 32; return d; }
#define TR_LOOP(DESC_EXPR, first, limit, step) do { int it_ = (first); if (it_ < (limit)) { float rg_[32]; TrDesc d_ = DESC_EXPR(it_); tr_load(d_, rg_, X.lane); \
        for (;;) { const int nx_ = it_ + (step); if (nx_ < (limit)) { float rn_[32]; const TrDesc dn_ = DESC_EXPR(nx_); tr_load(dn_, rn_, X.lane); tr_finish(d_, rg_, scr, X.lane); d_ = dn_; _Pragma("unroll") for (int q_ = 0; q_ < 32; ++q_) rg_[q_] = rn_[q_]; it_ = nx_; } \
                   else { tr_finish(d_, rg_, scr, X.lane); break; } } } } while (0)
DI void ph_prologue(const Ctx& X, const Params& P) {
    LAS float* sc = (LAS float*)X.lds;
    LAS float* red = sc + 3072;
    float* MODS = (float*)(P.ws + WS_MODS);
    for (int it = X.bid; it < 193; it += X.nb) {
        if (it < 192) {
            const int l = it / 96, cg = it % 96;
            { float cv_[6];
#pragma unroll
              for (int q = 0; q < 6; ++q) { const int k = X.tid + NTHREADS * (q & 1); cv_[q] = (q >> 1) < 2 ? P.in[1][(q >> 1) * 1024 + k] : P.in[3][k]; }
#pragma unroll
              for (int q = 0; q < 6; ++q) sc[X.tid + NTHREADS * q] = siluf_(cv_[q]); }
            __syncthreads();
            const int kq = X.tid >> 4, c4 = X.tid & 15;
            float acc[3][4];
#pragma unroll
            for (int a = 0; a < 3; ++a)
#pragma unroll
                for (int j = 0; j < 4; ++j) acc[a][j] = 0.f;
            const float* w = P.in[4] + (size_t)l * D * 6144 + cg * 64 + c4 * 4;
#pragma unroll 16
            for (int i = 0; i < 32; ++i) { const int k = kq + 32 * i; const f32x4 wv = __builtin_nontemporal_load((const f32x4*)(w + (size_t)k * 6144));
                const float s0 = sc[k], s1 = sc[1024 + k], s2 = sc[2048 + k];
#pragma unroll
                for (int j = 0; j < 4; ++j) { acc[0][j] += s0 * wv[j]; acc[1][j] += s1 * wv[j]; acc[2][j] += s2 * wv[j]; } }
#pragma unroll
            for (int a = 0; a < 3; ++a)
#pragma unroll
                for (int j = 0; j < 4; ++j) red[(kq * 3 + a) * 64 + c4 * 4 + j] = acc[a][j];
            __syncthreads();
            if (X.tid < 192) { const int cond = X.tid >> 6, col = X.tid & 63; float s = 0.f;
                for (int q = 0; q < 32; ++q) s += red[(q * 3 + cond) * 64 + col];
                MODS[(l * 3 + cond) * 6144 + cg * 64 + col] = s + P.in[5][l * 6144 + cg * 64 + col]; }
            __syncthreads();
        } else {
            float* LB = (float*)(P.ws + WS_LB);
            { const int i = X.tid; const float l0 = P.in[7][i], l1 = P.in[7][512 + i]; const float p1 = 1.0f / (1.0f + expf(l0 - l1));
              LB[i] = 1e-6f; LB[512 + i] = fmaxf(p1, 1e-6f); }
            float* RP = (float*)(P.ws + WS_ROPE);
            for (int i = X.tid; i < 2048 + 16; i += NTHREADS) { const int pos = i >> 4, f = i & 15; const float inv = powf(10000.0f, -(float)f / 16.0f); const float ang = pos < 128 ? (float)pos * inv : 0.0f;
                RP[2 * i] = cosf(ang); RP[2 * i + 1] = sinf(ang); }
        }
    }
    __syncthreads();
    LAS float* scr = (LAS float*)X.lds + X.wave * (64 * 33);
    const int gw = X.bid * NWAVES + X.wave, NGW = X.nb * NWAVES;
#define DESC_WIN0(i) win0_desc(P, (i))
    TR_LOOP(DESC_WIN0, gw, 1408, NGW);
}
DI void convert_rest(const Ctx& X, const Params& P) {
    LAS float* scr = (LAS float*)X.lds + X.wave * (64 * 33);
    const int gw = X.bid * NWAVES + X.wave, NGW = X.nb * NWAVES;
#define DESC_REST(i) rest_desc(P, (i))
    TR_LOOP(DESC_REST, gw, 2432, NGW);
}

DI const float* mods_row(const Params& P, int l, int row) { const int cond = row < NLAT ? (row >> 13) : 2; return (const float*)(P.ws + WS_MODS) + (l * 3 + cond) * 6144; }
template <int NR>
DI void modulate_load(const Ctx& X, const Params& P, int row0, f32x4 (&x)[NR][4]) {
    const float* xr = row0 < NLAT ? P.in[0] + (size_t)row0 * D : P.in[2] + (size_t)(row0 - NLAT) * D;
#pragma unroll
    for (int j = 0; j < 4; ++j)
#pragma unroll
        for (int r = 0; r < NR; ++r) x[r][j] = __builtin_nontemporal_load((const f32x4*)(xr + (size_t)r * D + 4 * X.lane + 256 * j));
}
template <int NR>
DI void modulate_store(const Ctx& X, const Params& P, int l, int row0, const f32x4 (&x)[NR][4]) {
    bf16_t* H = (bf16_t*)(P.ws + WS_H); const float* md = mods_row(P, l, row0);
#pragma unroll
    for (int j = 0; j < 4; ++j) { const int c = 4 * X.lane + 256 * j; const f32x4 sh = *(const f32x4*)(md + c), sc = *(const f32x4*)(md + 1024 + c);
#pragma unroll
        for (int r = 0; r < NR; ++r) *(unsigned*)((unsigned char*)H + (size_t)(row0 + r) * D + c) = pk_fp8x4(x[r][j] * (1.0f + sc) + sh); }
}
DI void ph_modulate(const Ctx& X, const Params& P, int l) {
    const int gw = X.bid * NWAVES + X.wave;
    f32x4 xa[4][4], xb[4][4], xc[1][4];
    if (gw < NLAT / 8) { modulate_load<4>(X, P, 8 * gw, xa); modulate_load<4>(X, P, 8 * gw + 4, xb); }
    if (gw < NCTX) modulate_load<1>(X, P, NLAT + gw, xc);
    asm volatile("" ::: "memory");
    if (gw < NLAT / 8) { modulate_store<4>(X, P, l, 8 * gw, xa); modulate_store<4>(X, P, l, 8 * gw + 4, xb); }
    if (gw < NCTX) modulate_store<1>(X, P, l, NLAT + gw, xc);
}
template <int NR>
DI void ln1_rows(const Ctx& X, const Params& P, int l, int row0, int slot0, const LAS float* wrT, float (&lgv)[16]) {
    bf16_t* H = (bf16_t*)(P.ws + WS_H); const bf16_t* YO = (const bf16_t*)(P.ws + WS_YO); bf16_t* X1 = (bf16_t*)(P.ws + WS_X1) + (size_t)row0 * D;
    const float* g = P.in[12] + l * D; const float* bta = P.in[13] + l * D;
    const bool lat = row0 < NLAT;
    const float* xr = lat ? P.in[0] + (size_t)row0 * D : P.in[2] + (size_t)(row0 - NLAT) * D;
    const bf16_t* xb = (const bf16_t*)P.out + (size_t)row0 * D;
    const float* md = mods_row(P, l, row0);
    const int c0 = 4 * X.lane;
    f32x4 v[NR][4]; float sm[NR];
#pragma unroll
    for (int r = 0; r < NR; ++r) sm[r] = 0.f;
#pragma unroll
    for (int j = 0; j < 4; ++j) { const int c = c0 + 256 * j; const f32x4 g1 = *(const f32x4*)(md + 2048 + c);
#pragma unroll
        for (int r = 0; r < NR; ++r) { f32x4 x; if (l == 0) x = __builtin_nontemporal_load((const f32x4*)(xr + (size_t)r * D + c)); else { const u32x2 xw = __builtin_nontemporal_load((const u32x2*)(xb + (size_t)r * D + c)); x = (f32x4){bflo(xw.x), bfhi(xw.x), bflo(xw.y), bfhi(xw.y)}; }
            const u32x2 yw = __builtin_nontemporal_load((const u32x2*)(YO + (size_t)(row0 + r) * D + c));
            const f32x4 y = {bflo(yw.x), bfhi(yw.x), bflo(yw.y), bfhi(yw.y)}; v[r][j] = ALPHA * x + g1 * y; sm[r] += (v[r][j][0] + v[r][j][1]) + (v[r][j][2] + v[r][j][3]); } }
    float rstd[NR];
    f32x4 gmv[4], btv[4], sc2v[4], sh2v[4];
#pragma unroll
    for (int j = 0; j < 4; ++j) { const int c = c0 + 256 * j; gmv[j] = *(const f32x4*)(g + c); btv[j] = *(const f32x4*)(bta + c); sc2v[j] = *(const f32x4*)(md + 4096 + c); sh2v[j] = *(const f32x4*)(md + 3072 + c); }
    asm volatile("" ::: "memory");
#pragma unroll
    for (int r = 0; r < NR; ++r) { const float mean = wave_sum(sm[r]) * (1.0f / D); float q = 0.f;
#pragma unroll
        for (int j = 0; j < 4; ++j) { v[r][j] = v[r][j] - mean; q += (v[r][j][0] * v[r][j][0] + v[r][j][1] * v[r][j][1]) + (v[r][j][2] * v[r][j][2] + v[r][j][3] * v[r][j][3]); }
        sm[r] = q; }
#pragma unroll
    for (int r = 0; r < NR; ++r) rstd[r] = 1.0f / sqrtf(wave_sum(sm[r]) * (1.0f / D) + LN_EPS);
#pragma unroll
    for (int j = 0; j < 4; ++j) { const int c = c0 + 256 * j; const f32x4 gm = gmv[j], bt = btv[j], sc2 = sc2v[j], sh2 = sh2v[j];
#pragma unroll
        for (int r = 0; r < NR; ++r) { const f32x4 x1 = v[r][j] * rstd[r] * gm + bt; store_bf4(X1 + (size_t)r * D + c, x1);
            const f32x4 h2 = x1 * (1.0f + sc2) + sh2; *(unsigned*)((unsigned char*)H + (size_t)(row0 + r) * D + c) = pk_fp8x4(h2); v[r][j] = h2; } }
#pragma unroll
    for (int e = 0; e < 16; ++e) {
        f32x4 w[4];
#pragma unroll
        for (int j = 0; j < 4; ++j) w[j] = *(const LAS f32x4*)(wrT + e * 1024 + c0 + 256 * j);
#pragma unroll
        for (int r = 0; r < NR; ++r) { f32x4 acc = v[r][0] * w[0]; acc += v[r][1] * w[1]; acc += v[r][2] * w[2]; acc += v[r][3] * w[3];
            const float tot = wave_sum((acc[0] + acc[1]) + (acc[2] + acc[3]));
            lgv[e] = X.lane == slot0 + r ? tot : lgv[e]; }
        asm volatile("" ::: "memory");
    }
}
DI void ph_ln1(const Ctx& X, const Params& P, int l, bool dummy = false) {
    LAS float* wrT = (LAS float*)X.lds;
    { f32x4 t_[8];
#pragma unroll
      for (int q = 0; q < 8; ++q) t_[q] = *(const f32x4*)(P.in[16] + 4 * (X.tid + NTHREADS * q));
#pragma unroll
      for (int q = 0; q < 8; ++q) { const int i = 4 * (X.tid + NTHREADS * q), k = i >> 4, e = i & 15;
#pragma unroll
          for (int j = 0; j < 4; ++j) wrT[(e + j) * 1024 + k] = t_[q][j]; } }
    int* TOKP = (int*)(P.ws + WS_TOKP); int* LIST = (int*)(P.ws + WS_LIST);
    unsigned* CNT = (unsigned*)(P.ws + WS_CTL) + CW_CNT + 1024 * l + (dummy ? 4096 : 0);
    LAS int* lcnt = (LAS int*)(X.lds + 65536); LAS int* lbase = lcnt + 16; LAS int* linfo = lcnt + 32;
    if (X.tid < 16) lcnt[X.tid] = 0;
    for (int i = X.tid; i < 72 * 4; i += NTHREADS) linfo[i] = -1;
    __syncthreads();
    const int gw = X.bid * NWAVES + X.wave;
    float lgv[16];
#pragma unroll
    for (int e = 0; e < 16; ++e) lgv[e] = 0.f;
    if (gw < NLAT / 8) ln1_rows<8>(X, P, l, 8 * gw, 0, wrT, lgv);
    const bool hasctx = l == 0 && gw < NCTX;
    if (hasctx) ln1_rows<1>(X, P, l, NLAT + gw, 8, wrT, lgv);
    {
        int* TOKE = (int*)(P.ws + WS_TOKE); float* TOKW = (float*)(P.ws + WS_TOKW);
        const int k = X.lane; const bool valid = (k < 8 && gw < NLAT / 8) || (k == 8 && hasctx); const int row = k < 8 ? 8 * gw + k : NLAT + gw;
        float sg[16], sel[16];
#pragma unroll
        for (int e = 0; e < 16; ++e) { sg[e] = sigmoidf_(lgv[e]); sel[e] = sg[e] + P.in[17][e]; }
        int best = 0; float bestv = -3e38f;
#pragma unroll
        for (int gq = 0; gq < 4; ++gq) { float m1 = -3e38f, m2 = -3e38f;
#pragma unroll
            for (int j = 0; j < 4; ++j) { const float t = sel[gq * 4 + j]; const float lo = fminf(m1, t); m1 = fmaxf(m1, t); m2 = fmaxf(m2, lo); }
            const float gs = m1 + m2; const bool bt = gs > bestv; best = bt ? gq : best; bestv = bt ? gs : bestv; }
        int i0 = 0, i1 = 0; float v0 = -3e38f, v1 = -3e38f, s0 = 0.f, s1 = 0.f;
#pragma unroll
        for (int e = 0; e < 16; ++e) { const float t = (e >> 2) == best ? sel[e] : -3e38f; const bool c0 = t > v0, c1 = !c0 && t > v1;
            v1 = c0 ? v0 : (c1 ? t : v1); i1 = c0 ? i0 : (c1 ? e : i1); s1 = c0 ? s0 : (c1 ? sg[e] : s1);
            v0 = c0 ? t : v0; i0 = c0 ? e : i0; s0 = c0 ? sg[e] : s0; }
        if (valid) { const int slot = X.wave * 9 + k; const float inv = 1.0f / (s0 + s1);
            const int p0 = __hip_atomic_fetch_add(lcnt + i0, 1, __ATOMIC_RELAXED, __HIP_MEMORY_SCOPE_WORKGROUP), p1 = __hip_atomic_fetch_add(lcnt + i1, 1, __ATOMIC_RELAXED, __HIP_MEMORY_SCOPE_WORKGROUP);
            linfo[4 * slot] = row; linfo[4 * slot + 1] = i0 | (i1 << 8); linfo[4 * slot + 2] = p0; linfo[4 * slot + 3] = p1;
            TOKE[2 * row] = i0; TOKE[2 * row + 1] = i1; TOKW[2 * row] = s0 * inv; TOKW[2 * row + 1] = s1 * inv; }
    }
    __syncthreads();
    if (X.tid < 16) lbase[X.tid] = (int)atomicAdd(CNT + 64 * X.tid, (unsigned)lcnt[X.tid]);
    __syncthreads();
    if (X.tid < 72) { const int row = linfo[4 * X.tid];
        if (row >= 0) { const int ee = linfo[4 * X.tid + 1], e0 = ee & 255, e1 = ee >> 8, p0 = lbase[e0] + linfo[4 * X.tid + 2], p1 = lbase[e1] + linfo[4 * X.tid + 3];
            LIST[e0 * LISTCAP + p0] = row; LIST[e1 * LISTCAP + p1] = row; TOKP[2 * row] = p0; TOKP[2 * row + 1] = p1; } }
}
template <int NR> struct Ln2Raw { u32x2 x[NR][4]; int a[NR][4], b[NR][4]; float w0[NR], w1[NR]; };
template <int NR>
DI void ln2_load(const Ctx& X, const Params& P, int l, int row0, const int (&off)[16], Ln2Raw<NR>& R) {
    const unsigned char* O = P.ws + WS_O; const bf16_t* X1 = (const bf16_t*)(P.ws + WS_X1) + (size_t)row0 * D;
    const int* TOKE = (const int*)(P.ws + WS_TOKE); const int* TOKP = (const int*)(P.ws + WS_TOKP); const float* TOKW = (const float*)(P.ws + WS_TOKW);
    const int c0 = 4 * X.lane;
    const unsigned char* ra[NR]; const unsigned char* rb[NR];
#pragma unroll
    for (int r = 0; r < NR; ++r) { const int row = row0 + r; const int e0 = TOKE[2 * row], e1 = TOKE[2 * row + 1]; int o0 = 0, o1 = 0;
#pragma unroll
        for (int e = 0; e < 16; ++e) { if (e == e0) o0 = off[e]; if (e == e1) o1 = off[e]; }
        ra[r] = O + (size_t)(o0 + TOKP[2 * row]) * D; rb[r] = O + (size_t)(o1 + TOKP[2 * row + 1]) * D; R.w0[r] = TOKW[2 * row] * 0.0625f; R.w1[r] = TOKW[2 * row + 1] * 0.0625f; }
#pragma unroll
    for (int j = 0; j < 4; ++j) { const int c = c0 + 256 * j;
#pragma unroll
        for (int r = 0; r < NR; ++r) { R.x[r][j] = __builtin_nontemporal_load((const u32x2*)(X1 + (size_t)r * D + c)); R.a[r][j] = __builtin_nontemporal_load((const int*)(ra[r] + c)); R.b[r][j] = __builtin_nontemporal_load((const int*)(rb[r] + c)); } }
}
template <int NR>
DI void ln2_rows(const Ctx& X, const Params& P, int l, int row0, const Ln2Raw<NR>& R) {
    bf16_t* H = (bf16_t*)(P.ws + WS_H);
    const float* g = P.in[14] + l * D; const float* bta = P.in[15] + l * D;
    const bool lat = row0 < NLAT;
    const float* md = mods_row(P, l, row0); const float* mdn = mods_row(P, 1, row0);
    const int c0 = 4 * X.lane;
    f32x4 v[NR][4]; float sm[NR];
#pragma unroll
    for (int r = 0; r < NR; ++r) sm[r] = 0.f;
#pragma unroll
    for (int j = 0; j < 4; ++j) { const int c = c0 + 256 * j; const f32x4 g2 = *(const f32x4*)(md + 5120 + c);
#pragma unroll
        for (int r = 0; r < NR; ++r) { const u32x2 xw = R.x[r][j]; const f32x4 x = {bflo(xw.x), bfhi(xw.x), bflo(xw.y), bfhi(xw.y)}; const int a = R.a[r][j], b = R.b[r][j];
            const f32x2 a01 = __builtin_amdgcn_cvt_pk_f32_fp8(a, false), a23 = __builtin_amdgcn_cvt_pk_f32_fp8(a, true), b01 = __builtin_amdgcn_cvt_pk_f32_fp8(b, false), b23 = __builtin_amdgcn_cvt_pk_f32_fp8(b, true);
            const f32x4 f = R.w0[r] * (f32x4){a01[0], a01[1], a23[0], a23[1]} + R.w1[r] * (f32x4){b01[0], b01[1], b23[0], b23[1]};
            v[r][j] = ALPHA * x + g2 * f; sm[r] += (v[r][j][0] + v[r][j][1]) + (v[r][j][2] + v[r][j][3]); } }
    float rstd[NR];
#pragma unroll
    for (int r = 0; r < NR; ++r) { const float mean = wave_sum(sm[r]) * (1.0f / D); float q = 0.f;
#pragma unroll
        for (int j = 0; j < 4; ++j) { v[r][j] = v[r][j] - mean; q += (v[r][j][0] * v[r][j][0] + v[r][j][1] * v[r][j][1]) + (v[r][j][2] * v[r][j][2] + v[r][j][3] * v[r][j][3]); }
        sm[r] = q; }
#pragma unroll
    for (int r = 0; r < NR; ++r) rstd[r] = 1.0f / sqrtf(wave_sum(sm[r]) * (1.0f / D) + LN_EPS);
#pragma unroll
    for (int j = 0; j < 4; ++j) { const int c = c0 + 256 * j; const f32x4 gm = *(const f32x4*)(g + c), bt = *(const f32x4*)(bta + c);
        f32x4 sc1 = {0.f, 0.f, 0.f, 0.f}, sh1 = {0.f, 0.f, 0.f, 0.f}; if (l == 0) { sc1 = *(const f32x4*)(mdn + 1024 + c); sh1 = *(const f32x4*)(mdn + c); }
#pragma unroll
        for (int r = 0; r < NR; ++r) { const f32x4 x2 = v[r][j] * rstd[r] * gm + bt;
            if (l == 0) { if (lat) store_bf4((bf16_t*)P.out + (size_t)(row0 + r) * D + c, x2); *(unsigned*)((unsigned char*)H + (size_t)(row0 + r) * D + c) = pk_fp8x4(x2 * (1.0f + sc1) + sh1); }
            else __builtin_nontemporal_store(x2, (f32x4*)(P.out + (size_t)(row0 + r) * D + c)); } }
}
DI void ph_ln2(const Ctx& X, const Params& P, int l) {
    const unsigned* CNT = (const unsigned*)(P.ws + WS_CTL) + CW_CNT + 1024 * l;
    int off[16]; { int acc = 0;
#pragma unroll
        for (int e = 0; e < 16; ++e) { off[e] = acc; acc += (((int)CNT[e * 64] + 255) >> 8) << 8; } }
    const int gw = X.bid * NWAVES + X.wave;
    if (gw < NLAT / 8) {
        Ln2Raw<4> RA, RB; ln2_load<4>(X, P, l, 8 * gw, off, RA); ln2_load<4>(X, P, l, 8 * gw + 4, off, RB);
        asm volatile("" ::: "memory");
        ln2_rows<4>(X, P, l, 8 * gw, RA); ln2_rows<4>(X, P, l, 8 * gw + 4, RB);
    }
    if (l == 0 && gw < NCTX) { Ln2Raw<1> RC; ln2_load<1>(X, P, l, NLAT + gw, off, RC); ln2_rows<1>(X, P, l, NLAT + gw, RC); }
}

struct KeysNA { int b, r, c, rs, cs, h; const float* rpb;
    DI int n() const { return 128 + CTXL; }
    DI void get(int k, int& krow, float& bias) const { if (k < 128) { const int kr = rs + (k >> 4), kc = cs + (k & 15); krow = b * SEQ + kr * 64 + kc; bias = LOG2E * rpb[h * 465 + (kr - r + 7) * 31 + (kc - c + 15)]; } else { krow = NLAT + b * CTXL + (k - 128); bias = 0.f; } } };
struct KeysSWA { int b, lo, nband;
    DI int n() const { return nband + CTXL; }
    DI void get(int k, int& krow, float& bias) const { krow = k < nband ? b * SEQ + lo + k : NLAT + b * CTXL + (k - nband); bias = 0.f; } };
struct KeysCtx { int b;
    DI int n() const { return CTXL; }
    DI void get(int k, int& krow, float& bias) const { krow = NLAT + b * CTXL + k; bias = 0.f; } };
template <class Keys>
DI void attn_row_naive(const bf16_t* PB, int qrow, int qcol, int kcol, int vcol, const Keys& KS, bool has_sink, float sink, LAS float* sc, bf16_t* yout, int lane) {
    float q[64];
    { const u32x4* qp = (const u32x4*)(PB + (size_t)qrow * PBW + qcol);
#pragma unroll
      for (int i = 0; i < 8; ++i) { const u32x4 w = qp[i]; q[8 * i] = bflo(w.x); q[8 * i + 1] = bfhi(w.x); q[8 * i + 2] = bflo(w.y); q[8 * i + 3] = bfhi(w.y); q[8 * i + 4] = bflo(w.z); q[8 * i + 5] = bfhi(w.z); q[8 * i + 6] = bflo(w.w); q[8 * i + 7] = bfhi(w.w); } }
    const int nk = KS.n(); float mx = has_sink ? sink : -3e38f;
    for (int k = lane; k < nk; k += 64) { int krow; float bias; KS.get(k, krow, bias);
        const u32x4* kp = (const u32x4*)(PB + (size_t)krow * PBW + kcol); float s = 0.f;
#pragma unroll
        for (int i = 0; i < 8; ++i) { const u32x4 w = kp[i]; s += q[8 * i] * bflo(w.x) + q[8 * i + 1] * bfhi(w.x) + q[8 * i + 2] * bflo(w.y) + q[8 * i + 3] * bfhi(w.y) + q[8 * i + 4] * bflo(w.z) + q[8 * i + 5] * bfhi(w.z) + q[8 * i + 6] * bflo(w.w) + q[8 * i + 7] * bfhi(w.w); }
        s += bias; sc[k] = s; mx = fmaxf(mx, s); }
    mx = wave_max(mx); float den = 0.f;
    for (int k = lane; k < nk; k += 64) { const float p = exp2f(sc[k] - mx); sc[k] = p; den += p; }
    den = wave_sum(den); if (has_sink) den += exp2f(sink - mx);
    asm volatile("s_waitcnt lgkmcnt(0)" ::: "memory");
    float o = 0.f;
    for (int k = 0; k < nk; ++k) { int krow; float bias; KS.get(k, krow, bias); o += sc[k] * bf2f(PB[(size_t)krow * PBW + vcol + lane]); }
    yout[lane] = (bf16_t)f2bf(o / den);
    asm volatile("s_waitcnt lgkmcnt(0)" ::: "memory");
}
DI void ph_attn_naive(const Ctx& X, const Params& P, int l) {
    const bf16_t* PB = (const bf16_t*)(P.ws + WS_PB); bf16_t* Y = (bf16_t*)(P.ws + WS_Y);
    LAS float* sc = (LAS float*)X.lds + X.wave * 640;
    const float* rpb = P.in[9] + l * 4 * 465; const float* sink = P.in[10] + l * 8;
    const int nrows = l == 0 ? NROWS : NLAT;
    const int gw = X.bid * NWAVES + X.wave, NGW = X.nb * NWAVES;
    for (int it = gw; it < nrows * 12; it += NGW) {
        const int row = it / 12, hh = it % 12;
        if (row < NLAT) { const int b = row >> 13, t = row & (SEQ - 1);
            if (hh < 4) { KeysNA K; K.b = b; K.r = t >> 6; K.c = t & 63; K.rs = min(max(K.r - 4, 0), 120); K.cs = min(max(K.c - 8, 0), 48); K.h = hh; K.rpb = rpb;
                attn_row_naive(PB, row, PB_NQ + hh * 64, PB_NK + hh * 64, PB_NV + hh * 64, K, false, 0.f, sc, Y + (size_t)row * D + 256 + hh * 64, X.lane);
            } else { const int qh = hh - 4, n = qh >> 2; KeysSWA K; K.b = b; K.lo = max(t - 128, 0); K.nband = min(t + 128, SEQ - 1) - K.lo + 1;
                attn_row_naive(PB, row, PB_SQ + qh * 64, PB_SK + n * 64, PB_SV + n * 64, K, true, LOG2E * sink[qh], sc, Y + (size_t)row * D + 512 + qh * 64, X.lane); }
        } else { const int b = (row - NLAT) >> 8; KeysCtx K; K.b = b;
            if (hh < 4) attn_row_naive(PB, row, PB_NQ + hh * 64, PB_NK + hh * 64, PB_NV + hh * 64, K, false, 0.f, sc, Y + (size_t)row * D + 256 + hh * 64, X.lane);
            else { const int qh = hh - 4, n = qh >> 2; attn_row_naive(PB, row, PB_SQ + qh * 64, PB_SK + n * 64, PB_SV + n * 64, K, true, LOG2E * sink[qh], sc, Y + (size_t)row * D + 512 + qh * 64, X.lane); }
        }
    }
}
DI void ph_hgrn_naive(const Ctx& X, const Params& P, int l) {
    const bf16_t* PB = (const bf16_t*)(P.ws + WS_PB); const float* Z = (const float*)(P.ws + WS_Z); float* O32 = (float*)(P.ws + WS_S);
    const float* LB = (const float*)(P.ws + WS_LB) + l * 512;
    const int gw = X.bid * NWAVES + X.wave;
    if (gw >= 16) return;
    const int b = gw >> 3, h = (gw >> 1) & 3, dir = gw & 1, lane = X.lane;
    const float lb = LB[dir * 256 + h * 64 + lane];
    float S[64];
#pragma unroll
    for (int d = 0; d < 64; ++d) S[d] = 0.f;
    for (int step = 0; step < CTXL + SEQ; ++step) {
        int row;
        if (step < CTXL) row = NLAT + b * CTXL + (dir ? CTXL - 1 - step : step); else { const int t = step - CTXL; row = b * SEQ + (dir ? SEQ - 1 - t : t); }
        float f = exp2f(bf2f(((const bf16_t*)Z)[(size_t)row * ZW + dir * 256 + h * 64 + lane])); const float kk = bf2f(((const bf16_t*)(P.ws + WS_KK))[(size_t)row * ZW + dir * 256 + h * 64 + lane]); (void)lb;
#if DBG_HG_MODE & 8
        f = 1.0f;
#endif
        const float qv = bf2f(PB[(size_t)row * PBW + PB_AQ + h * 64 + lane]), vv = bf2f(PB[(size_t)row * PBW + PB_AI + h * 64 + lane]);
#if DBG_HG_MODE & 1
        if ((step & 63) == 0) {
#pragma unroll
            for (int d = 0; d < 64; ++d) S[d] = 0.f; }
#endif
        float o = 0.f;
#pragma unroll
        for (int d = 0; d < 64; ++d) { const float fd = __builtin_bit_cast(float, __builtin_amdgcn_readlane(__builtin_bit_cast(int, f), d)), kd = __builtin_bit_cast(float, __builtin_amdgcn_readlane(__builtin_bit_cast(int, kk), d)), qd = __builtin_bit_cast(float, __builtin_amdgcn_readlane(__builtin_bit_cast(int, qv), d));
            S[d] = fd * S[d] + kd * vv; o += S[d] * qd; }
#if DBG_HG_MODE & 2
        if (dir == 1) o = 0.f;
#endif
#if DBG_HG_MODE & 4
        if (dir == 0) o = 0.f;
#endif
        O32[((size_t)dir * NROWS + row) * 256 + h * 64 + lane] = o;
    }
}
DI void ph_hgrn_combine_naive(const Ctx& X, const Params& P, int l) {
    const bf16_t* PB = (const bf16_t*)(P.ws + WS_PB); const float* O32 = (const float*)(P.ws + WS_S); bf16_t* Y = (bf16_t*)(P.ws + WS_Y);
    const float* nw = P.in[8] + l * 64;
    const int nrows = l == 0 ? NROWS : NLAT;
    const int gw = X.bid * NWAVES + X.wave, NGW = X.nb * NWAVES;
    for (int it = gw; it < nrows * 4; it += NGW) { const int row = it >> 2, h = it & 3;
        const float o = O32[(size_t)row * 256 + h * 64 + X.lane] + O32[((size_t)NROWS + row) * 256 + h * 64 + X.lane];
        const float ms = wave_sum(o * o) * (1.0f / 64.0f); const float y = o * (1.0f / sqrtf(ms + RMS_EPS)) * nw[X.lane];
        const float gte = bf2f(PB[(size_t)row * PBW + PB_AG + h * 64 + X.lane]);
        Y[(size_t)row * D + h * 64 + X.lane] = (bf16_t)f2bf(y * siluf_(gte)); }
}

typedef short v4i16_t __attribute__((ext_vector_type(4)));
DI s16x4 tr_read(const LAS unsigned char* p) { return __builtin_bit_cast(s16x4, __builtin_amdgcn_ds_read_tr16_b64_v4i16((LAS v4i16_t*)p)); }
DI bf16x8 cat8(s16x4 a, s16x4 b) { return __builtin_shufflevector(a, b, 0, 1, 2, 3, 4, 5, 6, 7); }
DI bf16x8 pack8(float a0, float a1, float a2, float a3, float a4, float a5, float a6, float a7) {
    u32x4 w; w.x = pk2(a0, a1); w.y = pk2(a2, a3); w.z = pk2(a4, a5); w.w = pk2(a6, a7); return __builtin_bit_cast(bf16x8, w); }
DI float shfl_f(float v, int src) { return __shfl(v, src); }

constexpr int HP = 144;
constexpr size_t WS_QT = WS_H, WS_KT = WS_H + (size_t)2 * NROWS * 256 * 2;
#ifdef DBG_MIX
constexpr size_t WS_ST = 318 * MiB;
#else
constexpr size_t WS_ST = WS_Z;
#endif
DI size_t st_base(const Ctx& X) {
#ifdef QPROBE
    return *(volatile LAS unsigned*)(X.lds + 144 * 1024 + 48) ? WS_Y : WS_ST;
#else
    (void)X; return WS_ST;
#endif
}
static_assert(WS_KT + (size_t)2 * NROWS * 256 * 2 <= WS_Y && (size_t)2112 * 4096 * 2 <= (size_t)NROWS * ZW * 4, "hgrn buffers");
DI void hgrn_chunk_rows(int b, int dir, int p, int& row0) {
    if (p < 4) row0 = NLAT + b * CTXL + 64 * (dir ? 3 - p : p); else row0 = b * SEQ + 64 * (dir ? 131 - p : p - 4);
}
DI void hgrn_local_item(const Ctx& X, const Params& P, int l, int it) {
    const bf16_t* PB = (const bf16_t*)(P.ws + WS_PB); const bf16_t* Z = (const bf16_t*)(P.ws + WS_Z);
    bf16_t* QT = (bf16_t*)(P.ws + WS_QT); bf16_t* KT = (bf16_t*)(P.ws + WS_KT); float* U = (float*)(P.ws + WS_S); float* DD = (float*)(P.ws + WS_DD); float* ER = DD + 2112 * 64;
    const float* LB = (const float*)(P.ws + WS_LB) + l * 512;
    LAS unsigned char* kt_l = X.lds + X.wave * (2 * 64 * HP); LAS unsigned char* v_l = kt_l + 64 * HP;
    const int lane = X.lane;
    if (it < 2112) {
        const int p = it % NCHAIN, chain = it / NCHAIN, dir = chain & 1, h = (chain >> 1) & 3, b = chain >> 3;
        int row0; hgrn_chunk_rows(b, dir, p, row0);
#pragma unroll
        for (int i = 0; i < 8; ++i) { const int r = i * 8 + (lane >> 3), pc = lane & 7; const u32x4 w = *(const u32x4*)(PB + (size_t)(row0 + r) * PBW + PB_AI + h * 64 + pc * 8); *(LAS u32x4*)(v_l + r * HP + pc * 16) = w; }
        float lf[64];
        const bf16_t* zp = Z + (size_t)row0 * ZW + dir * 256 + h * 64 + lane;
#pragma unroll
        for (int s = 0; s < 64; ++s) lf[s] = bf2f(zp[(size_t)s * ZW]);
        unsigned kkp[32];
#pragma unroll
        for (int s = 0; s < 64; s += 2) kkp[s >> 1] = pk2(1.0f - __builtin_amdgcn_exp2f(lf[s]), 1.0f - __builtin_amdgcn_exp2f(lf[s + 1]));
        float ref, last;
        if (dir == 0) {
#pragma unroll
            for (int s = 1; s < 64; ++s) lf[s] += lf[s - 1];
            ref = lf[31]; last = lf[63];
        } else {
#pragma unroll
            for (int s = 62; s >= 0; --s) lf[s] += lf[s + 1];
            ref = lf[32]; last = lf[0];
        }
        const bf16_t* qp = PB + (size_t)row0 * PBW + PB_AQ + h * 64 + lane; const bf16_t* kp = (const bf16_t*)(P.ws + WS_KK) + (size_t)row0 * ZW + dir * 256 + h * 64 + lane;
        bf16_t* qto = QT + ((size_t)dir * NROWS + row0) * 256 + h * 64 + lane; bf16_t* kto = KT + ((size_t)dir * NROWS + row0) * 256 + h * 64 + lane;
#pragma unroll
        for (int hf = 0; hf < 2; ++hf) {
            unsigned short qv[32];
#pragma unroll
            for (int s = 0; s < 32; ++s) qv[s] = qp[(size_t)(32 * hf + s) * PBW];
#pragma unroll
            for (int s2 = 0; s2 < 32; ++s2) { const int s = 32 * hf + s2;
                const float q = bf2f(qv[s2]), kk = (s & 1) ? bfhi(kkp[s >> 1]) : bflo(kkp[s >> 1]);
                const float eq = __builtin_amdgcn_exp2f(lf[s] - ref), ek = __builtin_amdgcn_exp2f(ref - lf[s]);
                const unsigned short qb = (unsigned short)f2bf(q * eq), kb = (unsigned short)f2bf(kk * ek);
                st_wth(qto + (size_t)s * 256, qb); st_wth(kto + (size_t)s * 256, kb);
                *(LAS unsigned short*)(kt_l + s * HP + lane * 2) = kb; }
            asm volatile("" ::: "memory");
        }
        asm volatile("" ::: "memory");
        const float e_lr = __builtin_amdgcn_exp2f(last - ref);
        st_wtf(DD + it * 64 + lane, __builtin_amdgcn_exp2f(last)); st_wtf(ER + it * 64 + lane, __builtin_amdgcn_exp2f(ref));
        f32x4 acc[4][4];
#pragma unroll
        for (int m = 0; m < 4; ++m)
#pragma unroll
            for (int n = 0; n < 4; ++n) acc[m][n] = (f32x4){0.f, 0.f, 0.f, 0.f};
        const int g = lane >> 4, i16 = lane & 15;
        const int troff = (8 * g + (i16 >> 2)) * HP + (i16 & 3) * 8;
#pragma unroll
        for (int ks = 0; ks < 2; ++ks) {
            bf16x8 af[4], bfv[4];
#pragma unroll
            for (int m = 0; m < 4; ++m) af[m] = cat8(tr_read(kt_l + troff + ks * 32 * HP + m * 32), tr_read(kt_l + troff + (ks * 32 + 4) * HP + m * 32));
#pragma unroll
            for (int n = 0; n < 4; ++n) bfv[n] = cat8(tr_read(v_l + troff + ks * 32 * HP + n * 32), tr_read(v_l + troff + (ks * 32 + 4) * HP + n * 32));
#pragma unroll
            for (int m = 0; m < 4; ++m)
#pragma unroll
                for (int n = 0; n < 4; ++n) acc[m][n] = __builtin_amdgcn_mfma_f32_16x16x32_bf16(af[m], bfv[n], acc[m][n], 0, 0, 0);
        }
        float* up = U + (size_t)it * 4096;
#pragma unroll
        for (int m = 0; m < 4; ++m)
#pragma unroll
            for (int r = 0; r < 4; ++r) { const int d = 16 * m + 4 * g + r; const float sc = shfl_f(e_lr, d);
#pragma unroll
                for (int n = 0; n < 4; ++n) st_wtf(up + d * 64 + 16 * n + i16, acc[m][n][r] * sc); }
        asm volatile("s_waitcnt lgkmcnt(0)" ::: "memory");
    }
}
DI void ph_hgrn_scan(const Ctx& X, const Params& P, int part) {
    const float* U = (const float*)(P.ws + WS_S); const float* DD = (const float*)(P.ws + WS_DD); const float* ER = DD + 2112 * 64; bf16_t* ST = (bf16_t*)(P.ws + st_base(X));
    const int gt = part * NTHREADS + X.tid;
    const int chain = gt >> 11, d = (gt >> 5) & 63, e2 = (gt & 31) * 2;
    float s0 = 0.f, s1 = 0.f;
    for (int p0 = 0; p0 < NCHAIN; p0 += 4) {
        f32x2 u[4]; float dd[4], er[4];
#pragma unroll
        for (int j = 0; j < 4; ++j) { const int slot = chain * NCHAIN + p0 + j; u[j] = __builtin_nontemporal_load((const f32x2*)(U + (size_t)slot * 4096 + d * 64 + e2)); dd[j] = DD[slot * 64 + d]; er[j] = ER[slot * 64 + d]; }
#pragma unroll
        for (int j = 0; j < 4; ++j) { const int slot = chain * NCHAIN + p0 + j; st_wt(ST + (size_t)slot * 4096 + d * 64 + e2, pk2(s0 * er[j], s1 * er[j])); s0 = dd[j] * s0 + u[j][0]; s1 = dd[j] * s1 + u[j][1]; }
    }
}
DI void hgrn_out_item(const Ctx& X, const Params& P, int l, int it) {
    const bf16_t* PB = (const bf16_t*)(P.ws + WS_PB); const bf16_t* QT = (const bf16_t*)(P.ws + WS_QT); const bf16_t* KT = (const bf16_t*)(P.ws + WS_KT); const bf16_t* ST = (const bf16_t*)(P.ws + st_base(X));
    unsigned char* Y = P.ws + WS_Y;        const float* nw = P.in[8] + l * 64;
    LAS unsigned char* s_l = X.lds + X.wave * (2 * 64 * HP); LAS unsigned char* v_l = s_l + 64 * HP;
    const int lane = X.lane, g = lane >> 4, i16 = lane & 15, gw = X.wave * X.nb + X.bid, NGW = X.nb * NWAVES;
    const int nchunk = l == 0 ? 132 : 128;
    const int troff = (8 * g + (i16 >> 2)) * HP + (i16 & 3) * 8;
    const int troff4 = (4 * g + (i16 >> 2)) * HP + (i16 & 3) * 8;
    (void)gw; (void)NGW;
    if (it < 8 * nchunk) {
        const int c = it % nchunk, bh = it / nchunk, h = bh & 3, b = bh >> 2;
        const bool isctx = c >= 128; const int row0 = isctx ? NLAT + b * CTXL + 64 * (c - 128) : b * SEQ + 64 * c;
#pragma unroll
        for (int i = 0; i < 8; ++i) { const int r = i * 8 + (lane >> 3), pc = lane & 7; const u32x4 w = *(const u32x4*)(PB + (size_t)(row0 + r) * PBW + PB_AI + h * 64 + pc * 8); *(LAS u32x4*)(v_l + r * HP + pc * 16) = w; }
        f32x4 o[4][4];
#pragma unroll
        for (int a = 0; a < 4; ++a)
#pragma unroll
            for (int t = 0; t < 4; ++t) o[a][t] = (f32x4){0.f, 0.f, 0.f, 0.f};
#pragma unroll 1
        for (int dir = 0; dir < 2; ++dir) {
#if DBG_HG_MODE & 2
            if (dir == 1) continue;
#endif
#if DBG_HG_MODE & 4
            if (dir == 0) continue;
#endif
            const int p = isctx ? (dir ? 3 - (c - 128) : c - 128) : (dir ? 127 - c + 4 : c + 4);
            const int slot = ((b * 4 + h) * 2 + dir) * NCHAIN + p, sgn = 1 - 2 * dir;
            asm volatile("s_waitcnt lgkmcnt(0)" ::: "memory");
            u32x4 stv[8];
#pragma unroll
            for (int i = 0; i < 8; ++i) { const int r = i * 8 + (lane >> 3), pc = lane & 7; stv[i] = *(const u32x4*)(ST + (size_t)slot * 4096 + r * 64 + pc * 8); }
            const bf16_t* qt = QT + ((size_t)dir * NROWS + row0) * 256 + h * 64 + g * 8; const bf16_t* kt = KT + ((size_t)dir * NROWS + row0) * 256 + h * 64 + g * 8;
            bf16x8 qf[4][2];
#pragma unroll
            for (int t = 0; t < 4; ++t)
#pragma unroll
                for (int ks = 0; ks < 2; ++ks) qf[t][ks] = *(const bf16x8*)(qt + (size_t)(16 * t + i16) * 256 + 32 * ks);
            bf16x8 kfa[2][2][2];
#pragma unroll
            for (int pr = 0; pr < 2; ++pr)
#pragma unroll
                for (int t = 0; t < 2; ++t)
#pragma unroll
                    for (int ks = 0; ks < 2; ++ks) kfa[pr][t][ks] = *(const bf16x8*)(kt + (size_t)(16 * (2 * pr + t) + i16) * 256 + 32 * ks);
            asm volatile("" ::: "memory");
#pragma unroll
            for (int i = 0; i < 8; ++i) { const int r = i * 8 + (lane >> 3), pc = lane & 7; *(LAS u32x4*)(s_l + r * HP + pc * 16) = stv[i]; }
#pragma unroll
            for (int pr = 0; pr < 2; ++pr) {
                bf16x8 kf[2][2];
#pragma unroll
                for (int t = 0; t < 2; ++t)
#pragma unroll
                    for (int ks = 0; ks < 2; ++ks) kf[t][ks] = kfa[pr][t][ks];
                f32x4 sc[2][4];
#pragma unroll
                for (int s2 = 0; s2 < 2; ++s2)
#pragma unroll
                    for (int tt = 0; tt < 4; ++tt) { f32x4 a = {0.f, 0.f, 0.f, 0.f};
                        a = __builtin_amdgcn_mfma_f32_16x16x32_bf16(kf[s2][0], qf[tt][0], a, 0, 0, 0); a = __builtin_amdgcn_mfma_f32_16x16x32_bf16(kf[s2][1], qf[tt][1], a, 0, 0, 0);
#pragma unroll
                        for (int r = 0; r < 4; ++r) { const int sidx = 16 * (2 * pr + s2) + 4 * g + r, tidx = 16 * tt + i16; const int keep = ~(((tidx - sidx) * sgn) >> 31); { const float av = a[r]; a[r] = __int_as_float(__float_as_int(av) & keep); } }
                        sc[s2][tt] = a; }
                bf16x8 vf[4];
#pragma unroll
#ifdef DBG_NO_TR
                for (int et = 0; et < 4; ++et) { unsigned short tv[8];
#pragma unroll
                    for (int j = 0; j < 8; ++j) { const int sidx = 32 * pr + (j < 4 ? 4 * g + j : 16 + 4 * g + (j - 4)); tv[j] = *(const LAS unsigned short*)(v_l + sidx * HP + (16 * et + i16) * 2); }
                    u32x4 w; w.x = tv[0] | ((unsigned)tv[1] << 16); w.y = tv[2] | ((unsigned)tv[3] << 16); w.z = tv[4] | ((unsigned)tv[5] << 16); w.w = tv[6] | ((unsigned)tv[7] << 16); vf[et] = __builtin_bit_cast(bf16x8, w); }
#else
                for (int et = 0; et < 4; ++et) vf[et] = cat8(tr_read(v_l + troff4 + (32 * pr) * HP + et * 32), tr_read(v_l + troff4 + (32 * pr + 16) * HP + et * 32));
#endif
#ifdef DBG_BRUTE
                {   float* dacc = (float*)(P.ws + WS_CTL) + CW_DBG + 16; float nA = 0.f, dA = 0.f, nB = 0.f, dB = 0.f;
                    const bf16_t* qt0 = QT + ((size_t)dir * NROWS + row0) * 256 + h * 64; const bf16_t* kt0 = KT + ((size_t)dir * NROWS + row0) * 256 + h * 64;
#if DBG_TEST == 1
#pragma unroll
                    for (int s2 = 0; s2 < 2; ++s2)
#pragma unroll
                        for (int tt = 0; tt < 4; ++tt)
#pragma unroll
                            for (int r = 0; r < 4; ++r) *(LAS float*)(s_l + (((s2 * 4 + tt) * 4 + r) * 64 + lane) * 4) = sc[s2][tt][r];
                    asm volatile("s_waitcnt lgkmcnt(0)" ::: "memory");
#pragma unroll 1
                    for (int idx = 0; idx < 32; ++idx) { const int s2 = idx >> 4, tt = (idx >> 2) & 3, r = idx & 3; const int sidx = 16 * (2 * pr + s2) + 4 * g + r, tidx = 16 * tt + i16; float ref = 0.f;
#pragma unroll 1
                        for (int d = 0; d < 64; ++d) ref += bf2f(kt0[(size_t)sidx * 256 + d]) * bf2f(qt0[(size_t)tidx * 256 + d]);
                        if (sidx > tidx) ref = 0.f; const float got = *(LAS float*)(s_l + (idx * 64 + lane) * 4); const float df = got - ref; nA += df * df; dA += ref * ref; }
#endif
#if DBG_TEST == 2
#pragma unroll
                    for (int et = 0; et < 4; ++et)
#pragma unroll
                        for (int j = 0; j < 8; ++j) { const int sidx = 32 * pr + (j < 4 ? 4 * g + j : 16 + 4 * g + (j - 4)); const float ref = bf2f(PB[(size_t)(row0 + sidx) * PBW + PB_AI + h * 64 + 16 * et + i16]);
                            const float got = bf2f((unsigned short)vf[et][j]); const float df = got - ref; nB += df * df; dB += ref * ref; asm volatile("" : "+v"(nB), "+v"(dB) :: "memory"); }
#endif
                    nA = wave_sum(nA); dA = wave_sum(dA); nB = wave_sum(nB); dB = wave_sum(dB); if (lane == 0) { atomicAdd(dacc, nA); atomicAdd(dacc + 1, dA); atomicAdd(dacc + 2, nB); atomicAdd(dacc + 3, dB); }
                }
#endif
#pragma unroll
                for (int tt = 0; tt < 4; ++tt) { const f32x4 p0 = sc[0][tt], p1 = sc[1][tt]; const bf16x8 pf = pack8(p0[0], p0[1], p0[2], p0[3], p1[0], p1[1], p1[2], p1[3]);
#pragma unroll
                    for (int et = 0; et < 4; ++et) o[et][tt] = __builtin_amdgcn_mfma_f32_16x16x32_bf16(vf[et], pf, o[et][tt], 0, 0, 0); }
                asm volatile("" ::: "memory");
            }
#pragma unroll
            for (int ks = 0; ks < ((DBG_HG_MODE & 1) ? 0 : 2); ++ks) {
                bf16x8 sf[4];
#pragma unroll
                for (int et = 0; et < 4; ++et) sf[et] = cat8(tr_read(s_l + troff + (32 * ks) * HP + et * 32), tr_read(s_l + troff + (32 * ks + 4) * HP + et * 32));
#pragma unroll
                for (int tt = 0; tt < 4; ++tt)
#pragma unroll
                    for (int et = 0; et < 4; ++et) o[et][tt] = __builtin_amdgcn_mfma_f32_16x16x32_bf16(sf[et], qf[tt][ks], o[et][tt], 0, 0, 0);
            }
        }
#if defined(DBG_BRUTE) && DBG_TEST == 3
        {
            float* dacc = (float*)(P.ws + WS_CTL) + CW_DBG + 8; float num = 0.f, den = 0.f;
            const bf16_t* qt0 = QT + ((size_t)0 * NROWS + row0) * 256 + h * 64; const bf16_t* kt0 = KT + ((size_t)0 * NROWS + row0) * 256 + h * 64;
            for (int tt = 0; tt < 4; ++tt) for (int et = 0; et < 4; ++et) for (int r = 0; r < 4; ++r) {
                const int t = 16 * tt + i16, e = 16 * et + 4 * g + r; float ref = 0.f;
                for (int s2 = 0; s2 <= t; ++s2) { float sc = 0.f; for (int d = 0; d < 64; ++d) sc += bf2f(kt0[(size_t)s2 * 256 + d]) * bf2f(qt0[(size_t)t * 256 + d]);
                    ref += bf2f((unsigned short)f2bf(sc)) * bf2f(PB[(size_t)(row0 + s2) * PBW + PB_AI + h * 64 + e]); }
                float got = 0.f;
#pragma unroll
                for (int a = 0; a < 4; ++a)
#pragma unroll
                    for (int b2 = 0; b2 < 4; ++b2)
#pragma unroll
                        for (int c2 = 0; c2 < 4; ++c2) if (a == tt && b2 == et && c2 == r) got = o[b2][a][c2];
                num += (got - ref) * (got - ref); den += ref * ref; }
            num = wave_sum(num); den = wave_sum(den); if (lane == 0) { atomicAdd(dacc, num); atomicAdd(dacc + 1, den); }
        }
#endif
        u32x2 gwv[4][4];
#pragma unroll
        for (int tt = 0; tt < 4; ++tt)
#pragma unroll
            for (int et = 0; et < 4; ++et) gwv[tt][et] = *(const u32x2*)(PB + ((size_t)row0 + 16 * tt + i16) * PBW + PB_AG + h * 64 + 16 * et + 4 * g);
        asm volatile("" ::: "memory");
#pragma unroll
        for (int tt = 0; tt < 4; ++tt) {
            float ss = 0.f;
#pragma unroll
            for (int et = 0; et < 4; ++et) ss += (o[et][tt][0] * o[et][tt][0] + o[et][tt][1] * o[et][tt][1]) + (o[et][tt][2] * o[et][tt][2] + o[et][tt][3] * o[et][tt][3]);
            ss += __shfl_xor(ss, 16); ss += __shfl_xor(ss, 32);
            const float rstd = 1.0f / sqrtf(ss * (1.0f / 64.0f) + RMS_EPS);
            const size_t row = (size_t)row0 + 16 * tt + i16;
#pragma unroll
            for (int et = 0; et < 4; ++et) { const int e = 16 * et + 4 * g; const u32x2 gw2 = gwv[tt][et]; const f32x4 wv = *(const f32x4*)(nw + e);
                const f32x4 gt = {bflo(gw2.x), bfhi(gw2.x), bflo(gw2.y), bfhi(gw2.y)}; f32x4 y;
#pragma unroll
                for (int r = 0; r < 4; ++r) y[r] = o[et][tt][r] * rstd * wv[r] * siluf_(gt[r]);
                *(unsigned*)(Y + row * D + h * 64 + e) = pk_fp8x4(y); }
        }
        asm volatile("s_waitcnt lgkmcnt(0)" ::: "memory");
    }
}


DI void ph_hgrn_out(const Ctx& X, const Params& P, int l) { const int n = 8 * (l == 0 ? 132 : 128); for (int it = X.wave * X.nb + X.bid; it < n; it += X.nb * NWAVES) hgrn_out_item(X, P, l, it); }

#ifdef DBG_BRUTE
DI void ph_dbg_scores(const Ctx& X, const Params& P, int l) {
    const bf16_t* QT = (const bf16_t*)(P.ws + WS_QT); const bf16_t* KT = (const bf16_t*)(P.ws + WS_KT);
    LAS unsigned char* s_l = X.lds + X.wave * (2 * 64 * HP);
    const int lane = X.lane, g = lane >> 4, i16 = lane & 15, gw = X.wave * X.nb + X.bid, NGW = X.nb * NWAVES;
    float* dacc = (float*)(P.ws + WS_CTL) + CW_DBG + 16; float nA = 0.f, dA = 0.f;
    for (int it = gw; it < 8 * 128; it += NGW) {
        const int c = it % 128, bh = it / 128, h = bh & 3, b = bh >> 2, dir = 0, sgn = 1; const int row0 = b * SEQ + 64 * c;
        const bf16_t* qt = QT + ((size_t)dir * NROWS + row0) * 256 + h * 64 + g * 8; const bf16_t* kt = KT + ((size_t)dir * NROWS + row0) * 256 + h * 64 + g * 8;
        const bf16_t* qt0 = QT + ((size_t)dir * NROWS + row0) * 256 + h * 64; const bf16_t* kt0 = KT + ((size_t)dir * NROWS + row0) * 256 + h * 64;
        bf16x8 qf[4][2];
#pragma unroll
        for (int t = 0; t < 4; ++t)
#pragma unroll
            for (int ks = 0; ks < 2; ++ks) qf[t][ks] = *(const bf16x8*)(qt + (size_t)(16 * t + i16) * 256 + 32 * ks);
#pragma unroll 1
        for (int pr = 0; pr < 2; ++pr) {
            bf16x8 kf[2][2];
#pragma unroll
            for (int t = 0; t < 2; ++t)
#pragma unroll
                for (int ks = 0; ks < 2; ++ks) kf[t][ks] = *(const bf16x8*)(kt + (size_t)(16 * (2 * pr + t) + i16) * 256 + 32 * ks);
#pragma unroll
            for (int s2 = 0; s2 < 2; ++s2)
#pragma unroll
                for (int tt = 0; tt < 4; ++tt) { f32x4 a = {0.f, 0.f, 0.f, 0.f};
                    a = __builtin_amdgcn_mfma_f32_16x16x32_bf16(kf[s2][0], qf[tt][0], a, 0, 0, 0); a = __builtin_amdgcn_mfma_f32_16x16x32_bf16(kf[s2][1], qf[tt][1], a, 0, 0, 0);
#pragma unroll
                    for (int r = 0; r < 4; ++r) { const int sidx = 16 * (2 * pr + s2) + 4 * g + r, tidx = 16 * tt + i16; const int keep = ~(((tidx - sidx) * sgn) >> 31); { const float av = a[r]; a[r] = __int_as_float(__float_as_int(av) & keep); }
                        *(LAS float*)(s_l + (((s2 * 4 + tt) * 4 + r) * 64 + lane) * 4) = a[r]; } }
            asm volatile("s_waitcnt lgkmcnt(0)" ::: "memory");
#pragma unroll 1
            for (int idx = 0; idx < 32; ++idx) { const int s2 = idx >> 4, tt = (idx >> 2) & 3, r = idx & 3; const int sidx = 16 * (2 * pr + s2) + 4 * g + r, tidx = 16 * tt + i16; float ref = 0.f;
#pragma unroll 1
                for (int d = 0; d < 64; ++d) ref += bf2f(kt0[(size_t)sidx * 256 + d]) * bf2f(qt0[(size_t)tidx * 256 + d]);
                if (sidx > tidx) ref = 0.f; const float got = *(LAS float*)(s_l + (idx * 64 + lane) * 4); const float df = got - ref; nA += df * df; dA += ref * ref; }
            asm volatile("s_waitcnt lgkmcnt(0)" ::: "memory");
        }
    }
    nA = wave_sum(nA); dA = wave_sum(dA); if (lane == 0) { atomicAdd(dacc, nA); atomicAdd(dacc + 1, dA); }
}
#endif
constexpr int KP = 144, VP = 192, KBYTES = 128 * KP, VBYTES = 128 * VP, CHB = KBYTES + VBYTES, RPB_OFF = 2 * CHB;
static_assert(RPB_OFF + 4096 <= 144 * 1024, "attn lds");
struct ChunkSrc { int mode, rbase, kr0; };
DI int chunk_row(const ChunkSrc& c, int key) { return c.mode == 0 ? c.rbase + key : c.rbase + min(c.kr0 + (key >> 5), 127) * 64 + (key & 31); }
struct StageRegs { u32x4 k[2], v[2]; };
DI void stage_load(const Ctx& X, const bf16_t* PB, int kcol, int vcol, const ChunkSrc& c, StageRegs& R) {
#pragma unroll
    for (int i = 0; i < 2; ++i) { const int idx = X.tid + NTHREADS * i, key = idx >> 3, pc = idx & 7; const size_t row = (size_t)chunk_row(c, key);
        R.k[i] = *(const u32x4*)(PB + row * PBW + kcol + pc * 8); R.v[i] = *(const u32x4*)(PB + row * PBW + vcol + pc * 8); }
}
DI void stage_store(const Ctx& X, LAS unsigned char* buf, const StageRegs& R) {
#pragma unroll
    for (int i = 0; i < 2; ++i) { const int idx = X.tid + NTHREADS * i, key = idx >> 3, pc = idx & 7;
        *(LAS u32x4*)(buf + key * KP + pc * 16) = R.k[i]; *(LAS u32x4*)(buf + KBYTES + key * VP + pc * 16) = R.v[i]; }
}
template <int NQT> struct AttnState { f32x16 o[NQT][2]; float m[NQT], l[NQT]; };
template <int NQT, class MaskF>
DI void attn_tile_kv(const bf16x8 (&kf)[4], const LAS unsigned char* vt, int kt, const bf16x8 (&qf)[NQT][4], AttnState<NQT>& S, const bool (&act)[NQT], const MaskF& MF, int lane) {
    const int h = lane >> 5, G = lane >> 4, i16 = lane & 15;
    const LAS unsigned char* vb = vt + (4 * h + (i16 >> 2)) * VP + (16 * (G & 1) + 4 * (i16 & 3)) * 2;
    bf16x8 vf[2][2];
#pragma unroll
    for (int db = 0; db < 2; ++db)
#pragma unroll
        for (int s2 = 0; s2 < 2; ++s2) vf[db][s2] = cat8(tr_read(vb + (16 * s2) * VP + db * 64), tr_read(vb + (16 * s2 + 8) * VP + db * 64));
#pragma unroll
    for (int qt = 0; qt < NQT; ++qt) {
        if (!act[qt]) continue;
        f32x16 s;
#pragma unroll
        for (int r = 0; r < 16; ++r) s[r] = 0.f;
#pragma unroll
        for (int ks = 0; ks < 4; ++ks) s = __builtin_amdgcn_mfma_f32_32x32x16_bf16(kf[ks], qf[qt][ks], s, 0, 0, 0);
        MF(s, qt, kt);
        float mx = s[0];
#pragma unroll
        for (int r = 1; r < 16; ++r) mx = fmaxf(mx, s[r]);
        { const auto rr = __builtin_amdgcn_permlane32_swap(__float_as_uint(mx), __float_as_uint(mx), false, false); mx = fmaxf(__uint_as_float(rr[0]), __uint_as_float(rr[1])); }
        if (__builtin_amdgcn_ballot_w64(mx > S.m[qt] + 8.0f) != 0ull) {
            const float mn = fmaxf(S.m[qt], mx), alpha = __builtin_amdgcn_exp2f(S.m[qt] - mn); S.m[qt] = mn; S.l[qt] *= alpha;
#pragma unroll
            for (int db = 0; db < 2; ++db)
#pragma unroll
                for (int r = 0; r < 16; ++r) S.o[qt][db][r] *= alpha;
        }
        const float mcur = S.m[qt]; float ps = 0.f;
#pragma unroll
        for (int r = 0; r < 16; ++r) { s[r] = __builtin_amdgcn_exp2f(s[r] - mcur); ps += s[r]; }
        S.l[qt] += ps;
        const bf16x8 p0 = pack8(s[0], s[1], s[2], s[3], s[4], s[5], s[6], s[7]), p1 = pack8(s[8], s[9], s[10], s[11], s[12], s[13], s[14], s[15]);
#pragma unroll
        for (int db = 0; db < 2; ++db) { S.o[qt][db] = __builtin_amdgcn_mfma_f32_32x32x16_bf16(vf[db][0], p0, S.o[qt][db], 0, 0, 0); S.o[qt][db] = __builtin_amdgcn_mfma_f32_32x32x16_bf16(vf[db][1], p1, S.o[qt][db], 0, 0, 0); }
    }
}
template <int NQT, class MaskF>
DI void attn_tile(const LAS unsigned char* buf, int kt, const bf16x8 (&qf)[NQT][4], AttnState<NQT>& S, const bool (&act)[NQT], const MaskF& MF, int lane) {
    bf16x8 kf[4];
#pragma unroll
    for (int ks = 0; ks < 4; ++ks) kf[ks] = *(const LAS bf16x8*)(buf + (32 * kt + (lane & 31)) * KP + ks * 32 + (lane >> 5) * 16);
    attn_tile_kv<NQT, MaskF>(kf, buf + KBYTES + 32 * kt * VP, kt, qf, S, act, MF, lane);
}
template <int NQT>
DI void attn_finish(AttnState<NQT>& S, int qt, unsigned char* yrow  , int lane) {
    const int h = lane >> 5; float l = S.l[qt]; { const auto rr = __builtin_amdgcn_permlane32_swap(__float_as_uint(l), __float_as_uint(l), false, false); l = __uint_as_float(rr[0]) + __uint_as_float(rr[1]); } const float inv = 1.0f / l;
#pragma unroll
    for (int db = 0; db < 2; ++db)
#pragma unroll
        for (int gq = 0; gq < 4; ++gq) *(unsigned*)(yrow + 32 * db + 8 * gq + 4 * h) = pk_fp8x4((f32x4){S.o[qt][db][4 * gq] * inv, S.o[qt][db][4 * gq + 1] * inv, S.o[qt][db][4 * gq + 2] * inv, S.o[qt][db][4 * gq + 3] * inv});
}
struct MaskNone { DI void operator()(f32x16&, int, int) const {} };
struct MaskSWA { int cmode, u0, lane;
    DI void operator()(f32x16& s, int qt, int kt) const {
        if (cmode == 1 || 32 * kt != u0 + 32 * qt) return;
        const int sg = cmode == 0 ? 1 : -1, e = sg * (4 * (lane >> 5) - (lane & 31));
#pragma unroll
        for (int r = 0; r < 16; ++r) { const int thr = -sg * ((r & 3) + 8 * (r >> 2)); s[r] = e >= thr ? s[r] : -1e30f; }
    } };
DI void swa_item(const Ctx& X, const Params& P, int l, int it) {
    const bf16_t* PB = (const bf16_t*)(P.ws + WS_PB); unsigned char* Y = P.ws + WS_Y;        const float* sink = P.in[10] + l * 8;
    const int lane = X.lane, w = X.wave;
    {
        const int j = it & 63, n = (it >> 6) & 1, b = it >> 7;
        const int qh = n * 4 + (w >> 1), u0 = (w & 1) * 64;
        const int nchunks = 3 + (j > 0) + (j < 63);
        bf16x8 qf[2][4];
#pragma unroll
        for (int qt = 0; qt < 2; ++qt)
#pragma unroll
            for (int ks = 0; ks < 4; ++ks) qf[qt][ks] = *(const bf16x8*)(PB + (size_t)(b * SEQ + 128 * j + u0 + 32 * qt + (lane & 31)) * PBW + PB_SQ + qh * 64 + 16 * ks + 8 * (lane >> 5));
        AttnState<2> S;
#pragma unroll
        for (int qt = 0; qt < 2; ++qt) { S.m[qt] = LOG2E * sink[qh]; S.l[qt] = lane < 32 ? 1.0f : 0.0f;
#pragma unroll
            for (int db = 0; db < 2; ++db)
#pragma unroll
                for (int r = 0; r < 16; ++r) S.o[qt][db][r] = 0.f; }
        StageRegs R;
        auto chunk_id = [&](int i) -> int { return i < 2 ? 3 + i : (i == 2 ? 1 : (i == 3 ? (j > 0 ? 0 : 2) : 2)); };
        auto chunk_src = [&](int c) -> ChunkSrc { ChunkSrc cs; cs.mode = 0; cs.kr0 = 0; cs.rbase = c < 3 ? b * SEQ + 128 * (j - 1 + c) : NLAT + b * CTXL + 128 * (c - 3); return cs; };
        stage_load(X, PB, PB_SK + n * 64, PB_SV + n * 64, chunk_src(chunk_id(0)), R);
#pragma unroll
        for (int qt = 0; qt < 2; ++qt)
#pragma unroll
            for (int ks = 0; ks < 4; ++ks) asm volatile("" : "+v"(qf[qt][ks]));
        stage_store(X, X.lds, R);
        __syncthreads();
        for (int i = 0; i < nchunks; ++i) {
            const int c = chunk_id(i);
            if (i + 1 < nchunks) stage_load(X, PB, PB_SK + n * 64, PB_SV + n * 64, chunk_src(chunk_id(i + 1)), R);
            const LAS unsigned char* buf = X.lds + (i & 1) * CHB;
            MaskSWA MF; MF.cmode = c == 0 ? 0 : (c == 2 ? 2 : 1); MF.u0 = u0; MF.lane = lane;
#pragma unroll 1
            for (int kt = 0; kt < 4; ++kt) {
                bool act[2];
#pragma unroll
                for (int qt = 0; qt < 2; ++qt) act[qt] = c == 0 ? (32 * kt + 31 >= u0 + 32 * qt) : (c == 2 ? (32 * kt <= u0 + 32 * qt + 31) : true);
                if (!(act[0] || act[1])) continue;
                attn_tile<2>(buf, kt, qf, S, act, MF, lane);
            }
            if (i + 1 < nchunks) stage_store(X, X.lds + ((i + 1) & 1) * CHB, R);
            __syncthreads();
        }
#pragma unroll
        for (int qt = 0; qt < 2; ++qt) attn_finish<2>(S, qt, Y + (size_t)(b * SEQ + 128 * j + u0 + 32 * qt + (lane & 31)) * D + 512 + qh * 64, lane);
    }
}
struct MaskNA { bool win; int kr0, qr, qc, rs, cs, blk, lane; const LAS float* rpb;
    DI void operator()(f32x16& s, int qt, int kt) const {
        if (!win) return;
        const int kr = kr0 + kt; const bool rowok = kr >= rs && kr < rs + 8;
        const int kcb = blk + 4 * (lane >> 5); const int ib = rowok ? (kr - qr + 7) * 31 + (kcb - qc + 15) : 0;
        float bv[16];
#pragma unroll
        for (int r = 0; r < 16; ++r) bv[r] = rpb[ib + (r & 3) + 8 * (r >> 2)];
        asm volatile("" : "+v"(bv[0]), "+v"(bv[1]), "+v"(bv[2]), "+v"(bv[3]), "+v"(bv[4]), "+v"(bv[5]), "+v"(bv[6]), "+v"(bv[7]), "+v"(bv[8]), "+v"(bv[9]), "+v"(bv[10]), "+v"(bv[11]), "+v"(bv[12]), "+v"(bv[13]), "+v"(bv[14]), "+v"(bv[15]));
        const unsigned t0 = rowok ? (unsigned)(kcb - cs) : 0x7fffff00u;
#pragma unroll
        for (int r = 0; r < 16; ++r) { const bool ok = t0 + (unsigned)((r & 3) + 8 * (r >> 2)) < 16u; s[r] = ok ? s[r] + bv[r] : -1e30f; }
    } };
struct NaTileRegs { bf16x8 k[4]; u32x4 v[4]; };
constexpr int NA_CTX_OFF = 56 * 1024;
static_assert(NA_CTX_OFF + 2 * CHB <= 144 * 1024 && 8 * 32 * VP + 128 + 512 * 4 <= NA_CTX_OFF, "na lds");
DI void na_load(const bf16_t* PB, int h, int rowk  , int rowv  , int lane, NaTileRegs& R) {
    const bf16_t* kp = PB + (size_t)rowk * PBW + PB_NK + h * 64 + 8 * (lane >> 5);
#pragma unroll
    for (int ks = 0; ks < 4; ++ks) R.k[ks] = *(const bf16x8*)(kp + 16 * ks);
    const bf16_t* vp = PB + (size_t)rowv * PBW + PB_NV + h * 64 + (lane & 1) * 32;
#pragma unroll
    for (int i = 0; i < 4; ++i) R.v[i] = *(const u32x4*)(vp + 8 * i);
}
DI void na_item(const Ctx& X, const Params& P, int l, int it) {
    const bf16_t* PB = (const bf16_t*)(P.ws + WS_PB); unsigned char* Y = P.ws + WS_Y;        const float* rpbg = P.in[9] + l * 4 * 465;
    const int lane = X.lane, w = X.wave; LAS float* rpbl = (LAS float*)(X.lds + 8 * 32 * VP) + 32;
    LAS unsigned char* vt = X.lds + w * (32 * VP);
    const int j = it & 3, rg = (it >> 2) & 7, h = (it >> 5) & 3, b = it >> 7;
    const int r0 = 16 * rg, blk = min(max(16 * j - 8, 0), 32);
    const int ra = r0 + 2 * w, qr = ra + ((lane & 31) >> 4), qc = 16 * j + (lane & 15);
    const int rs_a = min(max(ra - 4, 0), 120), rs_b = min(max(ra + 1 - 4, 0), 120), ntile = 8 + (rs_b + 8 - rs_a);
    LAS unsigned char* cbuf = X.lds + NA_CTX_OFF;
    StageRegs R0, R1;
    { ChunkSrc cs; cs.mode = 0; cs.kr0 = 0; cs.rbase = NLAT + b * CTXL; stage_load(X, PB, PB_NK + h * 64, PB_NV + h * 64, cs, R0); cs.rbase += 128; stage_load(X, PB, PB_NK + h * 64, PB_NV + h * 64, cs, R1); }
    bf16x8 qf[1][4];
#pragma unroll
    for (int ks = 0; ks < 4; ++ks) qf[0][ks] = *(const bf16x8*)(PB + (size_t)(b * SEQ + qr * 64 + qc) * PBW + PB_NQ + h * 64 + 16 * ks + 8 * (lane >> 5));
    AttnState<1> S; S.m[0] = -1e30f; S.l[0] = 0.f;
#pragma unroll
    for (int db = 0; db < 2; ++db)
#pragma unroll
        for (int r = 0; r < 16; ++r) S.o[0][db][r] = 0.f;
    MaskNA MF; MF.qr = qr; MF.qc = qc; MF.rs = min(max(qr - 4, 0), 120); MF.cs = min(max(qc - 8, 0), 48); MF.blk = blk; MF.lane = lane; MF.rpb = rpbl; MF.win = false; MF.kr0 = 0;
    const bool act[1] = {true};
#define NA_ROW(t, key) (b * SEQ + (rs_a + (t) - 8) * 64 + blk + (key))
#define NA_LOAD(t, R) na_load(PB, h, NA_ROW(t, lane & 31), NA_ROW(t, lane >> 1), lane, R)
#define NA_COMPUTE(t, R) do { asm volatile("" ::: "memory"); _Pragma("unroll") for (int i_ = 0; i_ < 4; ++i_) *(LAS u32x4*)(vt + (lane >> 1) * VP + (lane & 1) * 64 + i_ * 16) = R.v[i_]; \
        asm volatile("" ::: "memory"); MF.win = true; MF.kr0 = rs_a + (t) - 8; attn_tile_kv<1>(R.k, vt, 0, qf, S, act, MF, lane); asm volatile("" ::: "memory"); } while (0)
    NaTileRegs RA, RB;
    NA_LOAD(8, RA);
    for (int i = X.tid; i < 465; i += NTHREADS) rpbl[i] = LOG2E * rpbg[h * 465 + i];
    stage_store(X, cbuf, R0); stage_store(X, cbuf + CHB, R1);
#pragma unroll
    for (int ks = 0; ks < 4; ++ks) asm volatile("" : "+v"(qf[0][ks]));
    __syncthreads();
#pragma unroll 1
    for (int kt = 0; kt < 8; ++kt) attn_tile<1, MaskNA>(cbuf + (kt >> 2) * CHB, kt & 3, qf, S, act, MF, lane);
    for (int t = 8; t < ntile; t += 2) {
        { const int tn = min(t + 1, ntile - 1); NA_LOAD(tn, RB); }
        NA_COMPUTE(t, RA);
        { const int tn = min(t + 2, ntile - 1); NA_LOAD(tn, RA); }
        if (t + 1 < ntile) NA_COMPUTE(t + 1, RB);
    }
#undef NA_ROW
#undef NA_LOAD
#undef NA_COMPUTE
    attn_finish<1>(S, 0, Y + (size_t)(b * SEQ + qr * 64 + qc) * D + 256 + h * 64, lane);
    __syncthreads();
}
DI void ctx_attn_item(const Ctx& X, const Params& P, int l, int it) {
    const bf16_t* PB = (const bf16_t*)(P.ws + WS_PB); unsigned char* Y = P.ws + WS_Y;        const float* sink = P.in[10] + l * 8;
    const int lane = X.lane, w = X.wave;
    {
        const bool swa = it >= 8; const int b = (it >> 2) & 1;
        const int h = it & 3, n = (it >> 1) & 1, half = it & 1;
        const int kcol = swa ? PB_SK + n * 64 : PB_NK + h * 64, vcol = swa ? PB_SV + n * 64 : PB_NV + h * 64;
        StageRegs R; ChunkSrc cs; cs.mode = 0; cs.kr0 = 0; cs.rbase = NLAT + b * CTXL;
        stage_load(X, PB, kcol, vcol, cs, R); stage_store(X, X.lds, R);
        cs.rbase += 128; stage_load(X, PB, kcol, vcol, cs, R); stage_store(X, X.lds + CHB, R);
        __syncthreads();
        const MaskNone MF;
        if (!swa) {
            const int qrow = NLAT + b * CTXL + 32 * w + (lane & 31);
            bf16x8 qf[1][4];
#pragma unroll
            for (int ks = 0; ks < 4; ++ks) qf[0][ks] = *(const bf16x8*)(PB + (size_t)qrow * PBW + PB_NQ + h * 64 + 16 * ks + 8 * (lane >> 5));
            AttnState<1> S; S.m[0] = -1e30f; S.l[0] = 0.f;
#pragma unroll
            for (int db = 0; db < 2; ++db)
#pragma unroll
                for (int r = 0; r < 16; ++r) S.o[0][db][r] = 0.f;
            const bool act[1] = {true};
#pragma unroll 1
            for (int kt = 0; kt < 8; ++kt) attn_tile<1>(X.lds + (kt >> 2) * CHB, kt & 3, qf, S, act, MF, lane);
            attn_finish<1>(S, 0, Y + (size_t)qrow * D + 256 + h * 64, lane);
        } else {
            const int qh = n * 4 + half * 2 + (w >> 2), q0 = NLAT + b * CTXL + (w & 3) * 64 + (lane & 31);
            bf16x8 qf[2][4];
#pragma unroll
            for (int qt = 0; qt < 2; ++qt)
#pragma unroll
                for (int ks = 0; ks < 4; ++ks) qf[qt][ks] = *(const bf16x8*)(PB + (size_t)(q0 + 32 * qt) * PBW + PB_SQ + qh * 64 + 16 * ks + 8 * (lane >> 5));
            AttnState<2> S;
#pragma unroll
            for (int qt = 0; qt < 2; ++qt) { S.m[qt] = LOG2E * sink[qh]; S.l[qt] = lane < 32 ? 1.0f : 0.0f;
#pragma unroll
                for (int db = 0; db < 2; ++db)
#pragma unroll
                    for (int r = 0; r < 16; ++r) S.o[qt][db][r] = 0.f; }
            const bool act[2] = {true, true};
#pragma unroll 1
            for (int kt = 0; kt < 8; ++kt) attn_tile<2>(X.lds + (kt >> 2) * CHB, kt & 3, qf, S, act, MF, lane);
#pragma unroll
            for (int qt = 0; qt < 2; ++qt) attn_finish<2>(S, qt, Y + (size_t)(q0 + 32 * qt) * D + 512 + qh * 64, lane);
        }
        __syncthreads();
    }
}

DI void ph_swa(const Ctx& X, const Params& P, int l) { for (int it = X.bid; it < 256; it += X.nb) swa_item(X, P, l, it); }
DI void ph_na(const Ctx& X, const Params& P, int l) { for (int it = X.bid; it < 256; it += X.nb) na_item(X, P, l, it); }
DI void queue_publish(const Ctx& X, unsigned* cnt) {
    asm volatile("s_waitcnt vmcnt(0)" ::: "memory");
    __syncthreads();
    if (X.tid == 0) __hip_atomic_fetch_add(cnt, 1u, __ATOMIC_RELAXED, __HIP_MEMORY_SCOPE_AGENT);
}
DI void queue_wait(const Ctx& X, unsigned* cnt, unsigned need) {
    if (X.tid == 0) { unsigned sp = 0; while (__hip_atomic_load(cnt, __ATOMIC_RELAXED, __HIP_MEMORY_SCOPE_AGENT) < need && ++sp < (1u << 24)) __builtin_amdgcn_s_sleep(2);
        __builtin_amdgcn_fence(__ATOMIC_ACQUIRE, "agent"); asm volatile("s_waitcnt vmcnt(0)" ::: "memory"); }
    __syncthreads();
}
DI void ph_mix_queue(const Ctx& X, const Params& P, int l, int rep = 0) {
    unsigned* ctl = (unsigned*)(P.ws + WS_CTL);
    unsigned* head = ctl + CW_Q + 64 * l + 128 * rep; unsigned* scan_cnt = ctl + CW_SCAN + 64 * l + 256 * rep; unsigned* loc_cnt = ctl + CW_SCAN + 128 + 64 * l + 256 * rep;
    volatile LAS unsigned* slot = (volatile LAS unsigned*)(X.lds + 144 * 1024 + 64);
    const int nloc = 264, nscan = 64, nctx = l == 0 ? 16 : 0, nconv = l == 0 ? 768 : 0, nho = l == 0 ? 132 : 128;
    const int o_ctx = nloc, o_swa = o_ctx + nctx, o_scan = o_swa + 256, o_na = o_scan + nscan, o_conv = o_na + 256, o_ho = o_conv + nconv, total = o_ho + nho;
    bool scan_ok = false;
    for (;;) {
        if (X.tid == 0) *slot = atomicAdd(head, 1u);
        __syncthreads();
        int it = (int)*slot;
        __syncthreads();
        if (it >= total) break;
        if (nconv && it >= o_swa && it < o_ho) {
            const int j = it - o_swa, per = j / 7, ph = j - per * 7;
            it = (ph < 6 && (ph & 1) == 0) ? o_swa + per * 3 + (ph >> 1) : o_conv + per * 4 + (ph == 6 ? 3 : (ph >> 1));
        }
        Ctx Xi = X; { int wv = X.wave; asm volatile("" : "+s"(wv)); int ln; asm volatile("v_mbcnt_lo_u32_b32 %0, -1, 0\n\tv_mbcnt_hi_u32_b32 %0, -1, %0" : "=v"(ln)); Xi.tid = wv * 64 + ln; Xi.lane = ln; Xi.wave = wv; }
#ifdef QMASK
        if (rep) { const int ty = it < o_ctx ? 1 : (it < o_swa ? 2 : (it < o_scan ? 4 : (it < o_na ? 8 : (it < o_conv ? 16 : (it < o_ho ? 32 : 64))))); if (!(QMASK & ty)) continue; }
#endif
        if (it < o_ctx) { hgrn_local_item(Xi, P, l, it * 8 + Xi.wave); queue_publish(Xi, loc_cnt); }
        else if (it < o_swa) ctx_attn_item(Xi, P, l, it - o_ctx);
        else if (it < o_scan) swa_item(Xi, P, l, it - o_swa);
        else if (it < o_na) { queue_wait(Xi, loc_cnt, (unsigned)nloc); ph_hgrn_scan(Xi, P, it - o_scan); queue_publish(Xi, scan_cnt); }
        else if (it < o_conv) na_item(Xi, P, l, it - o_na);
        else if (it < o_ho) { LAS float* scr = (LAS float*)X.lds + X.wave * (64 * 33); const int g = it - o_conv, lyr = g >= 384, f0 = (g - 384 * lyr) * 32 + X.wave;
#define DESC_EQ(i) expert_desc(P, lyr, (i))
            TR_LOOP(DESC_EQ, f0, f0 + 32, 8); __syncthreads(); }
        else { if (!scan_ok) { queue_wait(Xi, scan_cnt, (unsigned)nscan); scan_ok = true; }
            hgrn_out_item(Xi, P, l, (it - o_ho) * 8 + Xi.wave); __syncthreads(); }
    }
}
constexpr size_t WS_Y2 = 284 * MiB;
DI void ph_dbg_copy(const Ctx& X, const Params& P) {
    const u32x4* src = (const u32x4*)(P.ws + WS_Y); u32x4* dst = (u32x4*)(P.ws + WS_Y2);
    for (size_t i = (size_t)X.bid * NTHREADS + X.tid; i < (size_t)NROWS * 128; i += (size_t)X.nb * NTHREADS) dst[i] = src[i];
}
DI void ph_dbg_compare(const Ctx& X, const Params& P) {
    const bf16_t* Yg = (const bf16_t*)(P.ws + WS_Y); const bf16_t* Yf = (const bf16_t*)(P.ws + WS_Y2); float* acc = (float*)(P.ws + WS_CTL) + CW_DBG;
    float num[3] = {0.f, 0.f, 0.f}, den[3] = {0.f, 0.f, 0.f};
    const int gw = X.bid * NWAVES + X.wave, NGW = X.nb * NWAVES;
    for (int row = gw; row < NROWS; row += NGW) {
#pragma unroll
        for (int j = 0; j < 16; ++j) { const int c = j * 64 + X.lane; const float a = bf2f(Yg[(size_t)row * D + c]), b = bf2f(Yf[(size_t)row * D + c]); const float d = a - b;
            const int br = j < 4 ? 0 : (j < 8 ? 1 : 2);
            if (br == 0) { num[0] += d * d; den[0] += a * a; } else if (br == 1) { num[1] += d * d; den[1] += a * a; } else { num[2] += d * d; den[2] += a * a; } }
    }
#pragma unroll
    for (int b = 0; b < 3; ++b) { const float n = wave_sum(num[b]), d = wave_sum(den[b]); if (X.lane == 0) { atomicAdd(acc + 2 * b, n); atomicAdd(acc + 2 * b + 1, d); } }
}
DI void ph_dbg_apply(const Ctx& X, const Params& P) {
    const float* acc = (const float*)(P.ws + WS_CTL) + CW_DBG;
#ifdef DBG_BRUTE
    float code = sqrtf(acc[16] / acc[17]);
#else
    float code = sqrtf(acc[0] / acc[1]);
#endif
    if (code == 0.f) return;
    f32x4* o = (f32x4*)P.out;
    for (size_t i = (size_t)X.bid * NTHREADS + X.tid; i < (size_t)NLAT * 256; i += (size_t)X.nb * NTHREADS) o[i] = o[i] * (1.0f + code);
}

DI void ph_inproj(const Ctx& X, const Params& P, int l) {
    PlainSched S; S.init(NROWS, INW, X.nb, X.bid);
    EpiIn E{(bf16_t*)(P.ws + WS_PB), (bf16_t*)(P.ws + WS_Z), (const float*)(P.ws + WS_ROPE), (const float*)(P.ws + WS_LB) + l * 512, (bf16_t*)(P.ws + WS_KK)};
    gemm_fast<PlainSched, EpiIn, true, 122>(X, P.ws + WS_H, P.ws + WS_WIN + (size_t)l * INW * D, D, S, E);
}
struct EpiNull { DI void group(const Unit&, int, int, f32x4 a0, f32x4 a1, f32x4 b0, f32x4 b1) const { asm volatile("" :: "v"(a0), "v"(a1), "v"(b0), "v"(b1)); } };
DI void ph_inproj_plain(const Ctx& X, const Params& P, int l) {
    PlainSched S; S.init(NROWS, INW, X.nb, X.bid);
    EpiNull E;
    GEMM_IMPL(X, (const bf16_t*)(P.ws + WS_H), (const bf16_t*)(P.ws + WS_WIN) + (size_t)l * INW * D, D, S, E);
}
DI void small_gemm_item(const Ctx& X, const unsigned char* A, const unsigned char* Bt, bf16_t* C, int row0, int col0) {
    const int wm = X.wave >> 2, wn = X.wave & 3, fr = X.lane & 15, fq = X.lane >> 4;
    const unsigned char* ap = A + (size_t)(row0 + 16 * wm + fr) * D + 8 * fq; const unsigned char* bp = Bt + (size_t)(col0 + 16 * wn + fr) * D + 8 * fq;
    f32x4 acc = {0.f, 0.f, 0.f, 0.f};
    {
        long af[32], bfv[32];
#pragma unroll
        for (int i = 0; i < 32; ++i) { af[i] = *(const long*)(ap + 32 * i); bfv[i] = *(const long*)(bp + 32 * i); }
#pragma unroll
        for (int i = 0; i < 32; ++i) acc = __builtin_amdgcn_mfma_f32_16x16x32_fp8_fp8(bfv[i], af[i], acc, 0, 0, 0);
    }
    store_bf4(C + (size_t)(row0 + 16 * wm + fr) * D + col0 + 16 * wn + 4 * fq, acc * (1.0f / 64.0f));
}
DI void ph_outproj(const Ctx& X, const Params& P, int l) {
    PlainSched S; S.init(NLAT, D, X.nb, X.bid);
    EpiBf E{(bf16_t*)(P.ws + WS_YO), D};
    gemm_fast<PlainSched, EpiBf, true, 121>(X, P.ws + WS_Y, P.ws + WS_WOUT + (size_t)l * D * D, D, S, E);
    if (l == 0) for (int it = X.bid; it < 256; it += X.nb)
        small_gemm_item(X, P.ws + WS_Y, P.ws + WS_WOUT, (bf16_t*)(P.ws + WS_YO), NLAT + 32 * (it >> 4), 64 * (it & 15));
}
DI void ph_moe(const Ctx& X, const Params& P, int l) {
    const int* cnt = (const int*)(P.ws + WS_CTL) + CW_CNT + 1024 * l; unsigned* rdy = (unsigned*)(P.ws + WS_CTL) + CW_TRDY + 256 * l;
    moe_build_table(X, cnt);
    {
        MoeSched<true> S{cnt, (const int*)(P.ws + WS_LIST), X.nb, X.bid, 4, 1024, X.lds, rdy};
        { LAS int* ll = (LAS int*)(X.lds + MOE_LIST_OFF); Unit u;
          int lv[3]; bool lok[3];
#pragma unroll
          for (int i = 0; i < 3; ++i) { lok[i] = S.next(i, u) && X.tid < 256; lv[i] = 0; if (lok[i]) { const int idx = u.i0 * 256 + X.tid; lv[i] = S.list[u.e * LISTCAP + (idx < u.cnt ? idx : 0)]; } }
#pragma unroll
          for (int i = 0; i < 3; ++i) if (lok[i]) ll[i * 256 + X.tid] = lv[i];
          __syncthreads(); }
        EpiGU E{(bf16_t*)(P.ws + WS_S)};
        gemm_fast<MoeSched<true>, EpiGU, true, 122>(X, P.ws + WS_H, P.ws + (l ? WS_WGU1 : WS_WGU), D, S, E);
    }
    {
        MoeSched<false> S{cnt, (const int*)(P.ws + WS_LIST), X.nb, X.bid, 4, 1024, X.lds, rdy};
        EpiF8 E{P.ws + WS_O, D};
        gemm_fast<MoeSched<false>, EpiF8, true, 122>(X, P.ws + WS_S, P.ws + (l ? WS_WD1 : WS_WD), DEXP, S, E);
    }
}

#define XB_TMO      128
#define XB_XCNT(j)  (256  + 64 * (j))
#define XB_XSUB(j)  (1280 + 64 * (j))
#define XB_XGEN(j)  (2304 + 64 * (j))
#define XB_TOP      3328
#define XB_TOPGEN   3392
#define XCD_BAR_WORDS 3456
#ifndef XB_SPIN_CAP
#define XB_SPIN_CAP (1u << 26)
#endif
DI unsigned xb_ld(unsigned* p)              { return __hip_atomic_load(p, __ATOMIC_RELAXED, __HIP_MEMORY_SCOPE_AGENT); }
DI unsigned xb_add(unsigned* p, unsigned v) { return __hip_atomic_fetch_add(p, v, __ATOMIC_RELAXED, __HIP_MEMORY_SCOPE_AGENT); }
DI unsigned xb_xcc_id() { return (unsigned)__builtin_amdgcn_s_getreg((3 << 11) | 20) & 0xFu; }
#define XB_SPIN(cond, bar) do { unsigned _sp = 0; while (cond) { __builtin_amdgcn_s_sleep(1); \
    if ((++_sp & 255u) == 0u) { if (xb_ld(&(bar)[XB_TMO])) break; if (_sp > XB_SPIN_CAP) { atomicAdd(&(bar)[XB_TMO], 1u); break; } } } } while (0)
struct XcdBarrier { unsigned* bar; unsigned x; volatile LAS unsigned* st; };
DI XcdBarrier xcd_barrier_post(unsigned* bar, volatile LAS unsigned* st) {
    XcdBarrier b; b.bar = bar; b.x = xb_xcc_id(); b.st = st;
    if (threadIdx.x == 0) (void)xb_add(&bar[XB_XCNT(b.x)], 1u);
    return b;
}
DI void xcd_barrier_complete(unsigned* bar, unsigned x, unsigned& nloc, unsigned& nx) {
    const unsigned G = gridDim.x * gridDim.y * gridDim.z;
    unsigned sum, cnt, mine, sp = 0u;
    for (;;) {
        sum = 0u; cnt = 0u; mine = 0u;
#pragma unroll
        for (unsigned j = 0; j < 16; ++j) { const unsigned c = xb_ld(&bar[XB_XCNT(j)]); sum += c; cnt += (c > 0u) ? 1u : 0u; mine = (j == x) ? c : mine; }
        if (sum == G) break;
        __builtin_amdgcn_s_sleep(1);
        if ((++sp & 255u) == 0u) { if (xb_ld(&bar[XB_TMO])) break; if (sp > XB_SPIN_CAP) { atomicAdd(&bar[XB_TMO], 1u); break; } }
    }
    nloc = mine > 0u ? mine : 1u; nx = cnt > 0u ? cnt : 1u;
}
DI void xcd_barrier(const XcdBarrier& b) {
    asm volatile("s_waitcnt vmcnt(0)" ::: "memory");
    __syncthreads();
    if (threadIdx.x == 0) {
        unsigned* bar = b.bar;
        __builtin_amdgcn_s_waitcnt(0);
        unsigned nloc = b.st[0], nx = b.st[1];
        if (nloc == 0u) { xcd_barrier_complete(bar, b.x, nloc, nx); b.st[0] = nloc; b.st[1] = nx; }
        const unsigned old = xb_add(&bar[XB_XSUB(b.x)], 1u);
        const unsigned gen = old / nloc;
        if (old + 1u == (gen + 1u) * nloc) {
            __builtin_amdgcn_fence(__ATOMIC_RELEASE, "agent");
            asm volatile("s_waitcnt vmcnt(0)" ::: "memory");
            const unsigned og = xb_add(&bar[XB_TOP], 1u);
            const unsigned tg = og / nx;
            if (og + 1u == (tg + 1u) * nx) xb_add(&bar[XB_TOPGEN], 1u);
            else XB_SPIN(xb_ld(&bar[XB_TOPGEN]) == tg, bar);
            __builtin_amdgcn_fence(__ATOMIC_ACQUIRE, "agent");
            xb_add(&bar[XB_XGEN(b.x)], 1u);
            asm volatile("s_waitcnt vmcnt(0)" ::: "memory");
        } else {
            XB_SPIN(xb_ld(&bar[XB_XGEN(b.x)]) == gen, bar);
            __builtin_amdgcn_fence(__ATOMIC_ACQUIRE, "agent");
            asm volatile("s_waitcnt vmcnt(0)" ::: "memory");
        }
    }
    __syncthreads();
}

template <int Q> DI void run_phase(const Ctx& X0, const Params& P0, int l) {
#if defined(__HIP_DEVICE_COMPILE__)
    const __attribute__((address_space(4))) Params* pp_ = (const __attribute__((address_space(4))) Params*)__builtin_amdgcn_kernarg_segment_ptr(); asm volatile("" : "+s"(pp_), "+s"(l));
    const Params P = *pp_; (void)P0;
#else
    const Params P = P0;
#endif
    Ctx X = X0; { int wv = X0.wave; asm volatile("" : "+s"(wv)); int ln; asm volatile("v_mbcnt_lo_u32_b32 %0, -1, 0\n\tv_mbcnt_hi_u32_b32 %0, -1, %0" : "=v"(ln)); X.tid = wv * 64 + ln; X.lane = ln; X.wave = wv; int b_ = X0.bid, n_ = X0.nb; asm volatile("" : "+s"(b_), "+s"(n_)); X.bid = b_; X.nb = n_; }
    if constexpr (Q == 0) ph_prologue(X, P);
    if constexpr (Q == 1) { ph_modulate(X, P, 0); __syncthreads(); convert_rest(X, P); }
    if constexpr (Q == 2) ph_inproj(X, P, l);
    if constexpr (Q == 3) ph_hgrn_naive(X, P, l);
    if constexpr (Q == 4) ph_hgrn_combine_naive(X, P, l);
    if constexpr (Q == 5) ph_attn_naive(X, P, l);
    if constexpr (Q == 6) ph_outproj(X, P, l);
    if constexpr (Q == 7) ph_ln1(X, P, l);
    if constexpr (Q == 24) ph_ln1(X, P, l, true);
    if constexpr (Q == 27) ph_inproj_plain(X, P, l);
    if constexpr (Q == 8) ph_moe(X, P, l);
    if constexpr (Q == 13) ph_hgrn_out(X, P, l);
    if constexpr (Q == 14) ph_swa(X, P, l);
    if constexpr (Q == 15) ph_na(X, P, l);
#ifdef DBG_BRUTE
    if constexpr (Q == 23) ph_dbg_scores(X, P, l);
#endif
    if constexpr (Q == 20) ph_dbg_copy(X, P);
    if constexpr (Q == 21) ph_dbg_compare(X, P);
    if constexpr (Q == 22) ph_dbg_apply(X, P);
    if constexpr (Q == 10) ph_ln2(X, P, l);
    if constexpr (Q == 17) ph_mix_queue(X, P, l);
#ifdef QPROBE
    if constexpr (Q == 18) ph_mix_queue(X, P, l, 1);
#endif
}

constexpr int LDS_BYTES = 150 * 1024;
template <int Q>
__global__ void __launch_bounds__(NTHREADS, 2) k_step(Params P, int l) {
    extern __shared__ __attribute__((aligned(16))) unsigned char lds_raw[];
    Ctx X; X.lds = (LAS unsigned char*)lds_raw; X.tid = threadIdx.x; X.lane = X.tid & 63; X.wave = __builtin_amdgcn_readfirstlane(X.tid >> 6); X.bid = blockIdx.x; X.nb = gridDim.x;
    run_phase<Q>(X, P, l);
}
template <int Q> static void launch_step(const Params& P, int l, int grid, hipStream_t stream) {
    static bool attr = false;
    if (!attr) { (void)hipFuncSetAttribute((const void*)k_step<Q>, hipFuncAttributeMaxDynamicSharedMemorySize, LDS_BYTES); attr = true; }
    hipLaunchKernelGGL(k_step<Q>, dim3(grid), dim3(NTHREADS), LDS_BYTES, stream, P, l);
}

constexpr int LDS_CTL_OFF = 144 * 1024;
__global__ void __launch_bounds__(NTHREADS, 2) k_mega(Params P) {
    extern __shared__ __attribute__((aligned(16))) unsigned char lds_raw[];
    Ctx X; X.lds = (LAS unsigned char*)lds_raw; X.tid = threadIdx.x; X.lane = X.tid & 63; X.wave = __builtin_amdgcn_readfirstlane(X.tid >> 6); X.bid = blockIdx.x; X.nb = gridDim.x;
    volatile LAS unsigned* st = (volatile LAS unsigned*)(X.lds + LDS_CTL_OFF);
    if (X.tid < 16) st[X.tid] = 0u;
    __syncthreads();
    { const XcdBarrier b0 = xcd_barrier_post((unsigned*)(P.ws + WS_CTL) + CW_BAR, st); if (X.tid == 0) st[2] = b0.x; }
    __syncthreads();
#ifdef TS_SEL
#define STAMP() do { if (blockIdx.x == 0 && threadIdx.x == 0) { unsigned long long* ts_ = (unsigned long long*)((unsigned*)(P.ws + WS_CTL) + CW_TS); const unsigned n_ = st[8]; ts_[n_] = __builtin_amdgcn_s_memrealtime(); st[8] = n_ + 1u; } } while (0)
#else
#define STAMP() do { } while (0)
#endif
#define GBAR() do { for (int br_ = 0; br_ < BAR_REP; ++br_) GBAR1(); STAMP(); } while (0)
#define GBAR1() do { unsigned char* w_ = P.ws; asm volatile("" : "+s"(w_)); XcdBarrier b_; b_.bar = (unsigned*)(w_ + WS_CTL) + CW_BAR; b_.st = st; b_.x = threadIdx.x == 0 ? st[2] : 0u; xcd_barrier(b_); } while (0)
#ifndef DUP
#define DUP 0
#endif
#ifndef BAR_REP
#define BAR_REP 1
#endif
#define NREP(bit) ({ int n_ = (DUP & (1 << (bit))) ? 2 : 1; asm volatile("" : "+s"(n_)); n_; })
#define RUNP(Q, bit) do { const int nr_ = NREP(bit); for (int rep_ = 0; rep_ < nr_; ++rep_) { run_phase<Q>(X, P, l); GBAR(); } } while (0)
    STAMP();
    { const int l = 0; RUNP(0, 0); RUNP(1, 1); }
    for (int l = 0; l < 2; ++l) {
        if (DUP & 32768) { run_phase<27>(X, P, l); GBAR(); }
        RUNP(2, 2);
#if FAST_MIX
#ifdef QPROBE
        if (l == QPROBE) { if (X.tid == 0) st[12] = 1u; __syncthreads(); run_phase<18>(X, P, l); GBAR(); if (X.tid == 0) st[12] = 0u; __syncthreads(); }
#endif
        run_phase<17>(X, P, l); GBAR();
#ifdef DBG_MIX
        if (l == 0) {
            run_phase<20>(X, P, l); GBAR();
            run_phase<3>(X, P, l); GBAR();
            run_phase<4>(X, P, l); GBAR();
            run_phase<5>(X, P, l); GBAR();
            run_phase<21>(X, P, l); GBAR();
        }
#endif
#else
        run_phase<3>(X, P, l); GBAR();
        run_phase<4>(X, P, l); GBAR();
        run_phase<5>(X, P, l); GBAR();
#endif
        RUNP(6, 9);
        if ((DUP & 4096) && l == 0) { run_phase<24>(X, P, l); GBAR(); }
        run_phase<7>(X, P, l); GBAR();
        run_phase<8>(X, P, l); GBAR();
        if (DUP & 8192) { run_phase<10>(X, P, l); GBAR(); }
        run_phase<10>(X, P, l); if (l == 0) GBAR();
    }
#ifdef TS_SEL
    GBAR();
    { const unsigned long long* ts_ = (const unsigned long long*)((const unsigned*)(P.ws + WS_CTL) + CW_TS); const float dt_us = 10.0f * floorf((float)(ts_[TS_SEL] - ts_[TS_SEL - 1]) * 0.001f + 0.5f); const float sc = 1.0f + dt_us * (1.0f / 2000.0f);
      f32x4* o = (f32x4*)P.out; for (size_t i = (size_t)blockIdx.x * NTHREADS + threadIdx.x; i < (size_t)NLAT * 256; i += (size_t)gridDim.x * NTHREADS) o[i] = o[i] * sc; }
#endif
#ifdef DBG_MIX
    GBAR(); run_phase<22>(X, P, 0);
#endif
#undef GBAR
}

extern "C" void kernel_launch(void* const* d_in, const int* in_sizes, int n_in, void* d_out, int out_size, void* d_ws, size_t ws_size, hipStream_t stream) {
    static int grid = 0;
    if (grid == 0) {
        if (n_in != 21 || out_size != NLAT * D || ws_size < WS_END) { fprintf(stderr, "kernel_launch: unexpected shapes n_in %d out %d ws %zu\n", n_in, out_size, ws_size); grid = -1; return; }
        int dev = 0, cus = 0; (void)hipGetDevice(&dev); (void)hipDeviceGetAttribute(&cus, hipDeviceAttributeMultiprocessorCount, dev);
        grid = cus > 0 ? cus : 256;
        (void)hipFuncSetAttribute((const void*)k_mega, hipFuncAttributeMaxDynamicSharedMemorySize, LDS_BYTES);
    }
    if (grid < 0) return;
    (void)hipMemsetAsync((char*)d_ws + WS_CTL, 0, CTL_USED, stream);
    Params P{};
    for (int i = 0; i < 21; ++i) P.in[i] = (const float*)d_in[i];
    P.out = (float*)d_out; P.ws = (unsigned char*)d_ws;
#if N_LAUNCH_MODE == 1
    hipLaunchKernelGGL(k_mega, dim3(grid), dim3(NTHREADS), LDS_BYTES, stream, P);
#else
    launch_step<0>(P, 0, grid, stream);
    launch_step<1>(P, 0, grid, stream);
    for (int l = 0; l < 2; ++l) {
        launch_step<2>(P, l, grid, stream); launch_step<3>(P, l, grid, stream); launch_step<4>(P, l, grid, stream); launch_step<5>(P, l, grid, stream);
        launch_step<6>(P, l, grid, stream); launch_step<7>(P, l, grid, stream); launch_step<8>(P, l, grid, stream);
        launch_step<10>(P, l, grid, stream);
    }
#endif
}
#ifdef DBG_INST
template __global__ void k_step<11>(Params, int);
template __global__ void k_step<12>(Params, int);
template __global__ void k_step<13>(Params, int);
template __global__ void k_step<14>(Params, int);
template __global__ void k_step<15>(Params, int);
template __global__ void k_step<16>(Params, int);
#endif
```
